# Optimizing an MI355X kernel written in HIP

```python
import jax
import jax.numpy as jnp
from jax import lax
import numpy as np


D_MODEL = 1024
BATCH = 8
SEQ = 4096
DEPTH = 2

GRID_W = 64
CTX_LEN = 256
MIX_W = D_MODEL
FOURIER_W = MIX_W // 2
FOURIER_GROUPS = 4
DN_W = MIX_W - FOURIER_W
DN_HEADS = 4
DN_HEAD_DIM = DN_W // DN_HEADS
CONV_K = 5
CHUNK = 64
N_EXPERTS = 32
TOP_K = 4
D_FF_EXPERT = D_MODEL
SWIGLU_LIMIT = 7.0
SWIGLU_ALPHA = 1.702
MOE_BLOCK = 256
IN_W = FOURIER_W + 4 * DN_W + 4 * DN_HEADS
EPS = 1e-6

kernel_name = "hybrid_fourier_gdn_moe_prefix_dit"


def _rms_norm(x, g):
    xf = x.astype(jnp.float32)
    y = xf * lax.rsqrt(jnp.mean(xf * xf, axis=-1, keepdims=True) + EPS) * g.astype(jnp.float32)
    return y.astype(x.dtype)


def _split_mod(m):
    return jnp.split(m[..., None, :], 6, axis=-1)


def _short_conv(u, w):
    ch = u.shape[-1]
    return lax.conv_general_dilated(
        u, w[:, None, :].astype(u.dtype), window_strides=(1,),
        padding=[(CONV_K // 2, CONV_K // 2)],
        dimension_numbers=('NWC', 'WIO', 'NWC'), feature_group_count=ch)


def _l2norm(t):
    return t * lax.rsqrt(jnp.sum(t * t, axis=-1, keepdims=True) + EPS)


def _fourier(f):
    b, l, _ = f.shape
    fg = f.astype(jnp.float32).reshape(b, l, FOURIER_GROUPS, FOURIER_W // FOURIER_GROUPS)
    return jnp.fft.fftn(fg, axes=(1, 3), norm='ortho').real.reshape(b, l, FOURIER_W)


def _dn_inputs(u, conv_w):
    b, l, _ = u.shape
    u = u.astype(jnp.float32)
    qkv = jax.nn.silu(_short_conv(u[..., :3 * DN_W], conv_w.astype(jnp.float32)))
    q, k, v = jnp.split(qkv, 3, axis=-1)
    heads = lambda t: t.reshape(b, l, DN_HEADS, DN_HEAD_DIM).transpose(0, 2, 1, 3)
    q = _l2norm(heads(q)) * (DN_HEAD_DIM ** -0.5)
    k = _l2norm(heads(k))
    v = heads(v)
    z = u[..., 3 * DN_W:4 * DN_W]
    ab = u[..., 4 * DN_W:].reshape(b, l, 2, 2, DN_HEADS)
    return q, k, v, z, ab


def _gated_delta_chunked(q, k, v, g, beta, s0):
    b, h, l, dk = q.shape
    dv = v.shape[-1]
    n = l // CHUNK
    q = q.reshape(b, h, n, CHUNK, dk)
    k = k.reshape(b, h, n, CHUNK, dk)
    v = v.reshape(b, h, n, CHUNK, dv)
    beta = beta.reshape(b, h, n, CHUNK)
    gam = jnp.cumsum(g.reshape(b, h, n, CHUNK), axis=-1)
    idx = jnp.arange(CHUNK)
    incl = idx[:, None] >= idx[None, :]
    strict = idx[:, None] > idx[None, :]
    decay = jnp.exp(jnp.where(incl, gam[..., :, None] - gam[..., None, :], -jnp.inf))
    kb = k * beta[..., None]
    lmat = jnp.where(strict, jnp.einsum('bhnid,bhnjd->bhnij', kb, k) * decay, 0.0)
    eye = jnp.eye(CHUNK, dtype=q.dtype)
    tmat = lax.linalg.triangular_solve(lmat + eye, jnp.broadcast_to(eye, lmat.shape),
                                       left_side=True, lower=True, unit_diagonal=True)
    u_val = tmat @ (v * beta[..., None])
    w_k = tmat @ (kb * jnp.exp(gam)[..., None])
    attn = jnp.einsum('bhnid,bhnjd->bhnij', q, k) * decay
    qg = q * jnp.exp(gam)[..., None]
    kend = k * jnp.exp(gam[..., -1:] - gam)[..., None]
    gend = jnp.exp(gam[..., -1])

    def step(s, xs):
        u_i, w_i, a_i, qg_i, ke_i, ge_i = xs
        v_new = u_i - w_i @ s
        o_i = qg_i @ s + a_i @ v_new
        s = s * ge_i[..., None, None] + jnp.einsum('bhck,bhcv->bhkv', ke_i, v_new)
        return s, o_i

    xs = tuple(jnp.moveaxis(t, 2, 0) for t in (u_val, w_k, attn, qg, kend, gend))
    s_fin, o = lax.scan(step, s0, xs)
    o = jnp.moveaxis(o, 0, 2).reshape(b, h, l, dv)
    return o, s_fin


def _bidir_delta(q, k, v, ab, a_log, dt_bias, s0_fwd, s0_bwd):
    a_log = a_log.astype(jnp.float32)
    dt_bias = dt_bias.astype(jnp.float32)
    outs, states = [], []
    for d, s0 in ((0, s0_fwd), (1, s0_bwd)):
        g = -jnp.exp(a_log[d])[None, :, None] * jax.nn.softplus(
            ab[:, :, d, 0, :].transpose(0, 2, 1) + dt_bias[d][None, :, None])
        beta = jax.nn.sigmoid(ab[:, :, d, 1, :].transpose(0, 2, 1))
        args = (q, k, v, g, beta)
        if d == 1:
            args = tuple(jnp.flip(t, axis=2) for t in args)
        o, s = _gated_delta_chunked(*args, s0)
        if d == 1:
            o = jnp.flip(o, axis=2)
        outs.append(o)
        states.append(s)
    return outs[0] + outs[1], states[0], states[1]


def _gated_out(o, z, g_out):
    b, h, l, dv = o.shape
    o = o.transpose(0, 2, 1, 3)
    o = o * lax.rsqrt(jnp.mean(o * o, axis=-1, keepdims=True) + EPS) * g_out.astype(jnp.float32)
    o = o * jax.nn.silu(z.reshape(b, l, h, dv))
    return o.reshape(b, l, h * dv)


def _moe(h, w_router, b_router, w_gate, b_gate, w_up, b_up, w_down, b_down):
    t, d = h.shape
    logits = (h @ w_router + b_router).astype(jnp.float32)
    top_v, top_i = lax.top_k(logits, TOP_K)
    gates = jax.nn.softmax(top_v, axis=-1)
    tk = t * TOP_K
    flat_e = top_i.reshape(tk)
    flat_tok = jnp.repeat(jnp.arange(t, dtype=jnp.int32), TOP_K)
    flat_g = gates.reshape(tk)
    order = jnp.argsort(flat_e)
    se = flat_e[order]
    counts = jnp.bincount(flat_e, length=N_EXPERTS)
    group_start = jnp.cumsum(counts) - counts
    padded = (counts + MOE_BLOCK - 1) // MOE_BLOCK * MOE_BLOCK
    padded_end = jnp.cumsum(padded)
    padded_start = padded_end - padded
    dest = padded_start[se] + jnp.arange(tk) - group_start[se]
    n_blocks = -(-tk // MOE_BLOCK) + N_EXPERTS
    p = n_blocks * MOE_BLOCK
    slot_tok = jnp.full((p,), t, jnp.int32).at[dest].set(flat_tok[order])
    slot_gate = jnp.zeros((p,), jnp.float32).at[dest].set(flat_g[order])
    block_e = jnp.minimum(
        jnp.searchsorted(padded_end, jnp.arange(n_blocks) * MOE_BLOCK, side='right'), N_EXPERTS - 1)
    h_pad = jnp.concatenate([h, jnp.zeros((1, d), h.dtype)], axis=0)

    def expert_block(args):
        tok, gate, e = args
        xb = h_pad[tok]
        a = jnp.minimum(xb @ w_gate[e] + b_gate[e], SWIGLU_LIMIT)
        u = jnp.clip(xb @ w_up[e] + b_up[e], -SWIGLU_LIMIT, SWIGLU_LIMIT)
        y = (a * jax.nn.sigmoid(SWIGLU_ALPHA * a) * (u + 1.0)) @ w_down[e] + b_down[e]
        return y * gate[:, None].astype(y.dtype)

    y = lax.map(expert_block, (slot_tok.reshape(n_blocks, MOE_BLOCK),
                               slot_gate.reshape(n_blocks, MOE_BLOCK), block_e))
    return jnp.zeros((t + 1, d), h.dtype).at[slot_tok].add(y.reshape(p, d))[:t]


def _layer(x, xc, c, c_ctx, w_mod, b_mod, g_norm1, w_in, conv_w, a_log, dt_bias, g_out_norm,
           w_out, g_norm2, w_router, b_router, w_gate, b_gate, w_up, b_up, w_down, b_down,
           update_ctx):
    dt = x.dtype
    bsz, seq, d = x.shape
    sh1, sc1, gt1, sh2, sc2, gt2 = _split_mod(jax.nn.silu(c) @ w_mod + b_mod)
    sh1c, sc1c, gt1c, sh2c, sc2c, gt2c = _split_mod(jax.nn.silu(c_ctx) @ w_mod + b_mod)

    hx = _rms_norm(x, g_norm1) * (1.0 + sc1) + sh1
    hc = _rms_norm(xc, g_norm1) * (1.0 + sc1c) + sh1c
    ux = hx @ w_in
    uc = hc @ w_in

    qc, kc, vc, zc, abc = _dn_inputs(uc[..., FOURIER_W:], conv_w)
    s_zero = jnp.zeros((xc.shape[0], DN_HEADS, DN_HEAD_DIM, DN_HEAD_DIM), jnp.float32)
    oc, s_ctx_f, s_ctx_b = _bidir_delta(qc, kc, vc, abc, a_log, dt_bias, s_zero, s_zero)

    qx, kx, vx, zx, abx = _dn_inputs(ux[..., FOURIER_W:], conv_w)
    ox, _, _ = _bidir_delta(qx, kx, vx, abx, a_log, dt_bias, s_ctx_f, s_ctx_b)

    mix_x = jnp.concatenate([_fourier(ux[..., :FOURIER_W]), _gated_out(ox, zx, g_out_norm)],
                            axis=-1).astype(dt) @ w_out
    x = x + gt1 * mix_x
    h2x = _rms_norm(x, g_norm2) * (1.0 + sc2) + sh2

    if update_ctx:
        mix_c = jnp.concatenate([_fourier(uc[..., :FOURIER_W]), _gated_out(oc, zc, g_out_norm)],
                                axis=-1).astype(dt) @ w_out
        xc = xc + gt1c * mix_c
        h2c = _rms_norm(xc, g_norm2) * (1.0 + sc2c) + sh2c
        n_lat = bsz * seq
        tokens = jnp.concatenate([h2x.reshape(n_lat, d), h2c.reshape(-1, d)], axis=0)
        y = _moe(tokens, w_router, b_router, w_gate, b_gate, w_up, b_up, w_down, b_down)
        x = x + gt2 * y[:n_lat].reshape(bsz, seq, d)
        xc = xc + gt2c * y[n_lat:].reshape(xc.shape)
    else:
        y = _moe(h2x.reshape(bsz * seq, d), w_router, b_router, w_gate, b_gate, w_up, b_up,
                 w_down, b_down)
        x = x + gt2 * y.reshape(bsz, seq, d)
    return x, xc


def setup_inputs(seed: int = 0) -> dict:
    key = jax.random.key(seed)
    ks = jax.random.split(key, 26)
    d, nl, e, f = D_MODEL, DEPTH, N_EXPERTS, D_FF_EXPERT
    f32 = jnp.float32

    def nrm(k, shape, fan_in, s=1.0):
        return s * jax.random.normal(k, shape, f32) * (fan_in ** -0.5)

    def small(k, shape, s=0.02):
        return s * jax.random.normal(k, shape, f32)

    dt_init = jnp.exp(jax.random.uniform(ks[10], (nl, 2, DN_HEADS), f32,
                                         jnp.log(1e-3), jnp.log(1e-1)))
    return {
        'x': jax.random.normal(ks[0], (BATCH, SEQ, d), f32),
        'c': jax.random.normal(ks[1], (BATCH, d), f32),
        'ctx': jax.random.normal(ks[2], (BATCH, CTX_LEN, d), f32),
        'c_ctx': jax.random.normal(ks[3], (d,), f32),
        'w_mod': nrm(ks[4], (nl, d, 6 * d), d, 0.5),
        'b_mod': small(ks[5], (nl, 6 * d)),
        'g_norm1': 1.0 + small(ks[6], (nl, d)),
        'w_in': nrm(ks[7], (nl, d, IN_W), d),
        'conv_w': nrm(ks[8], (nl, CONV_K, 3 * DN_W), CONV_K),
        'a_log': jnp.log(jax.random.uniform(ks[9], (nl, 2, DN_HEADS), f32, 1.0, 16.0)),
        'dt_bias': dt_init + jnp.log(-jnp.expm1(-dt_init)),
        'g_out_norm': 1.0 + small(ks[11], (nl, DN_HEAD_DIM)),
        'w_out': nrm(ks[12], (nl, MIX_W, d), MIX_W),
        'g_norm2': 1.0 + small(ks[13], (nl, d)),
        'w_router': nrm(ks[14], (nl, d, e), d),
        'b_router': small(ks[15], (nl, e), 0.01),
        'w_gate': nrm(ks[16], (nl, e, d, f), d),
        'b_gate': small(ks[17], (nl, e, f)),
        'w_up': nrm(ks[18], (nl, e, d, f), d),
        'b_up': small(ks[19], (nl, e, f)),
        'w_down': nrm(ks[20], (nl, e, f, d), f),
        'b_down': small(ks[21], (nl, e, d)),
        'g_final': 1.0 + small(ks[22], (d,)),
    }


def reference(x, c, ctx, c_ctx, w_mod, b_mod, g_norm1, w_in, conv_w, a_log, dt_bias,
              g_out_norm, w_out, g_norm2, w_router, b_router, w_gate, b_gate, w_up, b_up,
              w_down, b_down, g_final):
    xc = ctx
    for l in range(DEPTH):
        x, xc = _layer(x, xc, c, c_ctx, w_mod[l], b_mod[l], g_norm1[l], w_in[l], conv_w[l],
                       a_log[l], dt_bias[l], g_out_norm[l], w_out[l], g_norm2[l], w_router[l],
                       b_router[l], w_gate[l], b_gate[l], w_up[l], b_up[l], w_down[l], b_down[l],
                       l < DEPTH - 1)
    return _rms_norm(x, g_final)
```

```cpp
#define MK_ONE_LAUNCH 1
#include <hip/hip_runtime.h>
#include <cstdio>
#include <cstdint>

#ifndef MK_ONE_LAUNCH
#define MK_ONE_LAUNCH 1
#endif

namespace pg8 {
#define PG8_LAS __attribute__((address_space(3)))
typedef unsigned short bf16_t;
typedef short bf16x8 __attribute__((ext_vector_type(8)));
typedef float f32x4 __attribute__((ext_vector_type(4)));
typedef unsigned u32x4 __attribute__((ext_vector_type(4)));
constexpr int BM = 256, BK = 64, HALF = 128, HTB = HALF * BK * 2  , STAGE_BYTES = 8 * HTB, NXCD = 8, WGM = 8;

__host__ __device__ __forceinline__ int lds_byte(int r, int c) { const int st = (r >> 4) * 2 + (c >> 5), rr = r & 15, cc = c & 31, ob = rr * 64 + cc * 2; return st * 1024 + (ob ^ (((ob >> 9) & 1) << 5)); }
__host__ __device__ __forceinline__ void stage_rc(int b, int& R, int& C) { const int st = b / 1024, sb = b % 1024, swz = sb ^ (((sb >> 9) & 1) << 5); R = (st >> 1) * 16 + swz / 64; C = (st & 1) * 32 + (swz % 64) / 2; }
__host__ __device__ __forceinline__ int perm32(int rho) { const int n = rho >> 4, i = rho & 15; return 8 * (i >> 2) + 4 * n + (i & 3); }

struct Unit { int pm, pn, kind, e; };
struct Gemm { int K; };

__device__ __forceinline__ int xcd_remap(int L, int nwg) { const int q = nwg / NXCD, r = nwg % NXCD, xcd = L % NXCD, off = L / NXCD; return (xcd < r ? xcd * (q + 1) : r * (q + 1) + (xcd - r) * q) + off; }
__device__ __forceinline__ void grp_decode(int wgid, int nM, int nN, int& pm, int& pn) { const int nig = WGM * nN, gid = wgid / nig, fm = gid * WGM, gsz = (nM - fm) < WGM ? (nM - fm) : WGM; pm = fm + ((wgid % nig) % gsz); pn = (wgid % nig) / gsz; }

__device__ __forceinline__ unsigned cvt_pk_bf16(float lo, float hi) { unsigned r; asm volatile("v_cvt_pk_bf16_f32 %0, %1, %2" : "=v"(r) : "v"(lo), "v"(hi)); return r; }

template <class Epi, class Sched, bool ALIGN_EPI = false, bool SP2 = false>
__device__ __forceinline__ void gemm_phase(PG8_LAS unsigned char* lds, const Gemm g, const Sched& S, const Epi& E) {
    int tid_ = threadIdx.x; asm volatile("" : "+v"(tid_));
    const int tid = tid_, wid = __builtin_amdgcn_readfirstlane(tid >> 6), lane = tid & 63, wr = wid >> 2, wc = wid & 3, fr = lane & 15, fq = lane >> 4;
    const int K = g.K, nt = K / BK;
    unsigned voffA[2], voffB[2];
#pragma unroll
    for (int i = 0; i < 2; ++i) { int R, C; stage_rc(tid * 16 + i * 8192, R, C); const int Rb = Epi::PERM ? ((R & ~31) + perm32(R & 31)) : R;
        voffA[i] = (unsigned)(R * K + C) * 2u; voffB[i] = (unsigned)(Rb * K + C) * 2u; }
    const size_t kstep = (size_t)(BK * 2);
    const size_t hstep = (size_t)HALF * K * 2;
    const size_t tstep = 2 * hstep;
    const unsigned ldsw = (unsigned)wid * 1024u;
    const int aoff = lds_byte(wr * 64 + fr, fq * 8), boff = lds_byte(wc * 32 + fr, fq * 8);
#define PG8_SA(b, h) (((b) * 2 + (h)) * HTB)
#define PG8_SB(b, h) ((4 + (b) * 2 + (h)) * HTB)
#define PG8_STAGE(bufoff, gbase, voff) do { _Pragma("unroll") for (int _i = 0; _i < 2; ++_i) \
        __builtin_amdgcn_global_load_lds((const unsigned*)((const char*)(gbase) + (voff)[_i]), (PG8_LAS unsigned*)(lds + (bufoff) + ldsw + _i * 8192), 16, 0, 0); } while (0)
#define PG8_LDA(dst, b, h) do { _Pragma("unroll") for (int m = 0; m < 4; ++m) _Pragma("unroll") for (int k = 0; k < 2; ++k) dst[m][k] = *(const PG8_LAS bf16x8*)(lds + PG8_SA(b, h) + aoff + m * 2048 + k * 1024); } while (0)
#define PG8_LDB(dst, b, h) do { _Pragma("unroll") for (int n = 0; n < 2; ++n) _Pragma("unroll") for (int k = 0; k < 2; ++k) dst[n][k] = *(const PG8_LAS bf16x8*)(lds + PG8_SB(b, h) + boff + n * 2048 + k * 1024); } while (0)
#define PG8_MMA(ai, bj, At, Bt) do { __builtin_amdgcn_s_setprio(1); _Pragma("unroll") for (int m = 0; m < 4; ++m) _Pragma("unroll") for (int n = 0; n < 2; ++n) _Pragma("unroll") for (int k = 0; k < 2; ++k) \
        acc[ai][bj][m][n] = __builtin_amdgcn_mfma_f32_16x16x32_bf16(Bt[n][k], At[m][k], acc[ai][bj][m][n], 0, 0, 0); __builtin_amdgcn_s_setprio(0); } while (0)
#define PG8_WAIT_V(n) asm volatile("s_waitcnt vmcnt(" #n ")" ::: "memory")
#define PG8_WAIT_L(n) asm volatile("s_waitcnt lgkmcnt(" #n ")" ::: "memory")
#define PG8_BAR __builtin_amdgcn_s_barrier()
#define PG8_SCHED __builtin_amdgcn_sched_barrier(0)
    Unit cur, nxt; int ui = 0;
    if (!S.next(0, cur)) return;
    f32x4 acc[2][2][4][2];
#pragma unroll
    for (int a = 0; a < 2; ++a)
#pragma unroll
        for (int b = 0; b < 2; ++b)
#pragma unroll
            for (int m = 0; m < 4; ++m)
#pragma unroll
                for (int n = 0; n < 2; ++n) acc[a][b][m][n] = (f32x4){0.f, 0.f, 0.f, 0.f};
    bf16x8 At[4][2], B0[2][2], B1[2][2];
    const char* cA = S.a_base(cur, tstep); const char* cB = S.b_base(cur, tstep);
    S.a_ready(cur);
    if constexpr (SP2) {
        PG8_STAGE(PG8_SB(0, 0), cB, voffB); PG8_STAGE(PG8_SB(0, 1), cB + hstep, voffB); PG8_STAGE(PG8_SA(0, 0), cA, voffA); PG8_STAGE(PG8_SA(0, 1), cA + hstep, voffA);
        if (wr == 1) PG8_BAR;
        PG8_WAIT_V(2); PG8_BAR;
        PG8_STAGE(PG8_SB(1, 0), cB + kstep, voffB); PG8_STAGE(PG8_SA(1, 0), cA + kstep, voffA); PG8_STAGE(PG8_SB(1, 1), cB + hstep + kstep, voffB);
        PG8_WAIT_V(6); PG8_BAR;
    } else {
        PG8_STAGE(PG8_SB(0, 0), cB, voffB); PG8_STAGE(PG8_SA(0, 0), cA, voffA); PG8_STAGE(PG8_SB(0, 1), cB + hstep, voffB); PG8_STAGE(PG8_SA(0, 1), cA + hstep, voffA);
        if (wr == 1) PG8_BAR;
        PG8_WAIT_V(4); PG8_BAR;
        PG8_STAGE(PG8_SB(1, 0), cB + kstep, voffB); PG8_STAGE(PG8_SA(1, 0), cA + kstep, voffA); PG8_STAGE(PG8_SB(1, 1), cB + hstep + kstep, voffB);
        PG8_WAIT_V(6); PG8_BAR;
    }
    for (;;) {
        const bool has_next = S.next(ui + 1, nxt);
        const char* nA = has_next ? S.a_base(nxt, tstep) : cA; const char* nB = has_next ? S.b_base(nxt, tstep) : cB;
        for (int t = 0; t < nt; t += 2) {
            const bool last = (t == nt - 2);
            const char* a1 = cA + (size_t)(t + 1) * kstep;
            const char* a2 = last ? nA : cA + (size_t)(t + 2) * kstep; const char* b2 = last ? nB : cB + (size_t)(t + 2) * kstep;
            const char* a3 = a2 + kstep; const char* b3 = b2 + kstep;
            if (last && has_next) S.a_ready(nxt);
            if constexpr (SP2) {
            PG8_LDB(B0, 0, 0); PG8_LDB(B1, 0, 1); PG8_SCHED; PG8_LDA(At, 0, 0); PG8_STAGE(PG8_SA(1, 1), a1 + hstep, voffA);
            PG8_WAIT_V(8); PG8_WAIT_L(0); PG8_BAR; PG8_MMA(0, 0, At, B0); PG8_MMA(0, 1, At, B1); PG8_BAR; PG8_SCHED;
            PG8_LDA(At, 0, 1); PG8_STAGE(PG8_SB(0, 0), b2, voffB); PG8_STAGE(PG8_SB(0, 1), b2 + hstep, voffB); PG8_STAGE(PG8_SA(0, 0), a2, voffA);
            PG8_WAIT_V(8); PG8_WAIT_L(0); PG8_BAR; PG8_MMA(1, 0, At, B0); PG8_MMA(1, 1, At, B1); PG8_BAR; PG8_SCHED;
            PG8_LDB(B0, 1, 0); PG8_LDB(B1, 1, 1); PG8_SCHED; PG8_LDA(At, 1, 0); PG8_STAGE(PG8_SA(0, 1), a2 + hstep, voffA);
            PG8_WAIT_V(8); PG8_WAIT_L(0); PG8_BAR; PG8_MMA(0, 0, At, B0); PG8_MMA(0, 1, At, B1); PG8_BAR; PG8_SCHED;
            PG8_LDA(At, 1, 1); PG8_STAGE(PG8_SB(1, 0), b3, voffB); PG8_STAGE(PG8_SB(1, 1), b3 + hstep, voffB); PG8_STAGE(PG8_SA(1, 0), a3, voffA);
            PG8_WAIT_V(8); PG8_WAIT_L(0); PG8_BAR; PG8_MMA(1, 0, At, B0); PG8_MMA(1, 1, At, B1); PG8_BAR; PG8_SCHED;
            } else {
            PG8_LDB(B0, 0, 0); PG8_SCHED; PG8_LDA(At, 0, 0); PG8_STAGE(PG8_SA(1, 1), a1 + hstep, voffA);
            PG8_WAIT_L(8); PG8_BAR; PG8_WAIT_L(0); PG8_MMA(0, 0, At, B0); PG8_BAR; PG8_SCHED;
            PG8_LDB(B1, 0, 1); PG8_STAGE(PG8_SB(0, 0), b2, voffB);
            PG8_BAR; PG8_WAIT_L(0); PG8_MMA(0, 1, At, B1); PG8_BAR;
            PG8_LDA(At, 0, 1); PG8_STAGE(PG8_SA(0, 0), a2, voffA);
            PG8_BAR; PG8_WAIT_L(0); PG8_MMA(1, 0, At, B0); PG8_BAR; PG8_SCHED;
            PG8_STAGE(PG8_SB(0, 1), b2 + hstep, voffB);
            PG8_WAIT_V(6); PG8_BAR; PG8_MMA(1, 1, At, B1); PG8_BAR;
            PG8_LDB(B0, 1, 0); PG8_SCHED; PG8_LDA(At, 1, 0); PG8_STAGE(PG8_SA(0, 1), a2 + hstep, voffA);
            PG8_WAIT_L(8); PG8_BAR; PG8_WAIT_L(0); PG8_MMA(0, 0, At, B0); PG8_BAR; PG8_SCHED;
            PG8_LDB(B1, 1, 1); PG8_STAGE(PG8_SB(1, 0), b3, voffB);
            PG8_BAR; PG8_WAIT_L(0); PG8_MMA(0, 1, At, B1); PG8_BAR;
            PG8_LDA(At, 1, 1); PG8_STAGE(PG8_SA(1, 0), a3, voffA);
            PG8_BAR; PG8_WAIT_L(0); PG8_MMA(1, 0, At, B0); PG8_BAR; PG8_SCHED;
            PG8_STAGE(PG8_SB(1, 1), b3 + hstep, voffB);
            PG8_WAIT_V(6); PG8_BAR; PG8_MMA(1, 1, At, B1); PG8_BAR;
            }
        }
        if constexpr (ALIGN_EPI) { if (wr == 0) PG8_BAR; }
        if constexpr (!Epi::AFTER_DRAIN) { E(acc, cur, wr, wc, fr, fq); S.done(cur); }
        if (!has_next) break;
#pragma unroll
        for (int a = 0; a < 2; ++a)
#pragma unroll
            for (int b = 0; b < 2; ++b)
#pragma unroll
                for (int m = 0; m < 4; ++m)
#pragma unroll
                    for (int n = 0; n < 2; ++n) acc[a][b][m][n] = (f32x4){0.f, 0.f, 0.f, 0.f};
        cur = nxt; cA = nA; cB = nB; ++ui;
        if constexpr (ALIGN_EPI) { if (wr == 1) PG8_BAR; }
    }
    PG8_WAIT_V(0);
    if constexpr (!ALIGN_EPI) { if (wr == 0) PG8_BAR; }
    PG8_BAR;
    if constexpr (Epi::AFTER_DRAIN) { E.fused(acc, cur, wr, wc, fr, fq, lds, wid, lane); S.done(cur); }
#undef PG8_SA
#undef PG8_SB
#undef PG8_STAGE
#undef PG8_LDA
#undef PG8_LDB
#undef PG8_MMA
#undef PG8_WAIT_V
#undef PG8_WAIT_L
#undef PG8_BAR
#undef PG8_SCHED
}
}

constexpr int NWAVES = 8, NTHR = 512;
constexpr int D = 1024, NB = 8, SEQ = 4096, CTXL = 256, NL = 2;
constexpr int NLAT = NB * SEQ;
constexpr int NCTX = NB * CTXL;
constexpr int MT = NLAT + NCTX;
constexpr int INW = 2576, NEXP = 32, TOPK = 4;
constexpr int PMAX = (MT * TOPK / 256 + NEXP) * 256;
constexpr float EPS = 1e-6f;

constexpr size_t MiB = 1u << 20;
constexpr size_t WS_CTL = 0, CTL_ZERO_BYTES = 1 * MiB;
constexpr size_t WS_MODV = 1 * MiB;
constexpr size_t WS_WRT = 2 * MiB;
constexpr size_t WS_WABT = WS_WRT + 512 * 1024;
constexpr size_t WS_SELE = 3 * MiB;
constexpr size_t WS_SELP = WS_SELE + 640 * 1024;
constexpr size_t WS_SELG = WS_SELP + 640 * 1024;
constexpr size_t WS_G = 5 * MiB;
constexpr size_t WS_BETA = WS_G + 1536 * 1024;
constexpr size_t WS_AB = 8 * MiB;
constexpr size_t WS_WIN = 12 * MiB;
constexpr size_t WS_WOUT = 24 * MiB;
constexpr size_t WS_DFTM = 32 * MiB;
constexpr size_t WS_W1 = 96 * MiB;
constexpr size_t WS_W2 = 224 * MiB;
constexpr size_t WS_XC = 288 * MiB;
constexpr size_t WS_ACT = 296 * MiB;
constexpr size_t WS_S = 364 * MiB;
constexpr size_t WS_QKVZ = WS_S;
constexpr size_t WS_ZTL = WS_S + 136 * MiB;
constexpr size_t WS_ZTC = WS_ZTL + 64 * MiB;
constexpr size_t WS_QKVN = WS_ZTC + 4 * MiB;
constexpr size_t WS_OF = WS_QKVN + 102 * MiB;
constexpr size_t WS_OB = WS_OF + 34 * MiB;
constexpr size_t WS_XS = WS_S;
constexpr size_t WS_HS = WS_S + 288 * MiB;
constexpr size_t WS_END = 1024 * MiB;
static_assert(WS_OB + 34 * MiB <= WS_END && WS_HS + 288 * MiB <= WS_END && (size_t)PMAX * 1024 * 2 == 288 * MiB, "d_ws map");
static_assert((size_t)MT * 16 <= 640 * 1024 && (size_t)MT * 32 <= 1536 * 1024, "sel / g maps");
constexpr int CW_BAR = 4096;
constexpr int CW_GCNT = 16384;

constexpr int RING_BYTES = 131072;
constexpr int LDSCTL_OFF = RING_BYTES, MISC_OFF = LDSCTL_OFF + 320;
constexpr int XT_OFF = RING_BYTES + 1024;
constexpr int LDS_BYTES = 147456;

#define GAS __attribute__((address_space(1)))
#define LAS __attribute__((address_space(3)))
typedef unsigned short bf16;
typedef unsigned v4u __attribute__((ext_vector_type(4)));
typedef unsigned v2u __attribute__((ext_vector_type(2)));
typedef float f32x4 __attribute__((ext_vector_type(4)));
typedef GAS unsigned gu32;
#define RLX_AGENT __ATOMIC_RELAXED, __HIP_MEMORY_SCOPE_AGENT
#define LDS_WAIT() asm volatile("s_waitcnt lgkmcnt(0)" ::: "memory")
#define VM_WAIT() asm volatile("s_waitcnt vmcnt(0)" ::: "memory")
__device__ __forceinline__ unsigned f2bf(float f) { unsigned u = __builtin_bit_cast(unsigned, f); return (u + 0x7fffu + ((u >> 16) & 1u)) >> 16; }
__device__ __forceinline__ unsigned pk2(float lo, float hi) { return f2bf(lo) | (f2bf(hi) << 16); }
__device__ __forceinline__ float bflo(unsigned w) { return __builtin_bit_cast(float, w << 16); }
__device__ __forceinline__ float bfhi(unsigned w) { return __builtin_bit_cast(float, w & 0xffff0000u); }
__device__ __forceinline__ float wave_sum(float v) {
#pragma unroll
    for (int o = 1; o < 64; o <<= 1) v += __shfl_xor(v, o);
    return v;
}
__device__ __forceinline__ float sum16(float v) {
#pragma unroll
    for (int o = 1; o < 16; o <<= 1) v += __shfl_xor(v, o);
    return v;
}
__device__ __forceinline__ float silu_f(float x) { return x / (1.f + __expf(-x)); }

#define XB_TMO      128
#define XB_XCNT(j)  (256  + 64 * (j))
#define XB_XSUB(j)  (1280 + 64 * (j))
#define XB_XGEN(j)  (2304 + 64 * (j))
#define XB_TOP      3328
#define XB_TOPGEN   3392
#define XCD_BAR_WORDS 3456
#define XB_SPIN_CAP (1u << 18)
__device__ __forceinline__ unsigned xb_ld(unsigned* p)              { return __hip_atomic_load(p, __ATOMIC_RELAXED, __HIP_MEMORY_SCOPE_AGENT); }
__device__ __forceinline__ unsigned xb_add(unsigned* p, unsigned v) { return __hip_atomic_fetch_add(p, v, __ATOMIC_RELAXED, __HIP_MEMORY_SCOPE_AGENT); }
__device__ __forceinline__ unsigned xb_xcc_id() { return (unsigned)__builtin_amdgcn_s_getreg((3 << 11) | 20) & 0xFu; }
#define XB_SPIN(cond, bar) do { unsigned _sp = 0; while (cond) { __builtin_amdgcn_s_sleep(1); \
    if ((++_sp & 255u) == 0u) { if (xb_ld(&(bar)[XB_TMO])) break; if (_sp > XB_SPIN_CAP) { atomicAdd(&(bar)[XB_TMO], 1u); break; } } } } while (0)
struct XcdBarrier { unsigned* bar; unsigned x; volatile LAS unsigned* st; };
__device__ __forceinline__ XcdBarrier xcd_barrier_post(unsigned* bar, volatile LAS unsigned* st) {
    XcdBarrier b; b.bar = bar; b.x = xb_xcc_id(); b.st = st;
    if (threadIdx.x == 0) (void)xb_add(&bar[XB_XCNT(b.x)], 1u);
    return b;
}
__device__ __forceinline__ void xcd_barrier_complete(unsigned* bar, unsigned x, unsigned& nloc, unsigned& nx) {
    const unsigned G = gridDim.x * gridDim.y * gridDim.z;
    unsigned sum, cnt, mine, sp = 0u;
    for (;;) {
        sum = 0u; cnt = 0u; mine = 0u;
#pragma unroll
        for (unsigned j = 0; j < 16; ++j) { const unsigned c = xb_ld(&bar[XB_XCNT(j)]); sum += c; cnt += (c > 0u) ? 1u : 0u; mine = (j == x) ? c : mine; }
        if (sum == G) break;
        __builtin_amdgcn_s_sleep(1);
        if ((++sp & 255u) == 0u) { if (xb_ld(&bar[XB_TMO])) break; if (sp > XB_SPIN_CAP) { atomicAdd(&bar[XB_TMO], 1u); break; } }
    }
    nloc = mine > 0u ? mine : 1u; nx = cnt > 0u ? cnt : 1u;
}
__device__ __forceinline__ void xcd_barrier(const XcdBarrier& b) {
    asm volatile("s_waitcnt vmcnt(0)" ::: "memory");
    __syncthreads();
    if (threadIdx.x == 0) {
        unsigned* bar = b.bar; unsigned bx = b.x;
        asm volatile("" : "+v"(bar), "+v"(bx));
        __builtin_amdgcn_s_waitcnt(0);
        unsigned nloc = b.st[0], nx = b.st[1];
        if (nloc == 0u) { xcd_barrier_complete(bar, bx, nloc, nx); b.st[0] = nloc; b.st[1] = nx; }
        const unsigned old = xb_add(&bar[XB_XSUB(bx)], 1u);
        const unsigned gen = old / nloc;
        if (old + 1u == (gen + 1u) * nloc) {
            __builtin_amdgcn_fence(__ATOMIC_RELEASE, "agent");
            asm volatile("s_waitcnt vmcnt(0)" ::: "memory");
            const unsigned og = xb_add(&bar[XB_TOP], 1u);
            const unsigned tg = og / nx;
            if (og + 1u == (tg + 1u) * nx) xb_add(&bar[XB_TOPGEN], 1u);
            else XB_SPIN(xb_ld(&bar[XB_TOPGEN]) == tg, bar);
            __builtin_amdgcn_fence(__ATOMIC_ACQUIRE, "agent");
            xb_add(&bar[XB_XGEN(bx)], 1u);
            asm volatile("s_waitcnt vmcnt(0)" ::: "memory");
        } else {
            XB_SPIN(xb_ld(&bar[XB_XGEN(bx)]) == gen, bar);
            __builtin_amdgcn_fence(__ATOMIC_ACQUIRE, "agent");
            asm volatile("s_waitcnt vmcnt(0)" ::: "memory");
        }
    }
    __syncthreads();
}

struct Args { const float* in[23]; float* out; unsigned char* ws; int ph_lo, ph_hi; };
struct Frame {
    LAS unsigned char* lds;
    volatile LAS unsigned* MISC;
    unsigned* ctl;
    unsigned char* ws;
    int tid, lane, wave, vcu, G, gw, NGW;
    float* out;
};
__device__ __forceinline__ const Args* kargs() { const void* p = (const void*)__builtin_amdgcn_kernarg_segment_ptr(); asm volatile("" : "+s"(p)); return (const Args*)p; }
enum InIdx { I_X = 0, I_C, I_CTX, I_CCTX, I_WMOD, I_BMOD, I_GN1, I_WIN, I_CONVW, I_ALOG, I_DTB, I_GOUT, I_WOUT, I_GN2, I_WR, I_BR, I_WG, I_BG, I_WU, I_BU, I_WD, I_BD, I_GF };
__device__ __forceinline__ float* xr_row(const Frame& F, int t) { return t < NLAT ? F.out + (size_t)t * D : (float*)(F.ws + WS_XC) + (size_t)(t - NLAT) * D; }
__device__ __forceinline__ int mod_row(int t) { return t < NLAT ? (t >> 12) : 8; }
__device__ __forceinline__ const float* modv(const Frame& F, int l, int r, int piece) { return (const float*)(F.ws + WS_MODV) + ((size_t)(l * 9 + r) * 6 + piece) * D; }

struct SchedIn {
    const bf16* hx; const bf16* win; int G, c;
    static constexpr int N0 = (MT / 256) * 8, N1 = 4 * (MT / 256), NWG = N0 + N1;
    __device__ __forceinline__ bool next(int i, pg8::Unit& u) const {
        const long L = (long)i * G + c; if (L >= NWG) return false;
        int w = pg8::xcd_remap((int)L, NWG);
        if (w < N0) { u.kind = 0; pg8::grp_decode(w, MT / 256, 8, u.pm, u.pn); } else { w -= N0; u.kind = 1; u.pn = w >> 2; u.pm = w & 3; }
        u.e = 0; return true;
    }
    __device__ __forceinline__ const char* a_base(const pg8::Unit& u, size_t tstep) const { return u.kind == 0 ? (const char*)hx + (size_t)u.pm * tstep : (const char*)win + (size_t)(8 + u.pm) * tstep; }
    __device__ __forceinline__ const char* b_base(const pg8::Unit& u, size_t tstep) const { return u.kind == 0 ? (const char*)win + (size_t)u.pn * tstep : (const char*)hx + (size_t)u.pn * tstep; }
    __device__ __forceinline__ void a_ready(const pg8::Unit&) const {}
    __device__ __forceinline__ void done(const pg8::Unit&) const {}
};
struct EpiIn {
    static constexpr bool PERM = true, AFTER_DRAIN = false;
    bf16* qkvz; bf16* ztl; bf16* ztc;
    __device__ __forceinline__ void operator()(const pg8::f32x4 (&acc)[2][2][4][2], const pg8::Unit& u, int wr, int wc, int fr_, int fq_) const {
        int fr = fr_, fq = fq_; asm volatile("" : "+v"(fr), "+v"(fq));
        const int row0 = u.pm * 256 + wr * 64 + fr, cin = wc * 32 + 8 * fq;
        bf16* base; size_t ldc;
        if (u.kind == 0) { base = qkvz + (size_t)u.pn * 256 + cin; ldc = 2048; }
        else if (u.pn < 128) { base = ztl + (size_t)(u.pn >> 4) * 1024 * 4096 + (size_t)(u.pn & 15) * 256 + cin; ldc = 4096; }
        else { base = ztc + (size_t)(u.pn - 128) * 1024 * 256 + cin; ldc = 256; }
#pragma unroll
        for (int ai = 0; ai < 2; ++ai)
#pragma unroll
            for (int m = 0; m < 4; ++m) { bf16* rowp = base + (size_t)(row0 + ai * 128 + m * 16) * ldc;
#pragma unroll
                for (int bj = 0; bj < 2; ++bj) { const pg8::f32x4 v0 = acc[ai][bj][m][0], v1 = acc[ai][bj][m][1]; pg8::u32x4 w;
                    w.x = pg8::cvt_pk_bf16(v0[0], v0[1]); w.y = pg8::cvt_pk_bf16(v0[2], v0[3]); w.z = pg8::cvt_pk_bf16(v1[0], v1[1]); w.w = pg8::cvt_pk_bf16(v1[2], v1[3]);
                    *(pg8::u32x4*)(rowp + bj * 128) = w; } }
    }
};
struct SchedDft {
    const bf16* dftm; const bf16* ztl; int G, c;
    __device__ __forceinline__ bool next(int i, pg8::Unit& u) const {
        const long L = (long)i * G + c; if (L >= 256) return false;
        const int w = pg8::xcd_remap((int)L, 256), x = w >> 5, j = w & 31, bp = j >> 2;
        u.pm = 4 * (x & 3) + (j & 3); u.e = 4 * (x >> 2) + (bp >> 1); u.pn = bp & 1; u.kind = 0; return true;
    }
    __device__ __forceinline__ const char* a_base(const pg8::Unit& u, size_t tstep) const { return (const char*)dftm + (size_t)u.pm * tstep; }
    __device__ __forceinline__ const char* b_base(const pg8::Unit& u, size_t tstep) const { return (const char*)ztl + (size_t)u.e * (512 * 8192 * 2) + (size_t)u.pn * tstep; }
    __device__ __forceinline__ void a_ready(const pg8::Unit&) const {}
    __device__ __forceinline__ void done(const pg8::Unit&) const {}
};
struct EpiDft {
    static constexpr bool PERM = true, AFTER_DRAIN = false;
    bf16* mix; float scale;
    __device__ __forceinline__ void operator()(const pg8::f32x4 (&acc)[2][2][4][2], const pg8::Unit& u, int wr, int wc, int fr_, int fq_) const {
        int fr = fr_, fq = fq_; asm volatile("" : "+v"(fr), "+v"(fq));
        const int row0 = u.e * SEQ + u.pm * 256 + wr * 64 + fr, col0 = u.pn * 256 + wc * 32 + 8 * fq;
#pragma unroll
        for (int ai = 0; ai < 2; ++ai)
#pragma unroll
            for (int m = 0; m < 4; ++m) { bf16* rowp = mix + (size_t)(row0 + ai * 128 + m * 16) * D + col0;
#pragma unroll
                for (int bj = 0; bj < 2; ++bj) { const pg8::f32x4 v0 = acc[ai][bj][m][0] * scale, v1 = acc[ai][bj][m][1] * scale; pg8::u32x4 w;
                    w.x = pg8::cvt_pk_bf16(v0[0], v0[1]); w.y = pg8::cvt_pk_bf16(v0[2], v0[3]); w.z = pg8::cvt_pk_bf16(v1[0], v1[1]); w.w = pg8::cvt_pk_bf16(v1[2], v1[3]);
                    *(pg8::u32x4*)(rowp + bj * 128) = w; } }
    }
};
struct SchedOut {
    const bf16* mix; const bf16* wout; int nM, G, c;
    __device__ __forceinline__ bool next(int i, pg8::Unit& u) const {
        const int nwg = nM * 4; const long L = (long)i * G + c; if (L >= nwg) return false;
        pg8::grp_decode(pg8::xcd_remap((int)L, nwg), nM, 4, u.pm, u.pn); u.kind = 0; u.e = 0; return true;
    }
    __device__ __forceinline__ const char* a_base(const pg8::Unit& u, size_t tstep) const { return (const char*)mix + (size_t)u.pm * tstep; }
    __device__ __forceinline__ const char* b_base(const pg8::Unit& u, size_t tstep) const { return (const char*)wout + (size_t)u.pn * tstep; }
    __device__ __forceinline__ void a_ready(const pg8::Unit&) const {}
    __device__ __forceinline__ void done(const pg8::Unit&) const {}
};
struct EpiOut {
    static constexpr bool PERM = false, AFTER_DRAIN = false;
    float* xlat; float* xctx; const float* gt1;
    __device__ __forceinline__ void operator()(const pg8::f32x4 (&acc)[2][2][4][2], const pg8::Unit& u, int wr, int wc, int fr_, int fq_) const {
        int fr = fr_, fq = fq_; asm volatile("" : "+v"(fr), "+v"(fq));
        const int col0 = u.pn * 256 + wc * 32 + 4 * fq, rl = wr * 64 + fr;
        float* xb = u.pm < 128 ? xlat + (size_t)u.pm * 256 * D : xctx + (size_t)(u.pm - 128) * 256 * D;
        const float* g = gt1 + (size_t)(u.pm < 128 ? (u.pm >> 4) : 8) * 6 * D + col0;
        pg8::f32x4 gv[2][2];
#pragma unroll
        for (int bj = 0; bj < 2; ++bj)
#pragma unroll
            for (int n = 0; n < 2; ++n) gv[bj][n] = *(const pg8::f32x4*)(g + bj * 128 + n * 16);
#pragma unroll
        for (int ai = 0; ai < 2; ++ai)
#pragma unroll
            for (int m = 0; m < 4; ++m) { float* rowp = xb + (size_t)(rl + ai * 128 + m * 16) * D + col0;
#pragma unroll
                for (int bj = 0; bj < 2; ++bj)
#pragma unroll
                    for (int n = 0; n < 2; ++n) { pg8::f32x4* p = (pg8::f32x4*)(rowp + bj * 128 + n * 16); const pg8::f32x4 xo = *p; *p = xo + gv[bj][n] * acc[ai][bj][m][n]; }
                if (m & 1) asm volatile("" ::: "memory"); }
    }
};
struct SchedMoe {
    const bf16* A; const bf16* W; size_t wstride; const LAS int* pend; int nM, nN, G, c;
    __device__ __forceinline__ bool next(int i, pg8::Unit& u) const {
        const int nwg = nM * nN; const long L = (long)i * G + c; if (L >= nwg) return false;
        pg8::grp_decode(pg8::xcd_remap((int)L, nwg), nM, nN, u.pm, u.pn);
        int e = 0;
#pragma unroll 1
        for (int j = 0; j < NEXP - 1; ++j) e += (pend[j] <= u.pm) ? 1 : 0;
        u.e = e; u.kind = 0; return true;
    }
    __device__ __forceinline__ const char* a_base(const pg8::Unit& u, size_t tstep) const { return (const char*)A + (size_t)u.pm * tstep; }
    __device__ __forceinline__ const char* b_base(const pg8::Unit& u, size_t tstep) const { return (const char*)W + (size_t)u.e * wstride + (size_t)u.pn * tstep; }
    __device__ __forceinline__ void a_ready(const pg8::Unit&) const {}
    __device__ __forceinline__ void done(const pg8::Unit&) const {}
};
struct EpiSwiglu {
    static constexpr bool PERM = true, AFTER_DRAIN = false;
    bf16* hs; const float* bg; const float* bu;
    __device__ __forceinline__ void operator()(const pg8::f32x4 (&acc)[2][2][4][2], const pg8::Unit& u, int wr, int wc, int fr_, int fq_) const {
        int fr = fr_, fq = fq_; asm volatile("" : "+v"(fr), "+v"(fq));
        const int row0 = u.pm * 256 + wr * 64 + fr, f0 = u.pn * 128 + wc * 32 + 8 * fq;
        const pg8::f32x4 bg0 = *(const pg8::f32x4*)(bg + u.e * D + f0), bg1 = *(const pg8::f32x4*)(bg + u.e * D + f0 + 4);
        const pg8::f32x4 bu0 = *(const pg8::f32x4*)(bu + u.e * D + f0), bu1 = *(const pg8::f32x4*)(bu + u.e * D + f0 + 4);
#pragma unroll
        for (int ai = 0; ai < 2; ++ai)
#pragma unroll
            for (int m = 0; m < 4; ++m) {
                float h[8];
#pragma unroll
                for (int n = 0; n < 2; ++n) { const pg8::f32x4 ga = acc[ai][0][m][n] + (n ? bg1 : bg0), ua = acc[ai][1][m][n] + (n ? bu1 : bu0);
#pragma unroll
                    for (int j = 0; j < 4; ++j) { const float a = fminf(ga[j], 7.0f), uu = fminf(fmaxf(ua[j], -7.0f), 7.0f);
                        h[n * 4 + j] = a * __builtin_amdgcn_rcpf(1.0f + __expf(-1.702f * a)) * (uu + 1.0f); } }
                pg8::u32x4 w; w.x = pg8::cvt_pk_bf16(h[0], h[1]); w.y = pg8::cvt_pk_bf16(h[2], h[3]); w.z = pg8::cvt_pk_bf16(h[4], h[5]); w.w = pg8::cvt_pk_bf16(h[6], h[7]);
                *(pg8::u32x4*)(hs + (size_t)(row0 + ai * 128 + m * 16) * D + f0) = w; }
    }
};
struct EpiDown {
    static constexpr bool PERM = true, AFTER_DRAIN = false;
    bf16* ys; const float* bd;
    __device__ __forceinline__ void operator()(const pg8::f32x4 (&acc)[2][2][4][2], const pg8::Unit& u, int wr, int wc, int fr_, int fq_) const {
        int fr = fr_, fq = fq_; asm volatile("" : "+v"(fr), "+v"(fq));
        const int row0 = u.pm * 256 + wr * 64 + fr, col0 = u.pn * 256 + wc * 32 + 8 * fq;
        pg8::f32x4 bv[2][2];
#pragma unroll
        for (int bj = 0; bj < 2; ++bj)
#pragma unroll
            for (int n = 0; n < 2; ++n) bv[bj][n] = *(const pg8::f32x4*)(bd + u.e * D + col0 + bj * 128 + 4 * n);
#pragma unroll
        for (int ai = 0; ai < 2; ++ai)
#pragma unroll
            for (int m = 0; m < 4; ++m) { bf16* rowp = ys + (size_t)(row0 + ai * 128 + m * 16) * D + col0;
#pragma unroll
                for (int bj = 0; bj < 2; ++bj) { const pg8::f32x4 v0 = acc[ai][bj][m][0] + bv[bj][0], v1 = acc[ai][bj][m][1] + bv[bj][1]; pg8::u32x4 w;
                    w.x = pg8::cvt_pk_bf16(v0[0], v0[1]); w.y = pg8::cvt_pk_bf16(v0[2], v0[3]); w.z = pg8::cvt_pk_bf16(v1[0], v1[1]); w.w = pg8::cvt_pk_bf16(v1[2], v1[3]);
                    *(pg8::u32x4*)(rowp + bj * 128) = w; } }
    }
};

__device__ __forceinline__ void transpose_item(const float* W, int ldw, int col0, int K, bf16* WT, int drow0, LAS float* scr, int kb, int lane) {
    const int k0 = 64 * kb;
#pragma unroll 8
    for (int i = 0; i < 32; ++i) { const int kk = 2 * i + (lane >> 5); scr[kk * 33 + (lane & 31)] = W[(size_t)(k0 + kk) * ldw + col0 + (lane & 31)]; }
    LDS_WAIT(); asm volatile("" ::: "memory");
    const int c = lane & 7;
#pragma unroll
    for (int j = 0; j < 4; ++j) { const int n = (lane >> 3) + 8 * j; const LAS float* s = scr + (8 * c) * 33 + n;
        v4u o; o.x = pk2(s[0 * 33], s[1 * 33]); o.y = pk2(s[2 * 33], s[3 * 33]); o.z = pk2(s[4 * 33], s[5 * 33]); o.w = pk2(s[6 * 33], s[7 * 33]);
        *(v4u*)(WT + (size_t)(drow0 + n) * K + k0 + 8 * c) = o; }
    LDS_WAIT(); asm volatile("" ::: "memory");
}
__device__ __forceinline__ void convert_experts(const Frame& F, int l) {
    const Args* A = kargs();
    LAS float* scr = (LAS float*)(F.lds + F.wave * 16384);
    bf16* W1 = (bf16*)(F.ws + WS_W1); bf16* W2 = (bf16*)(F.ws + WS_W2);
    constexpr int IPM = 16 * 32;
    for (int it = F.gw; it < 3 * NEXP * IPM; it += F.NGW) {
        const int which = it / (NEXP * IPM), r = it % (NEXP * IPM), e = r / IPM, q = r % IPM, kb = q >> 5, nb = q & 31;
        const size_t moff = ((size_t)l * NEXP + e) * D * D;
        if (which == 0) transpose_item(A->in[I_WG] + moff, D, nb * 32, D, W1 + (size_t)e * 2048 * D, 256 * (nb >> 2) + 32 * (nb & 3), scr, kb, F.lane);
        else if (which == 1) transpose_item(A->in[I_WU] + moff, D, nb * 32, D, W1 + (size_t)e * 2048 * D, 256 * (nb >> 2) + 128 + 32 * (nb & 3), scr, kb, F.lane);
        else transpose_item(A->in[I_WD] + moff, D, nb * 32, D, W2 + (size_t)e * D * D, nb * 32, scr, kb, F.lane);
    }
}
__device__ __forceinline__ void p0_prologue(const Frame& F) {
    const Args* A = kargs();
    float* mv = (float*)(F.ws + WS_MODV);
    {
        LAS float* sc = (LAS float*)F.lds;
        LAS float* red = sc + 9 * 1024;
        for (int i = F.tid; i < 9 * 1024; i += NTHR) { const int r = i >> 10, k = i & 1023; sc[i] = silu_f(r < 8 ? A->in[I_C][r * D + k] : A->in[I_CCTX][k]); }
        __syncthreads();
        for (int item = blockIdx.x; item < 192; item += F.G) {
            const int l = item / 96, cg = item % 96, cl = F.tid & 63, ks = F.tid >> 6;
            const float* w = A->in[I_WMOD] + ((size_t)l * D + ks * 128) * 6144 + cg * 64 + cl;
            float a[9];
#pragma unroll
            for (int r = 0; r < 9; ++r) a[r] = 0.f;
#pragma unroll 4
            for (int k = 0; k < 128; ++k) { const float wv = w[(size_t)k * 6144];
#pragma unroll
                for (int r = 0; r < 9; ++r) a[r] += sc[r * 1024 + ks * 128 + k] * wv; }
#pragma unroll
            for (int r = 0; r < 9; ++r) red[(ks * 9 + r) * 64 + cl] = a[r];
            __syncthreads();
            for (int i = F.tid; i < 9 * 64; i += NTHR) { const int r = i >> 6, cc = i & 63; float s = 0.f;
#pragma unroll
                for (int k2 = 0; k2 < 8; ++k2) s += red[(k2 * 9 + r) * 64 + cc];
                mv[(size_t)(l * 9 + r) * 6144 + cg * 64 + cc] = s + A->in[I_BMOD][l * 6144 + cg * 64 + cc]; }
            __syncthreads();
        }
    }
    {
        LAS float* T = (LAS float*)F.lds;
        LAS float* cs = T + 64 * 129; LAS float* sn = cs + 128;
        __syncthreads();
        if (F.tid < 128) { cs[F.tid] = cospif((float)F.tid * (1.0f / 64.0f)); sn[F.tid] = sinpif((float)F.tid * (1.0f / 64.0f)); }
        for (int item = (blockIdx.x + 64) % F.G; item < 128; item += F.G) {
            const int l = item >> 6, kg = (item & 63) >> 2, g = item & 3;
            __syncthreads();
            for (int i = F.tid; i < 64 * 128; i += NTHR) { const int kk = i >> 7, cc = i & 127; T[kk * 129 + cc] = A->in[I_WIN][((size_t)l * D + kg * 64 + kk) * INW + g * 128 + cc]; }
            __syncthreads();
            const int kk = F.tid & 63, ng = F.tid >> 6;
            bf16* dst = (bf16*)(F.ws + WS_WIN) + ((size_t)l * 3072 + 2048 + g * 256) * D + kg * 64 + kk;
#pragma unroll 1
            for (int nn = 0; nn < 32; ++nn) { const int np = ng * 32 + nn, cp = np >> 1; float s = 0.f;
                if (np & 1) {
#pragma unroll 8
                    for (int cc = 0; cc < 128; ++cc) s -= T[kk * 129 + cc] * sn[(cc * cp) & 127]; }
                else {
#pragma unroll 8
                    for (int cc = 0; cc < 128; ++cc) s += T[kk * 129 + cc] * cs[(cc * cp) & 127]; }
                dst[(size_t)np * D] = (bf16)f2bf(s); }
        }
        __syncthreads();
    }
    {
        LAS float* scr = (LAS float*)(F.lds + F.wave * 16384);
        constexpr int I_IN = 16 * 64, I_OUT = 16 * 32;
        for (int it = F.gw; it < NL * (I_IN + I_OUT); it += F.NGW) {
            const int l = it / (I_IN + I_OUT), r = it % (I_IN + I_OUT);
            if (r < I_IN) transpose_item(A->in[I_WIN] + (size_t)l * D * INW, INW, 512 + 32 * (r & 63), D, (bf16*)(F.ws + WS_WIN) + (size_t)l * 3072 * D, 32 * (r & 63), scr, r >> 6, F.lane);
            else { const int q = r - I_IN; transpose_item(A->in[I_WOUT] + (size_t)l * D * D, D, 32 * (q & 31), D, (bf16*)(F.ws + WS_WOUT) + (size_t)l * D * D, 32 * (q & 31), scr, q >> 5, F.lane); }
        }
    }
    convert_experts(F, 0);
    {
        const int gt = F.gw * 64 + F.lane, NT = F.NGW * 64;
        float* wrt = (float*)(F.ws + WS_WRT); float* wabt = (float*)(F.ws + WS_WABT);
        for (int i = gt; i < NL * NEXP * D; i += NT) { const int l = i >> 15, e = (i >> 10) & 31, c = i & 1023; wrt[i] = A->in[I_WR][((size_t)l * D + c) * NEXP + e]; }
        for (int i = gt; i < NL * 16 * D; i += NT) { const int l = i >> 14, j = (i >> 10) & 15, c = i & 1023; wabt[i] = A->in[I_WIN][((size_t)l * D + c) * INW + 2560 + j]; }
        bf16* dm = (bf16*)(F.ws + WS_DFTM);
        for (int i = gt; i < 4096 * 1024; i += NT) { const int kf = i >> 10, j0 = (i & 1023) * 8; float v[8];
#pragma unroll
            for (int jj = 0; jj < 8; ++jj) { const int j = j0 + jj; const float a = (float)((kf * (j & 4095)) & 4095) * (1.0f / 2048.0f); v[jj] = j < 4096 ? cospif(a) : sinpif(a); }
            v4u o; o.x = pk2(v[0], v[1]); o.y = pk2(v[2], v[3]); o.z = pk2(v[4], v[5]); o.w = pk2(v[6], v[7]);
            *(v4u*)(dm + (size_t)kf * 8192 + j0) = o; }
    }
}

template <int MODE>
__device__ __forceinline__ void row_pass(const Frame& F, int l_cur, int l_nxt) {
    const Args* A = kargs();
    LAS float* wl = (LAS float*)F.lds;
    if (MODE != 2) { const f32x4* src = (const f32x4*)((const float*)(F.ws + WS_WABT) + (size_t)l_nxt * 16 * D);
        for (int i = F.tid; i < 16 * D / 4; i += NTHR) ((LAS f32x4*)wl)[i] = src[i];
        __syncthreads(); }
    const int nrows = MODE == 2 ? NLAT : MT;
    const int* sele = (const int*)(F.ws + WS_SELE); const int* selp = (const int*)(F.ws + WS_SELP); const float* selg = (const float*)(F.ws + WS_SELG);
    const bf16* ys = (const bf16*)(F.ws + WS_XS);
    bf16* hx = (bf16*)(F.ws + WS_ACT); float* ab = (float*)(F.ws + WS_AB);
    for (int t = F.gw; t < nrows; t += F.NGW) {
        const int r = mod_row(t);
        f32x4 v[4];
        float* xr = xr_row(F, t);
        if (MODE == 0) { const float* xin = t < NLAT ? A->in[I_X] + (size_t)t * D : A->in[I_CTX] + (size_t)(t - NLAT) * D;
#pragma unroll
            for (int j = 0; j < 4; ++j) v[j] = *((const f32x4*)xin + F.lane + 64 * j);
        } else {
#pragma unroll
            for (int j = 0; j < 4; ++j) v[j] = *((const f32x4*)xr + F.lane + 64 * j);
            f32x4 y[4];
#pragma unroll
            for (int j = 0; j < 4; ++j) y[j] = (f32x4){0.f, 0.f, 0.f, 0.f};
            (void)sele;
#pragma unroll
            for (int k = 0; k < 4; ++k) { const int dst = selp[t * 4 + k]; const float gk = selg[t * 4 + k]; const v2u* yr = (const v2u*)(ys + (size_t)dst * D) + F.lane;
#pragma unroll
                for (int j = 0; j < 4; ++j) { const v2u w = yr[64 * j]; y[j] += gk * (f32x4){bflo(w.x), bfhi(w.x), bflo(w.y), bfhi(w.y)}; } }
            const f32x4* g2 = (const f32x4*)modv(F, l_cur, r, 5) + F.lane;
#pragma unroll
            for (int j = 0; j < 4; ++j) v[j] += g2[64 * j] * y[j];
        }
        if (MODE != 2) {
#pragma unroll
            for (int j = 0; j < 4; ++j) *((f32x4*)xr + F.lane + 64 * j) = v[j];
        }
        float ss = 0.f;
#pragma unroll
        for (int j = 0; j < 4; ++j) ss += (v[j].x * v[j].x + v[j].y * v[j].y) + (v[j].z * v[j].z + v[j].w * v[j].w);
        const float rstd = 1.0f / sqrtf(wave_sum(ss) * (1.0f / D) + EPS);
        if (MODE == 2) {
            const f32x4* gf = (const f32x4*)A->in[I_GF] + F.lane;
#pragma unroll
            for (int j = 0; j < 4; ++j) *((f32x4*)(F.out + (size_t)t * D) + F.lane + 64 * j) = v[j] * rstd * gf[64 * j];
        } else {
            const f32x4* g1 = (const f32x4*)(A->in[I_GN1] + (size_t)l_nxt * D) + F.lane;
            const f32x4* sh = (const f32x4*)modv(F, l_nxt, r, 0) + F.lane; const f32x4* scl = (const f32x4*)modv(F, l_nxt, r, 1) + F.lane;
            v2u* ho = (v2u*)(hx + (size_t)t * D) + F.lane;
#pragma unroll
            for (int j = 0; j < 4; ++j) { v[j] = v[j] * rstd * g1[64 * j] * (scl[64 * j] + 1.0f) + sh[64 * j]; v2u w; w.x = pk2(v[j].x, v[j].y); w.y = pk2(v[j].z, v[j].w); ho[64 * j] = w; }
            float mine = 0.f;
#pragma unroll 2
            for (int jj = 0; jj < 16; ++jj) { float p = 0.f;
#pragma unroll
                for (int j = 0; j < 4; ++j) { const f32x4 w = ((const LAS f32x4*)(wl + jj * D))[F.lane + 64 * j]; p += (v[j].x * w.x + v[j].y * w.y) + (v[j].z * w.z + v[j].w * w.w); }
                p = wave_sum(p); if (F.lane == jj) mine = p; }
            if (F.lane < 16) ab[(size_t)t * 16 + F.lane] = mine;
        }
    }
}

__device__ __forceinline__ void conv_phase(const Frame& F, int l) {
    const Args* A = kargs();
    LAS float* cw = (LAS float*)F.lds;
    for (int i = F.tid; i < 5 * 1536; i += NTHR) cw[i] = A->in[I_CONVW][(size_t)l * 5 * 1536 + i];
    __syncthreads();
    const bf16* qkvz = (const bf16*)(F.ws + WS_QKVZ); bf16* qkvn = (bf16*)(F.ws + WS_QKVN);
    const float* ab = (const float*)(F.ws + WS_AB); float* gb = (float*)(F.ws + WS_G); float* bb = (float*)(F.ws + WS_BETA);
    for (int t = F.gw; t < MT; t += F.NGW) {
        int sb, p, Ls;
        if (t < NLAT) { sb = t & ~4095; p = t & 4095; Ls = SEQ; } else { const int tt = t - NLAT; sb = NLAT + (tt & ~255); p = tt & 255; Ls = CTXL; }
        float a[3][8];
#pragma unroll
        for (int q = 0; q < 3; ++q)
#pragma unroll
            for (int i = 0; i < 8; ++i) a[q][i] = 0.f;
#pragma unroll
        for (int tap = 0; tap < 5; ++tap) { const int pp = p + tap - 2;
            if (pp >= 0 && pp < Ls) {
#pragma unroll
                for (int q = 0; q < 3; ++q) { const v4u u = *(const v4u*)(qkvz + (size_t)(sb + pp) * 2048 + q * 512 + 8 * F.lane);
                    const LAS f32x4* wp = (const LAS f32x4*)(cw + tap * 1536 + q * 512 + 8 * F.lane); const f32x4 w0 = wp[0], w1 = wp[1];
                    a[q][0] += bflo(u.x) * w0.x; a[q][1] += bfhi(u.x) * w0.y; a[q][2] += bflo(u.y) * w0.z; a[q][3] += bfhi(u.y) * w0.w;
                    a[q][4] += bflo(u.z) * w1.x; a[q][5] += bfhi(u.z) * w1.y; a[q][6] += bflo(u.w) * w1.z; a[q][7] += bfhi(u.w) * w1.w; } } }
#pragma unroll
        for (int q = 0; q < 3; ++q) { float ss = 0.f;
#pragma unroll
            for (int i = 0; i < 8; ++i) { a[q][i] = silu_f(a[q][i]); ss += a[q][i] * a[q][i]; }
            float sc = 1.0f;
            if (q < 2) { ss = sum16(ss); sc = (1.0f / sqrtf(ss + EPS)) * (q == 0 ? 0.08838834764831845f : 1.0f); }
            v4u o; o.x = pk2(a[q][0] * sc, a[q][1] * sc); o.y = pk2(a[q][2] * sc, a[q][3] * sc); o.z = pk2(a[q][4] * sc, a[q][5] * sc); o.w = pk2(a[q][6] * sc, a[q][7] * sc);
            *(v4u*)(qkvn + (size_t)t * 1536 + q * 512 + 8 * F.lane) = o; }
        if (F.lane < 8) { const int d = F.lane >> 2, h = F.lane & 3;
            const float xg = ab[(size_t)t * 16 + d * 8 + h] + A->in[I_DTB][l * 8 + d * 4 + h];
            const float sp = xg > 20.f ? xg : log1pf(expf(xg));
            gb[(size_t)t * 8 + F.lane] = -expf(A->in[I_ALOG][l * 8 + d * 4 + h]) * sp;
            bb[(size_t)t * 8 + F.lane] = 1.0f / (1.0f + expf(-ab[(size_t)t * 16 + d * 8 + 4 + h])); }
    }
}

__device__ __forceinline__ void ctx_dft(const Frame& F) {
    LAS float* cs = (LAS float*)F.lds;
    LAS float* sn = cs + 256;
    __syncthreads();
    if (F.tid < 256) { cs[F.tid] = cospif((float)F.tid * (1.0f / 128.0f)); sn[F.tid] = sinpif((float)F.tid * (1.0f / 128.0f)); }
    __syncthreads();
    const bf16* ztc = (const bf16*)(F.ws + WS_ZTC); bf16* mix = (bf16*)(F.ws + WS_ACT);
    const float scale = 1.0f / sqrtf(256.0f * 128.0f);
    const int gt = F.gw * 64 + F.lane, NT = F.NGW * 64;
    for (int i = gt; i < NCTX * 512; i += NT) {
        const int c = i & 511, lp = (i >> 9) & 255, b = i >> 17;
        const bf16* z = ztc + ((size_t)b * 512 + c) * 512;
        float s = 0.f;
#pragma unroll 4
        for (int l = 0; l < 256; l += 2) { const unsigned zr = *(const unsigned*)(z + l), zi = *(const unsigned*)(z + 256 + l);
            const int i0 = (l * lp) & 255, i1 = ((l + 1) * lp) & 255;
            s += bflo(zr) * cs[i0] + bflo(zi) * sn[i0] + bfhi(zr) * cs[i1] + bfhi(zi) * sn[i1]; }
        mix[(size_t)(NLAT + b * 256 + lp) * D + c] = (bf16)f2bf(s * scale);
    }
}

__device__ __forceinline__ void scan_naive(const Frame& F, int l) {
    LAS float* kL = (LAS float*)F.lds;
    LAS float* qL = kL + 64 * 128;
    LAS float* vL = qL + 64 * 128;
    LAS float* oL = vL + 64 * 32;
    LAS float* gL = oL + 64 * 32;
    LAS float* bL = gL + 64;
    const bf16* qkvn = (const bf16*)(F.ws + WS_QKVN);
    const float* gb = (const float*)(F.ws + WS_G); const float* bb = (const float*)(F.ws + WS_BETA);
    for (int unit = F.vcu; unit < 256; unit += F.G) {
        const int qd = unit & 3, s = unit >> 2, d = s & 1, h = (s >> 1) & 3, b = s >> 3;
        bf16* od = (bf16*)(F.ws + (d ? WS_OB : WS_OF));
        const int j = F.tid >> 4, rg = F.tid & 15;
        float S[8];
#pragma unroll
        for (int i = 0; i < 8; ++i) S[i] = 0.f;
#pragma unroll 1
        for (int ci = 0; ci < 68; ++ci) {
            int rowbase; const bool isctx = ci < 4;
            if (isctx) rowbase = NLAT + b * 256 + (d ? 3 - ci : ci) * 64; else { const int lc = ci - 4; rowbase = b * SEQ + (d ? 63 - lc : lc) * 64; }
            __syncthreads();
            for (int i = F.tid; i < 64 * 16; i += NTHR) { const int r = i >> 4, g8 = i & 15; const bf16* rp = qkvn + (size_t)(rowbase + r) * 1536 + h * 128 + g8 * 8;
                const v4u q = *(const v4u*)rp, k = *(const v4u*)(rp + 512);
                LAS float* qo = qL + r * 128 + g8 * 8; LAS float* ko = kL + r * 128 + g8 * 8;
                qo[0] = bflo(q.x); qo[1] = bfhi(q.x); qo[2] = bflo(q.y); qo[3] = bfhi(q.y); qo[4] = bflo(q.z); qo[5] = bfhi(q.z); qo[6] = bflo(q.w); qo[7] = bfhi(q.w);
                ko[0] = bflo(k.x); ko[1] = bfhi(k.x); ko[2] = bflo(k.y); ko[3] = bfhi(k.y); ko[4] = bflo(k.z); ko[5] = bfhi(k.z); ko[6] = bflo(k.w); ko[7] = bfhi(k.w); }
            if (F.tid < 256) { const int r = F.tid >> 2, g8 = F.tid & 3; const v4u v = *(const v4u*)(qkvn + (size_t)(rowbase + r) * 1536 + 1024 + h * 128 + qd * 32 + g8 * 8);
                LAS float* vo = vL + r * 32 + g8 * 8;
                vo[0] = bflo(v.x); vo[1] = bfhi(v.x); vo[2] = bflo(v.y); vo[3] = bfhi(v.y); vo[4] = bflo(v.z); vo[5] = bfhi(v.z); vo[6] = bflo(v.w); vo[7] = bfhi(v.w); }
            else if (F.tid < 320) { const int r = F.tid - 256; gL[r] = __expf(gb[(size_t)(rowbase + r) * 8 + d * 4 + h]); bL[r] = bb[(size_t)(rowbase + r) * 8 + d * 4 + h]; }
            __syncthreads();
#pragma unroll 2
            for (int st = 0; st < 64; ++st) {
                const int r = d ? 63 - st : st;
                const float alpha = gL[r], bt = bL[r];
                const f32x4 k0 = *(const LAS f32x4*)(kL + r * 128 + rg * 8), k1 = *(const LAS f32x4*)(kL + r * 128 + rg * 8 + 4);
                const f32x4 q0 = *(const LAS f32x4*)(qL + r * 128 + rg * 8), q1 = *(const LAS f32x4*)(qL + r * 128 + rg * 8 + 4);
                float part = (k0.x * S[0] + k0.y * S[1]) + (k0.z * S[2] + k0.w * S[3]) + (k1.x * S[4] + k1.y * S[5]) + (k1.z * S[6] + k1.w * S[7]);
                part = sum16(part);
                const float dl = bt * (vL[r * 32 + j] - alpha * part);
                S[0] = alpha * S[0] + k0.x * dl; S[1] = alpha * S[1] + k0.y * dl; S[2] = alpha * S[2] + k0.z * dl; S[3] = alpha * S[3] + k0.w * dl;
                S[4] = alpha * S[4] + k1.x * dl; S[5] = alpha * S[5] + k1.y * dl; S[6] = alpha * S[6] + k1.z * dl; S[7] = alpha * S[7] + k1.w * dl;
                float op = (q0.x * S[0] + q0.y * S[1]) + (q0.z * S[2] + q0.w * S[3]) + (q1.x * S[4] + q1.y * S[5]) + (q1.z * S[6] + q1.w * S[7]);
                op = sum16(op);
                if (rg == 0) oL[r * 32 + j] = op;
            }
            __syncthreads();
            if (!(isctx && l == NL - 1)) { const int r = F.tid >> 3, g4 = F.tid & 7; const LAS float* op = oL + r * 32 + g4 * 4;
                v2u w; w.x = pk2(op[0], op[1]); w.y = pk2(op[2], op[3]);
                *(v2u*)(od + (size_t)(rowbase + r) * 512 + h * 128 + qd * 32 + g4 * 4) = w; }
        }
        __syncthreads();
    }
}

__device__ __forceinline__ void gated_out(const Frame& F, int l) {
    const Args* A = kargs();
    const bf16* of = (const bf16*)(F.ws + WS_OF); const bf16* ob = (const bf16*)(F.ws + WS_OB); const bf16* qkvz = (const bf16*)(F.ws + WS_QKVZ);
    bf16* mix = (bf16*)(F.ws + WS_ACT);
    const int nrows = l == NL - 1 ? NLAT : MT;
    const f32x4 g0 = *(const f32x4*)(A->in[I_GOUT] + l * 128 + (F.lane & 15) * 8), g1 = *(const f32x4*)(A->in[I_GOUT] + l * 128 + (F.lane & 15) * 8 + 4);
    for (int t = F.gw; t < nrows; t += F.NGW) {
        const v4u a = *(const v4u*)(of + (size_t)t * 512 + 8 * F.lane), b = *(const v4u*)(ob + (size_t)t * 512 + 8 * F.lane), z = *(const v4u*)(qkvz + (size_t)t * 2048 + 1536 + 8 * F.lane);
        float o[8] = {bflo(a.x) + bflo(b.x), bfhi(a.x) + bfhi(b.x), bflo(a.y) + bflo(b.y), bfhi(a.y) + bfhi(b.y), bflo(a.z) + bflo(b.z), bfhi(a.z) + bfhi(b.z), bflo(a.w) + bflo(b.w), bfhi(a.w) + bfhi(b.w)};
        const float zz[8] = {bflo(z.x), bfhi(z.x), bflo(z.y), bfhi(z.y), bflo(z.z), bfhi(z.z), bflo(z.w), bfhi(z.w)};
        const float gg[8] = {g0.x, g0.y, g0.z, g0.w, g1.x, g1.y, g1.z, g1.w};
        float ss = 0.f;
#pragma unroll
        for (int i = 0; i < 8; ++i) ss += o[i] * o[i];
        const float rs = 1.0f / sqrtf(sum16(ss) * (1.0f / 128.0f) + EPS);
#pragma unroll
        for (int i = 0; i < 8; ++i) o[i] = o[i] * rs * gg[i] * silu_f(zz[i]);
        v4u w; w.x = pk2(o[0], o[1]); w.y = pk2(o[2], o[3]); w.z = pk2(o[4], o[5]); w.w = pk2(o[6], o[7]);
        *(v4u*)(mix + (size_t)t * D + 512 + 8 * F.lane) = w;
    }
}

__device__ __forceinline__ void router_phase(const Frame& F, int l) {
    const Args* A = kargs();
    LAS float* wr = (LAS float*)F.lds;
    LAS int* lcnt = (LAS int*)(F.lds + XT_OFF);
    LAS int* lbase = lcnt + 32;
    LAS int* sE = lbase + 32;
    LAS int* sP = sE + 136 * 4;
    LAS float* sG = (LAS float*)(sP + 136 * 4);
    const int nrows = l == NL - 1 ? NLAT : MT, rpb = nrows / 256;
    { const f32x4* src = (const f32x4*)((const float*)(F.ws + WS_WRT) + (size_t)l * NEXP * D);
      for (int i = F.tid; i < NEXP * D / 4; i += NTHR) ((LAS f32x4*)wr)[i] = src[i];
      if (F.tid < 32) lcnt[F.tid] = 0; }
    __syncthreads();
    bf16* h2 = (bf16*)(F.ws + WS_ACT);
    const int row0 = F.vcu * rpb;
    if (F.vcu < 256) {
    for (int rl = F.wave; rl < rpb; rl += NWAVES) {
        const int t = row0 + rl, r = mod_row(t);
        const float* xr = xr_row(F, t);
        f32x4 v[4]; float ss = 0.f;
#pragma unroll
        for (int j = 0; j < 4; ++j) { v[j] = *((const f32x4*)xr + F.lane + 64 * j); ss += (v[j].x * v[j].x + v[j].y * v[j].y) + (v[j].z * v[j].z + v[j].w * v[j].w); }
        const float rstd = 1.0f / sqrtf(wave_sum(ss) * (1.0f / D) + EPS);
        const f32x4* g2 = (const f32x4*)(A->in[I_GN2] + (size_t)l * D) + F.lane;
        const f32x4* sh = (const f32x4*)modv(F, l, r, 3) + F.lane; const f32x4* scl = (const f32x4*)modv(F, l, r, 4) + F.lane;
        v2u* ho = (v2u*)(h2 + (size_t)t * D) + F.lane;
#pragma unroll
        for (int j = 0; j < 4; ++j) { v[j] = v[j] * rstd * g2[64 * j] * (scl[64 * j] + 1.0f) + sh[64 * j]; v2u w; w.x = pk2(v[j].x, v[j].y); w.y = pk2(v[j].z, v[j].w); ho[64 * j] = w; }
        float lg = -3.0e38f;
#pragma unroll 2
        for (int e = 0; e < NEXP; ++e) { float p = 0.f;
#pragma unroll
            for (int j = 0; j < 4; ++j) { const f32x4 w = ((const LAS f32x4*)(wr + e * D))[F.lane + 64 * j]; p += (v[j].x * w.x + v[j].y * w.y) + (v[j].z * w.z + v[j].w * w.w); }
            p = wave_sum(p); if (F.lane == e) lg = p + A->in[I_BR][l * NEXP + e]; }
        int se[4]; float sv[4];
#pragma unroll
        for (int k = 0; k < 4; ++k) { float m = lg;
#pragma unroll
            for (int o = 1; o < 64; o <<= 1) m = fmaxf(m, __shfl_xor(m, o));
            const unsigned long long bal = __ballot(lg == m); const int idx = __ffsll((long long)bal) - 1;
            se[k] = idx; sv[k] = m; if (F.lane == idx) lg = -3.0e38f; }
        const float e1 = __expf(sv[1] - sv[0]), e2 = __expf(sv[2] - sv[0]), e3 = __expf(sv[3] - sv[0]), inv = 1.0f / (1.0f + e1 + e2 + e3);
        if (F.lane == 0) {
            const float gt[4] = {inv, e1 * inv, e2 * inv, e3 * inv};
#pragma unroll
            for (int k = 0; k < 4; ++k) { sE[rl * 4 + k] = se[k]; sP[rl * 4 + k] = __hip_atomic_fetch_add(lcnt + se[k], 1, __ATOMIC_RELAXED, __HIP_MEMORY_SCOPE_WORKGROUP); sG[rl * 4 + k] = gt[k]; } }
    }
    }
    __syncthreads();
    if (F.tid < 32) { const int n = lcnt[F.tid]; lbase[F.tid] = n ? (int)__hip_atomic_fetch_add(F.ctl + CW_GCNT + (l * 32 + F.tid) * 64, (unsigned)n, RLX_AGENT) : 0; }
    __syncthreads();
    if (F.vcu < 256) {
        int* sele = (int*)(F.ws + WS_SELE); int* selp = (int*)(F.ws + WS_SELP); float* selg = (float*)(F.ws + WS_SELG);
        for (int i = F.tid; i < rpb * 4; i += NTHR) { const int e = sE[i]; sele[(size_t)row0 * 4 + i] = e; selp[(size_t)row0 * 4 + i] = lbase[e] + sP[i]; selg[(size_t)row0 * 4 + i] = sG[i]; }
    }
}
__device__ __forceinline__ void moe_layout(const Frame& F, int l, LAS int* pend, LAS int* pstart) {
    __syncthreads();
    if (F.tid == 0) { int acc = 0;
        for (int e = 0; e < NEXP; ++e) { const int n = (int)__hip_atomic_load(F.ctl + CW_GCNT + (l * 32 + e) * 64, RLX_AGENT); pstart[e] = acc * 256; acc += (n + 255) >> 8; pend[e] = acc; } }
    __syncthreads();
}
__device__ __forceinline__ void gather_phase(const Frame& F, int l) {
    LAS int* pend = (LAS int*)(F.lds + XT_OFF); LAS int* pstart = pend + 32;
    moe_layout(F, l, pend, pstart);
    const int nrows = l == NL - 1 ? NLAT : MT;
    const int* sele = (const int*)(F.ws + WS_SELE); int* selp = (int*)(F.ws + WS_SELP);
    const bf16* h2 = (const bf16*)(F.ws + WS_ACT); bf16* xs = (bf16*)(F.ws + WS_XS);
    for (int it = F.gw; it < nrows * 4; it += F.NGW) {
        const int t = it >> 2, e = sele[it], dst = pstart[e] + selp[it];
        const v4u* src = (const v4u*)(h2 + (size_t)t * D) + F.lane; v4u* dp = (v4u*)(xs + (size_t)dst * D) + F.lane;
        const v4u a = src[0], b = src[64];
        dp[0] = a; dp[64] = b;
        if (F.lane == 0) selp[it] = dst;
    }
}

#ifndef PHMASK
#define PHMASK 0xffff
#endif
constexpr int PH_PER_LAYER = 11, N_PHASES = 2 + NL * PH_PER_LAYER;
#ifndef PG8_SP2
#define PG8_SP2 true
#endif
#ifndef PG8_ALIGN
#define PG8_ALIGN true
#endif
__device__ __forceinline__ Frame make_frame() {
    extern __shared__ __attribute__((aligned(16))) unsigned char lds[];
    const Args* A = kargs();
    Frame F;
    { unsigned lb = (unsigned)(uintptr_t)(LAS unsigned char*)lds; asm volatile("" : "+s"(lb)); F.lds = (LAS unsigned char*)(uintptr_t)lb; }
    F.MISC = (volatile LAS unsigned*)(F.lds + MISC_OFF);
    { int t_ = threadIdx.x; asm volatile("" : "+v"(t_)); F.tid = t_; } F.lane = F.tid & 63; F.wave = __builtin_amdgcn_readfirstlane(F.tid >> 6);
    F.G = gridDim.x; { const int bx = blockIdx.x; F.vcu = (F.G % 8 == 0) ? (bx % 8) * (F.G / 8) + bx / 8 : bx; }
    F.gw = F.vcu * NWAVES + F.wave; F.NGW = F.G * NWAVES;
    F.ws = A->ws; F.ctl = (unsigned*)(A->ws + WS_CTL); F.out = A->out;
    return F;
}

__global__ void __launch_bounds__(NTHR, 2) mk_fwd(Args args) {
    { Frame F = make_frame();
    for (int u = F.tid; u < (LDS_BYTES - LDSCTL_OFF) / 4; u += NTHR) ((LAS unsigned*)(F.lds + LDSCTL_OFF))[u] = 0u;
    __syncthreads(); }
    const int lo = args.ph_lo, hi = args.ph_hi;
    if (hi - lo > 1) { Frame F = make_frame(); (void)xcd_barrier_post((unsigned*)(F.ctl + CW_BAR), F.MISC + 8); }
#define IN(k) (lo <= (k) && (k) < hi)
#define SEAM(k) do { if (IN(k) && IN((k) + 1)) { Frame Fb = make_frame(); XcdBarrier bar; bar.bar = (unsigned*)(Fb.ctl + CW_BAR); bar.x = xb_xcc_id(); bar.st = Fb.MISC + 8; xcd_barrier(bar); } } while (0)

    if (IN(0)) { Frame F = make_frame();
#if (PHMASK >> 0) & 1
            p0_prologue(F);
#endif
 } SEAM(0);
    if (IN(1)) { Frame F = make_frame();
#if (PHMASK >> 1) & 1
            row_pass<0>(F, 0, 0);
#endif
 } SEAM(1);
#pragma unroll 1
    for (int l = 0; l < NL; ++l) {
        const int pb = 2 + l * PH_PER_LAYER;
        if (IN(pb + 0)) { Frame F = make_frame();
            SchedIn S{(const bf16*)(F.ws + WS_ACT), (const bf16*)(F.ws + WS_WIN) + (size_t)l * 3072 * D, F.G, (int)blockIdx.x};
            EpiIn E{(bf16*)(F.ws + WS_QKVZ), (bf16*)(F.ws + WS_ZTL), (bf16*)(F.ws + WS_ZTC)};

#if (PHMASK >> 8) & 1
            pg8::gemm_phase<EpiIn, SchedIn, PG8_ALIGN, PG8_SP2>(F.lds, pg8::Gemm{D}, S, E);
#endif

        }
        SEAM(pb + 0);
        if (IN(pb + 1)) { Frame F = make_frame();
#if (PHMASK >> 2) & 1
            conv_phase(F, l);
#endif
 } SEAM(pb + 1);
        if (IN(pb + 2)) { Frame F = make_frame();
            SchedDft S{(const bf16*)(F.ws + WS_DFTM), (const bf16*)(F.ws + WS_ZTL), F.G, (int)blockIdx.x};
            EpiDft E{(bf16*)(F.ws + WS_ACT), 1.0f / sqrtf(4096.0f * 128.0f)};

#if (PHMASK >> 9) & 1
            pg8::gemm_phase<EpiDft, SchedDft, PG8_ALIGN, PG8_SP2>(F.lds, pg8::Gemm{8192}, S, E);
#endif


#if (PHMASK >> 3) & 1
            if (l == 0) ctx_dft(F);
#endif

        }
        SEAM(pb + 2);
        if (IN(pb + 3)) { Frame F = make_frame();
#if (PHMASK >> 4) & 1
            scan_naive(F, l);
#endif
 } SEAM(pb + 3);
        if (IN(pb + 4)) { Frame F = make_frame();
#if (PHMASK >> 5) & 1
            gated_out(F, l);
#endif
 } SEAM(pb + 4);
        if (IN(pb + 5)) { Frame F = make_frame();
            SchedOut S{(const bf16*)(F.ws + WS_ACT), (const bf16*)(F.ws + WS_WOUT) + (size_t)l * D * D, l == NL - 1 ? NLAT / 256 : MT / 256, F.G, (int)blockIdx.x};
            EpiOut E{F.out, (float*)(F.ws + WS_XC), modv(F, l, 0, 2)};

#if (PHMASK >> 10) & 1
            pg8::gemm_phase<EpiOut, SchedOut, PG8_ALIGN, PG8_SP2>(F.lds, pg8::Gemm{D}, S, E);
#endif

        }
        SEAM(pb + 5);
        if (IN(pb + 6)) { Frame F = make_frame();
#if (PHMASK >> 6) & 1
            router_phase(F, l);
#endif
 } SEAM(pb + 6);
        if (IN(pb + 7)) { Frame F = make_frame();
#if (PHMASK >> 7) & 1
            gather_phase(F, l);
#endif
 } SEAM(pb + 7);
        if (IN(pb + 8)) { Frame F = make_frame();
            LAS int* pend = (LAS int*)(F.lds + XT_OFF); moe_layout(F, l, pend, pend + 32);
            SchedMoe S{(const bf16*)(F.ws + WS_XS), (const bf16*)(F.ws + WS_W1), (size_t)2048 * D * 2, pend, pend[NEXP - 1], 8, F.G, (int)blockIdx.x};
            EpiSwiglu E{(bf16*)(F.ws + WS_HS), kargs()->in[I_BG] + (size_t)l * NEXP * D, kargs()->in[I_BU] + (size_t)l * NEXP * D};

#if (PHMASK >> 11) & 1
            pg8::gemm_phase<EpiSwiglu, SchedMoe, PG8_ALIGN, PG8_SP2>(F.lds, pg8::Gemm{D}, S, E);
#endif

        }
        SEAM(pb + 8);
        if (IN(pb + 9)) { Frame F = make_frame();
            LAS int* pend = (LAS int*)(F.lds + XT_OFF); moe_layout(F, l, pend, pend + 32);
            SchedMoe S{(const bf16*)(F.ws + WS_HS), (const bf16*)(F.ws + WS_W2), (size_t)D * D * 2, pend, pend[NEXP - 1], 4, F.G, (int)blockIdx.x};
            EpiDown E{(bf16*)(F.ws + WS_XS), kargs()->in[I_BD] + (size_t)l * NEXP * D};

#if (PHMASK >> 12) & 1
            pg8::gemm_phase<EpiDown, SchedMoe, PG8_ALIGN, PG8_SP2>(F.lds, pg8::Gemm{D}, S, E);
#endif

        }
        SEAM(pb + 9);
        if (IN(pb + 10)) { Frame F = make_frame();

#if (PHMASK >> 13) & 1
            if (l == NL - 1) row_pass<2>(F, l, l);
            else { row_pass<1>(F, l, l + 1); __syncthreads(); convert_experts(F, l + 1); }
#endif

        }
        if (l + 1 < NL) SEAM(pb + 10);
    }
#undef IN
#undef SEAM
}

extern "C" void kernel_launch(void* const* d_in, const int* in_sizes, int n_in, void* d_out, int out_size, void* d_ws, size_t ws_size, hipStream_t stream) {
    static int grid = 0;
    if (grid == 0) {
        if (n_in != 23 || out_size != NLAT * D || ws_size < WS_END) { fprintf(stderr, "kernel_launch: unexpected shapes (n_in %d, out %d, ws %zu); nothing launched\n", n_in, out_size, ws_size); grid = -1; return; }
        int dev = 0, cus = 0, per_cu = 0;
        if (hipGetDevice(&dev) != hipSuccess || hipDeviceGetAttribute(&cus, hipDeviceAttributeMultiprocessorCount, dev) != hipSuccess) { grid = -1; return; }
        if (hipFuncSetAttribute((const void*)mk_fwd, hipFuncAttributeMaxDynamicSharedMemorySize, LDS_BYTES) != hipSuccess) { fprintf(stderr, "kernel_launch: hipFuncSetAttribute failed\n"); grid = -1; return; }
        if (hipOccupancyMaxActiveBlocksPerMultiprocessor(&per_cu, (const void*)mk_fwd, NTHR, LDS_BYTES) != hipSuccess || per_cu < 1)
            fprintf(stderr, "kernel_launch: note: occupancy query reports %d workgroups per CU\n", per_cu);
        (void)hipGetLastError();
        grid = cus;
        if (grid != 256) { fprintf(stderr, "kernel_launch: built for 256 CUs, found %d; nothing launched\n", grid); grid = -1; return; }
    }
    if (grid < 0) return;
    if (hipMemsetAsync((char*)d_ws + WS_CTL, 0, CTL_ZERO_BYTES, stream) != hipSuccess) { fprintf(stderr, "kernel_launch: hipMemsetAsync failed\n"); return; }
    Args a{};
    for (int i = 0; i < 23; ++i) a.in[i] = (const float*)d_in[i];
    a.out = (float*)d_out; a.ws = (unsigned char*)d_ws;
#if MK_ONE_LAUNCH
    a.ph_lo = 0; a.ph_hi = N_PHASES;
    hipLaunchKernelGGL(mk_fwd, dim3(grid), dim3(NTHR), LDS_BYTES, stream, a);
#else
    for (int p = 0; p < N_PHASES; ++p) { a.ph_lo = p; a.ph_hi = p + 1; hipLaunchKernelGGL(mk_fwd, dim3(grid), dim3(NTHR), LDS_BYTES, stream, a); }
#endif
    const hipError_t le = hipPeekAtLastError();
    if (le != hipSuccess) fprintf(stderr, "kernel_launch: launch failed: %s\n", hipGetErrorName(le));
}
```

```cpp
#define MK_ONE_LAUNCH 1
#include <hip/hip_runtime.h>
#include <cstdio>
#include <cstdint>

#ifndef MK_ONE_LAUNCH
#define MK_ONE_LAUNCH 1
#endif

namespace pg8 {
#define PG8_LAS __attribute__((address_space(3)))
typedef unsigned short bf16_t;
typedef short bf16x8 __attribute__((ext_vector_type(8)));
typedef float f32x4 __attribute__((ext_vector_type(4)));
typedef unsigned u32x4 __attribute__((ext_vector_type(4)));
constexpr int BM = 256, BK = 64, HALF = 128, HTB = HALF * BK * 2  , STAGE_BYTES = 8 * HTB, NXCD = 8, WGM = 8;

__host__ __device__ __forceinline__ int lds_byte(int r, int c) { const int st = (r >> 4) * 2 + (c >> 5), rr = r & 15, cc = c & 31, ob = rr * 64 + cc * 2; return st * 1024 + (ob ^ (((ob >> 9) & 1) << 5)); }
__host__ __device__ __forceinline__ void stage_rc(int b, int& R, int& C) { const int st = b / 1024, sb = b % 1024, swz = sb ^ (((sb >> 9) & 1) << 5); R = (st >> 1) * 16 + swz / 64; C = (st & 1) * 32 + (swz % 64) / 2; }
__host__ __device__ __forceinline__ int perm32(int rho) { const int n = rho >> 4, i = rho & 15; return 8 * (i >> 2) + 4 * n + (i & 3); }

struct Unit { int pm, pn, kind, e; };
struct Gemm { int K; };

__device__ __forceinline__ int xcd_remap(int L, int nwg) { const int q = nwg / NXCD, r = nwg % NXCD, xcd = L % NXCD, off = L / NXCD; return (xcd < r ? xcd * (q + 1) : r * (q + 1) + (xcd - r) * q) + off; }
__device__ __forceinline__ void grp_decode(int wgid, int nM, int nN, int& pm, int& pn) { const int nig = WGM * nN, gid = wgid / nig, fm = gid * WGM, gsz = (nM - fm) < WGM ? (nM - fm) : WGM; pm = fm + ((wgid % nig) % gsz); pn = (wgid % nig) / gsz; }

__device__ __forceinline__ const char* uni_ptr(const char* p) { const unsigned long long v = (unsigned long long)p; const unsigned lo = __builtin_amdgcn_readfirstlane((unsigned)v), hi = __builtin_amdgcn_readfirstlane((unsigned)(v >> 32)); return (const char*)(((unsigned long long)hi << 32) | lo); }
__device__ __forceinline__ unsigned cvt_pk_bf16(float lo, float hi) { unsigned r; asm volatile("v_cvt_pk_bf16_f32 %0, %1, %2" : "=v"(r) : "v"(lo), "v"(hi)); return r; }

template <class Epi, class Sched, bool ALIGN_EPI = false, bool SP2 = false>
__device__ __forceinline__ void gemm_phase(PG8_LAS unsigned char* lds, const Gemm g, const Sched& S, const Epi& E) {
    int tid_ = threadIdx.x; asm volatile("" : "+v"(tid_));
    const int tid = tid_, wid = __builtin_amdgcn_readfirstlane(tid >> 6), lane = tid & 63, wr = wid >> 2, wc = wid & 3, fr = lane & 15, fq = lane >> 4;
    const int K = g.K, nt = K / BK;
    unsigned voffA[2], voffB[2];
#pragma unroll
    for (int i = 0; i < 2; ++i) { int R, C; stage_rc(tid * 16 + i * 8192, R, C); const int Rb = Epi::PERM ? ((R & ~31) + perm32(R & 31)) : R;
        voffA[i] = (unsigned)(R * K + C) * 2u; voffB[i] = (unsigned)(Rb * K + C) * 2u; }
    const size_t kstep = (size_t)(BK * 2);
    const size_t hstep = (size_t)HALF * K * 2;
    const size_t tstep = 2 * hstep;
    const unsigned ldsw = (unsigned)wid * 1024u;
    const int aoff = lds_byte(wr * 64 + fr, fq * 8), boff = lds_byte(wc * 32 + fr, fq * 8);
#define PG8_SA(b, h) (((b) * 2 + (h)) * HTB)
#define PG8_SB(b, h) ((4 + (b) * 2 + (h)) * HTB)
#define PG8_STAGE(bufoff, gbase, voff) do { _Pragma("unroll") for (int _i = 0; _i < 2; ++_i) \
        __builtin_amdgcn_global_load_lds((const unsigned*)((const char*)(gbase) + (voff)[_i]), (PG8_LAS unsigned*)(lds + (bufoff) + ldsw + _i * 8192), 16, 0, 0); } while (0)
#define PG8_LDA(dst, b, h) do { _Pragma("unroll") for (int m = 0; m < 4; ++m) _Pragma("unroll") for (int k = 0; k < 2; ++k) dst[m][k] = *(const PG8_LAS bf16x8*)(lds + PG8_SA(b, h) + aoff + m * 2048 + k * 1024); } while (0)
#define PG8_LDB(dst, b, h) do { _Pragma("unroll") for (int n = 0; n < 2; ++n) _Pragma("unroll") for (int k = 0; k < 2; ++k) dst[n][k] = *(const PG8_LAS bf16x8*)(lds + PG8_SB(b, h) + boff + n * 2048 + k * 1024); } while (0)
#define PG8_MMA(ai, bj, At, Bt) do { __builtin_amdgcn_s_setprio(1); _Pragma("unroll") for (int m = 0; m < 4; ++m) _Pragma("unroll") for (int n = 0; n < 2; ++n) _Pragma("unroll") for (int k = 0; k < 2; ++k) \
        acc[ai][bj][m][n] = __builtin_amdgcn_mfma_f32_16x16x32_bf16(Bt[n][k], At[m][k], acc[ai][bj][m][n], 0, 0, 0); __builtin_amdgcn_s_setprio(0); } while (0)
#define PG8_WAIT_V(n) asm volatile("s_waitcnt vmcnt(" #n ")" ::: "memory")
#define PG8_WAIT_L(n) asm volatile("s_waitcnt lgkmcnt(" #n ")" ::: "memory")
#define PG8_BAR __builtin_amdgcn_s_barrier()
#define PG8_SCHED __builtin_amdgcn_sched_barrier(0)
    Unit cur, nxt; int ui = 0;
    if (!S.next(0, cur)) return;
    f32x4 acc[2][2][4][2];
#pragma unroll
    for (int a = 0; a < 2; ++a)
#pragma unroll
        for (int b = 0; b < 2; ++b)
#pragma unroll
            for (int m = 0; m < 4; ++m)
#pragma unroll
                for (int n = 0; n < 2; ++n) acc[a][b][m][n] = (f32x4){0.f, 0.f, 0.f, 0.f};
    bf16x8 At[4][2], B0[2][2], B1[2][2];
    const char* cA = uni_ptr(S.a_base(cur, tstep)); const char* cB = uni_ptr(S.b_base(cur, tstep));
    S.a_ready(cur);
    if constexpr (SP2) {
        PG8_STAGE(PG8_SB(0, 0), cB, voffB); PG8_STAGE(PG8_SB(0, 1), cB + hstep, voffB); PG8_STAGE(PG8_SA(0, 0), cA, voffA); PG8_STAGE(PG8_SA(0, 1), cA + hstep, voffA);
        if (wr == 1) PG8_BAR;
        PG8_WAIT_V(2); PG8_BAR;
        PG8_STAGE(PG8_SB(1, 0), cB + kstep, voffB); PG8_STAGE(PG8_SA(1, 0), cA + kstep, voffA); PG8_STAGE(PG8_SB(1, 1), cB + hstep + kstep, voffB);
        PG8_WAIT_V(6); PG8_BAR;
    } else {
        PG8_STAGE(PG8_SB(0, 0), cB, voffB); PG8_STAGE(PG8_SA(0, 0), cA, voffA); PG8_STAGE(PG8_SB(0, 1), cB + hstep, voffB); PG8_STAGE(PG8_SA(0, 1), cA + hstep, voffA);
        if (wr == 1) PG8_BAR;
        PG8_WAIT_V(4); PG8_BAR;
        PG8_STAGE(PG8_SB(1, 0), cB + kstep, voffB); PG8_STAGE(PG8_SA(1, 0), cA + kstep, voffA); PG8_STAGE(PG8_SB(1, 1), cB + hstep + kstep, voffB);
        PG8_WAIT_V(6); PG8_BAR;
    }
    for (;;) {
        const bool has_next = S.next(ui + 1, nxt);
        const char* nA = uni_ptr(has_next ? S.a_base(nxt, tstep) : cA); const char* nB = uni_ptr(has_next ? S.b_base(nxt, tstep) : cB);
        for (int t = 0; t < nt; t += 2) {
            const bool last = (t == nt - 2);
            const char* a1 = cA + (size_t)(t + 1) * kstep;
            const char* a2 = last ? nA : cA + (size_t)(t + 2) * kstep; const char* b2 = last ? nB : cB + (size_t)(t + 2) * kstep;
            const char* a3 = a2 + kstep; const char* b3 = b2 + kstep;
            if (last && has_next) S.a_ready(nxt);
            if constexpr (SP2) {
            PG8_LDB(B0, 0, 0); PG8_LDB(B1, 0, 1); PG8_SCHED; PG8_LDA(At, 0, 0); PG8_STAGE(PG8_SA(1, 1), a1 + hstep, voffA);
            PG8_WAIT_V(8); PG8_WAIT_L(0); PG8_BAR; PG8_MMA(0, 0, At, B0); PG8_MMA(0, 1, At, B1); PG8_BAR; PG8_SCHED;
            PG8_LDA(At, 0, 1); PG8_STAGE(PG8_SB(0, 0), b2, voffB); PG8_STAGE(PG8_SB(0, 1), b2 + hstep, voffB); PG8_STAGE(PG8_SA(0, 0), a2, voffA);
            PG8_WAIT_V(8); PG8_WAIT_L(0); PG8_BAR; PG8_MMA(1, 0, At, B0); PG8_MMA(1, 1, At, B1); PG8_BAR; PG8_SCHED;
            PG8_LDB(B0, 1, 0); PG8_LDB(B1, 1, 1); PG8_SCHED; PG8_LDA(At, 1, 0); PG8_STAGE(PG8_SA(0, 1), a2 + hstep, voffA);
            PG8_WAIT_V(8); PG8_WAIT_L(0); PG8_BAR; PG8_MMA(0, 0, At, B0); PG8_MMA(0, 1, At, B1); PG8_BAR; PG8_SCHED;
            PG8_LDA(At, 1, 1); PG8_STAGE(PG8_SB(1, 0), b3, voffB); PG8_STAGE(PG8_SB(1, 1), b3 + hstep, voffB); PG8_STAGE(PG8_SA(1, 0), a3, voffA);
            PG8_WAIT_V(8); PG8_WAIT_L(0); PG8_BAR; PG8_MMA(1, 0, At, B0); PG8_MMA(1, 1, At, B1); PG8_BAR; PG8_SCHED;
            } else {
            PG8_LDB(B0, 0, 0); PG8_SCHED; PG8_LDA(At, 0, 0); PG8_STAGE(PG8_SA(1, 1), a1 + hstep, voffA);
            PG8_WAIT_L(8); PG8_BAR; PG8_WAIT_L(0); PG8_MMA(0, 0, At, B0); PG8_BAR; PG8_SCHED;
            PG8_LDB(B1, 0, 1); PG8_STAGE(PG8_SB(0, 0), b2, voffB);
            PG8_BAR; PG8_WAIT_L(0); PG8_MMA(0, 1, At, B1); PG8_BAR;
            PG8_LDA(At, 0, 1); PG8_STAGE(PG8_SA(0, 0), a2, voffA);
            PG8_BAR; PG8_WAIT_L(0); PG8_MMA(1, 0, At, B0); PG8_BAR; PG8_SCHED;
            PG8_STAGE(PG8_SB(0, 1), b2 + hstep, voffB);
            PG8_WAIT_V(6); PG8_BAR; PG8_MMA(1, 1, At, B1); PG8_BAR;
            PG8_LDB(B0, 1, 0); PG8_SCHED; PG8_LDA(At, 1, 0); PG8_STAGE(PG8_SA(0, 1), a2 + hstep, voffA);
            PG8_WAIT_L(8); PG8_BAR; PG8_WAIT_L(0); PG8_MMA(0, 0, At, B0); PG8_BAR; PG8_SCHED;
            PG8_LDB(B1, 1, 1); PG8_STAGE(PG8_SB(1, 0), b3, voffB);
            PG8_BAR; PG8_WAIT_L(0); PG8_MMA(0, 1, At, B1); PG8_BAR;
            PG8_LDA(At, 1, 1); PG8_STAGE(PG8_SA(1, 0), a3, voffA);
            PG8_BAR; PG8_WAIT_L(0); PG8_MMA(1, 0, At, B0); PG8_BAR; PG8_SCHED;
            PG8_STAGE(PG8_SB(1, 1), b3 + hstep, voffB);
            PG8_WAIT_V(6); PG8_BAR; PG8_MMA(1, 1, At, B1); PG8_BAR;
            }
        }
        if constexpr (ALIGN_EPI) { if (wr == 0) PG8_BAR; }
        if constexpr (!Epi::AFTER_DRAIN) { E(acc, cur, wr, wc, fr, fq); S.done(cur); }
        if (!has_next) break;
#pragma unroll
        for (int a = 0; a < 2; ++a)
#pragma unroll
            for (int b = 0; b < 2; ++b)
#pragma unroll
                for (int m = 0; m < 4; ++m)
#pragma unroll
                    for (int n = 0; n < 2; ++n) acc[a][b][m][n] = (f32x4){0.f, 0.f, 0.f, 0.f};
        cur = nxt; cA = nA; cB = nB; ++ui;
        if constexpr (ALIGN_EPI) { if (wr == 1) PG8_BAR; }
    }
    PG8_WAIT_V(0);
    if constexpr (!ALIGN_EPI) { if (wr == 0) PG8_BAR; }
    PG8_BAR;
    if constexpr (Epi::AFTER_DRAIN) { E.fused(acc, cur, wr, wc, fr, fq, lds, wid, lane); S.done(cur); }
#undef PG8_SA
#undef PG8_SB
#undef PG8_STAGE
#undef PG8_LDA
#undef PG8_LDB
#undef PG8_MMA
#undef PG8_WAIT_V
#undef PG8_WAIT_L
#undef PG8_BAR
#undef PG8_SCHED
}
}

constexpr int NWAVES = 8, NTHR = 512;
constexpr int D = 1024, NB = 8, SEQ = 4096, CTXL = 256, NL = 2;
constexpr int NLAT = NB * SEQ;
constexpr int NCTX = NB * CTXL;
constexpr int MT = NLAT + NCTX;
constexpr int INW = 2576, NEXP = 32, TOPK = 4;
constexpr int PMAX = (MT * TOPK / 256 + NEXP) * 256;
constexpr float EPS = 1e-6f;

constexpr size_t MiB = 1u << 20;
constexpr size_t WS_CTL = 0, CTL_ZERO_BYTES = 1 * MiB;
constexpr size_t WS_MODV = 1 * MiB;
constexpr size_t WS_WRT = 2 * MiB;
constexpr size_t WS_WABT = WS_WRT + 512 * 1024;
constexpr size_t WS_SELE = 3 * MiB;
constexpr size_t WS_SELP = WS_SELE + 640 * 1024;
constexpr size_t WS_SELG = WS_SELP + 640 * 1024;
constexpr size_t WS_G = 5 * MiB;
constexpr size_t WS_BETA = WS_G + 1536 * 1024;
constexpr size_t WS_AB = 8 * MiB;
constexpr size_t WS_WIN = 12 * MiB;
constexpr size_t WS_WOUT = 24 * MiB;
constexpr size_t WS_DFTM = 32 * MiB;
constexpr size_t WS_W1 = 96 * MiB;
constexpr size_t WS_W2 = 224 * MiB;
constexpr size_t WS_XC = 288 * MiB;
constexpr size_t WS_ACT = 296 * MiB;
constexpr size_t WS_S = 364 * MiB;
constexpr size_t WS_QKVZ = WS_S;
constexpr size_t WS_ZTL = WS_S + 136 * MiB;
constexpr size_t WS_ZTC = WS_ZTL + 64 * MiB;
constexpr size_t WS_QKVN = WS_ZTC + 4 * MiB;
constexpr size_t WS_OF = WS_QKVN + 102 * MiB;
constexpr size_t WS_OB = WS_OF + 34 * MiB;
constexpr size_t WS_XS = WS_S;
constexpr size_t WS_HS = WS_S + 288 * MiB;
constexpr size_t WS_END = 1024 * MiB;
static_assert(WS_OB + 34 * MiB <= WS_END && WS_HS + 288 * MiB <= WS_END && (size_t)PMAX * 1024 * 2 == 288 * MiB, "d_ws map");
static_assert((size_t)MT * 16 <= 640 * 1024 && (size_t)MT * 32 <= 1536 * 1024, "sel / g maps");
constexpr int CW_BAR = 4096;
constexpr int CW_GCNT = 16384;

constexpr int RING_BYTES = 131072;
constexpr int LDSCTL_OFF = RING_BYTES, MISC_OFF = LDSCTL_OFF + 320;
constexpr int XT_OFF = RING_BYTES + 1024;
constexpr int LDS_BYTES = 147456;

#define GAS __attribute__((address_space(1)))
#define LAS __attribute__((address_space(3)))
typedef unsigned short bf16;
typedef unsigned v4u __attribute__((ext_vector_type(4)));
typedef unsigned v2u __attribute__((ext_vector_type(2)));
typedef float f32x4 __attribute__((ext_vector_type(4)));
typedef GAS unsigned gu32;
#define RLX_AGENT __ATOMIC_RELAXED, __HIP_MEMORY_SCOPE_AGENT
#define LDS_WAIT() asm volatile("s_waitcnt lgkmcnt(0)" ::: "memory")
#define VM_WAIT() asm volatile("s_waitcnt vmcnt(0)" ::: "memory")
__device__ __forceinline__ unsigned f2bf(float f) { unsigned u = __builtin_bit_cast(unsigned, f); return (u + 0x7fffu + ((u >> 16) & 1u)) >> 16; }
__device__ __forceinline__ unsigned pk2(float lo, float hi) { return f2bf(lo) | (f2bf(hi) << 16); }
__device__ __forceinline__ float bflo(unsigned w) { return __builtin_bit_cast(float, w << 16); }
__device__ __forceinline__ float bfhi(unsigned w) { return __builtin_bit_cast(float, w & 0xffff0000u); }
__device__ __forceinline__ float wave_sum(float v) {
#pragma unroll
    for (int o = 1; o < 64; o <<= 1) v += __shfl_xor(v, o);
    return v;
}
__device__ __forceinline__ float sum16(float v) {
#pragma unroll
    for (int o = 1; o < 16; o <<= 1) v += __shfl_xor(v, o);
    return v;
}
__device__ __forceinline__ float silu_f(float x) { return x / (1.f + __expf(-x)); }

#define XB_TMO      128
#define XB_XCNT(j)  (256  + 64 * (j))
#define XB_XSUB(j)  (1280 + 64 * (j))
#define XB_XGEN(j)  (2304 + 64 * (j))
#define XB_TOP      3328
#define XB_TOPGEN   3392
#define XCD_BAR_WORDS 3456
#define XB_SPIN_CAP (1u << 18)
__device__ __forceinline__ unsigned xb_ld(unsigned* p)              { return __hip_atomic_load(p, __ATOMIC_RELAXED, __HIP_MEMORY_SCOPE_AGENT); }
__device__ __forceinline__ unsigned xb_add(unsigned* p, unsigned v) { return __hip_atomic_fetch_add(p, v, __ATOMIC_RELAXED, __HIP_MEMORY_SCOPE_AGENT); }
__device__ __forceinline__ unsigned xb_xcc_id() { return (unsigned)__builtin_amdgcn_s_getreg((3 << 11) | 20) & 0xFu; }
#define XB_SPIN(cond, bar) do { unsigned _sp = 0; while (cond) { __builtin_amdgcn_s_sleep(1); \
    if ((++_sp & 255u) == 0u) { if (xb_ld(&(bar)[XB_TMO])) break; if (_sp > XB_SPIN_CAP) { atomicAdd(&(bar)[XB_TMO], 1u); break; } } } } while (0)
struct XcdBarrier { unsigned* bar; unsigned x; volatile LAS unsigned* st; };
__device__ __forceinline__ XcdBarrier xcd_barrier_post(unsigned* bar, volatile LAS unsigned* st) {
    XcdBarrier b; b.bar = bar; b.x = xb_xcc_id(); b.st = st;
    if (threadIdx.x == 0) (void)xb_add(&bar[XB_XCNT(b.x)], 1u);
    return b;
}
__device__ __forceinline__ void xcd_barrier_complete(unsigned* bar, unsigned x, unsigned& nloc, unsigned& nx) {
    const unsigned G = gridDim.x * gridDim.y * gridDim.z;
    unsigned sum, cnt, mine, sp = 0u;
    for (;;) {
        sum = 0u; cnt = 0u; mine = 0u;
#pragma unroll
        for (unsigned j = 0; j < 16; ++j) { const unsigned c = xb_ld(&bar[XB_XCNT(j)]); sum += c; cnt += (c > 0u) ? 1u : 0u; mine = (j == x) ? c : mine; }
        if (sum == G) break;
        __builtin_amdgcn_s_sleep(1);
        if ((++sp & 255u) == 0u) { if (xb_ld(&bar[XB_TMO])) break; if (sp > XB_SPIN_CAP) { atomicAdd(&bar[XB_TMO], 1u); break; } }
    }
    nloc = mine > 0u ? mine : 1u; nx = cnt > 0u ? cnt : 1u;
}
__device__ __forceinline__ void xcd_barrier(const XcdBarrier& b) {
    asm volatile("s_waitcnt vmcnt(0)" ::: "memory");
    __syncthreads();
    if (threadIdx.x == 0) {
        unsigned* bar = b.bar; unsigned bx = b.x;
        asm volatile("" : "+v"(bar), "+v"(bx));
        __builtin_amdgcn_s_waitcnt(0);
        unsigned nloc = b.st[0], nx = b.st[1];
        if (nloc == 0u) { xcd_barrier_complete(bar, bx, nloc, nx); b.st[0] = nloc; b.st[1] = nx; }
        const unsigned old = xb_add(&bar[XB_XSUB(bx)], 1u);
        const unsigned gen = old / nloc;
        if (old + 1u == (gen + 1u) * nloc) {
            __builtin_amdgcn_fence(__ATOMIC_RELEASE, "agent");
            asm volatile("s_waitcnt vmcnt(0)" ::: "memory");
            const unsigned og = xb_add(&bar[XB_TOP], 1u);
            const unsigned tg = og / nx;
            if (og + 1u == (tg + 1u) * nx) xb_add(&bar[XB_TOPGEN], 1u);
            else XB_SPIN(xb_ld(&bar[XB_TOPGEN]) == tg, bar);
            __builtin_amdgcn_fence(__ATOMIC_ACQUIRE, "agent");
            xb_add(&bar[XB_XGEN(bx)], 1u);
            asm volatile("s_waitcnt vmcnt(0)" ::: "memory");
        } else {
            XB_SPIN(xb_ld(&bar[XB_XGEN(bx)]) == gen, bar);
            __builtin_amdgcn_fence(__ATOMIC_ACQUIRE, "agent");
            asm volatile("s_waitcnt vmcnt(0)" ::: "memory");
        }
    }
    __syncthreads();
}

struct Args { const float* in[23]; float* out; unsigned char* ws; int ph_lo, ph_hi; };
struct Frame {
    LAS unsigned char* lds;
    volatile LAS unsigned* MISC;
    unsigned* ctl;
    unsigned char* ws;
    int tid, lane, wave, vcu, G, gw, NGW;
    float* out;
};
__device__ __forceinline__ const Args* kargs() { const void* p = (const void*)__builtin_amdgcn_kernarg_segment_ptr(); asm volatile("" : "+s"(p)); return (const Args*)p; }
enum InIdx { I_X = 0, I_C, I_CTX, I_CCTX, I_WMOD, I_BMOD, I_GN1, I_WIN, I_CONVW, I_ALOG, I_DTB, I_GOUT, I_WOUT, I_GN2, I_WR, I_BR, I_WG, I_BG, I_WU, I_BU, I_WD, I_BD, I_GF };
__device__ __forceinline__ float* xr_row(const Frame& F, int t) { return t < NLAT ? F.out + (size_t)t * D : (float*)(F.ws + WS_XC) + (size_t)(t - NLAT) * D; }
__device__ __forceinline__ int mod_row(int t) { return t < NLAT ? (t >> 12) : 8; }
__device__ __forceinline__ const float* modv(const Frame& F, int l, int r, int piece) { return (const float*)(F.ws + WS_MODV) + ((size_t)(l * 9 + r) * 6 + piece) * D; }

struct SchedIn {
    const bf16* hx; const bf16* win; int G, c;
    static constexpr int N0 = (MT / 256) * 8, N1 = 4 * (MT / 256), NWG = N0 + N1;
    __device__ __forceinline__ bool next(int i, pg8::Unit& u) const {
        const long L = (long)i * G + c; if (L >= NWG) return false;
        int w = pg8::xcd_remap((int)L, NWG);
        if (w < N0) { u.kind = 0; pg8::grp_decode(w, MT / 256, 8, u.pm, u.pn); } else { w -= N0; u.kind = 1; u.pn = w >> 2; u.pm = w & 3; }
        u.e = 0; return true;
    }
    __device__ __forceinline__ const char* a_base(const pg8::Unit& u, size_t tstep) const { return u.kind == 0 ? (const char*)hx + (size_t)u.pm * tstep : (const char*)win + (size_t)(8 + u.pm) * tstep; }
    __device__ __forceinline__ const char* b_base(const pg8::Unit& u, size_t tstep) const { return u.kind == 0 ? (const char*)win + (size_t)u.pn * tstep : (const char*)hx + (size_t)u.pn * tstep; }
    __device__ __forceinline__ void a_ready(const pg8::Unit&) const {}
    __device__ __forceinline__ void done(const pg8::Unit&) const {}
};
struct EpiIn {
    static constexpr bool PERM = true, AFTER_DRAIN = false;
    bf16* qkvz; bf16* ztl; bf16* ztc;
    __device__ __forceinline__ void operator()(const pg8::f32x4 (&acc)[2][2][4][2], const pg8::Unit& u, int wr, int wc, int fr_, int fq_) const {
        int fr = fr_, fq = fq_; asm volatile("" : "+v"(fr), "+v"(fq));
        const int row0 = u.pm * 256 + wr * 64 + fr, cin = wc * 32 + 8 * fq;
        bf16* base; size_t ldc;
        if (u.kind == 0) { base = qkvz + (size_t)u.pn * 256 + cin; ldc = 2048; }
        else if (u.pn < 128) { base = ztl + (size_t)(u.pn >> 4) * 1024 * 4096 + (size_t)(u.pn & 15) * 256 + cin; ldc = 4096; }
        else { base = ztc + (size_t)(u.pn - 128) * 1024 * 256 + cin; ldc = 256; }
#pragma unroll
        for (int ai = 0; ai < 2; ++ai)
#pragma unroll
            for (int m = 0; m < 4; ++m) { bf16* rowp = base + (size_t)(row0 + ai * 128 + m * 16) * ldc;
#pragma unroll
                for (int bj = 0; bj < 2; ++bj) { const pg8::f32x4 v0 = acc[ai][bj][m][0], v1 = acc[ai][bj][m][1]; pg8::u32x4 w;
                    w.x = pg8::cvt_pk_bf16(v0[0], v0[1]); w.y = pg8::cvt_pk_bf16(v0[2], v0[3]); w.z = pg8::cvt_pk_bf16(v1[0], v1[1]); w.w = pg8::cvt_pk_bf16(v1[2], v1[3]);
                    *(pg8::u32x4*)(rowp + bj * 128) = w; } }
    }
};
struct SchedDft {
    const bf16* dftm; const bf16* ztl; int G, c;
    __device__ __forceinline__ bool next(int i, pg8::Unit& u) const {
        const long L = (long)i * G + c; if (L >= 256) return false;
        const int w = pg8::xcd_remap((int)L, 256), x = w >> 5, j = w & 31, bp = j >> 2;
        u.pm = 4 * (x & 3) + (j & 3); u.e = 4 * (x >> 2) + (bp >> 1); u.pn = bp & 1; u.kind = 0; return true;
    }
    __device__ __forceinline__ const char* a_base(const pg8::Unit& u, size_t tstep) const { return (const char*)dftm + (size_t)u.pm * tstep; }
    __device__ __forceinline__ const char* b_base(const pg8::Unit& u, size_t tstep) const { return (const char*)ztl + (size_t)u.e * (512 * 8192 * 2) + (size_t)u.pn * tstep; }
    __device__ __forceinline__ void a_ready(const pg8::Unit&) const {}
    __device__ __forceinline__ void done(const pg8::Unit&) const {}
};
struct EpiDft {
    static constexpr bool PERM = true, AFTER_DRAIN = false;
    bf16* mix; float scale;
    __device__ __forceinline__ void operator()(const pg8::f32x4 (&acc)[2][2][4][2], const pg8::Unit& u, int wr, int wc, int fr_, int fq_) const {
        int fr = fr_, fq = fq_; asm volatile("" : "+v"(fr), "+v"(fq));
        const int row0 = u.e * SEQ + u.pm * 256 + wr * 64 + fr, col0 = u.pn * 256 + wc * 32 + 8 * fq;
#pragma unroll
        for (int ai = 0; ai < 2; ++ai)
#pragma unroll
            for (int m = 0; m < 4; ++m) { bf16* rowp = mix + (size_t)(row0 + ai * 128 + m * 16) * D + col0;
#pragma unroll
                for (int bj = 0; bj < 2; ++bj) { const pg8::f32x4 v0 = acc[ai][bj][m][0] * scale, v1 = acc[ai][bj][m][1] * scale; pg8::u32x4 w;
                    w.x = pg8::cvt_pk_bf16(v0[0], v0[1]); w.y = pg8::cvt_pk_bf16(v0[2], v0[3]); w.z = pg8::cvt_pk_bf16(v1[0], v1[1]); w.w = pg8::cvt_pk_bf16(v1[2], v1[3]);
                    *(pg8::u32x4*)(rowp + bj * 128) = w; } }
    }
};
struct SchedOut {
    const bf16* mix; const bf16* wout; int nM, G, c;
    __device__ __forceinline__ bool next(int i, pg8::Unit& u) const {
        const int nwg = nM * 4; const long L = (long)i * G + c; if (L >= nwg) return false;
        pg8::grp_decode(pg8::xcd_remap((int)L, nwg), nM, 4, u.pm, u.pn); u.kind = 0; u.e = 0; return true;
    }
    __device__ __forceinline__ const char* a_base(const pg8::Unit& u, size_t tstep) const { return (const char*)mix + (size_t)u.pm * tstep; }
    __device__ __forceinline__ const char* b_base(const pg8::Unit& u, size_t tstep) const { return (const char*)wout + (size_t)u.pn * tstep; }
    __device__ __forceinline__ void a_ready(const pg8::Unit&) const {}
    __device__ __forceinline__ void done(const pg8::Unit&) const {}
};
struct EpiOut {
    static constexpr bool PERM = false, AFTER_DRAIN = false;
    float* xlat; float* xctx; const float* gt1;
    __device__ __forceinline__ void operator()(const pg8::f32x4 (&acc)[2][2][4][2], const pg8::Unit& u, int wr, int wc, int fr_, int fq_) const {
        int fr = fr_, fq = fq_; asm volatile("" : "+v"(fr), "+v"(fq));
        const int col0 = u.pn * 256 + wc * 32 + 4 * fq, rl = wr * 64 + fr;
        float* xb = u.pm < 128 ? xlat + (size_t)u.pm * 256 * D : xctx + (size_t)(u.pm - 128) * 256 * D;
        const float* g = gt1 + (size_t)(u.pm < 128 ? (u.pm >> 4) : 8) * 6 * D + col0;
        pg8::f32x4 gv[2][2];
#pragma unroll
        for (int bj = 0; bj < 2; ++bj)
#pragma unroll
            for (int n = 0; n < 2; ++n) gv[bj][n] = *(const pg8::f32x4*)(g + bj * 128 + n * 16);
#pragma unroll
        for (int ai = 0; ai < 2; ++ai)
#pragma unroll
            for (int m = 0; m < 4; ++m) { float* rowp = xb + (size_t)(rl + ai * 128 + m * 16) * D + col0;
#pragma unroll
                for (int bj = 0; bj < 2; ++bj)
#pragma unroll
                    for (int n = 0; n < 2; ++n) { pg8::f32x4* p = (pg8::f32x4*)(rowp + bj * 128 + n * 16); const pg8::f32x4 xo = *p; *p = xo + gv[bj][n] * acc[ai][bj][m][n]; }
                if (m & 1) asm volatile("" ::: "memory"); }
    }
};
struct SchedMoe {
    const bf16* A; const bf16* W; size_t wstride; const LAS int* pend; int nM, nN, G, c;
    __device__ __forceinline__ bool next(int i, pg8::Unit& u) const {
        const int nwg = nM * nN; const long L = (long)i * G + c; if (L >= nwg) return false;
        pg8::grp_decode(pg8::xcd_remap((int)L, nwg), nM, nN, u.pm, u.pn);
        int e = 0;
#pragma unroll 1
        for (int j = 0; j < NEXP - 1; ++j) e += (pend[j] <= u.pm) ? 1 : 0;
        u.e = e; u.kind = 0; return true;
    }
    __device__ __forceinline__ const char* a_base(const pg8::Unit& u, size_t tstep) const { return (const char*)A + (size_t)u.pm * tstep; }
    __device__ __forceinline__ const char* b_base(const pg8::Unit& u, size_t tstep) const { return (const char*)W + (size_t)u.e * wstride + (size_t)u.pn * tstep; }
    __device__ __forceinline__ void a_ready(const pg8::Unit&) const {}
    __device__ __forceinline__ void done(const pg8::Unit&) const {}
};
struct EpiSwiglu {
    static constexpr bool PERM = true, AFTER_DRAIN = false;
    bf16* hs; const float* bg; const float* bu;
    __device__ __forceinline__ void operator()(const pg8::f32x4 (&acc)[2][2][4][2], const pg8::Unit& u, int wr, int wc, int fr_, int fq_) const {
        int fr = fr_, fq = fq_; asm volatile("" : "+v"(fr), "+v"(fq));
        const int row0 = u.pm * 256 + wr * 64 + fr, f0 = u.pn * 128 + wc * 32 + 8 * fq;
        const pg8::f32x4 bg0 = *(const pg8::f32x4*)(bg + u.e * D + f0), bg1 = *(const pg8::f32x4*)(bg + u.e * D + f0 + 4);
        const pg8::f32x4 bu0 = *(const pg8::f32x4*)(bu + u.e * D + f0), bu1 = *(const pg8::f32x4*)(bu + u.e * D + f0 + 4);
#pragma unroll
        for (int ai = 0; ai < 2; ++ai)
#pragma unroll
            for (int m = 0; m < 4; ++m) {
                float h[8];
#pragma unroll
                for (int n = 0; n < 2; ++n) { const pg8::f32x4 ga = acc[ai][0][m][n] + (n ? bg1 : bg0), ua = acc[ai][1][m][n] + (n ? bu1 : bu0);
#pragma unroll
                    for (int j = 0; j < 4; ++j) { const float a = fminf(ga[j], 7.0f), uu = fminf(fmaxf(ua[j], -7.0f), 7.0f);
                        h[n * 4 + j] = a * __builtin_amdgcn_rcpf(1.0f + __expf(-1.702f * a)) * (uu + 1.0f); } }
                pg8::u32x4 w; w.x = pg8::cvt_pk_bf16(h[0], h[1]); w.y = pg8::cvt_pk_bf16(h[2], h[3]); w.z = pg8::cvt_pk_bf16(h[4], h[5]); w.w = pg8::cvt_pk_bf16(h[6], h[7]);
                *(pg8::u32x4*)(hs + (size_t)(row0 + ai * 128 + m * 16) * D + f0) = w; }
    }
};
struct EpiDown {
    static constexpr bool PERM = true, AFTER_DRAIN = false;
    bf16* ys; const float* bd;
    __device__ __forceinline__ void operator()(const pg8::f32x4 (&acc)[2][2][4][2], const pg8::Unit& u, int wr, int wc, int fr_, int fq_) const {
        int fr = fr_, fq = fq_; asm volatile("" : "+v"(fr), "+v"(fq));
        const int row0 = u.pm * 256 + wr * 64 + fr, col0 = u.pn * 256 + wc * 32 + 8 * fq;
        pg8::f32x4 bv[2][2];
#pragma unroll
        for (int bj = 0; bj < 2; ++bj)
#pragma unroll
            for (int n = 0; n < 2; ++n) bv[bj][n] = *(const pg8::f32x4*)(bd + u.e * D + col0 + bj * 128 + 4 * n);
#pragma unroll
        for (int ai = 0; ai < 2; ++ai)
#pragma unroll
            for (int m = 0; m < 4; ++m) { bf16* rowp = ys + (size_t)(row0 + ai * 128 + m * 16) * D + col0;
#pragma unroll
                for (int bj = 0; bj < 2; ++bj) { const pg8::f32x4 v0 = acc[ai][bj][m][0] + bv[bj][0], v1 = acc[ai][bj][m][1] + bv[bj][1]; pg8::u32x4 w;
                    w.x = pg8::cvt_pk_bf16(v0[0], v0[1]); w.y = pg8::cvt_pk_bf16(v0[2], v0[3]); w.z = pg8::cvt_pk_bf16(v1[0], v1[1]); w.w = pg8::cvt_pk_bf16(v1[2], v1[3]);
                    *(pg8::u32x4*)(rowp + bj * 128) = w; } }
    }
};

__device__ __forceinline__ void transpose_item(const float* W, int ldw, int col0, int K, bf16* WT, int drow0, LAS float* scr, int kb, int lane) {
    const int k0 = 64 * kb;
#pragma unroll 8
    for (int i = 0; i < 32; ++i) { const int kk = 2 * i + (lane >> 5); scr[kk * 33 + (lane & 31)] = W[(size_t)(k0 + kk) * ldw + col0 + (lane & 31)]; }
    LDS_WAIT(); asm volatile("" ::: "memory");
    const int c = lane & 7;
#pragma unroll
    for (int j = 0; j < 4; ++j) { const int n = (lane >> 3) + 8 * j; const LAS float* s = scr + (8 * c) * 33 + n;
        v4u o; o.x = pk2(s[0 * 33], s[1 * 33]); o.y = pk2(s[2 * 33], s[3 * 33]); o.z = pk2(s[4 * 33], s[5 * 33]); o.w = pk2(s[6 * 33], s[7 * 33]);
        *(v4u*)(WT + (size_t)(drow0 + n) * K + k0 + 8 * c) = o; }
    LDS_WAIT(); asm volatile("" ::: "memory");
}
__device__ __forceinline__ void convert_experts(const Frame& F, int l) {
    const Args* A = kargs();
    LAS float* scr = (LAS float*)(F.lds + F.wave * 16384);
    bf16* W1 = (bf16*)(F.ws + WS_W1); bf16* W2 = (bf16*)(F.ws + WS_W2);
    constexpr int IPM = 16 * 32;
    for (int it = F.gw; it < 3 * NEXP * IPM; it += F.NGW) {
        const int which = it / (NEXP * IPM), r = it % (NEXP * IPM), e = r / IPM, q = r % IPM, kb = q >> 5, nb = q & 31;
        const size_t moff = ((size_t)l * NEXP + e) * D * D;
        if (which == 0) transpose_item(A->in[I_WG] + moff, D, nb * 32, D, W1 + (size_t)e * 2048 * D, 256 * (nb >> 2) + 32 * (nb & 3), scr, kb, F.lane);
        else if (which == 1) transpose_item(A->in[I_WU] + moff, D, nb * 32, D, W1 + (size_t)e * 2048 * D, 256 * (nb >> 2) + 128 + 32 * (nb & 3), scr, kb, F.lane);
        else transpose_item(A->in[I_WD] + moff, D, nb * 32, D, W2 + (size_t)e * D * D, nb * 32, scr, kb, F.lane);
    }
}
__device__ __forceinline__ void p0_prologue(const Frame& F) {
    const Args* A = kargs();
    float* mv = (float*)(F.ws + WS_MODV);
    {
        LAS float* sc = (LAS float*)F.lds;
        LAS float* red = sc + 9 * 1024;
        for (int i = F.tid; i < 9 * 1024; i += NTHR) { const int r = i >> 10, k = i & 1023; sc[i] = silu_f(r < 8 ? A->in[I_C][r * D + k] : A->in[I_CCTX][k]); }
        __syncthreads();
        for (int item = blockIdx.x; item < 192; item += F.G) {
            const int l = item / 96, cg = item % 96, cl = F.tid & 63, ks = F.tid >> 6;
            const float* w = A->in[I_WMOD] + ((size_t)l * D + ks * 128) * 6144 + cg * 64 + cl;
            float a[9];
#pragma unroll
            for (int r = 0; r < 9; ++r) a[r] = 0.f;
#pragma unroll 4
            for (int k = 0; k < 128; ++k) { const float wv = w[(size_t)k * 6144];
#pragma unroll
                for (int r = 0; r < 9; ++r) a[r] += sc[r * 1024 + ks * 128 + k] * wv; }
#pragma unroll
            for (int r = 0; r < 9; ++r) red[(ks * 9 + r) * 64 + cl] = a[r];
            __syncthreads();
            for (int i = F.tid; i < 9 * 64; i += NTHR) { const int r = i >> 6, cc = i & 63; float s = 0.f;
#pragma unroll
                for (int k2 = 0; k2 < 8; ++k2) s += red[(k2 * 9 + r) * 64 + cc];
                mv[(size_t)(l * 9 + r) * 6144 + cg * 64 + cc] = s + A->in[I_BMOD][l * 6144 + cg * 64 + cc]; }
            __syncthreads();
        }
    }
    {
        LAS float* T = (LAS float*)F.lds;
        LAS float* cs = T + 64 * 129; LAS float* sn = cs + 128;
        __syncthreads();
        if (F.tid < 128) { cs[F.tid] = cospif((float)F.tid * (1.0f / 64.0f)); sn[F.tid] = sinpif((float)F.tid * (1.0f / 64.0f)); }
        for (int item = (blockIdx.x + 64) % F.G; item < 128; item += F.G) {
            const int l = item >> 6, kg = (item & 63) >> 2, g = item & 3;
            __syncthreads();
            for (int i = F.tid; i < 64 * 128; i += NTHR) { const int kk = i >> 7, cc = i & 127; T[kk * 129 + cc] = A->in[I_WIN][((size_t)l * D + kg * 64 + kk) * INW + g * 128 + cc]; }
            __syncthreads();
            const int kk = F.tid & 63, ng = F.tid >> 6;
            bf16* dst = (bf16*)(F.ws + WS_WIN) + ((size_t)l * 3072 + 2048 + g * 256) * D + kg * 64 + kk;
#pragma unroll 1
            for (int nn = 0; nn < 32; ++nn) { const int np = ng * 32 + nn, cp = np >> 1; float s = 0.f;
                if (np & 1) {
#pragma unroll 8
                    for (int cc = 0; cc < 128; ++cc) s -= T[kk * 129 + cc] * sn[(cc * cp) & 127]; }
                else {
#pragma unroll 8
                    for (int cc = 0; cc < 128; ++cc) s += T[kk * 129 + cc] * cs[(cc * cp) & 127]; }
                dst[(size_t)np * D] = (bf16)f2bf(s); }
        }
        __syncthreads();
    }
    {
        LAS float* scr = (LAS float*)(F.lds + F.wave * 16384);
        constexpr int I_IN = 16 * 64, I_OUT = 16 * 32;
        for (int it = F.gw; it < NL * (I_IN + I_OUT); it += F.NGW) {
            const int l = it / (I_IN + I_OUT), r = it % (I_IN + I_OUT);
            if (r < I_IN) transpose_item(A->in[I_WIN] + (size_t)l * D * INW, INW, 512 + 32 * (r & 63), D, (bf16*)(F.ws + WS_WIN) + (size_t)l * 3072 * D, 32 * (r & 63), scr, r >> 6, F.lane);
            else { const int q = r - I_IN; transpose_item(A->in[I_WOUT] + (size_t)l * D * D, D, 32 * (q & 31), D, (bf16*)(F.ws + WS_WOUT) + (size_t)l * D * D, 32 * (q & 31), scr, q >> 5, F.lane); }
        }
    }
    convert_experts(F, 0);
    {
        const int gt = F.gw * 64 + F.lane, NT = F.NGW * 64;
        float* wrt = (float*)(F.ws + WS_WRT); float* wabt = (float*)(F.ws + WS_WABT);
        for (int i = gt; i < NL * NEXP * D; i += NT) { const int l = i >> 15, e = (i >> 10) & 31, c = i & 1023; wrt[i] = A->in[I_WR][((size_t)l * D + c) * NEXP + e]; }
        for (int i = gt; i < NL * 16 * D; i += NT) { const int l = i >> 14, j = (i >> 10) & 15, c = i & 1023; wabt[i] = A->in[I_WIN][((size_t)l * D + c) * INW + 2560 + j]; }
        bf16* dm = (bf16*)(F.ws + WS_DFTM);
        for (int i = gt; i < 4096 * 1024; i += NT) { const int kf = i >> 10, j0 = (i & 1023) * 8; float v[8];
#pragma unroll
            for (int jj = 0; jj < 8; ++jj) { const int j = j0 + jj; const float a = (float)((kf * (j & 4095)) & 4095) * (1.0f / 2048.0f); v[jj] = j < 4096 ? cospif(a) : sinpif(a); }
            v4u o; o.x = pk2(v[0], v[1]); o.y = pk2(v[2], v[3]); o.z = pk2(v[4], v[5]); o.w = pk2(v[6], v[7]);
            *(v4u*)(dm + (size_t)kf * 8192 + j0) = o; }
    }
}

template <int MODE>
__device__ __forceinline__ void row_pass(const Frame& F, int l_cur, int l_nxt) {
    const Args* A = kargs();
    LAS float* wl = (LAS float*)F.lds;
    if (MODE != 2) { const f32x4* src = (const f32x4*)((const float*)(F.ws + WS_WABT) + (size_t)l_nxt * 16 * D);
        for (int i = F.tid; i < 16 * D / 4; i += NTHR) ((LAS f32x4*)wl)[i] = src[i];
        __syncthreads(); }
    const int nrows = MODE == 2 ? NLAT : MT;
    const int* sele = (const int*)(F.ws + WS_SELE); const int* selp = (const int*)(F.ws + WS_SELP); const float* selg = (const float*)(F.ws + WS_SELG);
    const bf16* ys = (const bf16*)(F.ws + WS_XS);
    bf16* hx = (bf16*)(F.ws + WS_ACT); float* ab = (float*)(F.ws + WS_AB);
    for (int t = F.gw; t < nrows; t += F.NGW) {
        const int r = mod_row(t);
        f32x4 v[4];
        float* xr = xr_row(F, t);
        if (MODE == 0) { const float* xin = t < NLAT ? A->in[I_X] + (size_t)t * D : A->in[I_CTX] + (size_t)(t - NLAT) * D;
#pragma unroll
            for (int j = 0; j < 4; ++j) v[j] = *((const f32x4*)xin + F.lane + 64 * j);
        } else {
#pragma unroll
            for (int j = 0; j < 4; ++j) v[j] = *((const f32x4*)xr + F.lane + 64 * j);
            f32x4 y[4];
#pragma unroll
            for (int j = 0; j < 4; ++j) y[j] = (f32x4){0.f, 0.f, 0.f, 0.f};
            (void)sele;
#pragma unroll
            for (int k = 0; k < 4; ++k) { const int dst = selp[t * 4 + k]; const float gk = selg[t * 4 + k]; const v2u* yr = (const v2u*)(ys + (size_t)dst * D) + F.lane;
#pragma unroll
                for (int j = 0; j < 4; ++j) { const v2u w = yr[64 * j]; y[j] += gk * (f32x4){bflo(w.x), bfhi(w.x), bflo(w.y), bfhi(w.y)}; } }
            const f32x4* g2 = (const f32x4*)modv(F, l_cur, r, 5) + F.lane;
#pragma unroll
            for (int j = 0; j < 4; ++j) v[j] += g2[64 * j] * y[j];
        }
        if (MODE != 2) {
#pragma unroll
            for (int j = 0; j < 4; ++j) *((f32x4*)xr + F.lane + 64 * j) = v[j];
        }
        float ss = 0.f;
#pragma unroll
        for (int j = 0; j < 4; ++j) ss += (v[j].x * v[j].x + v[j].y * v[j].y) + (v[j].z * v[j].z + v[j].w * v[j].w);
        const float rstd = 1.0f / sqrtf(wave_sum(ss) * (1.0f / D) + EPS);
        if (MODE == 2) {
            const f32x4* gf = (const f32x4*)A->in[I_GF] + F.lane;
#pragma unroll
            for (int j = 0; j < 4; ++j) *((f32x4*)(F.out + (size_t)t * D) + F.lane + 64 * j) = v[j] * rstd * gf[64 * j];
        } else {
            const f32x4* g1 = (const f32x4*)(A->in[I_GN1] + (size_t)l_nxt * D) + F.lane;
            const f32x4* sh = (const f32x4*)modv(F, l_nxt, r, 0) + F.lane; const f32x4* scl = (const f32x4*)modv(F, l_nxt, r, 1) + F.lane;
            v2u* ho = (v2u*)(hx + (size_t)t * D) + F.lane;
#pragma unroll
            for (int j = 0; j < 4; ++j) { v[j] = v[j] * rstd * g1[64 * j] * (scl[64 * j] + 1.0f) + sh[64 * j]; v2u w; w.x = pk2(v[j].x, v[j].y); w.y = pk2(v[j].z, v[j].w); ho[64 * j] = w; }
            float mine = 0.f;
#pragma unroll 2
            for (int jj = 0; jj < 16; ++jj) { float p = 0.f;
#pragma unroll
                for (int j = 0; j < 4; ++j) { const f32x4 w = ((const LAS f32x4*)(wl + jj * D))[F.lane + 64 * j]; p += (v[j].x * w.x + v[j].y * w.y) + (v[j].z * w.z + v[j].w * w.w); }
                p = wave_sum(p); if (F.lane == jj) mine = p; }
            if (F.lane < 16) ab[(size_t)t * 16 + F.lane] = mine;
        }
    }
}

__device__ __forceinline__ void conv_phase(const Frame& F, int l) {
    const Args* A = kargs();
    LAS float* cw = (LAS float*)F.lds;
    for (int i = F.tid; i < 5 * 1536; i += NTHR) cw[i] = A->in[I_CONVW][(size_t)l * 5 * 1536 + i];
    __syncthreads();
    const bf16* qkvz = (const bf16*)(F.ws + WS_QKVZ); bf16* qkvn = (bf16*)(F.ws + WS_QKVN);
    const float* ab = (const float*)(F.ws + WS_AB); float* gb = (float*)(F.ws + WS_G); float* bb = (float*)(F.ws + WS_BETA);
    for (int t = F.gw; t < MT; t += F.NGW) {
        int sb, p, Ls;
        if (t < NLAT) { sb = t & ~4095; p = t & 4095; Ls = SEQ; } else { const int tt = t - NLAT; sb = NLAT + (tt & ~255); p = tt & 255; Ls = CTXL; }
        float a[3][8];
#pragma unroll
        for (int q = 0; q < 3; ++q)
#pragma unroll
            for (int i = 0; i < 8; ++i) a[q][i] = 0.f;
#pragma unroll
        for (int tap = 0; tap < 5; ++tap) { const int pp = p + tap - 2;
            if (pp >= 0 && pp < Ls) {
#pragma unroll
                for (int q = 0; q < 3; ++q) { const v4u u = *(const v4u*)(qkvz + (size_t)(sb + pp) * 2048 + q * 512 + 8 * F.lane);
                    const LAS f32x4* wp = (const LAS f32x4*)(cw + tap * 1536 + q * 512 + 8 * F.lane); const f32x4 w0 = wp[0], w1 = wp[1];
                    a[q][0] += bflo(u.x) * w0.x; a[q][1] += bfhi(u.x) * w0.y; a[q][2] += bflo(u.y) * w0.z; a[q][3] += bfhi(u.y) * w0.w;
                    a[q][4] += bflo(u.z) * w1.x; a[q][5] += bfhi(u.z) * w1.y; a[q][6] += bflo(u.w) * w1.z; a[q][7] += bfhi(u.w) * w1.w; } } }
#pragma unroll
        for (int q = 0; q < 3; ++q) { float ss = 0.f;
#pragma unroll
            for (int i = 0; i < 8; ++i) { a[q][i] = silu_f(a[q][i]); ss += a[q][i] * a[q][i]; }
            float sc = 1.0f;
            if (q < 2) { ss = sum16(ss); sc = (1.0f / sqrtf(ss + EPS)) * (q == 0 ? 0.08838834764831845f : 1.0f); }
            v4u o; o.x = pk2(a[q][0] * sc, a[q][1] * sc); o.y = pk2(a[q][2] * sc, a[q][3] * sc); o.z = pk2(a[q][4] * sc, a[q][5] * sc); o.w = pk2(a[q][6] * sc, a[q][7] * sc);
            *(v4u*)(qkvn + (size_t)t * 1536 + q * 512 + 8 * F.lane) = o; }
        if (F.lane < 8) { const int d = F.lane >> 2, h = F.lane & 3;
            const float xg = ab[(size_t)t * 16 + d * 8 + h] + A->in[I_DTB][l * 8 + d * 4 + h];
            const float sp = xg > 20.f ? xg : log1pf(expf(xg));
            gb[(size_t)t * 8 + F.lane] = -expf(A->in[I_ALOG][l * 8 + d * 4 + h]) * sp;
            bb[(size_t)t * 8 + F.lane] = 1.0f / (1.0f + expf(-ab[(size_t)t * 16 + d * 8 + 4 + h])); }
    }
}

__device__ __forceinline__ void ctx_dft(const Frame& F) {
    LAS float* cs = (LAS float*)F.lds;
    LAS float* sn = cs + 256;
    __syncthreads();
    if (F.tid < 256) { cs[F.tid] = cospif((float)F.tid * (1.0f / 128.0f)); sn[F.tid] = sinpif((float)F.tid * (1.0f / 128.0f)); }
    __syncthreads();
    const bf16* ztc = (const bf16*)(F.ws + WS_ZTC); bf16* mix = (bf16*)(F.ws + WS_ACT);
    const float scale = 1.0f / sqrtf(256.0f * 128.0f);
    const int gt = F.gw * 64 + F.lane, NT = F.NGW * 64;
    for (int i = gt; i < NCTX * 512; i += NT) {
        const int c = i & 511, lp = (i >> 9) & 255, b = i >> 17;
        const bf16* z = ztc + ((size_t)b * 512 + c) * 512;
        float s = 0.f;
#pragma unroll 4
        for (int l = 0; l < 256; l += 2) { const unsigned zr = *(const unsigned*)(z + l), zi = *(const unsigned*)(z + 256 + l);
            const int i0 = (l * lp) & 255, i1 = ((l + 1) * lp) & 255;
            s += bflo(zr) * cs[i0] + bflo(zi) * sn[i0] + bfhi(zr) * cs[i1] + bfhi(zi) * sn[i1]; }
        mix[(size_t)(NLAT + b * 256 + lp) * D + c] = (bf16)f2bf(s * scale);
    }
}

__device__ __forceinline__ void scan_naive(const Frame& F, int l) {
    LAS float* kL = (LAS float*)F.lds;
    LAS float* qL = kL + 64 * 128;
    LAS float* vL = qL + 64 * 128;
    LAS float* oL = vL + 64 * 32;
    LAS float* gL = oL + 64 * 32;
    LAS float* bL = gL + 64;
    const bf16* qkvn = (const bf16*)(F.ws + WS_QKVN);
    const float* gb = (const float*)(F.ws + WS_G); const float* bb = (const float*)(F.ws + WS_BETA);
    for (int unit = F.vcu; unit < 256; unit += F.G) {
        const int qd = unit & 3, s = unit >> 2, d = s & 1, h = (s >> 1) & 3, b = s >> 3;
        bf16* od = (bf16*)(F.ws + (d ? WS_OB : WS_OF));
        const int j = F.tid >> 4, rg = F.tid & 15;
        float S[8];
#pragma unroll
        for (int i = 0; i < 8; ++i) S[i] = 0.f;
#pragma unroll 1
        for (int ci = 0; ci < 68; ++ci) {
            int rowbase; const bool isctx = ci < 4;
            if (isctx) rowbase = NLAT + b * 256 + (d ? 3 - ci : ci) * 64; else { const int lc = ci - 4; rowbase = b * SEQ + (d ? 63 - lc : lc) * 64; }
            __syncthreads();
            for (int i = F.tid; i < 64 * 16; i += NTHR) { const int r = i >> 4, g8 = i & 15; const bf16* rp = qkvn + (size_t)(rowbase + r) * 1536 + h * 128 + g8 * 8;
                const v4u q = *(const v4u*)rp, k = *(const v4u*)(rp + 512);
                LAS float* qo = qL + r * 128 + g8 * 8; LAS float* ko = kL + r * 128 + g8 * 8;
                qo[0] = bflo(q.x); qo[1] = bfhi(q.x); qo[2] = bflo(q.y); qo[3] = bfhi(q.y); qo[4] = bflo(q.z); qo[5] = bfhi(q.z); qo[6] = bflo(q.w); qo[7] = bfhi(q.w);
                ko[0] = bflo(k.x); ko[1] = bfhi(k.x); ko[2] = bflo(k.y); ko[3] = bfhi(k.y); ko[4] = bflo(k.z); ko[5] = bfhi(k.z); ko[6] = bflo(k.w); ko[7] = bfhi(k.w); }
            if (F.tid < 256) { const int r = F.tid >> 2, g8 = F.tid & 3; const v4u v = *(const v4u*)(qkvn + (size_t)(rowbase + r) * 1536 + 1024 + h * 128 + qd * 32 + g8 * 8);
                LAS float* vo = vL + r * 32 + g8 * 8;
                vo[0] = bflo(v.x); vo[1] = bfhi(v.x); vo[2] = bflo(v.y); vo[3] = bfhi(v.y); vo[4] = bflo(v.z); vo[5] = bfhi(v.z); vo[6] = bflo(v.w); vo[7] = bfhi(v.w); }
            else if (F.tid < 320) { const int r = F.tid - 256; gL[r] = __expf(gb[(size_t)(rowbase + r) * 8 + d * 4 + h]); bL[r] = bb[(size_t)(rowbase + r) * 8 + d * 4 + h]; }
            __syncthreads();
#pragma unroll 2
            for (int st = 0; st < 64; ++st) {
                const int r = d ? 63 - st : st;
                const float alpha = gL[r], bt = bL[r];
                const f32x4 k0 = *(const LAS f32x4*)(kL + r * 128 + rg * 8), k1 = *(const LAS f32x4*)(kL + r * 128 + rg * 8 + 4);
                const f32x4 q0 = *(const LAS f32x4*)(qL + r * 128 + rg * 8), q1 = *(const LAS f32x4*)(qL + r * 128 + rg * 8 + 4);
                float part = (k0.x * S[0] + k0.y * S[1]) + (k0.z * S[2] + k0.w * S[3]) + (k1.x * S[4] + k1.y * S[5]) + (k1.z * S[6] + k1.w * S[7]);
                part = sum16(part);
                const float dl = bt * (vL[r * 32 + j] - alpha * part);
                S[0] = alpha * S[0] + k0.x * dl; S[1] = alpha * S[1] + k0.y * dl; S[2] = alpha * S[2] + k0.z * dl; S[3] = alpha * S[3] + k0.w * dl;
                S[4] = alpha * S[4] + k1.x * dl; S[5] = alpha * S[5] + k1.y * dl; S[6] = alpha * S[6] + k1.z * dl; S[7] = alpha * S[7] + k1.w * dl;
                float op = (q0.x * S[0] + q0.y * S[1]) + (q0.z * S[2] + q0.w * S[3]) + (q1.x * S[4] + q1.y * S[5]) + (q1.z * S[6] + q1.w * S[7]);
                op = sum16(op);
                if (rg == 0) oL[r * 32 + j] = op;
            }
            __syncthreads();
            if (!(isctx && l == NL - 1)) { const int r = F.tid >> 3, g4 = F.tid & 7; const LAS float* op = oL + r * 32 + g4 * 4;
                v2u w; w.x = pk2(op[0], op[1]); w.y = pk2(op[2], op[3]);
                *(v2u*)(od + (size_t)(rowbase + r) * 512 + h * 128 + qd * 32 + g4 * 4) = w; }
        }
        __syncthreads();
    }
}

__device__ __forceinline__ void gated_out(const Frame& F, int l) {
    const Args* A = kargs();
    const bf16* of = (const bf16*)(F.ws + WS_OF); const bf16* ob = (const bf16*)(F.ws + WS_OB); const bf16* qkvz = (const bf16*)(F.ws + WS_QKVZ);
    bf16* mix = (bf16*)(F.ws + WS_ACT);
    const int nrows = l == NL - 1 ? NLAT : MT;
    const f32x4 g0 = *(const f32x4*)(A->in[I_GOUT] + l * 128 + (F.lane & 15) * 8), g1 = *(const f32x4*)(A->in[I_GOUT] + l * 128 + (F.lane & 15) * 8 + 4);
    for (int t = F.gw; t < nrows; t += F.NGW) {
        const v4u a = *(const v4u*)(of + (size_t)t * 512 + 8 * F.lane), b = *(const v4u*)(ob + (size_t)t * 512 + 8 * F.lane), z = *(const v4u*)(qkvz + (size_t)t * 2048 + 1536 + 8 * F.lane);
        float o[8] = {bflo(a.x) + bflo(b.x), bfhi(a.x) + bfhi(b.x), bflo(a.y) + bflo(b.y), bfhi(a.y) + bfhi(b.y), bflo(a.z) + bflo(b.z), bfhi(a.z) + bfhi(b.z), bflo(a.w) + bflo(b.w), bfhi(a.w) + bfhi(b.w)};
        const float zz[8] = {bflo(z.x), bfhi(z.x), bflo(z.y), bfhi(z.y), bflo(z.z), bfhi(z.z), bflo(z.w), bfhi(z.w)};
        const float gg[8] = {g0.x, g0.y, g0.z, g0.w, g1.x, g1.y, g1.z, g1.w};
        float ss = 0.f;
#pragma unroll
        for (int i = 0; i < 8; ++i) ss += o[i] * o[i];
        const float rs = 1.0f / sqrtf(sum16(ss) * (1.0f / 128.0f) + EPS);
#pragma unroll
        for (int i = 0; i < 8; ++i) o[i] = o[i] * rs * gg[i] * silu_f(zz[i]);
        v4u w; w.x = pk2(o[0], o[1]); w.y = pk2(o[2], o[3]); w.z = pk2(o[4], o[5]); w.w = pk2(o[6], o[7]);
        *(v4u*)(mix + (size_t)t * D + 512 + 8 * F.lane) = w;
    }
}

__device__ __forceinline__ void router_phase(const Frame& F, int l) {
    const Args* A = kargs();
    LAS float* wr = (LAS float*)F.lds;
    LAS int* lcnt = (LAS int*)(F.lds + XT_OFF);
    LAS int* lbase = lcnt + 32;
    LAS int* sE = lbase + 32;
    LAS int* sP = sE + 136 * 4;
    LAS float* sG = (LAS float*)(sP + 136 * 4);
    const int nrows = l == NL - 1 ? NLAT : MT, rpb = nrows / 256;
    { const f32x4* src = (const f32x4*)((const float*)(F.ws + WS_WRT) + (size_t)l * NEXP * D);
      for (int i = F.tid; i < NEXP * D / 4; i += NTHR) ((LAS f32x4*)wr)[i] = src[i];
      if (F.tid < 32) lcnt[F.tid] = 0; }
    __syncthreads();
    bf16* h2 = (bf16*)(F.ws + WS_ACT);
    const int row0 = F.vcu * rpb;
    if (F.vcu < 256) {
    for (int rl = F.wave; rl < rpb; rl += NWAVES) {
        const int t = row0 + rl, r = mod_row(t);
        const float* xr = xr_row(F, t);
        f32x4 v[4]; float ss = 0.f;
#pragma unroll
        for (int j = 0; j < 4; ++j) { v[j] = *((const f32x4*)xr + F.lane + 64 * j); ss += (v[j].x * v[j].x + v[j].y * v[j].y) + (v[j].z * v[j].z + v[j].w * v[j].w); }
        const float rstd = 1.0f / sqrtf(wave_sum(ss) * (1.0f / D) + EPS);
        const f32x4* g2 = (const f32x4*)(A->in[I_GN2] + (size_t)l * D) + F.lane;
        const f32x4* sh = (const f32x4*)modv(F, l, r, 3) + F.lane; const f32x4* scl = (const f32x4*)modv(F, l, r, 4) + F.lane;
        v2u* ho = (v2u*)(h2 + (size_t)t * D) + F.lane;
#pragma unroll
        for (int j = 0; j < 4; ++j) { v[j] = v[j] * rstd * g2[64 * j] * (scl[64 * j] + 1.0f) + sh[64 * j]; v2u w; w.x = pk2(v[j].x, v[j].y); w.y = pk2(v[j].z, v[j].w); ho[64 * j] = w; }
        float lg = -3.0e38f;
#pragma unroll 2
        for (int e = 0; e < NEXP; ++e) { float p = 0.f;
#pragma unroll
            for (int j = 0; j < 4; ++j) { const f32x4 w = ((const LAS f32x4*)(wr + e * D))[F.lane + 64 * j]; p += (v[j].x * w.x + v[j].y * w.y) + (v[j].z * w.z + v[j].w * w.w); }
            p = wave_sum(p); if (F.lane == e) lg = p + A->in[I_BR][l * NEXP + e]; }
        int se[4]; float sv[4];
#pragma unroll
        for (int k = 0; k < 4; ++k) { float m = lg;
#pragma unroll
            for (int o = 1; o < 64; o <<= 1) m = fmaxf(m, __shfl_xor(m, o));
            const unsigned long long bal = __ballot(lg == m); const int idx = __ffsll((long long)bal) - 1;
            se[k] = idx; sv[k] = m; if (F.lane == idx) lg = -3.0e38f; }
        const float e1 = __expf(sv[1] - sv[0]), e2 = __expf(sv[2] - sv[0]), e3 = __expf(sv[3] - sv[0]), inv = 1.0f / (1.0f + e1 + e2 + e3);
        if (F.lane == 0) {
            const float gt[4] = {inv, e1 * inv, e2 * inv, e3 * inv};
#pragma unroll
            for (int k = 0; k < 4; ++k) { sE[rl * 4 + k] = se[k]; sP[rl * 4 + k] = __hip_atomic_fetch_add(lcnt + se[k], 1, __ATOMIC_RELAXED, __HIP_MEMORY_SCOPE_WORKGROUP); sG[rl * 4 + k] = gt[k]; } }
    }
    }
    __syncthreads();
    if (F.tid < 32) { const int n = lcnt[F.tid]; lbase[F.tid] = n ? (int)__hip_atomic_fetch_add(F.ctl + CW_GCNT + (l * 32 + F.tid) * 64, (unsigned)n, RLX_AGENT) : 0; }
    __syncthreads();
    if (F.vcu < 256) {
        int* sele = (int*)(F.ws + WS_SELE); int* selp = (int*)(F.ws + WS_SELP); float* selg = (float*)(F.ws + WS_SELG);
        for (int i = F.tid; i < rpb * 4; i += NTHR) { const int e = sE[i]; sele[(size_t)row0 * 4 + i] = e; selp[(size_t)row0 * 4 + i] = lbase[e] + sP[i]; selg[(size_t)row0 * 4 + i] = sG[i]; }
    }
}
__device__ __forceinline__ void moe_layout(const Frame& F, int l, LAS int* pend, LAS int* pstart) {
    __syncthreads();
    if (F.tid == 0) { int acc = 0;
        for (int e = 0; e < NEXP; ++e) { const int n = (int)__hip_atomic_load(F.ctl + CW_GCNT + (l * 32 + e) * 64, RLX_AGENT); pstart[e] = acc * 256; acc += (n + 255) >> 8; pend[e] = acc; } }
    __syncthreads();
}
__device__ __forceinline__ void gather_phase(const Frame& F, int l) {
    LAS int* pend = (LAS int*)(F.lds + XT_OFF); LAS int* pstart = pend + 32;
    moe_layout(F, l, pend, pstart);
    const int nrows = l == NL - 1 ? NLAT : MT;
    const int* sele = (const int*)(F.ws + WS_SELE); int* selp = (int*)(F.ws + WS_SELP);
    const bf16* h2 = (const bf16*)(F.ws + WS_ACT); bf16* xs = (bf16*)(F.ws + WS_XS);
    for (int it = F.gw; it < nrows * 4; it += F.NGW) {
        const int t = it >> 2, e = sele[it], dst = pstart[e] + selp[it];
        const v4u* src = (const v4u*)(h2 + (size_t)t * D) + F.lane; v4u* dp = (v4u*)(xs + (size_t)dst * D) + F.lane;
        const v4u a = src[0], b = src[64];
        dp[0] = a; dp[64] = b;
        if (F.lane == 0) selp[it] = dst;
    }
}

constexpr size_t WS_PW = WS_OB + 34 * MiB;
constexpr size_t WS_PKET = WS_PW + 68 * MiB;
constexpr size_t WS_PUT = WS_PKET + 68 * MiB;
constexpr size_t WS_PATT = WS_PUT + 68 * MiB;
constexpr size_t WS_PGAM = WS_PATT + 34 * MiB;
static_assert(WS_PGAM + 2 * MiB <= WS_END, "prep map");
typedef short bf16x8_t __attribute__((ext_vector_type(8)));
#define MFMA16(a, b, c) __builtin_amdgcn_mfma_f32_16x16x32_bf16((a), (b), (c), 0, 0, 0)
__device__ __forceinline__ v2u pack4(const f32x4 v) { v2u w; w.x = pk2(v.x, v.y); w.y = pk2(v.z, v.w); return w; }
__device__ __forceinline__ int chunk_rowbase(int b, int cn) { return cn < 4 ? NLAT + b * CTXL + cn * 64 : b * SEQ + (cn - 4) * 64; }

__device__ __forceinline__ void prep_phase(const Frame& F) {
    LAS bf16* k_rm = (LAS bf16*)F.lds;
    LAS bf16* q_rm = k_rm + 64 * 136;
    LAS float* Lp = (LAS float*)F.lds;
    LAS bf16* kT = (LAS bf16*)(F.lds + 34816);
    LAS bf16* vT = kT + 128 * 72;
    LAS float* Gm = (LAS float*)(F.lds + 34816 + 36864);
    LAS float* A0 = Gm + 64 * 72;
    LAS bf16* Tm = (LAS bf16*)Gm;
    LAS float* gs = (LAS float*)(F.lds + 34816 + 36864 + 36864);
    LAS float* bs = gs + 128;
    LAS float* gam = bs + 128;
    const bf16* qkvn = (const bf16*)(F.ws + WS_QKVN);
    const float* gb = (const float*)(F.ws + WS_G); const float* bb = (const float*)(F.ws + WS_BETA);
    const int w = F.wave;
    for (int unit = F.vcu; unit < 32 * 68; unit += F.G) {
        int tid_ = F.tid; asm volatile("" : "+v"(tid_));
        const int tid = tid_, lane = tid & 63, l15 = lane & 15, l4 = lane >> 4;
        const int bh = unit / 68, cn = unit % 68, b = bh >> 2, h = bh & 3, rowbase = chunk_rowbase(b, cn);
        const size_t pu = (size_t)(bh * 68 + cn) * 2;
        __syncthreads();
        for (int p = tid; p < 1024; p += NTHR) { const int i = p & 63, c8 = p >> 6; const bf16* rp = qkvn + (size_t)(rowbase + i) * 1536 + h * 128 + c8 * 8;
            const v4u qv = *(const v4u*)rp, kv = *(const v4u*)(rp + 512), vv = *(const v4u*)(rp + 1024);
            *(LAS v4u*)(q_rm + i * 136 + c8 * 8) = qv; *(LAS v4u*)(k_rm + i * 136 + c8 * 8) = kv;
#pragma unroll
            for (int e = 0; e < 4; ++e) { const unsigned kw = kv[e], vw = vv[e];
                kT[(c8 * 8 + 2 * e) * 72 + i] = (bf16)(kw & 0xffffu); kT[(c8 * 8 + 2 * e + 1) * 72 + i] = (bf16)(kw >> 16);
                vT[(c8 * 8 + 2 * e) * 72 + i] = (bf16)(vw & 0xffffu); vT[(c8 * 8 + 2 * e + 1) * 72 + i] = (bf16)(vw >> 16); } }
        if (tid < 128) { const int d = tid >> 6, i = tid & 63; gs[tid] = gb[(size_t)(rowbase + i) * 8 + d * 4 + h]; bs[tid] = bb[(size_t)(rowbase + i) * 8 + d * 4 + h]; }
        __syncthreads();
        if (tid < 128) { const int d = tid >> 6, i = tid & 63; float s = 0.f;
            if (d == 0) { for (int j = 0; j <= i; ++j) s += gs[j]; } else { for (int j = 63; j >= i; --j) s += gs[64 + j]; }
            gam[tid] = s; }
#pragma unroll
        for (int tt = 0; tt < 2; ++tt) { const int idx = 2 * w + tt, ti = idx >> 2, tj = idx & 3;
            f32x4 aG = {0.f, 0.f, 0.f, 0.f}, aA = {0.f, 0.f, 0.f, 0.f};
#pragma unroll
            for (int ks = 0; ks < 4; ++ks) { const int co = 32 * ks + 8 * l4;
                const bf16x8_t bk = *(const LAS bf16x8_t*)(k_rm + (16 * tj + l15) * 136 + co), ak = *(const LAS bf16x8_t*)(k_rm + (16 * ti + l15) * 136 + co), aq = *(const LAS bf16x8_t*)(q_rm + (16 * ti + l15) * 136 + co);
                aG = MFMA16(ak, bk, aG); aA = MFMA16(aq, bk, aA); }
#pragma unroll
            for (int r = 0; r < 4; ++r) { Gm[(16 * ti + 4 * l4 + r) * 72 + 16 * tj + l15] = aG[r]; A0[(16 * ti + 4 * l4 + r) * 72 + 16 * tj + l15] = aA[r]; } }
        __syncthreads();
        for (int idx = tid; idx < 8192; idx += NTHR) { const int d = idx >> 12, ip = (idx >> 6) & 63, jp = idx & 63, i = d ? 63 - ip : ip, j = d ? 63 - jp : jp;
            Lp[idx] = jp < ip ? bs[d * 64 + i] * Gm[i * 72 + j] * __expf(gam[d * 64 + i] - gam[d * 64 + j]) : 0.f; }
        for (int it = tid; it < 1024; it += NTHR) { const int d = it >> 9, i = (it >> 3) & 63, j0 = (it & 7) * 8; float v[8];
#pragma unroll
            for (int e = 0; e < 8; ++e) { const int j = j0 + e; const bool in = d ? (j >= i) : (j <= i); v[e] = in ? A0[i * 72 + j] * __expf(gam[d * 64 + i] - gam[d * 64 + j]) : 0.f; }
            v4u o; o.x = pk2(v[0], v[1]); o.y = pk2(v[2], v[3]); o.z = pk2(v[4], v[5]); o.w = pk2(v[6], v[7]);
            *(v4u*)((bf16*)(F.ws + WS_PATT) + (pu + d) * 4096 + i * 64 + j0) = o; }
        for (int it = tid; it < 2048; it += NTHR) { const int d = it >> 10, dk = (it >> 3) & 127, j0 = (it & 7) * 8; const float gl = d ? gam[64] : gam[63]; float v[8];
            const v4u kk = *(const LAS v4u*)(kT + dk * 72 + j0);
            v[0] = bflo(kk.x); v[1] = bfhi(kk.x); v[2] = bflo(kk.y); v[3] = bfhi(kk.y); v[4] = bflo(kk.z); v[5] = bfhi(kk.z); v[6] = bflo(kk.w); v[7] = bfhi(kk.w);
#pragma unroll
            for (int e = 0; e < 8; ++e) v[e] *= __expf(gl - gam[d * 64 + j0 + e]);
            v4u o; o.x = pk2(v[0], v[1]); o.y = pk2(v[2], v[3]); o.z = pk2(v[4], v[5]); o.w = pk2(v[6], v[7]);
            *(v4u*)((bf16*)(F.ws + WS_PKET) + (pu + d) * 8192 + dk * 64 + j0) = o; }
        if (tid < 128) ((float*)(F.ws + WS_PGAM))[(pu + (tid >> 6)) * 64 + (tid & 63)] = gam[tid];
        __syncthreads();
        if (w < 2) {
            const int d = w; const LAS float* Lr = Lp + d * 4096;
            float t[64];
#pragma unroll
            for (int ip = 0; ip < 64; ++ip) {
                float a0 = (lane == ip) ? 1.f : 0.f, a1 = 0.f;
#pragma unroll
                for (int j4 = 0; j4 < (ip + 3) / 4; ++j4) { const f32x4 Lv = *(const LAS f32x4*)(Lr + ip * 64 + 4 * j4);
                    if (4 * j4 + 0 < ip) a0 -= Lv.x * t[4 * j4 + 0];
                    if (4 * j4 + 1 < ip) a1 -= Lv.y * t[4 * j4 + 1];
                    if (4 * j4 + 2 < ip) a0 -= Lv.z * t[4 * j4 + 2];
                    if (4 * j4 + 3 < ip) a1 -= Lv.w * t[4 * j4 + 3]; }
                t[ip] = a0 + a1; asm volatile("" ::: "memory"); }
            const int jn = d ? 63 - lane : lane; const float bj = bs[d * 64 + jn], bge = bj * __expf(gam[d * 64 + jn]);
            LAS bf16* Tu = Tm + (d * 2) * 64 * 72; LAS bf16* Tw = Tu + 64 * 72;
#pragma unroll
            for (int ip = 0; ip < 64; ++ip) { const int in = d ? 63 - ip : ip; Tu[in * 72 + jn] = (bf16)f2bf(t[ip] * bj); Tw[in * 72 + jn] = (bf16)f2bf(t[ip] * bge); }
        }
        __syncthreads();
        {
            const int d = w >> 2, ww = w & 3;
            const LAS bf16* Tu = Tm + (d * 2) * 64 * 72; const LAS bf16* Tw = Tu + 64 * 72;
            bf16x8_t tu[2], tw[2];
#pragma unroll
            for (int ks = 0; ks < 2; ++ks) { tu[ks] = *(const LAS bf16x8_t*)(Tu + (16 * ww + l15) * 72 + 32 * ks + 8 * l4); tw[ks] = *(const LAS bf16x8_t*)(Tw + (16 * ww + l15) * 72 + 32 * ks + 8 * l4); }
            bf16* ut = (bf16*)(F.ws + WS_PUT) + (pu + d) * 8192; bf16* wg = (bf16*)(F.ws + WS_PW) + (pu + d) * 8192;
#pragma unroll 2
            for (int tj = 0; tj < 8; ++tj) {
                f32x4 au = {0.f, 0.f, 0.f, 0.f}, aw = {0.f, 0.f, 0.f, 0.f};
#pragma unroll
                for (int ks = 0; ks < 2; ++ks) { const bf16x8_t bv = *(const LAS bf16x8_t*)(vT + (16 * tj + l15) * 72 + 32 * ks + 8 * l4), ak = *(const LAS bf16x8_t*)(kT + (16 * tj + l15) * 72 + 32 * ks + 8 * l4);
                    au = MFMA16(tu[ks], bv, au); aw = MFMA16(ak, tw[ks], aw); }
                *(v2u*)(ut + (16 * tj + l15) * 64 + 16 * ww + 4 * l4) = pack4(au);
                *(v2u*)(wg + (16 * ww + l15) * 128 + 16 * tj + 4 * l4) = pack4(aw);
            }
        }
    }
    __syncthreads();
}

__device__ __forceinline__ void scan_mfma(const Frame& F, int l) {
    LAS bf16* ST = (LAS bf16*)F.lds;
    LAS bf16* vnT = ST + 32 * 136;
    const bf16* qkvn = (const bf16*)(F.ws + WS_QKVN);
    const int lane = F.lane, l15 = lane & 15, l4 = lane >> 4, w = F.wave;
    for (int unit = F.vcu; unit < 256; unit += F.G) {
        const int s = unit & 3, sd = unit >> 2, d = sd & 1, bh = sd >> 1, b = bh >> 2, h = bh & 3;
        bf16* od = (bf16*)(F.ws + (d ? WS_OB : WS_OF));
        __syncthreads();
        for (int i = F.tid; i < 32 * 136 / 2; i += NTHR) ((LAS unsigned*)ST)[i] = 0u;
        f32x4 S0 = {0.f, 0.f, 0.f, 0.f}, S1 = {0.f, 0.f, 0.f, 0.f};
        __syncthreads();
        const int rt = w & 3;
#pragma unroll 1
        for (int ci = 0; ci < 68; ++ci) {
            const int cn = ci < 4 ? (d ? 3 - ci : ci) : 4 + (d ? 67 - ci : ci - 4);
            const int rowbase = chunk_rowbase(b, cn);
            const size_t pu = (size_t)(bh * 68 + cn) * 2 + d;
            const float* gmp = (const float*)(F.ws + WS_PGAM) + pu * 64;
            const float gend = __expf(gmp[d ? 0 : 63]);
            bf16x8_t fa[4], fb[2]; v2u uv0 = {0u, 0u}, uv1 = {0u, 0u}; float eg = 1.f;
            const bf16* ket = (const bf16*)(F.ws + WS_PKET) + pu * 8192 + (16 * w + l15) * 64 + 8 * l4;
            const bf16x8_t kf0 = *(const bf16x8_t*)ket, kf1 = *(const bf16x8_t*)(ket + 32);
            if (w < 4) {
                const bf16* wp = (const bf16*)(F.ws + WS_PW) + pu * 8192 + (16 * rt + l15) * 128 + 8 * l4;
#pragma unroll
                for (int ks = 0; ks < 4; ++ks) fa[ks] = *(const bf16x8_t*)(wp + 32 * ks);
                const bf16* up = (const bf16*)(F.ws + WS_PUT) + pu * 8192 + (32 * s + l15) * 64 + 16 * rt + 4 * l4;
                uv0 = *(const v2u*)up; uv1 = *(const v2u*)(up + 16 * 64);
                fb[0] = fa[0]; fb[1] = fa[0];
            } else {
                const bf16* qp = qkvn + (size_t)(rowbase + 16 * rt + l15) * 1536 + h * 128 + 8 * l4;
                eg = __expf(gmp[16 * rt + l15]);
#pragma unroll
                for (int ks = 0; ks < 4; ++ks) { const v4u qv = *(const v4u*)(qp + 32 * ks); v4u o;
                    o.x = pk2(bflo(qv.x) * eg, bfhi(qv.x) * eg); o.y = pk2(bflo(qv.y) * eg, bfhi(qv.y) * eg); o.z = pk2(bflo(qv.z) * eg, bfhi(qv.z) * eg); o.w = pk2(bflo(qv.w) * eg, bfhi(qv.w) * eg);
                    fa[ks] = __builtin_bit_cast(bf16x8_t, o); }
                const bf16* ap = (const bf16*)(F.ws + WS_PATT) + pu * 4096 + (16 * rt + l15) * 64 + 8 * l4;
                fb[0] = *(const bf16x8_t*)ap; fb[1] = *(const bf16x8_t*)(ap + 32);
            }
            f32x4 c0 = {0.f, 0.f, 0.f, 0.f}, c1 = {0.f, 0.f, 0.f, 0.f};
#pragma unroll
            for (int ks = 0; ks < 4; ++ks) { const bf16x8_t b0 = *(const LAS bf16x8_t*)(ST + l15 * 136 + 32 * ks + 8 * l4), b1 = *(const LAS bf16x8_t*)(ST + (16 + l15) * 136 + 32 * ks + 8 * l4);
                c0 = MFMA16(fa[ks], b0, c0); c1 = MFMA16(fa[ks], b1, c1); }
            if (w < 4) {
                const f32x4 u0 = {bflo(uv0.x), bfhi(uv0.x), bflo(uv0.y), bfhi(uv0.y)}, u1 = {bflo(uv1.x), bfhi(uv1.x), bflo(uv1.y), bfhi(uv1.y)};
                *(LAS v2u*)(vnT + l15 * 72 + 16 * rt + 4 * l4) = pack4(u0 - c0);
                *(LAS v2u*)(vnT + (16 + l15) * 72 + 16 * rt + 4 * l4) = pack4(u1 - c1);
            }
            __syncthreads();
            const bf16x8_t v00 = *(const LAS bf16x8_t*)(vnT + l15 * 72 + 8 * l4), v01 = *(const LAS bf16x8_t*)(vnT + l15 * 72 + 32 + 8 * l4);
            const bf16x8_t v10 = *(const LAS bf16x8_t*)(vnT + (16 + l15) * 72 + 8 * l4), v11 = *(const LAS bf16x8_t*)(vnT + (16 + l15) * 72 + 32 + 8 * l4);
            if (w >= 4) {
                c0 = MFMA16(fb[0], v00, c0); c0 = MFMA16(fb[1], v01, c0); c1 = MFMA16(fb[0], v10, c1); c1 = MFMA16(fb[1], v11, c1);
                if (!(cn < 4 && l == NL - 1)) {
                    bf16* op = od + (size_t)(rowbase + 16 * rt + 4 * l4) * 512 + h * 128 + 32 * s + l15;
#pragma unroll
                    for (int r = 0; r < 4; ++r) { op[(size_t)r * 512] = (bf16)f2bf(c0[r]); op[(size_t)r * 512 + 16] = (bf16)f2bf(c1[r]); }
                }
            }
            S0 = S0 * gend; S1 = S1 * gend;
            S0 = MFMA16(kf0, v00, S0); S0 = MFMA16(kf1, v01, S0); S1 = MFMA16(kf0, v10, S1); S1 = MFMA16(kf1, v11, S1);
            *(LAS v2u*)(ST + l15 * 136 + 16 * w + 4 * l4) = pack4(S0);
            *(LAS v2u*)(ST + (16 + l15) * 136 + 16 * w + 4 * l4) = pack4(S1);
            __syncthreads();
        }
    }
}

#ifndef USE_NAIVE_SCAN
#define USE_NAIVE_SCAN 0
#endif
#ifndef REP_MASK
#define REP_MASK 0
#endif
#define REPS(p) for (int _r = 0; _r < 1 + ((REP_MASK >> (p)) & 1); ++_r)
#ifndef PHMASK
#define PHMASK 0xffff
#endif
constexpr int PH_PER_LAYER = 11, N_PHASES = 2 + NL * PH_PER_LAYER;
#ifndef PG8_SP2
#define PG8_SP2 true
#endif
#ifndef PG8_ALIGN
#define PG8_ALIGN true
#endif
__device__ __forceinline__ Frame make_frame() {
    extern __shared__ __attribute__((aligned(16))) unsigned char lds[];
    const Args* A = kargs();
    Frame F;
    { unsigned lb = (unsigned)(uintptr_t)(LAS unsigned char*)lds; asm volatile("" : "+s"(lb)); F.lds = (LAS unsigned char*)(uintptr_t)lb; }
    F.MISC = (volatile LAS unsigned*)(F.lds + MISC_OFF);
    { int t_ = threadIdx.x; asm volatile("" : "+v"(t_)); F.tid = t_; } F.lane = F.tid & 63; F.wave = __builtin_amdgcn_readfirstlane(F.tid >> 6);
    F.G = gridDim.x; { const int bx = blockIdx.x; F.vcu = (F.G % 8 == 0) ? (bx % 8) * (F.G / 8) + bx / 8 : bx; }
    F.gw = F.vcu * NWAVES + F.wave; F.NGW = F.G * NWAVES;
    F.ws = A->ws; F.ctl = (unsigned*)(A->ws + WS_CTL); F.out = A->out;
    return F;
}

__global__ void __launch_bounds__(NTHR, 2) mk_fwd(Args args) {
    { Frame F = make_frame();
    for (int u = F.tid; u < (LDS_BYTES - LDSCTL_OFF) / 4; u += NTHR) ((LAS unsigned*)(F.lds + LDSCTL_OFF))[u] = 0u;
    __syncthreads(); }
    const int lo = args.ph_lo, hi = args.ph_hi;
    if (hi - lo > 1) { Frame F = make_frame(); (void)xcd_barrier_post((unsigned*)(F.ctl + CW_BAR), F.MISC + 8); }
#define IN(k) (lo <= (k) && (k) < hi)
#define SEAM(k) do { if (IN(k) && IN((k) + 1)) { Frame Fb = make_frame(); XcdBarrier bar; bar.bar = (unsigned*)(Fb.ctl + CW_BAR); bar.x = xb_xcc_id(); bar.st = Fb.MISC + 8; xcd_barrier(bar); } } while (0)

    if (IN(0)) { Frame F = make_frame();
#if (PHMASK >> 0) & 1
            REPS(0) { p0_prologue(F); __syncthreads(); }
#endif
 } SEAM(0);
    if (IN(1)) { Frame F = make_frame();
#if (PHMASK >> 1) & 1
            row_pass<0>(F, 0, 0);
#endif
 } SEAM(1);
#pragma unroll 1
    for (int l = 0; l < NL; ++l) {
        const int pb = 2 + l * PH_PER_LAYER;
        if (IN(pb + 0)) { Frame F = make_frame();
            SchedIn S{(const bf16*)(F.ws + WS_ACT), (const bf16*)(F.ws + WS_WIN) + (size_t)l * 3072 * D, F.G, (int)blockIdx.x};
            EpiIn E{(bf16*)(F.ws + WS_QKVZ), (bf16*)(F.ws + WS_ZTL), (bf16*)(F.ws + WS_ZTC)};

#if (PHMASK >> 8) & 1
            REPS(8) { pg8::gemm_phase<EpiIn, SchedIn, PG8_ALIGN, PG8_SP2>(F.lds, pg8::Gemm{D}, S, E); __syncthreads(); }
#endif

        }
        SEAM(pb + 0);
        if (IN(pb + 1)) { Frame F = make_frame();
#if (PHMASK >> 2) & 1
            REPS(2) { conv_phase(F, l); __syncthreads(); }
#endif
 } SEAM(pb + 1);
        if (IN(pb + 2)) { Frame F = make_frame();
            SchedDft S{(const bf16*)(F.ws + WS_DFTM), (const bf16*)(F.ws + WS_ZTL), F.G, (int)blockIdx.x};
            EpiDft E{(bf16*)(F.ws + WS_ACT), 1.0f / sqrtf(4096.0f * 128.0f)};

#if (PHMASK >> 9) & 1
            REPS(9) { pg8::gemm_phase<EpiDft, SchedDft, PG8_ALIGN, PG8_SP2>(F.lds, pg8::Gemm{8192}, S, E); __syncthreads(); }
#endif


#if (PHMASK >> 3) & 1
            if (l == 0) { Frame F3 = make_frame(); ctx_dft(F3); }
#if !USE_NAIVE_SCAN
            { Frame F2 = make_frame(); prep_phase(F2); }
#endif

#endif

        }
        SEAM(pb + 2);
        if (IN(pb + 3)) { Frame F = make_frame();
#if (PHMASK >> 4) & 1

#if USE_NAIVE_SCAN
            REPS(4) { scan_naive(F, l); __syncthreads(); }
#else
            REPS(4) { scan_mfma(F, l); __syncthreads(); }
#endif

#endif
 } SEAM(pb + 3);
        if (IN(pb + 4)) { Frame F = make_frame();
#if (PHMASK >> 5) & 1
            REPS(5) { gated_out(F, l); __syncthreads(); }
#endif
 } SEAM(pb + 4);
        if (IN(pb + 5)) { Frame F = make_frame();
            SchedOut S{(const bf16*)(F.ws + WS_ACT), (const bf16*)(F.ws + WS_WOUT) + (size_t)l * D * D, l == NL - 1 ? NLAT / 256 : MT / 256, F.G, (int)blockIdx.x};
            EpiOut E{F.out, (float*)(F.ws + WS_XC), modv(F, l, 0, 2)};

#if (PHMASK >> 10) & 1
            pg8::gemm_phase<EpiOut, SchedOut, PG8_ALIGN, PG8_SP2>(F.lds, pg8::Gemm{D}, S, E);
#endif

        }
        SEAM(pb + 5);
        if (IN(pb + 6)) { Frame F = make_frame();
#if (PHMASK >> 6) & 1
            router_phase(F, l);
#endif
 } SEAM(pb + 6);
        if (IN(pb + 7)) { Frame F = make_frame();
#if (PHMASK >> 7) & 1
            gather_phase(F, l);
#endif
 } SEAM(pb + 7);
        if (IN(pb + 8)) { Frame F = make_frame();
            LAS int* pend = (LAS int*)(F.lds + XT_OFF); moe_layout(F, l, pend, pend + 32);
            SchedMoe S{(const bf16*)(F.ws + WS_XS), (const bf16*)(F.ws + WS_W1), (size_t)2048 * D * 2, pend, pend[NEXP - 1], 8, F.G, (int)blockIdx.x};
            EpiSwiglu E{(bf16*)(F.ws + WS_HS), kargs()->in[I_BG] + (size_t)l * NEXP * D, kargs()->in[I_BU] + (size_t)l * NEXP * D};

#if (PHMASK >> 11) & 1
            REPS(11) { pg8::gemm_phase<EpiSwiglu, SchedMoe, PG8_ALIGN, PG8_SP2>(F.lds, pg8::Gemm{D}, S, E); __syncthreads(); }
#endif

        }
        SEAM(pb + 8);
        if (IN(pb + 9)) { Frame F = make_frame();
            LAS int* pend = (LAS int*)(F.lds + XT_OFF); moe_layout(F, l, pend, pend + 32);
            SchedMoe S{(const bf16*)(F.ws + WS_HS), (const bf16*)(F.ws + WS_W2), (size_t)D * D * 2, pend, pend[NEXP - 1], 4, F.G, (int)blockIdx.x};
            EpiDown E{(bf16*)(F.ws + WS_XS), kargs()->in[I_BD] + (size_t)l * NEXP * D};

#if (PHMASK >> 12) & 1
            REPS(12) { pg8::gemm_phase<EpiDown, SchedMoe, PG8_ALIGN, PG8_SP2>(F.lds, pg8::Gemm{D}, S, E); __syncthreads(); }
#endif

        }
        SEAM(pb + 9);
        if (IN(pb + 10)) { Frame F = make_frame();

#if (PHMASK >> 13) & 1
            if (l == NL - 1) row_pass<2>(F, l, l);
            else { row_pass<1>(F, l, l + 1); __syncthreads(); convert_experts(F, l + 1); }
#endif

        }
        if (l + 1 < NL) SEAM(pb + 10);
    }
#undef IN
#undef SEAM
}

extern "C" void kernel_launch(void* const* d_in, const int* in_sizes, int n_in, void* d_out, int out_size, void* d_ws, size_t ws_size, hipStream_t stream) {
    static int grid = 0;
    if (grid == 0) {
        if (n_in != 23 || out_size != NLAT * D || ws_size < WS_END) { fprintf(stderr, "kernel_launch: unexpected shapes (n_in %d, out %d, ws %zu); nothing launched\n", n_in, out_size, ws_size); grid = -1; return; }
        int dev = 0, cus = 0, per_cu = 0;
        if (hipGetDevice(&dev) != hipSuccess || hipDeviceGetAttribute(&cus, hipDeviceAttributeMultiprocessorCount, dev) != hipSuccess) { grid = -1; return; }
        if (hipFuncSetAttribute((const void*)mk_fwd, hipFuncAttributeMaxDynamicSharedMemorySize, LDS_BYTES) != hipSuccess) { fprintf(stderr, "kernel_launch: hipFuncSetAttribute failed\n"); grid = -1; return; }
        if (hipOccupancyMaxActiveBlocksPerMultiprocessor(&per_cu, (const void*)mk_fwd, NTHR, LDS_BYTES) != hipSuccess || per_cu < 1)
            fprintf(stderr, "kernel_launch: note: occupancy query reports %d workgroups per CU\n", per_cu);
        (void)hipGetLastError();
        grid = cus;
        if (grid != 256) { fprintf(stderr, "kernel_launch: built for 256 CUs, found %d; nothing launched\n", grid); grid = -1; return; }
    }
    if (grid < 0) return;
    if (hipMemsetAsync((char*)d_ws + WS_CTL, 0, CTL_ZERO_BYTES, stream) != hipSuccess) { fprintf(stderr, "kernel_launch: hipMemsetAsync failed\n"); return; }
    Args a{};
    for (int i = 0; i < 23; ++i) a.in[i] = (const float*)d_in[i];
    a.out = (float*)d_out; a.ws = (unsigned char*)d_ws;
#if MK_ONE_LAUNCH
    a.ph_lo = 0; a.ph_hi = N_PHASES;
    hipLaunchKernelGGL(mk_fwd, dim3(grid), dim3(NTHR), LDS_BYTES, stream, a);
#else
    for (int p = 0; p < N_PHASES; ++p) { a.ph_lo = p; a.ph_hi = p + 1; hipLaunchKernelGGL(mk_fwd, dim3(grid), dim3(NTHR), LDS_BYTES, stream, a); }
#endif
    const hipError_t le = hipPeekAtLastError();
    if (le != hipSuccess) fprintf(stderr, "kernel_launch: launch failed: %s\n", hipGetErrorName(le));
}
```

```cpp
#define MK_ONE_LAUNCH 1
#include <hip/hip_runtime.h>
#include <cstdio>
#include <cstdint>

#ifndef MK_ONE_LAUNCH
#define MK_ONE_LAUNCH 1
#endif

namespace pg8 {
#define PG8_LAS __attribute__((address_space(3)))
typedef unsigned short bf16_t;
typedef short bf16x8 __attribute__((ext_vector_type(8)));
typedef float f32x4 __attribute__((ext_vector_type(4)));
typedef unsigned u32x4 __attribute__((ext_vector_type(4)));
constexpr int BM = 256, BK = 64, HALF = 128, HTB = HALF * BK * 2  , STAGE_BYTES = 8 * HTB, NXCD = 8, WGM = 8;

__host__ __device__ __forceinline__ int lds_byte(int r, int c) { const int st = (r >> 4) * 2 + (c >> 5), rr = r & 15, cc = c & 31, ob = rr * 64 + cc * 2; return st * 1024 + (ob ^ (((ob >> 9) & 1) << 5)); }
__host__ __device__ __forceinline__ void stage_rc(int b, int& R, int& C) { const int st = b / 1024, sb = b % 1024, swz = sb ^ (((sb >> 9) & 1) << 5); R = (st >> 1) * 16 + swz / 64; C = (st & 1) * 32 + (swz % 64) / 2; }
__host__ __device__ __forceinline__ int perm32(int rho) { const int n = rho >> 4, i = rho & 15; return 8 * (i >> 2) + 4 * n + (i & 3); }

struct Unit { int pm, pn, kind, e; };
struct Gemm { int K; };

__device__ __forceinline__ int xcd_remap(int L, int nwg) { const int q = nwg / NXCD, r = nwg % NXCD, xcd = L % NXCD, off = L / NXCD; return (xcd < r ? xcd * (q + 1) : r * (q + 1) + (xcd - r) * q) + off; }
__device__ __forceinline__ void grp_decode(int wgid, int nM, int nN, int& pm, int& pn) { const int nig = WGM * nN, gid = wgid / nig, fm = gid * WGM, gsz = (nM - fm) < WGM ? (nM - fm) : WGM; pm = fm + ((wgid % nig) % gsz); pn = (wgid % nig) / gsz; }

__device__ __forceinline__ const char* uni_ptr(const char* p) { const unsigned long long v = (unsigned long long)p; const unsigned lo = __builtin_amdgcn_readfirstlane((unsigned)v), hi = __builtin_amdgcn_readfirstlane((unsigned)(v >> 32)); return (const char*)(((unsigned long long)hi << 32) | lo); }
__device__ __forceinline__ unsigned cvt_pk_bf16(float lo, float hi) { unsigned r; asm volatile("v_cvt_pk_bf16_f32 %0, %1, %2" : "=v"(r) : "v"(lo), "v"(hi)); return r; }

template <class Epi, class Sched, bool ALIGN_EPI = false, bool SP2 = false>
__device__ __forceinline__ void gemm_phase(PG8_LAS unsigned char* lds, const Gemm g, const Sched& S, const Epi& E, int tid_in) {
    int tid_ = tid_in; asm volatile("" : "+v"(tid_));
    const int tid = tid_, wid = __builtin_amdgcn_readfirstlane(tid >> 6), lane = tid & 63, wr = wid >> 2, wc = wid & 3, fr = lane & 15, fq = lane >> 4;
    const int K = g.K, nt = K / BK;
    unsigned voffA[2], voffB[2];
#pragma unroll
    for (int i = 0; i < 2; ++i) { int R, C; stage_rc(tid * 16 + i * 8192, R, C); const int Rb = Epi::PERM ? ((R & ~31) + perm32(R & 31)) : R;
        voffA[i] = (unsigned)(R * K + C) * 2u; voffB[i] = (unsigned)(Rb * K + C) * 2u; }
    const size_t kstep = (size_t)(BK * 2);
    const size_t hstep = (size_t)HALF * K * 2;
    const size_t tstep = 2 * hstep;
    const unsigned ldsw = (unsigned)wid * 1024u;
    const int aoff = lds_byte(wr * 64 + fr, fq * 8), boff = lds_byte(wc * 32 + fr, fq * 8);
#define PG8_SA(b, h) (((b) * 2 + (h)) * HTB)
#define PG8_SB(b, h) ((4 + (b) * 2 + (h)) * HTB)
#define PG8_STAGE(bufoff, gbase, voff) do { _Pragma("unroll") for (int _i = 0; _i < 2; ++_i) \
        __builtin_amdgcn_global_load_lds((const unsigned*)((const char*)(gbase) + (voff)[_i]), (PG8_LAS unsigned*)(lds + (bufoff) + ldsw + _i * 8192), 16, 0, 0); } while (0)
#define PG8_LDA(dst, b, h) do { _Pragma("unroll") for (int m = 0; m < 4; ++m) _Pragma("unroll") for (int k = 0; k < 2; ++k) dst[m][k] = *(const PG8_LAS bf16x8*)(lds + PG8_SA(b, h) + aoff + m * 2048 + k * 1024); } while (0)
#define PG8_LDB(dst, b, h) do { _Pragma("unroll") for (int n = 0; n < 2; ++n) _Pragma("unroll") for (int k = 0; k < 2; ++k) dst[n][k] = *(const PG8_LAS bf16x8*)(lds + PG8_SB(b, h) + boff + n * 2048 + k * 1024); } while (0)
#define PG8_MMA(ai, bj, At, Bt) do { __builtin_amdgcn_s_setprio(1); _Pragma("unroll") for (int m = 0; m < 4; ++m) _Pragma("unroll") for (int n = 0; n < 2; ++n) _Pragma("unroll") for (int k = 0; k < 2; ++k) \
        acc[ai][bj][m][n] = __builtin_amdgcn_mfma_f32_16x16x32_bf16(Bt[n][k], At[m][k], acc[ai][bj][m][n], 0, 0, 0); __builtin_amdgcn_s_setprio(0); } while (0)
#define PG8_WAIT_V(n) asm volatile("s_waitcnt vmcnt(" #n ")" ::: "memory")
#define PG8_WAIT_L(n) asm volatile("s_waitcnt lgkmcnt(" #n ")" ::: "memory")
#define PG8_BAR __builtin_amdgcn_s_barrier()
#define PG8_SCHED __builtin_amdgcn_sched_barrier(0)
    Unit cur, nxt; int ui = 0;
    if (!S.next(0, cur)) return;
    f32x4 acc[2][2][4][2];
#pragma unroll
    for (int a = 0; a < 2; ++a)
#pragma unroll
        for (int b = 0; b < 2; ++b)
#pragma unroll
            for (int m = 0; m < 4; ++m)
#pragma unroll
                for (int n = 0; n < 2; ++n) acc[a][b][m][n] = (f32x4){0.f, 0.f, 0.f, 0.f};
    bf16x8 At[4][2], B0[2][2], B1[2][2];
    const char* cA = uni_ptr(S.a_base(cur, tstep)); const char* cB = uni_ptr(S.b_base(cur, tstep));
    S.a_ready(cur);
    if constexpr (SP2) {
        PG8_STAGE(PG8_SB(0, 0), cB, voffB); PG8_STAGE(PG8_SB(0, 1), cB + hstep, voffB); PG8_STAGE(PG8_SA(0, 0), cA, voffA); PG8_STAGE(PG8_SA(0, 1), cA + hstep, voffA);
        if (wr == 1) PG8_BAR;
        PG8_WAIT_V(2); PG8_BAR;
        PG8_STAGE(PG8_SB(1, 0), cB + kstep, voffB); PG8_STAGE(PG8_SA(1, 0), cA + kstep, voffA); PG8_STAGE(PG8_SB(1, 1), cB + hstep + kstep, voffB);
        PG8_WAIT_V(6); PG8_BAR;
    } else {
        PG8_STAGE(PG8_SB(0, 0), cB, voffB); PG8_STAGE(PG8_SA(0, 0), cA, voffA); PG8_STAGE(PG8_SB(0, 1), cB + hstep, voffB); PG8_STAGE(PG8_SA(0, 1), cA + hstep, voffA);
        if (wr == 1) PG8_BAR;
        PG8_WAIT_V(4); PG8_BAR;
        PG8_STAGE(PG8_SB(1, 0), cB + kstep, voffB); PG8_STAGE(PG8_SA(1, 0), cA + kstep, voffA); PG8_STAGE(PG8_SB(1, 1), cB + hstep + kstep, voffB);
        PG8_WAIT_V(6); PG8_BAR;
    }
    for (;;) {
        const bool has_next = S.next(ui + 1, nxt);
        const char* nA = uni_ptr(has_next ? S.a_base(nxt, tstep) : cA); const char* nB = uni_ptr(has_next ? S.b_base(nxt, tstep) : cB);
        for (int t = 0; t < nt; t += 2) {
            const bool last = (t == nt - 2);
            const char* a1 = cA + (size_t)(t + 1) * kstep;
            const char* a2 = last ? nA : cA + (size_t)(t + 2) * kstep; const char* b2 = last ? nB : cB + (size_t)(t + 2) * kstep;
            const char* a3 = a2 + kstep; const char* b3 = b2 + kstep;
            if (last && has_next) S.a_ready(nxt);
            if constexpr (SP2) {
            PG8_LDB(B0, 0, 0); PG8_LDB(B1, 0, 1); PG8_SCHED; PG8_LDA(At, 0, 0); PG8_STAGE(PG8_SA(1, 1), a1 + hstep, voffA);
            PG8_WAIT_V(8); PG8_WAIT_L(0); PG8_BAR; PG8_MMA(0, 0, At, B0); PG8_MMA(0, 1, At, B1); PG8_BAR; PG8_SCHED;
            PG8_LDA(At, 0, 1); PG8_STAGE(PG8_SB(0, 0), b2, voffB); PG8_STAGE(PG8_SB(0, 1), b2 + hstep, voffB); PG8_STAGE(PG8_SA(0, 0), a2, voffA);
            PG8_WAIT_V(8); PG8_WAIT_L(0); PG8_BAR; PG8_MMA(1, 0, At, B0); PG8_MMA(1, 1, At, B1); PG8_BAR; PG8_SCHED;
            PG8_LDB(B0, 1, 0); PG8_LDB(B1, 1, 1); PG8_SCHED; PG8_LDA(At, 1, 0); PG8_STAGE(PG8_SA(0, 1), a2 + hstep, voffA);
            PG8_WAIT_V(8); PG8_WAIT_L(0); PG8_BAR; PG8_MMA(0, 0, At, B0); PG8_MMA(0, 1, At, B1); PG8_BAR; PG8_SCHED;
            PG8_LDA(At, 1, 1); PG8_STAGE(PG8_SB(1, 0), b3, voffB); PG8_STAGE(PG8_SB(1, 1), b3 + hstep, voffB); PG8_STAGE(PG8_SA(1, 0), a3, voffA);
            PG8_WAIT_V(8); PG8_WAIT_L(0); PG8_BAR; PG8_MMA(1, 0, At, B0); PG8_MMA(1, 1, At, B1); PG8_BAR; PG8_SCHED;
            } else {
            PG8_LDB(B0, 0, 0); PG8_SCHED; PG8_LDA(At, 0, 0); PG8_STAGE(PG8_SA(1, 1), a1 + hstep, voffA);
            PG8_WAIT_L(8); PG8_BAR; PG8_WAIT_L(0); PG8_MMA(0, 0, At, B0); PG8_BAR; PG8_SCHED;
            PG8_LDB(B1, 0, 1); PG8_STAGE(PG8_SB(0, 0), b2, voffB);
            PG8_BAR; PG8_WAIT_L(0); PG8_MMA(0, 1, At, B1); PG8_BAR;
            PG8_LDA(At, 0, 1); PG8_STAGE(PG8_SA(0, 0), a2, voffA);
            PG8_BAR; PG8_WAIT_L(0); PG8_MMA(1, 0, At, B0); PG8_BAR; PG8_SCHED;
            PG8_STAGE(PG8_SB(0, 1), b2 + hstep, voffB);
            PG8_WAIT_V(6); PG8_BAR; PG8_MMA(1, 1, At, B1); PG8_BAR;
            PG8_LDB(B0, 1, 0); PG8_SCHED; PG8_LDA(At, 1, 0); PG8_STAGE(PG8_SA(0, 1), a2 + hstep, voffA);
            PG8_WAIT_L(8); PG8_BAR; PG8_WAIT_L(0); PG8_MMA(0, 0, At, B0); PG8_BAR; PG8_SCHED;
            PG8_LDB(B1, 1, 1); PG8_STAGE(PG8_SB(1, 0), b3, voffB);
            PG8_BAR; PG8_WAIT_L(0); PG8_MMA(0, 1, At, B1); PG8_BAR;
            PG8_LDA(At, 1, 1); PG8_STAGE(PG8_SA(1, 0), a3, voffA);
            PG8_BAR; PG8_WAIT_L(0); PG8_MMA(1, 0, At, B0); PG8_BAR; PG8_SCHED;
            PG8_STAGE(PG8_SB(1, 1), b3 + hstep, voffB);
            PG8_WAIT_V(6); PG8_BAR; PG8_MMA(1, 1, At, B1); PG8_BAR;
            }
        }
        if constexpr (ALIGN_EPI) { if (wr == 0) PG8_BAR; }
        if constexpr (!Epi::AFTER_DRAIN) { E(acc, cur, wr, wc, fr, fq); S.done(cur); }
        if (!has_next) break;
#pragma unroll
        for (int a = 0; a < 2; ++a)
#pragma unroll
            for (int b = 0; b < 2; ++b)
#pragma unroll
                for (int m = 0; m < 4; ++m)
#pragma unroll
                    for (int n = 0; n < 2; ++n) acc[a][b][m][n] = (f32x4){0.f, 0.f, 0.f, 0.f};
        cur = nxt; cA = nA; cB = nB; ++ui;
        if constexpr (ALIGN_EPI) { if (wr == 1) PG8_BAR; }
    }
    PG8_WAIT_V(0);
    if constexpr (!ALIGN_EPI) { if (wr == 0) PG8_BAR; }
    PG8_BAR;
    if constexpr (Epi::AFTER_DRAIN) { E.fused(acc, cur, wr, wc, fr, fq, lds, wid, lane); S.done(cur); }
#undef PG8_SA
#undef PG8_SB
#undef PG8_STAGE
#undef PG8_LDA
#undef PG8_LDB
#undef PG8_MMA
#undef PG8_WAIT_V
#undef PG8_WAIT_L
#undef PG8_BAR
#undef PG8_SCHED
}
}

constexpr int NWAVES = 8, NTHR = 512;
constexpr int D = 1024, NB = 8, SEQ = 4096, CTXL = 256, NL = 2;
constexpr int NLAT = NB * SEQ;
constexpr int NCTX = NB * CTXL;
constexpr int MT = NLAT + NCTX;
constexpr int INW = 2576, NEXP = 32, TOPK = 4;
constexpr int PMAX = (MT * TOPK / 256 + NEXP) * 256;
constexpr float EPS = 1e-6f;

constexpr size_t MiB = 1u << 20;
constexpr size_t WS_CTL = 0, CTL_ZERO_BYTES = 1 * MiB;
constexpr size_t WS_MODV = 1 * MiB;
constexpr size_t WS_WRT = 2 * MiB;
constexpr size_t WS_WABT = WS_WRT + 512 * 1024;
constexpr size_t WS_SELE = 3 * MiB;
constexpr size_t WS_SELP = WS_SELE + 640 * 1024;
constexpr size_t WS_SELG = WS_SELP + 640 * 1024;
constexpr size_t WS_G = 5 * MiB;
constexpr size_t WS_BETA = WS_G + 1536 * 1024;
constexpr size_t WS_AB = 8 * MiB;
constexpr size_t WS_WIN = 12 * MiB;
constexpr size_t WS_WOUT = 24 * MiB;
constexpr size_t WS_DFTM = 32 * MiB;
constexpr size_t WS_W1 = 96 * MiB;
constexpr size_t WS_W2 = 224 * MiB;
constexpr size_t WS_XC = 288 * MiB;
constexpr size_t WS_ACT = 296 * MiB;
constexpr size_t WS_S = 364 * MiB;
constexpr size_t WS_QKVZ = WS_S;
constexpr size_t WS_ZTL = WS_S + 136 * MiB;
constexpr size_t WS_ZTC = WS_ZTL + 64 * MiB;
constexpr size_t WS_QKVN = WS_ZTC + 4 * MiB;
constexpr size_t WS_OF = WS_QKVN + 102 * MiB;
constexpr size_t WS_OB = WS_OF + 34 * MiB;
constexpr size_t WS_XS = WS_S;
constexpr size_t WS_HS = WS_S + 288 * MiB;
constexpr size_t WS_END = 1024 * MiB;
static_assert(WS_OB + 34 * MiB <= WS_END && WS_HS + 288 * MiB <= WS_END && (size_t)PMAX * 1024 * 2 == 288 * MiB, "d_ws map");
static_assert((size_t)MT * 16 <= 640 * 1024 && (size_t)MT * 32 <= 1536 * 1024, "sel / g maps");
constexpr int CW_BAR = 4096;
constexpr int CW_GCNT = 16384;

constexpr int RING_BYTES = 131072;
constexpr int LDSCTL_OFF = RING_BYTES, MISC_OFF = LDSCTL_OFF + 320;
constexpr int XT_OFF = RING_BYTES + 1024;
constexpr int LDS_BYTES = 147456;

#define GAS __attribute__((address_space(1)))
#define LAS __attribute__((address_space(3)))
typedef unsigned short bf16;
typedef unsigned v4u __attribute__((ext_vector_type(4)));
typedef unsigned v2u __attribute__((ext_vector_type(2)));
typedef float f32x4 __attribute__((ext_vector_type(4)));
typedef GAS unsigned gu32;
#define RLX_AGENT __ATOMIC_RELAXED, __HIP_MEMORY_SCOPE_AGENT
#define LDS_WAIT() asm volatile("s_waitcnt lgkmcnt(0)" ::: "memory")
#define VM_WAIT() asm volatile("s_waitcnt vmcnt(0)" ::: "memory")
__device__ __forceinline__ unsigned f2bf(float f) { unsigned u = __builtin_bit_cast(unsigned, f); return (u + 0x7fffu + ((u >> 16) & 1u)) >> 16; }
__device__ __forceinline__ unsigned pk2(float lo, float hi) { return f2bf(lo) | (f2bf(hi) << 16); }
__device__ __forceinline__ float bflo(unsigned w) { return __builtin_bit_cast(float, w << 16); }
__device__ __forceinline__ float bfhi(unsigned w) { return __builtin_bit_cast(float, w & 0xffff0000u); }
__device__ __forceinline__ float wave_sum(float v) {
#pragma unroll
    for (int o = 1; o < 64; o <<= 1) v += __shfl_xor(v, o);
    return v;
}
__device__ __forceinline__ float sum16(float v) {
#pragma unroll
    for (int o = 1; o < 16; o <<= 1) v += __shfl_xor(v, o);
    return v;
}
__device__ __forceinline__ float rs32(float (&p)[32], int lane) {
#pragma unroll
    for (int e = 0; e < 16; ++e) { const bool up = (lane & 32) != 0; const float send = up ? p[e] : p[e + 16], keep = up ? p[e + 16] : p[e]; p[e] = keep + __shfl_xor(send, 32); }
#pragma unroll
    for (int e = 0; e < 8; ++e) { const bool up = (lane & 16) != 0; const float send = up ? p[e] : p[e + 8], keep = up ? p[e + 8] : p[e]; p[e] = keep + __shfl_xor(send, 16); }
#pragma unroll
    for (int e = 0; e < 4; ++e) { const bool up = (lane & 8) != 0; const float send = up ? p[e] : p[e + 4], keep = up ? p[e + 4] : p[e]; p[e] = keep + __shfl_xor(send, 8); }
#pragma unroll
    for (int e = 0; e < 2; ++e) { const bool up = (lane & 4) != 0; const float send = up ? p[e] : p[e + 2], keep = up ? p[e + 2] : p[e]; p[e] = keep + __shfl_xor(send, 4); }
    { const bool up = (lane & 2) != 0; const float send = up ? p[0] : p[1], keep = up ? p[1] : p[0]; p[0] = keep + __shfl_xor(send, 2); }
    return p[0] + __shfl_xor(p[0], 1);
}
__device__ __forceinline__ float rs16(float (&p)[16], int lane) {
#pragma unroll
    for (int e = 0; e < 8; ++e) { const bool up = (lane & 32) != 0; const float send = up ? p[e] : p[e + 8], keep = up ? p[e + 8] : p[e]; p[e] = keep + __shfl_xor(send, 32); }
#pragma unroll
    for (int e = 0; e < 4; ++e) { const bool up = (lane & 16) != 0; const float send = up ? p[e] : p[e + 4], keep = up ? p[e + 4] : p[e]; p[e] = keep + __shfl_xor(send, 16); }
#pragma unroll
    for (int e = 0; e < 2; ++e) { const bool up = (lane & 8) != 0; const float send = up ? p[e] : p[e + 2], keep = up ? p[e + 2] : p[e]; p[e] = keep + __shfl_xor(send, 8); }
    { const bool up = (lane & 4) != 0; const float send = up ? p[0] : p[1], keep = up ? p[1] : p[0]; p[0] = keep + __shfl_xor(send, 4); }
    float r = p[0] + __shfl_xor(p[0], 2);
    return r + __shfl_xor(r, 1);
}
__device__ __forceinline__ float silu_f(float x) { return x / (1.f + __expf(-x)); }

#define XB_TMO      128
#define XB_XCNT(j)  (256  + 64 * (j))
#define XB_XSUB(j)  (1280 + 64 * (j))
#define XB_XGEN(j)  (2304 + 64 * (j))
#define XB_TOP      3328
#define XB_TOPGEN   3392
#define XCD_BAR_WORDS 3456
#define XB_SPIN_CAP (1u << 18)
__device__ __forceinline__ unsigned xb_ld(unsigned* p)              { return __hip_atomic_load(p, __ATOMIC_RELAXED, __HIP_MEMORY_SCOPE_AGENT); }
__device__ __forceinline__ unsigned xb_add(unsigned* p, unsigned v) { return __hip_atomic_fetch_add(p, v, __ATOMIC_RELAXED, __HIP_MEMORY_SCOPE_AGENT); }
__device__ __forceinline__ unsigned xb_xcc_id() { return (unsigned)__builtin_amdgcn_s_getreg((3 << 11) | 20) & 0xFu; }
#define XB_SPIN(cond, bar) do { unsigned _sp = 0; while (cond) { __builtin_amdgcn_s_sleep(1); \
    if ((++_sp & 255u) == 0u) { if (xb_ld(&(bar)[XB_TMO])) break; if (_sp > XB_SPIN_CAP) { atomicAdd(&(bar)[XB_TMO], 1u); break; } } } } while (0)
struct XcdBarrier { unsigned* bar; unsigned x; volatile LAS unsigned* st; };
__device__ __forceinline__ XcdBarrier xcd_barrier_post(unsigned* bar, volatile LAS unsigned* st, int tid) {
    XcdBarrier b; b.bar = bar; b.x = xb_xcc_id(); b.st = st;
    if (tid == 0) (void)xb_add(&bar[XB_XCNT(b.x)], 1u);
    return b;
}
__device__ __forceinline__ void xcd_barrier_complete(unsigned* bar, unsigned x, unsigned& nloc, unsigned& nx) {
    const unsigned G = gridDim.x * gridDim.y * gridDim.z;
    unsigned sum, cnt, mine, sp = 0u;
    for (;;) {
        sum = 0u; cnt = 0u; mine = 0u;
#pragma unroll
        for (unsigned j = 0; j < 16; ++j) { const unsigned c = xb_ld(&bar[XB_XCNT(j)]); sum += c; cnt += (c > 0u) ? 1u : 0u; mine = (j == x) ? c : mine; }
        if (sum == G) break;
        __builtin_amdgcn_s_sleep(1);
        if ((++sp & 255u) == 0u) { if (xb_ld(&bar[XB_TMO])) break; if (sp > XB_SPIN_CAP) { atomicAdd(&bar[XB_TMO], 1u); break; } }
    }
    nloc = mine > 0u ? mine : 1u; nx = cnt > 0u ? cnt : 1u;
}
__device__ __forceinline__ void xcd_barrier(const XcdBarrier& b, int tid) {
    asm volatile("s_waitcnt vmcnt(0)" ::: "memory");
    __syncthreads();
    if (tid == 0) {
        unsigned* bar = b.bar; unsigned bx = b.x;
        asm volatile("" : "+v"(bar), "+v"(bx));
        __builtin_amdgcn_s_waitcnt(0);
        unsigned nloc = b.st[0], nx = b.st[1];
        if (nloc == 0u) { xcd_barrier_complete(bar, bx, nloc, nx); b.st[0] = nloc; b.st[1] = nx; }
        const unsigned old = xb_add(&bar[XB_XSUB(bx)], 1u);
        const unsigned gen = old / nloc;
        if (old + 1u == (gen + 1u) * nloc) {
            __builtin_amdgcn_fence(__ATOMIC_RELEASE, "agent");
            asm volatile("s_waitcnt vmcnt(0)" ::: "memory");
            const unsigned og = xb_add(&bar[XB_TOP], 1u);
            const unsigned tg = og / nx;
            if (og + 1u == (tg + 1u) * nx) xb_add(&bar[XB_TOPGEN], 1u);
            else XB_SPIN(xb_ld(&bar[XB_TOPGEN]) == tg, bar);
            __builtin_amdgcn_fence(__ATOMIC_ACQUIRE, "agent");
            xb_add(&bar[XB_XGEN(bx)], 1u);
            asm volatile("s_waitcnt vmcnt(0)" ::: "memory");
        } else {
            XB_SPIN(xb_ld(&bar[XB_XGEN(bx)]) == gen, bar);
            __builtin_amdgcn_fence(__ATOMIC_ACQUIRE, "agent");
            asm volatile("s_waitcnt vmcnt(0)" ::: "memory");
        }
    }
    __syncthreads();
}

struct Args { const float* in[23]; float* out; unsigned char* ws; int ph_lo, ph_hi; };
struct Frame {
    LAS unsigned char* lds;
    volatile LAS unsigned* MISC;
    unsigned* ctl;
    unsigned char* ws;
    int tid, lane, wave, vcu, G, gw, NGW;
    float* out;
};
typedef const Args __attribute__((address_space(4)))* KArgsP;
__device__ __forceinline__ KArgsP kargs() { unsigned long long v = (unsigned long long)__builtin_amdgcn_kernarg_segment_ptr(); asm volatile("" : "+s"(v)); return (KArgsP)v; }
enum InIdx { I_X = 0, I_C, I_CTX, I_CCTX, I_WMOD, I_BMOD, I_GN1, I_WIN, I_CONVW, I_ALOG, I_DTB, I_GOUT, I_WOUT, I_GN2, I_WR, I_BR, I_WG, I_BG, I_WU, I_BU, I_WD, I_BD, I_GF };
__device__ __forceinline__ float* xr_row(const Frame& F, int t) { return t < NLAT ? F.out + (size_t)t * D : (float*)(F.ws + WS_XC) + (size_t)(t - NLAT) * D; }
__device__ __forceinline__ int mod_row(int t) { return t < NLAT ? (t >> 12) : 8; }
__device__ __forceinline__ const float* modv(const Frame& F, int l, int r, int piece) { return (const float*)(F.ws + WS_MODV) + ((size_t)(l * 9 + r) * 6 + piece) * D; }

struct SchedIn {
    const bf16* hx; const bf16* win; int G, c;
    static constexpr int N0 = (MT / 256) * 8, N1 = 4 * (MT / 256), NWG = N0 + N1;
    __device__ __forceinline__ bool next(int i, pg8::Unit& u) const {
        const long L = (long)i * G + c; if (L >= NWG) return false;
        int w = pg8::xcd_remap((int)L, NWG);
        if (w < N0) { u.kind = 0; pg8::grp_decode(w, MT / 256, 8, u.pm, u.pn); } else { w -= N0; u.kind = 1; u.pn = w >> 2; u.pm = w & 3; }
        u.e = 0; return true;
    }
    __device__ __forceinline__ const char* a_base(const pg8::Unit& u, size_t tstep) const { return u.kind == 0 ? (const char*)hx + (size_t)u.pm * tstep : (const char*)win + (size_t)(8 + u.pm) * tstep; }
    __device__ __forceinline__ const char* b_base(const pg8::Unit& u, size_t tstep) const { return u.kind == 0 ? (const char*)win + (size_t)u.pn * tstep : (const char*)hx + (size_t)u.pn * tstep; }
    __device__ __forceinline__ void a_ready(const pg8::Unit&) const {}
    __device__ __forceinline__ void done(const pg8::Unit&) const {}
};
struct EpiIn {
    static constexpr bool PERM = true, AFTER_DRAIN = false;
    bf16* qkvz; bf16* ztl; bf16* ztc;
    __device__ __forceinline__ void operator()(const pg8::f32x4 (&acc)[2][2][4][2], const pg8::Unit& u, int wr, int wc, int fr_, int fq_) const {
        int fr = fr_, fq = fq_; asm volatile("" : "+v"(fr), "+v"(fq));
        const int row0 = u.pm * 256 + wr * 64 + fr, cin = wc * 32 + 8 * fq;
        bf16* base; size_t ldc;
        if (u.kind == 0) { base = qkvz + (size_t)u.pn * 256 + cin; ldc = 2048; }
        else if (u.pn < 128) { base = ztl + (size_t)(u.pn >> 4) * 1024 * 4096 + (size_t)(u.pn & 15) * 256 + cin; ldc = 4096; }
        else { base = ztc + (size_t)(u.pn - 128) * 1024 * 256 + cin; ldc = 256; }
#pragma unroll
        for (int ai = 0; ai < 2; ++ai)
#pragma unroll
            for (int m = 0; m < 4; ++m) { bf16* rowp = base + (size_t)(row0 + ai * 128 + m * 16) * ldc;
#pragma unroll
                for (int bj = 0; bj < 2; ++bj) { const pg8::f32x4 v0 = acc[ai][bj][m][0], v1 = acc[ai][bj][m][1]; pg8::u32x4 w;
                    w.x = pg8::cvt_pk_bf16(v0[0], v0[1]); w.y = pg8::cvt_pk_bf16(v0[2], v0[3]); w.z = pg8::cvt_pk_bf16(v1[0], v1[1]); w.w = pg8::cvt_pk_bf16(v1[2], v1[3]);
                    *(pg8::u32x4*)(rowp + bj * 128) = w; } }
    }
};
struct SchedDft {
    const bf16* dftm; const bf16* ztl; int G, c;
    __device__ __forceinline__ bool next(int i, pg8::Unit& u) const {
        const long L = (long)i * G + c; if (L >= 256) return false;
        const int w = pg8::xcd_remap((int)L, 256), x = w >> 5, j = w & 31, bp = j >> 2;
        u.pm = 4 * (x & 3) + (j & 3); u.e = 4 * (x >> 2) + (bp >> 1); u.pn = bp & 1; u.kind = 0; return true;
    }
    __device__ __forceinline__ const char* a_base(const pg8::Unit& u, size_t tstep) const { return (const char*)dftm + (size_t)u.pm * tstep; }
    __device__ __forceinline__ const char* b_base(const pg8::Unit& u, size_t tstep) const { return (const char*)ztl + (size_t)u.e * (512 * 8192 * 2) + (size_t)u.pn * tstep; }
    __device__ __forceinline__ void a_ready(const pg8::Unit&) const {}
    __device__ __forceinline__ void done(const pg8::Unit&) const {}
};
struct EpiDft {
    static constexpr bool PERM = true, AFTER_DRAIN = false;
    bf16* mix; float scale;
    __device__ __forceinline__ void operator()(const pg8::f32x4 (&acc)[2][2][4][2], const pg8::Unit& u, int wr, int wc, int fr_, int fq_) const {
        int fr = fr_, fq = fq_; asm volatile("" : "+v"(fr), "+v"(fq));
        const int row0 = u.e * SEQ + u.pm * 256 + wr * 64 + fr, col0 = u.pn * 256 + wc * 32 + 8 * fq;
#pragma unroll
        for (int ai = 0; ai < 2; ++ai)
#pragma unroll
            for (int m = 0; m < 4; ++m) { bf16* rowp = mix + (size_t)(row0 + ai * 128 + m * 16) * D + col0;
#pragma unroll
                for (int bj = 0; bj < 2; ++bj) { const pg8::f32x4 v0 = acc[ai][bj][m][0] * scale, v1 = acc[ai][bj][m][1] * scale; pg8::u32x4 w;
                    w.x = pg8::cvt_pk_bf16(v0[0], v0[1]); w.y = pg8::cvt_pk_bf16(v0[2], v0[3]); w.z = pg8::cvt_pk_bf16(v1[0], v1[1]); w.w = pg8::cvt_pk_bf16(v1[2], v1[3]);
                    *(pg8::u32x4*)(rowp + bj * 128) = w; } }
    }
};
struct SchedOut {
    const bf16* mix; const bf16* wout; int nM, G, c;
    __device__ __forceinline__ bool next(int i, pg8::Unit& u) const {
        const int nwg = nM * 4; const long L = (long)i * G + c; if (L >= nwg) return false;
        pg8::grp_decode(pg8::xcd_remap((int)L, nwg), nM, 4, u.pm, u.pn); u.kind = 0; u.e = 0; return true;
    }
    __device__ __forceinline__ const char* a_base(const pg8::Unit& u, size_t tstep) const { return (const char*)mix + (size_t)u.pm * tstep; }
    __device__ __forceinline__ const char* b_base(const pg8::Unit& u, size_t tstep) const { return (const char*)wout + (size_t)u.pn * tstep; }
    __device__ __forceinline__ void a_ready(const pg8::Unit&) const {}
    __device__ __forceinline__ void done(const pg8::Unit&) const {}
};
struct EpiOut {
    static constexpr bool PERM = false, AFTER_DRAIN = false;
    float* xlat; float* xctx; const float* gt1; float dsc;
    __device__ __forceinline__ void operator()(const pg8::f32x4 (&acc)[2][2][4][2], const pg8::Unit& u, int wr, int wc, int fr_, int fq_) const {
        int fr = fr_, fq = fq_; asm volatile("" : "+v"(fr), "+v"(fq));
        const int col0 = u.pn * 256 + wc * 32 + 4 * fq, rl = wr * 64 + fr;
        float* xb = u.pm < 128 ? xlat + (size_t)u.pm * 256 * D : xctx + (size_t)(u.pm - 128) * 256 * D;
        const float* g = gt1 + (size_t)(u.pm < 128 ? (u.pm >> 4) : 8) * 6 * D + col0;
        pg8::f32x4 gv[2][2];
#pragma unroll
        for (int bj = 0; bj < 2; ++bj)
#pragma unroll
            for (int n = 0; n < 2; ++n) gv[bj][n] = *(const pg8::f32x4*)(g + bj * 128 + n * 16);
#pragma unroll
        for (int ai = 0; ai < 2; ++ai)
#pragma unroll
            for (int m = 0; m < 4; ++m) { float* rowp = xb + (size_t)(rl + ai * 128 + m * 16) * D + col0;
#pragma unroll
                for (int bj = 0; bj < 2; ++bj)
#pragma unroll
                    for (int n = 0; n < 2; ++n) { pg8::f32x4* p = (pg8::f32x4*)(rowp + bj * 128 + n * 16); const pg8::f32x4 xo = *p; *p = xo + gv[bj][n] * acc[ai][bj][m][n] * dsc; }
                if (m & 1) asm volatile("" ::: "memory"); }
    }
};
struct SchedMoe {
    const bf16* A; const bf16* W; size_t wstride; const LAS int* pend; int nM, nN, G, c;
    __device__ __forceinline__ bool next(int i, pg8::Unit& u) const {
        const int nwg = nM * nN; const long L = (long)i * G + c; if (L >= nwg) return false;
        pg8::grp_decode(pg8::xcd_remap((int)L, nwg), nM, nN, u.pm, u.pn);
        int e = 0;
#pragma unroll 1
        for (int j = 0; j < NEXP - 1; ++j) e += (pend[j] <= u.pm) ? 1 : 0;
        u.e = e; u.kind = 0; return true;
    }
    __device__ __forceinline__ const char* a_base(const pg8::Unit& u, size_t tstep) const { return (const char*)A + (size_t)u.pm * tstep; }
    __device__ __forceinline__ const char* b_base(const pg8::Unit& u, size_t tstep) const { return (const char*)W + (size_t)u.e * wstride + (size_t)u.pn * tstep; }
    __device__ __forceinline__ void a_ready(const pg8::Unit&) const {}
    __device__ __forceinline__ void done(const pg8::Unit&) const {}
};
struct EpiSwiglu {
    static constexpr bool PERM = true, AFTER_DRAIN = false;
    bf16* hs; const float* bg; const float* bu;
    __device__ __forceinline__ void operator()(const pg8::f32x4 (&acc)[2][2][4][2], const pg8::Unit& u, int wr, int wc, int fr_, int fq_) const {
        int fr = fr_, fq = fq_; asm volatile("" : "+v"(fr), "+v"(fq));
        const int row0 = u.pm * 256 + wr * 64 + fr, f0 = u.pn * 128 + wc * 32 + 8 * fq;
        const pg8::f32x4 bg0 = *(const pg8::f32x4*)(bg + u.e * D + f0), bg1 = *(const pg8::f32x4*)(bg + u.e * D + f0 + 4);
        const pg8::f32x4 bu0 = *(const pg8::f32x4*)(bu + u.e * D + f0), bu1 = *(const pg8::f32x4*)(bu + u.e * D + f0 + 4);
#pragma unroll
        for (int ai = 0; ai < 2; ++ai)
#pragma unroll
            for (int m = 0; m < 4; ++m) {
                float h[8];
#pragma unroll
                for (int n = 0; n < 2; ++n) { const pg8::f32x4 ga = acc[ai][0][m][n] + (n ? bg1 : bg0), ua = acc[ai][1][m][n] + (n ? bu1 : bu0);
#pragma unroll
                    for (int j = 0; j < 4; ++j) { const float a = fminf(ga[j], 7.0f), uu = fminf(fmaxf(ua[j], -7.0f), 7.0f);
                        h[n * 4 + j] = a * __builtin_amdgcn_rcpf(1.0f + __expf(-1.702f * a)) * (uu + 1.0f); } }
                pg8::u32x4 w; w.x = pg8::cvt_pk_bf16(h[0], h[1]); w.y = pg8::cvt_pk_bf16(h[2], h[3]); w.z = pg8::cvt_pk_bf16(h[4], h[5]); w.w = pg8::cvt_pk_bf16(h[6], h[7]);
                *(pg8::u32x4*)(hs + (size_t)(row0 + ai * 128 + m * 16) * D + f0) = w; }
    }
};
struct EpiDown {
    static constexpr bool PERM = true, AFTER_DRAIN = false;
    bf16* ys; const float* bd;
    __device__ __forceinline__ void operator()(const pg8::f32x4 (&acc)[2][2][4][2], const pg8::Unit& u, int wr, int wc, int fr_, int fq_) const {
        int fr = fr_, fq = fq_; asm volatile("" : "+v"(fr), "+v"(fq));
        const int row0 = u.pm * 256 + wr * 64 + fr, col0 = u.pn * 256 + wc * 32 + 8 * fq;
        pg8::f32x4 bv[2][2];
#pragma unroll
        for (int bj = 0; bj < 2; ++bj)
#pragma unroll
            for (int n = 0; n < 2; ++n) bv[bj][n] = *(const pg8::f32x4*)(bd + u.e * D + col0 + bj * 128 + 4 * n);
#pragma unroll
        for (int ai = 0; ai < 2; ++ai)
#pragma unroll
            for (int m = 0; m < 4; ++m) { bf16* rowp = ys + (size_t)(row0 + ai * 128 + m * 16) * D + col0;
#pragma unroll
                for (int bj = 0; bj < 2; ++bj) { const pg8::f32x4 v0 = acc[ai][bj][m][0] + bv[bj][0], v1 = acc[ai][bj][m][1] + bv[bj][1]; pg8::u32x4 w;
                    w.x = pg8::cvt_pk_bf16(v0[0], v0[1]); w.y = pg8::cvt_pk_bf16(v0[2], v0[3]); w.z = pg8::cvt_pk_bf16(v1[0], v1[1]); w.w = pg8::cvt_pk_bf16(v1[2], v1[3]);
                    *(pg8::u32x4*)(rowp + bj * 128) = w; } }
    }
};

__device__ __forceinline__ void transpose_item(const float* W, int ldw, int col0, int K, bf16* WT, int drow0, LAS float* scr, int kb, int lane) {
    const int k0 = 64 * kb;
#pragma unroll 8
    for (int i = 0; i < 32; ++i) { const int kk = 2 * i + (lane >> 5); scr[kk * 33 + (lane & 31)] = W[(size_t)(k0 + kk) * ldw + col0 + (lane & 31)]; }
    LDS_WAIT(); asm volatile("" ::: "memory");
    const int c = lane & 7;
#pragma unroll
    for (int j = 0; j < 4; ++j) { const int n = (lane >> 3) + 8 * j; const LAS float* s = scr + (8 * c) * 33 + n;
        v4u o; o.x = pk2(s[0 * 33], s[1 * 33]); o.y = pk2(s[2 * 33], s[3 * 33]); o.z = pk2(s[4 * 33], s[5 * 33]); o.w = pk2(s[6 * 33], s[7 * 33]);
        *(v4u*)(WT + (size_t)(drow0 + n) * K + k0 + 8 * c) = o; }
    LDS_WAIT(); asm volatile("" ::: "memory");
}
__device__ __forceinline__ void convert_experts(const Frame& F, int l) {
    const KArgsP A = kargs();
    LAS float* scr = (LAS float*)(F.lds + F.wave * 16384);
    bf16* W1 = (bf16*)(F.ws + WS_W1); bf16* W2 = (bf16*)(F.ws + WS_W2);
    constexpr int IPM = 16 * 32;
    for (int it = F.gw; it < 3 * NEXP * IPM; it += F.NGW) {
        const int which = it / (NEXP * IPM), r = it % (NEXP * IPM), e = r / IPM, q = r % IPM, kb = q >> 5, nb = q & 31;
        const size_t moff = ((size_t)l * NEXP + e) * D * D;
        if (which == 0) transpose_item(A->in[I_WG] + moff, D, nb * 32, D, W1 + (size_t)e * 2048 * D, 256 * (nb >> 2) + 32 * (nb & 3), scr, kb, F.lane);
        else if (which == 1) transpose_item(A->in[I_WU] + moff, D, nb * 32, D, W1 + (size_t)e * 2048 * D, 256 * (nb >> 2) + 128 + 32 * (nb & 3), scr, kb, F.lane);
        else transpose_item(A->in[I_WD] + moff, D, nb * 32, D, W2 + (size_t)e * D * D, nb * 32, scr, kb, F.lane);
    }
}
__device__ __forceinline__ void p0_prologue(const Frame& F) {
    const KArgsP A = kargs();
    float* mv = (float*)(F.ws + WS_MODV);
    {
        LAS float* sc = (LAS float*)F.lds;
        LAS float* red = sc + 9 * 1024;
        for (int i = F.tid; i < 9 * 1024; i += NTHR) { const int r = i >> 10, k = i & 1023; sc[i] = silu_f(r < 8 ? A->in[I_C][r * D + k] : A->in[I_CCTX][k]); }
        __syncthreads();
        for (int item = blockIdx.x; item < 192; item += F.G) {
            const int l = item / 96, cg = item % 96, cl = F.tid & 63, ks = F.tid >> 6;
            const float* w = A->in[I_WMOD] + ((size_t)l * D + ks * 128) * 6144 + cg * 64 + cl;
            float a[9];
#pragma unroll
            for (int r = 0; r < 9; ++r) a[r] = 0.f;
#pragma unroll 4
            for (int k = 0; k < 128; ++k) { const float wv = w[(size_t)k * 6144];
#pragma unroll
                for (int r = 0; r < 9; ++r) a[r] += sc[r * 1024 + ks * 128 + k] * wv; }
#pragma unroll
            for (int r = 0; r < 9; ++r) red[(ks * 9 + r) * 64 + cl] = a[r];
            __syncthreads();
            for (int i = F.tid; i < 9 * 64; i += NTHR) { const int r = i >> 6, cc = i & 63; float s = 0.f;
#pragma unroll
                for (int k2 = 0; k2 < 8; ++k2) s += red[(k2 * 9 + r) * 64 + cc];
                mv[(size_t)(l * 9 + r) * 6144 + cg * 64 + cc] = s + A->in[I_BMOD][l * 6144 + cg * 64 + cc]; }
            __syncthreads();
        }
    }
    {
        LAS float* T = (LAS float*)F.lds;
        LAS float* cs = T + 64 * 129; LAS float* sn = cs + 128;
        __syncthreads();
        if (F.tid < 128) { cs[F.tid] = cospif((float)F.tid * (1.0f / 64.0f)); sn[F.tid] = sinpif((float)F.tid * (1.0f / 64.0f)); }
        for (int item = (blockIdx.x + 64) % F.G; item < 128; item += F.G) {
            const int l = item >> 6, kg = (item & 63) >> 2, g = item & 3;
            __syncthreads();
            for (int i = F.tid; i < 64 * 128; i += NTHR) { const int kk = i >> 7, cc = i & 127; T[kk * 129 + cc] = A->in[I_WIN][((size_t)l * D + kg * 64 + kk) * INW + g * 128 + cc]; }
            __syncthreads();
            const int kk = F.tid & 63, ng = F.tid >> 6;
            bf16* dst = (bf16*)(F.ws + WS_WIN) + ((size_t)l * 3072 + 2048 + g * 256) * D + kg * 64 + kk;
#pragma unroll 1
            for (int nn = 0; nn < 32; ++nn) { const int np = ng * 32 + nn, cp = np >> 1; float s = 0.f;
                if (np & 1) {
#pragma unroll 8
                    for (int cc = 0; cc < 128; ++cc) s -= T[kk * 129 + cc] * sn[(cc * cp) & 127]; }
                else {
#pragma unroll 8
                    for (int cc = 0; cc < 128; ++cc) s += T[kk * 129 + cc] * cs[(cc * cp) & 127]; }
                dst[(size_t)np * D] = (bf16)f2bf(s); }
        }
        __syncthreads();
    }
    {
        LAS float* scr = (LAS float*)(F.lds + F.wave * 16384);
        constexpr int I_IN = 16 * 64, I_OUT = 16 * 32;
        for (int it = F.gw; it < NL * (I_IN + I_OUT); it += F.NGW) {
            const int l = it / (I_IN + I_OUT), r = it % (I_IN + I_OUT);
            if (r < I_IN) transpose_item(A->in[I_WIN] + (size_t)l * D * INW, INW, 512 + 32 * (r & 63), D, (bf16*)(F.ws + WS_WIN) + (size_t)l * 3072 * D, 32 * (r & 63), scr, r >> 6, F.lane);
            else { const int q = r - I_IN; transpose_item(A->in[I_WOUT] + (size_t)l * D * D, D, 32 * (q & 31), D, (bf16*)(F.ws + WS_WOUT) + (size_t)l * D * D, 32 * (q & 31), scr, q >> 5, F.lane); }
        }
    }
    convert_experts(F, 0);
    {
        const int gt = F.gw * 64 + F.lane, NT = F.NGW * 64;
        float* wrt = (float*)(F.ws + WS_WRT); float* wabt = (float*)(F.ws + WS_WABT);
        for (int i = gt; i < NL * NEXP * D; i += NT) { const int l = i >> 15, e = (i >> 10) & 31, c = i & 1023; wrt[i] = A->in[I_WR][((size_t)l * D + c) * NEXP + e]; }
        for (int i = gt; i < NL * 16 * D; i += NT) { const int l = i >> 14, j = (i >> 10) & 15, c = i & 1023; wabt[i] = A->in[I_WIN][((size_t)l * D + c) * INW + 2560 + j]; }
        bf16* dm = (bf16*)(F.ws + WS_DFTM);
        for (int i = gt; i < 4096 * 1024; i += NT) { const int kf = i >> 10, j0 = (i & 1023) * 8; float v[8];
#pragma unroll
            for (int jj = 0; jj < 8; ++jj) { const int j = j0 + jj; const float a = (float)((kf * (j & 4095)) & 4095) * (1.0f / 2048.0f); v[jj] = j < 4096 ? cospif(a) : sinpif(a); }
            v4u o; o.x = pk2(v[0], v[1]); o.y = pk2(v[2], v[3]); o.z = pk2(v[4], v[5]); o.w = pk2(v[6], v[7]);
            *(v4u*)(dm + (size_t)kf * 8192 + j0) = o; }
    }
}

template <int MODE>
__device__ __forceinline__ void row_pass(const Frame& F, int l_cur, int l_nxt, bool dummy = false) {
    const KArgsP A = kargs();
    LAS float* wl = (LAS float*)F.lds;
    if (MODE != 2) { const f32x4* src = (const f32x4*)((const float*)(F.ws + WS_WABT) + (size_t)l_nxt * 16 * D);
        for (int i = F.tid; i < 16 * D / 4; i += NTHR) ((LAS f32x4*)wl)[i] = src[i];
        __syncthreads(); }
    const int nrows = MODE == 2 ? NLAT : MT;
    const int* sele = (const int*)(F.ws + WS_SELE); const int* selp = (const int*)(F.ws + WS_SELP); const float* selg = (const float*)(F.ws + WS_SELG);
    const bf16* ys = (const bf16*)(F.ws + WS_XS);
    bf16* hx = (bf16*)(F.ws + WS_ACT); float* ab = (float*)(F.ws + WS_AB);
    for (int t = F.gw; t < nrows; t += F.NGW) {
        const int r = mod_row(t);
        f32x4 v[4];
        float* xr = xr_row(F, t);
        if (MODE == 0) { const float* xin = t < NLAT ? A->in[I_X] + (size_t)t * D : A->in[I_CTX] + (size_t)(t - NLAT) * D;
#pragma unroll
            for (int j = 0; j < 4; ++j) v[j] = *((const f32x4*)xin + F.lane + 64 * j);
        } else {
#pragma unroll
            for (int j = 0; j < 4; ++j) v[j] = *((const f32x4*)xr + F.lane + 64 * j);
            f32x4 y[4];
#pragma unroll
            for (int j = 0; j < 4; ++j) y[j] = (f32x4){0.f, 0.f, 0.f, 0.f};
            (void)sele;
#pragma unroll
            for (int k = 0; k < 4; ++k) { const int dst = selp[t * 4 + k]; const float gk = selg[t * 4 + k]; const v2u* yr = (const v2u*)(ys + (size_t)dst * D) + F.lane;
#pragma unroll
                for (int j = 0; j < 4; ++j) { const v2u w = yr[64 * j]; y[j] += gk * (f32x4){bflo(w.x), bfhi(w.x), bflo(w.y), bfhi(w.y)}; } }
            const f32x4* g2 = (const f32x4*)modv(F, l_cur, r, 5) + F.lane;
#pragma unroll
            for (int j = 0; j < 4; ++j) v[j] += g2[64 * j] * y[j];
        }
        if (MODE != 2 && !dummy) {
#pragma unroll
            for (int j = 0; j < 4; ++j) *((f32x4*)xr + F.lane + 64 * j) = v[j];
        }
        float ss = 0.f;
#pragma unroll
        for (int j = 0; j < 4; ++j) ss += (v[j].x * v[j].x + v[j].y * v[j].y) + (v[j].z * v[j].z + v[j].w * v[j].w);
        const float rstd = 1.0f / sqrtf(wave_sum(ss) * (1.0f / D) + EPS);
        if (MODE == 2) {
            const f32x4* gf = (const f32x4*)A->in[I_GF] + F.lane;
#pragma unroll
            for (int j = 0; j < 4; ++j) *((f32x4*)(F.out + (size_t)t * D) + F.lane + 64 * j) = v[j] * rstd * gf[64 * j];
        } else {
            const f32x4* g1 = (const f32x4*)(A->in[I_GN1] + (size_t)l_nxt * D) + F.lane;
            const f32x4* sh = (const f32x4*)modv(F, l_nxt, r, 0) + F.lane; const f32x4* scl = (const f32x4*)modv(F, l_nxt, r, 1) + F.lane;
            v2u* ho = (v2u*)(hx + (size_t)t * D) + F.lane;
#pragma unroll
            for (int j = 0; j < 4; ++j) { v[j] = v[j] * rstd * g1[64 * j] * (scl[64 * j] + 1.0f) + sh[64 * j]; v2u w; w.x = pk2(v[j].x, v[j].y); w.y = pk2(v[j].z, v[j].w); ho[64 * j] = w; }
            float pp[16];
            int lofs = F.lane; asm volatile("" : "+v"(lofs));
#pragma unroll
            for (int jj = 0; jj < 16; ++jj) { float p = 0.f;
#pragma unroll
                for (int j = 0; j < 4; ++j) { const f32x4 w = ((const LAS f32x4*)(wl + jj * D))[lofs + 64 * j]; p += (v[j].x * w.x + v[j].y * w.y) + (v[j].z * w.z + v[j].w * w.w); }
                pp[jj] = p; if ((jj & 3) == 3) asm volatile("" ::: "memory"); }
            const float mine = rs16(pp, F.lane);
            if ((F.lane & 3) == 0) ab[(size_t)t * 16 + (F.lane >> 2)] = mine;
        }
    }
}

__device__ __forceinline__ void conv_phase(const Frame& F, int l) {
    const KArgsP A = kargs();
    LAS float* cw = (LAS float*)F.lds;
    for (int i = F.tid; i < 5 * 1536; i += NTHR) cw[i] = A->in[I_CONVW][(size_t)l * 5 * 1536 + i];
    __syncthreads();
    const bf16* qkvz = (const bf16*)(F.ws + WS_QKVZ); bf16* qkvn = (bf16*)(F.ws + WS_QKVN);
    const float* ab = (const float*)(F.ws + WS_AB); float* gb = (float*)(F.ws + WS_G); float* bb = (float*)(F.ws + WS_BETA);
    for (int t = F.gw; t < MT; t += F.NGW) {
        int sb, p, Ls;
        if (t < NLAT) { sb = t & ~4095; p = t & 4095; Ls = SEQ; } else { const int tt = t - NLAT; sb = NLAT + (tt & ~255); p = tt & 255; Ls = CTXL; }
        float a[3][8];
#pragma unroll
        for (int q = 0; q < 3; ++q)
#pragma unroll
            for (int i = 0; i < 8; ++i) a[q][i] = 0.f;
#pragma unroll
        for (int tap = 0; tap < 5; ++tap) { const int pp = p + tap - 2;
            if (pp >= 0 && pp < Ls) {
#pragma unroll
                for (int q = 0; q < 3; ++q) { const v4u u = *(const v4u*)(qkvz + (size_t)(sb + pp) * 2048 + q * 512 + 8 * F.lane);
                    const LAS f32x4* wp = (const LAS f32x4*)(cw + tap * 1536 + q * 512 + 8 * F.lane); const f32x4 w0 = wp[0], w1 = wp[1];
                    a[q][0] += bflo(u.x) * w0.x; a[q][1] += bfhi(u.x) * w0.y; a[q][2] += bflo(u.y) * w0.z; a[q][3] += bfhi(u.y) * w0.w;
                    a[q][4] += bflo(u.z) * w1.x; a[q][5] += bfhi(u.z) * w1.y; a[q][6] += bflo(u.w) * w1.z; a[q][7] += bfhi(u.w) * w1.w; } } }
#pragma unroll
        for (int q = 0; q < 3; ++q) { float ss = 0.f;
#pragma unroll
            for (int i = 0; i < 8; ++i) { a[q][i] = silu_f(a[q][i]); ss += a[q][i] * a[q][i]; }
            float sc = 1.0f;
            if (q < 2) { ss = sum16(ss); sc = (1.0f / sqrtf(ss + EPS)) * (q == 0 ? 0.08838834764831845f : 1.0f); }
            v4u o; o.x = pk2(a[q][0] * sc, a[q][1] * sc); o.y = pk2(a[q][2] * sc, a[q][3] * sc); o.z = pk2(a[q][4] * sc, a[q][5] * sc); o.w = pk2(a[q][6] * sc, a[q][7] * sc);
            *(v4u*)(qkvn + (size_t)t * 1536 + q * 512 + 8 * F.lane) = o; }
        if (F.lane < 8) { const int d = F.lane >> 2, h = F.lane & 3;
            const float xg = ab[(size_t)t * 16 + d * 8 + h] + A->in[I_DTB][l * 8 + d * 4 + h];
            const float sp = xg > 20.f ? xg : log1pf(expf(xg));
            gb[(size_t)t * 8 + F.lane] = -expf(A->in[I_ALOG][l * 8 + d * 4 + h]) * sp;
            bb[(size_t)t * 8 + F.lane] = 1.0f / (1.0f + expf(-ab[(size_t)t * 16 + d * 8 + 4 + h])); }
    }
}

__device__ __forceinline__ void ctx_dft(const Frame& F) {
    LAS float* cs = (LAS float*)F.lds;
    LAS float* sn = cs + 256;
    __syncthreads();
    if (F.tid < 256) { cs[F.tid] = cospif((float)F.tid * (1.0f / 128.0f)); sn[F.tid] = sinpif((float)F.tid * (1.0f / 128.0f)); }
    __syncthreads();
    const bf16* ztc = (const bf16*)(F.ws + WS_ZTC); bf16* mix = (bf16*)(F.ws + WS_ACT);
    const float scale = 1.0f / sqrtf(256.0f * 128.0f);
    const int gt = F.gw * 64 + F.lane, NT = F.NGW * 64;
    for (int i = gt; i < NCTX * 512; i += NT) {
        const int c = i & 511, lp = (i >> 9) & 255, b = i >> 17;
        const bf16* z = ztc + ((size_t)b * 512 + c) * 512;
        float s = 0.f;
#pragma unroll 4
        for (int l = 0; l < 256; l += 2) { const unsigned zr = *(const unsigned*)(z + l), zi = *(const unsigned*)(z + 256 + l);
            const int i0 = (l * lp) & 255, i1 = ((l + 1) * lp) & 255;
            s += bflo(zr) * cs[i0] + bflo(zi) * sn[i0] + bfhi(zr) * cs[i1] + bfhi(zi) * sn[i1]; }
        mix[(size_t)(NLAT + b * 256 + lp) * D + c] = (bf16)f2bf(s * scale);
    }
}

__device__ __forceinline__ void scan_naive(const Frame& F, int l) {
    LAS float* kL = (LAS float*)F.lds;
    LAS float* qL = kL + 64 * 128;
    LAS float* vL = qL + 64 * 128;
    LAS float* oL = vL + 64 * 32;
    LAS float* gL = oL + 64 * 32;
    LAS float* bL = gL + 64;
    const bf16* qkvn = (const bf16*)(F.ws + WS_QKVN);
    const float* gb = (const float*)(F.ws + WS_G); const float* bb = (const float*)(F.ws + WS_BETA);
    for (int unit = F.vcu; unit < 256; unit += F.G) {
        const int qd = unit & 3, s = unit >> 2, d = s & 1, h = (s >> 1) & 3, b = s >> 3;
        bf16* od = (bf16*)(F.ws + (d ? WS_OB : WS_OF));
        const int j = F.tid >> 4, rg = F.tid & 15;
        float S[8];
#pragma unroll
        for (int i = 0; i < 8; ++i) S[i] = 0.f;
#pragma unroll 1
        for (int ci = 0; ci < 68; ++ci) {
            int rowbase; const bool isctx = ci < 4;
            if (isctx) rowbase = NLAT + b * 256 + (d ? 3 - ci : ci) * 64; else { const int lc = ci - 4; rowbase = b * SEQ + (d ? 63 - lc : lc) * 64; }
            __syncthreads();
            for (int i = F.tid; i < 64 * 16; i += NTHR) { const int r = i >> 4, g8 = i & 15; const bf16* rp = qkvn + (size_t)(rowbase + r) * 1536 + h * 128 + g8 * 8;
                const v4u q = *(const v4u*)rp, k = *(const v4u*)(rp + 512);
                LAS float* qo = qL + r * 128 + g8 * 8; LAS float* ko = kL + r * 128 + g8 * 8;
                qo[0] = bflo(q.x); qo[1] = bfhi(q.x); qo[2] = bflo(q.y); qo[3] = bfhi(q.y); qo[4] = bflo(q.z); qo[5] = bfhi(q.z); qo[6] = bflo(q.w); qo[7] = bfhi(q.w);
                ko[0] = bflo(k.x); ko[1] = bfhi(k.x); ko[2] = bflo(k.y); ko[3] = bfhi(k.y); ko[4] = bflo(k.z); ko[5] = bfhi(k.z); ko[6] = bflo(k.w); ko[7] = bfhi(k.w); }
            if (F.tid < 256) { const int r = F.tid >> 2, g8 = F.tid & 3; const v4u v = *(const v4u*)(qkvn + (size_t)(rowbase + r) * 1536 + 1024 + h * 128 + qd * 32 + g8 * 8);
                LAS float* vo = vL + r * 32 + g8 * 8;
                vo[0] = bflo(v.x); vo[1] = bfhi(v.x); vo[2] = bflo(v.y); vo[3] = bfhi(v.y); vo[4] = bflo(v.z); vo[5] = bfhi(v.z); vo[6] = bflo(v.w); vo[7] = bfhi(v.w); }
            else if (F.tid < 320) { const int r = F.tid - 256; gL[r] = __expf(gb[(size_t)(rowbase + r) * 8 + d * 4 + h]); bL[r] = bb[(size_t)(rowbase + r) * 8 + d * 4 + h]; }
            __syncthreads();
#pragma unroll 2
            for (int st = 0; st < 64; ++st) {
                const int r = d ? 63 - st : st;
                const float alpha = gL[r], bt = bL[r];
                const f32x4 k0 = *(const LAS f32x4*)(kL + r * 128 + rg * 8), k1 = *(const LAS f32x4*)(kL + r * 128 + rg * 8 + 4);
                const f32x4 q0 = *(const LAS f32x4*)(qL + r * 128 + rg * 8), q1 = *(const LAS f32x4*)(qL + r * 128 + rg * 8 + 4);
                float part = (k0.x * S[0] + k0.y * S[1]) + (k0.z * S[2] + k0.w * S[3]) + (k1.x * S[4] + k1.y * S[5]) + (k1.z * S[6] + k1.w * S[7]);
                part = sum16(part);
                const float dl = bt * (vL[r * 32 + j] - alpha * part);
                S[0] = alpha * S[0] + k0.x * dl; S[1] = alpha * S[1] + k0.y * dl; S[2] = alpha * S[2] + k0.z * dl; S[3] = alpha * S[3] + k0.w * dl;
                S[4] = alpha * S[4] + k1.x * dl; S[5] = alpha * S[5] + k1.y * dl; S[6] = alpha * S[6] + k1.z * dl; S[7] = alpha * S[7] + k1.w * dl;
                float op = (q0.x * S[0] + q0.y * S[1]) + (q0.z * S[2] + q0.w * S[3]) + (q1.x * S[4] + q1.y * S[5]) + (q1.z * S[6] + q1.w * S[7]);
                op = sum16(op);
                if (rg == 0) oL[r * 32 + j] = op;
            }
            __syncthreads();
            if (!(isctx && l == NL - 1)) { const int r = F.tid >> 3, g4 = F.tid & 7; const LAS float* op = oL + r * 32 + g4 * 4;
                v2u w; w.x = pk2(op[0], op[1]); w.y = pk2(op[2], op[3]);
                *(v2u*)(od + (size_t)(rowbase + r) * 512 + h * 128 + qd * 32 + g4 * 4) = w; }
        }
        __syncthreads();
    }
}

__device__ __forceinline__ void gated_out(const Frame& F, int l) {
    const KArgsP A = kargs();
    const bf16* of = (const bf16*)(F.ws + WS_OF); const bf16* ob = (const bf16*)(F.ws + WS_OB); const bf16* qkvz = (const bf16*)(F.ws + WS_QKVZ);
    bf16* mix = (bf16*)(F.ws + WS_ACT);
    const int nrows = l == NL - 1 ? NLAT : MT;
    const f32x4 g0 = *(const f32x4*)(A->in[I_GOUT] + l * 128 + (F.lane & 15) * 8), g1 = *(const f32x4*)(A->in[I_GOUT] + l * 128 + (F.lane & 15) * 8 + 4);
    for (int t = F.gw; t < nrows; t += F.NGW) {
        const v4u a = *(const v4u*)(of + (size_t)t * 512 + 8 * F.lane), b = *(const v4u*)(ob + (size_t)t * 512 + 8 * F.lane), z = *(const v4u*)(qkvz + (size_t)t * 2048 + 1536 + 8 * F.lane);
        float o[8] = {bflo(a.x) + bflo(b.x), bfhi(a.x) + bfhi(b.x), bflo(a.y) + bflo(b.y), bfhi(a.y) + bfhi(b.y), bflo(a.z) + bflo(b.z), bfhi(a.z) + bfhi(b.z), bflo(a.w) + bflo(b.w), bfhi(a.w) + bfhi(b.w)};
        const float zz[8] = {bflo(z.x), bfhi(z.x), bflo(z.y), bfhi(z.y), bflo(z.z), bfhi(z.z), bflo(z.w), bfhi(z.w)};
        const float gg[8] = {g0.x, g0.y, g0.z, g0.w, g1.x, g1.y, g1.z, g1.w};
        float ss = 0.f;
#pragma unroll
        for (int i = 0; i < 8; ++i) ss += o[i] * o[i];
        const float rs = 1.0f / sqrtf(sum16(ss) * (1.0f / 128.0f) + EPS);
#pragma unroll
        for (int i = 0; i < 8; ++i) o[i] = o[i] * rs * gg[i] * silu_f(zz[i]);
        v4u w; w.x = pk2(o[0], o[1]); w.y = pk2(o[2], o[3]); w.z = pk2(o[4], o[5]); w.w = pk2(o[6], o[7]);
        *(v4u*)(mix + (size_t)t * D + 512 + 8 * F.lane) = w;
    }
}

__device__ __forceinline__ void router_phase(const Frame& F, int l, int bank = 0) {
    const KArgsP A = kargs();
    LAS float* wr = (LAS float*)F.lds;
    LAS int* lcnt = (LAS int*)(F.lds + XT_OFF);
    LAS int* lbase = lcnt + 32;
    LAS int* sE = lbase + 32;
    LAS int* sP = sE + 136 * 4;
    LAS float* sG = (LAS float*)(sP + 136 * 4);
    const int nrows = l == NL - 1 ? NLAT : MT, rpb = nrows / 256;
    { const f32x4* src = (const f32x4*)((const float*)(F.ws + WS_WRT) + (size_t)l * NEXP * D);
      for (int i = F.tid; i < NEXP * D / 4; i += NTHR) ((LAS f32x4*)wr)[i] = src[i];
      if (F.tid < 32) lcnt[F.tid] = 0; }
    __syncthreads();
    bf16* h2 = (bf16*)(F.ws + WS_ACT);
    const int row0 = F.vcu * rpb;
    if (F.vcu < 256) {
    for (int rl = F.wave; rl < rpb; rl += NWAVES) {
        const int t = row0 + rl, r = mod_row(t);
        const float* xr = xr_row(F, t);
        f32x4 v[4]; float ss = 0.f;
#pragma unroll
        for (int j = 0; j < 4; ++j) { v[j] = *((const f32x4*)xr + F.lane + 64 * j); ss += (v[j].x * v[j].x + v[j].y * v[j].y) + (v[j].z * v[j].z + v[j].w * v[j].w); }
        const float rstd = 1.0f / sqrtf(wave_sum(ss) * (1.0f / D) + EPS);
        const f32x4* g2 = (const f32x4*)(A->in[I_GN2] + (size_t)l * D) + F.lane;
        const f32x4* sh = (const f32x4*)modv(F, l, r, 3) + F.lane; const f32x4* scl = (const f32x4*)modv(F, l, r, 4) + F.lane;
        v2u* ho = (v2u*)(h2 + (size_t)t * D) + F.lane;
#pragma unroll
        for (int j = 0; j < 4; ++j) { v[j] = v[j] * rstd * g2[64 * j] * (scl[64 * j] + 1.0f) + sh[64 * j]; v2u w; w.x = pk2(v[j].x, v[j].y); w.y = pk2(v[j].z, v[j].w); ho[64 * j] = w; }
        float pe[32];
        int lofs = F.lane; asm volatile("" : "+v"(lofs));
#pragma unroll
        for (int e = 0; e < NEXP; ++e) { float p = 0.f;
#pragma unroll
            for (int j = 0; j < 4; ++j) { const f32x4 w = ((const LAS f32x4*)(wr + e * D))[lofs + 64 * j]; p += (v[j].x * w.x + v[j].y * w.y) + (v[j].z * w.z + v[j].w * w.w); }
            pe[e] = p; if ((e & 3) == 3) asm volatile("" ::: "memory"); }
        float lg = rs32(pe, F.lane) + A->in[I_BR][l * NEXP + (F.lane >> 1)];
        if (F.lane & 1) lg = -3.0e38f;
        int se[4]; float sv[4];
#pragma unroll
        for (int k = 0; k < 4; ++k) { float m = lg;
#pragma unroll
            for (int o = 1; o < 64; o <<= 1) m = fmaxf(m, __shfl_xor(m, o));
            const unsigned long long bal = __ballot(lg == m); const int idx = __ffsll((long long)bal) - 1;
            se[k] = idx >> 1; sv[k] = m; if (F.lane == idx) lg = -3.0e38f; }
        const float e1 = __expf(sv[1] - sv[0]), e2 = __expf(sv[2] - sv[0]), e3 = __expf(sv[3] - sv[0]), inv = 1.0f / (1.0f + e1 + e2 + e3);
        if (F.lane == 0) {
            const float gt[4] = {inv, e1 * inv, e2 * inv, e3 * inv};
#pragma unroll
            for (int k = 0; k < 4; ++k) { sE[rl * 4 + k] = se[k]; sP[rl * 4 + k] = __hip_atomic_fetch_add(lcnt + se[k], 1, __ATOMIC_RELAXED, __HIP_MEMORY_SCOPE_WORKGROUP); sG[rl * 4 + k] = gt[k]; } }
    }
    }
    __syncthreads();
    if (F.tid < 32) { const int n = lcnt[F.tid]; lbase[F.tid] = n ? (int)__hip_atomic_fetch_add(F.ctl + CW_GCNT + ((bank * 2 + l) * 32 + F.tid) * 64, (unsigned)n, RLX_AGENT) : 0; }
    __syncthreads();
    if (F.vcu < 256) {
        int* sele = (int*)(F.ws + WS_SELE); int* selp = (int*)(F.ws + WS_SELP); float* selg = (float*)(F.ws + WS_SELG);
        for (int i = F.tid; i < rpb * 4; i += NTHR) { const int e = sE[i]; sele[(size_t)row0 * 4 + i] = e; selp[(size_t)row0 * 4 + i] = lbase[e] + sP[i]; selg[(size_t)row0 * 4 + i] = sG[i]; }
    }
}
__device__ __forceinline__ void moe_layout(const Frame& F, int l, LAS int* pend, LAS int* pstart) {
    __syncthreads();
    if (F.tid == 0) { int acc = 0;
        for (int e = 0; e < NEXP; ++e) { const int n = (int)__hip_atomic_load(F.ctl + CW_GCNT + (l * 32 + e) * 64, RLX_AGENT); pstart[e] = acc * 256; acc += (n + 255) >> 8; pend[e] = acc; } }
    __syncthreads();
}
__device__ __forceinline__ void gather_phase(const Frame& F, int l, bool dummy = false) {
    LAS int* pend = (LAS int*)(F.lds + XT_OFF); LAS int* pstart = pend + 32;
    moe_layout(F, l, pend, pstart);
    const int nrows = l == NL - 1 ? NLAT : MT;
    const int* sele = (const int*)(F.ws + WS_SELE); int* selp = (int*)(F.ws + WS_SELP);
    const bf16* h2 = (const bf16*)(F.ws + WS_ACT); bf16* xs = (bf16*)(F.ws + WS_XS);
    for (int it = F.gw; it < nrows * 4; it += F.NGW) {
        const int t = it >> 2, e = sele[it], dst = pstart[e] + selp[it];
        const v4u* src = (const v4u*)(h2 + (size_t)t * D) + F.lane; v4u* dp = (v4u*)(xs + (size_t)dst * D) + F.lane;
        const v4u a = src[0], b = src[64];
        dp[0] = a; dp[64] = b;
        if (F.lane == 0 && !dummy) selp[it] = dst;
    }
}

constexpr size_t WS_PW = WS_OB + 34 * MiB;
constexpr size_t WS_PKET = WS_PW + 68 * MiB;
constexpr size_t WS_PUT = WS_PKET + 68 * MiB;
constexpr size_t WS_PATT = WS_PUT + 68 * MiB;
constexpr size_t WS_PGAM = WS_PATT + 34 * MiB;
static_assert(WS_PGAM + 2 * MiB <= WS_END, "prep map");
typedef short bf16x8_t __attribute__((ext_vector_type(8)));
#define MFMA16(a, b, c) __builtin_amdgcn_mfma_f32_16x16x32_bf16((a), (b), (c), 0, 0, 0)
__device__ __forceinline__ v2u pack4(const f32x4 v) { v2u w; w.x = pk2(v.x, v.y); w.y = pk2(v.z, v.w); return w; }
__device__ __forceinline__ int chunk_rowbase(int b, int cn) { return cn < 4 ? NLAT + b * CTXL + cn * 64 : b * SEQ + (cn - 4) * 64; }

__device__ __forceinline__ void prep_phase(const Frame& F) {
    LAS bf16* k_rm = (LAS bf16*)F.lds;
    LAS bf16* q_rm = k_rm + 64 * 136;
    LAS float* Lp = (LAS float*)F.lds;
    LAS bf16* kT = (LAS bf16*)(F.lds + 34816);
    LAS bf16* vT = kT + 128 * 72;
    LAS float* Gm = (LAS float*)(F.lds + 34816 + 36864);
    LAS float* A0 = Gm + 64 * 72;
    LAS bf16* Tm = (LAS bf16*)Gm;
    LAS float* gs = (LAS float*)(F.lds + 34816 + 36864 + 36864);
    LAS float* bs = gs + 128;
    LAS float* gam = bs + 128;
    const bf16* qkvn = (const bf16*)(F.ws + WS_QKVN);
    const float* gb = (const float*)(F.ws + WS_G); const float* bb = (const float*)(F.ws + WS_BETA);
    const int w = F.wave;
    for (int unit = F.vcu; unit < 32 * 68; unit += F.G) {
        int tid_ = F.tid; asm volatile("" : "+v"(tid_));
        const int tid = tid_, lane = tid & 63, l15 = lane & 15, l4 = lane >> 4;
        const int bh = unit / 68, cn = unit % 68, b = bh >> 2, h = bh & 3, rowbase = chunk_rowbase(b, cn);
        const size_t pu = (size_t)(bh * 68 + cn) * 2;
        __syncthreads();
        for (int p = tid; p < 1024; p += NTHR) { const int i = p & 63, c8 = p >> 6; const bf16* rp = qkvn + (size_t)(rowbase + i) * 1536 + h * 128 + c8 * 8;
            const v4u qv = *(const v4u*)rp, kv = *(const v4u*)(rp + 512), vv = *(const v4u*)(rp + 1024);
            *(LAS v4u*)(q_rm + i * 136 + c8 * 8) = qv; *(LAS v4u*)(k_rm + i * 136 + c8 * 8) = kv;
#pragma unroll
            for (int e = 0; e < 4; ++e) { const unsigned kw = kv[e], vw = vv[e];
                kT[(c8 * 8 + 2 * e) * 72 + i] = (bf16)(kw & 0xffffu); kT[(c8 * 8 + 2 * e + 1) * 72 + i] = (bf16)(kw >> 16);
                vT[(c8 * 8 + 2 * e) * 72 + i] = (bf16)(vw & 0xffffu); vT[(c8 * 8 + 2 * e + 1) * 72 + i] = (bf16)(vw >> 16); } }
        if (tid < 128) { const int d = tid >> 6, i = tid & 63; gs[tid] = gb[(size_t)(rowbase + i) * 8 + d * 4 + h]; bs[tid] = bb[(size_t)(rowbase + i) * 8 + d * 4 + h]; }
        __syncthreads();
        if (tid < 128) { const int d = tid >> 6, i = tid & 63; float s = 0.f;
            if (d == 0) { for (int j = 0; j <= i; ++j) s += gs[j]; } else { for (int j = 63; j >= i; --j) s += gs[64 + j]; }
            gam[tid] = s; }
#pragma unroll
        for (int tt = 0; tt < 2; ++tt) { const int idx = 2 * w + tt, ti = idx >> 2, tj = idx & 3;
            f32x4 aG = {0.f, 0.f, 0.f, 0.f}, aA = {0.f, 0.f, 0.f, 0.f};
#pragma unroll
            for (int ks = 0; ks < 4; ++ks) { const int co = 32 * ks + 8 * l4;
                const bf16x8_t bk = *(const LAS bf16x8_t*)(k_rm + (16 * tj + l15) * 136 + co), ak = *(const LAS bf16x8_t*)(k_rm + (16 * ti + l15) * 136 + co), aq = *(const LAS bf16x8_t*)(q_rm + (16 * ti + l15) * 136 + co);
                aG = MFMA16(ak, bk, aG); aA = MFMA16(aq, bk, aA); }
#pragma unroll
            for (int r = 0; r < 4; ++r) { Gm[(16 * ti + 4 * l4 + r) * 72 + 16 * tj + l15] = aG[r]; A0[(16 * ti + 4 * l4 + r) * 72 + 16 * tj + l15] = aA[r]; } }
        __syncthreads();
        for (int idx = tid; idx < 8192; idx += NTHR) { const int d = idx >> 12, ip = (idx >> 6) & 63, jp = idx & 63, i = d ? 63 - ip : ip, j = d ? 63 - jp : jp;
            Lp[idx] = jp < ip ? bs[d * 64 + i] * Gm[i * 72 + j] * __expf(gam[d * 64 + i] - gam[d * 64 + j]) : 0.f; }
        for (int it = tid; it < 1024; it += NTHR) { const int d = it >> 9, i = (it >> 3) & 63, j0 = (it & 7) * 8; float v[8];
#pragma unroll
            for (int e = 0; e < 8; ++e) { const int j = j0 + e; const bool in = d ? (j >= i) : (j <= i); v[e] = in ? A0[i * 72 + j] * __expf(gam[d * 64 + i] - gam[d * 64 + j]) : 0.f; }
            v4u o; o.x = pk2(v[0], v[1]); o.y = pk2(v[2], v[3]); o.z = pk2(v[4], v[5]); o.w = pk2(v[6], v[7]);
            *(v4u*)((bf16*)(F.ws + WS_PATT) + (pu + d) * 4096 + i * 64 + j0) = o; }
        for (int it = tid; it < 2048; it += NTHR) { const int d = it >> 10, dk = (it >> 3) & 127, j0 = (it & 7) * 8; const float gl = d ? gam[64] : gam[63]; float v[8];
            const v4u kk = *(const LAS v4u*)(kT + dk * 72 + j0);
            v[0] = bflo(kk.x); v[1] = bfhi(kk.x); v[2] = bflo(kk.y); v[3] = bfhi(kk.y); v[4] = bflo(kk.z); v[5] = bfhi(kk.z); v[6] = bflo(kk.w); v[7] = bfhi(kk.w);
#pragma unroll
            for (int e = 0; e < 8; ++e) v[e] *= __expf(gl - gam[d * 64 + j0 + e]);
            v4u o; o.x = pk2(v[0], v[1]); o.y = pk2(v[2], v[3]); o.z = pk2(v[4], v[5]); o.w = pk2(v[6], v[7]);
            *(v4u*)((bf16*)(F.ws + WS_PKET) + (pu + d) * 8192 + dk * 64 + j0) = o; }
        if (tid < 128) ((float*)(F.ws + WS_PGAM))[(pu + (tid >> 6)) * 64 + (tid & 63)] = gam[tid];
        __syncthreads();
        if (w < 2) {
            const int d = w; const LAS float* Lr = Lp + d * 4096;
            float t[64];
#pragma unroll
            for (int ip = 0; ip < 64; ++ip) {
                float a0 = (lane == ip) ? 1.f : 0.f, a1 = 0.f;
#pragma unroll
                for (int j4 = 0; j4 < (ip + 3) / 4; ++j4) { const f32x4 Lv = *(const LAS f32x4*)(Lr + ip * 64 + 4 * j4);
                    if (4 * j4 + 0 < ip) a0 -= Lv.x * t[4 * j4 + 0];
                    if (4 * j4 + 1 < ip) a1 -= Lv.y * t[4 * j4 + 1];
                    if (4 * j4 + 2 < ip) a0 -= Lv.z * t[4 * j4 + 2];
                    if (4 * j4 + 3 < ip) a1 -= Lv.w * t[4 * j4 + 3]; }
                t[ip] = a0 + a1; asm volatile("" ::: "memory"); }
            const int jn = d ? 63 - lane : lane; const float bj = bs[d * 64 + jn], bge = bj * __expf(gam[d * 64 + jn]);
            LAS bf16* Tu = Tm + (d * 2) * 64 * 72; LAS bf16* Tw = Tu + 64 * 72;
#pragma unroll
            for (int ip = 0; ip < 64; ++ip) { const int in = d ? 63 - ip : ip; Tu[in * 72 + jn] = (bf16)f2bf(t[ip] * bj); Tw[in * 72 + jn] = (bf16)f2bf(t[ip] * bge); }
        }
        __syncthreads();
        {
            const int d = w >> 2, ww = w & 3;
            const LAS bf16* Tu = Tm + (d * 2) * 64 * 72; const LAS bf16* Tw = Tu + 64 * 72;
            bf16x8_t tu[2], tw[2];
#pragma unroll
            for (int ks = 0; ks < 2; ++ks) { tu[ks] = *(const LAS bf16x8_t*)(Tu + (16 * ww + l15) * 72 + 32 * ks + 8 * l4); tw[ks] = *(const LAS bf16x8_t*)(Tw + (16 * ww + l15) * 72 + 32 * ks + 8 * l4); }
            bf16* ut = (bf16*)(F.ws + WS_PUT) + (pu + d) * 8192; bf16* wg = (bf16*)(F.ws + WS_PW) + (pu + d) * 8192;
#pragma unroll 2
            for (int tj = 0; tj < 8; ++tj) {
                f32x4 au = {0.f, 0.f, 0.f, 0.f}, aw = {0.f, 0.f, 0.f, 0.f};
#pragma unroll
                for (int ks = 0; ks < 2; ++ks) { const bf16x8_t bv = *(const LAS bf16x8_t*)(vT + (16 * tj + l15) * 72 + 32 * ks + 8 * l4), ak = *(const LAS bf16x8_t*)(kT + (16 * tj + l15) * 72 + 32 * ks + 8 * l4);
                    au = MFMA16(tu[ks], bv, au); aw = MFMA16(ak, tw[ks], aw); }
                *(v2u*)(ut + (16 * tj + l15) * 64 + 16 * ww + 4 * l4) = pack4(au);
                *(v2u*)(wg + (16 * ww + l15) * 128 + 16 * tj + 4 * l4) = pack4(aw);
            }
        }
    }
    __syncthreads();
}

__device__ __forceinline__ void scan_mfma(const Frame& F, int l) {
    LAS bf16* ST = (LAS bf16*)F.lds;
    LAS bf16* vnT = ST + 32 * 136;
    const bf16* qkvn = (const bf16*)(F.ws + WS_QKVN);
    const int lane = F.lane, l15 = lane & 15, l4 = lane >> 4, w = F.wave;
    for (int unit = F.vcu; unit < 256; unit += F.G) {
        const int s = unit & 3, sd = unit >> 2, d = sd & 1, bh = sd >> 1, b = bh >> 2, h = bh & 3;
        bf16* od = (bf16*)(F.ws + (d ? WS_OB : WS_OF));
        __syncthreads();
        for (int i = F.tid; i < 32 * 136 / 2; i += NTHR) ((LAS unsigned*)ST)[i] = 0u;
        f32x4 S0 = {0.f, 0.f, 0.f, 0.f}, S1 = {0.f, 0.f, 0.f, 0.f};
        __syncthreads();
        const int rt = w & 3;
#pragma unroll 1
        for (int ci = 0; ci < 68; ++ci) {
            const int cn = ci < 4 ? (d ? 3 - ci : ci) : 4 + (d ? 67 - ci : ci - 4);
            const int rowbase = chunk_rowbase(b, cn);
            const size_t pu = (size_t)(bh * 68 + cn) * 2 + d;
            const float* gmp = (const float*)(F.ws + WS_PGAM) + pu * 64;
            const float gend = __expf(gmp[d ? 0 : 63]);
            bf16x8_t fa[4], fb[2]; v2u uv0 = {0u, 0u}, uv1 = {0u, 0u}; float eg = 1.f;
            const bf16* ket = (const bf16*)(F.ws + WS_PKET) + pu * 8192 + (16 * w + l15) * 64 + 8 * l4;
            const bf16x8_t kf0 = *(const bf16x8_t*)ket, kf1 = *(const bf16x8_t*)(ket + 32);
            if (w < 4) {
                const bf16* wp = (const bf16*)(F.ws + WS_PW) + pu * 8192 + (16 * rt + l15) * 128 + 8 * l4;
#pragma unroll
                for (int ks = 0; ks < 4; ++ks) fa[ks] = *(const bf16x8_t*)(wp + 32 * ks);
                const bf16* up = (const bf16*)(F.ws + WS_PUT) + pu * 8192 + (32 * s + l15) * 64 + 16 * rt + 4 * l4;
                uv0 = *(const v2u*)up; uv1 = *(const v2u*)(up + 16 * 64);
                fb[0] = fa[0]; fb[1] = fa[0];
            } else {
                const bf16* qp = qkvn + (size_t)(rowbase + 16 * rt + l15) * 1536 + h * 128 + 8 * l4;
                eg = __expf(gmp[16 * rt + l15]);
#pragma unroll
                for (int ks = 0; ks < 4; ++ks) { const v4u qv = *(const v4u*)(qp + 32 * ks); v4u o;
                    o.x = pk2(bflo(qv.x) * eg, bfhi(qv.x) * eg); o.y = pk2(bflo(qv.y) * eg, bfhi(qv.y) * eg); o.z = pk2(bflo(qv.z) * eg, bfhi(qv.z) * eg); o.w = pk2(bflo(qv.w) * eg, bfhi(qv.w) * eg);
                    fa[ks] = __builtin_bit_cast(bf16x8_t, o); }
                const bf16* ap = (const bf16*)(F.ws + WS_PATT) + pu * 4096 + (16 * rt + l15) * 64 + 8 * l4;
                fb[0] = *(const bf16x8_t*)ap; fb[1] = *(const bf16x8_t*)(ap + 32);
            }
            f32x4 c0 = {0.f, 0.f, 0.f, 0.f}, c1 = {0.f, 0.f, 0.f, 0.f};
#pragma unroll
            for (int ks = 0; ks < 4; ++ks) { const bf16x8_t b0 = *(const LAS bf16x8_t*)(ST + l15 * 136 + 32 * ks + 8 * l4), b1 = *(const LAS bf16x8_t*)(ST + (16 + l15) * 136 + 32 * ks + 8 * l4);
                c0 = MFMA16(fa[ks], b0, c0); c1 = MFMA16(fa[ks], b1, c1); }
            if (w < 4) {
                const f32x4 u0 = {bflo(uv0.x), bfhi(uv0.x), bflo(uv0.y), bfhi(uv0.y)}, u1 = {bflo(uv1.x), bfhi(uv1.x), bflo(uv1.y), bfhi(uv1.y)};
                *(LAS v2u*)(vnT + l15 * 72 + 16 * rt + 4 * l4) = pack4(u0 - c0);
                *(LAS v2u*)(vnT + (16 + l15) * 72 + 16 * rt + 4 * l4) = pack4(u1 - c1);
            }
            __syncthreads();
            const bf16x8_t v00 = *(const LAS bf16x8_t*)(vnT + l15 * 72 + 8 * l4), v01 = *(const LAS bf16x8_t*)(vnT + l15 * 72 + 32 + 8 * l4);
            const bf16x8_t v10 = *(const LAS bf16x8_t*)(vnT + (16 + l15) * 72 + 8 * l4), v11 = *(const LAS bf16x8_t*)(vnT + (16 + l15) * 72 + 32 + 8 * l4);
            if (w >= 4) {
                c0 = MFMA16(fb[0], v00, c0); c0 = MFMA16(fb[1], v01, c0); c1 = MFMA16(fb[0], v10, c1); c1 = MFMA16(fb[1], v11, c1);
                if (!(cn < 4 && l == NL - 1)) {
                    bf16* op = od + (size_t)(rowbase + 16 * rt + 4 * l4) * 512 + h * 128 + 32 * s + l15;
#pragma unroll
                    for (int r = 0; r < 4; ++r) { op[(size_t)r * 512] = (bf16)f2bf(c0[r]); op[(size_t)r * 512 + 16] = (bf16)f2bf(c1[r]); }
                }
            }
            S0 = S0 * gend; S1 = S1 * gend;
            S0 = MFMA16(kf0, v00, S0); S0 = MFMA16(kf1, v01, S0); S1 = MFMA16(kf0, v10, S1); S1 = MFMA16(kf1, v11, S1);
            *(LAS v2u*)(ST + l15 * 136 + 16 * w + 4 * l4) = pack4(S0);
            *(LAS v2u*)(ST + (16 + l15) * 136 + 16 * w + 4 * l4) = pack4(S1);
            __syncthreads();
        }
    }
}

#ifndef USE_NAIVE_SCAN
#define USE_NAIVE_SCAN 0
#endif
#ifndef REP_MASK
#define REP_MASK 0
#endif
#define REPS(p) for (int _r = 0; _r < 1 + ((REP_MASK >> (p)) & 1); ++_r)
#define LASTREP(p) (_r == ((REP_MASK >> (p)) & 1))
constexpr int PH_PER_LAYER = 11, N_PHASES = 2 + NL * PH_PER_LAYER;
#ifndef PG8_SP2
#define PG8_SP2 true
#endif
#ifndef PG8_ALIGN
#define PG8_ALIGN true
#endif
__device__ __forceinline__ Frame make_frame(int wv) {
    extern __shared__ __attribute__((aligned(16))) unsigned char lds[];
    const KArgsP A = kargs();
    Frame F;
    { unsigned lb = (unsigned)(uintptr_t)(LAS unsigned char*)lds; asm volatile("" : "+s"(lb)); F.lds = (LAS unsigned char*)(uintptr_t)lb; }
    F.MISC = (volatile LAS unsigned*)(F.lds + MISC_OFF);
    { int ln = (int)__builtin_amdgcn_mbcnt_hi(~0u, __builtin_amdgcn_mbcnt_lo(~0u, 0u)); asm volatile("" : "+v"(ln)); F.lane = ln; }
    { int w_ = wv; asm volatile("" : "+s"(w_)); F.wave = w_; } F.tid = F.wave * 64 + F.lane;
    F.G = gridDim.x; { const int bx = blockIdx.x; F.vcu = (F.G % 8 == 0) ? (bx % 8) * (F.G / 8) + bx / 8 : bx; }
    F.gw = F.vcu * NWAVES + F.wave; F.NGW = F.G * NWAVES;
    F.ws = A->ws; F.ctl = (unsigned*)(A->ws + WS_CTL); F.out = A->out;
    return F;
}
__global__ void __launch_bounds__(NTHR, 2) mk_fwd(Args args) {
    const int wv = __builtin_amdgcn_readfirstlane((int)threadIdx.x >> 6);
    { Frame F = make_frame(wv);
      for (int u = F.tid; u < (LDS_BYTES - LDSCTL_OFF) / 4; u += NTHR) ((LAS unsigned*)(F.lds + LDSCTL_OFF))[u] = 0u;
      __syncthreads(); }
    const int lo = args.ph_lo, hi = args.ph_hi;
    if (hi - lo > 1) { Frame F = make_frame(wv); (void)xcd_barrier_post((unsigned*)(F.ctl + CW_BAR), F.MISC + 8, F.tid); }
#define IN(k) (lo <= (k) && (k) < hi)
#define SEAM(k) do { if (IN(k) && IN((k) + 1)) { Frame Fb = make_frame(wv); XcdBarrier bar; bar.bar = (unsigned*)(Fb.ctl + CW_BAR); bar.x = xb_xcc_id(); bar.st = Fb.MISC + 8; xcd_barrier(bar, Fb.tid); } } while (0)
    if (IN(0)) { Frame F = make_frame(wv); REPS(0) { p0_prologue(F); __syncthreads(); } }
    SEAM(0);
    if (IN(1)) { Frame F = make_frame(wv); REPS(1) { row_pass<0>(F, 0, 0); __syncthreads(); } }
    SEAM(1);
#pragma unroll 1
    for (int l = 0; l < NL; ++l) {
        const int pb = 2 + l * PH_PER_LAYER;
        if (IN(pb + 0)) { Frame F = make_frame(wv);
            SchedIn S{(const bf16*)(F.ws + WS_ACT), (const bf16*)(F.ws + WS_WIN) + (size_t)l * 3072 * D, F.G, (int)blockIdx.x};
            EpiIn E{(bf16*)(F.ws + WS_QKVZ), (bf16*)(F.ws + WS_ZTL), (bf16*)(F.ws + WS_ZTC)};
            REPS(8) { pg8::gemm_phase<EpiIn, SchedIn, PG8_ALIGN, PG8_SP2>(F.lds, pg8::Gemm{D}, S, E, F.tid); __syncthreads(); } }
        SEAM(pb + 0);
        if (IN(pb + 1)) { Frame F = make_frame(wv); REPS(2) { conv_phase(F, l); __syncthreads(); } }
        SEAM(pb + 1);
        if (IN(pb + 2)) {
            { Frame F = make_frame(wv);
              SchedDft S{(const bf16*)(F.ws + WS_DFTM), (const bf16*)(F.ws + WS_ZTL), F.G, (int)blockIdx.x};
              EpiDft E{(bf16*)(F.ws + WS_ACT), 1.0f / sqrtf(4096.0f * 128.0f)};
              REPS(9) { pg8::gemm_phase<EpiDft, SchedDft, PG8_ALIGN, PG8_SP2>(F.lds, pg8::Gemm{8192}, S, E, F.tid); __syncthreads(); } }
            if (l == 0) { Frame F = make_frame(wv); ctx_dft(F); }
#if !USE_NAIVE_SCAN
            { Frame F = make_frame(wv); REPS(3) { prep_phase(F); } }
#endif
        }
        SEAM(pb + 2);
        if (IN(pb + 3)) { Frame F = make_frame(wv);
#if USE_NAIVE_SCAN
            REPS(4) { scan_naive(F, l); __syncthreads(); }
#else
            REPS(4) { scan_mfma(F, l); __syncthreads(); }
#endif
        }
        SEAM(pb + 3);
        if (IN(pb + 4)) { Frame F = make_frame(wv); REPS(5) { gated_out(F, l); __syncthreads(); } }
        SEAM(pb + 4);
        if (IN(pb + 5)) { Frame F = make_frame(wv);
            SchedOut S{(const bf16*)(F.ws + WS_ACT), (const bf16*)(F.ws + WS_WOUT) + (size_t)l * D * D, l == NL - 1 ? NLAT / 256 : MT / 256, F.G, (int)blockIdx.x};
            REPS(10) { EpiOut E{F.out, (float*)(F.ws + WS_XC), modv(F, l, 0, 2), LASTREP(10) ? 1.0f : 0.0f};
                pg8::gemm_phase<EpiOut, SchedOut, PG8_ALIGN, PG8_SP2>(F.lds, pg8::Gemm{D}, S, E, F.tid); __syncthreads(); } }
        SEAM(pb + 5);
        if (IN(pb + 6)) { Frame F = make_frame(wv); REPS(6) { router_phase(F, l, LASTREP(6) ? 0 : 1); __syncthreads(); } }
        SEAM(pb + 6);
        if (IN(pb + 7)) { Frame F = make_frame(wv); REPS(7) { gather_phase(F, l, !LASTREP(7)); __syncthreads(); } }
        SEAM(pb + 7);
        if (IN(pb + 8)) { Frame F = make_frame(wv);
            LAS int* pend = (LAS int*)(F.lds + XT_OFF); moe_layout(F, l, pend, pend + 32);
            SchedMoe S{(const bf16*)(F.ws + WS_XS), (const bf16*)(F.ws + WS_W1), (size_t)2048 * D * 2, pend, pend[NEXP - 1], 8, F.G, (int)blockIdx.x};
            EpiSwiglu E{(bf16*)(F.ws + WS_HS), kargs()->in[I_BG] + (size_t)l * NEXP * D, kargs()->in[I_BU] + (size_t)l * NEXP * D};
            REPS(11) { pg8::gemm_phase<EpiSwiglu, SchedMoe, PG8_ALIGN, PG8_SP2>(F.lds, pg8::Gemm{D}, S, E, F.tid); __syncthreads(); } }
        SEAM(pb + 8);
        if (IN(pb + 9)) { Frame F = make_frame(wv);
            LAS int* pend = (LAS int*)(F.lds + XT_OFF); moe_layout(F, l, pend, pend + 32);
            SchedMoe S{(const bf16*)(F.ws + WS_HS), (const bf16*)(F.ws + WS_W2), (size_t)D * D * 2, pend, pend[NEXP - 1], 4, F.G, (int)blockIdx.x};
            EpiDown E{(bf16*)(F.ws + WS_XS), kargs()->in[I_BD] + (size_t)l * NEXP * D};
            REPS(12) { pg8::gemm_phase<EpiDown, SchedMoe, PG8_ALIGN, PG8_SP2>(F.lds, pg8::Gemm{D}, S, E, F.tid); __syncthreads(); } }
        SEAM(pb + 9);
        if (IN(pb + 10)) {
            { Frame F = make_frame(wv);
              if (l == NL - 1) row_pass<2>(F, l, l); else { REPS(13) { row_pass<1>(F, l, l + 1, !LASTREP(13)); __syncthreads(); } } }
            if (l != NL - 1) { Frame F = make_frame(wv); __syncthreads(); REPS(14) { convert_experts(F, l + 1); __syncthreads(); } }
        }
        if (l + 1 < NL) SEAM(pb + 10);
    }
#undef IN
#undef SEAM
}

extern "C" void kernel_launch(void* const* d_in, const int* in_sizes, int n_in, void* d_out, int out_size, void* d_ws, size_t ws_size, hipStream_t stream) {
    static int grid = 0;
    if (grid == 0) {
        if (n_in != 23 || out_size != NLAT * D || ws_size < WS_END) { fprintf(stderr, "kernel_launch: unexpected shapes (n_in %d, out %d, ws %zu); nothing launched\n", n_in, out_size, ws_size); grid = -1; return; }
        int dev = 0, cus = 0, per_cu = 0;
        if (hipGetDevice(&dev) != hipSuccess || hipDeviceGetAttribute(&cus, hipDeviceAttributeMultiprocessorCount, dev) != hipSuccess) { grid = -1; return; }
        if (hipFuncSetAttribute((const void*)mk_fwd, hipFuncAttributeMaxDynamicSharedMemorySize, LDS_BYTES) != hipSuccess) { fprintf(stderr, "kernel_launch: hipFuncSetAttribute failed\n"); grid = -1; return; }
        if (hipOccupancyMaxActiveBlocksPerMultiprocessor(&per_cu, (const void*)mk_fwd, NTHR, LDS_BYTES) != hipSuccess || per_cu < 1)
            fprintf(stderr, "kernel_launch: note: occupancy query reports %d workgroups per CU\n", per_cu);
        (void)hipGetLastError();
        grid = cus;
        if (grid != 256) { fprintf(stderr, "kernel_launch: built for 256 CUs, found %d; nothing launched\n", grid); grid = -1; return; }
    }
    if (grid < 0) return;
    if (hipMemsetAsync((char*)d_ws + WS_CTL, 0, CTL_ZERO_BYTES, stream) != hipSuccess) { fprintf(stderr, "kernel_launch: hipMemsetAsync failed\n"); return; }
    Args a{};
    for (int i = 0; i < 23; ++i) a.in[i] = (const float*)d_in[i];
    a.out = (float*)d_out; a.ws = (unsigned char*)d_ws;
#if MK_ONE_LAUNCH
    a.ph_lo = 0; a.ph_hi = N_PHASES;
    hipLaunchKernelGGL(mk_fwd, dim3(grid), dim3(NTHR), LDS_BYTES, stream, a);
#else
    for (int p = 0; p < N_PHASES; ++p) { a.ph_lo = p; a.ph_hi = p + 1; hipLaunchKernelGGL(mk_fwd, dim3(grid), dim3(NTHR), LDS_BYTES, stream, a); }
#endif
    const hipError_t le = hipPeekAtLastError();
    if (le != hipSuccess) fprintf(stderr, "kernel_launch: launch failed: %s\n", hipGetErrorName(le));
}
```

```cpp
#define MK_ONE_LAUNCH 1
#include <hip/hip_runtime.h>
#include <cstdio>
#include <cstdint>

#ifndef MK_ONE_LAUNCH
#define MK_ONE_LAUNCH 1
#endif

namespace pg8 {
#define PG8_LAS __attribute__((address_space(3)))
typedef unsigned short bf16_t;
typedef short bf16x8 __attribute__((ext_vector_type(8)));
typedef float f32x4 __attribute__((ext_vector_type(4)));
typedef unsigned u32x4 __attribute__((ext_vector_type(4)));
constexpr int BM = 256, BK = 64, HALF = 128, HTB = HALF * BK * 2  , STAGE_BYTES = 8 * HTB, NXCD = 8, WGM = 8;

__host__ __device__ __forceinline__ int lds_byte(int r, int c) { const int st = (r >> 4) * 2 + (c >> 5), rr = r & 15, cc = c & 31, ob = rr * 64 + cc * 2; return st * 1024 + (ob ^ (((ob >> 9) & 1) << 5)); }
__host__ __device__ __forceinline__ void stage_rc(int b, int& R, int& C) { const int st = b / 1024, sb = b % 1024, swz = sb ^ (((sb >> 9) & 1) << 5); R = (st >> 1) * 16 + swz / 64; C = (st & 1) * 32 + (swz % 64) / 2; }
__host__ __device__ __forceinline__ int perm32(int rho) { const int n = rho >> 4, i = rho & 15; return 8 * (i >> 2) + 4 * n + (i & 3); }

struct Unit { int pm, pn, kind, e; };
struct Gemm { int K; };

__device__ __forceinline__ int xcd_remap(int L, int nwg) { const int q = nwg / NXCD, r = nwg % NXCD, xcd = L % NXCD, off = L / NXCD; return (xcd < r ? xcd * (q + 1) : r * (q + 1) + (xcd - r) * q) + off; }
__device__ __forceinline__ void grp_decode(int wgid, int nM, int nN, int& pm, int& pn) { const int nig = WGM * nN, gid = wgid / nig, fm = gid * WGM, gsz = (nM - fm) < WGM ? (nM - fm) : WGM; pm = fm + ((wgid % nig) % gsz); pn = (wgid % nig) / gsz; }

__device__ __forceinline__ const char* uni_ptr(const char* p) { const unsigned long long v = (unsigned long long)p; const unsigned lo = __builtin_amdgcn_readfirstlane((unsigned)v), hi = __builtin_amdgcn_readfirstlane((unsigned)(v >> 32)); return (const char*)(((unsigned long long)hi << 32) | lo); }
__device__ __forceinline__ unsigned cvt_pk_bf16(float lo, float hi) { unsigned r; asm volatile("v_cvt_pk_bf16_f32 %0, %1, %2" : "=v"(r) : "v"(lo), "v"(hi)); return r; }

template <class Epi, class Sched, bool ALIGN_EPI = false, bool SP2 = false>
__device__ __forceinline__ void gemm_phase(PG8_LAS unsigned char* lds, const Gemm g, const Sched& S, const Epi& E, int tid_in) {
    int tid_ = tid_in; asm volatile("" : "+v"(tid_));
    const int tid = tid_, wid = __builtin_amdgcn_readfirstlane(tid >> 6), lane = tid & 63, wr = wid >> 2, wc = wid & 3, fr = lane & 15, fq = lane >> 4;
    const int K = g.K, nt = K / BK;
    unsigned voffA[2], voffB[2];
#pragma unroll
    for (int i = 0; i < 2; ++i) { int R, C; stage_rc(tid * 16 + i * 8192, R, C); const int Rb = Epi::PERM ? ((R & ~31) + perm32(R & 31)) : R;
        voffA[i] = (unsigned)(R * K + C) * 2u; voffB[i] = (unsigned)(Rb * K + C) * 2u; }
    const size_t kstep = (size_t)(BK * 2);
    const size_t hstep = (size_t)HALF * K * 2;
    const size_t tstep = 2 * hstep;
    const unsigned ldsw = (unsigned)wid * 1024u;
    const int aoff = lds_byte(wr * 64 + fr, fq * 8), boff = lds_byte(wc * 32 + fr, fq * 8);
#define PG8_SA(b, h) (((b) * 2 + (h)) * HTB)
#define PG8_SB(b, h) ((4 + (b) * 2 + (h)) * HTB)
#define PG8_STAGE(bufoff, gbase, voff) do { _Pragma("unroll") for (int _i = 0; _i < 2; ++_i) \
        __builtin_amdgcn_global_load_lds((const unsigned*)((const char*)(gbase) + (voff)[_i]), (PG8_LAS unsigned*)(lds + (bufoff) + ldsw + _i * 8192), 16, 0, 0); } while (0)
#define PG8_LDA(dst, b, h) do { _Pragma("unroll") for (int m = 0; m < 4; ++m) _Pragma("unroll") for (int k = 0; k < 2; ++k) dst[m][k] = *(const PG8_LAS bf16x8*)(lds + PG8_SA(b, h) + aoff + m * 2048 + k * 1024); } while (0)
#define PG8_LDB(dst, b, h) do { _Pragma("unroll") for (int n = 0; n < 2; ++n) _Pragma("unroll") for (int k = 0; k < 2; ++k) dst[n][k] = *(const PG8_LAS bf16x8*)(lds + PG8_SB(b, h) + boff + n * 2048 + k * 1024); } while (0)
#define PG8_MMA(ai, bj, At, Bt) do { __builtin_amdgcn_s_setprio(1); _Pragma("unroll") for (int m = 0; m < 4; ++m) _Pragma("unroll") for (int n = 0; n < 2; ++n) _Pragma("unroll") for (int k = 0; k < 2; ++k) \
        acc[ai][bj][m][n] = __builtin_amdgcn_mfma_f32_16x16x32_bf16(Bt[n][k], At[m][k], acc[ai][bj][m][n], 0, 0, 0); __builtin_amdgcn_s_setprio(0); } while (0)
#define PG8_WAIT_V(n) asm volatile("s_waitcnt vmcnt(" #n ")" ::: "memory")
#define PG8_WAIT_L(n) asm volatile("s_waitcnt lgkmcnt(" #n ")" ::: "memory")
#define PG8_BAR __builtin_amdgcn_s_barrier()
#define PG8_SCHED __builtin_amdgcn_sched_barrier(0)
    Unit cur, nxt; int ui = 0;
    if (!S.next(0, cur)) return;
    f32x4 acc[2][2][4][2];
#pragma unroll
    for (int a = 0; a < 2; ++a)
#pragma unroll
        for (int b = 0; b < 2; ++b)
#pragma unroll
            for (int m = 0; m < 4; ++m)
#pragma unroll
                for (int n = 0; n < 2; ++n) acc[a][b][m][n] = (f32x4){0.f, 0.f, 0.f, 0.f};
    bf16x8 At[4][2], B0[2][2], B1[2][2];
    const char* cA = uni_ptr(S.a_base(cur, tstep)); const char* cB = uni_ptr(S.b_base(cur, tstep));
    S.a_ready(cur);
    if constexpr (SP2) {
        PG8_STAGE(PG8_SB(0, 0), cB, voffB); PG8_STAGE(PG8_SB(0, 1), cB + hstep, voffB); PG8_STAGE(PG8_SA(0, 0), cA, voffA); PG8_STAGE(PG8_SA(0, 1), cA + hstep, voffA);
        if (wr == 1) PG8_BAR;
        PG8_WAIT_V(2); PG8_BAR;
        PG8_STAGE(PG8_SB(1, 0), cB + kstep, voffB); PG8_STAGE(PG8_SA(1, 0), cA + kstep, voffA); PG8_STAGE(PG8_SB(1, 1), cB + hstep + kstep, voffB);
        PG8_WAIT_V(6); PG8_BAR;
    } else {
        PG8_STAGE(PG8_SB(0, 0), cB, voffB); PG8_STAGE(PG8_SA(0, 0), cA, voffA); PG8_STAGE(PG8_SB(0, 1), cB + hstep, voffB); PG8_STAGE(PG8_SA(0, 1), cA + hstep, voffA);
        if (wr == 1) PG8_BAR;
        PG8_WAIT_V(4); PG8_BAR;
        PG8_STAGE(PG8_SB(1, 0), cB + kstep, voffB); PG8_STAGE(PG8_SA(1, 0), cA + kstep, voffA); PG8_STAGE(PG8_SB(1, 1), cB + hstep + kstep, voffB);
        PG8_WAIT_V(6); PG8_BAR;
    }
    for (;;) {
        const bool has_next = S.next(ui + 1, nxt);
        const char* nA = uni_ptr(has_next ? S.a_base(nxt, tstep) : cA); const char* nB = uni_ptr(has_next ? S.b_base(nxt, tstep) : cB);
        for (int t = 0; t < nt; t += 2) {
            const bool last = (t == nt - 2);
            const char* a1 = cA + (size_t)(t + 1) * kstep;
            const char* a2 = last ? nA : cA + (size_t)(t + 2) * kstep; const char* b2 = last ? nB : cB + (size_t)(t + 2) * kstep;
            const char* a3 = a2 + kstep; const char* b3 = b2 + kstep;
            if (last && has_next) S.a_ready(nxt);
            if constexpr (SP2) {
            PG8_LDB(B0, 0, 0); PG8_LDB(B1, 0, 1); PG8_SCHED; PG8_LDA(At, 0, 0); PG8_STAGE(PG8_SA(1, 1), a1 + hstep, voffA);
            PG8_WAIT_V(8); PG8_WAIT_L(0); PG8_BAR; PG8_MMA(0, 0, At, B0); PG8_MMA(0, 1, At, B1); PG8_BAR; PG8_SCHED;
            PG8_LDA(At, 0, 1); PG8_STAGE(PG8_SB(0, 0), b2, voffB); PG8_STAGE(PG8_SB(0, 1), b2 + hstep, voffB); PG8_STAGE(PG8_SA(0, 0), a2, voffA);
            PG8_WAIT_V(8); PG8_WAIT_L(0); PG8_BAR; PG8_MMA(1, 0, At, B0); PG8_MMA(1, 1, At, B1); PG8_BAR; PG8_SCHED;
            PG8_LDB(B0, 1, 0); PG8_LDB(B1, 1, 1); PG8_SCHED; PG8_LDA(At, 1, 0); PG8_STAGE(PG8_SA(0, 1), a2 + hstep, voffA);
            PG8_WAIT_V(8); PG8_WAIT_L(0); PG8_BAR; PG8_MMA(0, 0, At, B0); PG8_MMA(0, 1, At, B1); PG8_BAR; PG8_SCHED;
            PG8_LDA(At, 1, 1); PG8_STAGE(PG8_SB(1, 0), b3, voffB); PG8_STAGE(PG8_SB(1, 1), b3 + hstep, voffB); PG8_STAGE(PG8_SA(1, 0), a3, voffA);
            PG8_WAIT_V(8); PG8_WAIT_L(0); PG8_BAR; PG8_MMA(1, 0, At, B0); PG8_MMA(1, 1, At, B1); PG8_BAR; PG8_SCHED;
            } else {
            PG8_LDB(B0, 0, 0); PG8_SCHED; PG8_LDA(At, 0, 0); PG8_STAGE(PG8_SA(1, 1), a1 + hstep, voffA);
            PG8_WAIT_L(8); PG8_BAR; PG8_WAIT_L(0); PG8_MMA(0, 0, At, B0); PG8_BAR; PG8_SCHED;
            PG8_LDB(B1, 0, 1); PG8_STAGE(PG8_SB(0, 0), b2, voffB);
            PG8_BAR; PG8_WAIT_L(0); PG8_MMA(0, 1, At, B1); PG8_BAR;
            PG8_LDA(At, 0, 1); PG8_STAGE(PG8_SA(0, 0), a2, voffA);
            PG8_BAR; PG8_WAIT_L(0); PG8_MMA(1, 0, At, B0); PG8_BAR; PG8_SCHED;
            PG8_STAGE(PG8_SB(0, 1), b2 + hstep, voffB);
            PG8_WAIT_V(6); PG8_BAR; PG8_MMA(1, 1, At, B1); PG8_BAR;
            PG8_LDB(B0, 1, 0); PG8_SCHED; PG8_LDA(At, 1, 0); PG8_STAGE(PG8_SA(0, 1), a2 + hstep, voffA);
            PG8_WAIT_L(8); PG8_BAR; PG8_WAIT_L(0); PG8_MMA(0, 0, At, B0); PG8_BAR; PG8_SCHED;
            PG8_LDB(B1, 1, 1); PG8_STAGE(PG8_SB(1, 0), b3, voffB);
            PG8_BAR; PG8_WAIT_L(0); PG8_MMA(0, 1, At, B1); PG8_BAR;
            PG8_LDA(At, 1, 1); PG8_STAGE(PG8_SA(1, 0), a3, voffA);
            PG8_BAR; PG8_WAIT_L(0); PG8_MMA(1, 0, At, B0); PG8_BAR; PG8_SCHED;
            PG8_STAGE(PG8_SB(1, 1), b3 + hstep, voffB);
            PG8_WAIT_V(6); PG8_BAR; PG8_MMA(1, 1, At, B1); PG8_BAR;
            }
        }
        if constexpr (ALIGN_EPI) { if (wr == 0) PG8_BAR; }
        if constexpr (!Epi::AFTER_DRAIN) { E(acc, cur, wr, wc, fr, fq); S.done(cur); }
        if (!has_next) break;
#pragma unroll
        for (int a = 0; a < 2; ++a)
#pragma unroll
            for (int b = 0; b < 2; ++b)
#pragma unroll
                for (int m = 0; m < 4; ++m)
#pragma unroll
                    for (int n = 0; n < 2; ++n) acc[a][b][m][n] = (f32x4){0.f, 0.f, 0.f, 0.f};
        cur = nxt; cA = nA; cB = nB; ++ui;
        if constexpr (ALIGN_EPI) { if (wr == 1) PG8_BAR; }
    }
    PG8_WAIT_V(0);
    if constexpr (!ALIGN_EPI) { if (wr == 0) PG8_BAR; }
    PG8_BAR;
    if constexpr (Epi::AFTER_DRAIN) { E.fused(acc, cur, wr, wc, fr, fq, lds, wid, lane); S.done(cur); }
#undef PG8_SA
#undef PG8_SB
#undef PG8_STAGE
#undef PG8_LDA
#undef PG8_LDB
#undef PG8_MMA
#undef PG8_WAIT_V
#undef PG8_WAIT_L
#undef PG8_BAR
#undef PG8_SCHED
}
}

constexpr int NWAVES = 8, NTHR = 512;
constexpr int D = 1024, NB = 8, SEQ = 4096, CTXL = 256, NL = 2;
constexpr int NLAT = NB * SEQ;
constexpr int NCTX = NB * CTXL;
constexpr int MT = NLAT + NCTX;
constexpr int INW = 2576, NEXP = 32, TOPK = 4;
constexpr int PMAX = (MT * TOPK / 256 + NEXP) * 256;
constexpr float EPS = 1e-6f;

constexpr size_t MiB = 1u << 20;
constexpr size_t WS_CTL = 0, CTL_ZERO_BYTES = 1 * MiB;
constexpr size_t WS_MODV = 1 * MiB;
constexpr size_t WS_WRT = 2 * MiB;
constexpr size_t WS_WABT = WS_WRT + 512 * 1024;
constexpr size_t WS_SELE = 3 * MiB;
constexpr size_t WS_SELP = WS_SELE + 640 * 1024;
constexpr size_t WS_SELG = WS_SELP + 640 * 1024;
constexpr size_t WS_G = 5 * MiB;
constexpr size_t WS_BETA = WS_G + 1536 * 1024;
constexpr size_t WS_AB = 8 * MiB;
constexpr size_t WS_WIN = 12 * MiB;
constexpr size_t WS_WOUT = 24 * MiB;
constexpr size_t WS_DFTM = 32 * MiB;
constexpr size_t WS_W1 = 96 * MiB;
constexpr size_t WS_W2 = 224 * MiB;
constexpr size_t WS_XC = 288 * MiB;
constexpr size_t WS_ACT = 296 * MiB;
constexpr size_t WS_S = 364 * MiB;
constexpr size_t WS_QKVZ = WS_S;
constexpr size_t WS_ZTL = WS_S + 136 * MiB;
constexpr size_t WS_ZTC = WS_ZTL + 64 * MiB;
constexpr size_t WS_QKVN = WS_ZTC + 4 * MiB;
constexpr size_t WS_OF = WS_QKVN + 102 * MiB;
constexpr size_t WS_OB = WS_OF + 34 * MiB;
constexpr size_t WS_XS = WS_S;
constexpr size_t WS_HS = WS_S + 288 * MiB;
constexpr size_t WS_END = 1024 * MiB;
static_assert(WS_OB + 34 * MiB <= WS_END && WS_HS + 288 * MiB <= WS_END && (size_t)PMAX * 1024 * 2 == 288 * MiB, "d_ws map");
static_assert((size_t)MT * 16 <= 640 * 1024 && (size_t)MT * 32 <= 1536 * 1024, "sel / g maps");
constexpr int CW_BAR = 4096;
constexpr int CW_GCNT = 16384;

constexpr int RING_BYTES = 131072;
constexpr int LDSCTL_OFF = RING_BYTES, MISC_OFF = LDSCTL_OFF + 320;
constexpr int XT_OFF = RING_BYTES + 1024;
constexpr int LDS_BYTES = 147456;

#define GAS __attribute__((address_space(1)))
#define LAS __attribute__((address_space(3)))
typedef unsigned short bf16;
typedef unsigned v4u __attribute__((ext_vector_type(4)));
typedef unsigned v2u __attribute__((ext_vector_type(2)));
typedef float f32x4 __attribute__((ext_vector_type(4)));
typedef GAS unsigned gu32;
#define RLX_AGENT __ATOMIC_RELAXED, __HIP_MEMORY_SCOPE_AGENT
#define LDS_WAIT() asm volatile("s_waitcnt lgkmcnt(0)" ::: "memory")
#define VM_WAIT() asm volatile("s_waitcnt vmcnt(0)" ::: "memory")
typedef float f32x2_t __attribute__((ext_vector_type(2))); typedef __bf16 bf16x2_t __attribute__((ext_vector_type(2)));
__device__ __forceinline__ unsigned pk2(float lo, float hi) { const f32x2_t v = {lo, hi}; const bf16x2_t b = __builtin_convertvector(v, bf16x2_t); return __builtin_bit_cast(unsigned, b); }
__device__ __forceinline__ unsigned f2bf(float f) { return pk2(f, 0.f) & 0xffffu; }
__device__ __forceinline__ float bflo(unsigned w) { return __builtin_bit_cast(float, w << 16); }
__device__ __forceinline__ float bfhi(unsigned w) { return __builtin_bit_cast(float, w & 0xffff0000u); }
__device__ __forceinline__ float wave_sum(float v) {
#pragma unroll
    for (int o = 1; o < 64; o <<= 1) v += __shfl_xor(v, o);
    return v;
}
__device__ __forceinline__ float sum16(float v) {
#pragma unroll
    for (int o = 1; o < 16; o <<= 1) v += __shfl_xor(v, o);
    return v;
}
__device__ __forceinline__ float rs32(float (&p)[32], int lane) {
#pragma unroll
    for (int e = 0; e < 16; ++e) { const bool up = (lane & 32) != 0; const float send = up ? p[e] : p[e + 16], keep = up ? p[e + 16] : p[e]; p[e] = keep + __shfl_xor(send, 32); }
#pragma unroll
    for (int e = 0; e < 8; ++e) { const bool up = (lane & 16) != 0; const float send = up ? p[e] : p[e + 8], keep = up ? p[e + 8] : p[e]; p[e] = keep + __shfl_xor(send, 16); }
#pragma unroll
    for (int e = 0; e < 4; ++e) { const bool up = (lane & 8) != 0; const float send = up ? p[e] : p[e + 4], keep = up ? p[e + 4] : p[e]; p[e] = keep + __shfl_xor(send, 8); }
#pragma unroll
    for (int e = 0; e < 2; ++e) { const bool up = (lane & 4) != 0; const float send = up ? p[e] : p[e + 2], keep = up ? p[e + 2] : p[e]; p[e] = keep + __shfl_xor(send, 4); }
    { const bool up = (lane & 2) != 0; const float send = up ? p[0] : p[1], keep = up ? p[1] : p[0]; p[0] = keep + __shfl_xor(send, 2); }
    return p[0] + __shfl_xor(p[0], 1);
}
__device__ __forceinline__ float rs16(float (&p)[16], int lane) {
#pragma unroll
    for (int e = 0; e < 8; ++e) { const bool up = (lane & 32) != 0; const float send = up ? p[e] : p[e + 8], keep = up ? p[e + 8] : p[e]; p[e] = keep + __shfl_xor(send, 32); }
#pragma unroll
    for (int e = 0; e < 4; ++e) { const bool up = (lane & 16) != 0; const float send = up ? p[e] : p[e + 4], keep = up ? p[e + 4] : p[e]; p[e] = keep + __shfl_xor(send, 16); }
#pragma unroll
    for (int e = 0; e < 2; ++e) { const bool up = (lane & 8) != 0; const float send = up ? p[e] : p[e + 2], keep = up ? p[e + 2] : p[e]; p[e] = keep + __shfl_xor(send, 8); }
    { const bool up = (lane & 4) != 0; const float send = up ? p[0] : p[1], keep = up ? p[1] : p[0]; p[0] = keep + __shfl_xor(send, 4); }
    float r = p[0] + __shfl_xor(p[0], 2);
    return r + __shfl_xor(r, 1);
}
__device__ __forceinline__ float silu_f(float x) { return x / (1.f + __expf(-x)); }

#define XB_TMO      128
#define XB_XCNT(j)  (256  + 64 * (j))
#define XB_XSUB(j)  (1280 + 64 * (j))
#define XB_XGEN(j)  (2304 + 64 * (j))
#define XB_TOP      3328
#define XB_TOPGEN   3392
#define XCD_BAR_WORDS 3456
#define XB_SPIN_CAP (1u << 18)
__device__ __forceinline__ unsigned xb_ld(unsigned* p)              { return __hip_atomic_load(p, __ATOMIC_RELAXED, __HIP_MEMORY_SCOPE_AGENT); }
__device__ __forceinline__ unsigned xb_add(unsigned* p, unsigned v) { return __hip_atomic_fetch_add(p, v, __ATOMIC_RELAXED, __HIP_MEMORY_SCOPE_AGENT); }
__device__ __forceinline__ unsigned xb_xcc_id() { return (unsigned)__builtin_amdgcn_s_getreg((3 << 11) | 20) & 0xFu; }
#define XB_SPIN(cond, bar) do { unsigned _sp = 0; while (cond) { __builtin_amdgcn_s_sleep(1); \
    if ((++_sp & 255u) == 0u) { if (xb_ld(&(bar)[XB_TMO])) break; if (_sp > XB_SPIN_CAP) { atomicAdd(&(bar)[XB_TMO], 1u); break; } } } } while (0)
struct XcdBarrier { unsigned* bar; unsigned x; volatile LAS unsigned* st; };
__device__ __forceinline__ XcdBarrier xcd_barrier_post(unsigned* bar, volatile LAS unsigned* st, int tid) {
    XcdBarrier b; b.bar = bar; b.x = xb_xcc_id(); b.st = st;
    if (tid == 0) (void)xb_add(&bar[XB_XCNT(b.x)], 1u);
    return b;
}
__device__ __forceinline__ void xcd_barrier_complete(unsigned* bar, unsigned x, unsigned& nloc, unsigned& nx) {
    const unsigned G = gridDim.x * gridDim.y * gridDim.z;
    unsigned sum, cnt, mine, sp = 0u;
    for (;;) {
        sum = 0u; cnt = 0u; mine = 0u;
#pragma unroll
        for (unsigned j = 0; j < 16; ++j) { const unsigned c = xb_ld(&bar[XB_XCNT(j)]); sum += c; cnt += (c > 0u) ? 1u : 0u; mine = (j == x) ? c : mine; }
        if (sum == G) break;
        __builtin_amdgcn_s_sleep(1);
        if ((++sp & 255u) == 0u) { if (xb_ld(&bar[XB_TMO])) break; if (sp > XB_SPIN_CAP) { atomicAdd(&bar[XB_TMO], 1u); break; } }
    }
    nloc = mine > 0u ? mine : 1u; nx = cnt > 0u ? cnt : 1u;
}
__device__ __forceinline__ void xcd_barrier(const XcdBarrier& b, int tid) {
    asm volatile("s_waitcnt vmcnt(0)" ::: "memory");
    __syncthreads();
    if (tid == 0) {
        unsigned* bar = b.bar; unsigned bx = b.x;
        asm volatile("" : "+v"(bar), "+v"(bx));
        __builtin_amdgcn_s_waitcnt(0);
        unsigned nloc = b.st[0], nx = b.st[1];
        if (nloc == 0u) { xcd_barrier_complete(bar, bx, nloc, nx); b.st[0] = nloc; b.st[1] = nx; }
        const unsigned old = xb_add(&bar[XB_XSUB(bx)], 1u);
        const unsigned gen = old / nloc;
        if (old + 1u == (gen + 1u) * nloc) {
            __builtin_amdgcn_fence(__ATOMIC_RELEASE, "agent");
            asm volatile("s_waitcnt vmcnt(0)" ::: "memory");
            const unsigned og = xb_add(&bar[XB_TOP], 1u);
            const unsigned tg = og / nx;
            if (og + 1u == (tg + 1u) * nx) xb_add(&bar[XB_TOPGEN], 1u);
            else XB_SPIN(xb_ld(&bar[XB_TOPGEN]) == tg, bar);
            __builtin_amdgcn_fence(__ATOMIC_ACQUIRE, "agent");
            xb_add(&bar[XB_XGEN(bx)], 1u);
            asm volatile("s_waitcnt vmcnt(0)" ::: "memory");
        } else {
            XB_SPIN(xb_ld(&bar[XB_XGEN(bx)]) == gen, bar);
            __builtin_amdgcn_fence(__ATOMIC_ACQUIRE, "agent");
            asm volatile("s_waitcnt vmcnt(0)" ::: "memory");
        }
    }
    __syncthreads();
}

struct Args { const float* in[23]; float* out; unsigned char* ws; int ph_lo, ph_hi; };
struct Frame {
    LAS unsigned char* lds;
    volatile LAS unsigned* MISC;
    unsigned* ctl;
    unsigned char* ws;
    int tid, lane, wave, vcu, G, gw, NGW;
    float* out;
};
typedef const Args __attribute__((address_space(4)))* KArgsP;
__device__ __forceinline__ KArgsP kargs() { unsigned long long v = (unsigned long long)__builtin_amdgcn_kernarg_segment_ptr(); asm volatile("" : "+s"(v)); return (KArgsP)v; }
enum InIdx { I_X = 0, I_C, I_CTX, I_CCTX, I_WMOD, I_BMOD, I_GN1, I_WIN, I_CONVW, I_ALOG, I_DTB, I_GOUT, I_WOUT, I_GN2, I_WR, I_BR, I_WG, I_BG, I_WU, I_BU, I_WD, I_BD, I_GF };
__device__ __forceinline__ float* xr_row(const Frame& F, int t) { return t < NLAT ? F.out + (size_t)t * D : (float*)(F.ws + WS_XC) + (size_t)(t - NLAT) * D; }
__device__ __forceinline__ int mod_row(int t) { return t < NLAT ? (t >> 12) : 8; }
__device__ __forceinline__ const float* modv(const Frame& F, int l, int r, int piece) { return (const float*)(F.ws + WS_MODV) + ((size_t)(l * 9 + r) * 6 + piece) * D; }

struct SchedIn {
    const bf16* hx; const bf16* win; int G, c;
    static constexpr int N0 = (MT / 256) * 8, N1 = 4 * (MT / 256), NWG = N0 + N1;
    __device__ __forceinline__ bool next(int i, pg8::Unit& u) const {
        const long L = (long)i * G + c; if (L >= NWG) return false;
        int w = pg8::xcd_remap((int)L, NWG);
        if (w < N0) { u.kind = 0; pg8::grp_decode(w, MT / 256, 8, u.pm, u.pn); } else { w -= N0; u.kind = 1; u.pn = w >> 2; u.pm = w & 3; }
        u.e = 0; return true;
    }
    __device__ __forceinline__ const char* a_base(const pg8::Unit& u, size_t tstep) const { return u.kind == 0 ? (const char*)hx + (size_t)u.pm * tstep : (const char*)win + (size_t)(8 + u.pm) * tstep; }
    __device__ __forceinline__ const char* b_base(const pg8::Unit& u, size_t tstep) const { return u.kind == 0 ? (const char*)win + (size_t)u.pn * tstep : (const char*)hx + (size_t)u.pn * tstep; }
    __device__ __forceinline__ void a_ready(const pg8::Unit&) const {}
    __device__ __forceinline__ void done(const pg8::Unit&) const {}
};
struct EpiIn {
    static constexpr bool PERM = true, AFTER_DRAIN = false;
    bf16* qkvz; bf16* ztl; bf16* ztc;
    __device__ __forceinline__ void operator()(const pg8::f32x4 (&acc)[2][2][4][2], const pg8::Unit& u, int wr, int wc, int fr_, int fq_) const {
        int fr = fr_, fq = fq_; asm volatile("" : "+v"(fr), "+v"(fq));
        const int row0 = u.pm * 256 + wr * 64 + fr, cin = wc * 32 + 8 * fq;
        bf16* base; size_t ldc;
        if (u.kind == 0) { base = qkvz + (size_t)u.pn * 256 + cin; ldc = 2048; }
        else if (u.pn < 128) { base = ztl + (size_t)(u.pn >> 4) * 1024 * 4096 + (size_t)(u.pn & 15) * 256 + cin; ldc = 4096; }
        else { base = ztc + (size_t)(u.pn - 128) * 1024 * 256 + cin; ldc = 256; }
#pragma unroll
        for (int ai = 0; ai < 2; ++ai)
#pragma unroll
            for (int m = 0; m < 4; ++m) { bf16* rowp = base + (size_t)(row0 + ai * 128 + m * 16) * ldc;
#pragma unroll
                for (int bj = 0; bj < 2; ++bj) { const pg8::f32x4 v0 = acc[ai][bj][m][0], v1 = acc[ai][bj][m][1]; pg8::u32x4 w;
                    w.x = pg8::cvt_pk_bf16(v0[0], v0[1]); w.y = pg8::cvt_pk_bf16(v0[2], v0[3]); w.z = pg8::cvt_pk_bf16(v1[0], v1[1]); w.w = pg8::cvt_pk_bf16(v1[2], v1[3]);
                    *(pg8::u32x4*)(rowp + bj * 128) = w; } }
    }
};
struct SchedDft {
    const bf16* dftm; const bf16* ztl; int G, c;
    __device__ __forceinline__ bool next(int i, pg8::Unit& u) const {
        const long L = (long)i * G + c; if (L >= 256) return false;
        const int w = pg8::xcd_remap((int)L, 256), x = w >> 5, j = w & 31, bp = j >> 2;
        u.pm = 4 * (x & 3) + (j & 3); u.e = 4 * (x >> 2) + (bp >> 1); u.pn = bp & 1; u.kind = 0; return true;
    }
    __device__ __forceinline__ const char* a_base(const pg8::Unit& u, size_t tstep) const { return (const char*)dftm + (size_t)u.pm * tstep; }
    __device__ __forceinline__ const char* b_base(const pg8::Unit& u, size_t tstep) const { return (const char*)ztl + (size_t)u.e * (512 * 8192 * 2) + (size_t)u.pn * tstep; }
    __device__ __forceinline__ void a_ready(const pg8::Unit&) const {}
    __device__ __forceinline__ void done(const pg8::Unit&) const {}
};
struct EpiDft {
    static constexpr bool PERM = true, AFTER_DRAIN = false;
    bf16* mix; float scale;
    __device__ __forceinline__ void operator()(const pg8::f32x4 (&acc)[2][2][4][2], const pg8::Unit& u, int wr, int wc, int fr_, int fq_) const {
        int fr = fr_, fq = fq_; asm volatile("" : "+v"(fr), "+v"(fq));
        const int row0 = u.e * SEQ + u.pm * 256 + wr * 64 + fr, col0 = u.pn * 256 + wc * 32 + 8 * fq;
#pragma unroll
        for (int ai = 0; ai < 2; ++ai)
#pragma unroll
            for (int m = 0; m < 4; ++m) { bf16* rowp = mix + (size_t)(row0 + ai * 128 + m * 16) * D + col0;
#pragma unroll
                for (int bj = 0; bj < 2; ++bj) { const pg8::f32x4 v0 = acc[ai][bj][m][0] * scale, v1 = acc[ai][bj][m][1] * scale; pg8::u32x4 w;
                    w.x = pg8::cvt_pk_bf16(v0[0], v0[1]); w.y = pg8::cvt_pk_bf16(v0[2], v0[3]); w.z = pg8::cvt_pk_bf16(v1[0], v1[1]); w.w = pg8::cvt_pk_bf16(v1[2], v1[3]);
                    *(pg8::u32x4*)(rowp + bj * 128) = w; } }
    }
};
struct SchedOut {
    const bf16* mix; const bf16* wout; int nM, G, c;
    __device__ __forceinline__ bool next(int i, pg8::Unit& u) const {
        const int nwg = nM * 4; const long L = (long)i * G + c; if (L >= nwg) return false;
        pg8::grp_decode(pg8::xcd_remap((int)L, nwg), nM, 4, u.pm, u.pn); u.kind = 0; u.e = 0; return true;
    }
    __device__ __forceinline__ const char* a_base(const pg8::Unit& u, size_t tstep) const { return (const char*)mix + (size_t)u.pm * tstep; }
    __device__ __forceinline__ const char* b_base(const pg8::Unit& u, size_t tstep) const { return (const char*)wout + (size_t)u.pn * tstep; }
    __device__ __forceinline__ void a_ready(const pg8::Unit&) const {}
    __device__ __forceinline__ void done(const pg8::Unit&) const {}
};
struct EpiOut {
    static constexpr bool PERM = false, AFTER_DRAIN = false;
    float* xlat; float* xctx; const float* gt1; float dsc;
    __device__ __forceinline__ void operator()(const pg8::f32x4 (&acc)[2][2][4][2], const pg8::Unit& u, int wr, int wc, int fr_, int fq_) const {
        int fr = fr_, fq = fq_; asm volatile("" : "+v"(fr), "+v"(fq));
        const int col0 = u.pn * 256 + wc * 32 + 4 * fq, rl = wr * 64 + fr;
        float* xb = u.pm < 128 ? xlat + (size_t)u.pm * 256 * D : xctx + (size_t)(u.pm - 128) * 256 * D;
        const float* g = gt1 + (size_t)(u.pm < 128 ? (u.pm >> 4) : 8) * 6 * D + col0;
        pg8::f32x4 gv[2][2];
#pragma unroll
        for (int bj = 0; bj < 2; ++bj)
#pragma unroll
            for (int n = 0; n < 2; ++n) gv[bj][n] = *(const pg8::f32x4*)(g + bj * 128 + n * 16);
#pragma unroll
        for (int ai = 0; ai < 2; ++ai)
#pragma unroll
            for (int m = 0; m < 4; ++m) { float* rowp = xb + (size_t)(rl + ai * 128 + m * 16) * D + col0;
#pragma unroll
                for (int bj = 0; bj < 2; ++bj)
#pragma unroll
                    for (int n = 0; n < 2; ++n) { pg8::f32x4* p = (pg8::f32x4*)(rowp + bj * 128 + n * 16); const pg8::f32x4 xo = *p; *p = xo + gv[bj][n] * acc[ai][bj][m][n] * dsc; }
                if (m & 1) asm volatile("" ::: "memory"); }
    }
};
struct SchedMoe {
    const bf16* A; const bf16* W; size_t wstride; const LAS int* pend; int nM, nN, G, c;
    __device__ __forceinline__ bool next(int i, pg8::Unit& u) const {
        const int nwg = nM * nN; const long L = (long)i * G + c; if (L >= nwg) return false;
        pg8::grp_decode(pg8::xcd_remap((int)L, nwg), nM, nN, u.pm, u.pn);
        int e = 0;
#pragma unroll 1
        for (int j = 0; j < NEXP - 1; ++j) e += (pend[j] <= u.pm) ? 1 : 0;
        u.e = e; u.kind = 0; return true;
    }
    __device__ __forceinline__ const char* a_base(const pg8::Unit& u, size_t tstep) const { return (const char*)A + (size_t)u.pm * tstep; }
    __device__ __forceinline__ const char* b_base(const pg8::Unit& u, size_t tstep) const { return (const char*)W + (size_t)u.e * wstride + (size_t)u.pn * tstep; }
    __device__ __forceinline__ void a_ready(const pg8::Unit&) const {}
    __device__ __forceinline__ void done(const pg8::Unit&) const {}
};
struct EpiSwiglu {
    static constexpr bool PERM = true, AFTER_DRAIN = false;
    bf16* hs; const float* bg; const float* bu;
    __device__ __forceinline__ void operator()(const pg8::f32x4 (&acc)[2][2][4][2], const pg8::Unit& u, int wr, int wc, int fr_, int fq_) const {
        int fr = fr_, fq = fq_; asm volatile("" : "+v"(fr), "+v"(fq));
        const int row0 = u.pm * 256 + wr * 64 + fr, f0 = u.pn * 128 + wc * 32 + 8 * fq;
        const pg8::f32x4 bg0 = *(const pg8::f32x4*)(bg + u.e * D + f0), bg1 = *(const pg8::f32x4*)(bg + u.e * D + f0 + 4);
        const pg8::f32x4 bu0 = *(const pg8::f32x4*)(bu + u.e * D + f0), bu1 = *(const pg8::f32x4*)(bu + u.e * D + f0 + 4);
#pragma unroll
        for (int ai = 0; ai < 2; ++ai)
#pragma unroll
            for (int m = 0; m < 4; ++m) {
                float h[8];
#pragma unroll
                for (int n = 0; n < 2; ++n) { const pg8::f32x4 ga = acc[ai][0][m][n] + (n ? bg1 : bg0), ua = acc[ai][1][m][n] + (n ? bu1 : bu0);
#pragma unroll
                    for (int j = 0; j < 4; ++j) { const float a = fminf(ga[j], 7.0f), uu = fminf(fmaxf(ua[j], -7.0f), 7.0f);
                        h[n * 4 + j] = a * __builtin_amdgcn_rcpf(1.0f + __expf(-1.702f * a)) * (uu + 1.0f); } }
                pg8::u32x4 w; w.x = pg8::cvt_pk_bf16(h[0], h[1]); w.y = pg8::cvt_pk_bf16(h[2], h[3]); w.z = pg8::cvt_pk_bf16(h[4], h[5]); w.w = pg8::cvt_pk_bf16(h[6], h[7]);
                *(pg8::u32x4*)(hs + (size_t)(row0 + ai * 128 + m * 16) * D + f0) = w; }
    }
};
struct EpiDown {
    static constexpr bool PERM = true, AFTER_DRAIN = false;
    bf16* ys; const float* bd;
    __device__ __forceinline__ void operator()(const pg8::f32x4 (&acc)[2][2][4][2], const pg8::Unit& u, int wr, int wc, int fr_, int fq_) const {
        int fr = fr_, fq = fq_; asm volatile("" : "+v"(fr), "+v"(fq));
        const int row0 = u.pm * 256 + wr * 64 + fr, col0 = u.pn * 256 + wc * 32 + 8 * fq;
        pg8::f32x4 bv[2][2];
#pragma unroll
        for (int bj = 0; bj < 2; ++bj)
#pragma unroll
            for (int n = 0; n < 2; ++n) bv[bj][n] = *(const pg8::f32x4*)(bd + u.e * D + col0 + bj * 128 + 4 * n);
#pragma unroll
        for (int ai = 0; ai < 2; ++ai)
#pragma unroll
            for (int m = 0; m < 4; ++m) { bf16* rowp = ys + (size_t)(row0 + ai * 128 + m * 16) * D + col0;
#pragma unroll
                for (int bj = 0; bj < 2; ++bj) { const pg8::f32x4 v0 = acc[ai][bj][m][0] + bv[bj][0], v1 = acc[ai][bj][m][1] + bv[bj][1]; pg8::u32x4 w;
                    w.x = pg8::cvt_pk_bf16(v0[0], v0[1]); w.y = pg8::cvt_pk_bf16(v0[2], v0[3]); w.z = pg8::cvt_pk_bf16(v1[0], v1[1]); w.w = pg8::cvt_pk_bf16(v1[2], v1[3]);
                    *(pg8::u32x4*)(rowp + bj * 128) = w; } }
    }
};

__device__ __forceinline__ void transpose_item(const float* W, int ldw, int col0, int K, bf16* WT, int drow0, LAS float* scr, int kb, int lane) {
    const int k0 = 64 * kb;
#pragma unroll 8
    for (int i = 0; i < 32; ++i) { const int kk = 2 * i + (lane >> 5); scr[kk * 33 + (lane & 31)] = W[(size_t)(k0 + kk) * ldw + col0 + (lane & 31)]; }
    LDS_WAIT(); asm volatile("" ::: "memory");
    const int c = lane & 7;
#pragma unroll
    for (int j = 0; j < 4; ++j) { const int n = (lane >> 3) + 8 * j; const LAS float* s = scr + (8 * c) * 33 + n;
        v4u o; o.x = pk2(s[0 * 33], s[1 * 33]); o.y = pk2(s[2 * 33], s[3 * 33]); o.z = pk2(s[4 * 33], s[5 * 33]); o.w = pk2(s[6 * 33], s[7 * 33]);
        *(v4u*)(WT + (size_t)(drow0 + n) * K + k0 + 8 * c) = o; }
    LDS_WAIT(); asm volatile("" ::: "memory");
}
__device__ __forceinline__ void convert_experts(const Frame& F, int l) {
    const KArgsP A = kargs();
    LAS float* scr = (LAS float*)(F.lds + F.wave * 16384);
    bf16* W1 = (bf16*)(F.ws + WS_W1); bf16* W2 = (bf16*)(F.ws + WS_W2);
    constexpr int IPM = 16 * 32;
    for (int it = F.gw; it < 3 * NEXP * IPM; it += F.NGW) {
        const int which = it / (NEXP * IPM), r = it % (NEXP * IPM), e = r / IPM, q = r % IPM, kb = q >> 5, nb = q & 31;
        const size_t moff = ((size_t)l * NEXP + e) * D * D;
        if (which == 0) transpose_item(A->in[I_WG] + moff, D, nb * 32, D, W1 + (size_t)e * 2048 * D, 256 * (nb >> 2) + 32 * (nb & 3), scr, kb, F.lane);
        else if (which == 1) transpose_item(A->in[I_WU] + moff, D, nb * 32, D, W1 + (size_t)e * 2048 * D, 256 * (nb >> 2) + 128 + 32 * (nb & 3), scr, kb, F.lane);
        else transpose_item(A->in[I_WD] + moff, D, nb * 32, D, W2 + (size_t)e * D * D, nb * 32, scr, kb, F.lane);
    }
}
__device__ __forceinline__ void p0_prologue(const Frame& F) {
    const KArgsP A = kargs();
    float* mv = (float*)(F.ws + WS_MODV);
    {
        LAS float* sc = (LAS float*)F.lds;
        LAS float* red = sc + 9 * 1024;
        for (int i = F.tid; i < 9 * 1024; i += NTHR) { const int r = i >> 10, k = i & 1023; sc[i] = silu_f(r < 8 ? A->in[I_C][r * D + k] : A->in[I_CCTX][k]); }
        __syncthreads();
        for (int item = blockIdx.x; item < 192; item += F.G) {
            const int l = item / 96, cg = item % 96, cl = F.tid & 63, ks = F.tid >> 6;
            const float* w = A->in[I_WMOD] + ((size_t)l * D + ks * 128) * 6144 + cg * 64 + cl;
            float a[9];
#pragma unroll
            for (int r = 0; r < 9; ++r) a[r] = 0.f;
#pragma unroll 4
            for (int k = 0; k < 128; ++k) { const float wv = w[(size_t)k * 6144];
#pragma unroll
                for (int r = 0; r < 9; ++r) a[r] += sc[r * 1024 + ks * 128 + k] * wv; }
#pragma unroll
            for (int r = 0; r < 9; ++r) red[(ks * 9 + r) * 64 + cl] = a[r];
            __syncthreads();
            for (int i = F.tid; i < 9 * 64; i += NTHR) { const int r = i >> 6, cc = i & 63; float s = 0.f;
#pragma unroll
                for (int k2 = 0; k2 < 8; ++k2) s += red[(k2 * 9 + r) * 64 + cc];
                mv[(size_t)(l * 9 + r) * 6144 + cg * 64 + cc] = s + A->in[I_BMOD][l * 6144 + cg * 64 + cc]; }
            __syncthreads();
        }
    }
    {
        LAS float* T = (LAS float*)F.lds;
        LAS float* cs = T + 64 * 129; LAS float* sn = cs + 128;
        __syncthreads();
        if (F.tid < 128) { cs[F.tid] = cospif((float)F.tid * (1.0f / 64.0f)); sn[F.tid] = sinpif((float)F.tid * (1.0f / 64.0f)); }
        for (int item = (blockIdx.x + 64) % F.G; item < 128; item += F.G) {
            const int l = item >> 6, kg = (item & 63) >> 2, g = item & 3;
            __syncthreads();
            for (int i = F.tid; i < 64 * 128; i += NTHR) { const int kk = i >> 7, cc = i & 127; T[kk * 129 + cc] = A->in[I_WIN][((size_t)l * D + kg * 64 + kk) * INW + g * 128 + cc]; }
            __syncthreads();
            const int kk = F.tid & 63, ng = F.tid >> 6;
            bf16* dst = (bf16*)(F.ws + WS_WIN) + ((size_t)l * 3072 + 2048 + g * 256) * D + kg * 64 + kk;
#pragma unroll 1
            for (int nn = 0; nn < 32; ++nn) { const int np = ng * 32 + nn, cp = np >> 1; float s = 0.f;
                if (np & 1) {
#pragma unroll 8
                    for (int cc = 0; cc < 128; ++cc) s -= T[kk * 129 + cc] * sn[(cc * cp) & 127]; }
                else {
#pragma unroll 8
                    for (int cc = 0; cc < 128; ++cc) s += T[kk * 129 + cc] * cs[(cc * cp) & 127]; }
                dst[(size_t)np * D] = (bf16)f2bf(s); }
        }
        __syncthreads();
    }
    {
        LAS float* scr = (LAS float*)(F.lds + F.wave * 16384);
        constexpr int I_IN = 16 * 64, I_OUT = 16 * 32;
        for (int it = F.gw; it < NL * (I_IN + I_OUT); it += F.NGW) {
            const int l = it / (I_IN + I_OUT), r = it % (I_IN + I_OUT);
            if (r < I_IN) transpose_item(A->in[I_WIN] + (size_t)l * D * INW, INW, 512 + 32 * (r & 63), D, (bf16*)(F.ws + WS_WIN) + (size_t)l * 3072 * D, 32 * (r & 63), scr, r >> 6, F.lane);
            else { const int q = r - I_IN; transpose_item(A->in[I_WOUT] + (size_t)l * D * D, D, 32 * (q & 31), D, (bf16*)(F.ws + WS_WOUT) + (size_t)l * D * D, 32 * (q & 31), scr, q >> 5, F.lane); }
        }
    }
    convert_experts(F, 0);
    {
        const int gt = F.gw * 64 + F.lane, NT = F.NGW * 64;
        float* wrt = (float*)(F.ws + WS_WRT); float* wabt = (float*)(F.ws + WS_WABT);
        for (int i = gt; i < NL * NEXP * D; i += NT) { const int l = i >> 15, e = (i >> 10) & 31, c = i & 1023; wrt[i] = A->in[I_WR][((size_t)l * D + c) * NEXP + e]; }
        for (int i = gt; i < NL * 16 * D; i += NT) { const int l = i >> 14, j = (i >> 10) & 15, c = i & 1023; wabt[i] = A->in[I_WIN][((size_t)l * D + c) * INW + 2560 + j]; }
        bf16* dm = (bf16*)(F.ws + WS_DFTM);
        for (int i = gt; i < 4096 * 1024; i += NT) { const int kf = i >> 10, j0 = (i & 1023) * 8; float v[8];
#pragma unroll
            for (int jj = 0; jj < 8; ++jj) { const int j = j0 + jj; const float a = (float)((kf * (j & 4095)) & 4095) * (1.0f / 2048.0f); v[jj] = j < 4096 ? cospif(a) : sinpif(a); }
            v4u o; o.x = pk2(v[0], v[1]); o.y = pk2(v[2], v[3]); o.z = pk2(v[4], v[5]); o.w = pk2(v[6], v[7]);
            *(v4u*)(dm + (size_t)kf * 8192 + j0) = o; }
    }
}

template <int MODE>
__device__ __forceinline__ void row_pass(const Frame& F, int l_cur, int l_nxt, bool dummy = false) {
    const KArgsP A = kargs();
    LAS float* wl = (LAS float*)F.lds;
    if (MODE != 2) { const f32x4* src = (const f32x4*)((const float*)(F.ws + WS_WABT) + (size_t)l_nxt * 16 * D);
        for (int i = F.tid; i < 16 * D / 4; i += NTHR) ((LAS f32x4*)wl)[i] = src[i];
        __syncthreads(); }
    const int nrows = MODE == 2 ? NLAT : MT;
    const int* sele = (const int*)(F.ws + WS_SELE); const int* selp = (const int*)(F.ws + WS_SELP); const float* selg = (const float*)(F.ws + WS_SELG);
    const bf16* ys = (const bf16*)(F.ws + WS_XS);
    bf16* hx = (bf16*)(F.ws + WS_ACT); float* ab = (float*)(F.ws + WS_AB);
    for (int t = F.gw; t < nrows; t += F.NGW) {
        const int r = mod_row(t);
        f32x4 v[4];
        float* xr = xr_row(F, t);
        if (MODE == 0) { const float* xin = t < NLAT ? A->in[I_X] + (size_t)t * D : A->in[I_CTX] + (size_t)(t - NLAT) * D;
#pragma unroll
            for (int j = 0; j < 4; ++j) v[j] = *((const f32x4*)xin + F.lane + 64 * j);
        } else {
#pragma unroll
            for (int j = 0; j < 4; ++j) v[j] = *((const f32x4*)xr + F.lane + 64 * j);
            f32x4 y[4];
#pragma unroll
            for (int j = 0; j < 4; ++j) y[j] = (f32x4){0.f, 0.f, 0.f, 0.f};
            (void)sele;
#pragma unroll
            for (int k = 0; k < 4; ++k) { const int dst = selp[t * 4 + k]; const float gk = selg[t * 4 + k]; const v2u* yr = (const v2u*)(ys + (size_t)dst * D) + F.lane;
#pragma unroll
                for (int j = 0; j < 4; ++j) { const v2u w = yr[64 * j]; y[j] += gk * (f32x4){bflo(w.x), bfhi(w.x), bflo(w.y), bfhi(w.y)}; } }
            const f32x4* g2 = (const f32x4*)modv(F, l_cur, r, 5) + F.lane;
#pragma unroll
            for (int j = 0; j < 4; ++j) v[j] += g2[64 * j] * y[j];
        }
        if (MODE != 2 && !dummy) {
#pragma unroll
            for (int j = 0; j < 4; ++j) *((f32x4*)xr + F.lane + 64 * j) = v[j];
        }
        float ss = 0.f;
#pragma unroll
        for (int j = 0; j < 4; ++j) ss += (v[j].x * v[j].x + v[j].y * v[j].y) + (v[j].z * v[j].z + v[j].w * v[j].w);
        const float rstd = 1.0f / sqrtf(wave_sum(ss) * (1.0f / D) + EPS);
        if (MODE == 2) {
            const f32x4* gf = (const f32x4*)A->in[I_GF] + F.lane;
#pragma unroll
            for (int j = 0; j < 4; ++j) *((f32x4*)(F.out + (size_t)t * D) + F.lane + 64 * j) = v[j] * rstd * gf[64 * j];
        } else {
            const f32x4* g1 = (const f32x4*)(A->in[I_GN1] + (size_t)l_nxt * D) + F.lane;
            const f32x4* sh = (const f32x4*)modv(F, l_nxt, r, 0) + F.lane; const f32x4* scl = (const f32x4*)modv(F, l_nxt, r, 1) + F.lane;
            v2u* ho = (v2u*)(hx + (size_t)t * D) + F.lane;
#pragma unroll
            for (int j = 0; j < 4; ++j) { v[j] = v[j] * rstd * g1[64 * j] * (scl[64 * j] + 1.0f) + sh[64 * j]; v2u w; w.x = pk2(v[j].x, v[j].y); w.y = pk2(v[j].z, v[j].w); ho[64 * j] = w; }
            float pp[16];
            int lofs = F.lane; asm volatile("" : "+v"(lofs));
#pragma unroll
            for (int jj = 0; jj < 16; ++jj) { float p = 0.f;
#pragma unroll
                for (int j = 0; j < 4; ++j) { const f32x4 w = ((const LAS f32x4*)(wl + jj * D))[lofs + 64 * j]; p += (v[j].x * w.x + v[j].y * w.y) + (v[j].z * w.z + v[j].w * w.w); }
                pp[jj] = p; if ((jj & 3) == 3) asm volatile("" ::: "memory"); }
            const float mine = rs16(pp, F.lane);
            if ((F.lane & 3) == 0) ab[(size_t)t * 16 + (F.lane >> 2)] = mine;
        }
    }
}

__device__ __forceinline__ int seq_id(int x) { return x < 0 ? -1 : (x < NLAT ? (x >> 12) : (x < MT ? 8 + ((x - NLAT) >> 8) : -2)); }
__device__ __forceinline__ void conv_phase(const Frame& F, int l) {
    const KArgsP A = kargs();
    LAS float* cw = (LAS float*)F.lds;
    for (int i = F.tid; i < 5 * 1536; i += NTHR) cw[i] = A->in[I_CONVW][(size_t)l * 5 * 1536 + i];
    __syncthreads();
    const bf16* qkvz = (const bf16*)(F.ws + WS_QKVZ); bf16* qkvn = (bf16*)(F.ws + WS_QKVN);
    const float* ab = (const float*)(F.ws + WS_AB); float* gb = (float*)(F.ws + WS_G); float* bb = (float*)(F.ws + WS_BETA);
    constexpr int RUN = MT / (256 * NWAVES);
    static_assert(RUN * 256 * NWAVES == MT, "conv runs");
    for (int run = F.gw; run < MT / RUN; run += F.NGW) {
        const int t0 = run * RUN;
        v4u W[5][3];
#pragma unroll
        for (int k = 0; k < 5; ++k) { const int g = t0 + k - 2, gc = g < 0 ? 0 : (g >= MT ? MT - 1 : g);
#pragma unroll
            for (int q = 0; q < 3; ++q) W[k][q] = *(const v4u*)(qkvz + (size_t)gc * 2048 + q * 512 + 8 * F.lane); }
#pragma unroll 1
        for (int t = t0; t < t0 + RUN; ++t) {
            v4u N[3];
            { const int g = t + 3, gc = g >= MT ? MT - 1 : g;
#pragma unroll
              for (int q = 0; q < 3; ++q) N[q] = *(const v4u*)(qkvz + (size_t)gc * 2048 + q * 512 + 8 * F.lane); }
            const int sid = seq_id(t);
            float a[3][8];
#pragma unroll
            for (int q = 0; q < 3; ++q)
#pragma unroll
                for (int i = 0; i < 8; ++i) a[q][i] = 0.f;
#pragma unroll
            for (int tap = 0; tap < 5; ++tap) { const float vm = (seq_id(t + tap - 2) == sid) ? 1.0f : 0.0f;
#pragma unroll
                for (int q = 0; q < 3; ++q) { const v4u u = W[tap][q];
                    const LAS f32x4* wp = (const LAS f32x4*)(cw + tap * 1536 + q * 512 + 8 * F.lane); const f32x4 w0 = wp[0] * vm, w1 = wp[1] * vm;
                    a[q][0] += bflo(u.x) * w0.x; a[q][1] += bfhi(u.x) * w0.y; a[q][2] += bflo(u.y) * w0.z; a[q][3] += bfhi(u.y) * w0.w;
                    a[q][4] += bflo(u.z) * w1.x; a[q][5] += bfhi(u.z) * w1.y; a[q][6] += bflo(u.w) * w1.z; a[q][7] += bfhi(u.w) * w1.w; } }
#pragma unroll
            for (int q = 0; q < 3; ++q) { float ss = 0.f;
#pragma unroll
                for (int i = 0; i < 8; ++i) { a[q][i] = silu_f(a[q][i]); ss += a[q][i] * a[q][i]; }
                float sc = 1.0f;
                if (q < 2) { ss = sum16(ss); sc = (1.0f / sqrtf(ss + EPS)) * (q == 0 ? 0.08838834764831845f : 1.0f); }
                v4u o; o.x = pk2(a[q][0] * sc, a[q][1] * sc); o.y = pk2(a[q][2] * sc, a[q][3] * sc); o.z = pk2(a[q][4] * sc, a[q][5] * sc); o.w = pk2(a[q][6] * sc, a[q][7] * sc);
                *(v4u*)(qkvn + (size_t)t * 1536 + q * 512 + 8 * F.lane) = o; }
            if (F.lane < 8) { const int d = F.lane >> 2, h = F.lane & 3;
                const float xg = ab[(size_t)t * 16 + d * 8 + h] + A->in[I_DTB][l * 8 + d * 4 + h];
                const float sp = xg > 20.f ? xg : log1pf(expf(xg));
                gb[(size_t)t * 8 + F.lane] = -expf(A->in[I_ALOG][l * 8 + d * 4 + h]) * sp;
                bb[(size_t)t * 8 + F.lane] = 1.0f / (1.0f + expf(-ab[(size_t)t * 16 + d * 8 + 4 + h])); }
#pragma unroll
            for (int q = 0; q < 3; ++q) { W[0][q] = W[1][q]; W[1][q] = W[2][q]; W[2][q] = W[3][q]; W[3][q] = W[4][q]; W[4][q] = N[q]; }
        }
    }
}

__device__ __forceinline__ void ctx_dft(const Frame& F) {
    LAS float* cs = (LAS float*)F.lds;
    LAS float* sn = cs + 256;
    __syncthreads();
    if (F.tid < 256) { cs[F.tid] = cospif((float)F.tid * (1.0f / 128.0f)); sn[F.tid] = sinpif((float)F.tid * (1.0f / 128.0f)); }
    __syncthreads();
    const bf16* ztc = (const bf16*)(F.ws + WS_ZTC); bf16* mix = (bf16*)(F.ws + WS_ACT);
    const float scale = 1.0f / sqrtf(256.0f * 128.0f);
    const int gt = F.gw * 64 + F.lane, NT = F.NGW * 64;
    for (int i = gt; i < NCTX * 512; i += NT) {
        const int c = i & 511, lp = (i >> 9) & 255, b = i >> 17;
        const bf16* z = ztc + ((size_t)b * 512 + c) * 512;
        float s = 0.f;
#pragma unroll 4
        for (int l = 0; l < 256; l += 2) { const unsigned zr = *(const unsigned*)(z + l), zi = *(const unsigned*)(z + 256 + l);
            const int i0 = (l * lp) & 255, i1 = ((l + 1) * lp) & 255;
            s += bflo(zr) * cs[i0] + bflo(zi) * sn[i0] + bfhi(zr) * cs[i1] + bfhi(zi) * sn[i1]; }
        mix[(size_t)(NLAT + b * 256 + lp) * D + c] = (bf16)f2bf(s * scale);
    }
}

__device__ __forceinline__ void scan_naive(const Frame& F, int l) {
    LAS float* kL = (LAS float*)F.lds;
    LAS float* qL = kL + 64 * 128;
    LAS float* vL = qL + 64 * 128;
    LAS float* oL = vL + 64 * 32;
    LAS float* gL = oL + 64 * 32;
    LAS float* bL = gL + 64;
    const bf16* qkvn = (const bf16*)(F.ws + WS_QKVN);
    const float* gb = (const float*)(F.ws + WS_G); const float* bb = (const float*)(F.ws + WS_BETA);
    for (int unit = F.vcu; unit < 256; unit += F.G) {
        const int qd = unit & 3, s = unit >> 2, d = s & 1, h = (s >> 1) & 3, b = s >> 3;
        bf16* od = (bf16*)(F.ws + (d ? WS_OB : WS_OF));
        const int j = F.tid >> 4, rg = F.tid & 15;
        float S[8];
#pragma unroll
        for (int i = 0; i < 8; ++i) S[i] = 0.f;
#pragma unroll 1
        for (int ci = 0; ci < 68; ++ci) {
            int rowbase; const bool isctx = ci < 4;
            if (isctx) rowbase = NLAT + b * 256 + (d ? 3 - ci : ci) * 64; else { const int lc = ci - 4; rowbase = b * SEQ + (d ? 63 - lc : lc) * 64; }
            __syncthreads();
            for (int i = F.tid; i < 64 * 16; i += NTHR) { const int r = i >> 4, g8 = i & 15; const bf16* rp = qkvn + (size_t)(rowbase + r) * 1536 + h * 128 + g8 * 8;
                const v4u q = *(const v4u*)rp, k = *(const v4u*)(rp + 512);
                LAS float* qo = qL + r * 128 + g8 * 8; LAS float* ko = kL + r * 128 + g8 * 8;
                qo[0] = bflo(q.x); qo[1] = bfhi(q.x); qo[2] = bflo(q.y); qo[3] = bfhi(q.y); qo[4] = bflo(q.z); qo[5] = bfhi(q.z); qo[6] = bflo(q.w); qo[7] = bfhi(q.w);
                ko[0] = bflo(k.x); ko[1] = bfhi(k.x); ko[2] = bflo(k.y); ko[3] = bfhi(k.y); ko[4] = bflo(k.z); ko[5] = bfhi(k.z); ko[6] = bflo(k.w); ko[7] = bfhi(k.w); }
            if (F.tid < 256) { const int r = F.tid >> 2, g8 = F.tid & 3; const v4u v = *(const v4u*)(qkvn + (size_t)(rowbase + r) * 1536 + 1024 + h * 128 + qd * 32 + g8 * 8);
                LAS float* vo = vL + r * 32 + g8 * 8;
                vo[0] = bflo(v.x); vo[1] = bfhi(v.x); vo[2] = bflo(v.y); vo[3] = bfhi(v.y); vo[4] = bflo(v.z); vo[5] = bfhi(v.z); vo[6] = bflo(v.w); vo[7] = bfhi(v.w); }
            else if (F.tid < 320) { const int r = F.tid - 256; gL[r] = __expf(gb[(size_t)(rowbase + r) * 8 + d * 4 + h]); bL[r] = bb[(size_t)(rowbase + r) * 8 + d * 4 + h]; }
            __syncthreads();
#pragma unroll 2
            for (int st = 0; st < 64; ++st) {
                const int r = d ? 63 - st : st;
                const float alpha = gL[r], bt = bL[r];
                const f32x4 k0 = *(const LAS f32x4*)(kL + r * 128 + rg * 8), k1 = *(const LAS f32x4*)(kL + r * 128 + rg * 8 + 4);
                const f32x4 q0 = *(const LAS f32x4*)(qL + r * 128 + rg * 8), q1 = *(const LAS f32x4*)(qL + r * 128 + rg * 8 + 4);
                float part = (k0.x * S[0] + k0.y * S[1]) + (k0.z * S[2] + k0.w * S[3]) + (k1.x * S[4] + k1.y * S[5]) + (k1.z * S[6] + k1.w * S[7]);
                part = sum16(part);
                const float dl = bt * (vL[r * 32 + j] - alpha * part);
                S[0] = alpha * S[0] + k0.x * dl; S[1] = alpha * S[1] + k0.y * dl; S[2] = alpha * S[2] + k0.z * dl; S[3] = alpha * S[3] + k0.w * dl;
                S[4] = alpha * S[4] + k1.x * dl; S[5] = alpha * S[5] + k1.y * dl; S[6] = alpha * S[6] + k1.z * dl; S[7] = alpha * S[7] + k1.w * dl;
                float op = (q0.x * S[0] + q0.y * S[1]) + (q0.z * S[2] + q0.w * S[3]) + (q1.x * S[4] + q1.y * S[5]) + (q1.z * S[6] + q1.w * S[7]);
                op = sum16(op);
                if (rg == 0) oL[r * 32 + j] = op;
            }
            __syncthreads();
            if (!(isctx && l == NL - 1)) { const int r = F.tid >> 3, g4 = F.tid & 7; const LAS float* op = oL + r * 32 + g4 * 4;
                v2u w; w.x = pk2(op[0], op[1]); w.y = pk2(op[2], op[3]);
                *(v2u*)(od + (size_t)(rowbase + r) * 512 + h * 128 + qd * 32 + g4 * 4) = w; }
        }
        __syncthreads();
    }
}

__device__ __forceinline__ void gated_out(const Frame& F, int l) {
    const KArgsP A = kargs();
    const bf16* of = (const bf16*)(F.ws + WS_OF); const bf16* ob = (const bf16*)(F.ws + WS_OB); const bf16* qkvz = (const bf16*)(F.ws + WS_QKVZ);
    bf16* mix = (bf16*)(F.ws + WS_ACT);
    const int nrows = l == NL - 1 ? NLAT : MT;
    const f32x4 g0 = *(const f32x4*)(A->in[I_GOUT] + l * 128 + (F.lane & 15) * 8), g1 = *(const f32x4*)(A->in[I_GOUT] + l * 128 + (F.lane & 15) * 8 + 4);
    for (int t = F.gw; t < nrows; t += F.NGW) {
        const v4u a = *(const v4u*)(of + (size_t)t * 512 + 8 * F.lane), b = *(const v4u*)(ob + (size_t)t * 512 + 8 * F.lane), z = *(const v4u*)(qkvz + (size_t)t * 2048 + 1536 + 8 * F.lane);
        float o[8] = {bflo(a.x) + bflo(b.x), bfhi(a.x) + bfhi(b.x), bflo(a.y) + bflo(b.y), bfhi(a.y) + bfhi(b.y), bflo(a.z) + bflo(b.z), bfhi(a.z) + bfhi(b.z), bflo(a.w) + bflo(b.w), bfhi(a.w) + bfhi(b.w)};
        const float zz[8] = {bflo(z.x), bfhi(z.x), bflo(z.y), bfhi(z.y), bflo(z.z), bfhi(z.z), bflo(z.w), bfhi(z.w)};
        const float gg[8] = {g0.x, g0.y, g0.z, g0.w, g1.x, g1.y, g1.z, g1.w};
        float ss = 0.f;
#pragma unroll
        for (int i = 0; i < 8; ++i) ss += o[i] * o[i];
        const float rs = 1.0f / sqrtf(sum16(ss) * (1.0f / 128.0f) + EPS);
#pragma unroll
        for (int i = 0; i < 8; ++i) o[i] = o[i] * rs * gg[i] * silu_f(zz[i]);
        v4u w; w.x = pk2(o[0], o[1]); w.y = pk2(o[2], o[3]); w.z = pk2(o[4], o[5]); w.w = pk2(o[6], o[7]);
        *(v4u*)(mix + (size_t)t * D + 512 + 8 * F.lane) = w;
    }
}

__device__ __forceinline__ void router_phase(const Frame& F, int l, int bank = 0) {
    const KArgsP A = kargs();
    LAS float* wr = (LAS float*)F.lds;
    LAS int* lcnt = (LAS int*)(F.lds + XT_OFF);
    LAS int* lbase = lcnt + 32;
    LAS int* sE = lbase + 32;
    LAS int* sP = sE + 136 * 4;
    LAS float* sG = (LAS float*)(sP + 136 * 4);
    const int nrows = l == NL - 1 ? NLAT : MT, rpb = nrows / 256;
    { const f32x4* src = (const f32x4*)((const float*)(F.ws + WS_WRT) + (size_t)l * NEXP * D);
      for (int i = F.tid; i < NEXP * D / 4; i += NTHR) ((LAS f32x4*)wr)[i] = src[i];
      if (F.tid < 32) lcnt[F.tid] = 0; }
    __syncthreads();
    bf16* h2 = (bf16*)(F.ws + WS_ACT);
    const int row0 = F.vcu * rpb;
    if (F.vcu < 256) {
    for (int rl = F.wave; rl < rpb; rl += NWAVES) {
        const int t = row0 + rl, r = mod_row(t);
        const float* xr = xr_row(F, t);
        f32x4 v[4]; float ss = 0.f;
#pragma unroll
        for (int j = 0; j < 4; ++j) { v[j] = *((const f32x4*)xr + F.lane + 64 * j); ss += (v[j].x * v[j].x + v[j].y * v[j].y) + (v[j].z * v[j].z + v[j].w * v[j].w); }
        const float rstd = 1.0f / sqrtf(wave_sum(ss) * (1.0f / D) + EPS);
        const f32x4* g2 = (const f32x4*)(A->in[I_GN2] + (size_t)l * D) + F.lane;
        const f32x4* sh = (const f32x4*)modv(F, l, r, 3) + F.lane; const f32x4* scl = (const f32x4*)modv(F, l, r, 4) + F.lane;
        v2u* ho = (v2u*)(h2 + (size_t)t * D) + F.lane;
#pragma unroll
        for (int j = 0; j < 4; ++j) { v[j] = v[j] * rstd * g2[64 * j] * (scl[64 * j] + 1.0f) + sh[64 * j]; v2u w; w.x = pk2(v[j].x, v[j].y); w.y = pk2(v[j].z, v[j].w); ho[64 * j] = w; }
        float pe[32];
        int lofs = F.lane; asm volatile("" : "+v"(lofs));
#pragma unroll
        for (int e = 0; e < NEXP; ++e) { float p = 0.f;
#pragma unroll
            for (int j = 0; j < 4; ++j) { const f32x4 w = ((const LAS f32x4*)(wr + e * D))[lofs + 64 * j]; p += (v[j].x * w.x + v[j].y * w.y) + (v[j].z * w.z + v[j].w * w.w); }
            pe[e] = p; if ((e & 3) == 3) asm volatile("" ::: "memory"); }
        float lg = rs32(pe, F.lane) + A->in[I_BR][l * NEXP + (F.lane >> 1)];
        if (F.lane & 1) lg = -3.0e38f;
        int se[4]; float sv[4];
#pragma unroll
        for (int k = 0; k < 4; ++k) { float m = lg;
#pragma unroll
            for (int o = 1; o < 64; o <<= 1) m = fmaxf(m, __shfl_xor(m, o));
            const unsigned long long bal = __ballot(lg == m); const int idx = __ffsll((long long)bal) - 1;
            se[k] = idx >> 1; sv[k] = m; if (F.lane == idx) lg = -3.0e38f; }
        const float e1 = __expf(sv[1] - sv[0]), e2 = __expf(sv[2] - sv[0]), e3 = __expf(sv[3] - sv[0]), inv = 1.0f / (1.0f + e1 + e2 + e3);
        if (F.lane == 0) {
            const float gt[4] = {inv, e1 * inv, e2 * inv, e3 * inv};
#pragma unroll
            for (int k = 0; k < 4; ++k) { sE[rl * 4 + k] = se[k]; sP[rl * 4 + k] = __hip_atomic_fetch_add(lcnt + se[k], 1, __ATOMIC_RELAXED, __HIP_MEMORY_SCOPE_WORKGROUP); sG[rl * 4 + k] = gt[k]; } }
    }
    }
    __syncthreads();
    if (F.tid < 32) { const int n = lcnt[F.tid]; lbase[F.tid] = n ? (int)__hip_atomic_fetch_add(F.ctl + CW_GCNT + ((bank * 2 + l) * 32 + F.tid) * 64, (unsigned)n, RLX_AGENT) : 0; }
    __syncthreads();
    if (F.vcu < 256) {
        int* sele = (int*)(F.ws + WS_SELE); int* selp = (int*)(F.ws + WS_SELP); float* selg = (float*)(F.ws + WS_SELG);
        for (int i = F.tid; i < rpb * 4; i += NTHR) { const int e = sE[i]; sele[(size_t)row0 * 4 + i] = e; selp[(size_t)row0 * 4 + i] = lbase[e] + sP[i]; selg[(size_t)row0 * 4 + i] = sG[i]; }
    }
}
__device__ __forceinline__ void moe_layout(const Frame& F, int l, LAS int* pend, LAS int* pstart) {
    __syncthreads();
    if (F.tid == 0) { int acc = 0;
        for (int e = 0; e < NEXP; ++e) { const int n = (int)__hip_atomic_load(F.ctl + CW_GCNT + (l * 32 + e) * 64, RLX_AGENT); pstart[e] = acc * 256; acc += (n + 255) >> 8; pend[e] = acc; } }
    __syncthreads();
}
__device__ __forceinline__ void gather_phase(const Frame& F, int l, bool dummy = false) {
    LAS int* pend = (LAS int*)(F.lds + XT_OFF); LAS int* pstart = pend + 32;
    moe_layout(F, l, pend, pstart);
    const int nrows = l == NL - 1 ? NLAT : MT;
    const int* sele = (const int*)(F.ws + WS_SELE); int* selp = (int*)(F.ws + WS_SELP);
    const bf16* h2 = (const bf16*)(F.ws + WS_ACT); bf16* xs = (bf16*)(F.ws + WS_XS);
    for (int it = F.gw; it < nrows * 4; it += F.NGW) {
        const int t = it >> 2, e = sele[it], dst = pstart[e] + selp[it];
        const v4u* src = (const v4u*)(h2 + (size_t)t * D) + F.lane; v4u* dp = (v4u*)(xs + (size_t)dst * D) + F.lane;
        const v4u a = src[0], b = src[64];
        dp[0] = a; dp[64] = b;
        if (F.lane == 0 && !dummy) selp[it] = dst;
    }
}

constexpr size_t WS_PW = WS_OB + 34 * MiB;
constexpr size_t WS_PKET = WS_PW + 68 * MiB;
constexpr size_t WS_PUT = WS_PKET + 68 * MiB;
constexpr size_t WS_PATT = WS_PUT + 68 * MiB;
constexpr size_t WS_PGAM = WS_PATT + 34 * MiB;
static_assert(WS_PGAM + 6 * MiB <= WS_END, "prep map");
typedef short bf16x8_t __attribute__((ext_vector_type(8)));
#define MFMA16(a, b, c) __builtin_amdgcn_mfma_f32_16x16x32_bf16((a), (b), (c), 0, 0, 0)
__device__ __forceinline__ v2u pack4(const f32x4 v) { v2u w; w.x = pk2(v.x, v.y); w.y = pk2(v.z, v.w); return w; }
__device__ __forceinline__ int chunk_rowbase(int b, int cn) { return cn < 4 ? NLAT + b * CTXL + cn * 64 : b * SEQ + (cn - 4) * 64; }

__device__ __forceinline__ void prep_phase(const Frame& F) {
    LAS bf16* k_rm = (LAS bf16*)F.lds;
    LAS bf16* q_rm = k_rm + 64 * 136;
    LAS float* Lp = (LAS float*)F.lds;
    LAS bf16* kT = (LAS bf16*)(F.lds + 34816);
    LAS bf16* vT = kT + 128 * 72;
    LAS float* Gm = (LAS float*)(F.lds + 34816 + 36864);
    LAS float* A0 = Gm + 64 * 72;
    LAS bf16* Tm = (LAS bf16*)Gm;
    LAS float* gs = (LAS float*)(F.lds + 34816 + 36864 + 36864);
    LAS float* bs = gs + 128;
    LAS float* gam = bs + 128;
    const bf16* qkvn = (const bf16*)(F.ws + WS_QKVN);
    const float* gb = (const float*)(F.ws + WS_G); const float* bb = (const float*)(F.ws + WS_BETA);
    const int w = F.wave;
    for (int unit = F.vcu; unit < 32 * 68; unit += F.G) {
        int tid_ = F.tid; asm volatile("" : "+v"(tid_));
        const int tid = tid_, lane = tid & 63, l15 = lane & 15, l4 = lane >> 4;
        const int bh = unit / 68, cn = unit % 68, b = bh >> 2, h = bh & 3, rowbase = chunk_rowbase(b, cn);
        const size_t pu = (size_t)(bh * 68 + cn) * 2;
        __syncthreads();
        for (int p = tid; p < 1024; p += NTHR) { const int i = p & 63, c8 = p >> 6; const bf16* rp = qkvn + (size_t)(rowbase + i) * 1536 + h * 128 + c8 * 8;
            const v4u qv = *(const v4u*)rp, kv = *(const v4u*)(rp + 512), vv = *(const v4u*)(rp + 1024);
            *(LAS v4u*)(q_rm + i * 136 + c8 * 8) = qv; *(LAS v4u*)(k_rm + i * 136 + c8 * 8) = kv;
#pragma unroll
            for (int e = 0; e < 4; ++e) { const unsigned kw = kv[e], vw = vv[e];
                kT[(c8 * 8 + 2 * e) * 72 + i] = (bf16)(kw & 0xffffu); kT[(c8 * 8 + 2 * e + 1) * 72 + i] = (bf16)(kw >> 16);
                vT[(c8 * 8 + 2 * e) * 72 + i] = (bf16)(vw & 0xffffu); vT[(c8 * 8 + 2 * e + 1) * 72 + i] = (bf16)(vw >> 16); } }
        if (tid < 128) { const int d = tid >> 6, i = tid & 63; gs[tid] = gb[(size_t)(rowbase + i) * 8 + d * 4 + h]; bs[tid] = bb[(size_t)(rowbase + i) * 8 + d * 4 + h]; }
        __syncthreads();
        if (tid < 128) { const int d = tid >> 6, i = tid & 63; float s = 0.f;
            if (d == 0) { for (int j = 0; j <= i; ++j) s += gs[j]; } else { for (int j = 63; j >= i; --j) s += gs[64 + j]; }
            gam[tid] = s; }
#pragma unroll
        for (int tt = 0; tt < 2; ++tt) { const int idx = 2 * w + tt, ti = idx >> 2, tj = idx & 3;
            f32x4 aG = {0.f, 0.f, 0.f, 0.f}, aA = {0.f, 0.f, 0.f, 0.f};
#pragma unroll
            for (int ks = 0; ks < 4; ++ks) { const int co = 32 * ks + 8 * l4;
                const bf16x8_t bk = *(const LAS bf16x8_t*)(k_rm + (16 * tj + l15) * 136 + co), ak = *(const LAS bf16x8_t*)(k_rm + (16 * ti + l15) * 136 + co), aq = *(const LAS bf16x8_t*)(q_rm + (16 * ti + l15) * 136 + co);
                aG = MFMA16(ak, bk, aG); aA = MFMA16(aq, bk, aA); }
#pragma unroll
            for (int r = 0; r < 4; ++r) { Gm[(16 * ti + 4 * l4 + r) * 72 + 16 * tj + l15] = aG[r]; A0[(16 * ti + 4 * l4 + r) * 72 + 16 * tj + l15] = aA[r]; } }
        __syncthreads();
        for (int idx = tid; idx < 8192; idx += NTHR) { const int d = idx >> 12, ip = (idx >> 6) & 63, jp = idx & 63, i = d ? 63 - ip : ip, j = d ? 63 - jp : jp;
            Lp[idx] = jp < ip ? bs[d * 64 + i] * Gm[i * 72 + j] * __expf(gam[d * 64 + i] - gam[d * 64 + j]) : 0.f; }
        for (int it = tid; it < 1024; it += NTHR) { const int d = it >> 9, i = (it >> 3) & 63, j0 = (it & 7) * 8; float v[8];
#pragma unroll
            for (int e = 0; e < 8; ++e) { const int j = j0 + e; const bool in = d ? (j >= i) : (j <= i); v[e] = in ? A0[i * 72 + j] * __expf(gam[d * 64 + i] - gam[d * 64 + j]) : 0.f; }
            v4u o; o.x = pk2(v[0], v[1]); o.y = pk2(v[2], v[3]); o.z = pk2(v[4], v[5]); o.w = pk2(v[6], v[7]);
            *(v4u*)((bf16*)(F.ws + WS_PATT) + (pu + d) * 4096 + i * 64 + j0) = o; }
        for (int it = tid; it < 2048; it += NTHR) { const int d = it >> 10, dk = (it >> 3) & 127, j0 = (it & 7) * 8; const float gl = d ? gam[64] : gam[63]; float v[8];
            const v4u kk = *(const LAS v4u*)(kT + dk * 72 + j0);
            v[0] = bflo(kk.x); v[1] = bfhi(kk.x); v[2] = bflo(kk.y); v[3] = bfhi(kk.y); v[4] = bflo(kk.z); v[5] = bfhi(kk.z); v[6] = bflo(kk.w); v[7] = bfhi(kk.w);
#pragma unroll
            for (int e = 0; e < 8; ++e) v[e] *= __expf(gl - gam[d * 64 + j0 + e]);
            v4u o; o.x = pk2(v[0], v[1]); o.y = pk2(v[2], v[3]); o.z = pk2(v[4], v[5]); o.w = pk2(v[6], v[7]);
            *(v4u*)((bf16*)(F.ws + WS_PKET) + (pu + d) * 8192 + dk * 64 + j0) = o; }
        if (tid < 128) ((float*)(F.ws + WS_PGAM))[(pu + (tid >> 6)) * 64 + (tid & 63)] = gam[tid];
        __syncthreads();
        if (w < 2) {
            const int d = w; const LAS float* Lr = Lp + d * 4096;
            float t[64];
#pragma unroll
            for (int ip = 0; ip < 64; ++ip) {
                float a0 = (lane == ip) ? 1.f : 0.f, a1 = 0.f;
#pragma unroll
                for (int j4 = 0; j4 < (ip + 3) / 4; ++j4) { const f32x4 Lv = *(const LAS f32x4*)(Lr + ip * 64 + 4 * j4);
                    if (4 * j4 + 0 < ip) a0 -= Lv.x * t[4 * j4 + 0];
                    if (4 * j4 + 1 < ip) a1 -= Lv.y * t[4 * j4 + 1];
                    if (4 * j4 + 2 < ip) a0 -= Lv.z * t[4 * j4 + 2];
                    if (4 * j4 + 3 < ip) a1 -= Lv.w * t[4 * j4 + 3]; }
                t[ip] = a0 + a1; asm volatile("" ::: "memory"); }
            const int jn = d ? 63 - lane : lane; const float bj = bs[d * 64 + jn], bge = bj * __expf(gam[d * 64 + jn]);
            LAS bf16* Tu = Tm + (d * 2) * 64 * 72; LAS bf16* Tw = Tu + 64 * 72;
#pragma unroll
            for (int ip = 0; ip < 64; ++ip) { const int in = d ? 63 - ip : ip; Tu[in * 72 + jn] = (bf16)f2bf(t[ip] * bj); Tw[in * 72 + jn] = (bf16)f2bf(t[ip] * bge); }
        }
        __syncthreads();
        {
            const int d = w >> 2, ww = w & 3;
            const LAS bf16* Tu = Tm + (d * 2) * 64 * 72; const LAS bf16* Tw = Tu + 64 * 72;
            bf16x8_t tu[2], tw[2];
#pragma unroll
            for (int ks = 0; ks < 2; ++ks) { tu[ks] = *(const LAS bf16x8_t*)(Tu + (16 * ww + l15) * 72 + 32 * ks + 8 * l4); tw[ks] = *(const LAS bf16x8_t*)(Tw + (16 * ww + l15) * 72 + 32 * ks + 8 * l4); }
            bf16* ut = (bf16*)(F.ws + WS_PUT) + (pu + d) * 8192; bf16* wg = (bf16*)(F.ws + WS_PW) + (pu + d) * 8192;
#pragma unroll 2
            for (int tj = 0; tj < 8; ++tj) {
                f32x4 au = {0.f, 0.f, 0.f, 0.f}, aw = {0.f, 0.f, 0.f, 0.f};
#pragma unroll
                for (int ks = 0; ks < 2; ++ks) { const bf16x8_t bv = *(const LAS bf16x8_t*)(vT + (16 * tj + l15) * 72 + 32 * ks + 8 * l4), ak = *(const LAS bf16x8_t*)(kT + (16 * tj + l15) * 72 + 32 * ks + 8 * l4);
                    au = MFMA16(tu[ks], bv, au); aw = MFMA16(ak, tw[ks], aw); }
                *(v2u*)(ut + (((((tj >> 2) * 16 + l15) * 4 + ww) * 4 + l4) * 4 + (tj & 3)) * 4) = pack4(au);
                *(v2u*)(wg + (16 * ww + l15) * 128 + 16 * tj + 4 * l4) = pack4(aw);
            }
        }
    }
    __syncthreads();
}

struct ScanRegs { bf16x8_t fa[4], fx[2], kf[2]; float graw, glast; int rowbase, cn; };
__device__ __forceinline__ void scan_load(ScanRegs& R, const unsigned char* ws, int ci_in, int b, int bh, int h, int d, int s, int w, int l15, int l4) {
    const int ci = ci_in < 68 ? ci_in : 67, rt = w & 3;
    const int cn = ci < 4 ? (d ? 3 - ci : ci) : 4 + (d ? 67 - ci : ci - 4);
    R.cn = cn; R.rowbase = chunk_rowbase(b, cn);
    const size_t pu = (size_t)(bh * 68 + cn) * 2 + d;
    const float* gmp = (const float*)(ws + WS_PGAM) + pu * 64;
    R.glast = gmp[d ? 0 : 63]; R.graw = gmp[16 * rt + l15];
    const bf16* ket = (const bf16*)(ws + WS_PKET) + pu * 8192 + (16 * w + l15) * 64 + 8 * l4;
    R.kf[0] = *(const bf16x8_t*)ket; R.kf[1] = *(const bf16x8_t*)(ket + 32);
    const bf16* wp = (const bf16*)(ws + WS_PW) + pu * 8192 + (16 * rt + l15) * 128 + 8 * l4;
    const bf16* qp = (const bf16*)(ws + WS_QKVN) + (size_t)(R.rowbase + 16 * rt + l15) * 1536 + h * 128 + 8 * l4;
    const bf16* ap_ = w < 4 ? wp : qp;
#pragma unroll
    for (int ks = 0; ks < 4; ++ks) R.fa[ks] = *(const bf16x8_t*)(ap_ + 32 * ks);
    const bf16* up = (const bf16*)(ws + WS_PUT) + pu * 8192 + ((((s * 16 + l15) * 4 + rt) * 4 + l4) * 16);
    const bf16* ap = (const bf16*)(ws + WS_PATT) + pu * 4096 + (16 * rt + l15) * 64 + 8 * l4;
    const bf16* xp = w < 4 ? up : ap; const int xo = w < 4 ? 8 : 32;
    R.fx[0] = *(const bf16x8_t*)xp; R.fx[1] = *(const bf16x8_t*)(xp + xo);
}
__device__ __forceinline__ void scan_step(const ScanRegs& R, f32x4 (&S)[4], LAS bf16* ST, LAS bf16* vnT, LAS bf16* oS, bf16* od, bf16* dump, bool skip_ctx_out, int h, int s, int w, int l15, int l4, int tid) {
    const int rt = w & 3;
    const float gend = __expf(R.glast), eg = w < 4 ? 1.0f : __expf(R.graw);
    bf16x8_t fa[4];
#pragma unroll
    for (int ks = 0; ks < 4; ++ks) fa[ks] = R.fa[ks];
    if (w >= 4) {
#pragma unroll
        for (int ks = 0; ks < 4; ++ks) { const v4u qv = __builtin_bit_cast(v4u, R.fa[ks]); v4u o;
            o.x = pk2(bflo(qv.x) * eg, bfhi(qv.x) * eg); o.y = pk2(bflo(qv.y) * eg, bfhi(qv.y) * eg); o.z = pk2(bflo(qv.z) * eg, bfhi(qv.z) * eg); o.w = pk2(bflo(qv.w) * eg, bfhi(qv.w) * eg);
            fa[ks] = __builtin_bit_cast(bf16x8_t, o); } }
    f32x4 c[4];
#pragma unroll
    for (int ct = 0; ct < 4; ++ct) { c[ct] = (f32x4){0.f, 0.f, 0.f, 0.f};
#pragma unroll
        for (int ks = 0; ks < 4; ++ks) { const bf16x8_t bq = *(const LAS bf16x8_t*)(ST + (16 * ct + l15) * 136 + 32 * ks + 8 * l4); c[ct] = MFMA16(fa[ks], bq, c[ct]); } }
    {
        const v4u ua = __builtin_bit_cast(v4u, R.fx[0]), ub = __builtin_bit_cast(v4u, R.fx[1]);
        const f32x4 u0 = {bflo(ua.x), bfhi(ua.x), bflo(ua.y), bfhi(ua.y)}, u1 = {bflo(ua.z), bfhi(ua.z), bflo(ua.w), bfhi(ua.w)};
        const f32x4 u2 = {bflo(ub.x), bfhi(ub.x), bflo(ub.y), bfhi(ub.y)}, u3 = {bflo(ub.z), bfhi(ub.z), bflo(ub.w), bfhi(ub.w)};
        LAS bf16* vp = vnT + (w < 4 ? 0 : 64 * 72) + l15 * 72 + 16 * rt + 4 * l4;
        *(LAS v2u*)(vp) = pack4(u0 - c[0]); *(LAS v2u*)(vp + 16 * 72) = pack4(u1 - c[1]); *(LAS v2u*)(vp + 32 * 72) = pack4(u2 - c[2]); *(LAS v2u*)(vp + 48 * 72) = pack4(u3 - c[3]);
    }
    __syncthreads();
    {
        LAS bf16* op = oS + (w < 4 ? 64 * 72 : 0) + (16 * rt + 4 * l4) * 72 + l15;
#pragma unroll
        for (int ct = 0; ct < 4; ++ct) { const bf16x8_t v0 = *(const LAS bf16x8_t*)(vnT + (16 * ct + l15) * 72 + 8 * l4), v1 = *(const LAS bf16x8_t*)(vnT + (16 * ct + l15) * 72 + 32 + 8 * l4);
            f32x4 o = MFMA16(R.fx[0], v0, c[ct]); o = MFMA16(R.fx[1], v1, o);
#pragma unroll
            for (int r = 0; r < 4; ++r) op[r * 72 + 16 * ct] = (bf16)f2bf(o[r]);
            f32x4 sn = S[ct] * gend; sn = MFMA16(R.kf[0], v0, sn); sn = MFMA16(R.kf[1], v1, sn); S[ct] = sn;
            *(LAS v2u*)(ST + (16 * ct + l15) * 136 + 16 * w + 4 * l4) = pack4(sn); }
    }
    __syncthreads();
    {
        const int i = tid >> 3, pc = tid & 7;
        const v4u ov = *(const LAS v4u*)(oS + i * 72 + pc * 8);
        const bool real = !(R.cn < 4 && skip_ctx_out);
        bf16* gp = real ? od + (size_t)(R.rowbase + i) * 512 + h * 128 + 64 * s + pc * 8 : dump + (size_t)i * 64 + pc * 8;
        *(v4u*)gp = ov;
    }
}
__device__ __forceinline__ void scan_mfma(const Frame& F, int l) {
    LAS bf16* ST = (LAS bf16*)F.lds;
    LAS bf16* vnT = ST + 64 * 136;
    LAS bf16* oS = vnT + 2 * 64 * 72;
    const int lane = F.lane, l15 = lane & 15, l4 = lane >> 4, w = F.wave;
    const bool skip_ctx_out = (l == NL - 1);
    for (int unit = F.vcu; unit < 128; unit += F.G) {
        const int s = unit & 1, sd = unit >> 1, d = sd & 1, bh = sd >> 1, b = bh >> 2, h = bh & 3;
        bf16* od = (bf16*)(F.ws + (d ? WS_OB : WS_OF)); bf16* dump = (bf16*)(F.ws + WS_PGAM + 1536 * 1024) + (size_t)unit * 16 * 512;
        __syncthreads();
        for (int i = F.tid; i < 64 * 136 / 2; i += NTHR) ((LAS unsigned*)ST)[i] = 0u;
        f32x4 S[4];
#pragma unroll
        for (int ct = 0; ct < 4; ++ct) S[ct] = (f32x4){0.f, 0.f, 0.f, 0.f};
        ScanRegs R0, R1, R2;
        scan_load(R0, F.ws, 0, b, bh, h, d, s, w, l15, l4); scan_load(R1, F.ws, 1, b, bh, h, d, s, w, l15, l4); scan_load(R2, F.ws, 2, b, bh, h, d, s, w, l15, l4);
        __syncthreads();
#pragma unroll 1
        for (int ci = 0; ci < 66; ci += 3) {
            scan_step(R0, S, ST, vnT, oS, od, dump, skip_ctx_out, h, s, w, l15, l4, F.tid); scan_load(R0, F.ws, ci + 3, b, bh, h, d, s, w, l15, l4);
            scan_step(R1, S, ST, vnT, oS, od, dump, skip_ctx_out, h, s, w, l15, l4, F.tid); scan_load(R1, F.ws, ci + 4, b, bh, h, d, s, w, l15, l4);
            scan_step(R2, S, ST, vnT, oS, od, dump, skip_ctx_out, h, s, w, l15, l4, F.tid); scan_load(R2, F.ws, ci + 5, b, bh, h, d, s, w, l15, l4);
        }
        scan_step(R0, S, ST, vnT, oS, od, dump, skip_ctx_out, h, s, w, l15, l4, F.tid);
        scan_step(R1, S, ST, vnT, oS, od, dump, skip_ctx_out, h, s, w, l15, l4, F.tid);
    }
}

#ifndef USE_NAIVE_SCAN
#define USE_NAIVE_SCAN 0
#endif
#ifndef REP_MASK
#define REP_MASK 0
#endif
#define REPS(p) for (int _r = 0; _r < 1 + ((REP_MASK >> (p)) & 1); ++_r)
#define LASTREP(p) (_r == ((REP_MASK >> (p)) & 1))
constexpr int PH_PER_LAYER = 11, N_PHASES = 2 + NL * PH_PER_LAYER;
#ifndef PG8_SP2
#define PG8_SP2 true
#endif
#ifndef PG8_ALIGN
#define PG8_ALIGN true
#endif
__device__ __forceinline__ Frame make_frame(int wv) {
    extern __shared__ __attribute__((aligned(16))) unsigned char lds[];
    const KArgsP A = kargs();
    Frame F;
    { unsigned lb = (unsigned)(uintptr_t)(LAS unsigned char*)lds; asm volatile("" : "+s"(lb)); F.lds = (LAS unsigned char*)(uintptr_t)lb; }
    F.MISC = (volatile LAS unsigned*)(F.lds + MISC_OFF);
    { unsigned m1 = ~0u; asm volatile("" : "+s"(m1)); int ln = (int)__builtin_amdgcn_mbcnt_hi(m1, __builtin_amdgcn_mbcnt_lo(m1, 0u)); asm volatile("" : "+v"(ln)); F.lane = ln; }
    { int w_ = wv; asm volatile("" : "+s"(w_)); F.wave = w_; } F.tid = F.wave * 64 + F.lane;
    F.G = gridDim.x; { const int bx = blockIdx.x; F.vcu = (F.G % 8 == 0) ? (bx % 8) * (F.G / 8) + bx / 8 : bx; }
    F.gw = F.vcu * NWAVES + F.wave; F.NGW = F.G * NWAVES;
    F.ws = A->ws; F.ctl = (unsigned*)(A->ws + WS_CTL); F.out = A->out;
    return F;
}
__global__ void __launch_bounds__(NTHR, 2) mk_fwd(Args args) {
    const int wv = __builtin_amdgcn_readfirstlane((int)threadIdx.x >> 6);
    { Frame F = make_frame(wv);
      for (int u = F.tid; u < (LDS_BYTES - LDSCTL_OFF) / 4; u += NTHR) ((LAS unsigned*)(F.lds + LDSCTL_OFF))[u] = 0u;
      __syncthreads(); }
    const int lo = args.ph_lo, hi = args.ph_hi;
#ifdef PROBE_P
    unsigned long long pr_acc = 0ull, pr_t0 = 0ull;
#define PR_BEGIN(p) do { if (((p) < 2 ? (p) : 2 + ((p) - 2) % PH_PER_LAYER) == PROBE_P) pr_t0 = __builtin_amdgcn_s_memrealtime(); } while (0)
#define PR_END(p) do { if (((p) < 2 ? (p) : 2 + ((p) - 2) % PH_PER_LAYER) == PROBE_P) pr_acc += __builtin_amdgcn_s_memrealtime() - pr_t0; } while (0)
#else
#define PR_BEGIN(p) do {} while (0)
#define PR_END(p) do {} while (0)
#endif
    if (hi - lo > 1) { Frame F = make_frame(wv); (void)xcd_barrier_post((unsigned*)(F.ctl + CW_BAR), F.MISC + 8, F.tid); }
#define IN(k) (lo <= (k) && (k) < hi)
#define SEAM(k) do { if (IN(k) && IN((k) + 1)) { Frame Fb = make_frame(wv); XcdBarrier bar; bar.bar = (unsigned*)(Fb.ctl + CW_BAR); bar.x = xb_xcc_id(); bar.st = Fb.MISC + 8; xcd_barrier(bar, Fb.tid); } } while (0)
    PR_BEGIN(0); if (IN(0)) { Frame F = make_frame(wv); REPS(0) { p0_prologue(F); __syncthreads(); } }
    SEAM(0); PR_END(0);
    PR_BEGIN(1); if (IN(1)) { Frame F = make_frame(wv); REPS(1) { row_pass<0>(F, 0, 0); __syncthreads(); } }
    SEAM(1); PR_END(1);
#define LAYER_BODY(l) { \
        const int pb = 2 + l * PH_PER_LAYER; \
        PR_BEGIN(pb + 0); if (IN(pb + 0)) { Frame F = make_frame(wv); \
            SchedIn S{(const bf16*)(F.ws + WS_ACT), (const bf16*)(F.ws + WS_WIN) + (size_t)l * 3072 * D, F.G, (int)blockIdx.x}; \
            EpiIn E{(bf16*)(F.ws + WS_QKVZ), (bf16*)(F.ws + WS_ZTL), (bf16*)(F.ws + WS_ZTC)}; \
            REPS(8) { pg8::gemm_phase<EpiIn, SchedIn, PG8_ALIGN, PG8_SP2>(F.lds, pg8::Gemm{D}, S, E, F.tid); __syncthreads(); } } \
        SEAM(pb + 0); PR_END(pb + 0); \
        PR_BEGIN(pb + 1); if (IN(pb + 1)) { Frame F = make_frame(wv); REPS(2) { conv_phase(F, l); __syncthreads(); } } \
        SEAM(pb + 1); PR_END(pb + 1); \
        PR_BEGIN(pb + 2); if (IN(pb + 2)) { \
            { Frame F = make_frame(wv); \
              SchedDft S{(const bf16*)(F.ws + WS_DFTM), (const bf16*)(F.ws + WS_ZTL), F.G, (int)blockIdx.x}; \
              EpiDft E{(bf16*)(F.ws + WS_ACT), 1.0f / sqrtf(4096.0f * 128.0f)}; \
              REPS(9) { pg8::gemm_phase<EpiDft, SchedDft, PG8_ALIGN, PG8_SP2>(F.lds, pg8::Gemm{8192}, S, E, F.tid); __syncthreads(); } } \
            if (l == 0) { Frame F = make_frame(wv); ctx_dft(F); } \
            { Frame F = make_frame(wv); REPS(3) { prep_phase(F); } } \
        } \
        SEAM(pb + 2); PR_END(pb + 2); \
        PR_BEGIN(pb + 3); if (IN(pb + 3)) { Frame F = make_frame(wv); \
            REPS(4) { scan_mfma(F, l); __syncthreads(); } \
        } \
        SEAM(pb + 3); PR_END(pb + 3); \
        PR_BEGIN(pb + 4); if (IN(pb + 4)) { Frame F = make_frame(wv); REPS(5) { gated_out(F, l); __syncthreads(); } } \
        SEAM(pb + 4); PR_END(pb + 4); \
        PR_BEGIN(pb + 5); if (IN(pb + 5)) { Frame F = make_frame(wv); \
            SchedOut S{(const bf16*)(F.ws + WS_ACT), (const bf16*)(F.ws + WS_WOUT) + (size_t)l * D * D, l == NL - 1 ? NLAT / 256 : MT / 256, F.G, (int)blockIdx.x}; \
            REPS(10) { EpiOut E{F.out, (float*)(F.ws + WS_XC), modv(F, l, 0, 2), LASTREP(10) ? 1.0f : 0.0f}; \
                pg8::gemm_phase<EpiOut, SchedOut, PG8_ALIGN, PG8_SP2>(F.lds, pg8::Gemm{D}, S, E, F.tid); __syncthreads(); } } \
        SEAM(pb + 5); PR_END(pb + 5); \
        PR_BEGIN(pb + 6); if (IN(pb + 6)) { Frame F = make_frame(wv); REPS(6) { router_phase(F, l, LASTREP(6) ? 0 : 1); __syncthreads(); } } \
        SEAM(pb + 6); PR_END(pb + 6); \
        PR_BEGIN(pb + 7); if (IN(pb + 7)) { Frame F = make_frame(wv); REPS(7) { gather_phase(F, l, !LASTREP(7)); __syncthreads(); } } \
        SEAM(pb + 7); PR_END(pb + 7); \
        PR_BEGIN(pb + 8); if (IN(pb + 8)) { Frame F = make_frame(wv); \
            LAS int* pend = (LAS int*)(F.lds + XT_OFF); moe_layout(F, l, pend, pend + 32); \
            SchedMoe S{(const bf16*)(F.ws + WS_XS), (const bf16*)(F.ws + WS_W1), (size_t)2048 * D * 2, pend, pend[NEXP - 1], 8, F.G, (int)blockIdx.x}; \
            EpiSwiglu E{(bf16*)(F.ws + WS_HS), kargs()->in[I_BG] + (size_t)l * NEXP * D, kargs()->in[I_BU] + (size_t)l * NEXP * D}; \
            REPS(11) { pg8::gemm_phase<EpiSwiglu, SchedMoe, PG8_ALIGN, PG8_SP2>(F.lds, pg8::Gemm{D}, S, E, F.tid); __syncthreads(); } } \
        SEAM(pb + 8); PR_END(pb + 8); \
        PR_BEGIN(pb + 9); if (IN(pb + 9)) { Frame F = make_frame(wv); \
            LAS int* pend = (LAS int*)(F.lds + XT_OFF); moe_layout(F, l, pend, pend + 32); \
            SchedMoe S{(const bf16*)(F.ws + WS_HS), (const bf16*)(F.ws + WS_W2), (size_t)D * D * 2, pend, pend[NEXP - 1], 4, F.G, (int)blockIdx.x}; \
            EpiDown E{(bf16*)(F.ws + WS_XS), kargs()->in[I_BD] + (size_t)l * NEXP * D}; \
            REPS(12) { pg8::gemm_phase<EpiDown, SchedMoe, PG8_ALIGN, PG8_SP2>(F.lds, pg8::Gemm{D}, S, E, F.tid); __syncthreads(); } } \
        SEAM(pb + 9); PR_END(pb + 9); \
        PR_BEGIN(pb + 10); if (IN(pb + 10)) { \
            { Frame F = make_frame(wv); \
              if (l == NL - 1) row_pass<2>(F, l, l); else { REPS(13) { row_pass<1>(F, l, l + 1, !LASTREP(13)); __syncthreads(); } } } \
            if (l != NL - 1) { Frame F = make_frame(wv); __syncthreads(); REPS(14) { convert_experts(F, l + 1); __syncthreads(); } } \
        } \
        if (l + 1 < NL) SEAM(pb + 10); PR_END(pb + 10); \
    }
    LAYER_BODY(0)
    LAYER_BODY(1)
#undef LAYER_BODY
#ifdef PROBE_P
    if (blockIdx.x == 0 && threadIdx.x == 0) { const unsigned long long t0 = __builtin_amdgcn_s_memrealtime(), want = pr_acc * PROBE_SCALE; while (__builtin_amdgcn_s_memrealtime() - t0 < want) __builtin_amdgcn_s_sleep(8); }
#endif
#undef IN
#undef SEAM
}

extern "C" void kernel_launch(void* const* d_in, const int* in_sizes, int n_in, void* d_out, int out_size, void* d_ws, size_t ws_size, hipStream_t stream) {
    static int grid = 0;
    if (grid == 0) {
        if (n_in != 23 || out_size != NLAT * D || ws_size < WS_END) { fprintf(stderr, "kernel_launch: unexpected shapes (n_in %d, out %d, ws %zu); nothing launched\n", n_in, out_size, ws_size); grid = -1; return; }
        int dev = 0, cus = 0, per_cu = 0;
        if (hipGetDevice(&dev) != hipSuccess || hipDeviceGetAttribute(&cus, hipDeviceAttributeMultiprocessorCount, dev) != hipSuccess) { grid = -1; return; }
        if (hipFuncSetAttribute((const void*)mk_fwd, hipFuncAttributeMaxDynamicSharedMemorySize, LDS_BYTES) != hipSuccess) { fprintf(stderr, "kernel_launch: hipFuncSetAttribute failed\n"); grid = -1; return; }
        if (hipOccupancyMaxActiveBlocksPerMultiprocessor(&per_cu, (const void*)mk_fwd, NTHR, LDS_BYTES) != hipSuccess || per_cu < 1)
            fprintf(stderr, "kernel_launch: note: occupancy query reports %d workgroups per CU\n", per_cu);
        (void)hipGetLastError();
        grid = cus;
        if (grid != 256) { fprintf(stderr, "kernel_launch: built for 256 CUs, found %d; nothing launched\n", grid); grid = -1; return; }
    }
    if (grid < 0) return;
    if (hipMemsetAsync((char*)d_ws + WS_CTL, 0, CTL_ZERO_BYTES, stream) != hipSuccess) { fprintf(stderr, "kernel_launch: hipMemsetAsync failed\n"); return; }
    Args a{};
    for (int i = 0; i < 23; ++i) a.in[i] = (const float*)d_in[i];
    a.out = (float*)d_out; a.ws = (unsigned char*)d_ws;
#if MK_ONE_LAUNCH
    a.ph_lo = 0; a.ph_hi = N_PHASES;
    hipLaunchKernelGGL(mk_fwd, dim3(grid), dim3(NTHR), LDS_BYTES, stream, a);
#else
    for (int p = 0; p < N_PHASES; ++p) { a.ph_lo = p; a.ph_hi = p + 1; hipLaunchKernelGGL(mk_fwd, dim3(grid), dim3(NTHR), LDS_BYTES, stream, a); }
#endif
    const hipError_t le = hipPeekAtLastError();
    if (le != hipSuccess) fprintf(stderr, "kernel_launch: launch failed: %s\n", hipGetErrorName(le));
}
```

```cpp
#define MK_ONE_LAUNCH 1
#include <hip/hip_runtime.h>
#include <cstdio>
#include <cstdint>

#ifndef MK_ONE_LAUNCH
#define MK_ONE_LAUNCH 1
#endif

namespace pg8 {
#define PG8_LAS __attribute__((address_space(3)))
typedef unsigned short bf16_t;
typedef short bf16x8 __attribute__((ext_vector_type(8)));
typedef float f32x4 __attribute__((ext_vector_type(4)));
typedef unsigned u32x4 __attribute__((ext_vector_type(4)));
constexpr int BM = 256, BK = 64, HALF = 128, HTB = HALF * BK * 2  , STAGE_BYTES = 8 * HTB, NXCD = 8, WGM = 8;

__host__ __device__ __forceinline__ int lds_byte(int r, int c) { const int st = (r >> 4) * 2 + (c >> 5), rr = r & 15, cc = c & 31, ob = rr * 64 + cc * 2; return st * 1024 + (ob ^ (((ob >> 9) & 1) << 5)); }
__host__ __device__ __forceinline__ void stage_rc(int b, int& R, int& C) { const int st = b / 1024, sb = b % 1024, swz = sb ^ (((sb >> 9) & 1) << 5); R = (st >> 1) * 16 + swz / 64; C = (st & 1) * 32 + (swz % 64) / 2; }
__host__ __device__ __forceinline__ int perm32(int rho) { const int n = rho >> 4, i = rho & 15; return 8 * (i >> 2) + 4 * n + (i & 3); }

struct Unit { int pm, pn, kind, e; };
struct Gemm { int K; };

__device__ __forceinline__ int xcd_remap(int L, int nwg) { const int q = nwg / NXCD, r = nwg % NXCD, xcd = L % NXCD, off = L / NXCD; return (xcd < r ? xcd * (q + 1) : r * (q + 1) + (xcd - r) * q) + off; }
__device__ __forceinline__ void grp_decode(int wgid, int nM, int nN, int& pm, int& pn) { const int nig = WGM * nN, gid = wgid / nig, fm = gid * WGM, gsz = (nM - fm) < WGM ? (nM - fm) : WGM; pm = fm + ((wgid % nig) % gsz); pn = (wgid % nig) / gsz; }

__device__ __forceinline__ const char* uni_ptr(const char* p) { const unsigned long long v = (unsigned long long)p; const unsigned lo = __builtin_amdgcn_readfirstlane((unsigned)v), hi = __builtin_amdgcn_readfirstlane((unsigned)(v >> 32)); return (const char*)(((unsigned long long)hi << 32) | lo); }
__device__ __forceinline__ unsigned cvt_pk_bf16(float lo, float hi) { unsigned r; asm volatile("v_cvt_pk_bf16_f32 %0, %1, %2" : "=v"(r) : "v"(lo), "v"(hi)); return r; }

template <class Epi, class Sched, bool ALIGN_EPI = false, bool SP2 = false>
__device__ __forceinline__ void gemm_phase(PG8_LAS unsigned char* lds, const Gemm g, const Sched& S, const Epi& E, int tid_in) {
    int tid_ = tid_in; asm volatile("" : "+v"(tid_));
    const int tid = tid_, wid = __builtin_amdgcn_readfirstlane(tid >> 6), lane = tid & 63, wr = wid >> 2, wc = wid & 3, fr = lane & 15, fq = lane >> 4;
    const int K = g.K, nt = K / BK;
    unsigned voffA[2], voffB[2];
#pragma unroll
    for (int i = 0; i < 2; ++i) { int R, C; stage_rc(tid * 16 + i * 8192, R, C); const int Rb = Epi::PERM ? ((R & ~31) + perm32(R & 31)) : R;
        voffA[i] = (unsigned)(R * K + C) * 2u; voffB[i] = (unsigned)(Rb * K + C) * 2u; }
    const size_t kstep = (size_t)(BK * 2);
    const size_t hstep = (size_t)HALF * K * 2;
    const size_t tstep = 2 * hstep;
    const unsigned ldsw = (unsigned)wid * 1024u;
    const int aoff = lds_byte(wr * 64 + fr, fq * 8), boff = lds_byte(wc * 32 + fr, fq * 8);
#define PG8_SA(b, h) (((b) * 2 + (h)) * HTB)
#define PG8_SB(b, h) ((4 + (b) * 2 + (h)) * HTB)
#define PG8_STAGE(bufoff, gbase, voff) do { _Pragma("unroll") for (int _i = 0; _i < 2; ++_i) \
        __builtin_amdgcn_global_load_lds((const unsigned*)((const char*)(gbase) + (voff)[_i]), (PG8_LAS unsigned*)(lds + (bufoff) + ldsw + _i * 8192), 16, 0, 0); } while (0)
#define PG8_LDA(dst, b, h) do { _Pragma("unroll") for (int m = 0; m < 4; ++m) _Pragma("unroll") for (int k = 0; k < 2; ++k) dst[m][k] = *(const PG8_LAS bf16x8*)(lds + PG8_SA(b, h) + aoff + m * 2048 + k * 1024); } while (0)
#define PG8_LDB(dst, b, h) do { _Pragma("unroll") for (int n = 0; n < 2; ++n) _Pragma("unroll") for (int k = 0; k < 2; ++k) dst[n][k] = *(const PG8_LAS bf16x8*)(lds + PG8_SB(b, h) + boff + n * 2048 + k * 1024); } while (0)
#define PG8_MMA(ai, bj, At, Bt) do { __builtin_amdgcn_s_setprio(1); _Pragma("unroll") for (int m = 0; m < 4; ++m) _Pragma("unroll") for (int n = 0; n < 2; ++n) _Pragma("unroll") for (int k = 0; k < 2; ++k) \
        acc[ai][bj][m][n] = __builtin_amdgcn_mfma_f32_16x16x32_bf16(Bt[n][k], At[m][k], acc[ai][bj][m][n], 0, 0, 0); __builtin_amdgcn_s_setprio(0); } while (0)
#define PG8_WAIT_V(n) asm volatile("s_waitcnt vmcnt(" #n ")" ::: "memory")
#define PG8_WAIT_L(n) asm volatile("s_waitcnt lgkmcnt(" #n ")" ::: "memory")
#define PG8_BAR __builtin_amdgcn_s_barrier()
#define PG8_SCHED __builtin_amdgcn_sched_barrier(0)
    Unit cur, nxt; int ui = 0;
    if (!S.next(0, cur)) return;
    f32x4 acc[2][2][4][2];
#pragma unroll
    for (int a = 0; a < 2; ++a)
#pragma unroll
        for (int b = 0; b < 2; ++b)
#pragma unroll
            for (int m = 0; m < 4; ++m)
#pragma unroll
                for (int n = 0; n < 2; ++n) acc[a][b][m][n] = (f32x4){0.f, 0.f, 0.f, 0.f};
    bf16x8 At[4][2], B0[2][2], B1[2][2];
    const char* cA = uni_ptr(S.a_base(cur, tstep)); const char* cB = uni_ptr(S.b_base(cur, tstep));
    S.a_ready(cur);
    if constexpr (SP2) {
        PG8_STAGE(PG8_SB(0, 0), cB, voffB); PG8_STAGE(PG8_SB(0, 1), cB + hstep, voffB); PG8_STAGE(PG8_SA(0, 0), cA, voffA); PG8_STAGE(PG8_SA(0, 1), cA + hstep, voffA);
        if (wr == 1) PG8_BAR;
        PG8_WAIT_V(2); PG8_BAR;
        PG8_STAGE(PG8_SB(1, 0), cB + kstep, voffB); PG8_STAGE(PG8_SA(1, 0), cA + kstep, voffA); PG8_STAGE(PG8_SB(1, 1), cB + hstep + kstep, voffB);
        PG8_WAIT_V(6); PG8_BAR;
    } else {
        PG8_STAGE(PG8_SB(0, 0), cB, voffB); PG8_STAGE(PG8_SA(0, 0), cA, voffA); PG8_STAGE(PG8_SB(0, 1), cB + hstep, voffB); PG8_STAGE(PG8_SA(0, 1), cA + hstep, voffA);
        if (wr == 1) PG8_BAR;
        PG8_WAIT_V(4); PG8_BAR;
        PG8_STAGE(PG8_SB(1, 0), cB + kstep, voffB); PG8_STAGE(PG8_SA(1, 0), cA + kstep, voffA); PG8_STAGE(PG8_SB(1, 1), cB + hstep + kstep, voffB);
        PG8_WAIT_V(6); PG8_BAR;
    }
    for (;;) {
        const bool has_next = S.next(ui + 1, nxt);
        const char* nA = uni_ptr(has_next ? S.a_base(nxt, tstep) : cA); const char* nB = uni_ptr(has_next ? S.b_base(nxt, tstep) : cB);
        for (int t = 0; t < nt; t += 2) {
            const bool last = (t == nt - 2);
            const char* a1 = cA + (size_t)(t + 1) * kstep;
            const char* a2 = last ? nA : cA + (size_t)(t + 2) * kstep; const char* b2 = last ? nB : cB + (size_t)(t + 2) * kstep;
            const char* a3 = a2 + kstep; const char* b3 = b2 + kstep;
            if (last && has_next) S.a_ready(nxt);
            if constexpr (SP2) {
            PG8_LDB(B0, 0, 0); PG8_LDB(B1, 0, 1); PG8_SCHED; PG8_LDA(At, 0, 0); PG8_STAGE(PG8_SA(1, 1), a1 + hstep, voffA);
            PG8_WAIT_V(8); PG8_WAIT_L(0); PG8_BAR; PG8_MMA(0, 0, At, B0); PG8_MMA(0, 1, At, B1); PG8_BAR; PG8_SCHED;
            PG8_LDA(At, 0, 1); PG8_STAGE(PG8_SB(0, 0), b2, voffB); PG8_STAGE(PG8_SB(0, 1), b2 + hstep, voffB); PG8_STAGE(PG8_SA(0, 0), a2, voffA);
            PG8_WAIT_V(8); PG8_WAIT_L(0); PG8_BAR; PG8_MMA(1, 0, At, B0); PG8_MMA(1, 1, At, B1); PG8_BAR; PG8_SCHED;
            PG8_LDB(B0, 1, 0); PG8_LDB(B1, 1, 1); PG8_SCHED; PG8_LDA(At, 1, 0); PG8_STAGE(PG8_SA(0, 1), a2 + hstep, voffA);
            PG8_WAIT_V(8); PG8_WAIT_L(0); PG8_BAR; PG8_MMA(0, 0, At, B0); PG8_MMA(0, 1, At, B1); PG8_BAR; PG8_SCHED;
            PG8_LDA(At, 1, 1); PG8_STAGE(PG8_SB(1, 0), b3, voffB); PG8_STAGE(PG8_SB(1, 1), b3 + hstep, voffB); PG8_STAGE(PG8_SA(1, 0), a3, voffA);
            PG8_WAIT_V(8); PG8_WAIT_L(0); PG8_BAR; PG8_MMA(1, 0, At, B0); PG8_MMA(1, 1, At, B1); PG8_BAR; PG8_SCHED;
            } else {
            PG8_LDB(B0, 0, 0); PG8_SCHED; PG8_LDA(At, 0, 0); PG8_STAGE(PG8_SA(1, 1), a1 + hstep, voffA);
            PG8_WAIT_L(8); PG8_BAR; PG8_WAIT_L(0); PG8_MMA(0, 0, At, B0); PG8_BAR; PG8_SCHED;
            PG8_LDB(B1, 0, 1); PG8_STAGE(PG8_SB(0, 0), b2, voffB);
            PG8_BAR; PG8_WAIT_L(0); PG8_MMA(0, 1, At, B1); PG8_BAR;
            PG8_LDA(At, 0, 1); PG8_STAGE(PG8_SA(0, 0), a2, voffA);
            PG8_BAR; PG8_WAIT_L(0); PG8_MMA(1, 0, At, B0); PG8_BAR; PG8_SCHED;
            PG8_STAGE(PG8_SB(0, 1), b2 + hstep, voffB);
            PG8_WAIT_V(6); PG8_BAR; PG8_MMA(1, 1, At, B1); PG8_BAR;
            PG8_LDB(B0, 1, 0); PG8_SCHED; PG8_LDA(At, 1, 0); PG8_STAGE(PG8_SA(0, 1), a2 + hstep, voffA);
            PG8_WAIT_L(8); PG8_BAR; PG8_WAIT_L(0); PG8_MMA(0, 0, At, B0); PG8_BAR; PG8_SCHED;
            PG8_LDB(B1, 1, 1); PG8_STAGE(PG8_SB(1, 0), b3, voffB);
            PG8_BAR; PG8_WAIT_L(0); PG8_MMA(0, 1, At, B1); PG8_BAR;
            PG8_LDA(At, 1, 1); PG8_STAGE(PG8_SA(1, 0), a3, voffA);
            PG8_BAR; PG8_WAIT_L(0); PG8_MMA(1, 0, At, B0); PG8_BAR; PG8_SCHED;
            PG8_STAGE(PG8_SB(1, 1), b3 + hstep, voffB);
            PG8_WAIT_V(6); PG8_BAR; PG8_MMA(1, 1, At, B1); PG8_BAR;
            }
        }
        if constexpr (ALIGN_EPI) { if (wr == 0) PG8_BAR; }
        if constexpr (!Epi::AFTER_DRAIN) { E(acc, cur, wr, wc, fr, fq); S.done(cur); }
        if (!has_next) break;
#pragma unroll
        for (int a = 0; a < 2; ++a)
#pragma unroll
            for (int b = 0; b < 2; ++b)
#pragma unroll
                for (int m = 0; m < 4; ++m)
#pragma unroll
                    for (int n = 0; n < 2; ++n) acc[a][b][m][n] = (f32x4){0.f, 0.f, 0.f, 0.f};
        cur = nxt; cA = nA; cB = nB; ++ui;
        if constexpr (ALIGN_EPI) { if (wr == 1) PG8_BAR; }
    }
    PG8_WAIT_V(0);
    if constexpr (!ALIGN_EPI) { if (wr == 0) PG8_BAR; }
    PG8_BAR;
    if constexpr (Epi::AFTER_DRAIN) { E.fused(acc, cur, wr, wc, fr, fq, lds, wid, lane); S.done(cur); }
#undef PG8_SA
#undef PG8_SB
#undef PG8_STAGE
#undef PG8_LDA
#undef PG8_LDB
#undef PG8_MMA
#undef PG8_WAIT_V
#undef PG8_WAIT_L
#undef PG8_BAR
#undef PG8_SCHED
}
}

constexpr int NWAVES = 8, NTHR = 512;
constexpr int D = 1024, NB = 8, SEQ = 4096, CTXL = 256, NL = 2;
constexpr int NLAT = NB * SEQ;
constexpr int NCTX = NB * CTXL;
constexpr int MT = NLAT + NCTX;
constexpr int INW = 2576, NEXP = 32, TOPK = 4;
constexpr int PMAX = (MT * TOPK / 256 + NEXP) * 256;
constexpr float EPS = 1e-6f;

constexpr size_t MiB = 1u << 20;
constexpr size_t WS_CTL = 0, CTL_ZERO_BYTES = 1 * MiB;
constexpr size_t WS_MODV = 1 * MiB;
constexpr size_t WS_WRT = 2 * MiB;
constexpr size_t WS_WABT = WS_WRT + 512 * 1024;
constexpr size_t WS_SELE = 3 * MiB;
constexpr size_t WS_SELP = WS_SELE + 640 * 1024;
constexpr size_t WS_SELG = WS_SELP + 640 * 1024;
constexpr size_t WS_G = 5 * MiB;
constexpr size_t WS_BETA = WS_G + 1536 * 1024;
constexpr size_t WS_AB = 8 * MiB;
constexpr size_t WS_WIN = 12 * MiB;
constexpr size_t WS_WOUT = 24 * MiB;
constexpr size_t WS_DFTM = 32 * MiB;
constexpr size_t WS_W1 = 96 * MiB;
constexpr size_t WS_W2 = 224 * MiB;
constexpr size_t WS_XC = 288 * MiB;
constexpr size_t WS_ACT = 296 * MiB;
constexpr size_t WS_S = 364 * MiB;
constexpr size_t WS_QKVZ = WS_S;
constexpr size_t WS_ZTL = WS_S + 136 * MiB;
constexpr size_t WS_ZTC = WS_ZTL + 64 * MiB;
constexpr size_t WS_QKVN = WS_ZTC + 4 * MiB;
constexpr size_t WS_OF = WS_QKVN + 102 * MiB;
constexpr size_t WS_OB = WS_OF + 34 * MiB;
constexpr size_t WS_XS = WS_S;
constexpr size_t WS_HS = WS_S + 288 * MiB;
constexpr size_t WS_EO = 984 * MiB;
constexpr size_t WS_AB2 = WS_ZTL;
constexpr size_t WS_ZN = 11 * MiB - 64 * 1024;
constexpr size_t WS_END = 1024 * MiB;
static_assert(WS_OB + 34 * MiB <= WS_END && WS_HS + 288 * MiB <= WS_END && (size_t)PMAX * 1024 * 2 == 288 * MiB, "d_ws map");
static_assert((size_t)MT * 16 <= 640 * 1024 && (size_t)MT * 32 <= 1536 * 1024, "sel / g maps");
constexpr int CW_BAR = 4096;
constexpr int CW_GCNT = 16384;

constexpr int RING_BYTES = 131072;
constexpr int LDSCTL_OFF = RING_BYTES, MISC_OFF = LDSCTL_OFF + 320;
constexpr int XT_OFF = RING_BYTES + 1024;
constexpr int LDS_BYTES = 147456;

#define GAS __attribute__((address_space(1)))
#define LAS __attribute__((address_space(3)))
typedef unsigned short bf16;
typedef unsigned v4u __attribute__((ext_vector_type(4)));
typedef unsigned v2u __attribute__((ext_vector_type(2)));
typedef float f32x4 __attribute__((ext_vector_type(4)));
typedef GAS unsigned gu32;
#define RLX_AGENT __ATOMIC_RELAXED, __HIP_MEMORY_SCOPE_AGENT
#define LDS_WAIT() asm volatile("s_waitcnt lgkmcnt(0)" ::: "memory")
#define VM_WAIT() asm volatile("s_waitcnt vmcnt(0)" ::: "memory")
typedef float f32x2_t __attribute__((ext_vector_type(2))); typedef __bf16 bf16x2_t __attribute__((ext_vector_type(2)));
__device__ __forceinline__ unsigned pk2(float lo, float hi) { const f32x2_t v = {lo, hi}; const bf16x2_t b = __builtin_convertvector(v, bf16x2_t); return __builtin_bit_cast(unsigned, b); }
__device__ __forceinline__ unsigned f2bf(float f) { return pk2(f, 0.f) & 0xffffu; }
__device__ __forceinline__ float bflo(unsigned w) { return __builtin_bit_cast(float, w << 16); }
__device__ __forceinline__ float bfhi(unsigned w) { return __builtin_bit_cast(float, w & 0xffff0000u); }
__device__ __forceinline__ float wave_sum(float v) {
#pragma unroll
    for (int o = 1; o < 64; o <<= 1) v += __shfl_xor(v, o);
    return v;
}
__device__ __forceinline__ float sum16(float v) {
#pragma unroll
    for (int o = 1; o < 16; o <<= 1) v += __shfl_xor(v, o);
    return v;
}
__device__ __forceinline__ float rs32(float (&p)[32], int lane) {
#pragma unroll
    for (int e = 0; e < 16; ++e) { const bool up = (lane & 32) != 0; const float send = up ? p[e] : p[e + 16], keep = up ? p[e + 16] : p[e]; p[e] = keep + __shfl_xor(send, 32); }
#pragma unroll
    for (int e = 0; e < 8; ++e) { const bool up = (lane & 16) != 0; const float send = up ? p[e] : p[e + 8], keep = up ? p[e + 8] : p[e]; p[e] = keep + __shfl_xor(send, 16); }
#pragma unroll
    for (int e = 0; e < 4; ++e) { const bool up = (lane & 8) != 0; const float send = up ? p[e] : p[e + 4], keep = up ? p[e + 4] : p[e]; p[e] = keep + __shfl_xor(send, 8); }
#pragma unroll
    for (int e = 0; e < 2; ++e) { const bool up = (lane & 4) != 0; const float send = up ? p[e] : p[e + 2], keep = up ? p[e + 2] : p[e]; p[e] = keep + __shfl_xor(send, 4); }
    { const bool up = (lane & 2) != 0; const float send = up ? p[0] : p[1], keep = up ? p[1] : p[0]; p[0] = keep + __shfl_xor(send, 2); }
    return p[0] + __shfl_xor(p[0], 1);
}
__device__ __forceinline__ float rs16(float (&p)[16], int lane) {
#pragma unroll
    for (int e = 0; e < 8; ++e) { const bool up = (lane & 32) != 0; const float send = up ? p[e] : p[e + 8], keep = up ? p[e + 8] : p[e]; p[e] = keep + __shfl_xor(send, 32); }
#pragma unroll
    for (int e = 0; e < 4; ++e) { const bool up = (lane & 16) != 0; const float send = up ? p[e] : p[e + 4], keep = up ? p[e + 4] : p[e]; p[e] = keep + __shfl_xor(send, 16); }
#pragma unroll
    for (int e = 0; e < 2; ++e) { const bool up = (lane & 8) != 0; const float send = up ? p[e] : p[e + 2], keep = up ? p[e + 2] : p[e]; p[e] = keep + __shfl_xor(send, 8); }
    { const bool up = (lane & 4) != 0; const float send = up ? p[0] : p[1], keep = up ? p[1] : p[0]; p[0] = keep + __shfl_xor(send, 4); }
    float r = p[0] + __shfl_xor(p[0], 2);
    return r + __shfl_xor(r, 1);
}
__device__ __forceinline__ float silu_f(float x) { return x / (1.f + __expf(-x)); }

#define XB_TMO      128
#define XB_XCNT(j)  (256  + 64 * (j))
#define XB_XSUB(j)  (1280 + 64 * (j))
#define XB_XGEN(j)  (2304 + 64 * (j))
#define XB_TOP      3328
#define XB_TOPGEN   3392
#define XCD_BAR_WORDS 3456
#define XB_SPIN_CAP (1u << 18)
__device__ __forceinline__ unsigned xb_ld(unsigned* p)              { return __hip_atomic_load(p, __ATOMIC_RELAXED, __HIP_MEMORY_SCOPE_AGENT); }
__device__ __forceinline__ unsigned xb_add(unsigned* p, unsigned v) { return __hip_atomic_fetch_add(p, v, __ATOMIC_RELAXED, __HIP_MEMORY_SCOPE_AGENT); }
__device__ __forceinline__ unsigned xb_xcc_id() { return (unsigned)__builtin_amdgcn_s_getreg((3 << 11) | 20) & 0xFu; }
#define XB_SPIN(cond, bar) do { unsigned _sp = 0; while (cond) { __builtin_amdgcn_s_sleep(1); \
    if ((++_sp & 255u) == 0u) { if (xb_ld(&(bar)[XB_TMO])) break; if (_sp > XB_SPIN_CAP) { atomicAdd(&(bar)[XB_TMO], 1u); break; } } } } while (0)
struct XcdBarrier { unsigned* bar; unsigned x; volatile LAS unsigned* st; };
__device__ __forceinline__ XcdBarrier xcd_barrier_post(unsigned* bar, volatile LAS unsigned* st, int tid) {
    XcdBarrier b; b.bar = bar; b.x = xb_xcc_id(); b.st = st;
    if (tid == 0) (void)xb_add(&bar[XB_XCNT(b.x)], 1u);
    return b;
}
__device__ __forceinline__ void xcd_barrier_complete(unsigned* bar, unsigned x, unsigned& nloc, unsigned& nx) {
    const unsigned G = gridDim.x * gridDim.y * gridDim.z;
    unsigned sum, cnt, mine, sp = 0u;
    for (;;) {
        sum = 0u; cnt = 0u; mine = 0u;
#pragma unroll
        for (unsigned j = 0; j < 16; ++j) { const unsigned c = xb_ld(&bar[XB_XCNT(j)]); sum += c; cnt += (c > 0u) ? 1u : 0u; mine = (j == x) ? c : mine; }
        if (sum == G) break;
        __builtin_amdgcn_s_sleep(1);
        if ((++sp & 255u) == 0u) { if (xb_ld(&bar[XB_TMO])) break; if (sp > XB_SPIN_CAP) { atomicAdd(&bar[XB_TMO], 1u); break; } }
    }
    nloc = mine > 0u ? mine : 1u; nx = cnt > 0u ? cnt : 1u;
}
__device__ __forceinline__ void xcd_barrier(const XcdBarrier& b, int tid) {
    asm volatile("s_waitcnt vmcnt(0)" ::: "memory");
    __syncthreads();
    if (tid == 0) {
        unsigned* bar = b.bar; unsigned bx = b.x;
        asm volatile("" : "+v"(bar), "+v"(bx));
        __builtin_amdgcn_s_waitcnt(0);
        unsigned nloc = b.st[0], nx = b.st[1];
        if (nloc == 0u) { xcd_barrier_complete(bar, bx, nloc, nx); b.st[0] = nloc; b.st[1] = nx; }
        const unsigned old = xb_add(&bar[XB_XSUB(bx)], 1u);
        const unsigned gen = old / nloc;
        if (old + 1u == (gen + 1u) * nloc) {
            __builtin_amdgcn_fence(__ATOMIC_RELEASE, "agent");
            asm volatile("s_waitcnt vmcnt(0)" ::: "memory");
            const unsigned og = xb_add(&bar[XB_TOP], 1u);
            const unsigned tg = og / nx;
            if (og + 1u == (tg + 1u) * nx) xb_add(&bar[XB_TOPGEN], 1u);
            else XB_SPIN(xb_ld(&bar[XB_TOPGEN]) == tg, bar);
            __builtin_amdgcn_fence(__ATOMIC_ACQUIRE, "agent");
            xb_add(&bar[XB_XGEN(bx)], 1u);
            asm volatile("s_waitcnt vmcnt(0)" ::: "memory");
        } else {
            XB_SPIN(xb_ld(&bar[XB_XGEN(bx)]) == gen, bar);
            __builtin_amdgcn_fence(__ATOMIC_ACQUIRE, "agent");
            asm volatile("s_waitcnt vmcnt(0)" ::: "memory");
        }
    }
    __syncthreads();
}

struct Args { const float* in[23]; float* out; unsigned char* ws; int ph_lo, ph_hi; };
struct Frame {
    LAS unsigned char* lds;
    volatile LAS unsigned* MISC;
    unsigned* ctl;
    unsigned char* ws;
    int tid, lane, wave, vcu, G, gw, NGW;
    float* out;
};
typedef const Args __attribute__((address_space(4)))* KArgsP;
__device__ __forceinline__ KArgsP kargs() { unsigned long long v = (unsigned long long)__builtin_amdgcn_kernarg_segment_ptr(); asm volatile("" : "+s"(v)); return (KArgsP)v; }
enum InIdx { I_X = 0, I_C, I_CTX, I_CCTX, I_WMOD, I_BMOD, I_GN1, I_WIN, I_CONVW, I_ALOG, I_DTB, I_GOUT, I_WOUT, I_GN2, I_WR, I_BR, I_WG, I_BG, I_WU, I_BU, I_WD, I_BD, I_GF };
__device__ __forceinline__ float* xr_row(const Frame& F, int t) { return t < NLAT ? F.out + (size_t)t * D : (float*)(F.ws + WS_XC) + (size_t)(t - NLAT) * D; }
__device__ __forceinline__ int mod_row(int t) { return t < NLAT ? (t >> 12) : 8; }
__device__ __forceinline__ const float* modv(const Frame& F, int l, int r, int piece) { return (const float*)(F.ws + WS_MODV) + ((size_t)(l * 9 + r) * 6 + piece) * D; }

struct SchedIn {
    const bf16* hx; const bf16* win; int G, c;
    static constexpr int N0 = (MT / 256) * 8, N1 = 4 * (MT / 256), NWG = N0 + N1;
    __device__ __forceinline__ bool next(int i, pg8::Unit& u) const {
        const long L = (long)i * G + c; if (L >= NWG) return false;
        int w = pg8::xcd_remap((int)L, NWG);
        if (w < N0) { u.kind = 0; pg8::grp_decode(w, MT / 256, 8, u.pm, u.pn); } else { w -= N0; u.kind = 1; u.pn = w >> 2; u.pm = w & 3; }
        u.e = 0; return true;
    }
    __device__ __forceinline__ const char* a_base(const pg8::Unit& u, size_t tstep) const { return u.kind == 0 ? (const char*)hx + (size_t)u.pm * tstep : (const char*)win + (size_t)(8 + u.pm) * tstep; }
    __device__ __forceinline__ const char* b_base(const pg8::Unit& u, size_t tstep) const { return u.kind == 0 ? (const char*)win + (size_t)u.pn * tstep : (const char*)hx + (size_t)u.pn * tstep; }
    __device__ __forceinline__ void a_ready(const pg8::Unit&) const {}
    __device__ __forceinline__ void done(const pg8::Unit&) const {}
};
struct EpiIn {
    static constexpr bool PERM = true, AFTER_DRAIN = false;
    bf16* qkvz; bf16* ztl; bf16* ztc;
    __device__ __forceinline__ void operator()(const pg8::f32x4 (&acc)[2][2][4][2], const pg8::Unit& u, int wr, int wc, int fr_, int fq_) const {
        int fr = fr_, fq = fq_; asm volatile("" : "+v"(fr), "+v"(fq));
        const int row0 = u.pm * 256 + wr * 64 + fr, cin = wc * 32 + 8 * fq;
        bf16* base; size_t ldc;
        if (u.kind == 0) { base = qkvz + (size_t)u.pn * 256 + cin; ldc = 2048; }
        else if (u.pn < 128) { base = ztl + (size_t)(u.pn >> 4) * 1024 * 4096 + (size_t)(u.pn & 15) * 256 + cin; ldc = 4096; }
        else { base = ztc + (size_t)(u.pn - 128) * 1024 * 256 + cin; ldc = 256; }
#pragma unroll
        for (int ai = 0; ai < 2; ++ai)
#pragma unroll
            for (int m = 0; m < 4; ++m) { bf16* rowp = base + (size_t)(row0 + ai * 128 + m * 16) * ldc;
#pragma unroll
                for (int bj = 0; bj < 2; ++bj) { const pg8::f32x4 v0 = acc[ai][bj][m][0], v1 = acc[ai][bj][m][1]; pg8::u32x4 w;
                    w.x = pg8::cvt_pk_bf16(v0[0], v0[1]); w.y = pg8::cvt_pk_bf16(v0[2], v0[3]); w.z = pg8::cvt_pk_bf16(v1[0], v1[1]); w.w = pg8::cvt_pk_bf16(v1[2], v1[3]);
                    *(pg8::u32x4*)(rowp + bj * 128) = w; } }
    }
};
struct SchedDft {
    const bf16* dftm; const bf16* eo; int G, c;
    __device__ __forceinline__ bool next(int i, pg8::Unit& u) const {
        const long L = (long)i * G + c; if (L >= 256) return false;
        const int w = pg8::xcd_remap((int)L, 256), x = w >> 5, j = w & 31;
        u.kind = x & 1; u.pm = 4 * ((x >> 1) & 1) + (j & 3); u.e = 4 * (x >> 2) + ((j >> 2) & 3); u.pn = j >> 4; return true;
    }
    __device__ __forceinline__ const char* a_base(const pg8::Unit& u, size_t tstep) const { return (const char*)dftm + (size_t)u.kind * (2048 * 2048 * 2) + (size_t)u.pm * tstep; }
    __device__ __forceinline__ const char* b_base(const pg8::Unit& u, size_t tstep) const { return (const char*)eo + (size_t)(u.e * 2 + u.kind) * (512 * 2048 * 2) + (size_t)u.pn * tstep; }
    __device__ __forceinline__ void a_ready(const pg8::Unit&) const {}
    __device__ __forceinline__ void done(const pg8::Unit&) const {}
};
struct EpiDft {
    static constexpr bool PERM = true, AFTER_DRAIN = false;
    bf16* ab2;
    __device__ __forceinline__ void operator()(const pg8::f32x4 (&acc)[2][2][4][2], const pg8::Unit& u, int wr, int wc, int fr_, int fq_) const {
        int fr = fr_, fq = fq_; asm volatile("" : "+v"(fr), "+v"(fq));
        const int row0 = u.pm * 256 + wr * 64 + fr, col0 = u.pn * 256 + wc * 32 + 8 * fq;
        bf16* base = ab2 + (size_t)(u.e * 2 + u.kind) * 2048 * 512;
#pragma unroll
        for (int ai = 0; ai < 2; ++ai)
#pragma unroll
            for (int m = 0; m < 4; ++m) { bf16* rowp = base + (size_t)(row0 + ai * 128 + m * 16) * 512 + col0;
#pragma unroll
                for (int bj = 0; bj < 2; ++bj) { const pg8::f32x4 v0 = acc[ai][bj][m][0], v1 = acc[ai][bj][m][1]; pg8::u32x4 w;
                    w.x = pg8::cvt_pk_bf16(v0[0], v0[1]); w.y = pg8::cvt_pk_bf16(v0[2], v0[3]); w.z = pg8::cvt_pk_bf16(v1[0], v1[1]); w.w = pg8::cvt_pk_bf16(v1[2], v1[3]);
                    *(pg8::u32x4*)(rowp + bj * 128) = w; } }
    }
};
struct SchedOut {
    const bf16* mix; const bf16* wout; int nM, G, c;
    __device__ __forceinline__ bool next(int i, pg8::Unit& u) const {
        const int nwg = nM * 4; const long L = (long)i * G + c; if (L >= nwg) return false;
        pg8::grp_decode(pg8::xcd_remap((int)L, nwg), nM, 4, u.pm, u.pn); u.kind = 0; u.e = 0; return true;
    }
    __device__ __forceinline__ const char* a_base(const pg8::Unit& u, size_t tstep) const { return (const char*)mix + (size_t)u.pm * tstep; }
    __device__ __forceinline__ const char* b_base(const pg8::Unit& u, size_t tstep) const { return (const char*)wout + (size_t)u.pn * tstep; }
    __device__ __forceinline__ void a_ready(const pg8::Unit&) const {}
    __device__ __forceinline__ void done(const pg8::Unit&) const {}
};
struct EpiOut {
    static constexpr bool PERM = false, AFTER_DRAIN = false;
    float* xlat; float* xctx; const float* gt1; float dsc;
    __device__ __forceinline__ void operator()(const pg8::f32x4 (&acc)[2][2][4][2], const pg8::Unit& u, int wr, int wc, int fr_, int fq_) const {
        int fr = fr_, fq = fq_; asm volatile("" : "+v"(fr), "+v"(fq));
        const int col0 = u.pn * 256 + wc * 32 + 4 * fq, rl = wr * 64 + fr;
        float* xb = u.pm < 128 ? xlat + (size_t)u.pm * 256 * D : xctx + (size_t)(u.pm - 128) * 256 * D;
        const float* g = gt1 + (size_t)(u.pm < 128 ? (u.pm >> 4) : 8) * 6 * D + col0;
        pg8::f32x4 gv[2][2];
#pragma unroll
        for (int bj = 0; bj < 2; ++bj)
#pragma unroll
            for (int n = 0; n < 2; ++n) gv[bj][n] = *(const pg8::f32x4*)(g + bj * 128 + n * 16);
#pragma unroll
        for (int ai = 0; ai < 2; ++ai)
#pragma unroll
            for (int m = 0; m < 4; ++m) { float* rowp = xb + (size_t)(rl + ai * 128 + m * 16) * D + col0;
#pragma unroll
                for (int bj = 0; bj < 2; ++bj)
#pragma unroll
                    for (int n = 0; n < 2; ++n) { pg8::f32x4* p = (pg8::f32x4*)(rowp + bj * 128 + n * 16); const pg8::f32x4 xo = *p; *p = xo + gv[bj][n] * acc[ai][bj][m][n] * dsc; }
                if (m & 1) asm volatile("" ::: "memory"); }
    }
};
struct SchedMoe {
    const bf16* A; const bf16* W; size_t wstride; const LAS int* pend; int nM, nN, G, c;
    __device__ __forceinline__ bool next(int i, pg8::Unit& u) const {
        const int nwg = nM * nN; const long L = (long)i * G + c; if (L >= nwg) return false;
        pg8::grp_decode(pg8::xcd_remap((int)L, nwg), nM, nN, u.pm, u.pn);
        int e = 0;
#pragma unroll 1
        for (int j = 0; j < NEXP - 1; ++j) e += (pend[j] <= u.pm) ? 1 : 0;
        u.e = e; u.kind = 0; return true;
    }
    __device__ __forceinline__ const char* a_base(const pg8::Unit& u, size_t tstep) const { return (const char*)A + (size_t)u.pm * tstep; }
    __device__ __forceinline__ const char* b_base(const pg8::Unit& u, size_t tstep) const { return (const char*)W + (size_t)u.e * wstride + (size_t)u.pn * tstep; }
    __device__ __forceinline__ void a_ready(const pg8::Unit&) const {}
    __device__ __forceinline__ void done(const pg8::Unit&) const {}
};
struct EpiSwiglu {
    static constexpr bool PERM = true, AFTER_DRAIN = false;
    bf16* hs; const float* bg; const float* bu;
    __device__ __forceinline__ void operator()(const pg8::f32x4 (&acc)[2][2][4][2], const pg8::Unit& u, int wr, int wc, int fr_, int fq_) const {
        int fr = fr_, fq = fq_; asm volatile("" : "+v"(fr), "+v"(fq));
        const int row0 = u.pm * 256 + wr * 64 + fr, f0 = u.pn * 128 + wc * 32 + 8 * fq;
        const pg8::f32x4 bg0 = *(const pg8::f32x4*)(bg + u.e * D + f0), bg1 = *(const pg8::f32x4*)(bg + u.e * D + f0 + 4);
        const pg8::f32x4 bu0 = *(const pg8::f32x4*)(bu + u.e * D + f0), bu1 = *(const pg8::f32x4*)(bu + u.e * D + f0 + 4);
#pragma unroll
        for (int ai = 0; ai < 2; ++ai)
#pragma unroll
            for (int m = 0; m < 4; ++m) {
                float h[8];
#pragma unroll
                for (int n = 0; n < 2; ++n) { const pg8::f32x4 ga = acc[ai][0][m][n] + (n ? bg1 : bg0), ua = acc[ai][1][m][n] + (n ? bu1 : bu0);
#pragma unroll
                    for (int j = 0; j < 4; ++j) { const float a = fminf(ga[j], 7.0f), uu = fminf(fmaxf(ua[j], -7.0f), 7.0f);
                        h[n * 4 + j] = a * __builtin_amdgcn_rcpf(1.0f + __expf(-1.702f * a)) * (uu + 1.0f); } }
                pg8::u32x4 w; w.x = pg8::cvt_pk_bf16(h[0], h[1]); w.y = pg8::cvt_pk_bf16(h[2], h[3]); w.z = pg8::cvt_pk_bf16(h[4], h[5]); w.w = pg8::cvt_pk_bf16(h[6], h[7]);
                *(pg8::u32x4*)(hs + (size_t)(row0 + ai * 128 + m * 16) * D + f0) = w; }
    }
};
struct EpiDown {
    static constexpr bool PERM = true, AFTER_DRAIN = false;
    bf16* ys; const float* bd;
    __device__ __forceinline__ void operator()(const pg8::f32x4 (&acc)[2][2][4][2], const pg8::Unit& u, int wr, int wc, int fr_, int fq_) const {
        int fr = fr_, fq = fq_; asm volatile("" : "+v"(fr), "+v"(fq));
        const int row0 = u.pm * 256 + wr * 64 + fr, col0 = u.pn * 256 + wc * 32 + 8 * fq;
        pg8::f32x4 bv[2][2];
#pragma unroll
        for (int bj = 0; bj < 2; ++bj)
#pragma unroll
            for (int n = 0; n < 2; ++n) bv[bj][n] = *(const pg8::f32x4*)(bd + u.e * D + col0 + bj * 128 + 4 * n);
#pragma unroll
        for (int ai = 0; ai < 2; ++ai)
#pragma unroll
            for (int m = 0; m < 4; ++m) { bf16* rowp = ys + (size_t)(row0 + ai * 128 + m * 16) * D + col0;
#pragma unroll
                for (int bj = 0; bj < 2; ++bj) { const pg8::f32x4 v0 = acc[ai][bj][m][0] + bv[bj][0], v1 = acc[ai][bj][m][1] + bv[bj][1]; pg8::u32x4 w;
                    w.x = pg8::cvt_pk_bf16(v0[0], v0[1]); w.y = pg8::cvt_pk_bf16(v0[2], v0[3]); w.z = pg8::cvt_pk_bf16(v1[0], v1[1]); w.w = pg8::cvt_pk_bf16(v1[2], v1[3]);
                    *(pg8::u32x4*)(rowp + bj * 128) = w; } }
    }
};

__device__ __forceinline__ void transpose_item(const float* W, int ldw, int col0, int K, bf16* WT, int drow0, LAS float* scr, int kb, int lane) {
    const int k0 = 64 * kb;
#pragma unroll 8
    for (int i = 0; i < 32; ++i) { const int kk = 2 * i + (lane >> 5); scr[kk * 33 + (lane & 31)] = W[(size_t)(k0 + kk) * ldw + col0 + (lane & 31)]; }
    LDS_WAIT(); asm volatile("" ::: "memory");
    const int c = lane & 7;
#pragma unroll
    for (int j = 0; j < 4; ++j) { const int n = (lane >> 3) + 8 * j; const LAS float* s = scr + (8 * c) * 33 + n;
        v4u o; o.x = pk2(s[0 * 33], s[1 * 33]); o.y = pk2(s[2 * 33], s[3 * 33]); o.z = pk2(s[4 * 33], s[5 * 33]); o.w = pk2(s[6 * 33], s[7 * 33]);
        *(v4u*)(WT + (size_t)(drow0 + n) * K + k0 + 8 * c) = o; }
    LDS_WAIT(); asm volatile("" ::: "memory");
}
__device__ __forceinline__ void convert_experts(const Frame& F, int l) {
    const KArgsP A = kargs();
    LAS float* scr = (LAS float*)(F.lds + F.wave * 16384);
    bf16* W1 = (bf16*)(F.ws + WS_W1); bf16* W2 = (bf16*)(F.ws + WS_W2);
    constexpr int IPM = 16 * 32;
    for (int it = F.gw; it < 3 * NEXP * IPM; it += F.NGW) {
        const int which = it / (NEXP * IPM), r = it % (NEXP * IPM), e = r / IPM, q = r % IPM, kb = q >> 5, nb = q & 31;
        const size_t moff = ((size_t)l * NEXP + e) * D * D;
        if (which == 0) transpose_item(A->in[I_WG] + moff, D, nb * 32, D, W1 + (size_t)e * 2048 * D, 256 * (nb >> 2) + 32 * (nb & 3), scr, kb, F.lane);
        else if (which == 1) transpose_item(A->in[I_WU] + moff, D, nb * 32, D, W1 + (size_t)e * 2048 * D, 256 * (nb >> 2) + 128 + 32 * (nb & 3), scr, kb, F.lane);
        else transpose_item(A->in[I_WD] + moff, D, nb * 32, D, W2 + (size_t)e * D * D, nb * 32, scr, kb, F.lane);
    }
}
__device__ __forceinline__ void p0_prologue(const Frame& F) {
    const KArgsP A = kargs();
    float* mv = (float*)(F.ws + WS_MODV);
    {
        LAS float* sc = (LAS float*)F.lds;
        LAS float* red = sc + 9 * 1024;
        for (int i = F.tid; i < 9 * 1024; i += NTHR) { const int r = i >> 10, k = i & 1023; sc[i] = silu_f(r < 8 ? A->in[I_C][r * D + k] : A->in[I_CCTX][k]); }
        __syncthreads();
        for (int item = blockIdx.x; item < 192; item += F.G) {
            const int l = item / 96, cg = item % 96, cl = F.tid & 63, ks = F.tid >> 6;
            const float* w = A->in[I_WMOD] + ((size_t)l * D + ks * 128) * 6144 + cg * 64 + cl;
            float a[9];
#pragma unroll
            for (int r = 0; r < 9; ++r) a[r] = 0.f;
#pragma unroll 4
            for (int k = 0; k < 128; ++k) { const float wv = w[(size_t)k * 6144];
#pragma unroll
                for (int r = 0; r < 9; ++r) a[r] += sc[r * 1024 + ks * 128 + k] * wv; }
#pragma unroll
            for (int r = 0; r < 9; ++r) red[(ks * 9 + r) * 64 + cl] = a[r];
            __syncthreads();
            for (int i = F.tid; i < 9 * 64; i += NTHR) { const int r = i >> 6, cc = i & 63; float s = 0.f;
#pragma unroll
                for (int k2 = 0; k2 < 8; ++k2) s += red[(k2 * 9 + r) * 64 + cc];
                mv[(size_t)(l * 9 + r) * 6144 + cg * 64 + cc] = s + A->in[I_BMOD][l * 6144 + cg * 64 + cc]; }
            __syncthreads();
        }
    }
    {
        LAS float* T = (LAS float*)F.lds;
        LAS float* cs = T + 64 * 129; LAS float* sn = cs + 128;
        __syncthreads();
        if (F.tid < 128) { cs[F.tid] = cospif((float)F.tid * (1.0f / 64.0f)); sn[F.tid] = sinpif((float)F.tid * (1.0f / 64.0f)); }
        for (int item = (blockIdx.x + 64) % F.G; item < 128; item += F.G) {
            const int l = item >> 6, kg = (item & 63) >> 2, g = item & 3;
            __syncthreads();
            for (int i = F.tid; i < 64 * 128; i += NTHR) { const int kk = i >> 7, cc = i & 127; T[kk * 129 + cc] = A->in[I_WIN][((size_t)l * D + kg * 64 + kk) * INW + g * 128 + cc]; }
            __syncthreads();
            const int kk = F.tid & 63, ng = F.tid >> 6;
            bf16* dst = (bf16*)(F.ws + WS_WIN) + ((size_t)l * 3072 + 2048 + g * 256) * D + kg * 64 + kk;
#pragma unroll 1
            for (int nn = 0; nn < 32; ++nn) { const int np = ng * 32 + nn, cp = np >> 1; float s = 0.f;
                if (np & 1) {
#pragma unroll 8
                    for (int cc = 0; cc < 128; ++cc) s -= T[kk * 129 + cc] * sn[(cc * cp) & 127]; }
                else {
#pragma unroll 8
                    for (int cc = 0; cc < 128; ++cc) s += T[kk * 129 + cc] * cs[(cc * cp) & 127]; }
                dst[(size_t)np * D] = (bf16)f2bf(s); }
        }
        __syncthreads();
    }
    {
        LAS float* scr = (LAS float*)(F.lds + F.wave * 16384);
        constexpr int I_IN = 16 * 64, I_OUT = 16 * 32;
        for (int it = F.gw; it < NL * (I_IN + I_OUT); it += F.NGW) {
            const int l = it / (I_IN + I_OUT), r = it % (I_IN + I_OUT);
            if (r < I_IN) transpose_item(A->in[I_WIN] + (size_t)l * D * INW, INW, 512 + 32 * (r & 63), D, (bf16*)(F.ws + WS_WIN) + (size_t)l * 3072 * D, 32 * (r & 63), scr, r >> 6, F.lane);
            else { const int q = r - I_IN; transpose_item(A->in[I_WOUT] + (size_t)l * D * D, D, 32 * (q & 31), D, (bf16*)(F.ws + WS_WOUT) + (size_t)l * D * D, 32 * (q & 31), scr, q >> 5, F.lane); }
        }
    }
    convert_experts(F, 0);
    {
        const int gt = F.gw * 64 + F.lane, NT = F.NGW * 64;
        float* wrt = (float*)(F.ws + WS_WRT); float* wabt = (float*)(F.ws + WS_WABT);
        for (int i = gt; i < NL * NEXP * D; i += NT) { const int l = i >> 15, e = (i >> 10) & 31, c = i & 1023; wrt[i] = A->in[I_WR][((size_t)l * D + c) * NEXP + e]; }
        for (int i = gt; i < NL * 16 * D; i += NT) { const int l = i >> 14, j = (i >> 10) & 15, c = i & 1023; wabt[i] = A->in[I_WIN][((size_t)l * D + c) * INW + 2560 + j]; }
        bf16* dm = (bf16*)(F.ws + WS_DFTM);
        for (int i = gt; i < 2 * 2048 * 256; i += NT) { const int mat = i >> 19, kf = (i >> 8) & 2047, j0 = (i & 255) * 8; float v[8];
#pragma unroll
            for (int jj = 0; jj < 8; ++jj) { const float a = (float)((kf * (j0 + jj)) & 4095) * (1.0f / 2048.0f); v[jj] = mat ? sinpif(a) : cospif(a); }
            v4u o; o.x = pk2(v[0], v[1]); o.y = pk2(v[2], v[3]); o.z = pk2(v[4], v[5]); o.w = pk2(v[6], v[7]);
            *(v4u*)(dm + (size_t)i * 8) = o; }
    }
}

template <int MODE>
__device__ __forceinline__ void row_pass(const Frame& F, int l_cur, int l_nxt, bool dummy = false) {
    const KArgsP A = kargs();
    LAS float* wl = (LAS float*)F.lds;
    if (MODE != 2) { const f32x4* src = (const f32x4*)((const float*)(F.ws + WS_WABT) + (size_t)l_nxt * 16 * D);
        for (int i = F.tid; i < 16 * D / 4; i += NTHR) ((LAS f32x4*)wl)[i] = src[i];
        __syncthreads(); }
    const int nrows = MODE == 2 ? NLAT : MT;
    const int* sele = (const int*)(F.ws + WS_SELE); const int* selp = (const int*)(F.ws + WS_SELP); const float* selg = (const float*)(F.ws + WS_SELG);
    const bf16* ys = (const bf16*)(F.ws + WS_XS);
    bf16* hx = (bf16*)(F.ws + WS_ACT); float* ab = (float*)(F.ws + WS_AB);
    for (int t = F.gw; t < nrows; t += F.NGW) {
        const int r = mod_row(t);
        f32x4 v[4];
        float* xr = xr_row(F, t);
        if (MODE == 0) { const float* xin = t < NLAT ? A->in[I_X] + (size_t)t * D : A->in[I_CTX] + (size_t)(t - NLAT) * D;
#pragma unroll
            for (int j = 0; j < 4; ++j) v[j] = *((const f32x4*)xin + F.lane + 64 * j);
        } else {
#pragma unroll
            for (int j = 0; j < 4; ++j) v[j] = *((const f32x4*)xr + F.lane + 64 * j);
            f32x4 y[4];
#pragma unroll
            for (int j = 0; j < 4; ++j) y[j] = (f32x4){0.f, 0.f, 0.f, 0.f};
            (void)sele;
#pragma unroll
            for (int k = 0; k < 4; ++k) { const int dst = selp[t * 4 + k]; const float gk = selg[t * 4 + k]; const v2u* yr = (const v2u*)(ys + (size_t)dst * D) + F.lane;
#pragma unroll
                for (int j = 0; j < 4; ++j) { const v2u w = yr[64 * j]; y[j] += gk * (f32x4){bflo(w.x), bfhi(w.x), bflo(w.y), bfhi(w.y)}; } }
            const f32x4* g2 = (const f32x4*)modv(F, l_cur, r, 5) + F.lane;
#pragma unroll
            for (int j = 0; j < 4; ++j) v[j] += g2[64 * j] * y[j];
        }
        if (MODE != 2 && !dummy) {
#pragma unroll
            for (int j = 0; j < 4; ++j) *((f32x4*)xr + F.lane + 64 * j) = v[j];
        }
        float ss = 0.f;
#pragma unroll
        for (int j = 0; j < 4; ++j) ss += (v[j].x * v[j].x + v[j].y * v[j].y) + (v[j].z * v[j].z + v[j].w * v[j].w);
        const float rstd = 1.0f / sqrtf(wave_sum(ss) * (1.0f / D) + EPS);
        if (MODE == 2) {
            const f32x4* gf = (const f32x4*)A->in[I_GF] + F.lane;
#pragma unroll
            for (int j = 0; j < 4; ++j) *((f32x4*)(F.out + (size_t)t * D) + F.lane + 64 * j) = v[j] * rstd * gf[64 * j];
        } else {
            const f32x4* g1 = (const f32x4*)(A->in[I_GN1] + (size_t)l_nxt * D) + F.lane;
            const f32x4* sh = (const f32x4*)modv(F, l_nxt, r, 0) + F.lane; const f32x4* scl = (const f32x4*)modv(F, l_nxt, r, 1) + F.lane;
            v2u* ho = (v2u*)(hx + (size_t)t * D) + F.lane;
#pragma unroll
            for (int j = 0; j < 4; ++j) { v[j] = v[j] * rstd * g1[64 * j] * (scl[64 * j] + 1.0f) + sh[64 * j]; v2u w; w.x = pk2(v[j].x, v[j].y); w.y = pk2(v[j].z, v[j].w); ho[64 * j] = w; }
            float pp[16];
            int lofs = F.lane; asm volatile("" : "+v"(lofs));
#pragma unroll
            for (int jj = 0; jj < 16; ++jj) { float p = 0.f;
#pragma unroll
                for (int j = 0; j < 4; ++j) { const f32x4 w = ((const LAS f32x4*)(wl + jj * D))[lofs + 64 * j]; p += (v[j].x * w.x + v[j].y * w.y) + (v[j].z * w.z + v[j].w * w.w); }
                pp[jj] = p; if ((jj & 3) == 3) asm volatile("" ::: "memory"); }
            const float mine = rs16(pp, F.lane);
            if ((F.lane & 3) == 0) ab[(size_t)t * 16 + (F.lane >> 2)] = mine;
        }
    }
}

__device__ __forceinline__ int seq_id(int x) { return x < 0 ? -1 : (x < NLAT ? (x >> 12) : (x < MT ? 8 + ((x - NLAT) >> 8) : -2)); }
__device__ __forceinline__ void conv_phase(const Frame& F, int l) {
    const KArgsP A = kargs();
    LAS float* cw = (LAS float*)F.lds;
    for (int i = F.tid; i < 5 * 1536; i += NTHR) cw[i] = A->in[I_CONVW][(size_t)l * 5 * 1536 + i];
    __syncthreads();
    const bf16* qkvz = (const bf16*)(F.ws + WS_QKVZ); bf16* qkvn = (bf16*)(F.ws + WS_QKVN);
    const float* ab = (const float*)(F.ws + WS_AB); float* gb = (float*)(F.ws + WS_G); float* bb = (float*)(F.ws + WS_BETA);
    constexpr int RUN = MT / (256 * NWAVES);
    static_assert(RUN * 256 * NWAVES == MT, "conv runs");
    for (int run = F.gw; run < MT / RUN; run += F.NGW) {
        const int t0 = run * RUN;
        v4u W[5][3];
#pragma unroll
        for (int k = 0; k < 5; ++k) { const int g = t0 + k - 2, gc = g < 0 ? 0 : (g >= MT ? MT - 1 : g);
#pragma unroll
            for (int q = 0; q < 3; ++q) W[k][q] = *(const v4u*)(qkvz + (size_t)gc * 2048 + q * 512 + 8 * F.lane); }
#pragma unroll 1
        for (int t = t0; t < t0 + RUN; ++t) {
            v4u N[3];
            { const int g = t + 3, gc = g >= MT ? MT - 1 : g;
#pragma unroll
              for (int q = 0; q < 3; ++q) N[q] = *(const v4u*)(qkvz + (size_t)gc * 2048 + q * 512 + 8 * F.lane); }
            const int sid = seq_id(t);
            float a[3][8];
#pragma unroll
            for (int q = 0; q < 3; ++q)
#pragma unroll
                for (int i = 0; i < 8; ++i) a[q][i] = 0.f;
#pragma unroll
            for (int tap = 0; tap < 5; ++tap) { const float vm = (seq_id(t + tap - 2) == sid) ? 1.0f : 0.0f;
#pragma unroll
                for (int q = 0; q < 3; ++q) { const v4u u = W[tap][q];
                    const LAS f32x4* wp = (const LAS f32x4*)(cw + tap * 1536 + q * 512 + 8 * F.lane); const f32x4 w0 = wp[0] * vm, w1 = wp[1] * vm;
                    a[q][0] += bflo(u.x) * w0.x; a[q][1] += bfhi(u.x) * w0.y; a[q][2] += bflo(u.y) * w0.z; a[q][3] += bfhi(u.y) * w0.w;
                    a[q][4] += bflo(u.z) * w1.x; a[q][5] += bfhi(u.z) * w1.y; a[q][6] += bflo(u.w) * w1.z; a[q][7] += bfhi(u.w) * w1.w; } }
#pragma unroll
            for (int q = 0; q < 3; ++q) { float ss = 0.f;
#pragma unroll
                for (int i = 0; i < 8; ++i) { a[q][i] = silu_f(a[q][i]); ss += a[q][i] * a[q][i]; }
                float sc = 1.0f;
                if (q < 2) { ss = sum16(ss); sc = (1.0f / sqrtf(ss + EPS)) * (q == 0 ? 0.08838834764831845f : 1.0f); }
                v4u o; o.x = pk2(a[q][0] * sc, a[q][1] * sc); o.y = pk2(a[q][2] * sc, a[q][3] * sc); o.z = pk2(a[q][4] * sc, a[q][5] * sc); o.w = pk2(a[q][6] * sc, a[q][7] * sc);
                *(v4u*)(qkvn + (size_t)t * 1536 + q * 512 + 8 * F.lane) = o; }
            if (F.lane < 8) { const int d = F.lane >> 2, h = F.lane & 3;
                const float xg = ab[(size_t)t * 16 + d * 8 + h] + A->in[I_DTB][l * 8 + d * 4 + h];
                const float sp = xg > 20.f ? xg : log1pf(expf(xg));
                gb[(size_t)t * 8 + F.lane] = -expf(A->in[I_ALOG][l * 8 + d * 4 + h]) * sp;
                bb[(size_t)t * 8 + F.lane] = 1.0f / (1.0f + expf(-ab[(size_t)t * 16 + d * 8 + 4 + h])); }
#pragma unroll
            for (int q = 0; q < 3; ++q) { W[0][q] = W[1][q]; W[1][q] = W[2][q]; W[2][q] = W[3][q]; W[3][q] = W[4][q]; W[4][q] = N[q]; }
        }
    }
}

__device__ __forceinline__ void fold_phase(const Frame& F) {
    const bf16* ztl = (const bf16*)(F.ws + WS_ZTL); bf16* eo = (bf16*)(F.ws + WS_EO); float* zn = (float*)(F.ws + WS_ZN);
    const int lam = F.lane;
    for (int row = F.gw; row < 8 * 512; row += F.NGW) {
        const int b = row >> 9, c = row & 511;
        const bf16* zr = ztl + (size_t)row * 8192; const bf16* zi = zr + 4096;
        v4u lo_r[4], hi_r[4], lo_i[4], hi_i[4];
#pragma unroll
        for (int q = 0; q < 4; ++q) { lo_r[q] = *(const v4u*)(zr + 32 * lam + 8 * q); hi_r[q] = *(const v4u*)(zr + 4064 - 32 * lam + 8 * q);
                                      lo_i[q] = *(const v4u*)(zi + 32 * lam + 8 * q); hi_i[q] = *(const v4u*)(zi + 4064 - 32 * lam + 8 * q); }
        float Lr[32], Hr[32], Li[32], Hi[32];
#pragma unroll
        for (int q = 0; q < 4; ++q)
#pragma unroll
            for (int e = 0; e < 4; ++e) { Lr[8 * q + 2 * e] = bflo(lo_r[q][e]); Lr[8 * q + 2 * e + 1] = bfhi(lo_r[q][e]); Hr[8 * q + 2 * e] = bflo(hi_r[q][e]); Hr[8 * q + 2 * e + 1] = bfhi(hi_r[q][e]);
                                          Li[8 * q + 2 * e] = bflo(lo_i[q][e]); Li[8 * q + 2 * e + 1] = bfhi(lo_i[q][e]); Hi[8 * q + 2 * e] = bflo(hi_i[q][e]); Hi[8 * q + 2 * e + 1] = bfhi(hi_i[q][e]); }
        float mr = __shfl_up(Hr[0], 1), mi = __shfl_up(Hi[0], 1); if (lam == 0) { mr = 0.f; mi = 0.f; }
        float E[32], O[32]; float ny = 0.f;
        E[0] = Lr[0] + mr; O[0] = lam == 0 ? 0.f : Li[0] - mi;
#pragma unroll
        for (int j = 1; j < 32; ++j) { E[j] = Lr[j] + Hr[32 - j]; O[j] = Li[j] - Hi[32 - j]; }
#pragma unroll
        for (int j = 0; j < 32; ++j) ny += (j & 1) ? -(Lr[j] + Hr[j]) : (Lr[j] + Hr[j]);
        ny = wave_sum(ny);
        bf16* ep = eo + ((size_t)(b * 2) * 512 + c) * 2048 + 32 * lam; bf16* op = ep + (size_t)512 * 2048;
#pragma unroll
        for (int q = 0; q < 4; ++q) { v4u e4, o4;
            e4.x = pk2(E[8 * q], E[8 * q + 1]); e4.y = pk2(E[8 * q + 2], E[8 * q + 3]); e4.z = pk2(E[8 * q + 4], E[8 * q + 5]); e4.w = pk2(E[8 * q + 6], E[8 * q + 7]);
            o4.x = pk2(O[8 * q], O[8 * q + 1]); o4.y = pk2(O[8 * q + 2], O[8 * q + 3]); o4.z = pk2(O[8 * q + 4], O[8 * q + 5]); o4.w = pk2(O[8 * q + 6], O[8 * q + 7]);
            *(v4u*)(ep + 8 * q) = e4; *(v4u*)(op + 8 * q) = o4; }
        if (lam == 63) zn[row] = Hr[0];
        if (lam == 0) zn[4096 + row] = ny;
    }
}

__device__ __forceinline__ void ctx_dft(const Frame& F) {
    LAS float* cs = (LAS float*)F.lds;
    LAS float* sn = cs + 256;
    __syncthreads();
    if (F.tid < 256) { cs[F.tid] = cospif((float)F.tid * (1.0f / 128.0f)); sn[F.tid] = sinpif((float)F.tid * (1.0f / 128.0f)); }
    __syncthreads();
    const bf16* ztc = (const bf16*)(F.ws + WS_ZTC); bf16* mix = (bf16*)(F.ws + WS_ACT);
    const float scale = 1.0f / sqrtf(256.0f * 128.0f);
    const int gt = F.gw * 64 + F.lane, NT = F.NGW * 64;
    for (int i = gt; i < NCTX * 512; i += NT) {
        const int c = i & 511, lp = (i >> 9) & 255, b = i >> 17;
        const bf16* z = ztc + ((size_t)b * 512 + c) * 512;
        float s = 0.f;
#pragma unroll 4
        for (int l = 0; l < 256; l += 2) { const unsigned zr = *(const unsigned*)(z + l), zi = *(const unsigned*)(z + 256 + l);
            const int i0 = (l * lp) & 255, i1 = ((l + 1) * lp) & 255;
            s += bflo(zr) * cs[i0] + bflo(zi) * sn[i0] + bfhi(zr) * cs[i1] + bfhi(zi) * sn[i1]; }
        mix[(size_t)(NLAT + b * 256 + lp) * D + c] = (bf16)f2bf(s * scale);
    }
}

__device__ __forceinline__ void scan_naive(const Frame& F, int l) {
    LAS float* kL = (LAS float*)F.lds;
    LAS float* qL = kL + 64 * 128;
    LAS float* vL = qL + 64 * 128;
    LAS float* oL = vL + 64 * 32;
    LAS float* gL = oL + 64 * 32;
    LAS float* bL = gL + 64;
    const bf16* qkvn = (const bf16*)(F.ws + WS_QKVN);
    const float* gb = (const float*)(F.ws + WS_G); const float* bb = (const float*)(F.ws + WS_BETA);
    for (int unit = F.vcu; unit < 256; unit += F.G) {
        const int qd = unit & 3, s = unit >> 2, d = s & 1, h = (s >> 1) & 3, b = s >> 3;
        bf16* od = (bf16*)(F.ws + (d ? WS_OB : WS_OF));
        const int j = F.tid >> 4, rg = F.tid & 15;
        float S[8];
#pragma unroll
        for (int i = 0; i < 8; ++i) S[i] = 0.f;
#pragma unroll 1
        for (int ci = 0; ci < 68; ++ci) {
            int rowbase; const bool isctx = ci < 4;
            if (isctx) rowbase = NLAT + b * 256 + (d ? 3 - ci : ci) * 64; else { const int lc = ci - 4; rowbase = b * SEQ + (d ? 63 - lc : lc) * 64; }
            __syncthreads();
            for (int i = F.tid; i < 64 * 16; i += NTHR) { const int r = i >> 4, g8 = i & 15; const bf16* rp = qkvn + (size_t)(rowbase + r) * 1536 + h * 128 + g8 * 8;
                const v4u q = *(const v4u*)rp, k = *(const v4u*)(rp + 512);
                LAS float* qo = qL + r * 128 + g8 * 8; LAS float* ko = kL + r * 128 + g8 * 8;
                qo[0] = bflo(q.x); qo[1] = bfhi(q.x); qo[2] = bflo(q.y); qo[3] = bfhi(q.y); qo[4] = bflo(q.z); qo[5] = bfhi(q.z); qo[6] = bflo(q.w); qo[7] = bfhi(q.w);
                ko[0] = bflo(k.x); ko[1] = bfhi(k.x); ko[2] = bflo(k.y); ko[3] = bfhi(k.y); ko[4] = bflo(k.z); ko[5] = bfhi(k.z); ko[6] = bflo(k.w); ko[7] = bfhi(k.w); }
            if (F.tid < 256) { const int r = F.tid >> 2, g8 = F.tid & 3; const v4u v = *(const v4u*)(qkvn + (size_t)(rowbase + r) * 1536 + 1024 + h * 128 + qd * 32 + g8 * 8);
                LAS float* vo = vL + r * 32 + g8 * 8;
                vo[0] = bflo(v.x); vo[1] = bfhi(v.x); vo[2] = bflo(v.y); vo[3] = bfhi(v.y); vo[4] = bflo(v.z); vo[5] = bfhi(v.z); vo[6] = bflo(v.w); vo[7] = bfhi(v.w); }
            else if (F.tid < 320) { const int r = F.tid - 256; gL[r] = __expf(gb[(size_t)(rowbase + r) * 8 + d * 4 + h]); bL[r] = bb[(size_t)(rowbase + r) * 8 + d * 4 + h]; }
            __syncthreads();
#pragma unroll 2
            for (int st = 0; st < 64; ++st) {
                const int r = d ? 63 - st : st;
                const float alpha = gL[r], bt = bL[r];
                const f32x4 k0 = *(const LAS f32x4*)(kL + r * 128 + rg * 8), k1 = *(const LAS f32x4*)(kL + r * 128 + rg * 8 + 4);
                const f32x4 q0 = *(const LAS f32x4*)(qL + r * 128 + rg * 8), q1 = *(const LAS f32x4*)(qL + r * 128 + rg * 8 + 4);
                float part = (k0.x * S[0] + k0.y * S[1]) + (k0.z * S[2] + k0.w * S[3]) + (k1.x * S[4] + k1.y * S[5]) + (k1.z * S[6] + k1.w * S[7]);
                part = sum16(part);
                const float dl = bt * (vL[r * 32 + j] - alpha * part);
                S[0] = alpha * S[0] + k0.x * dl; S[1] = alpha * S[1] + k0.y * dl; S[2] = alpha * S[2] + k0.z * dl; S[3] = alpha * S[3] + k0.w * dl;
                S[4] = alpha * S[4] + k1.x * dl; S[5] = alpha * S[5] + k1.y * dl; S[6] = alpha * S[6] + k1.z * dl; S[7] = alpha * S[7] + k1.w * dl;
                float op = (q0.x * S[0] + q0.y * S[1]) + (q0.z * S[2] + q0.w * S[3]) + (q1.x * S[4] + q1.y * S[5]) + (q1.z * S[6] + q1.w * S[7]);
                op = sum16(op);
                if (rg == 0) oL[r * 32 + j] = op;
            }
            __syncthreads();
            if (!(isctx && l == NL - 1)) { const int r = F.tid >> 3, g4 = F.tid & 7; const LAS float* op = oL + r * 32 + g4 * 4;
                v2u w; w.x = pk2(op[0], op[1]); w.y = pk2(op[2], op[3]);
                *(v2u*)(od + (size_t)(rowbase + r) * 512 + h * 128 + qd * 32 + g4 * 4) = w; }
        }
        __syncthreads();
    }
}

__device__ __forceinline__ void gated_out(const Frame& F, int l) {
    const KArgsP A = kargs();
    const bf16* of = (const bf16*)(F.ws + WS_OF); const bf16* ob = (const bf16*)(F.ws + WS_OB); const bf16* qkvz = (const bf16*)(F.ws + WS_QKVZ);
    const bf16* ab2 = (const bf16*)(F.ws + WS_AB2); const float* zn = (const float*)(F.ws + WS_ZN);
    bf16* mix = (bf16*)(F.ws + WS_ACT);
    const int nrows = l == NL - 1 ? NLAT : MT;
    const float fsc = 1.0f / sqrtf(4096.0f * 128.0f);
    const f32x4 g0 = *(const f32x4*)(A->in[I_GOUT] + l * 128 + (F.lane & 15) * 8), g1 = *(const f32x4*)(A->in[I_GOUT] + l * 128 + (F.lane & 15) * 8 + 4);
    for (int t = F.gw; t < nrows; t += F.NGW) {
        const v4u a = *(const v4u*)(of + (size_t)t * 512 + 8 * F.lane), b = *(const v4u*)(ob + (size_t)t * 512 + 8 * F.lane), z = *(const v4u*)(qkvz + (size_t)t * 2048 + 1536 + 8 * F.lane);
        if (t < NLAT) {
            const int bb_ = t >> 12, lp = t & 4095, k = lp <= 2048 ? lp : 4096 - lp;
            float y[8];
            if (k == 2048) { const f32x4 n0 = *(const f32x4*)(zn + 4096 + bb_ * 512 + 8 * F.lane), n1 = *(const f32x4*)(zn + 4096 + bb_ * 512 + 8 * F.lane + 4);
                y[0] = n0.x; y[1] = n0.y; y[2] = n0.z; y[3] = n0.w; y[4] = n1.x; y[5] = n1.y; y[6] = n1.z; y[7] = n1.w; }
            else { const v4u pa = *(const v4u*)(ab2 + ((size_t)(bb_ * 2) * 2048 + k) * 512 + 8 * F.lane), pb_ = *(const v4u*)(ab2 + ((size_t)(bb_ * 2 + 1) * 2048 + k) * 512 + 8 * F.lane);
                const f32x4 z0 = *(const f32x4*)(zn + bb_ * 512 + 8 * F.lane), z1 = *(const f32x4*)(zn + bb_ * 512 + 8 * F.lane + 4);
                const float sg = lp <= 2048 ? 1.0f : -1.0f, sz = (k & 1) ? -1.0f : 1.0f;
                y[0] = bflo(pa.x) + sg * bflo(pb_.x) + sz * z0.x; y[1] = bfhi(pa.x) + sg * bfhi(pb_.x) + sz * z0.y; y[2] = bflo(pa.y) + sg * bflo(pb_.y) + sz * z0.z; y[3] = bfhi(pa.y) + sg * bfhi(pb_.y) + sz * z0.w;
                y[4] = bflo(pa.z) + sg * bflo(pb_.z) + sz * z1.x; y[5] = bfhi(pa.z) + sg * bfhi(pb_.z) + sz * z1.y; y[6] = bflo(pa.w) + sg * bflo(pb_.w) + sz * z1.z; y[7] = bfhi(pa.w) + sg * bfhi(pb_.w) + sz * z1.w; }
            v4u wy; wy.x = pk2(y[0] * fsc, y[1] * fsc); wy.y = pk2(y[2] * fsc, y[3] * fsc); wy.z = pk2(y[4] * fsc, y[5] * fsc); wy.w = pk2(y[6] * fsc, y[7] * fsc);
            *(v4u*)(mix + (size_t)t * D + 8 * F.lane) = wy;
        }
        float o[8] = {bflo(a.x) + bflo(b.x), bfhi(a.x) + bfhi(b.x), bflo(a.y) + bflo(b.y), bfhi(a.y) + bfhi(b.y), bflo(a.z) + bflo(b.z), bfhi(a.z) + bfhi(b.z), bflo(a.w) + bflo(b.w), bfhi(a.w) + bfhi(b.w)};
        const float zz[8] = {bflo(z.x), bfhi(z.x), bflo(z.y), bfhi(z.y), bflo(z.z), bfhi(z.z), bflo(z.w), bfhi(z.w)};
        const float gg[8] = {g0.x, g0.y, g0.z, g0.w, g1.x, g1.y, g1.z, g1.w};
        float ss = 0.f;
#pragma unroll
        for (int i = 0; i < 8; ++i) ss += o[i] * o[i];
        const float rs = 1.0f / sqrtf(sum16(ss) * (1.0f / 128.0f) + EPS);
#pragma unroll
        for (int i = 0; i < 8; ++i) o[i] = o[i] * rs * gg[i] * silu_f(zz[i]);
        v4u w; w.x = pk2(o[0], o[1]); w.y = pk2(o[2], o[3]); w.z = pk2(o[4], o[5]); w.w = pk2(o[6], o[7]);
        *(v4u*)(mix + (size_t)t * D + 512 + 8 * F.lane) = w;
    }
}

__device__ __forceinline__ void router_phase(const Frame& F, int l, int bank = 0) {
    const KArgsP A = kargs();
    LAS float* wr = (LAS float*)F.lds;
    LAS int* lcnt = (LAS int*)(F.lds + XT_OFF);
    LAS int* lbase = lcnt + 32;
    LAS int* sE = lbase + 32;
    LAS int* sP = sE + 136 * 4;
    LAS float* sG = (LAS float*)(sP + 136 * 4);
    const int nrows = l == NL - 1 ? NLAT : MT, rpb = nrows / 256;
    { const f32x4* src = (const f32x4*)((const float*)(F.ws + WS_WRT) + (size_t)l * NEXP * D);
      for (int i = F.tid; i < NEXP * D / 4; i += NTHR) ((LAS f32x4*)wr)[i] = src[i];
      if (F.tid < 32) lcnt[F.tid] = 0; }
    __syncthreads();
    bf16* h2 = (bf16*)(F.ws + WS_ACT);
    const int row0 = F.vcu * rpb;
    if (F.vcu < 256) {
    for (int rl = F.wave; rl < rpb; rl += NWAVES) {
        const int t = row0 + rl, r = mod_row(t);
        const float* xr = xr_row(F, t);
        f32x4 v[4]; float ss = 0.f;
#pragma unroll
        for (int j = 0; j < 4; ++j) { v[j] = *((const f32x4*)xr + F.lane + 64 * j); ss += (v[j].x * v[j].x + v[j].y * v[j].y) + (v[j].z * v[j].z + v[j].w * v[j].w); }
        const float rstd = 1.0f / sqrtf(wave_sum(ss) * (1.0f / D) + EPS);
        const f32x4* g2 = (const f32x4*)(A->in[I_GN2] + (size_t)l * D) + F.lane;
        const f32x4* sh = (const f32x4*)modv(F, l, r, 3) + F.lane; const f32x4* scl = (const f32x4*)modv(F, l, r, 4) + F.lane;
        v2u* ho = (v2u*)(h2 + (size_t)t * D) + F.lane;
#pragma unroll
        for (int j = 0; j < 4; ++j) { v[j] = v[j] * rstd * g2[64 * j] * (scl[64 * j] + 1.0f) + sh[64 * j]; v2u w; w.x = pk2(v[j].x, v[j].y); w.y = pk2(v[j].z, v[j].w); ho[64 * j] = w; }
        float pe[32];
        int lofs = F.lane; asm volatile("" : "+v"(lofs));
#pragma unroll
        for (int e = 0; e < NEXP; ++e) { float p = 0.f;
#pragma unroll
            for (int j = 0; j < 4; ++j) { const f32x4 w = ((const LAS f32x4*)(wr + e * D))[lofs + 64 * j]; p += (v[j].x * w.x + v[j].y * w.y) + (v[j].z * w.z + v[j].w * w.w); }
            pe[e] = p; if ((e & 3) == 3) asm volatile("" ::: "memory"); }
        float lg = rs32(pe, F.lane) + A->in[I_BR][l * NEXP + (F.lane >> 1)];
        if (F.lane & 1) lg = -3.0e38f;
        int se[4]; float sv[4];
#pragma unroll
        for (int k = 0; k < 4; ++k) { float m = lg;
#pragma unroll
            for (int o = 1; o < 64; o <<= 1) m = fmaxf(m, __shfl_xor(m, o));
            const unsigned long long bal = __ballot(lg == m); const int idx = __ffsll((long long)bal) - 1;
            se[k] = idx >> 1; sv[k] = m; if (F.lane == idx) lg = -3.0e38f; }
        const float e1 = __expf(sv[1] - sv[0]), e2 = __expf(sv[2] - sv[0]), e3 = __expf(sv[3] - sv[0]), inv = 1.0f / (1.0f + e1 + e2 + e3);
        if (F.lane == 0) {
            const float gt[4] = {inv, e1 * inv, e2 * inv, e3 * inv};
#pragma unroll
            for (int k = 0; k < 4; ++k) { sE[rl * 4 + k] = se[k]; sP[rl * 4 + k] = __hip_atomic_fetch_add(lcnt + se[k], 1, __ATOMIC_RELAXED, __HIP_MEMORY_SCOPE_WORKGROUP); sG[rl * 4 + k] = gt[k]; } }
    }
    }
    __syncthreads();
    if (F.tid < 32) { const int n = lcnt[F.tid]; lbase[F.tid] = n ? (int)__hip_atomic_fetch_add(F.ctl + CW_GCNT + ((bank * 2 + l) * 32 + F.tid) * 64, (unsigned)n, RLX_AGENT) : 0; }
    __syncthreads();
    if (F.vcu < 256) {
        int* sele = (int*)(F.ws + WS_SELE); int* selp = (int*)(F.ws + WS_SELP); float* selg = (float*)(F.ws + WS_SELG);
        for (int i = F.tid; i < rpb * 4; i += NTHR) { const int e = sE[i]; sele[(size_t)row0 * 4 + i] = e; selp[(size_t)row0 * 4 + i] = lbase[e] + sP[i]; selg[(size_t)row0 * 4 + i] = sG[i]; }
    }
}
__device__ __forceinline__ void moe_layout(const Frame& F, int l, LAS int* pend, LAS int* pstart) {
    __syncthreads();
    if (F.tid == 0) { int acc = 0;
        for (int e = 0; e < NEXP; ++e) { const int n = (int)__hip_atomic_load(F.ctl + CW_GCNT + (l * 32 + e) * 64, RLX_AGENT); pstart[e] = acc * 256; acc += (n + 255) >> 8; pend[e] = acc; } }
    __syncthreads();
}
__device__ __forceinline__ void gather_phase(const Frame& F, int l, bool dummy = false) {
    LAS int* pend = (LAS int*)(F.lds + XT_OFF); LAS int* pstart = pend + 32;
    moe_layout(F, l, pend, pstart);
    const int nrows = l == NL - 1 ? NLAT : MT;
    const int* sele = (const int*)(F.ws + WS_SELE); int* selp = (int*)(F.ws + WS_SELP);
    const bf16* h2 = (const bf16*)(F.ws + WS_ACT); bf16* xs = (bf16*)(F.ws + WS_XS);
    for (int it = F.gw; it < nrows * 4; it += F.NGW) {
        const int t = it >> 2, e = sele[it], dst = pstart[e] + selp[it];
        const v4u* src = (const v4u*)(h2 + (size_t)t * D) + F.lane; v4u* dp = (v4u*)(xs + (size_t)dst * D) + F.lane;
        const v4u a = src[0], b = src[64];
        dp[0] = a; dp[64] = b;
        if (F.lane == 0 && !dummy) selp[it] = dst;
    }
}

constexpr size_t WS_PW = WS_OB + 34 * MiB;
constexpr size_t WS_PKET = WS_PW + 68 * MiB;
constexpr size_t WS_PUT = WS_PKET + 68 * MiB;
constexpr size_t WS_PATT = WS_PUT + 68 * MiB;
constexpr size_t WS_PGAM = WS_PATT + 34 * MiB;
static_assert(WS_PGAM + 6 * MiB <= WS_END, "prep map");
typedef short bf16x8_t __attribute__((ext_vector_type(8)));
#define MFMA16(a, b, c) __builtin_amdgcn_mfma_f32_16x16x32_bf16((a), (b), (c), 0, 0, 0)
__device__ __forceinline__ v2u pack4(const f32x4 v) { v2u w; w.x = pk2(v.x, v.y); w.y = pk2(v.z, v.w); return w; }
__device__ __forceinline__ int chunk_rowbase(int b, int cn) { return cn < 4 ? NLAT + b * CTXL + cn * 64 : b * SEQ + (cn - 4) * 64; }

__device__ __forceinline__ void prep_phase(const Frame& F) {
    LAS bf16* k_rm = (LAS bf16*)F.lds;
    LAS bf16* q_rm = k_rm + 64 * 136;
    LAS float* Lp = (LAS float*)F.lds;
    LAS bf16* kT = (LAS bf16*)(F.lds + 34816);
    LAS bf16* vT = kT + 128 * 72;
    LAS float* Gm = (LAS float*)(F.lds + 34816 + 36864);
    LAS float* A0 = Gm + 64 * 72;
    LAS bf16* Tm = (LAS bf16*)Gm;
    LAS float* gs = (LAS float*)(F.lds + 34816 + 36864 + 36864);
    LAS float* bs = gs + 128;
    LAS float* gam = bs + 128;
    const bf16* qkvn = (const bf16*)(F.ws + WS_QKVN);
    const float* gb = (const float*)(F.ws + WS_G); const float* bb = (const float*)(F.ws + WS_BETA);
    const int w = F.wave;
    for (int unit = F.vcu; unit < 32 * 68; unit += F.G) {
        int tid_ = F.tid; asm volatile("" : "+v"(tid_));
        const int tid = tid_, lane = tid & 63, l15 = lane & 15, l4 = lane >> 4;
        const int bh = unit / 68, cn = unit % 68, b = bh >> 2, h = bh & 3, rowbase = chunk_rowbase(b, cn);
        const size_t pu = (size_t)(bh * 68 + cn) * 2;
        __syncthreads();
        for (int p = tid; p < 1024; p += NTHR) { const int i = p & 63, c8 = p >> 6; const bf16* rp = qkvn + (size_t)(rowbase + i) * 1536 + h * 128 + c8 * 8;
            const v4u qv = *(const v4u*)rp, kv = *(const v4u*)(rp + 512), vv = *(const v4u*)(rp + 1024);
            *(LAS v4u*)(q_rm + i * 136 + c8 * 8) = qv; *(LAS v4u*)(k_rm + i * 136 + c8 * 8) = kv;
#pragma unroll
            for (int e = 0; e < 4; ++e) { const unsigned kw = kv[e], vw = vv[e];
                kT[(c8 * 8 + 2 * e) * 72 + i] = (bf16)(kw & 0xffffu); kT[(c8 * 8 + 2 * e + 1) * 72 + i] = (bf16)(kw >> 16);
                vT[(c8 * 8 + 2 * e) * 72 + i] = (bf16)(vw & 0xffffu); vT[(c8 * 8 + 2 * e + 1) * 72 + i] = (bf16)(vw >> 16); } }
        if (tid < 128) { const int d = tid >> 6, i = tid & 63; gs[tid] = gb[(size_t)(rowbase + i) * 8 + d * 4 + h]; bs[tid] = bb[(size_t)(rowbase + i) * 8 + d * 4 + h]; }
        __syncthreads();
        if (tid < 128) { const int d = tid >> 6, i = tid & 63; float s = 0.f;
            if (d == 0) { for (int j = 0; j <= i; ++j) s += gs[j]; } else { for (int j = 63; j >= i; --j) s += gs[64 + j]; }
            gam[tid] = s; }
#pragma unroll
        for (int tt = 0; tt < 2; ++tt) { const int idx = 2 * w + tt, ti = idx >> 2, tj = idx & 3;
            f32x4 aG = {0.f, 0.f, 0.f, 0.f}, aA = {0.f, 0.f, 0.f, 0.f};
#pragma unroll
            for (int ks = 0; ks < 4; ++ks) { const int co = 32 * ks + 8 * l4;
                const bf16x8_t bk = *(const LAS bf16x8_t*)(k_rm + (16 * tj + l15) * 136 + co), ak = *(const LAS bf16x8_t*)(k_rm + (16 * ti + l15) * 136 + co), aq = *(const LAS bf16x8_t*)(q_rm + (16 * ti + l15) * 136 + co);
                aG = MFMA16(ak, bk, aG); aA = MFMA16(aq, bk, aA); }
#pragma unroll
            for (int r = 0; r < 4; ++r) { Gm[(16 * ti + 4 * l4 + r) * 72 + 16 * tj + l15] = aG[r]; A0[(16 * ti + 4 * l4 + r) * 72 + 16 * tj + l15] = aA[r]; } }
        __syncthreads();
        for (int idx = tid; idx < 8192; idx += NTHR) { const int d = idx >> 12, ip = (idx >> 6) & 63, jp = idx & 63, i = d ? 63 - ip : ip, j = d ? 63 - jp : jp;
            Lp[idx] = jp < ip ? bs[d * 64 + i] * Gm[i * 72 + j] * __expf(gam[d * 64 + i] - gam[d * 64 + j]) : 0.f; }
        for (int it = tid; it < 1024; it += NTHR) { const int d = it >> 9, i = (it >> 3) & 63, j0 = (it & 7) * 8; float v[8];
#pragma unroll
            for (int e = 0; e < 8; ++e) { const int j = j0 + e; const bool in = d ? (j >= i) : (j <= i); v[e] = in ? A0[i * 72 + j] * __expf(gam[d * 64 + i] - gam[d * 64 + j]) : 0.f; }
            v4u o; o.x = pk2(v[0], v[1]); o.y = pk2(v[2], v[3]); o.z = pk2(v[4], v[5]); o.w = pk2(v[6], v[7]);
            *(v4u*)((bf16*)(F.ws + WS_PATT) + (pu + d) * 4096 + i * 64 + j0) = o; }
        for (int it = tid; it < 2048; it += NTHR) { const int d = it >> 10, dk = (it >> 3) & 127, j0 = (it & 7) * 8; const float gl = d ? gam[64] : gam[63]; float v[8];
            const v4u kk = *(const LAS v4u*)(kT + dk * 72 + j0);
            v[0] = bflo(kk.x); v[1] = bfhi(kk.x); v[2] = bflo(kk.y); v[3] = bfhi(kk.y); v[4] = bflo(kk.z); v[5] = bfhi(kk.z); v[6] = bflo(kk.w); v[7] = bfhi(kk.w);
#pragma unroll
            for (int e = 0; e < 8; ++e) v[e] *= __expf(gl - gam[d * 64 + j0 + e]);
            v4u o; o.x = pk2(v[0], v[1]); o.y = pk2(v[2], v[3]); o.z = pk2(v[4], v[5]); o.w = pk2(v[6], v[7]);
            *(v4u*)((bf16*)(F.ws + WS_PKET) + (pu + d) * 8192 + dk * 64 + j0) = o; }
        if (tid < 128) ((float*)(F.ws + WS_PGAM))[(pu + (tid >> 6)) * 64 + (tid & 63)] = gam[tid];
        __syncthreads();
        if (w < 2) {
            const int d = w; const LAS float* Lr = Lp + d * 4096;
            float t[64];
#pragma unroll
            for (int ip = 0; ip < 64; ++ip) {
                float a0 = (lane == ip) ? 1.f : 0.f, a1 = 0.f;
#pragma unroll
                for (int j4 = 0; j4 < (ip + 3) / 4; ++j4) { const f32x4 Lv = *(const LAS f32x4*)(Lr + ip * 64 + 4 * j4);
                    if (4 * j4 + 0 < ip) a0 -= Lv.x * t[4 * j4 + 0];
                    if (4 * j4 + 1 < ip) a1 -= Lv.y * t[4 * j4 + 1];
                    if (4 * j4 + 2 < ip) a0 -= Lv.z * t[4 * j4 + 2];
                    if (4 * j4 + 3 < ip) a1 -= Lv.w * t[4 * j4 + 3]; }
                t[ip] = a0 + a1; asm volatile("" ::: "memory"); }
            const int jn = d ? 63 - lane : lane; const float bj = bs[d * 64 + jn], bge = bj * __expf(gam[d * 64 + jn]);
            LAS bf16* Tu = Tm + (d * 2) * 64 * 72; LAS bf16* Tw = Tu + 64 * 72;
#pragma unroll
            for (int ip = 0; ip < 64; ++ip) { const int in = d ? 63 - ip : ip; Tu[in * 72 + jn] = (bf16)f2bf(t[ip] * bj); Tw[in * 72 + jn] = (bf16)f2bf(t[ip] * bge); }
        }
        __syncthreads();
        {
            const int d = w >> 2, ww = w & 3;
            const LAS bf16* Tu = Tm + (d * 2) * 64 * 72; const LAS bf16* Tw = Tu + 64 * 72;
            bf16x8_t tu[2], tw[2];
#pragma unroll
            for (int ks = 0; ks < 2; ++ks) { tu[ks] = *(const LAS bf16x8_t*)(Tu + (16 * ww + l15) * 72 + 32 * ks + 8 * l4); tw[ks] = *(const LAS bf16x8_t*)(Tw + (16 * ww + l15) * 72 + 32 * ks + 8 * l4); }
            bf16* ut = (bf16*)(F.ws + WS_PUT) + (pu + d) * 8192; bf16* wg = (bf16*)(F.ws + WS_PW) + (pu + d) * 8192;
#pragma unroll 2
            for (int tj = 0; tj < 8; ++tj) {
                f32x4 au = {0.f, 0.f, 0.f, 0.f}, aw = {0.f, 0.f, 0.f, 0.f};
#pragma unroll
                for (int ks = 0; ks < 2; ++ks) { const bf16x8_t bv = *(const LAS bf16x8_t*)(vT + (16 * tj + l15) * 72 + 32 * ks + 8 * l4), ak = *(const LAS bf16x8_t*)(kT + (16 * tj + l15) * 72 + 32 * ks + 8 * l4);
                    au = MFMA16(tu[ks], bv, au); aw = MFMA16(ak, tw[ks], aw); }
                *(v2u*)(ut + (((((tj >> 2) * 16 + l15) * 4 + ww) * 4 + l4) * 4 + (tj & 3)) * 4) = pack4(au);
                *(v2u*)(wg + (16 * ww + l15) * 128 + 16 * tj + 4 * l4) = pack4(aw);
            }
        }
    }
    __syncthreads();
}

struct ScanRegs { bf16x8_t fa[4], fx[2], kf[2]; float graw, glast; int rowbase, cn; };
__device__ __forceinline__ void scan_load(ScanRegs& R, const unsigned char* ws, int ci_in, int b, int bh, int h, int d, int s, int w, int l15, int l4) {
    const int ci = ci_in < 68 ? ci_in : 67, rt = w & 3;
    const int cn = ci < 4 ? (d ? 3 - ci : ci) : 4 + (d ? 67 - ci : ci - 4);
    R.cn = cn; R.rowbase = chunk_rowbase(b, cn);
    const size_t pu = (size_t)(bh * 68 + cn) * 2 + d;
    const float* gmp = (const float*)(ws + WS_PGAM) + pu * 64;
    R.glast = gmp[d ? 0 : 63]; R.graw = gmp[16 * rt + l15];
    const bf16* ket = (const bf16*)(ws + WS_PKET) + pu * 8192 + (16 * w + l15) * 64 + 8 * l4;
    R.kf[0] = *(const bf16x8_t*)ket; R.kf[1] = *(const bf16x8_t*)(ket + 32);
    const bf16* wp = (const bf16*)(ws + WS_PW) + pu * 8192 + (16 * rt + l15) * 128 + 8 * l4;
    const bf16* qp = (const bf16*)(ws + WS_QKVN) + (size_t)(R.rowbase + 16 * rt + l15) * 1536 + h * 128 + 8 * l4;
    const bf16* ap_ = w < 4 ? wp : qp;
#pragma unroll
    for (int ks = 0; ks < 4; ++ks) R.fa[ks] = *(const bf16x8_t*)(ap_ + 32 * ks);
    const bf16* up = (const bf16*)(ws + WS_PUT) + pu * 8192 + ((((s * 16 + l15) * 4 + rt) * 4 + l4) * 16);
    const bf16* ap = (const bf16*)(ws + WS_PATT) + pu * 4096 + (16 * rt + l15) * 64 + 8 * l4;
    const bf16* xp = w < 4 ? up : ap; const int xo = w < 4 ? 8 : 32;
    R.fx[0] = *(const bf16x8_t*)xp; R.fx[1] = *(const bf16x8_t*)(xp + xo);
}
__device__ __forceinline__ void scan_step(const ScanRegs& R, f32x4 (&S)[4], LAS bf16* ST, LAS bf16* vnT, LAS bf16* oS, bf16* od, bf16* dump, bool skip_ctx_out, int h, int s, int w, int l15, int l4, int tid) {
    const int rt = w & 3;
    const float gend = __expf(R.glast), eg = w < 4 ? 1.0f : __expf(R.graw);
    bf16x8_t fa[4];
#pragma unroll
    for (int ks = 0; ks < 4; ++ks) fa[ks] = R.fa[ks];
    if (w >= 4) {
#pragma unroll
        for (int ks = 0; ks < 4; ++ks) { const v4u qv = __builtin_bit_cast(v4u, R.fa[ks]); v4u o;
            o.x = pk2(bflo(qv.x) * eg, bfhi(qv.x) * eg); o.y = pk2(bflo(qv.y) * eg, bfhi(qv.y) * eg); o.z = pk2(bflo(qv.z) * eg, bfhi(qv.z) * eg); o.w = pk2(bflo(qv.w) * eg, bfhi(qv.w) * eg);
            fa[ks] = __builtin_bit_cast(bf16x8_t, o); } }
    f32x4 c[4];
#pragma unroll
    for (int ct = 0; ct < 4; ++ct) { c[ct] = (f32x4){0.f, 0.f, 0.f, 0.f};
#pragma unroll
        for (int ks = 0; ks < 4; ++ks) { const bf16x8_t bq = *(const LAS bf16x8_t*)(ST + (16 * ct + l15) * 136 + 32 * ks + 8 * l4); c[ct] = MFMA16(fa[ks], bq, c[ct]); } }
    {
        const v4u ua = __builtin_bit_cast(v4u, R.fx[0]), ub = __builtin_bit_cast(v4u, R.fx[1]);
        const f32x4 u0 = {bflo(ua.x), bfhi(ua.x), bflo(ua.y), bfhi(ua.y)}, u1 = {bflo(ua.z), bfhi(ua.z), bflo(ua.w), bfhi(ua.w)};
        const f32x4 u2 = {bflo(ub.x), bfhi(ub.x), bflo(ub.y), bfhi(ub.y)}, u3 = {bflo(ub.z), bfhi(ub.z), bflo(ub.w), bfhi(ub.w)};
        LAS bf16* vp = vnT + (w < 4 ? 0 : 64 * 72) + l15 * 72 + 16 * rt + 4 * l4;
        *(LAS v2u*)(vp) = pack4(u0 - c[0]); *(LAS v2u*)(vp + 16 * 72) = pack4(u1 - c[1]); *(LAS v2u*)(vp + 32 * 72) = pack4(u2 - c[2]); *(LAS v2u*)(vp + 48 * 72) = pack4(u3 - c[3]);
    }
    __syncthreads();
    {
        LAS bf16* op = oS + (w < 4 ? 64 * 72 : 0) + (16 * rt + 4 * l4) * 72 + l15;
#pragma unroll
        for (int ct = 0; ct < 4; ++ct) { const bf16x8_t v0 = *(const LAS bf16x8_t*)(vnT + (16 * ct + l15) * 72 + 8 * l4), v1 = *(const LAS bf16x8_t*)(vnT + (16 * ct + l15) * 72 + 32 + 8 * l4);
            f32x4 o = MFMA16(R.fx[0], v0, c[ct]); o = MFMA16(R.fx[1], v1, o);
#pragma unroll
            for (int r = 0; r < 4; ++r) op[r * 72 + 16 * ct] = (bf16)f2bf(o[r]);
            f32x4 sn = S[ct] * gend; sn = MFMA16(R.kf[0], v0, sn); sn = MFMA16(R.kf[1], v1, sn); S[ct] = sn;
            *(LAS v2u*)(ST + (16 * ct + l15) * 136 + 16 * w + 4 * l4) = pack4(sn); }
    }
    __syncthreads();
    {
        const int i = tid >> 3, pc = tid & 7;
        const v4u ov = *(const LAS v4u*)(oS + i * 72 + pc * 8);
        const bool real = !(R.cn < 4 && skip_ctx_out);
        bf16* gp = real ? od + (size_t)(R.rowbase + i) * 512 + h * 128 + 64 * s + pc * 8 : dump + (size_t)i * 64 + pc * 8;
        *(v4u*)gp = ov;
    }
}
__device__ __forceinline__ void scan_mfma(const Frame& F, int l) {
    LAS bf16* ST = (LAS bf16*)F.lds;
    LAS bf16* vnT = ST + 64 * 136;
    LAS bf16* oS = vnT + 2 * 64 * 72;
    const int lane = F.lane, l15 = lane & 15, l4 = lane >> 4, w = F.wave;
    const bool skip_ctx_out = (l == NL - 1);
    for (int unit = F.vcu; unit < 128; unit += F.G) {
        const int s = unit & 1, sd = unit >> 1, d = sd & 1, bh = sd >> 1, b = bh >> 2, h = bh & 3;
        bf16* od = (bf16*)(F.ws + (d ? WS_OB : WS_OF)); bf16* dump = (bf16*)(F.ws + WS_PGAM + 1536 * 1024) + (size_t)unit * 16 * 512;
        __syncthreads();
        for (int i = F.tid; i < 64 * 136 / 2; i += NTHR) ((LAS unsigned*)ST)[i] = 0u;
        f32x4 S[4];
#pragma unroll
        for (int ct = 0; ct < 4; ++ct) S[ct] = (f32x4){0.f, 0.f, 0.f, 0.f};
        ScanRegs R0, R1, R2;
        scan_load(R0, F.ws, 0, b, bh, h, d, s, w, l15, l4); scan_load(R1, F.ws, 1, b, bh, h, d, s, w, l15, l4); scan_load(R2, F.ws, 2, b, bh, h, d, s, w, l15, l4);
        __syncthreads();
#pragma unroll 1
        for (int ci = 0; ci < 66; ci += 3) {
            scan_step(R0, S, ST, vnT, oS, od, dump, skip_ctx_out, h, s, w, l15, l4, F.tid); scan_load(R0, F.ws, ci + 3, b, bh, h, d, s, w, l15, l4);
            scan_step(R1, S, ST, vnT, oS, od, dump, skip_ctx_out, h, s, w, l15, l4, F.tid); scan_load(R1, F.ws, ci + 4, b, bh, h, d, s, w, l15, l4);
            scan_step(R2, S, ST, vnT, oS, od, dump, skip_ctx_out, h, s, w, l15, l4, F.tid); scan_load(R2, F.ws, ci + 5, b, bh, h, d, s, w, l15, l4);
        }
        scan_step(R0, S, ST, vnT, oS, od, dump, skip_ctx_out, h, s, w, l15, l4, F.tid);
        scan_step(R1, S, ST, vnT, oS, od, dump, skip_ctx_out, h, s, w, l15, l4, F.tid);
    }
}

#ifndef USE_NAIVE_SCAN
#define USE_NAIVE_SCAN 0
#endif
#ifndef REP_MASK
#define REP_MASK 0
#endif
#define REPS(p) for (int _r = 0; _r < 1 + ((REP_MASK >> (p)) & 1); ++_r)
#define LASTREP(p) (_r == ((REP_MASK >> (p)) & 1))
constexpr int PH_PER_LAYER = 11, N_PHASES = 2 + NL * PH_PER_LAYER;
#ifndef PG8_SP2
#define PG8_SP2 true
#endif
#ifndef PG8_ALIGN
#define PG8_ALIGN true
#endif
__device__ __forceinline__ Frame make_frame(int wv) {
    extern __shared__ __attribute__((aligned(16))) unsigned char lds[];
    const KArgsP A = kargs();
    Frame F;
    { unsigned lb = (unsigned)(uintptr_t)(LAS unsigned char*)lds; asm volatile("" : "+s"(lb)); F.lds = (LAS unsigned char*)(uintptr_t)lb; }
    F.MISC = (volatile LAS unsigned*)(F.lds + MISC_OFF);
    { unsigned m1 = ~0u; asm volatile("" : "+s"(m1)); int ln = (int)__builtin_amdgcn_mbcnt_hi(m1, __builtin_amdgcn_mbcnt_lo(m1, 0u)); asm volatile("" : "+v"(ln)); F.lane = ln; }
    { int w_ = wv; asm volatile("" : "+s"(w_)); F.wave = w_; } F.tid = F.wave * 64 + F.lane;
    F.G = gridDim.x; { const int bx = blockIdx.x; F.vcu = (F.G % 8 == 0) ? (bx % 8) * (F.G / 8) + bx / 8 : bx; }
    F.gw = F.vcu * NWAVES + F.wave; F.NGW = F.G * NWAVES;
    F.ws = A->ws; F.ctl = (unsigned*)(A->ws + WS_CTL); F.out = A->out;
    return F;
}
__global__ void __launch_bounds__(NTHR, 2) mk_fwd(Args args) {
    const int wv = __builtin_amdgcn_readfirstlane((int)threadIdx.x >> 6);
    { Frame F = make_frame(wv);
      for (int u = F.tid; u < (LDS_BYTES - LDSCTL_OFF) / 4; u += NTHR) ((LAS unsigned*)(F.lds + LDSCTL_OFF))[u] = 0u;
      __syncthreads(); }
    const int lo = args.ph_lo, hi = args.ph_hi;
#ifdef PROBE_P
    unsigned long long pr_acc = 0ull, pr_t0 = 0ull;
#define PR_BEGIN(p) do { if (((p) < 2 ? (p) : 2 + ((p) - 2) % PH_PER_LAYER) == PROBE_P) pr_t0 = __builtin_amdgcn_s_memrealtime(); } while (0)
#define PR_END(p) do { if (((p) < 2 ? (p) : 2 + ((p) - 2) % PH_PER_LAYER) == PROBE_P) pr_acc += __builtin_amdgcn_s_memrealtime() - pr_t0; } while (0)
#else
#define PR_BEGIN(p) do {} while (0)
#define PR_END(p) do {} while (0)
#endif
    if (hi - lo > 1) { Frame F = make_frame(wv); (void)xcd_barrier_post((unsigned*)(F.ctl + CW_BAR), F.MISC + 8, F.tid); }
#define IN(k) (lo <= (k) && (k) < hi)
#define SEAM(k) do { if (IN(k) && IN((k) + 1)) { Frame Fb = make_frame(wv); XcdBarrier bar; bar.bar = (unsigned*)(Fb.ctl + CW_BAR); bar.x = xb_xcc_id(); bar.st = Fb.MISC + 8; xcd_barrier(bar, Fb.tid); } } while (0)
    PR_BEGIN(0); if (IN(0)) { Frame F = make_frame(wv); REPS(0) { p0_prologue(F); __syncthreads(); } }
    SEAM(0); PR_END(0);
    PR_BEGIN(1); if (IN(1)) { Frame F = make_frame(wv); REPS(1) { row_pass<0>(F, 0, 0); __syncthreads(); } }
    SEAM(1); PR_END(1);
#define LAYER_BODY(l) { \
        const int pb = 2 + l * PH_PER_LAYER; \
        PR_BEGIN(pb + 0); if (IN(pb + 0)) { Frame F = make_frame(wv); \
            SchedIn S{(const bf16*)(F.ws + WS_ACT), (const bf16*)(F.ws + WS_WIN) + (size_t)l * 3072 * D, F.G, (int)blockIdx.x}; \
            EpiIn E{(bf16*)(F.ws + WS_QKVZ), (bf16*)(F.ws + WS_ZTL), (bf16*)(F.ws + WS_ZTC)}; \
            REPS(8) { pg8::gemm_phase<EpiIn, SchedIn, PG8_ALIGN, PG8_SP2>(F.lds, pg8::Gemm{D}, S, E, F.tid); __syncthreads(); } } \
        SEAM(pb + 0); PR_END(pb + 0); \
        PR_BEGIN(pb + 1); if (IN(pb + 1)) { Frame F = make_frame(wv); REPS(2) { conv_phase(F, l); __syncthreads(); } fold_phase(F); } \
        SEAM(pb + 1); PR_END(pb + 1); \
        PR_BEGIN(pb + 2); if (IN(pb + 2)) { \
            { Frame F = make_frame(wv); \
              SchedDft S{(const bf16*)(F.ws + WS_DFTM), (const bf16*)(F.ws + WS_EO), F.G, (int)blockIdx.x}; \
              EpiDft E{(bf16*)(F.ws + WS_AB2)}; \
              REPS(9) { pg8::gemm_phase<EpiDft, SchedDft, PG8_ALIGN, PG8_SP2>(F.lds, pg8::Gemm{2048}, S, E, F.tid); __syncthreads(); } } \
            if (l == 0) { Frame F = make_frame(wv); ctx_dft(F); } \
            { Frame F = make_frame(wv); REPS(3) { prep_phase(F); } } \
        } \
        SEAM(pb + 2); PR_END(pb + 2); \
        PR_BEGIN(pb + 3); if (IN(pb + 3)) { Frame F = make_frame(wv); \
            REPS(4) { scan_mfma(F, l); __syncthreads(); } \
        } \
        SEAM(pb + 3); PR_END(pb + 3); \
        PR_BEGIN(pb + 4); if (IN(pb + 4)) { Frame F = make_frame(wv); REPS(5) { gated_out(F, l); __syncthreads(); } } \
        SEAM(pb + 4); PR_END(pb + 4); \
        PR_BEGIN(pb + 5); if (IN(pb + 5)) { Frame F = make_frame(wv); \
            SchedOut S{(const bf16*)(F.ws + WS_ACT), (const bf16*)(F.ws + WS_WOUT) + (size_t)l * D * D, l == NL - 1 ? NLAT / 256 : MT / 256, F.G, (int)blockIdx.x}; \
            REPS(10) { EpiOut E{F.out, (float*)(F.ws + WS_XC), modv(F, l, 0, 2), LASTREP(10) ? 1.0f : 0.0f}; \
                pg8::gemm_phase<EpiOut, SchedOut, PG8_ALIGN, PG8_SP2>(F.lds, pg8::Gemm{D}, S, E, F.tid); __syncthreads(); } } \
        SEAM(pb + 5); PR_END(pb + 5); \
        PR_BEGIN(pb + 6); if (IN(pb + 6)) { Frame F = make_frame(wv); REPS(6) { router_phase(F, l, LASTREP(6) ? 0 : 1); __syncthreads(); } } \
        SEAM(pb + 6); PR_END(pb + 6); \
        PR_BEGIN(pb + 7); if (IN(pb + 7)) { Frame F = make_frame(wv); REPS(7) { gather_phase(F, l, !LASTREP(7)); __syncthreads(); } } \
        SEAM(pb + 7); PR_END(pb + 7); \
        PR_BEGIN(pb + 8); if (IN(pb + 8)) { Frame F = make_frame(wv); \
            LAS int* pend = (LAS int*)(F.lds + XT_OFF); moe_layout(F, l, pend, pend + 32); \
            SchedMoe S{(const bf16*)(F.ws + WS_XS), (const bf16*)(F.ws + WS_W1), (size_t)2048 * D * 2, pend, pend[NEXP - 1], 8, F.G, (int)blockIdx.x}; \
            EpiSwiglu E{(bf16*)(F.ws + WS_HS), kargs()->in[I_BG] + (size_t)l * NEXP * D, kargs()->in[I_BU] + (size_t)l * NEXP * D}; \
            REPS(11) { pg8::gemm_phase<EpiSwiglu, SchedMoe, PG8_ALIGN, PG8_SP2>(F.lds, pg8::Gemm{D}, S, E, F.tid); __syncthreads(); } } \
        SEAM(pb + 8); PR_END(pb + 8); \
        PR_BEGIN(pb + 9); if (IN(pb + 9)) { Frame F = make_frame(wv); \
            LAS int* pend = (LAS int*)(F.lds + XT_OFF); moe_layout(F, l, pend, pend + 32); \
            SchedMoe S{(const bf16*)(F.ws + WS_HS), (const bf16*)(F.ws + WS_W2), (size_t)D * D * 2, pend, pend[NEXP - 1], 4, F.G, (int)blockIdx.x}; \
            EpiDown E{(bf16*)(F.ws + WS_XS), kargs()->in[I_BD] + (size_t)l * NEXP * D}; \
            REPS(12) { pg8::gemm_phase<EpiDown, SchedMoe, PG8_ALIGN, PG8_SP2>(F.lds, pg8::Gemm{D}, S, E, F.tid); __syncthreads(); } } \
        SEAM(pb + 9); PR_END(pb + 9); \
        PR_BEGIN(pb + 10); if (IN(pb + 10)) { \
            { Frame F = make_frame(wv); \
              if (l == NL - 1) row_pass<2>(F, l, l); else { REPS(13) { row_pass<1>(F, l, l + 1, !LASTREP(13)); __syncthreads(); } } } \
            if (l != NL - 1) { Frame F = make_frame(wv); __syncthreads(); REPS(14) { convert_experts(F, l + 1); __syncthreads(); } } \
        } \
        if (l + 1 < NL) SEAM(pb + 10); PR_END(pb + 10); \
    }
    LAYER_BODY(0)
    LAYER_BODY(1)
#undef LAYER_BODY
#ifdef PROBE_P
    if (blockIdx.x == 0 && threadIdx.x == 0) { const unsigned long long t0 = __builtin_amdgcn_s_memrealtime(), want = pr_acc * PROBE_SCALE; while (__builtin_amdgcn_s_memrealtime() - t0 < want) __builtin_amdgcn_s_sleep(8); }
#endif
#undef IN
#undef SEAM
}

extern "C" void kernel_launch(void* const* d_in, const int* in_sizes, int n_in, void* d_out, int out_size, void* d_ws, size_t ws_size, hipStream_t stream) {
    static int grid = 0;
    if (grid == 0) {
        if (n_in != 23 || out_size != NLAT * D || ws_size < WS_END) { fprintf(stderr, "kernel_launch: unexpected shapes (n_in %d, out %d, ws %zu); nothing launched\n", n_in, out_size, ws_size); grid = -1; return; }
        int dev = 0, cus = 0, per_cu = 0;
        if (hipGetDevice(&dev) != hipSuccess || hipDeviceGetAttribute(&cus, hipDeviceAttributeMultiprocessorCount, dev) != hipSuccess) { grid = -1; return; }
        if (hipFuncSetAttribute((const void*)mk_fwd, hipFuncAttributeMaxDynamicSharedMemorySize, LDS_BYTES) != hipSuccess) { fprintf(stderr, "kernel_launch: hipFuncSetAttribute failed\n"); grid = -1; return; }
        if (hipOccupancyMaxActiveBlocksPerMultiprocessor(&per_cu, (const void*)mk_fwd, NTHR, LDS_BYTES) != hipSuccess || per_cu < 1)
            fprintf(stderr, "kernel_launch: note: occupancy query reports %d workgroups per CU\n", per_cu);
        (void)hipGetLastError();
        grid = cus;
        if (grid != 256) { fprintf(stderr, "kernel_launch: built for 256 CUs, found %d; nothing launched\n", grid); grid = -1; return; }
    }
    if (grid < 0) return;
    if (hipMemsetAsync((char*)d_ws + WS_CTL, 0, CTL_ZERO_BYTES, stream) != hipSuccess) { fprintf(stderr, "kernel_launch: hipMemsetAsync failed\n"); return; }
    Args a{};
    for (int i = 0; i < 23; ++i) a.in[i] = (const float*)d_in[i];
    a.out = (float*)d_out; a.ws = (unsigned char*)d_ws;
#if MK_ONE_LAUNCH
    a.ph_lo = 0; a.ph_hi = N_PHASES;
    hipLaunchKernelGGL(mk_fwd, dim3(grid), dim3(NTHR), LDS_BYTES, stream, a);
#else
    for (int p = 0; p < N_PHASES; ++p) { a.ph_lo = p; a.ph_hi = p + 1; hipLaunchKernelGGL(mk_fwd, dim3(grid), dim3(NTHR), LDS_BYTES, stream, a); }
#endif
    const hipError_t le = hipPeekAtLastError();
    if (le != hipSuccess) fprintf(stderr, "kernel_launch: launch failed: %s\n", hipGetErrorName(le));
}
```

```cpp
#define MK_ONE_LAUNCH 1
#include <hip/hip_runtime.h>
#include <cstdio>
#include <cstdint>

#ifndef MK_ONE_LAUNCH
#define MK_ONE_LAUNCH 1
#endif

namespace pg8 {
#define PG8_LAS __attribute__((address_space(3)))
typedef unsigned short bf16_t;
typedef short bf16x8 __attribute__((ext_vector_type(8)));
typedef float f32x4 __attribute__((ext_vector_type(4)));
typedef unsigned u32x4 __attribute__((ext_vector_type(4)));
constexpr int BM = 256, BK = 64, HALF = 128, HTB = HALF * BK * 2  , STAGE_BYTES = 8 * HTB, NXCD = 8, WGM = 8;

__host__ __device__ __forceinline__ int lds_byte(int r, int c) { const int st = (r >> 4) * 2 + (c >> 5), rr = r & 15, cc = c & 31, ob = rr * 64 + cc * 2; return st * 1024 + (ob ^ (((ob >> 9) & 1) << 5)); }
__host__ __device__ __forceinline__ void stage_rc(int b, int& R, int& C) { const int st = b / 1024, sb = b % 1024, swz = sb ^ (((sb >> 9) & 1) << 5); R = (st >> 1) * 16 + swz / 64; C = (st & 1) * 32 + (swz % 64) / 2; }
__host__ __device__ __forceinline__ int perm32(int rho) { const int n = rho >> 4, i = rho & 15; return 8 * (i >> 2) + 4 * n + (i & 3); }

struct Unit { int pm, pn, kind, e; };
struct Gemm { int K; };

__device__ __forceinline__ int xcd_remap(int L, int nwg) { const int q = nwg / NXCD, r = nwg % NXCD, xcd = L % NXCD, off = L / NXCD; return (xcd < r ? xcd * (q + 1) : r * (q + 1) + (xcd - r) * q) + off; }
__device__ __forceinline__ void grp_decode(int wgid, int nM, int nN, int& pm, int& pn) { const int nig = WGM * nN, gid = wgid / nig, fm = gid * WGM, gsz = (nM - fm) < WGM ? (nM - fm) : WGM; pm = fm + ((wgid % nig) % gsz); pn = (wgid % nig) / gsz; }

__device__ __forceinline__ const char* uni_ptr(const char* p) { const unsigned long long v = (unsigned long long)p; const unsigned lo = __builtin_amdgcn_readfirstlane((unsigned)v), hi = __builtin_amdgcn_readfirstlane((unsigned)(v >> 32)); return (const char*)(((unsigned long long)hi << 32) | lo); }
__device__ __forceinline__ unsigned cvt_pk_bf16(float lo, float hi) { unsigned r; asm volatile("v_cvt_pk_bf16_f32 %0, %1, %2" : "=v"(r) : "v"(lo), "v"(hi)); return r; }

template <class Epi, class Sched, bool ALIGN_EPI = false, bool SP2 = false>
__device__ __forceinline__ void gemm_phase(PG8_LAS unsigned char* lds, const Gemm g, const Sched& S, const Epi& E, int tid_in) {
    int tid_ = tid_in; asm volatile("" : "+v"(tid_));
    const int tid = tid_, wid = __builtin_amdgcn_readfirstlane(tid >> 6), lane = tid & 63, wr = wid >> 2, wc = wid & 3, fr = lane & 15, fq = lane >> 4;
    const int K = g.K, nt = K / BK;
    unsigned voffA[2], voffB[2];
#pragma unroll
    for (int i = 0; i < 2; ++i) { int R, C; stage_rc(tid * 16 + i * 8192, R, C); const int Rb = Epi::PERM ? ((R & ~31) + perm32(R & 31)) : R;
        voffA[i] = (unsigned)(R * K + C) * 2u; voffB[i] = (unsigned)(Rb * K + C) * 2u; }
    const size_t kstep = (size_t)(BK * 2);
    const size_t hstep = (size_t)HALF * K * 2;
    const size_t tstep = 2 * hstep;
    const unsigned ldsw = (unsigned)wid * 1024u;
    const int aoff = lds_byte(wr * 64 + fr, fq * 8), boff = lds_byte(wc * 32 + fr, fq * 8);
#define PG8_SA(b, h) (((b) * 2 + (h)) * HTB)
#define PG8_SB(b, h) ((4 + (b) * 2 + (h)) * HTB)
#define PG8_STAGE(bufoff, gbase, voff) do { _Pragma("unroll") for (int _i = 0; _i < 2; ++_i) \
        __builtin_amdgcn_global_load_lds((const unsigned*)((const char*)(gbase) + (voff)[_i]), (PG8_LAS unsigned*)(lds + (bufoff) + ldsw + _i * 8192), 16, 0, 0); } while (0)
#define PG8_LDA(dst, b, h) do { _Pragma("unroll") for (int m = 0; m < 4; ++m) _Pragma("unroll") for (int k = 0; k < 2; ++k) dst[m][k] = *(const PG8_LAS bf16x8*)(lds + PG8_SA(b, h) + aoff + m * 2048 + k * 1024); } while (0)
#define PG8_LDB(dst, b, h) do { _Pragma("unroll") for (int n = 0; n < 2; ++n) _Pragma("unroll") for (int k = 0; k < 2; ++k) dst[n][k] = *(const PG8_LAS bf16x8*)(lds + PG8_SB(b, h) + boff + n * 2048 + k * 1024); } while (0)
#define PG8_MMA(ai, bj, At, Bt) do { __builtin_amdgcn_s_setprio(1); _Pragma("unroll") for (int m = 0; m < 4; ++m) _Pragma("unroll") for (int n = 0; n < 2; ++n) _Pragma("unroll") for (int k = 0; k < 2; ++k) \
        acc[ai][bj][m][n] = __builtin_amdgcn_mfma_f32_16x16x32_bf16(Bt[n][k], At[m][k], acc[ai][bj][m][n], 0, 0, 0); __builtin_amdgcn_s_setprio(0); } while (0)
#define PG8_WAIT_V(n) asm volatile("s_waitcnt vmcnt(" #n ")" ::: "memory")
#define PG8_WAIT_L(n) asm volatile("s_waitcnt lgkmcnt(" #n ")" ::: "memory")
#define PG8_BAR __builtin_amdgcn_s_barrier()
#define PG8_SCHED __builtin_amdgcn_sched_barrier(0)
    Unit cur, nxt; int ui = 0;
    if (!S.next(0, cur)) return;
    f32x4 acc[2][2][4][2];
#pragma unroll
    for (int a = 0; a < 2; ++a)
#pragma unroll
        for (int b = 0; b < 2; ++b)
#pragma unroll
            for (int m = 0; m < 4; ++m)
#pragma unroll
                for (int n = 0; n < 2; ++n) acc[a][b][m][n] = (f32x4){0.f, 0.f, 0.f, 0.f};
    bf16x8 At[4][2], B0[2][2], B1[2][2];
    const char* cA = uni_ptr(S.a_base(cur, tstep)); const char* cB = uni_ptr(S.b_base(cur, tstep));
    S.a_ready(cur);
    if constexpr (SP2) {
        PG8_STAGE(PG8_SB(0, 0), cB, voffB); PG8_STAGE(PG8_SB(0, 1), cB + hstep, voffB); PG8_STAGE(PG8_SA(0, 0), cA, voffA); PG8_STAGE(PG8_SA(0, 1), cA + hstep, voffA);
        if (wr == 1) PG8_BAR;
        PG8_WAIT_V(2); PG8_BAR;
        PG8_STAGE(PG8_SB(1, 0), cB + kstep, voffB); PG8_STAGE(PG8_SA(1, 0), cA + kstep, voffA); PG8_STAGE(PG8_SB(1, 1), cB + hstep + kstep, voffB);
        PG8_WAIT_V(6); PG8_BAR;
    } else {
        PG8_STAGE(PG8_SB(0, 0), cB, voffB); PG8_STAGE(PG8_SA(0, 0), cA, voffA); PG8_STAGE(PG8_SB(0, 1), cB + hstep, voffB); PG8_STAGE(PG8_SA(0, 1), cA + hstep, voffA);
        if (wr == 1) PG8_BAR;
        PG8_WAIT_V(4); PG8_BAR;
        PG8_STAGE(PG8_SB(1, 0), cB + kstep, voffB); PG8_STAGE(PG8_SA(1, 0), cA + kstep, voffA); PG8_STAGE(PG8_SB(1, 1), cB + hstep + kstep, voffB);
        PG8_WAIT_V(6); PG8_BAR;
    }
    for (;;) {
        const bool has_next = S.next(ui + 1, nxt);
        const char* nA = uni_ptr(has_next ? S.a_base(nxt, tstep) : cA); const char* nB = uni_ptr(has_next ? S.b_base(nxt, tstep) : cB);
        for (int t = 0; t < nt; t += 2) {
            const bool last = (t == nt - 2);
            const char* a1 = cA + (size_t)(t + 1) * kstep;
            const char* a2 = last ? nA : cA + (size_t)(t + 2) * kstep; const char* b2 = last ? nB : cB + (size_t)(t + 2) * kstep;
            const char* a3 = a2 + kstep; const char* b3 = b2 + kstep;
            if (last && has_next) S.a_ready(nxt);
            if constexpr (SP2) {
            PG8_LDB(B0, 0, 0); PG8_LDB(B1, 0, 1); PG8_SCHED; PG8_LDA(At, 0, 0); PG8_STAGE(PG8_SA(1, 1), a1 + hstep, voffA);
            PG8_WAIT_V(8); PG8_WAIT_L(0); PG8_BAR; PG8_MMA(0, 0, At, B0); PG8_MMA(0, 1, At, B1); PG8_BAR; PG8_SCHED;
            PG8_LDA(At, 0, 1); PG8_STAGE(PG8_SB(0, 0), b2, voffB); PG8_STAGE(PG8_SB(0, 1), b2 + hstep, voffB); PG8_STAGE(PG8_SA(0, 0), a2, voffA);
            PG8_WAIT_V(8); PG8_WAIT_L(0); PG8_BAR; PG8_MMA(1, 0, At, B0); PG8_MMA(1, 1, At, B1); PG8_BAR; PG8_SCHED;
            PG8_LDB(B0, 1, 0); PG8_LDB(B1, 1, 1); PG8_SCHED; PG8_LDA(At, 1, 0); PG8_STAGE(PG8_SA(0, 1), a2 + hstep, voffA);
            PG8_WAIT_V(8); PG8_WAIT_L(0); PG8_BAR; PG8_MMA(0, 0, At, B0); PG8_MMA(0, 1, At, B1); PG8_BAR; PG8_SCHED;
            PG8_LDA(At, 1, 1); PG8_STAGE(PG8_SB(1, 0), b3, voffB); PG8_STAGE(PG8_SB(1, 1), b3 + hstep, voffB); PG8_STAGE(PG8_SA(1, 0), a3, voffA);
            PG8_WAIT_V(8); PG8_WAIT_L(0); PG8_BAR; PG8_MMA(1, 0, At, B0); PG8_MMA(1, 1, At, B1); PG8_BAR; PG8_SCHED;
            } else {
            PG8_LDB(B0, 0, 0); PG8_SCHED; PG8_LDA(At, 0, 0); PG8_STAGE(PG8_SA(1, 1), a1 + hstep, voffA);
            PG8_WAIT_L(8); PG8_BAR; PG8_WAIT_L(0); PG8_MMA(0, 0, At, B0); PG8_BAR; PG8_SCHED;
            PG8_LDB(B1, 0, 1); PG8_STAGE(PG8_SB(0, 0), b2, voffB);
            PG8_BAR; PG8_WAIT_L(0); PG8_MMA(0, 1, At, B1); PG8_BAR;
            PG8_LDA(At, 0, 1); PG8_STAGE(PG8_SA(0, 0), a2, voffA);
            PG8_BAR; PG8_WAIT_L(0); PG8_MMA(1, 0, At, B0); PG8_BAR; PG8_SCHED;
            PG8_STAGE(PG8_SB(0, 1), b2 + hstep, voffB);
            PG8_WAIT_V(6); PG8_BAR; PG8_MMA(1, 1, At, B1); PG8_BAR;
            PG8_LDB(B0, 1, 0); PG8_SCHED; PG8_LDA(At, 1, 0); PG8_STAGE(PG8_SA(0, 1), a2 + hstep, voffA);
            PG8_WAIT_L(8); PG8_BAR; PG8_WAIT_L(0); PG8_MMA(0, 0, At, B0); PG8_BAR; PG8_SCHED;
            PG8_LDB(B1, 1, 1); PG8_STAGE(PG8_SB(1, 0), b3, voffB);
            PG8_BAR; PG8_WAIT_L(0); PG8_MMA(0, 1, At, B1); PG8_BAR;
            PG8_LDA(At, 1, 1); PG8_STAGE(PG8_SA(1, 0), a3, voffA);
            PG8_BAR; PG8_WAIT_L(0); PG8_MMA(1, 0, At, B0); PG8_BAR; PG8_SCHED;
            PG8_STAGE(PG8_SB(1, 1), b3 + hstep, voffB);
            PG8_WAIT_V(6); PG8_BAR; PG8_MMA(1, 1, At, B1); PG8_BAR;
            }
        }
        if constexpr (ALIGN_EPI) { if (wr == 0) PG8_BAR; }
        if constexpr (!Epi::AFTER_DRAIN) { E(acc, cur, wr, wc, fr, fq); S.done(cur); }
        if (!has_next) break;
#pragma unroll
        for (int a = 0; a < 2; ++a)
#pragma unroll
            for (int b = 0; b < 2; ++b)
#pragma unroll
                for (int m = 0; m < 4; ++m)
#pragma unroll
                    for (int n = 0; n < 2; ++n) acc[a][b][m][n] = (f32x4){0.f, 0.f, 0.f, 0.f};
        cur = nxt; cA = nA; cB = nB; ++ui;
        if constexpr (ALIGN_EPI) { if (wr == 1) PG8_BAR; }
    }
    PG8_WAIT_V(0);
    if constexpr (!ALIGN_EPI) { if (wr == 0) PG8_BAR; }
    PG8_BAR;
    if constexpr (Epi::AFTER_DRAIN) { E.fused(acc, cur, wr, wc, fr, fq, lds, wid, lane); S.done(cur); }
#undef PG8_SA
#undef PG8_SB
#undef PG8_STAGE
#undef PG8_LDA
#undef PG8_LDB
#undef PG8_MMA
#undef PG8_WAIT_V
#undef PG8_WAIT_L
#undef PG8_BAR
#undef PG8_SCHED
}
}

constexpr int NWAVES = 8, NTHR = 512;
constexpr int D = 1024, NB = 8, SEQ = 4096, CTXL = 256, NL = 2;
constexpr int NLAT = NB * SEQ;
constexpr int NCTX = NB * CTXL;
constexpr int MT = NLAT + NCTX;
constexpr int INW = 2576, NEXP = 32, TOPK = 4;
constexpr int PMAX = (MT * TOPK / 256 + NEXP) * 256;
constexpr float EPS = 1e-6f;

constexpr size_t MiB = 1u << 20;
constexpr size_t WS_CTL = 0, CTL_ZERO_BYTES = 1 * MiB;
constexpr size_t WS_MODV = 1 * MiB;
constexpr size_t WS_WRT = 2 * MiB;
constexpr size_t WS_WABT = WS_WRT + 512 * 1024;
constexpr size_t WS_SELE = 3 * MiB;
constexpr size_t WS_SELP = WS_SELE + 640 * 1024;
constexpr size_t WS_SELG = WS_SELP + 640 * 1024;
constexpr size_t WS_G = 5 * MiB;
constexpr size_t WS_BETA = WS_G + 1536 * 1024;
constexpr size_t WS_AB = 8 * MiB;
constexpr size_t WS_WIN = 12 * MiB;
constexpr size_t WS_WOUT = 24 * MiB;
constexpr size_t WS_DFTM = 32 * MiB;
constexpr size_t WS_W1 = 96 * MiB;
constexpr size_t WS_W2 = 224 * MiB;
constexpr size_t WS_XC = 288 * MiB;
constexpr size_t WS_ACT = 296 * MiB;
constexpr size_t WS_S = 364 * MiB;
constexpr size_t WS_QKVZ = WS_S;
constexpr size_t WS_ZTL = WS_S + 136 * MiB;
constexpr size_t WS_ZTC = WS_ZTL + 64 * MiB;
constexpr size_t WS_QKVN = WS_ZTC + 4 * MiB;
constexpr size_t WS_OF = WS_QKVN + 102 * MiB;
constexpr size_t WS_OB = WS_OF + 34 * MiB;
constexpr size_t WS_XS = WS_S;
constexpr size_t WS_HS = WS_S + 288 * MiB;
constexpr size_t WS_EO = 984 * MiB;
constexpr size_t WS_AB2 = WS_ZTL;
constexpr size_t WS_ZN = 11 * MiB - 64 * 1024;
constexpr size_t WS_END = 1024 * MiB;
static_assert(WS_OB + 34 * MiB <= WS_END && WS_HS + 288 * MiB <= WS_END && (size_t)PMAX * 1024 * 2 == 288 * MiB, "d_ws map");
static_assert((size_t)MT * 16 <= 640 * 1024 && (size_t)MT * 32 <= 1536 * 1024, "sel / g maps");
constexpr int CW_BAR = 4096;
constexpr int CW_GCNT = 16384;

constexpr int RING_BYTES = 131072;
constexpr int LDSCTL_OFF = RING_BYTES, MISC_OFF = LDSCTL_OFF + 320;
constexpr int XT_OFF = RING_BYTES + 1024;
constexpr int LDS_BYTES = 147456;

#define GAS __attribute__((address_space(1)))
#define LAS __attribute__((address_space(3)))
typedef unsigned short bf16;
typedef unsigned v4u __attribute__((ext_vector_type(4)));
typedef unsigned v2u __attribute__((ext_vector_type(2)));
typedef float f32x4 __attribute__((ext_vector_type(4)));
typedef GAS unsigned gu32;
#define RLX_AGENT __ATOMIC_RELAXED, __HIP_MEMORY_SCOPE_AGENT
#define LDS_WAIT() asm volatile("s_waitcnt lgkmcnt(0)" ::: "memory")
#define VM_WAIT() asm volatile("s_waitcnt vmcnt(0)" ::: "memory")
typedef float f32x2_t __attribute__((ext_vector_type(2))); typedef __bf16 bf16x2_t __attribute__((ext_vector_type(2)));
__device__ __forceinline__ unsigned pk2(float lo, float hi) { const f32x2_t v = {lo, hi}; const bf16x2_t b = __builtin_convertvector(v, bf16x2_t); return __builtin_bit_cast(unsigned, b); }
__device__ __forceinline__ unsigned f2bf(float f) { return pk2(f, 0.f) & 0xffffu; }
__device__ __forceinline__ float bflo(unsigned w) { return __builtin_bit_cast(float, w << 16); }
__device__ __forceinline__ float bfhi(unsigned w) { return __builtin_bit_cast(float, w & 0xffff0000u); }
__device__ __forceinline__ float wave_sum(float v) {
#pragma unroll
    for (int o = 1; o < 64; o <<= 1) v += __shfl_xor(v, o);
    return v;
}
__device__ __forceinline__ float sum16(float v) {
#pragma unroll
    for (int o = 1; o < 16; o <<= 1) v += __shfl_xor(v, o);
    return v;
}
__device__ __forceinline__ float rs32(float (&p)[32], int lane) {
#pragma unroll
    for (int e = 0; e < 16; ++e) { const bool up = (lane & 32) != 0; const float send = up ? p[e] : p[e + 16], keep = up ? p[e + 16] : p[e]; p[e] = keep + __shfl_xor(send, 32); }
#pragma unroll
    for (int e = 0; e < 8; ++e) { const bool up = (lane & 16) != 0; const float send = up ? p[e] : p[e + 8], keep = up ? p[e + 8] : p[e]; p[e] = keep + __shfl_xor(send, 16); }
#pragma unroll
    for (int e = 0; e < 4; ++e) { const bool up = (lane & 8) != 0; const float send = up ? p[e] : p[e + 4], keep = up ? p[e + 4] : p[e]; p[e] = keep + __shfl_xor(send, 8); }
#pragma unroll
    for (int e = 0; e < 2; ++e) { const bool up = (lane & 4) != 0; const float send = up ? p[e] : p[e + 2], keep = up ? p[e + 2] : p[e]; p[e] = keep + __shfl_xor(send, 4); }
    { const bool up = (lane & 2) != 0; const float send = up ? p[0] : p[1], keep = up ? p[1] : p[0]; p[0] = keep + __shfl_xor(send, 2); }
    return p[0] + __shfl_xor(p[0], 1);
}
__device__ __forceinline__ float rs16(float (&p)[16], int lane) {
#pragma unroll
    for (int e = 0; e < 8; ++e) { const bool up = (lane & 32) != 0; const float send = up ? p[e] : p[e + 8], keep = up ? p[e + 8] : p[e]; p[e] = keep + __shfl_xor(send, 32); }
#pragma unroll
    for (int e = 0; e < 4; ++e) { const bool up = (lane & 16) != 0; const float send = up ? p[e] : p[e + 4], keep = up ? p[e + 4] : p[e]; p[e] = keep + __shfl_xor(send, 16); }
#pragma unroll
    for (int e = 0; e < 2; ++e) { const bool up = (lane & 8) != 0; const float send = up ? p[e] : p[e + 2], keep = up ? p[e + 2] : p[e]; p[e] = keep + __shfl_xor(send, 8); }
    { const bool up = (lane & 4) != 0; const float send = up ? p[0] : p[1], keep = up ? p[1] : p[0]; p[0] = keep + __shfl_xor(send, 4); }
    float r = p[0] + __shfl_xor(p[0], 2);
    return r + __shfl_xor(r, 1);
}
__device__ __forceinline__ float silu_f(float x) { return x / (1.f + __expf(-x)); }

#define XB_TMO      128
#define XB_XCNT(j)  (256  + 64 * (j))
#define XB_XSUB(j)  (1280 + 64 * (j))
#define XB_XGEN(j)  (2304 + 64 * (j))
#define XB_TOP      3328
#define XB_TOPGEN   3392
#define XCD_BAR_WORDS 3456
#define XB_SPIN_CAP (1u << 18)
__device__ __forceinline__ unsigned xb_ld(unsigned* p)              { return __hip_atomic_load(p, __ATOMIC_RELAXED, __HIP_MEMORY_SCOPE_AGENT); }
__device__ __forceinline__ unsigned xb_add(unsigned* p, unsigned v) { return __hip_atomic_fetch_add(p, v, __ATOMIC_RELAXED, __HIP_MEMORY_SCOPE_AGENT); }
__device__ __forceinline__ unsigned xb_xcc_id() { return (unsigned)__builtin_amdgcn_s_getreg((3 << 11) | 20) & 0xFu; }
#define XB_SPIN(cond, bar) do { unsigned _sp = 0; while (cond) { __builtin_amdgcn_s_sleep(1); \
    if ((++_sp & 255u) == 0u) { if (xb_ld(&(bar)[XB_TMO])) break; if (_sp > XB_SPIN_CAP) { atomicAdd(&(bar)[XB_TMO], 1u); break; } } } } while (0)
struct XcdBarrier { unsigned* bar; unsigned x; volatile LAS unsigned* st; };
__device__ __forceinline__ XcdBarrier xcd_barrier_post(unsigned* bar, volatile LAS unsigned* st, int tid) {
    XcdBarrier b; b.bar = bar; b.x = xb_xcc_id(); b.st = st;
    if (tid == 0) (void)xb_add(&bar[XB_XCNT(b.x)], 1u);
    return b;
}
__device__ __forceinline__ void xcd_barrier_complete(unsigned* bar, unsigned x, unsigned& nloc, unsigned& nx) {
    const unsigned G = gridDim.x * gridDim.y * gridDim.z;
    unsigned sum, cnt, mine, sp = 0u;
    for (;;) {
        sum = 0u; cnt = 0u; mine = 0u;
#pragma unroll
        for (unsigned j = 0; j < 16; ++j) { const unsigned c = xb_ld(&bar[XB_XCNT(j)]); sum += c; cnt += (c > 0u) ? 1u : 0u; mine = (j == x) ? c : mine; }
        if (sum == G) break;
        __builtin_amdgcn_s_sleep(1);
        if ((++sp & 255u) == 0u) { if (xb_ld(&bar[XB_TMO])) break; if (sp > XB_SPIN_CAP) { atomicAdd(&bar[XB_TMO], 1u); break; } }
    }
    nloc = mine > 0u ? mine : 1u; nx = cnt > 0u ? cnt : 1u;
}
__device__ __forceinline__ void xcd_barrier(const XcdBarrier& b, int tid) {
    asm volatile("s_waitcnt vmcnt(0)" ::: "memory");
    __syncthreads();
    if (tid == 0) {
        unsigned* bar = b.bar; unsigned bx = b.x;
        asm volatile("" : "+v"(bar), "+v"(bx));
        __builtin_amdgcn_s_waitcnt(0);
        unsigned nloc = b.st[0], nx = b.st[1];
        if (nloc == 0u) { xcd_barrier_complete(bar, bx, nloc, nx); b.st[0] = nloc; b.st[1] = nx; }
        const unsigned old = xb_add(&bar[XB_XSUB(bx)], 1u);
        const unsigned gen = old / nloc;
        if (old + 1u == (gen + 1u) * nloc) {
            __builtin_amdgcn_fence(__ATOMIC_RELEASE, "agent");
            asm volatile("s_waitcnt vmcnt(0)" ::: "memory");
            const unsigned og = xb_add(&bar[XB_TOP], 1u);
            const unsigned tg = og / nx;
            if (og + 1u == (tg + 1u) * nx) xb_add(&bar[XB_TOPGEN], 1u);
            else XB_SPIN(xb_ld(&bar[XB_TOPGEN]) == tg, bar);
            __builtin_amdgcn_fence(__ATOMIC_ACQUIRE, "agent");
            xb_add(&bar[XB_XGEN(bx)], 1u);
            asm volatile("s_waitcnt vmcnt(0)" ::: "memory");
        } else {
            XB_SPIN(xb_ld(&bar[XB_XGEN(bx)]) == gen, bar);
            __builtin_amdgcn_fence(__ATOMIC_ACQUIRE, "agent");
            asm volatile("s_waitcnt vmcnt(0)" ::: "memory");
        }
    }
    __syncthreads();
}

struct Args { const float* in[23]; float* out; unsigned char* ws; int ph_lo, ph_hi; };
struct Frame {
    LAS unsigned char* lds;
    volatile LAS unsigned* MISC;
    unsigned* ctl;
    unsigned char* ws;
    int tid, lane, wave, vcu, G, gw, NGW;
    float* out;
};
typedef const Args __attribute__((address_space(4)))* KArgsP;
__device__ __forceinline__ KArgsP kargs() { unsigned long long v = (unsigned long long)__builtin_amdgcn_kernarg_segment_ptr(); asm volatile("" : "+s"(v)); return (KArgsP)v; }
enum InIdx { I_X = 0, I_C, I_CTX, I_CCTX, I_WMOD, I_BMOD, I_GN1, I_WIN, I_CONVW, I_ALOG, I_DTB, I_GOUT, I_WOUT, I_GN2, I_WR, I_BR, I_WG, I_BG, I_WU, I_BU, I_WD, I_BD, I_GF };
__device__ __forceinline__ float* xr_row(const Frame& F, int t) { return t < NLAT ? F.out + (size_t)t * D : (float*)(F.ws + WS_XC) + (size_t)(t - NLAT) * D; }
__device__ __forceinline__ int mod_row(int t) { return t < NLAT ? (t >> 12) : 8; }
__device__ __forceinline__ const float* modv(const Frame& F, int l, int r, int piece) { return (const float*)(F.ws + WS_MODV) + ((size_t)(l * 9 + r) * 6 + piece) * D; }

struct SchedIn {
    const bf16* hx; const bf16* win; int G, c;
    static constexpr int N0 = (MT / 256) * 8, N1 = 4 * (MT / 256), NWG = N0 + N1;
    __device__ __forceinline__ bool next(int i, pg8::Unit& u) const {
        const long L = (long)i * G + c; if (L >= NWG) return false;
        int w = pg8::xcd_remap((int)L, NWG);
        if (w < N0) { u.kind = 0; pg8::grp_decode(w, MT / 256, 8, u.pm, u.pn); } else { w -= N0; u.kind = 1; u.pn = w >> 2; u.pm = w & 3; }
        u.e = 0; return true;
    }
    __device__ __forceinline__ const char* a_base(const pg8::Unit& u, size_t tstep) const { return u.kind == 0 ? (const char*)hx + (size_t)u.pm * tstep : (const char*)win + (size_t)(8 + u.pm) * tstep; }
    __device__ __forceinline__ const char* b_base(const pg8::Unit& u, size_t tstep) const { return u.kind == 0 ? (const char*)win + (size_t)u.pn * tstep : (const char*)hx + (size_t)u.pn * tstep; }
    __device__ __forceinline__ void a_ready(const pg8::Unit&) const {}
    __device__ __forceinline__ void done(const pg8::Unit&) const {}
};
struct EpiIn {
    static constexpr bool PERM = true, AFTER_DRAIN = false;
    bf16* qkvz; bf16* ztl; bf16* ztc;
    __device__ __forceinline__ void operator()(const pg8::f32x4 (&acc)[2][2][4][2], const pg8::Unit& u, int wr, int wc, int fr_, int fq_) const {
        int fr = fr_, fq = fq_; asm volatile("" : "+v"(fr), "+v"(fq));
        const int row0 = u.pm * 256 + wr * 64 + fr, cin = wc * 32 + 8 * fq;
        bf16* base; size_t ldc;
        if (u.kind == 0) { base = qkvz + (size_t)u.pn * 256 + cin; ldc = 2048; }
        else if (u.pn < 128) { base = ztl + (size_t)(u.pn >> 4) * 1024 * 4096 + (size_t)(u.pn & 15) * 256 + cin; ldc = 4096; }
        else { base = ztc + (size_t)(u.pn - 128) * 1024 * 256 + cin; ldc = 256; }
#pragma unroll
        for (int ai = 0; ai < 2; ++ai)
#pragma unroll
            for (int m = 0; m < 4; ++m) { bf16* rowp = base + (size_t)(row0 + ai * 128 + m * 16) * ldc;
#pragma unroll
                for (int bj = 0; bj < 2; ++bj) { const pg8::f32x4 v0 = acc[ai][bj][m][0], v1 = acc[ai][bj][m][1]; pg8::u32x4 w;
                    w.x = pg8::cvt_pk_bf16(v0[0], v0[1]); w.y = pg8::cvt_pk_bf16(v0[2], v0[3]); w.z = pg8::cvt_pk_bf16(v1[0], v1[1]); w.w = pg8::cvt_pk_bf16(v1[2], v1[3]);
                    *(pg8::u32x4*)(rowp + bj * 128) = w; } }
    }
};
struct SchedDft {
    const bf16* dftm; const bf16* eo; int v;
    __device__ __forceinline__ bool next(int i, pg8::Unit& u) const {
        if (i >= 2 || v < 0) return false;
        const int w = (v >> 5) * 64 + i * 32 + (v & 31), x = w >> 5, j = w & 31;
        u.kind = x & 1; u.pm = 4 * ((x >> 1) & 1) + (j & 3); u.e = 4 * (x >> 2) + ((j >> 2) & 3); u.pn = j >> 4; return true;
    }
    __device__ __forceinline__ const char* a_base(const pg8::Unit& u, size_t tstep) const { return (const char*)dftm + (size_t)u.kind * (2048 * 2048 * 2) + (size_t)u.pm * tstep; }
    __device__ __forceinline__ const char* b_base(const pg8::Unit& u, size_t tstep) const { return (const char*)eo + (size_t)(u.e * 2 + u.kind) * (512 * 2048 * 2) + (size_t)u.pn * tstep; }
    __device__ __forceinline__ void a_ready(const pg8::Unit&) const {}
    __device__ __forceinline__ void done(const pg8::Unit&) const {}
};
struct EpiDft {
    static constexpr bool PERM = true, AFTER_DRAIN = false;
    bf16* ab2;
    __device__ __forceinline__ void operator()(const pg8::f32x4 (&acc)[2][2][4][2], const pg8::Unit& u, int wr, int wc, int fr_, int fq_) const {
        int fr = fr_, fq = fq_; asm volatile("" : "+v"(fr), "+v"(fq));
        const int row0 = u.pm * 256 + wr * 64 + fr, col0 = u.pn * 256 + wc * 32 + 8 * fq;
        bf16* base = ab2 + (size_t)(u.e * 2 + u.kind) * 2048 * 512;
#pragma unroll
        for (int ai = 0; ai < 2; ++ai)
#pragma unroll
            for (int m = 0; m < 4; ++m) { bf16* rowp = base + (size_t)(row0 + ai * 128 + m * 16) * 512 + col0;
#pragma unroll
                for (int bj = 0; bj < 2; ++bj) { const pg8::f32x4 v0 = acc[ai][bj][m][0], v1 = acc[ai][bj][m][1]; pg8::u32x4 w;
                    w.x = pg8::cvt_pk_bf16(v0[0], v0[1]); w.y = pg8::cvt_pk_bf16(v0[2], v0[3]); w.z = pg8::cvt_pk_bf16(v1[0], v1[1]); w.w = pg8::cvt_pk_bf16(v1[2], v1[3]);
                    *(pg8::u32x4*)(rowp + bj * 128) = w; } }
    }
};
struct SchedOut {
    const bf16* mix; const bf16* wout; int nM, G, c;
    __device__ __forceinline__ bool next(int i, pg8::Unit& u) const {
        const int nwg = nM * 4; const long L = (long)i * G + c; if (L >= nwg) return false;
        pg8::grp_decode(pg8::xcd_remap((int)L, nwg), nM, 4, u.pm, u.pn); u.kind = 0; u.e = 0; return true;
    }
    __device__ __forceinline__ const char* a_base(const pg8::Unit& u, size_t tstep) const { return (const char*)mix + (size_t)u.pm * tstep; }
    __device__ __forceinline__ const char* b_base(const pg8::Unit& u, size_t tstep) const { return (const char*)wout + (size_t)u.pn * tstep; }
    __device__ __forceinline__ void a_ready(const pg8::Unit&) const {}
    __device__ __forceinline__ void done(const pg8::Unit&) const {}
};
struct EpiOut {
    static constexpr bool PERM = false, AFTER_DRAIN = false;
    float* xlat; float* xctx; const float* gt1; float dsc;
    __device__ __forceinline__ void operator()(const pg8::f32x4 (&acc)[2][2][4][2], const pg8::Unit& u, int wr, int wc, int fr_, int fq_) const {
        int fr = fr_, fq = fq_; asm volatile("" : "+v"(fr), "+v"(fq));
        const int col0 = u.pn * 256 + wc * 32 + 4 * fq, rl = wr * 64 + fr;
        float* xb = u.pm < 128 ? xlat + (size_t)u.pm * 256 * D : xctx + (size_t)(u.pm - 128) * 256 * D;
        const float* g = gt1 + (size_t)(u.pm < 128 ? (u.pm >> 4) : 8) * 6 * D + col0;
        pg8::f32x4 gv[2][2];
#pragma unroll
        for (int bj = 0; bj < 2; ++bj)
#pragma unroll
            for (int n = 0; n < 2; ++n) gv[bj][n] = *(const pg8::f32x4*)(g + bj * 128 + n * 16);
#pragma unroll
        for (int ai = 0; ai < 2; ++ai)
#pragma unroll
            for (int m = 0; m < 4; ++m) { float* rowp = xb + (size_t)(rl + ai * 128 + m * 16) * D + col0;
#pragma unroll
                for (int bj = 0; bj < 2; ++bj)
#pragma unroll
                    for (int n = 0; n < 2; ++n) { pg8::f32x4* p = (pg8::f32x4*)(rowp + bj * 128 + n * 16); const pg8::f32x4 xo = *p; *p = xo + gv[bj][n] * acc[ai][bj][m][n] * dsc; }
                if (m & 1) asm volatile("" ::: "memory"); }
    }
};
struct SchedMoe {
    const bf16* A; const bf16* W; size_t wstride; const LAS int* pend; int nM, nN, G, c;
    __device__ __forceinline__ bool next(int i, pg8::Unit& u) const {
        const int nwg = nM * nN; const long L = (long)i * G + c; if (L >= nwg) return false;
        pg8::grp_decode(pg8::xcd_remap((int)L, nwg), nM, nN, u.pm, u.pn);
        int e = 0;
#pragma unroll 1
        for (int j = 0; j < NEXP - 1; ++j) e += (pend[j] <= u.pm) ? 1 : 0;
        u.e = e; u.kind = 0; return true;
    }
    __device__ __forceinline__ const char* a_base(const pg8::Unit& u, size_t tstep) const { return (const char*)A + (size_t)u.pm * tstep; }
    __device__ __forceinline__ const char* b_base(const pg8::Unit& u, size_t tstep) const { return (const char*)W + (size_t)u.e * wstride + (size_t)u.pn * tstep; }
    __device__ __forceinline__ void a_ready(const pg8::Unit&) const {}
    __device__ __forceinline__ void done(const pg8::Unit&) const {}
};
struct EpiSwiglu {
    static constexpr bool PERM = true, AFTER_DRAIN = false;
    bf16* hs; const float* bg; const float* bu;
    __device__ __forceinline__ void operator()(const pg8::f32x4 (&acc)[2][2][4][2], const pg8::Unit& u, int wr, int wc, int fr_, int fq_) const {
        int fr = fr_, fq = fq_; asm volatile("" : "+v"(fr), "+v"(fq));
        const int row0 = u.pm * 256 + wr * 64 + fr, f0 = u.pn * 128 + wc * 32 + 8 * fq;
        const pg8::f32x4 bg0 = *(const pg8::f32x4*)(bg + u.e * D + f0), bg1 = *(const pg8::f32x4*)(bg + u.e * D + f0 + 4);
        const pg8::f32x4 bu0 = *(const pg8::f32x4*)(bu + u.e * D + f0), bu1 = *(const pg8::f32x4*)(bu + u.e * D + f0 + 4);
#pragma unroll
        for (int ai = 0; ai < 2; ++ai)
#pragma unroll
            for (int m = 0; m < 4; ++m) {
                float h[8];
#pragma unroll
                for (int n = 0; n < 2; ++n) { const pg8::f32x4 ga = acc[ai][0][m][n] + (n ? bg1 : bg0), ua = acc[ai][1][m][n] + (n ? bu1 : bu0);
#pragma unroll
                    for (int j = 0; j < 4; ++j) { const float a = fminf(ga[j], 7.0f), uu = fminf(fmaxf(ua[j], -7.0f), 7.0f);
                        h[n * 4 + j] = a * __builtin_amdgcn_rcpf(1.0f + __expf(-1.702f * a)) * (uu + 1.0f); } }
                pg8::u32x4 w; w.x = pg8::cvt_pk_bf16(h[0], h[1]); w.y = pg8::cvt_pk_bf16(h[2], h[3]); w.z = pg8::cvt_pk_bf16(h[4], h[5]); w.w = pg8::cvt_pk_bf16(h[6], h[7]);
                *(pg8::u32x4*)(hs + (size_t)(row0 + ai * 128 + m * 16) * D + f0) = w; }
    }
};
struct EpiDown {
    static constexpr bool PERM = true, AFTER_DRAIN = false;
    bf16* ys; const float* bd;
    __device__ __forceinline__ void operator()(const pg8::f32x4 (&acc)[2][2][4][2], const pg8::Unit& u, int wr, int wc, int fr_, int fq_) const {
        int fr = fr_, fq = fq_; asm volatile("" : "+v"(fr), "+v"(fq));
        const int row0 = u.pm * 256 + wr * 64 + fr, col0 = u.pn * 256 + wc * 32 + 8 * fq;
        pg8::f32x4 bv[2][2];
#pragma unroll
        for (int bj = 0; bj < 2; ++bj)
#pragma unroll
            for (int n = 0; n < 2; ++n) bv[bj][n] = *(const pg8::f32x4*)(bd + u.e * D + col0 + bj * 128 + 4 * n);
#pragma unroll
        for (int ai = 0; ai < 2; ++ai)
#pragma unroll
            for (int m = 0; m < 4; ++m) { bf16* rowp = ys + (size_t)(row0 + ai * 128 + m * 16) * D + col0;
#pragma unroll
                for (int bj = 0; bj < 2; ++bj) { const pg8::f32x4 v0 = acc[ai][bj][m][0] + bv[bj][0], v1 = acc[ai][bj][m][1] + bv[bj][1]; pg8::u32x4 w;
                    w.x = pg8::cvt_pk_bf16(v0[0], v0[1]); w.y = pg8::cvt_pk_bf16(v0[2], v0[3]); w.z = pg8::cvt_pk_bf16(v1[0], v1[1]); w.w = pg8::cvt_pk_bf16(v1[2], v1[3]);
                    *(pg8::u32x4*)(rowp + bj * 128) = w; } }
    }
};

__device__ __forceinline__ void transpose_item(const float* W, int ldw, int col0, int K, bf16* WT, int drow0, LAS float* scr, int kb, int lane) {
    const int k0 = 64 * kb;
#pragma unroll 8
    for (int i = 0; i < 32; ++i) { const int kk = 2 * i + (lane >> 5); scr[kk * 33 + (lane & 31)] = W[(size_t)(k0 + kk) * ldw + col0 + (lane & 31)]; }
    LDS_WAIT(); asm volatile("" ::: "memory");
    const int c = lane & 7;
#pragma unroll
    for (int j = 0; j < 4; ++j) { const int n = (lane >> 3) + 8 * j; const LAS float* s = scr + (8 * c) * 33 + n;
        v4u o; o.x = pk2(s[0 * 33], s[1 * 33]); o.y = pk2(s[2 * 33], s[3 * 33]); o.z = pk2(s[4 * 33], s[5 * 33]); o.w = pk2(s[6 * 33], s[7 * 33]);
        *(v4u*)(WT + (size_t)(drow0 + n) * K + k0 + 8 * c) = o; }
    LDS_WAIT(); asm volatile("" ::: "memory");
}
__device__ __forceinline__ void convert_experts(const Frame& F, int l) {
    const KArgsP A = kargs();
    LAS float* scr = (LAS float*)(F.lds + F.wave * 16384);
    bf16* W1 = (bf16*)(F.ws + WS_W1); bf16* W2 = (bf16*)(F.ws + WS_W2);
    constexpr int IPM = 16 * 32;
    for (int it = F.gw; it < 3 * NEXP * IPM; it += F.NGW) {
        const int which = it / (NEXP * IPM), r = it % (NEXP * IPM), e = r / IPM, q = r % IPM, kb = q >> 5, nb = q & 31;
        const size_t moff = ((size_t)l * NEXP + e) * D * D;
        if (which == 0) transpose_item(A->in[I_WG] + moff, D, nb * 32, D, W1 + (size_t)e * 2048 * D, 256 * (nb >> 2) + 32 * (nb & 3), scr, kb, F.lane);
        else if (which == 1) transpose_item(A->in[I_WU] + moff, D, nb * 32, D, W1 + (size_t)e * 2048 * D, 256 * (nb >> 2) + 128 + 32 * (nb & 3), scr, kb, F.lane);
        else transpose_item(A->in[I_WD] + moff, D, nb * 32, D, W2 + (size_t)e * D * D, nb * 32, scr, kb, F.lane);
    }
}
__device__ __forceinline__ void p0_prologue(const Frame& F) {
    const KArgsP A = kargs();
    float* mv = (float*)(F.ws + WS_MODV);
    {
        LAS float* sc = (LAS float*)F.lds;
        LAS float* red = sc + 9 * 1024;
        for (int i = F.tid; i < 9 * 1024; i += NTHR) { const int r = i >> 10, k = i & 1023; sc[i] = silu_f(r < 8 ? A->in[I_C][r * D + k] : A->in[I_CCTX][k]); }
        __syncthreads();
        for (int item = blockIdx.x; item < 192; item += F.G) {
            const int l = item / 96, cg = item % 96, cl = F.tid & 63, ks = F.tid >> 6;
            const float* w = A->in[I_WMOD] + ((size_t)l * D + ks * 128) * 6144 + cg * 64 + cl;
            float a[9];
#pragma unroll
            for (int r = 0; r < 9; ++r) a[r] = 0.f;
#pragma unroll 4
            for (int k = 0; k < 128; ++k) { const float wv = w[(size_t)k * 6144];
#pragma unroll
                for (int r = 0; r < 9; ++r) a[r] += sc[r * 1024 + ks * 128 + k] * wv; }
#pragma unroll
            for (int r = 0; r < 9; ++r) red[(ks * 9 + r) * 64 + cl] = a[r];
            __syncthreads();
            for (int i = F.tid; i < 9 * 64; i += NTHR) { const int r = i >> 6, cc = i & 63; float s = 0.f;
#pragma unroll
                for (int k2 = 0; k2 < 8; ++k2) s += red[(k2 * 9 + r) * 64 + cc];
                mv[(size_t)(l * 9 + r) * 6144 + cg * 64 + cc] = s + A->in[I_BMOD][l * 6144 + cg * 64 + cc]; }
            __syncthreads();
        }
    }
    {
        LAS float* T = (LAS float*)F.lds;
        LAS float* cs = T + 64 * 129; LAS float* sn = cs + 128;
        __syncthreads();
        if (F.tid < 128) { cs[F.tid] = cospif((float)F.tid * (1.0f / 64.0f)); sn[F.tid] = sinpif((float)F.tid * (1.0f / 64.0f)); }
        for (int item = (blockIdx.x + 64) % F.G; item < 128; item += F.G) {
            const int l = item >> 6, kg = (item & 63) >> 2, g = item & 3;
            __syncthreads();
            for (int i = F.tid; i < 64 * 128; i += NTHR) { const int kk = i >> 7, cc = i & 127; T[kk * 129 + cc] = A->in[I_WIN][((size_t)l * D + kg * 64 + kk) * INW + g * 128 + cc]; }
            __syncthreads();
            const int kk = F.tid & 63, ng = F.tid >> 6;
            bf16* dst = (bf16*)(F.ws + WS_WIN) + ((size_t)l * 3072 + 2048 + g * 256) * D + kg * 64 + kk;
#pragma unroll 1
            for (int nn = 0; nn < 32; ++nn) { const int np = ng * 32 + nn, cp = np >> 1; float s = 0.f;
                if (np & 1) {
#pragma unroll 8
                    for (int cc = 0; cc < 128; ++cc) s -= T[kk * 129 + cc] * sn[(cc * cp) & 127]; }
                else {
#pragma unroll 8
                    for (int cc = 0; cc < 128; ++cc) s += T[kk * 129 + cc] * cs[(cc * cp) & 127]; }
                dst[(size_t)np * D] = (bf16)f2bf(s); }
        }
        __syncthreads();
    }
    {
        LAS float* scr = (LAS float*)(F.lds + F.wave * 16384);
        constexpr int I_IN = 16 * 64, I_OUT = 16 * 32;
        for (int it = F.gw; it < NL * (I_IN + I_OUT); it += F.NGW) {
            const int l = it / (I_IN + I_OUT), r = it % (I_IN + I_OUT);
            if (r < I_IN) transpose_item(A->in[I_WIN] + (size_t)l * D * INW, INW, 512 + 32 * (r & 63), D, (bf16*)(F.ws + WS_WIN) + (size_t)l * 3072 * D, 32 * (r & 63), scr, r >> 6, F.lane);
            else { const int q = r - I_IN; transpose_item(A->in[I_WOUT] + (size_t)l * D * D, D, 32 * (q & 31), D, (bf16*)(F.ws + WS_WOUT) + (size_t)l * D * D, 32 * (q & 31), scr, q >> 5, F.lane); }
        }
    }
    convert_experts(F, 0);
    {
        const int gt = F.gw * 64 + F.lane, NT = F.NGW * 64;
        float* wrt = (float*)(F.ws + WS_WRT); float* wabt = (float*)(F.ws + WS_WABT);
        for (int i = gt; i < NL * NEXP * D; i += NT) { const int l = i >> 15, e = (i >> 10) & 31, c = i & 1023; wrt[i] = A->in[I_WR][((size_t)l * D + c) * NEXP + e]; }
        for (int i = gt; i < NL * 16 * D; i += NT) { const int l = i >> 14, j = (i >> 10) & 15, c = i & 1023; wabt[i] = A->in[I_WIN][((size_t)l * D + c) * INW + 2560 + j]; }
        bf16* dm = (bf16*)(F.ws + WS_DFTM);
        for (int i = gt; i < 2 * 2048 * 256; i += NT) { const int mat = i >> 19, kf = (i >> 8) & 2047, j0 = (i & 255) * 8; float v[8];
#pragma unroll
            for (int jj = 0; jj < 8; ++jj) { const float a = (float)((kf * (j0 + jj)) & 4095) * (1.0f / 2048.0f); v[jj] = mat ? sinpif(a) : cospif(a); }
            v4u o; o.x = pk2(v[0], v[1]); o.y = pk2(v[2], v[3]); o.z = pk2(v[4], v[5]); o.w = pk2(v[6], v[7]);
            *(v4u*)(dm + (size_t)i * 8) = o; }
    }
}

template <int MODE>
__device__ __forceinline__ void row_pass(const Frame& F, int l_cur, int l_nxt, bool dummy = false) {
    const KArgsP A = kargs();
    LAS float* wl = (LAS float*)F.lds;
    if (MODE != 2) { const f32x4* src = (const f32x4*)((const float*)(F.ws + WS_WABT) + (size_t)l_nxt * 16 * D);
        for (int i = F.tid; i < 16 * D / 4; i += NTHR) ((LAS f32x4*)wl)[i] = src[i];
        __syncthreads(); }
    const int nrows = MODE == 2 ? NLAT : MT;
    const int* selp = (const int*)(F.ws + WS_SELP); const float* selg = (const float*)(F.ws + WS_SELG);
    const bf16* ys = (const bf16*)(F.ws + WS_XS);
    bf16* hx = (bf16*)(F.ws + WS_ACT); float* ab = (float*)(F.ws + WS_AB);
    f32x4 xc[4]; int dc[4]; float gc[4]; v2u yc[4][4];
    int t = F.gw;
    if (t < nrows) {
        const float* xin = MODE == 0 ? (t < NLAT ? A->in[I_X] + (size_t)t * D : A->in[I_CTX] + (size_t)(t - NLAT) * D) : xr_row(F, t);
#pragma unroll
        for (int j = 0; j < 4; ++j) xc[j] = *((const f32x4*)xin + F.lane + 64 * j);
        if (MODE != 0) {
#pragma unroll
            for (int k = 0; k < 4; ++k) { dc[k] = selp[t * 4 + k]; gc[k] = selg[t * 4 + k]; }
#pragma unroll
            for (int k = 0; k < 4; ++k) { const v2u* yr = (const v2u*)(ys + (size_t)dc[k] * D) + F.lane;
#pragma unroll
                for (int j = 0; j < 4; ++j) yc[k][j] = yr[64 * j]; } }
    }
    for (; t < nrows; t += F.NGW) {
        const int tn = t + F.NGW < nrows ? t + F.NGW : t;
        f32x4 xn[4]; int dn[4]; float gn[4];
        { const float* xin = MODE == 0 ? (tn < NLAT ? A->in[I_X] + (size_t)tn * D : A->in[I_CTX] + (size_t)(tn - NLAT) * D) : xr_row(F, tn);
#pragma unroll
          for (int j = 0; j < 4; ++j) xn[j] = *((const f32x4*)xin + F.lane + 64 * j);
          if (MODE != 0) {
#pragma unroll
              for (int k = 0; k < 4; ++k) { dn[k] = selp[tn * 4 + k]; gn[k] = selg[tn * 4 + k]; } } }
        const int r = mod_row(t);
        f32x4 v[4];
#pragma unroll
        for (int j = 0; j < 4; ++j) v[j] = xc[j];
        float* xr = xr_row(F, t);
        if (MODE != 0) {
            f32x4 y[4];
#pragma unroll
            for (int j = 0; j < 4; ++j) y[j] = (f32x4){0.f, 0.f, 0.f, 0.f};
#pragma unroll
            for (int k = 0; k < 4; ++k)
#pragma unroll
                for (int j = 0; j < 4; ++j) { const v2u w = yc[k][j]; y[j] += gc[k] * (f32x4){bflo(w.x), bfhi(w.x), bflo(w.y), bfhi(w.y)}; }
            const f32x4* g2 = (const f32x4*)modv(F, l_cur, r, 5) + F.lane;
#pragma unroll
            for (int j = 0; j < 4; ++j) v[j] += g2[64 * j] * y[j];
#pragma unroll
            for (int k = 0; k < 4; ++k) { const v2u* yr = (const v2u*)(ys + (size_t)dn[k] * D) + F.lane;
#pragma unroll
                for (int j = 0; j < 4; ++j) yc[k][j] = yr[64 * j]; }
        }
        if (MODE != 2 && !dummy) {
#pragma unroll
            for (int j = 0; j < 4; ++j) *((f32x4*)xr + F.lane + 64 * j) = v[j];
        }
        float ss = 0.f;
#pragma unroll
        for (int j = 0; j < 4; ++j) ss += (v[j].x * v[j].x + v[j].y * v[j].y) + (v[j].z * v[j].z + v[j].w * v[j].w);
        const float rstd = 1.0f / sqrtf(wave_sum(ss) * (1.0f / D) + EPS);
        if (MODE == 2) {
            const f32x4* gf = (const f32x4*)A->in[I_GF] + F.lane;
#pragma unroll
            for (int j = 0; j < 4; ++j) *((f32x4*)(F.out + (size_t)t * D) + F.lane + 64 * j) = v[j] * rstd * gf[64 * j];
        } else {
            const f32x4* g1 = (const f32x4*)(A->in[I_GN1] + (size_t)l_nxt * D) + F.lane;
            const f32x4* sh = (const f32x4*)modv(F, l_nxt, r, 0) + F.lane; const f32x4* scl = (const f32x4*)modv(F, l_nxt, r, 1) + F.lane;
            v2u* ho = (v2u*)(hx + (size_t)t * D) + F.lane;
#pragma unroll
            for (int j = 0; j < 4; ++j) { v[j] = v[j] * rstd * g1[64 * j] * (scl[64 * j] + 1.0f) + sh[64 * j]; v2u w; w.x = pk2(v[j].x, v[j].y); w.y = pk2(v[j].z, v[j].w); ho[64 * j] = w; }
            float pp[16];
            int lofs = F.lane; asm volatile("" : "+v"(lofs));
#pragma unroll
            for (int jj = 0; jj < 16; ++jj) { float p = 0.f;
#pragma unroll
                for (int j = 0; j < 4; ++j) { const f32x4 w = ((const LAS f32x4*)(wl + jj * D))[lofs + 64 * j]; p += (v[j].x * w.x + v[j].y * w.y) + (v[j].z * w.z + v[j].w * w.w); }
                pp[jj] = p; if ((jj & 3) == 3) asm volatile("" ::: "memory"); }
            const float mine = rs16(pp, F.lane);
            if ((F.lane & 3) == 0) ab[(size_t)t * 16 + (F.lane >> 2)] = mine;
        }
#pragma unroll
        for (int j = 0; j < 4; ++j) xc[j] = xn[j];
        if (MODE != 0) {
#pragma unroll
            for (int k = 0; k < 4; ++k) { dc[k] = dn[k]; gc[k] = gn[k]; } }
    }
}

__device__ __forceinline__ int seq_id(int x) { return x < 0 ? -1 : (x < NLAT ? (x >> 12) : (x < MT ? 8 + ((x - NLAT) >> 8) : -2)); }
__device__ __forceinline__ void conv_phase(const Frame& F, int l) {
    const KArgsP A = kargs();
    LAS float* cw = (LAS float*)F.lds;
    for (int i = F.tid; i < 5 * 1536; i += NTHR) cw[i] = A->in[I_CONVW][(size_t)l * 5 * 1536 + i];
    __syncthreads();
    const bf16* qkvz = (const bf16*)(F.ws + WS_QKVZ); bf16* qkvn = (bf16*)(F.ws + WS_QKVN);
    const float* ab = (const float*)(F.ws + WS_AB); float* gb = (float*)(F.ws + WS_G); float* bb = (float*)(F.ws + WS_BETA);
    constexpr int RUN = MT / (256 * NWAVES);
    static_assert(RUN * 256 * NWAVES == MT, "conv runs");
    for (int run = F.gw; run < MT / RUN; run += F.NGW) {
        const int t0 = run * RUN;
        v4u W[5][3];
#pragma unroll
        for (int k = 0; k < 5; ++k) { const int g = t0 + k - 2, gc = g < 0 ? 0 : (g >= MT ? MT - 1 : g);
#pragma unroll
            for (int q = 0; q < 3; ++q) W[k][q] = *(const v4u*)(qkvz + (size_t)gc * 2048 + q * 512 + 8 * F.lane); }
#pragma unroll 1
        for (int t = t0; t < t0 + RUN; ++t) {
            v4u N[3];
            { const int g = t + 3, gc = g >= MT ? MT - 1 : g;
#pragma unroll
              for (int q = 0; q < 3; ++q) N[q] = *(const v4u*)(qkvz + (size_t)gc * 2048 + q * 512 + 8 * F.lane); }
            const int sid = seq_id(t);
            float a[3][8];
#pragma unroll
            for (int q = 0; q < 3; ++q)
#pragma unroll
                for (int i = 0; i < 8; ++i) a[q][i] = 0.f;
#pragma unroll
            for (int tap = 0; tap < 5; ++tap) { const float vm = (seq_id(t + tap - 2) == sid) ? 1.0f : 0.0f;
#pragma unroll
                for (int q = 0; q < 3; ++q) { const v4u u = W[tap][q];
                    const LAS f32x4* wp = (const LAS f32x4*)(cw + tap * 1536 + q * 512 + 8 * F.lane); const f32x4 w0 = wp[0] * vm, w1 = wp[1] * vm;
                    a[q][0] += bflo(u.x) * w0.x; a[q][1] += bfhi(u.x) * w0.y; a[q][2] += bflo(u.y) * w0.z; a[q][3] += bfhi(u.y) * w0.w;
                    a[q][4] += bflo(u.z) * w1.x; a[q][5] += bfhi(u.z) * w1.y; a[q][6] += bflo(u.w) * w1.z; a[q][7] += bfhi(u.w) * w1.w; } }
#pragma unroll
            for (int q = 0; q < 3; ++q) { float ss = 0.f;
#pragma unroll
                for (int i = 0; i < 8; ++i) { a[q][i] = silu_f(a[q][i]); ss += a[q][i] * a[q][i]; }
                float sc = 1.0f;
                if (q < 2) { ss = sum16(ss); sc = (1.0f / sqrtf(ss + EPS)) * (q == 0 ? 0.08838834764831845f : 1.0f); }
                v4u o; o.x = pk2(a[q][0] * sc, a[q][1] * sc); o.y = pk2(a[q][2] * sc, a[q][3] * sc); o.z = pk2(a[q][4] * sc, a[q][5] * sc); o.w = pk2(a[q][6] * sc, a[q][7] * sc);
                *(v4u*)(qkvn + (size_t)t * 1536 + q * 512 + 8 * F.lane) = o; }
            if (F.lane < 8) { const int d = F.lane >> 2, h = F.lane & 3;
                const float xg = ab[(size_t)t * 16 + d * 8 + h] + A->in[I_DTB][l * 8 + d * 4 + h];
                const float sp = xg > 20.f ? xg : log1pf(expf(xg));
                gb[(size_t)t * 8 + F.lane] = -expf(A->in[I_ALOG][l * 8 + d * 4 + h]) * sp;
                bb[(size_t)t * 8 + F.lane] = 1.0f / (1.0f + expf(-ab[(size_t)t * 16 + d * 8 + 4 + h])); }
#pragma unroll
            for (int q = 0; q < 3; ++q) { W[0][q] = W[1][q]; W[1][q] = W[2][q]; W[2][q] = W[3][q]; W[3][q] = W[4][q]; W[4][q] = N[q]; }
        }
    }
}

__device__ __forceinline__ void fold_phase(const Frame& F) {
    const bf16* ztl = (const bf16*)(F.ws + WS_ZTL); bf16* eo = (bf16*)(F.ws + WS_EO); float* zn = (float*)(F.ws + WS_ZN);
    const int lam = F.lane;
    for (int row = F.gw; row < 8 * 512; row += F.NGW) {
        const int b = row >> 9, c = row & 511;
        const bf16* zr = ztl + (size_t)row * 8192; const bf16* zi = zr + 4096;
        v4u lo_r[4], hi_r[4], lo_i[4], hi_i[4];
#pragma unroll
        for (int q = 0; q < 4; ++q) { lo_r[q] = *(const v4u*)(zr + 32 * lam + 8 * q); hi_r[q] = *(const v4u*)(zr + 4064 - 32 * lam + 8 * q);
                                      lo_i[q] = *(const v4u*)(zi + 32 * lam + 8 * q); hi_i[q] = *(const v4u*)(zi + 4064 - 32 * lam + 8 * q); }
        float Lr[32], Hr[32], Li[32], Hi[32];
#pragma unroll
        for (int q = 0; q < 4; ++q)
#pragma unroll
            for (int e = 0; e < 4; ++e) { Lr[8 * q + 2 * e] = bflo(lo_r[q][e]); Lr[8 * q + 2 * e + 1] = bfhi(lo_r[q][e]); Hr[8 * q + 2 * e] = bflo(hi_r[q][e]); Hr[8 * q + 2 * e + 1] = bfhi(hi_r[q][e]);
                                          Li[8 * q + 2 * e] = bflo(lo_i[q][e]); Li[8 * q + 2 * e + 1] = bfhi(lo_i[q][e]); Hi[8 * q + 2 * e] = bflo(hi_i[q][e]); Hi[8 * q + 2 * e + 1] = bfhi(hi_i[q][e]); }
        float mr = __shfl_up(Hr[0], 1), mi = __shfl_up(Hi[0], 1); if (lam == 0) { mr = 0.f; mi = 0.f; }
        float E[32], O[32]; float ny = 0.f;
        E[0] = Lr[0] + mr; O[0] = lam == 0 ? 0.f : Li[0] - mi;
#pragma unroll
        for (int j = 1; j < 32; ++j) { E[j] = Lr[j] + Hr[32 - j]; O[j] = Li[j] - Hi[32 - j]; }
#pragma unroll
        for (int j = 0; j < 32; ++j) ny += (j & 1) ? -(Lr[j] + Hr[j]) : (Lr[j] + Hr[j]);
        ny = wave_sum(ny);
        bf16* ep = eo + ((size_t)(b * 2) * 512 + c) * 2048 + 32 * lam; bf16* op = ep + (size_t)512 * 2048;
#pragma unroll
        for (int q = 0; q < 4; ++q) { v4u e4, o4;
            e4.x = pk2(E[8 * q], E[8 * q + 1]); e4.y = pk2(E[8 * q + 2], E[8 * q + 3]); e4.z = pk2(E[8 * q + 4], E[8 * q + 5]); e4.w = pk2(E[8 * q + 6], E[8 * q + 7]);
            o4.x = pk2(O[8 * q], O[8 * q + 1]); o4.y = pk2(O[8 * q + 2], O[8 * q + 3]); o4.z = pk2(O[8 * q + 4], O[8 * q + 5]); o4.w = pk2(O[8 * q + 6], O[8 * q + 7]);
            *(v4u*)(ep + 8 * q) = e4; *(v4u*)(op + 8 * q) = o4; }
        if (lam == 63) zn[row] = Hr[0];
        if (lam == 0) zn[4096 + row] = ny;
    }
}

__device__ __forceinline__ void ctx_dft(const Frame& F) {
    LAS float* cs = (LAS float*)F.lds;
    LAS float* sn = cs + 256;
    LAS float* Z = sn + 256;
    const bf16* ztc = (const bf16*)(F.ws + WS_ZTC); bf16* mix = (bf16*)(F.ws + WS_ACT);
    const float scale = 1.0f / sqrtf(256.0f * 128.0f);
    __syncthreads();
    if (F.tid < 256) { cs[F.tid] = cospif((float)F.tid * (1.0f / 128.0f)); sn[F.tid] = sinpif((float)F.tid * (1.0f / 128.0f)); }
    for (int item = F.vcu - 128; item < 256; item += 128) {
        const int b = item >> 5, cg = item & 31;
        __syncthreads();
        for (int i = F.tid; i < 16 * 256; i += NTHR) { const int c = i >> 8, l2 = (i & 255) * 2; const unsigned w = *(const unsigned*)(ztc + ((size_t)b * 512 + cg * 16 + c) * 512 + l2);
            Z[c * 516 + l2] = bflo(w); Z[c * 516 + l2 + 1] = bfhi(w); }
        __syncthreads();
        const int c = F.tid & 15, lp0 = F.tid >> 4;
        float acc[8];
#pragma unroll
        for (int k = 0; k < 8; ++k) acc[k] = 0.f;
#pragma unroll 2
        for (int l = 0; l < 256; ++l) { const float zr = Z[c * 516 + l], zi = Z[c * 516 + 256 + l];
#pragma unroll
            for (int k = 0; k < 8; ++k) { const int idx = (l * (lp0 + 32 * k)) & 255; acc[k] += zr * cs[idx] + zi * sn[idx]; } }
#pragma unroll
        for (int k = 0; k < 8; ++k) mix[(size_t)(NLAT + b * 256 + lp0 + 32 * k) * D + cg * 16 + c] = (bf16)f2bf(acc[k] * scale);
    }
    __syncthreads();
}

__device__ __forceinline__ void scan_naive(const Frame& F, int l) {
    LAS float* kL = (LAS float*)F.lds;
    LAS float* qL = kL + 64 * 128;
    LAS float* vL = qL + 64 * 128;
    LAS float* oL = vL + 64 * 32;
    LAS float* gL = oL + 64 * 32;
    LAS float* bL = gL + 64;
    const bf16* qkvn = (const bf16*)(F.ws + WS_QKVN);
    const float* gb = (const float*)(F.ws + WS_G); const float* bb = (const float*)(F.ws + WS_BETA);
    for (int unit = F.vcu; unit < 256; unit += F.G) {
        const int qd = unit & 3, s = unit >> 2, d = s & 1, h = (s >> 1) & 3, b = s >> 3;
        bf16* od = (bf16*)(F.ws + (d ? WS_OB : WS_OF));
        const int j = F.tid >> 4, rg = F.tid & 15;
        float S[8];
#pragma unroll
        for (int i = 0; i < 8; ++i) S[i] = 0.f;
#pragma unroll 1
        for (int ci = 0; ci < 68; ++ci) {
            int rowbase; const bool isctx = ci < 4;
            if (isctx) rowbase = NLAT + b * 256 + (d ? 3 - ci : ci) * 64; else { const int lc = ci - 4; rowbase = b * SEQ + (d ? 63 - lc : lc) * 64; }
            __syncthreads();
            for (int i = F.tid; i < 64 * 16; i += NTHR) { const int r = i >> 4, g8 = i & 15; const bf16* rp = qkvn + (size_t)(rowbase + r) * 1536 + h * 128 + g8 * 8;
                const v4u q = *(const v4u*)rp, k = *(const v4u*)(rp + 512);
                LAS float* qo = qL + r * 128 + g8 * 8; LAS float* ko = kL + r * 128 + g8 * 8;
                qo[0] = bflo(q.x); qo[1] = bfhi(q.x); qo[2] = bflo(q.y); qo[3] = bfhi(q.y); qo[4] = bflo(q.z); qo[5] = bfhi(q.z); qo[6] = bflo(q.w); qo[7] = bfhi(q.w);
                ko[0] = bflo(k.x); ko[1] = bfhi(k.x); ko[2] = bflo(k.y); ko[3] = bfhi(k.y); ko[4] = bflo(k.z); ko[5] = bfhi(k.z); ko[6] = bflo(k.w); ko[7] = bfhi(k.w); }
            if (F.tid < 256) { const int r = F.tid >> 2, g8 = F.tid & 3; const v4u v = *(const v4u*)(qkvn + (size_t)(rowbase + r) * 1536 + 1024 + h * 128 + qd * 32 + g8 * 8);
                LAS float* vo = vL + r * 32 + g8 * 8;
                vo[0] = bflo(v.x); vo[1] = bfhi(v.x); vo[2] = bflo(v.y); vo[3] = bfhi(v.y); vo[4] = bflo(v.z); vo[5] = bfhi(v.z); vo[6] = bflo(v.w); vo[7] = bfhi(v.w); }
            else if (F.tid < 320) { const int r = F.tid - 256; gL[r] = __expf(gb[(size_t)(rowbase + r) * 8 + d * 4 + h]); bL[r] = bb[(size_t)(rowbase + r) * 8 + d * 4 + h]; }
            __syncthreads();
#pragma unroll 2
            for (int st = 0; st < 64; ++st) {
                const int r = d ? 63 - st : st;
                const float alpha = gL[r], bt = bL[r];
                const f32x4 k0 = *(const LAS f32x4*)(kL + r * 128 + rg * 8), k1 = *(const LAS f32x4*)(kL + r * 128 + rg * 8 + 4);
                const f32x4 q0 = *(const LAS f32x4*)(qL + r * 128 + rg * 8), q1 = *(const LAS f32x4*)(qL + r * 128 + rg * 8 + 4);
                float part = (k0.x * S[0] + k0.y * S[1]) + (k0.z * S[2] + k0.w * S[3]) + (k1.x * S[4] + k1.y * S[5]) + (k1.z * S[6] + k1.w * S[7]);
                part = sum16(part);
                const float dl = bt * (vL[r * 32 + j] - alpha * part);
                S[0] = alpha * S[0] + k0.x * dl; S[1] = alpha * S[1] + k0.y * dl; S[2] = alpha * S[2] + k0.z * dl; S[3] = alpha * S[3] + k0.w * dl;
                S[4] = alpha * S[4] + k1.x * dl; S[5] = alpha * S[5] + k1.y * dl; S[6] = alpha * S[6] + k1.z * dl; S[7] = alpha * S[7] + k1.w * dl;
                float op = (q0.x * S[0] + q0.y * S[1]) + (q0.z * S[2] + q0.w * S[3]) + (q1.x * S[4] + q1.y * S[5]) + (q1.z * S[6] + q1.w * S[7]);
                op = sum16(op);
                if (rg == 0) oL[r * 32 + j] = op;
            }
            __syncthreads();
            if (!(isctx && l == NL - 1)) { const int r = F.tid >> 3, g4 = F.tid & 7; const LAS float* op = oL + r * 32 + g4 * 4;
                v2u w; w.x = pk2(op[0], op[1]); w.y = pk2(op[2], op[3]);
                *(v2u*)(od + (size_t)(rowbase + r) * 512 + h * 128 + qd * 32 + g4 * 4) = w; }
        }
        __syncthreads();
    }
}

__device__ __forceinline__ void gated_out(const Frame& F, int l) {
    const KArgsP A = kargs();
    const bf16* of = (const bf16*)(F.ws + WS_OF); const bf16* ob = (const bf16*)(F.ws + WS_OB); const bf16* qkvz = (const bf16*)(F.ws + WS_QKVZ);
    const bf16* ab2 = (const bf16*)(F.ws + WS_AB2); const float* zn = (const float*)(F.ws + WS_ZN);
    bf16* mix = (bf16*)(F.ws + WS_ACT);
    const int nrows = l == NL - 1 ? NLAT : MT;
    const float fsc = 1.0f / sqrtf(4096.0f * 128.0f);
    const f32x4 g0 = *(const f32x4*)(A->in[I_GOUT] + l * 128 + (F.lane & 15) * 8), g1 = *(const f32x4*)(A->in[I_GOUT] + l * 128 + (F.lane & 15) * 8 + 4);
    for (int t = F.gw; t < nrows; t += F.NGW) {
        const v4u a = *(const v4u*)(of + (size_t)t * 512 + 8 * F.lane), b = *(const v4u*)(ob + (size_t)t * 512 + 8 * F.lane), z = *(const v4u*)(qkvz + (size_t)t * 2048 + 1536 + 8 * F.lane);
        if (t < NLAT) {
            const int bb_ = t >> 12, lp = t & 4095, k = lp <= 2048 ? lp : 4096 - lp;
            float y[8];
            if (k == 2048) { const f32x4 n0 = *(const f32x4*)(zn + 4096 + bb_ * 512 + 8 * F.lane), n1 = *(const f32x4*)(zn + 4096 + bb_ * 512 + 8 * F.lane + 4);
                y[0] = n0.x; y[1] = n0.y; y[2] = n0.z; y[3] = n0.w; y[4] = n1.x; y[5] = n1.y; y[6] = n1.z; y[7] = n1.w; }
            else { const v4u pa = *(const v4u*)(ab2 + ((size_t)(bb_ * 2) * 2048 + k) * 512 + 8 * F.lane), pb_ = *(const v4u*)(ab2 + ((size_t)(bb_ * 2 + 1) * 2048 + k) * 512 + 8 * F.lane);
                const f32x4 z0 = *(const f32x4*)(zn + bb_ * 512 + 8 * F.lane), z1 = *(const f32x4*)(zn + bb_ * 512 + 8 * F.lane + 4);
                const float sg = lp <= 2048 ? 1.0f : -1.0f, sz = (k & 1) ? -1.0f : 1.0f;
                y[0] = bflo(pa.x) + sg * bflo(pb_.x) + sz * z0.x; y[1] = bfhi(pa.x) + sg * bfhi(pb_.x) + sz * z0.y; y[2] = bflo(pa.y) + sg * bflo(pb_.y) + sz * z0.z; y[3] = bfhi(pa.y) + sg * bfhi(pb_.y) + sz * z0.w;
                y[4] = bflo(pa.z) + sg * bflo(pb_.z) + sz * z1.x; y[5] = bfhi(pa.z) + sg * bfhi(pb_.z) + sz * z1.y; y[6] = bflo(pa.w) + sg * bflo(pb_.w) + sz * z1.z; y[7] = bfhi(pa.w) + sg * bfhi(pb_.w) + sz * z1.w; }
            v4u wy; wy.x = pk2(y[0] * fsc, y[1] * fsc); wy.y = pk2(y[2] * fsc, y[3] * fsc); wy.z = pk2(y[4] * fsc, y[5] * fsc); wy.w = pk2(y[6] * fsc, y[7] * fsc);
            *(v4u*)(mix + (size_t)t * D + 8 * F.lane) = wy;
        }
        float o[8] = {bflo(a.x) + bflo(b.x), bfhi(a.x) + bfhi(b.x), bflo(a.y) + bflo(b.y), bfhi(a.y) + bfhi(b.y), bflo(a.z) + bflo(b.z), bfhi(a.z) + bfhi(b.z), bflo(a.w) + bflo(b.w), bfhi(a.w) + bfhi(b.w)};
        const float zz[8] = {bflo(z.x), bfhi(z.x), bflo(z.y), bfhi(z.y), bflo(z.z), bfhi(z.z), bflo(z.w), bfhi(z.w)};
        const float gg[8] = {g0.x, g0.y, g0.z, g0.w, g1.x, g1.y, g1.z, g1.w};
        float ss = 0.f;
#pragma unroll
        for (int i = 0; i < 8; ++i) ss += o[i] * o[i];
        const float rs = 1.0f / sqrtf(sum16(ss) * (1.0f / 128.0f) + EPS);
#pragma unroll
        for (int i = 0; i < 8; ++i) o[i] = o[i] * rs * gg[i] * silu_f(zz[i]);
        v4u w; w.x = pk2(o[0], o[1]); w.y = pk2(o[2], o[3]); w.z = pk2(o[4], o[5]); w.w = pk2(o[6], o[7]);
        *(v4u*)(mix + (size_t)t * D + 512 + 8 * F.lane) = w;
    }
}

__device__ __forceinline__ void router_phase(const Frame& F, int l, int bank = 0) {
    const KArgsP A = kargs();
    LAS float* wr = (LAS float*)F.lds;
    LAS int* lcnt = (LAS int*)(F.lds + XT_OFF);
    LAS int* lbase = lcnt + 32;
    LAS int* sE = lbase + 32;
    LAS int* sP = sE + 136 * 4;
    LAS float* sG = (LAS float*)(sP + 136 * 4);
    const int nrows = l == NL - 1 ? NLAT : MT, rpb = nrows / 256;
    { const f32x4* src = (const f32x4*)((const float*)(F.ws + WS_WRT) + (size_t)l * NEXP * D);
      for (int i = F.tid; i < NEXP * D / 4; i += NTHR) ((LAS f32x4*)wr)[i] = src[i];
      if (F.tid < 32) lcnt[F.tid] = 0; }
    __syncthreads();
    bf16* h2 = (bf16*)(F.ws + WS_ACT);
    const int row0 = F.vcu * rpb;
    if (F.vcu < 256) {
    for (int rl = F.wave; rl < rpb; rl += NWAVES) {
        const int t = row0 + rl, r = mod_row(t);
        const float* xr = xr_row(F, t);
        f32x4 v[4]; float ss = 0.f;
#pragma unroll
        for (int j = 0; j < 4; ++j) { v[j] = *((const f32x4*)xr + F.lane + 64 * j); ss += (v[j].x * v[j].x + v[j].y * v[j].y) + (v[j].z * v[j].z + v[j].w * v[j].w); }
        const float rstd = 1.0f / sqrtf(wave_sum(ss) * (1.0f / D) + EPS);
        const f32x4* g2 = (const f32x4*)(A->in[I_GN2] + (size_t)l * D) + F.lane;
        const f32x4* sh = (const f32x4*)modv(F, l, r, 3) + F.lane; const f32x4* scl = (const f32x4*)modv(F, l, r, 4) + F.lane;
        v2u* ho = (v2u*)(h2 + (size_t)t * D) + F.lane;
#pragma unroll
        for (int j = 0; j < 4; ++j) { v[j] = v[j] * rstd * g2[64 * j] * (scl[64 * j] + 1.0f) + sh[64 * j]; v2u w; w.x = pk2(v[j].x, v[j].y); w.y = pk2(v[j].z, v[j].w); ho[64 * j] = w; }
        float pe[32];
        int lofs = F.lane; asm volatile("" : "+v"(lofs));
#pragma unroll
        for (int e = 0; e < NEXP; ++e) { float p = 0.f;
#pragma unroll
            for (int j = 0; j < 4; ++j) { const f32x4 w = ((const LAS f32x4*)(wr + e * D))[lofs + 64 * j]; p += (v[j].x * w.x + v[j].y * w.y) + (v[j].z * w.z + v[j].w * w.w); }
            pe[e] = p; if ((e & 3) == 3) asm volatile("" ::: "memory"); }
        float lg = rs32(pe, F.lane) + A->in[I_BR][l * NEXP + (F.lane >> 1)];
        if (F.lane & 1) lg = -3.0e38f;
        int se[4]; float sv[4];
#pragma unroll
        for (int k = 0; k < 4; ++k) { float m = lg;
#pragma unroll
            for (int o = 1; o < 64; o <<= 1) m = fmaxf(m, __shfl_xor(m, o));
            const unsigned long long bal = __ballot(lg == m); const int idx = __ffsll((long long)bal) - 1;
            se[k] = idx >> 1; sv[k] = m; if (F.lane == idx) lg = -3.0e38f; }
        const float e1 = __expf(sv[1] - sv[0]), e2 = __expf(sv[2] - sv[0]), e3 = __expf(sv[3] - sv[0]), inv = 1.0f / (1.0f + e1 + e2 + e3);
        if (F.lane == 0) {
            const float gt[4] = {inv, e1 * inv, e2 * inv, e3 * inv};
#pragma unroll
            for (int k = 0; k < 4; ++k) { sE[rl * 4 + k] = se[k]; sP[rl * 4 + k] = __hip_atomic_fetch_add(lcnt + se[k], 1, __ATOMIC_RELAXED, __HIP_MEMORY_SCOPE_WORKGROUP); sG[rl * 4 + k] = gt[k]; } }
    }
    }
    __syncthreads();
    if (F.tid < 32) { const int n = lcnt[F.tid]; lbase[F.tid] = n ? (int)__hip_atomic_fetch_add(F.ctl + CW_GCNT + ((bank * 2 + l) * 32 + F.tid) * 64, (unsigned)n, RLX_AGENT) : 0; }
    __syncthreads();
    if (F.vcu < 256) {
        int* sele = (int*)(F.ws + WS_SELE); int* selp = (int*)(F.ws + WS_SELP); float* selg = (float*)(F.ws + WS_SELG);
        for (int i = F.tid; i < rpb * 4; i += NTHR) { const int e = sE[i]; sele[(size_t)row0 * 4 + i] = e; selp[(size_t)row0 * 4 + i] = lbase[e] + sP[i]; selg[(size_t)row0 * 4 + i] = sG[i]; }
    }
}
__device__ __forceinline__ void moe_layout(const Frame& F, int l, LAS int* pend, LAS int* pstart) {
    __syncthreads();
    if (F.tid == 0) { int acc = 0;
        for (int e = 0; e < NEXP; ++e) { const int n = (int)__hip_atomic_load(F.ctl + CW_GCNT + (l * 32 + e) * 64, RLX_AGENT); pstart[e] = acc * 256; acc += (n + 255) >> 8; pend[e] = acc; } }
    __syncthreads();
}
__device__ __forceinline__ void gather_phase(const Frame& F, int l, bool dummy = false) {
    LAS int* pend = (LAS int*)(F.lds + XT_OFF); LAS int* pstart = pend + 32;
    moe_layout(F, l, pend, pstart);
    const int nrows = l == NL - 1 ? NLAT : MT;
    const int* sele = (const int*)(F.ws + WS_SELE); int* selp = (int*)(F.ws + WS_SELP);
    const bf16* h2 = (const bf16*)(F.ws + WS_ACT); bf16* xs = (bf16*)(F.ws + WS_XS);
    for (int it = F.gw; it < nrows * 4; it += F.NGW) {
        const int t = it >> 2, e = sele[it], dst = pstart[e] + selp[it];
        const v4u* src = (const v4u*)(h2 + (size_t)t * D) + F.lane; v4u* dp = (v4u*)(xs + (size_t)dst * D) + F.lane;
        const v4u a = src[0], b = src[64];
        dp[0] = a; dp[64] = b;
        if (F.lane == 0 && !dummy) selp[it] = dst;
    }
}


constexpr size_t WS_PW = WS_OB + 34 * MiB;
constexpr size_t WS_PKET = WS_PW + 68 * MiB;
constexpr size_t WS_PUT = WS_PKET + 68 * MiB;
constexpr size_t WS_PATT = WS_PUT + 68 * MiB;
constexpr size_t WS_PGAM = WS_PATT + 34 * MiB;
static_assert(WS_PGAM + 6 * MiB <= WS_END, "prep map");
typedef short bf16x8_t __attribute__((ext_vector_type(8)));
#define MFMA16(a, b, c) __builtin_amdgcn_mfma_f32_16x16x32_bf16((a), (b), (c), 0, 0, 0)
__device__ __forceinline__ v2u pack4(const f32x4 v) { v2u w; w.x = pk2(v.x, v.y); w.y = pk2(v.z, v.w); return w; }
__device__ __forceinline__ int chunk_rowbase(int b, int cn) { return cn < 4 ? NLAT + b * CTXL + cn * 64 : b * SEQ + (cn - 4) * 64; }

__device__ __forceinline__ void prep_phase(const Frame& F) {
    LAS bf16* k_rm = (LAS bf16*)F.lds;
    LAS bf16* q_rm = k_rm + 64 * 136;
    LAS bf16* kT = (LAS bf16*)(F.lds + 36864);
    LAS bf16* vT = kT + 128 * 72;
    LAS float* Gm = (LAS float*)(F.lds + 36864 + 36864);
    LAS float* A0 = Gm + 64 * 72;
    LAS float* bs = (LAS float*)(F.lds + 36864 + 36864 + 36864);
    LAS float* gam = bs + 128;
    const bf16* qkvn = (const bf16*)(F.ws + WS_QKVN);
    const float* gb = (const float*)(F.ws + WS_G); const float* bb = (const float*)(F.ws + WS_BETA);
    const int w = F.wave;
    v4u ld[2][3];
    {
        int tid_ = F.tid; asm volatile("" : "+v"(tid_));
        const int unit = F.vcu;
        if (unit < 32 * 68) { const int bh = unit / 68, cn = unit % 68, rowbase = chunk_rowbase(bh >> 2, cn);
#pragma unroll
            for (int it = 0; it < 2; ++it) { const int p = tid_ + it * NTHR, i = p & 63, c8 = p >> 6; const bf16* rp = qkvn + (size_t)(rowbase + i) * 1536 + (bh & 3) * 128 + c8 * 8;
                ld[it][0] = *(const v4u*)rp; ld[it][1] = *(const v4u*)(rp + 512); ld[it][2] = *(const v4u*)(rp + 1024); } }
    }
    for (int unit = F.vcu; unit < 32 * 68; unit += F.G) {
        int tid_ = F.tid; asm volatile("" : "+v"(tid_));
        const int tid = tid_, lane = tid & 63, l15 = lane & 15, l4 = lane >> 4;
        const int bh = unit / 68, cn = unit % 68, b = bh >> 2, h = bh & 3, rowbase = chunk_rowbase(b, cn);
        const size_t pu = (size_t)(bh * 68 + cn) * 2;
        __syncthreads();
#pragma unroll
        for (int it = 0; it < 2; ++it) { const int p = tid + it * NTHR, i = p & 63, c8 = p >> 6;
            const v4u qv = ld[it][0], kv = ld[it][1], vv = ld[it][2];
            *(LAS v4u*)(q_rm + i * 136 + c8 * 8) = qv; *(LAS v4u*)(k_rm + i * 136 + c8 * 8) = kv;
#pragma unroll
            for (int e = 0; e < 4; ++e) { const unsigned kw = kv[e], vw = vv[e];
                kT[(c8 * 8 + 2 * e) * 72 + i] = (bf16)(kw & 0xffffu); kT[(c8 * 8 + 2 * e + 1) * 72 + i] = (bf16)(kw >> 16);
                vT[(c8 * 8 + 2 * e) * 72 + i] = (bf16)(vw & 0xffffu); vT[(c8 * 8 + 2 * e + 1) * 72 + i] = (bf16)(vw >> 16); } }
        if (w < 2) { const int d = w; float g = gb[(size_t)(rowbase + lane) * 8 + d * 4 + h]; bs[d * 64 + lane] = bb[(size_t)(rowbase + lane) * 8 + d * 4 + h];
            if (d == 0) {
#pragma unroll
                for (int o = 1; o < 64; o <<= 1) { const float t = __shfl_up(g, o); if (lane >= o) g += t; } }
            else {
#pragma unroll
                for (int o = 1; o < 64; o <<= 1) { const float t = __shfl_down(g, o); if (lane + o < 64) g += t; } }
            gam[d * 64 + lane] = g; }
        {
            const int un = unit + F.G;
            if (un < 32 * 68) { const int bh2 = un / 68, cn2 = un % 68, rb2 = chunk_rowbase(bh2 >> 2, cn2);
#pragma unroll
                for (int it = 0; it < 2; ++it) { const int p = tid + it * NTHR, i = p & 63, c8 = p >> 6; const bf16* rp = qkvn + (size_t)(rb2 + i) * 1536 + (bh2 & 3) * 128 + c8 * 8;
                    ld[it][0] = *(const v4u*)rp; ld[it][1] = *(const v4u*)(rp + 512); ld[it][2] = *(const v4u*)(rp + 1024); } }
        }
        __syncthreads();
#pragma unroll
        for (int tt = 0; tt < 2; ++tt) { const int idx = 2 * w + tt, ti = idx >> 2, tj = idx & 3;
            f32x4 aG = {0.f, 0.f, 0.f, 0.f}, aA = {0.f, 0.f, 0.f, 0.f};
#pragma unroll
            for (int ks = 0; ks < 4; ++ks) { const int co = 32 * ks + 8 * l4;
                const bf16x8_t bk = *(const LAS bf16x8_t*)(k_rm + (16 * tj + l15) * 136 + co), ak = *(const LAS bf16x8_t*)(k_rm + (16 * ti + l15) * 136 + co), aq = *(const LAS bf16x8_t*)(q_rm + (16 * ti + l15) * 136 + co);
                aG = MFMA16(ak, bk, aG); aA = MFMA16(aq, bk, aA); }
#pragma unroll
            for (int r = 0; r < 4; ++r) { Gm[(16 * ti + 4 * l4 + r) * 72 + 16 * tj + l15] = aG[r]; A0[(16 * ti + 4 * l4 + r) * 72 + 16 * tj + l15] = aA[r]; } }
        __syncthreads();
        for (int idx = tid; idx < 8192; idx += NTHR) { const int d = idx >> 12, ip = (idx >> 6) & 63, jp = idx & 63, i = d ? 63 - ip : ip, j = d ? 63 - jp : jp;
            ((LAS float*)(F.lds + d * 18432))[idx & 4095] = jp < ip ? bs[d * 64 + i] * Gm[i * 72 + j] * __expf(gam[d * 64 + i] - gam[d * 64 + j]) : 0.f; }
        __syncthreads();
        if (w < 2) {
            const int d = w; const LAS float* Lr = (const LAS float*)(F.lds + d * 18432);
            float t[64];
#pragma unroll
            for (int ip = 0; ip < 64; ++ip) {
                float a0 = (lane == ip) ? 1.f : 0.f, a1 = 0.f;
#pragma unroll
                for (int j4 = 0; j4 < (ip + 3) / 4; ++j4) { const f32x4 Lv = *(const LAS f32x4*)(Lr + ip * 64 + 4 * j4);
                    if (4 * j4 + 0 < ip) a0 -= Lv.x * t[4 * j4 + 0];
                    if (4 * j4 + 1 < ip) a1 -= Lv.y * t[4 * j4 + 1];
                    if (4 * j4 + 2 < ip) a0 -= Lv.z * t[4 * j4 + 2];
                    if (4 * j4 + 3 < ip) a1 -= Lv.w * t[4 * j4 + 3]; }
                t[ip] = a0 + a1; if (ip & 1) asm volatile("" ::: "memory"); }
            const int jn = d ? 63 - lane : lane; const float bj = bs[d * 64 + jn], bge = bj * __expf(gam[d * 64 + jn]);
            asm volatile("s_waitcnt lgkmcnt(0)" ::: "memory");
            LAS bf16* Tu = (LAS bf16*)(F.lds + d * 18432); LAS bf16* Tw = Tu + 64 * 72;
#pragma unroll
            for (int ip = 0; ip < 64; ++ip) { const int in = d ? 63 - ip : ip; Tu[in * 72 + jn] = (bf16)f2bf(t[ip] * bj); Tw[in * 72 + jn] = (bf16)f2bf(t[ip] * bge); }
        } else {
            const int t6 = tid - 128;
            for (int it = t6; it < 1024; it += NTHR - 128) { const int d = it >> 9, i = (it >> 3) & 63, j0 = (it & 7) * 8; float v[8];
#pragma unroll
                for (int e = 0; e < 8; ++e) { const int j = j0 + e; const bool in = d ? (j >= i) : (j <= i); v[e] = in ? A0[i * 72 + j] * __expf(gam[d * 64 + i] - gam[d * 64 + j]) : 0.f; }
                v4u o; o.x = pk2(v[0], v[1]); o.y = pk2(v[2], v[3]); o.z = pk2(v[4], v[5]); o.w = pk2(v[6], v[7]);
                *(v4u*)((bf16*)(F.ws + WS_PATT) + (pu + d) * 4096 + ((((i >> 4) * 2 + (j0 >> 5)) * 16 + (i & 15)) * 32 + (j0 & 31))) = o; }
            for (int it = t6; it < 2048; it += NTHR - 128) { const int d = it >> 10, dk = (it >> 3) & 127, j0 = (it & 7) * 8; const float gl = d ? gam[64] : gam[63]; float v[8];
                const v4u kk = *(const LAS v4u*)(kT + dk * 72 + j0);
                v[0] = bflo(kk.x); v[1] = bfhi(kk.x); v[2] = bflo(kk.y); v[3] = bfhi(kk.y); v[4] = bflo(kk.z); v[5] = bfhi(kk.z); v[6] = bflo(kk.w); v[7] = bfhi(kk.w);
#pragma unroll
                for (int e = 0; e < 8; ++e) v[e] *= __expf(gl - gam[d * 64 + j0 + e]);
                v4u o; o.x = pk2(v[0], v[1]); o.y = pk2(v[2], v[3]); o.z = pk2(v[4], v[5]); o.w = pk2(v[6], v[7]);
                *(v4u*)((bf16*)(F.ws + WS_PKET) + (pu + d) * 8192 + ((((dk >> 4) * 2 + (j0 >> 5)) * 16 + (dk & 15)) * 32 + (j0 & 31))) = o; }
            if (t6 < 128) ((float*)(F.ws + WS_PGAM))[(pu + (t6 >> 6)) * 64 + (t6 & 63)] = gam[t6];
        }
        __syncthreads();
        {
            const int d = w >> 2, ww = w & 3;
            const LAS bf16* Tu = (const LAS bf16*)(F.lds + d * 18432); const LAS bf16* Tw = Tu + 64 * 72;
            bf16x8_t tu[2], tw[2];
#pragma unroll
            for (int ks = 0; ks < 2; ++ks) { tu[ks] = *(const LAS bf16x8_t*)(Tu + (16 * ww + l15) * 72 + 32 * ks + 8 * l4); tw[ks] = *(const LAS bf16x8_t*)(Tw + (16 * ww + l15) * 72 + 32 * ks + 8 * l4); }
            bf16* ut = (bf16*)(F.ws + WS_PUT) + (pu + d) * 8192; bf16* wg = (bf16*)(F.ws + WS_PW) + (pu + d) * 8192;
#pragma unroll 2
            for (int tj = 0; tj < 8; ++tj) {
                f32x4 au = {0.f, 0.f, 0.f, 0.f}, aw = {0.f, 0.f, 0.f, 0.f};
#pragma unroll
                for (int ks = 0; ks < 2; ++ks) { const bf16x8_t bv = *(const LAS bf16x8_t*)(vT + (16 * tj + l15) * 72 + 32 * ks + 8 * l4), ak = *(const LAS bf16x8_t*)(kT + (16 * tj + l15) * 72 + 32 * ks + 8 * l4);
                    au = MFMA16(tu[ks], bv, au); aw = MFMA16(ak, tw[ks], aw); }
                *(v2u*)(ut + (((((tj >> 2) * 16 + l15) * 4 + ww) * 4 + l4) * 4 + (tj & 3)) * 4) = pack4(au);
                *(v2u*)(wg + ((ww * 4 + (tj >> 1)) * 16 + l15) * 32 + 16 * (tj & 1) + 4 * l4) = pack4(aw);
            }
        }
    }
    __syncthreads();
}

struct ScanRegs { bf16x8_t fa[4], fx[2], kf[2]; float graw, glast; int rowbase, cn; };
__device__ __forceinline__ void scan_load(ScanRegs& R, const unsigned char* ws, int ci_in, int b, int bh, int h, int d, int s, int w, int l15, int l4) {
    const int ci = ci_in < 68 ? ci_in : 67, rt = w & 3;
    const int cn = ci < 4 ? (d ? 3 - ci : ci) : 4 + (d ? 67 - ci : ci - 4);
    R.cn = cn; R.rowbase = chunk_rowbase(b, cn);
    const size_t pu = (size_t)(bh * 68 + cn) * 2 + d;
    const float* gmp = (const float*)(ws + WS_PGAM) + pu * 64;
    R.glast = gmp[d ? 0 : 63]; R.graw = gmp[16 * rt + l15];
    const bf16* ket = (const bf16*)(ws + WS_PKET) + pu * 8192 + ((w * 2) * 16 + l15) * 32 + 8 * l4;
    R.kf[0] = *(const bf16x8_t*)ket; R.kf[1] = *(const bf16x8_t*)(ket + 512);
    const bf16* wp = (const bf16*)(ws + WS_PW) + pu * 8192 + ((rt * 4) * 16 + l15) * 32 + 8 * l4;
    const bf16* qp = (const bf16*)(ws + WS_QKVN) + (size_t)(R.rowbase + 16 * rt + l15) * 1536 + h * 128 + 8 * l4;
    const bf16* ap_ = w < 4 ? wp : qp; const int kst = w < 4 ? 512 : 32;
#pragma unroll
    for (int ks = 0; ks < 4; ++ks) R.fa[ks] = *(const bf16x8_t*)(ap_ + kst * ks);
    const bf16* up = (const bf16*)(ws + WS_PUT) + pu * 8192 + ((((s * 16 + l15) * 4 + rt) * 4 + l4) * 16);
    const bf16* ap = (const bf16*)(ws + WS_PATT) + pu * 4096 + ((rt * 2) * 16 + l15) * 32 + 8 * l4;
    const bf16* xp = w < 4 ? up : ap; const int xo = w < 4 ? 8 : 512;
    R.fx[0] = *(const bf16x8_t*)xp; R.fx[1] = *(const bf16x8_t*)(xp + xo);
}
#if defined(PROBE_SCAN) && PROBE_SCAN >= 2
#define SCAN_SYNC(n) do { const unsigned long long t0_ = __builtin_amdgcn_s_memrealtime(); __syncthreads(); if (PROBE_SCAN == 2 || PROBE_SCAN == 2 + (n)) g_pacc += __builtin_amdgcn_s_memrealtime() - t0_; } while (0)
#else
#define SCAN_SYNC(n) __syncthreads()
#endif
__device__ __forceinline__ void scan_step(const ScanRegs& R, f32x4 (&S)[4], LAS bf16* ST, LAS bf16* vnT, LAS bf16* oS, bf16* od, bf16* dump, bool skip_ctx_out, int h, int s, int w, int l15, int l4, int tid, unsigned long long& g_pacc) {
#if defined(PROBE_SCAN) && PROBE_SCAN == 6
    const unsigned long long tp0_ = __builtin_amdgcn_s_memrealtime();
#endif
    const int rt = w & 3;
    const float gend = __expf(R.glast), eg = w < 4 ? 1.0f : __expf(R.graw);
    bf16x8_t fa[4];
#pragma unroll
    for (int ks = 0; ks < 4; ++ks) fa[ks] = R.fa[ks];
#if defined(PROBE_SCAN) && PROBE_SCAN == 5
    const unsigned long long tq0_ = __builtin_amdgcn_s_memrealtime();
#endif
    if (w >= 4) {
#pragma unroll
        for (int ks = 0; ks < 4; ++ks) { const v4u qv = __builtin_bit_cast(v4u, R.fa[ks]); v4u o;
            o.x = pk2(bflo(qv.x) * eg, bfhi(qv.x) * eg); o.y = pk2(bflo(qv.y) * eg, bfhi(qv.y) * eg); o.z = pk2(bflo(qv.z) * eg, bfhi(qv.z) * eg); o.w = pk2(bflo(qv.w) * eg, bfhi(qv.w) * eg);
            fa[ks] = __builtin_bit_cast(bf16x8_t, o); } }
#if defined(PROBE_SCAN) && PROBE_SCAN == 5
    asm volatile("" :: "v"(fa[0]), "v"(fa[1]), "v"(fa[2]), "v"(fa[3])); g_pacc += __builtin_amdgcn_s_memrealtime() - tq0_;
#endif
    f32x4 c[4];
#pragma unroll
    for (int ct = 0; ct < 4; ++ct) { c[ct] = (f32x4){0.f, 0.f, 0.f, 0.f};
#pragma unroll
        for (int ks = 0; ks < 4; ++ks) { const bf16x8_t bq = *(const LAS bf16x8_t*)(ST + (16 * ct + l15) * 136 + 32 * ks + 8 * l4); c[ct] = MFMA16(fa[ks], bq, c[ct]); } }
    {
        const v4u ua = __builtin_bit_cast(v4u, R.fx[0]), ub = __builtin_bit_cast(v4u, R.fx[1]);
        const f32x4 u0 = {bflo(ua.x), bfhi(ua.x), bflo(ua.y), bfhi(ua.y)}, u1 = {bflo(ua.z), bfhi(ua.z), bflo(ua.w), bfhi(ua.w)};
        const f32x4 u2 = {bflo(ub.x), bfhi(ub.x), bflo(ub.y), bfhi(ub.y)}, u3 = {bflo(ub.z), bfhi(ub.z), bflo(ub.w), bfhi(ub.w)};
        LAS bf16* vp = vnT + (w < 4 ? 0 : 64 * 72) + l15 * 72 + 16 * rt + 4 * l4;
        *(LAS v2u*)(vp) = pack4(u0 - c[0]); *(LAS v2u*)(vp + 16 * 72) = pack4(u1 - c[1]); *(LAS v2u*)(vp + 32 * 72) = pack4(u2 - c[2]); *(LAS v2u*)(vp + 48 * 72) = pack4(u3 - c[3]);
    }
#if defined(PROBE_SCAN) && PROBE_SCAN == 6
    asm volatile("s_waitcnt lgkmcnt(0)" ::: "memory"); g_pacc += __builtin_amdgcn_s_memrealtime() - tp0_;
#endif
    SCAN_SYNC(1);
    {
        LAS bf16* op = oS + (w < 4 ? 64 * 72 : 0) + (16 * rt + 4 * l4) * 72 + l15;
#pragma unroll
        for (int ct = 0; ct < 4; ++ct) { const bf16x8_t v0 = *(const LAS bf16x8_t*)(vnT + (16 * ct + l15) * 72 + 8 * l4), v1 = *(const LAS bf16x8_t*)(vnT + (16 * ct + l15) * 72 + 32 + 8 * l4);
            f32x4 o = MFMA16(R.fx[0], v0, c[ct]); o = MFMA16(R.fx[1], v1, o);
#pragma unroll
            for (int r = 0; r < 4; ++r) op[r * 72 + 16 * ct] = (bf16)f2bf(o[r]);
            f32x4 sn = S[ct] * gend; sn = MFMA16(R.kf[0], v0, sn); sn = MFMA16(R.kf[1], v1, sn); S[ct] = sn;
            *(LAS v2u*)(ST + (16 * ct + l15) * 136 + 16 * w + 4 * l4) = pack4(sn); }
    }
    SCAN_SYNC(2);
    {
        const int i = tid >> 3, pc = tid & 7;
        const v4u ov = *(const LAS v4u*)(oS + i * 72 + pc * 8);
        const bool real = !(R.cn < 4 && skip_ctx_out);
        bf16* gp = real ? od + (size_t)(R.rowbase + i) * 512 + h * 128 + 64 * s + pc * 8 : dump + (size_t)i * 64 + pc * 8;
        *(v4u*)gp = ov;
    }
}
__device__ __forceinline__ void scan_mfma(const Frame& F, int l) {
    LAS bf16* ST = (LAS bf16*)F.lds;
    LAS bf16* vnT = ST + 64 * 136;
    LAS bf16* oS = vnT + 2 * 64 * 72;
    const int lane = F.lane, l15 = lane & 15, l4 = lane >> 4, w = F.wave;
    const bool skip_ctx_out = (l == NL - 1);
    if (w >= 4) __builtin_amdgcn_s_setprio(1);
    for (int unit = F.vcu; unit < 128; unit += F.G) {
        const int s = unit & 1, sd = unit >> 1, d = sd & 1, bh = sd >> 1, b = bh >> 2, h = bh & 3;
        bf16* od = (bf16*)(F.ws + (d ? WS_OB : WS_OF)); bf16* dump = (bf16*)(F.ws + WS_PGAM + 1536 * 1024) + (size_t)unit * 16 * 512;
        __syncthreads();
        for (int i = F.tid; i < 64 * 136 / 2; i += NTHR) ((LAS unsigned*)ST)[i] = 0u;
        f32x4 S[4];
#pragma unroll
        for (int ct = 0; ct < 4; ++ct) S[ct] = (f32x4){0.f, 0.f, 0.f, 0.f};
        ScanRegs R0, R1, R2;
        scan_load(R0, F.ws, 0, b, bh, h, d, s, w, l15, l4); scan_load(R1, F.ws, 1, b, bh, h, d, s, w, l15, l4); scan_load(R2, F.ws, 2, b, bh, h, d, s, w, l15, l4);
        __syncthreads();
        unsigned long long pacc = 0ull;
#pragma unroll 1
        for (int ci = 0; ci < 66; ci += 3) {
#if defined(PROBE_SCAN) && PROBE_SCAN == 1
            { const unsigned long long t0 = __builtin_amdgcn_s_memrealtime(); asm volatile("s_waitcnt vmcnt(0)" ::: "memory"); pacc += __builtin_amdgcn_s_memrealtime() - t0; }
#endif
            scan_step(R0, S, ST, vnT, oS, od, dump, skip_ctx_out, h, s, w, l15, l4, F.tid, pacc); scan_load(R0, F.ws, ci + 3, b, bh, h, d, s, w, l15, l4);
            scan_step(R1, S, ST, vnT, oS, od, dump, skip_ctx_out, h, s, w, l15, l4, F.tid, pacc); scan_load(R1, F.ws, ci + 4, b, bh, h, d, s, w, l15, l4);
            scan_step(R2, S, ST, vnT, oS, od, dump, skip_ctx_out, h, s, w, l15, l4, F.tid, pacc); scan_load(R2, F.ws, ci + 5, b, bh, h, d, s, w, l15, l4);
        }
        scan_step(R0, S, ST, vnT, oS, od, dump, skip_ctx_out, h, s, w, l15, l4, F.tid, pacc);
        scan_step(R1, S, ST, vnT, oS, od, dump, skip_ctx_out, h, s, w, l15, l4, F.tid, pacc);
   #ifdef PROBE_SCAN
        if (F.vcu == 0 && F.tid == PROBE_TID) *(unsigned long long*)(F.ws + WS_ZN + 48 * 1024) += pacc;
#endif
    }
    __builtin_amdgcn_s_setprio(0);
}

#ifndef USE_NAIVE_SCAN
#define USE_NAIVE_SCAN 0
#endif
#ifndef REP_MASK
#define REP_MASK 0
#endif
#define REPS(p) for (int _r = 0; _r < 1 + ((REP_MASK >> (p)) & 1); ++_r)
#define LASTREP(p) (_r == ((REP_MASK >> (p)) & 1))
constexpr int PH_PER_LAYER = 11, N_PHASES = 2 + NL * PH_PER_LAYER;
#ifndef PG8_SP2
#define PG8_SP2 true
#endif
#ifndef PG8_ALIGN
#define PG8_ALIGN true
#endif
__device__ __forceinline__ Frame make_frame(int wv) {
    extern __shared__ __attribute__((aligned(16))) unsigned char lds[];
    const KArgsP A = kargs();
    Frame F;
    { unsigned lb = (unsigned)(uintptr_t)(LAS unsigned char*)lds; asm volatile("" : "+s"(lb)); F.lds = (LAS unsigned char*)(uintptr_t)lb; }
    F.MISC = (volatile LAS unsigned*)(F.lds + MISC_OFF);
    { unsigned m1 = ~0u; asm volatile("" : "+s"(m1)); int ln = (int)__builtin_amdgcn_mbcnt_hi(m1, __builtin_amdgcn_mbcnt_lo(m1, 0u)); asm volatile("" : "+v"(ln)); F.lane = ln; }
    { int w_ = wv; asm volatile("" : "+s"(w_)); F.wave = w_; } F.tid = F.wave * 64 + F.lane;
    F.G = gridDim.x; { const int bx = blockIdx.x; F.vcu = (F.G % 8 == 0) ? (bx % 8) * (F.G / 8) + bx / 8 : bx; }
    F.gw = F.vcu * NWAVES + F.wave; F.NGW = F.G * NWAVES;
    F.ws = A->ws; F.ctl = (unsigned*)(A->ws + WS_CTL); F.out = A->out;
    return F;
}
__global__ void __launch_bounds__(NTHR, 2) mk_fwd(Args args) {
    const int wv = __builtin_amdgcn_readfirstlane((int)threadIdx.x >> 6);
    { Frame F = make_frame(wv);
      for (int u = F.tid; u < (LDS_BYTES - LDSCTL_OFF) / 4; u += NTHR) ((LAS unsigned*)(F.lds + LDSCTL_OFF))[u] = 0u;
      __syncthreads(); }
    const int lo = args.ph_lo, hi = args.ph_hi;
#if defined(PROBE_SCAN) || defined(PROBE_ROUTER)
    { Frame Fp = make_frame(wv); if (Fp.vcu == 0 && Fp.tid == 0) *(unsigned long long*)(Fp.ws + WS_ZN + 48 * 1024) = 0ull; }
#endif
#ifdef PROBE_P
    unsigned long long pr_acc = 0ull, pr_t0 = 0ull;
#define PR_BEGIN(p) do { if (((p) < 2 ? (p) : 2 + ((p) - 2) % PH_PER_LAYER) == PROBE_P) pr_t0 = __builtin_amdgcn_s_memrealtime(); } while (0)
#define PR_END(p) do { if (((p) < 2 ? (p) : 2 + ((p) - 2) % PH_PER_LAYER) == PROBE_P) pr_acc += __builtin_amdgcn_s_memrealtime() - pr_t0; } while (0)
#else
#define PR_BEGIN(p) do {} while (0)
#define PR_END(p) do {} while (0)
#endif
    if (hi - lo > 1) { Frame F = make_frame(wv); (void)xcd_barrier_post((unsigned*)(F.ctl + CW_BAR), F.MISC + 8, F.tid); }
#define IN(k) (lo <= (k) && (k) < hi)
#define SEAM(k) do { if (IN(k) && IN((k) + 1)) { Frame Fb = make_frame(wv); XcdBarrier bar; bar.bar = (unsigned*)(Fb.ctl + CW_BAR); bar.x = xb_xcc_id(); bar.st = Fb.MISC + 8; xcd_barrier(bar, Fb.tid); } } while (0)
    PR_BEGIN(0); if (IN(0)) { Frame F = make_frame(wv); REPS(0) { p0_prologue(F); __syncthreads(); } }
    SEAM(0); PR_END(0);
    PR_BEGIN(1); if (IN(1)) { Frame F = make_frame(wv); REPS(1) { row_pass<0>(F, 0, 0); __syncthreads(); } }
    SEAM(1); PR_END(1);
#define LAYER_BODY(l) { \
        const int pb = 2 + l * PH_PER_LAYER; \
        PR_BEGIN(pb + 0); if (IN(pb + 0)) { Frame F = make_frame(wv); \
            SchedIn S{(const bf16*)(F.ws + WS_ACT), (const bf16*)(F.ws + WS_WIN) + (size_t)l * 3072 * D, F.G, (int)blockIdx.x}; \
            EpiIn E{(bf16*)(F.ws + WS_QKVZ), (bf16*)(F.ws + WS_ZTL), (bf16*)(F.ws + WS_ZTC)}; \
            REPS(8) { pg8::gemm_phase<EpiIn, SchedIn, PG8_ALIGN, PG8_SP2>(F.lds, pg8::Gemm{D}, S, E, F.tid); __syncthreads(); } } \
        SEAM(pb + 0); PR_END(pb + 0); \
        PR_BEGIN(pb + 1); if (IN(pb + 1)) { Frame F = make_frame(wv); REPS(2) { conv_phase(F, l); __syncthreads(); } fold_phase(F); } \
        SEAM(pb + 1); PR_END(pb + 1); \
        PR_BEGIN(pb + 2); if (IN(pb + 2)) { \
            { Frame F = make_frame(wv); REPS(3) { prep_phase(F); } } \
        } \
        SEAM(pb + 2); PR_END(pb + 2); \
        PR_BEGIN(pb + 3); if (IN(pb + 3)) { Frame F = make_frame(wv); \
            if (F.vcu < 128) { REPS(4) { scan_mfma(F, l); __syncthreads(); } } \
            else { \
              SchedDft S{(const bf16*)(F.ws + WS_DFTM), (const bf16*)(F.ws + WS_EO), F.vcu - 128}; \
              EpiDft E{(bf16*)(F.ws + WS_AB2)}; \
              REPS(9) { pg8::gemm_phase<EpiDft, SchedDft, PG8_ALIGN, PG8_SP2>(F.lds, pg8::Gemm{2048}, S, E, F.tid); __syncthreads(); } \
              if (l == 0) ctx_dft(F); } \
        } \
        SEAM(pb + 3); PR_END(pb + 3); \
        PR_BEGIN(pb + 4); if (IN(pb + 4)) { Frame F = make_frame(wv); REPS(5) { gated_out(F, l); __syncthreads(); } } \
        SEAM(pb + 4); PR_END(pb + 4); \
        PR_BEGIN(pb + 5); if (IN(pb + 5)) { Frame F = make_frame(wv); \
            SchedOut S{(const bf16*)(F.ws + WS_ACT), (const bf16*)(F.ws + WS_WOUT) + (size_t)l * D * D, l == NL - 1 ? NLAT / 256 : MT / 256, F.G, (int)blockIdx.x}; \
            REPS(10) { EpiOut E{F.out, (float*)(F.ws + WS_XC), modv(F, l, 0, 2), LASTREP(10) ? 1.0f : 0.0f}; \
                pg8::gemm_phase<EpiOut, SchedOut, PG8_ALIGN, PG8_SP2>(F.lds, pg8::Gemm{D}, S, E, F.tid); __syncthreads(); } } \
        SEAM(pb + 5); PR_END(pb + 5); \
        PR_BEGIN(pb + 6); if (IN(pb + 6)) { Frame F = make_frame(wv); REPS(6) { router_phase(F, l, LASTREP(6) ? 0 : 1); __syncthreads(); } } \
        SEAM(pb + 6); PR_END(pb + 6); \
        PR_BEGIN(pb + 7); if (IN(pb + 7)) { Frame F = make_frame(wv); REPS(7) { gather_phase(F, l, !LASTREP(7)); __syncthreads(); } } \
        SEAM(pb + 7); PR_END(pb + 7); \
        PR_BEGIN(pb + 8); if (IN(pb + 8)) { Frame F = make_frame(wv); \
            LAS int* pend = (LAS int*)(F.lds + XT_OFF); moe_layout(F, l, pend, pend + 32); \
            SchedMoe S{(const bf16*)(F.ws + WS_XS), (const bf16*)(F.ws + WS_W1), (size_t)2048 * D * 2, pend, pend[NEXP - 1], 8, F.G, (int)blockIdx.x}; \
            EpiSwiglu E{(bf16*)(F.ws + WS_HS), kargs()->in[I_BG] + (size_t)l * NEXP * D, kargs()->in[I_BU] + (size_t)l * NEXP * D}; \
            REPS(11) { pg8::gemm_phase<EpiSwiglu, SchedMoe, PG8_ALIGN, PG8_SP2>(F.lds, pg8::Gemm{D}, S, E, F.tid); __syncthreads(); } } \
        SEAM(pb + 8); PR_END(pb + 8); \
        PR_BEGIN(pb + 9); if (IN(pb + 9)) { Frame F = make_frame(wv); \
            LAS int* pend = (LAS int*)(F.lds + XT_OFF); moe_layout(F, l, pend, pend + 32); \
            SchedMoe S{(const bf16*)(F.ws + WS_HS), (const bf16*)(F.ws + WS_W2), (size_t)D * D * 2, pend, pend[NEXP - 1], 4, F.G, (int)blockIdx.x}; \
            EpiDown E{(bf16*)(F.ws + WS_XS), kargs()->in[I_BD] + (size_t)l * NEXP * D}; \
            REPS(12) { pg8::gemm_phase<EpiDown, SchedMoe, PG8_ALIGN, PG8_SP2>(F.lds, pg8::Gemm{D}, S, E, F.tid); __syncthreads(); } } \
        SEAM(pb + 9); PR_END(pb + 9); \
        PR_BEGIN(pb + 10); if (IN(pb + 10)) { \
            { Frame F = make_frame(wv); \
              if (l == NL - 1) row_pass<2>(F, l, l); else { REPS(13) { row_pass<1>(F, l, l + 1, !LASTREP(13)); __syncthreads(); } } } \
            if (l != NL - 1) { Frame F = make_frame(wv); __syncthreads(); REPS(14) { convert_experts(F, l + 1); __syncthreads(); } } \
        } \
        if (l + 1 < NL) SEAM(pb + 10); PR_END(pb + 10); \
    }
    LAYER_BODY(0)
    LAYER_BODY(1)
#undef LAYER_BODY
#ifdef PROBE_P
#if defined(PROBE_SCAN) || defined(PROBE_ROUTER)
    { Frame Fp = make_frame(wv); if (Fp.vcu == 0 && Fp.tid == 0) pr_acc = *(unsigned long long*)(Fp.ws + WS_ZN + 48 * 1024); else pr_acc = 0; }
#endif
    if (blockIdx.x == 0 && threadIdx.x == 0) { const unsigned long long t0 = __builtin_amdgcn_s_memrealtime(), want = pr_acc * PROBE_SCALE; while (__builtin_amdgcn_s_memrealtime() - t0 < want) __builtin_amdgcn_s_sleep(8); }
#endif
#undef IN
#undef SEAM
}

extern "C" void kernel_launch(void* const* d_in, const int* in_sizes, int n_in, void* d_out, int out_size, void* d_ws, size_t ws_size, hipStream_t stream) {
    static int grid = 0;
    if (grid == 0) {
        if (n_in != 23 || out_size != NLAT * D || ws_size < WS_END) { fprintf(stderr, "kernel_launch: unexpected shapes (n_in %d, out %d, ws %zu); nothing launched\n", n_in, out_size, ws_size); grid = -1; return; }
        int dev = 0, cus = 0, per_cu = 0;
        if (hipGetDevice(&dev) != hipSuccess || hipDeviceGetAttribute(&cus, hipDeviceAttributeMultiprocessorCount, dev) != hipSuccess) { grid = -1; return; }
        if (hipFuncSetAttribute((const void*)mk_fwd, hipFuncAttributeMaxDynamicSharedMemorySize, LDS_BYTES) != hipSuccess) { fprintf(stderr, "kernel_launch: hipFuncSetAttribute failed\n"); grid = -1; return; }
        if (hipOccupancyMaxActiveBlocksPerMultiprocessor(&per_cu, (const void*)mk_fwd, NTHR, LDS_BYTES) != hipSuccess || per_cu < 1)
            fprintf(stderr, "kernel_launch: note: occupancy query reports %d workgroups per CU\n", per_cu);
        (void)hipGetLastError();
        grid = cus;
        if (grid != 256) { fprintf(stderr, "kernel_launch: built for 256 CUs, found %d; nothing launched\n", grid); grid = -1; return; }
    }
    if (grid < 0) return;
    if (hipMemsetAsync((char*)d_ws + WS_CTL, 0, CTL_ZERO_BYTES, stream) != hipSuccess) { fprintf(stderr, "kernel_launch: hipMemsetAsync failed\n"); return; }
    Args a{};
    for (int i = 0; i < 23; ++i) a.in[i] = (const float*)d_in[i];
    a.out = (float*)d_out; a.ws = (unsigned char*)d_ws;
#if MK_ONE_LAUNCH
    a.ph_lo = 0; a.ph_hi = N_PHASES;
    hipLaunchKernelGGL(mk_fwd, dim3(grid), dim3(NTHR), LDS_BYTES, stream, a);
#else
    for (int p = 0; p < N_PHASES; ++p) { a.ph_lo = p; a.ph_hi = p + 1; hipLaunchKernelGGL(mk_fwd, dim3(grid), dim3(NTHR), LDS_BYTES, stream, a); }
#endif
    const hipError_t le = hipPeekAtLastError();
    if (le != hipSuccess) fprintf(stderr, "kernel_launch: launch failed: %s\n", hipGetErrorName(le));
}
```

```cpp
#define MK_ONE_LAUNCH 1
#include <hip/hip_runtime.h>
#include <cstdio>
#include <cstdint>

#ifndef MK_ONE_LAUNCH
#define MK_ONE_LAUNCH 1
#endif

namespace pg8 {
#define PG8_LAS __attribute__((address_space(3)))
typedef unsigned short bf16_t;
typedef short bf16x8 __attribute__((ext_vector_type(8)));
typedef float f32x4 __attribute__((ext_vector_type(4)));
typedef unsigned u32x4 __attribute__((ext_vector_type(4)));
constexpr int BM = 256, BK = 64, HALF = 128, HTB = HALF * BK * 2  , STAGE_BYTES = 8 * HTB, NXCD = 8, WGM = 8;

__host__ __device__ __forceinline__ int lds_byte(int r, int c) { const int st = (r >> 4) * 2 + (c >> 5), rr = r & 15, cc = c & 31, ob = rr * 64 + cc * 2; return st * 1024 + (ob ^ (((ob >> 9) & 1) << 5)); }
__host__ __device__ __forceinline__ void stage_rc(int b, int& R, int& C) { const int st = b / 1024, sb = b % 1024, swz = sb ^ (((sb >> 9) & 1) << 5); R = (st >> 1) * 16 + swz / 64; C = (st & 1) * 32 + (swz % 64) / 2; }
__host__ __device__ __forceinline__ int perm32(int rho) { const int n = rho >> 4, i = rho & 15; return 8 * (i >> 2) + 4 * n + (i & 3); }

struct Unit { int pm, pn, kind, e; };
struct Gemm { int K; };

__device__ __forceinline__ int xcd_remap(int L, int nwg) { const int q = nwg / NXCD, r = nwg % NXCD, xcd = L % NXCD, off = L / NXCD; return (xcd < r ? xcd * (q + 1) : r * (q + 1) + (xcd - r) * q) + off; }
__device__ __forceinline__ void grp_decode(int wgid, int nM, int nN, int& pm, int& pn) { const int nig = WGM * nN, gid = wgid / nig, fm = gid * WGM, gsz = (nM - fm) < WGM ? (nM - fm) : WGM; pm = fm + ((wgid % nig) % gsz); pn = (wgid % nig) / gsz; }

__device__ __forceinline__ const char* uni_ptr(const char* p) { const unsigned long long v = (unsigned long long)p; const unsigned lo = __builtin_amdgcn_readfirstlane((unsigned)v), hi = __builtin_amdgcn_readfirstlane((unsigned)(v >> 32)); return (const char*)(((unsigned long long)hi << 32) | lo); }
__device__ __forceinline__ unsigned cvt_pk_bf16(float lo, float hi) { unsigned r; asm volatile("v_cvt_pk_bf16_f32 %0, %1, %2" : "=v"(r) : "v"(lo), "v"(hi)); return r; }

template <class Epi, class Sched, bool ALIGN_EPI = false, bool SP2 = false, bool GATHER = false>
__device__ __forceinline__ void gemm_phase(PG8_LAS unsigned char* lds, const Gemm g, const Sched& S, const Epi& E, int tid_in, const unsigned* gtab = nullptr, PG8_LAS unsigned char* gl_tab = nullptr, unsigned glim = 0u) {
    static_assert(!GATHER || SP2, "GATHER is written for the SP2 loop");
    int tid_ = tid_in; asm volatile("" : "+v"(tid_));
    const int tid = tid_, wid = __builtin_amdgcn_readfirstlane(tid >> 6), lane = tid & 63, wr = wid >> 2, wc = wid & 3, fr = lane & 15, fq = lane >> 4;
    const int K = g.K, nt = K / BK;
    unsigned voffA[2], voffB[2];
#pragma unroll
    for (int i = 0; i < 2; ++i) { int R, C; stage_rc(tid * 16 + i * 8192, R, C); const int Rb = Epi::PERM ? ((R & ~31) + perm32(R & 31)) : R;
        voffA[i] = (unsigned)(R * K + C) * 2u; voffB[i] = (unsigned)(Rb * K + C) * 2u; }
    const size_t kstep = (size_t)(BK * 2);
    const size_t hstep = (size_t)HALF * K * 2;
    const size_t tstep = 2 * hstep;
    const unsigned ldsw = (unsigned)wid * 1024u;
    const int aoff = lds_byte(wr * 64 + fr, fq * 8), boff = lds_byte(wc * 32 + fr, fq * 8);
#define PG8_SA(b, h) (((b) * 2 + (h)) * HTB)
#define PG8_SB(b, h) ((4 + (b) * 2 + (h)) * HTB)
#define PG8_STAGE(bufoff, gbase, voff) do { _Pragma("unroll") for (int _i = 0; _i < 2; ++_i) \
        __builtin_amdgcn_global_load_lds((const unsigned*)((const char*)(gbase) + (voff)[_i]), (PG8_LAS unsigned*)(lds + (bufoff) + ldsw + _i * 8192), 16, 0, 0); } while (0)
#define PG8_STAGE_G(bufoff, gbase, G, H) do { _Pragma("unroll") for (int _i = 0; _i < 2; ++_i) \
        __builtin_amdgcn_global_load_lds((const unsigned*)((const char*)(gbase) + (G)[H][_i]), (PG8_LAS unsigned*)(lds + (bufoff) + ldsw + _i * 8192), 16, 0, 0); } while (0)
#define PG8_STAGE_A(bufoff, gbase, G, H) do { if constexpr (GATHER) PG8_STAGE_G(bufoff, gbase, G, H); else PG8_STAGE(bufoff, (gbase) + (H) * hstep, voffA); } while (0)
#define PG8_TAB_ISSUE(u_) __builtin_amdgcn_global_load_lds(gtab + ((size_t)(u_).pm * 512 + tid) * 4, (PG8_LAS unsigned*)(gl_tab + wid * 1024), 16, 0, 0)
#define PG8_TAB_READ(G) do { const u32x4 gv_ = *(const PG8_LAS u32x4*)(gl_tab + tid * 16); G[0][0] = gv_.x < glim ? gv_.x : 0u; G[0][1] = gv_.y < glim ? gv_.y : 0u; G[1][0] = gv_.z < glim ? gv_.z : 0u; G[1][1] = gv_.w < glim ? gv_.w : 0u; } while (0)
#define PG8_LDA(dst, b, h) do { _Pragma("unroll") for (int m = 0; m < 4; ++m) _Pragma("unroll") for (int k = 0; k < 2; ++k) dst[m][k] = *(const PG8_LAS bf16x8*)(lds + PG8_SA(b, h) + aoff + m * 2048 + k * 1024); } while (0)
#define PG8_LDB(dst, b, h) do { _Pragma("unroll") for (int n = 0; n < 2; ++n) _Pragma("unroll") for (int k = 0; k < 2; ++k) dst[n][k] = *(const PG8_LAS bf16x8*)(lds + PG8_SB(b, h) + boff + n * 2048 + k * 1024); } while (0)
#define PG8_MMA(ai, bj, At, Bt) do { __builtin_amdgcn_s_setprio(1); _Pragma("unroll") for (int m = 0; m < 4; ++m) _Pragma("unroll") for (int n = 0; n < 2; ++n) _Pragma("unroll") for (int k = 0; k < 2; ++k) \
        acc[ai][bj][m][n] = __builtin_amdgcn_mfma_f32_16x16x32_bf16(Bt[n][k], At[m][k], acc[ai][bj][m][n], 0, 0, 0); __builtin_amdgcn_s_setprio(0); } while (0)
#define PG8_WAIT_V(n) asm volatile("s_waitcnt vmcnt(" #n ")" ::: "memory")
#define PG8_WAIT_L(n) asm volatile("s_waitcnt lgkmcnt(" #n ")" ::: "memory")
#define PG8_BAR __builtin_amdgcn_s_barrier()
#define PG8_SCHED __builtin_amdgcn_sched_barrier(0)
    Unit cur, nxt; int ui = 0;
    if (!S.next(0, cur)) return;
    f32x4 acc[2][2][4][2];
#pragma unroll
    for (int a = 0; a < 2; ++a)
#pragma unroll
        for (int b = 0; b < 2; ++b)
#pragma unroll
            for (int m = 0; m < 4; ++m)
#pragma unroll
                for (int n = 0; n < 2; ++n) acc[a][b][m][n] = (f32x4){0.f, 0.f, 0.f, 0.f};
    bf16x8 At[4][2], B0[2][2], B1[2][2];
    const char* cA = uni_ptr(S.a_base(cur, tstep)); const char* cB = uni_ptr(S.b_base(cur, tstep));
    S.a_ready(cur);
    unsigned gC[2][2] = {{0u, 0u}, {0u, 0u}}, gN[2][2] = {{0u, 0u}, {0u, 0u}};
    if constexpr (GATHER) { PG8_TAB_ISSUE(cur); asm volatile("s_waitcnt vmcnt(0)" ::: "memory"); __builtin_amdgcn_s_barrier(); asm volatile("" ::: "memory"); PG8_TAB_READ(gC); }
    if constexpr (SP2) {
        PG8_STAGE(PG8_SB(0, 0), cB, voffB); PG8_STAGE(PG8_SB(0, 1), cB + hstep, voffB); PG8_STAGE_A(PG8_SA(0, 0), cA, gC, 0); PG8_STAGE_A(PG8_SA(0, 1), cA, gC, 1);
        if (wr == 1) PG8_BAR;
        PG8_WAIT_V(2); PG8_BAR;
        PG8_STAGE(PG8_SB(1, 0), cB + kstep, voffB); PG8_STAGE_A(PG8_SA(1, 0), cA + kstep, gC, 0); PG8_STAGE(PG8_SB(1, 1), cB + hstep + kstep, voffB);
        PG8_WAIT_V(6); PG8_BAR;
    } else {
        PG8_STAGE(PG8_SB(0, 0), cB, voffB); PG8_STAGE(PG8_SA(0, 0), cA, voffA); PG8_STAGE(PG8_SB(0, 1), cB + hstep, voffB); PG8_STAGE(PG8_SA(0, 1), cA + hstep, voffA);
        if (wr == 1) PG8_BAR;
        PG8_WAIT_V(4); PG8_BAR;
        PG8_STAGE(PG8_SB(1, 0), cB + kstep, voffB); PG8_STAGE(PG8_SA(1, 0), cA + kstep, voffA); PG8_STAGE(PG8_SB(1, 1), cB + hstep + kstep, voffB);
        PG8_WAIT_V(6); PG8_BAR;
    }
    for (;;) {
        const bool has_next = S.next(ui + 1, nxt);
        const char* nA = uni_ptr(has_next ? S.a_base(nxt, tstep) : cA); const char* nB = uni_ptr(has_next ? S.b_base(nxt, tstep) : cB);
        for (int t = 0; t < nt; t += 2) {
            const bool last = (t == nt - 2);
            const char* a1 = cA + (size_t)(t + 1) * kstep;
            const char* a2 = last ? nA : cA + (size_t)(t + 2) * kstep; const char* b2 = last ? nB : cB + (size_t)(t + 2) * kstep;
            const char* a3 = a2 + kstep; const char* b3 = b2 + kstep;
            if (last && has_next) S.a_ready(nxt);
            unsigned g2[2][2] = {{gC[0][0], gC[0][1]}, {gC[1][0], gC[1][1]}};
            if constexpr (GATHER) {
                if (t == nt - 4 && has_next) PG8_TAB_ISSUE(nxt);
                if (last && has_next) { PG8_TAB_READ(gN); g2[0][0] = gN[0][0]; g2[0][1] = gN[0][1]; g2[1][0] = gN[1][0]; g2[1][1] = gN[1][1]; }
            }
            if constexpr (SP2) {
            PG8_LDB(B0, 0, 0); PG8_LDB(B1, 0, 1); PG8_SCHED; PG8_LDA(At, 0, 0); PG8_STAGE_A(PG8_SA(1, 1), a1, gC, 1);
            PG8_WAIT_V(8); PG8_WAIT_L(0); PG8_BAR; PG8_MMA(0, 0, At, B0); PG8_MMA(0, 1, At, B1); PG8_BAR; PG8_SCHED;
            PG8_LDA(At, 0, 1); PG8_STAGE(PG8_SB(0, 0), b2, voffB); PG8_STAGE(PG8_SB(0, 1), b2 + hstep, voffB); PG8_STAGE_A(PG8_SA(0, 0), a2, g2, 0);
            PG8_WAIT_V(8); PG8_WAIT_L(0); PG8_BAR; PG8_MMA(1, 0, At, B0); PG8_MMA(1, 1, At, B1); PG8_BAR; PG8_SCHED;
            PG8_LDB(B0, 1, 0); PG8_LDB(B1, 1, 1); PG8_SCHED; PG8_LDA(At, 1, 0); PG8_STAGE_A(PG8_SA(0, 1), a2, g2, 1);
            PG8_WAIT_V(8); PG8_WAIT_L(0); PG8_BAR; PG8_MMA(0, 0, At, B0); PG8_MMA(0, 1, At, B1); PG8_BAR; PG8_SCHED;
            PG8_LDA(At, 1, 1); PG8_STAGE(PG8_SB(1, 0), b3, voffB); PG8_STAGE(PG8_SB(1, 1), b3 + hstep, voffB); PG8_STAGE_A(PG8_SA(1, 0), a3, g2, 0);
            PG8_WAIT_V(8); PG8_WAIT_L(0); PG8_BAR; PG8_MMA(1, 0, At, B0); PG8_MMA(1, 1, At, B1); PG8_BAR; PG8_SCHED;
            } else {
            PG8_LDB(B0, 0, 0); PG8_SCHED; PG8_LDA(At, 0, 0); PG8_STAGE(PG8_SA(1, 1), a1 + hstep, voffA);
            PG8_WAIT_L(8); PG8_BAR; PG8_WAIT_L(0); PG8_MMA(0, 0, At, B0); PG8_BAR; PG8_SCHED;
            PG8_LDB(B1, 0, 1); PG8_STAGE(PG8_SB(0, 0), b2, voffB);
            PG8_BAR; PG8_WAIT_L(0); PG8_MMA(0, 1, At, B1); PG8_BAR;
            PG8_LDA(At, 0, 1); PG8_STAGE(PG8_SA(0, 0), a2, voffA);
            PG8_BAR; PG8_WAIT_L(0); PG8_MMA(1, 0, At, B0); PG8_BAR; PG8_SCHED;
            PG8_STAGE(PG8_SB(0, 1), b2 + hstep, voffB);
            PG8_WAIT_V(6); PG8_BAR; PG8_MMA(1, 1, At, B1); PG8_BAR;
            PG8_LDB(B0, 1, 0); PG8_SCHED; PG8_LDA(At, 1, 0); PG8_STAGE(PG8_SA(0, 1), a2 + hstep, voffA);
            PG8_WAIT_L(8); PG8_BAR; PG8_WAIT_L(0); PG8_MMA(0, 0, At, B0); PG8_BAR; PG8_SCHED;
            PG8_LDB(B1, 1, 1); PG8_STAGE(PG8_SB(1, 0), b3, voffB);
            PG8_BAR; PG8_WAIT_L(0); PG8_MMA(0, 1, At, B1); PG8_BAR;
            PG8_LDA(At, 1, 1); PG8_STAGE(PG8_SA(1, 0), a3, voffA);
            PG8_BAR; PG8_WAIT_L(0); PG8_MMA(1, 0, At, B0); PG8_BAR; PG8_SCHED;
            PG8_STAGE(PG8_SB(1, 1), b3 + hstep, voffB);
            PG8_WAIT_V(6); PG8_BAR; PG8_MMA(1, 1, At, B1); PG8_BAR;
            }
        }
        if constexpr (ALIGN_EPI) { if (wr == 0) PG8_BAR; }
        if constexpr (!Epi::AFTER_DRAIN) { E(acc, cur, wr, wc, fr, fq); S.done(cur); }
        if (!has_next) break;
#pragma unroll
        for (int a = 0; a < 2; ++a)
#pragma unroll
            for (int b = 0; b < 2; ++b)
#pragma unroll
                for (int m = 0; m < 4; ++m)
#pragma unroll
                    for (int n = 0; n < 2; ++n) acc[a][b][m][n] = (f32x4){0.f, 0.f, 0.f, 0.f};
        cur = nxt; cA = nA; cB = nB; ++ui;
        if constexpr (GATHER) { gC[0][0] = gN[0][0]; gC[0][1] = gN[0][1]; gC[1][0] = gN[1][0]; gC[1][1] = gN[1][1]; }
        if constexpr (ALIGN_EPI) { if (wr == 1) PG8_BAR; }
    }
    PG8_WAIT_V(0);
    if constexpr (!ALIGN_EPI) { if (wr == 0) PG8_BAR; }
    PG8_BAR;
    if constexpr (Epi::AFTER_DRAIN) { E.fused(acc, cur, wr, wc, fr, fq, lds, wid, lane); S.done(cur); }
#undef PG8_SA
#undef PG8_SB
#undef PG8_STAGE
#undef PG8_STAGE_G
#undef PG8_STAGE_A
#undef PG8_TAB_ISSUE
#undef PG8_TAB_READ
#undef PG8_LDA
#undef PG8_LDB
#undef PG8_MMA
#undef PG8_WAIT_V
#undef PG8_WAIT_L
#undef PG8_BAR
#undef PG8_SCHED
}
}

constexpr int NWAVES = 8, NTHR = 512;
constexpr int D = 1024, NB = 8, SEQ = 4096, CTXL = 256, NL = 2;
constexpr int NLAT = NB * SEQ;
constexpr int NCTX = NB * CTXL;
constexpr int MT = NLAT + NCTX;
constexpr int INW = 2576, NEXP = 32, TOPK = 4;
constexpr int PMAX = (MT * TOPK / 256 + NEXP) * 256;
constexpr float EPS = 1e-6f;

constexpr size_t MiB = 1u << 20;
constexpr size_t WS_CTL = 0, CTL_ZERO_BYTES = 1 * MiB;
constexpr size_t WS_MODV = 1 * MiB;
constexpr size_t WS_WRT = 2 * MiB;
constexpr size_t WS_WABT = WS_WRT + 512 * 1024;
constexpr size_t WS_SELE = 3 * MiB;
constexpr size_t WS_SELP = WS_SELE + 640 * 1024;
constexpr size_t WS_SELG = WS_SELP + 640 * 1024;
constexpr size_t WS_G = 5 * MiB;
constexpr size_t WS_BETA = WS_G + 1536 * 1024;
constexpr size_t WS_AB = 8 * MiB;
constexpr size_t WS_WIN = 12 * MiB;
constexpr size_t WS_WOUT = 24 * MiB;
constexpr size_t WS_DFTM = 32 * MiB;
constexpr size_t WS_W1 = 96 * MiB;
constexpr size_t WS_W2 = 224 * MiB;
constexpr size_t WS_XC = 288 * MiB;
constexpr size_t WS_ACT = 296 * MiB;
constexpr size_t WS_S = 364 * MiB;
constexpr size_t WS_QKVZ = WS_S;
constexpr size_t WS_ZTL = WS_S + 136 * MiB;
constexpr size_t WS_ZTC = WS_ZTL + 64 * MiB;
constexpr size_t WS_QKVN = WS_ZTC + 4 * MiB;
constexpr size_t WS_OF = WS_QKVN + 102 * MiB;
constexpr size_t WS_OB = WS_OF + 34 * MiB;
constexpr size_t WS_XS = WS_S;
constexpr size_t WS_HS = WS_S + 288 * MiB;
constexpr size_t WS_EO = 984 * MiB;
constexpr size_t WS_AB2 = WS_ZTL;
constexpr size_t WS_ZN = 11 * MiB - 64 * 1024;
constexpr size_t WS_GOFF = 944 * MiB;
constexpr size_t WS_END = 1024 * MiB;
static_assert(WS_OB + 34 * MiB <= WS_END && WS_HS + 288 * MiB <= WS_END && (size_t)PMAX * 1024 * 2 == 288 * MiB, "d_ws map");
static_assert((size_t)MT * 16 <= 640 * 1024 && (size_t)MT * 32 <= 1536 * 1024, "sel / g maps");
constexpr int CW_BAR = 4096;
constexpr int CW_GCNT = 16384;

constexpr int RING_BYTES = 131072;
constexpr int LDSCTL_OFF = RING_BYTES, MISC_OFF = LDSCTL_OFF + 320;
constexpr int XT_OFF = RING_BYTES + 1024;
constexpr int LDS_BYTES = 147456;

#define GAS __attribute__((address_space(1)))
#define LAS __attribute__((address_space(3)))
typedef unsigned short bf16;
typedef unsigned v4u __attribute__((ext_vector_type(4)));
typedef unsigned v2u __attribute__((ext_vector_type(2)));
typedef float f32x4 __attribute__((ext_vector_type(4)));
typedef GAS unsigned gu32;
#define RLX_AGENT __ATOMIC_RELAXED, __HIP_MEMORY_SCOPE_AGENT
#define LDS_WAIT() asm volatile("s_waitcnt lgkmcnt(0)" ::: "memory")
#define VM_WAIT() asm volatile("s_waitcnt vmcnt(0)" ::: "memory")
typedef float f32x2_t __attribute__((ext_vector_type(2))); typedef __bf16 bf16x2_t __attribute__((ext_vector_type(2)));
__device__ __forceinline__ unsigned pk2(float lo, float hi) { const f32x2_t v = {lo, hi}; const bf16x2_t b = __builtin_convertvector(v, bf16x2_t); return __builtin_bit_cast(unsigned, b); }
__device__ __forceinline__ unsigned f2bf(float f) { return pk2(f, 0.f) & 0xffffu; }
__device__ __forceinline__ float bflo(unsigned w) { return __builtin_bit_cast(float, w << 16); }
__device__ __forceinline__ float bfhi(unsigned w) { return __builtin_bit_cast(float, w & 0xffff0000u); }
__device__ __forceinline__ float wave_sum(float v) {
#pragma unroll
    for (int o = 1; o < 64; o <<= 1) v += __shfl_xor(v, o);
    return v;
}
__device__ __forceinline__ float sum16(float v) {
#pragma unroll
    for (int o = 1; o < 16; o <<= 1) v += __shfl_xor(v, o);
    return v;
}
__device__ __forceinline__ float rs32(float (&p)[32], int lane) {
#pragma unroll
    for (int e = 0; e < 16; ++e) { const bool up = (lane & 32) != 0; const float send = up ? p[e] : p[e + 16], keep = up ? p[e + 16] : p[e]; p[e] = keep + __shfl_xor(send, 32); }
#pragma unroll
    for (int e = 0; e < 8; ++e) { const bool up = (lane & 16) != 0; const float send = up ? p[e] : p[e + 8], keep = up ? p[e + 8] : p[e]; p[e] = keep + __shfl_xor(send, 16); }
#pragma unroll
    for (int e = 0; e < 4; ++e) { const bool up = (lane & 8) != 0; const float send = up ? p[e] : p[e + 4], keep = up ? p[e + 4] : p[e]; p[e] = keep + __shfl_xor(send, 8); }
#pragma unroll
    for (int e = 0; e < 2; ++e) { const bool up = (lane & 4) != 0; const float send = up ? p[e] : p[e + 2], keep = up ? p[e + 2] : p[e]; p[e] = keep + __shfl_xor(send, 4); }
    { const bool up = (lane & 2) != 0; const float send = up ? p[0] : p[1], keep = up ? p[1] : p[0]; p[0] = keep + __shfl_xor(send, 2); }
    return p[0] + __shfl_xor(p[0], 1);
}
__device__ __forceinline__ float rs16(float (&p)[16], int lane) {
#pragma unroll
    for (int e = 0; e < 8; ++e) { const bool up = (lane & 32) != 0; const float send = up ? p[e] : p[e + 8], keep = up ? p[e + 8] : p[e]; p[e] = keep + __shfl_xor(send, 32); }
#pragma unroll
    for (int e = 0; e < 4; ++e) { const bool up = (lane & 16) != 0; const float send = up ? p[e] : p[e + 4], keep = up ? p[e + 4] : p[e]; p[e] = keep + __shfl_xor(send, 16); }
#pragma unroll
    for (int e = 0; e < 2; ++e) { const bool up = (lane & 8) != 0; const float send = up ? p[e] : p[e + 2], keep = up ? p[e + 2] : p[e]; p[e] = keep + __shfl_xor(send, 8); }
    { const bool up = (lane & 4) != 0; const float send = up ? p[0] : p[1], keep = up ? p[1] : p[0]; p[0] = keep + __shfl_xor(send, 4); }
    float r = p[0] + __shfl_xor(p[0], 2);
    return r + __shfl_xor(r, 1);
}
__device__ __forceinline__ float silu_f(float x) { return x / (1.f + __expf(-x)); }

#define XB_TMO      128
#define XB_XCNT(j)  (256  + 64 * (j))
#define XB_XSUB(j)  (1280 + 64 * (j))
#define XB_XGEN(j)  (2304 + 64 * (j))
#define XB_TOP      3328
#define XB_TOPGEN   3392
#define XCD_BAR_WORDS 3456
#define XB_SPIN_CAP (1u << 18)
__device__ __forceinline__ unsigned xb_ld(unsigned* p)              { return __hip_atomic_load(p, __ATOMIC_RELAXED, __HIP_MEMORY_SCOPE_AGENT); }
__device__ __forceinline__ unsigned xb_add(unsigned* p, unsigned v) { return __hip_atomic_fetch_add(p, v, __ATOMIC_RELAXED, __HIP_MEMORY_SCOPE_AGENT); }
__device__ __forceinline__ unsigned xb_xcc_id() { return (unsigned)__builtin_amdgcn_s_getreg((3 << 11) | 20) & 0xFu; }
#define XB_SPIN(cond, bar) do { unsigned _sp = 0; while (cond) { __builtin_amdgcn_s_sleep(1); \
    if ((++_sp & 255u) == 0u) { if (xb_ld(&(bar)[XB_TMO])) break; if (_sp > XB_SPIN_CAP) { atomicAdd(&(bar)[XB_TMO], 1u); break; } } } } while (0)
struct XcdBarrier { unsigned* bar; unsigned x; volatile LAS unsigned* st; };
__device__ __forceinline__ XcdBarrier xcd_barrier_post(unsigned* bar, volatile LAS unsigned* st, int tid) {
    XcdBarrier b; b.bar = bar; b.x = xb_xcc_id(); b.st = st;
    if (tid == 0) (void)xb_add(&bar[XB_XCNT(b.x)], 1u);
    return b;
}
__device__ __forceinline__ void xcd_barrier_complete(unsigned* bar, unsigned x, unsigned& nloc, unsigned& nx) {
    const unsigned G = gridDim.x * gridDim.y * gridDim.z;
    unsigned sum, cnt, mine, sp = 0u;
    for (;;) {
        sum = 0u; cnt = 0u; mine = 0u;
#pragma unroll
        for (unsigned j = 0; j < 16; ++j) { const unsigned c = xb_ld(&bar[XB_XCNT(j)]); sum += c; cnt += (c > 0u) ? 1u : 0u; mine = (j == x) ? c : mine; }
        if (sum == G) break;
        __builtin_amdgcn_s_sleep(1);
        if ((++sp & 255u) == 0u) { if (xb_ld(&bar[XB_TMO])) break; if (sp > XB_SPIN_CAP) { atomicAdd(&bar[XB_TMO], 1u); break; } }
    }
    nloc = mine > 0u ? mine : 1u; nx = cnt > 0u ? cnt : 1u;
}
__device__ __forceinline__ void xcd_barrier(const XcdBarrier& b, int tid) {
    asm volatile("s_waitcnt vmcnt(0)" ::: "memory");
    __syncthreads();
    if (tid == 0) {
        unsigned* bar = b.bar; unsigned bx = b.x;
        asm volatile("" : "+v"(bar), "+v"(bx));
        __builtin_amdgcn_s_waitcnt(0);
        unsigned nloc = b.st[0], nx = b.st[1];
        if (nloc == 0u) { xcd_barrier_complete(bar, bx, nloc, nx); b.st[0] = nloc; b.st[1] = nx; }
        const unsigned old = xb_add(&bar[XB_XSUB(bx)], 1u);
        const unsigned gen = old / nloc;
        if (old + 1u == (gen + 1u) * nloc) {
            __builtin_amdgcn_fence(__ATOMIC_RELEASE, "agent");
            asm volatile("s_waitcnt vmcnt(0)" ::: "memory");
            const unsigned og = xb_add(&bar[XB_TOP], 1u);
            const unsigned tg = og / nx;
            if (og + 1u == (tg + 1u) * nx) xb_add(&bar[XB_TOPGEN], 1u);
            else XB_SPIN(xb_ld(&bar[XB_TOPGEN]) == tg, bar);
            __builtin_amdgcn_fence(__ATOMIC_ACQUIRE, "agent");
            xb_add(&bar[XB_XGEN(bx)], 1u);
            asm volatile("s_waitcnt vmcnt(0)" ::: "memory");
        } else {
            XB_SPIN(xb_ld(&bar[XB_XGEN(bx)]) == gen, bar);
            __builtin_amdgcn_fence(__ATOMIC_ACQUIRE, "agent");
            asm volatile("s_waitcnt vmcnt(0)" ::: "memory");
        }
    }
    __syncthreads();
}

struct Args { const float* in[23]; float* out; unsigned char* ws; int ph_lo, ph_hi; };
struct Frame {
    LAS unsigned char* lds;
    volatile LAS unsigned* MISC;
    unsigned* ctl;
    unsigned char* ws;
    int tid, lane, wave, vcu, G, gw, NGW;
    float* out;
};
typedef const Args __attribute__((address_space(4)))* KArgsP;
__device__ __forceinline__ KArgsP kargs() { unsigned long long v = (unsigned long long)__builtin_amdgcn_kernarg_segment_ptr(); asm volatile("" : "+s"(v)); return (KArgsP)v; }
enum InIdx { I_X = 0, I_C, I_CTX, I_CCTX, I_WMOD, I_BMOD, I_GN1, I_WIN, I_CONVW, I_ALOG, I_DTB, I_GOUT, I_WOUT, I_GN2, I_WR, I_BR, I_WG, I_BG, I_WU, I_BU, I_WD, I_BD, I_GF };
__device__ __forceinline__ float* xr_row(const Frame& F, int t) { return t < NLAT ? F.out + (size_t)t * D : (float*)(F.ws + WS_XC) + (size_t)(t - NLAT) * D; }
__device__ __forceinline__ int mod_row(int t) { return t < NLAT ? (t >> 12) : 8; }
__device__ __forceinline__ const float* modv(const Frame& F, int l, int r, int piece) { return (const float*)(F.ws + WS_MODV) + ((size_t)(l * 9 + r) * 6 + piece) * D; }

struct SchedIn {
    const bf16* hx; const bf16* win; int G, c;
    static constexpr int N0 = (MT / 256) * 8, N1 = 4 * (MT / 256), NWG = N0 + N1;
    __device__ __forceinline__ bool next(int i, pg8::Unit& u) const {
        const long L = (long)i * G + c; if (L >= NWG) return false;
        int w = pg8::xcd_remap((int)L, NWG);
        if (w < N0) { u.kind = 0; pg8::grp_decode(w, MT / 256, 8, u.pm, u.pn); } else { w -= N0; u.kind = 1; u.pn = w >> 2; u.pm = w & 3; }
        u.e = 0; return true;
    }
    __device__ __forceinline__ const char* a_base(const pg8::Unit& u, size_t tstep) const { return u.kind == 0 ? (const char*)hx + (size_t)u.pm * tstep : (const char*)win + (size_t)(8 + u.pm) * tstep; }
    __device__ __forceinline__ const char* b_base(const pg8::Unit& u, size_t tstep) const { return u.kind == 0 ? (const char*)win + (size_t)u.pn * tstep : (const char*)hx + (size_t)u.pn * tstep; }
    __device__ __forceinline__ void a_ready(const pg8::Unit&) const {}
    __device__ __forceinline__ void done(const pg8::Unit&) const {}
};
struct EpiIn {
    static constexpr bool PERM = true, AFTER_DRAIN = false;
    bf16* qkvz; bf16* ztl; bf16* ztc;
    __device__ __forceinline__ void operator()(const pg8::f32x4 (&acc)[2][2][4][2], const pg8::Unit& u, int wr, int wc, int fr_, int fq_) const {
        int fr = fr_, fq = fq_; asm volatile("" : "+v"(fr), "+v"(fq));
        const int row0 = u.pm * 256 + wr * 64 + fr, cin = wc * 32 + 8 * fq;
        bf16* base; size_t ldc;
        if (u.kind == 0) { base = qkvz + (size_t)u.pn * 256 + cin; ldc = 2048; }
        else if (u.pn < 128) { base = ztl + (size_t)(u.pn >> 4) * 1024 * 4096 + (size_t)(u.pn & 15) * 256 + cin; ldc = 4096; }
        else { base = ztc + (size_t)(u.pn - 128) * 1024 * 256 + cin; ldc = 256; }
#pragma unroll
        for (int ai = 0; ai < 2; ++ai)
#pragma unroll
            for (int m = 0; m < 4; ++m) { bf16* rowp = base + (size_t)(row0 + ai * 128 + m * 16) * ldc;
#pragma unroll
                for (int bj = 0; bj < 2; ++bj) { const pg8::f32x4 v0 = acc[ai][bj][m][0], v1 = acc[ai][bj][m][1]; pg8::u32x4 w;
                    w.x = pg8::cvt_pk_bf16(v0[0], v0[1]); w.y = pg8::cvt_pk_bf16(v0[2], v0[3]); w.z = pg8::cvt_pk_bf16(v1[0], v1[1]); w.w = pg8::cvt_pk_bf16(v1[2], v1[3]);
                    *(pg8::u32x4*)(rowp + bj * 128) = w; } }
    }
};
struct SchedDft {
    const bf16* dftm; const bf16* eo; int v;
    __device__ __forceinline__ bool next(int i, pg8::Unit& u) const {
        if (i >= 2 || v < 0) return false;
        const int w = (v >> 5) * 64 + i * 32 + (v & 31), x = w >> 5, j = w & 31;
        u.kind = x & 1; u.pm = 4 * ((x >> 1) & 1) + (j & 3); u.e = 4 * (x >> 2) + ((j >> 2) & 3); u.pn = j >> 4; return true;
    }
    __device__ __forceinline__ const char* a_base(const pg8::Unit& u, size_t tstep) const { return (const char*)dftm + (size_t)u.kind * (2048 * 2048 * 2) + (size_t)u.pm * tstep; }
    __device__ __forceinline__ const char* b_base(const pg8::Unit& u, size_t tstep) const { return (const char*)eo + (size_t)(u.e * 2 + u.kind) * (512 * 2048 * 2) + (size_t)u.pn * tstep; }
    __device__ __forceinline__ void a_ready(const pg8::Unit&) const {}
    __device__ __forceinline__ void done(const pg8::Unit&) const {}
};
struct EpiDft {
    static constexpr bool PERM = true, AFTER_DRAIN = false;
    bf16* ab2;
    __device__ __forceinline__ void operator()(const pg8::f32x4 (&acc)[2][2][4][2], const pg8::Unit& u, int wr, int wc, int fr_, int fq_) const {
        int fr = fr_, fq = fq_; asm volatile("" : "+v"(fr), "+v"(fq));
        const int row0 = u.pm * 256 + wr * 64 + fr, col0 = u.pn * 256 + wc * 32 + 8 * fq;
        bf16* base = ab2 + (size_t)(u.e * 2 + u.kind) * 2048 * 512;
#pragma unroll
        for (int ai = 0; ai < 2; ++ai)
#pragma unroll
            for (int m = 0; m < 4; ++m) { bf16* rowp = base + (size_t)(row0 + ai * 128 + m * 16) * 512 + col0;
#pragma unroll
                for (int bj = 0; bj < 2; ++bj) { const pg8::f32x4 v0 = acc[ai][bj][m][0], v1 = acc[ai][bj][m][1]; pg8::u32x4 w;
                    w.x = pg8::cvt_pk_bf16(v0[0], v0[1]); w.y = pg8::cvt_pk_bf16(v0[2], v0[3]); w.z = pg8::cvt_pk_bf16(v1[0], v1[1]); w.w = pg8::cvt_pk_bf16(v1[2], v1[3]);
                    *(pg8::u32x4*)(rowp + bj * 128) = w; } }
    }
};
struct SchedOut {
    const bf16* mix; const bf16* wout; int nM, G, c;
    __device__ __forceinline__ bool next(int i, pg8::Unit& u) const {
        const int nwg = nM * 4; const long L = (long)i * G + c; if (L >= nwg) return false;
        pg8::grp_decode(pg8::xcd_remap((int)L, nwg), nM, 4, u.pm, u.pn); u.kind = 0; u.e = 0; return true;
    }
    __device__ __forceinline__ const char* a_base(const pg8::Unit& u, size_t tstep) const { return (const char*)mix + (size_t)u.pm * tstep; }
    __device__ __forceinline__ const char* b_base(const pg8::Unit& u, size_t tstep) const { return (const char*)wout + (size_t)u.pn * tstep; }
    __device__ __forceinline__ void a_ready(const pg8::Unit&) const {}
    __device__ __forceinline__ void done(const pg8::Unit&) const {}
};
struct EpiOut {
    static constexpr bool PERM = false, AFTER_DRAIN = false;
    float* xlat; float* xctx; const float* gt1; float dsc;
    __device__ __forceinline__ void operator()(const pg8::f32x4 (&acc)[2][2][4][2], const pg8::Unit& u, int wr, int wc, int fr_, int fq_) const {
        int fr = fr_, fq = fq_; asm volatile("" : "+v"(fr), "+v"(fq));
        const int col0 = u.pn * 256 + wc * 32 + 4 * fq, rl = wr * 64 + fr;
        float* xb = u.pm < 128 ? xlat + (size_t)u.pm * 256 * D : xctx + (size_t)(u.pm - 128) * 256 * D;
        const float* g = gt1 + (size_t)(u.pm < 128 ? (u.pm >> 4) : 8) * 6 * D + col0;
        pg8::f32x4 gv[2][2];
#pragma unroll
        for (int bj = 0; bj < 2; ++bj)
#pragma unroll
            for (int n = 0; n < 2; ++n) gv[bj][n] = *(const pg8::f32x4*)(g + bj * 128 + n * 16);
#pragma unroll
        for (int ai = 0; ai < 2; ++ai)
#pragma unroll
            for (int m = 0; m < 4; ++m) { float* rowp = xb + (size_t)(rl + ai * 128 + m * 16) * D + col0;
#pragma unroll
                for (int bj = 0; bj < 2; ++bj)
#pragma unroll
                    for (int n = 0; n < 2; ++n) { pg8::f32x4* p = (pg8::f32x4*)(rowp + bj * 128 + n * 16); const pg8::f32x4 xo = *p; *p = xo + gv[bj][n] * acc[ai][bj][m][n] * dsc; }
                if (m & 1) asm volatile("" ::: "memory"); }
    }
};
struct SchedMoe {
    const bf16* A; const bf16* W; size_t wstride; const LAS int* pend; int nM, nN, G, c, gather;
    __device__ __forceinline__ bool next(int i, pg8::Unit& u) const {
        const int nwg = nM * nN; const long L = (long)i * G + c; if (L >= nwg) return false;
        pg8::grp_decode(pg8::xcd_remap((int)L, nwg), nM, nN, u.pm, u.pn);
        int e = 0;
#pragma unroll 1
        for (int j = 0; j < NEXP - 1; ++j) e += (pend[j] <= u.pm) ? 1 : 0;
        u.e = e; u.kind = 0; return true;
    }
    __device__ __forceinline__ const char* a_base(const pg8::Unit& u, size_t tstep) const { return gather ? (const char*)A : (const char*)A + (size_t)u.pm * tstep; }
    __device__ __forceinline__ const char* b_base(const pg8::Unit& u, size_t tstep) const { return (const char*)W + (size_t)u.e * wstride + (size_t)u.pn * tstep; }
    __device__ __forceinline__ void a_ready(const pg8::Unit&) const {}
    __device__ __forceinline__ void done(const pg8::Unit&) const {}
};
struct EpiSwiglu {
    static constexpr bool PERM = true, AFTER_DRAIN = false;
    bf16* hs; const float* bg; const float* bu;
    __device__ __forceinline__ void operator()(const pg8::f32x4 (&acc)[2][2][4][2], const pg8::Unit& u, int wr, int wc, int fr_, int fq_) const {
        int fr = fr_, fq = fq_; asm volatile("" : "+v"(fr), "+v"(fq));
        const int row0 = u.pm * 256 + wr * 64 + fr, f0 = u.pn * 128 + wc * 32 + 8 * fq;
        const pg8::f32x4 bg0 = *(const pg8::f32x4*)(bg + u.e * D + f0), bg1 = *(const pg8::f32x4*)(bg + u.e * D + f0 + 4);
        const pg8::f32x4 bu0 = *(const pg8::f32x4*)(bu + u.e * D + f0), bu1 = *(const pg8::f32x4*)(bu + u.e * D + f0 + 4);
#pragma unroll
        for (int ai = 0; ai < 2; ++ai)
#pragma unroll
            for (int m = 0; m < 4; ++m) {
                float h[8];
#pragma unroll
                for (int n = 0; n < 2; ++n) { const pg8::f32x4 ga = acc[ai][0][m][n] + (n ? bg1 : bg0), ua = acc[ai][1][m][n] + (n ? bu1 : bu0);
#pragma unroll
                    for (int j = 0; j < 4; ++j) { const float a = fminf(ga[j], 7.0f), uu = fminf(fmaxf(ua[j], -7.0f), 7.0f);
                        h[n * 4 + j] = a * __builtin_amdgcn_rcpf(1.0f + __expf(-1.702f * a)) * (uu + 1.0f); } }
                pg8::u32x4 w; w.x = pg8::cvt_pk_bf16(h[0], h[1]); w.y = pg8::cvt_pk_bf16(h[2], h[3]); w.z = pg8::cvt_pk_bf16(h[4], h[5]); w.w = pg8::cvt_pk_bf16(h[6], h[7]);
                *(pg8::u32x4*)(hs + (size_t)(row0 + ai * 128 + m * 16) * D + f0) = w; }
    }
};
struct EpiDown {
    static constexpr bool PERM = true, AFTER_DRAIN = false;
    bf16* ys; const float* bd;
    __device__ __forceinline__ void operator()(const pg8::f32x4 (&acc)[2][2][4][2], const pg8::Unit& u, int wr, int wc, int fr_, int fq_) const {
        int fr = fr_, fq = fq_; asm volatile("" : "+v"(fr), "+v"(fq));
        const int row0 = u.pm * 256 + wr * 64 + fr, col0 = u.pn * 256 + wc * 32 + 8 * fq;
        pg8::f32x4 bv[2][2];
#pragma unroll
        for (int bj = 0; bj < 2; ++bj)
#pragma unroll
            for (int n = 0; n < 2; ++n) bv[bj][n] = *(const pg8::f32x4*)(bd + u.e * D + col0 + bj * 128 + 4 * n);
#pragma unroll
        for (int ai = 0; ai < 2; ++ai)
#pragma unroll
            for (int m = 0; m < 4; ++m) { bf16* rowp = ys + (size_t)(row0 + ai * 128 + m * 16) * D + col0;
#pragma unroll
                for (int bj = 0; bj < 2; ++bj) { const pg8::f32x4 v0 = acc[ai][bj][m][0] + bv[bj][0], v1 = acc[ai][bj][m][1] + bv[bj][1]; pg8::u32x4 w;
                    w.x = pg8::cvt_pk_bf16(v0[0], v0[1]); w.y = pg8::cvt_pk_bf16(v0[2], v0[3]); w.z = pg8::cvt_pk_bf16(v1[0], v1[1]); w.w = pg8::cvt_pk_bf16(v1[2], v1[3]);
                    *(pg8::u32x4*)(rowp + bj * 128) = w; } }
    }
};

__device__ __forceinline__ void transpose_item(const float* W, int ldw, int col0, int K, bf16* WT, int drow0, LAS float* scr, int kb, int lane) {
    const int k0 = 64 * kb;
#pragma unroll 8
    for (int i = 0; i < 32; ++i) { const int kk = 2 * i + (lane >> 5); scr[kk * 33 + (lane & 31)] = W[(size_t)(k0 + kk) * ldw + col0 + (lane & 31)]; }
    LDS_WAIT(); asm volatile("" ::: "memory");
    const int c = lane & 7;
#pragma unroll
    for (int j = 0; j < 4; ++j) { const int n = (lane >> 3) + 8 * j; const LAS float* s = scr + (8 * c) * 33 + n;
        v4u o; o.x = pk2(s[0 * 33], s[1 * 33]); o.y = pk2(s[2 * 33], s[3 * 33]); o.z = pk2(s[4 * 33], s[5 * 33]); o.w = pk2(s[6 * 33], s[7 * 33]);
        *(v4u*)(WT + (size_t)(drow0 + n) * K + k0 + 8 * c) = o; }
    LDS_WAIT(); asm volatile("" ::: "memory");
}
__device__ __forceinline__ void convert_experts(const Frame& F, int l) {
    const KArgsP A = kargs();
    LAS float* scr = (LAS float*)(F.lds + F.wave * 16384);
    bf16* W1 = (bf16*)(F.ws + WS_W1); bf16* W2 = (bf16*)(F.ws + WS_W2);
    constexpr int IPM = 16 * 32;
    for (int it = F.gw; it < 3 * NEXP * IPM; it += F.NGW) {
        const int which = it / (NEXP * IPM), r = it % (NEXP * IPM), e = r / IPM, q = r % IPM, kb = q >> 5, nb = q & 31;
        const size_t moff = ((size_t)l * NEXP + e) * D * D;
        if (which == 0) transpose_item(A->in[I_WG] + moff, D, nb * 32, D, W1 + (size_t)e * 2048 * D, 256 * (nb >> 2) + 32 * (nb & 3), scr, kb, F.lane);
        else if (which == 1) transpose_item(A->in[I_WU] + moff, D, nb * 32, D, W1 + (size_t)e * 2048 * D, 256 * (nb >> 2) + 128 + 32 * (nb & 3), scr, kb, F.lane);
        else transpose_item(A->in[I_WD] + moff, D, nb * 32, D, W2 + (size_t)e * D * D, nb * 32, scr, kb, F.lane);
    }
}
__device__ __forceinline__ void p0_prologue(const Frame& F) {
    const KArgsP A = kargs();
    float* mv = (float*)(F.ws + WS_MODV);
    {
        LAS float* sc = (LAS float*)F.lds;
        LAS float* red = sc + 9 * 1024;
        for (int i = F.tid; i < 9 * 1024; i += NTHR) { const int r = i >> 10, k = i & 1023; sc[i] = silu_f(r < 8 ? A->in[I_C][r * D + k] : A->in[I_CCTX][k]); }
        __syncthreads();
        for (int item = blockIdx.x; item < 192; item += F.G) {
            const int l = item / 96, cg = item % 96, cl = F.tid & 63, ks = F.tid >> 6;
            const float* w = A->in[I_WMOD] + ((size_t)l * D + ks * 128) * 6144 + cg * 64 + cl;
            float a[9];
#pragma unroll
            for (int r = 0; r < 9; ++r) a[r] = 0.f;
#pragma unroll 4
            for (int k = 0; k < 128; ++k) { const float wv = w[(size_t)k * 6144];
#pragma unroll
                for (int r = 0; r < 9; ++r) a[r] += sc[r * 1024 + ks * 128 + k] * wv; }
#pragma unroll
            for (int r = 0; r < 9; ++r) red[(ks * 9 + r) * 64 + cl] = a[r];
            __syncthreads();
            for (int i = F.tid; i < 9 * 64; i += NTHR) { const int r = i >> 6, cc = i & 63; float s = 0.f;
#pragma unroll
                for (int k2 = 0; k2 < 8; ++k2) s += red[(k2 * 9 + r) * 64 + cc];
                mv[(size_t)(l * 9 + r) * 6144 + cg * 64 + cc] = s + A->in[I_BMOD][l * 6144 + cg * 64 + cc]; }
            __syncthreads();
        }
    }
    {
        LAS float* T = (LAS float*)F.lds;
        LAS float* cs = T + 64 * 129; LAS float* sn = cs + 128;
        __syncthreads();
        if (F.tid < 128) { cs[F.tid] = cospif((float)F.tid * (1.0f / 64.0f)); sn[F.tid] = sinpif((float)F.tid * (1.0f / 64.0f)); }
        for (int item = (blockIdx.x + 64) % F.G; item < 128; item += F.G) {
            const int l = item >> 6, kg = (item & 63) >> 2, g = item & 3;
            __syncthreads();
            for (int i = F.tid; i < 64 * 128; i += NTHR) { const int kk = i >> 7, cc = i & 127; T[kk * 129 + cc] = A->in[I_WIN][((size_t)l * D + kg * 64 + kk) * INW + g * 128 + cc]; }
            __syncthreads();
            const int kk = F.tid & 63, ng = F.tid >> 6;
            bf16* dst = (bf16*)(F.ws + WS_WIN) + ((size_t)l * 3072 + 2048 + g * 256) * D + kg * 64 + kk;
#pragma unroll 1
            for (int nn = 0; nn < 32; ++nn) { const int np = ng * 32 + nn, cp = np >> 1; float s = 0.f;
                if (np & 1) {
#pragma unroll 8
                    for (int cc = 0; cc < 128; ++cc) s -= T[kk * 129 + cc] * sn[(cc * cp) & 127]; }
                else {
#pragma unroll 8
                    for (int cc = 0; cc < 128; ++cc) s += T[kk * 129 + cc] * cs[(cc * cp) & 127]; }
                dst[(size_t)np * D] = (bf16)f2bf(s); }
        }
        __syncthreads();
    }
    {
        LAS float* scr = (LAS float*)(F.lds + F.wave * 16384);
        constexpr int I_IN = 16 * 64, I_OUT = 16 * 32;
        for (int it = F.gw; it < NL * (I_IN + I_OUT); it += F.NGW) {
            const int l = it / (I_IN + I_OUT), r = it % (I_IN + I_OUT);
            if (r < I_IN) transpose_item(A->in[I_WIN] + (size_t)l * D * INW, INW, 512 + 32 * (r & 63), D, (bf16*)(F.ws + WS_WIN) + (size_t)l * 3072 * D, 32 * (r & 63), scr, r >> 6, F.lane);
            else { const int q = r - I_IN; transpose_item(A->in[I_WOUT] + (size_t)l * D * D, D, 32 * (q & 31), D, (bf16*)(F.ws + WS_WOUT) + (size_t)l * D * D, 32 * (q & 31), scr, q >> 5, F.lane); }
        }
    }
    convert_experts(F, 0);
    {
        const int gt = F.gw * 64 + F.lane, NT = F.NGW * 64;
        float* wrt = (float*)(F.ws + WS_WRT); float* wabt = (float*)(F.ws + WS_WABT);
        for (int i = gt; i < NL * NEXP * D; i += NT) { const int l = i >> 15, e = (i >> 10) & 31, c = i & 1023; wrt[i] = A->in[I_WR][((size_t)l * D + c) * NEXP + e]; }
        for (int i = gt; i < NL * 16 * D; i += NT) { const int l = i >> 14, j = (i >> 10) & 15, c = i & 1023; wabt[i] = A->in[I_WIN][((size_t)l * D + c) * INW + 2560 + j]; }
        bf16* dm = (bf16*)(F.ws + WS_DFTM);
        for (int i = gt; i < 2 * 2048 * 256; i += NT) { const int mat = i >> 19, kf = (i >> 8) & 2047, j0 = (i & 255) * 8; float v[8];
#pragma unroll
            for (int jj = 0; jj < 8; ++jj) { const float a = (float)((kf * (j0 + jj)) & 4095) * (1.0f / 2048.0f); v[jj] = mat ? sinpif(a) : cospif(a); }
            v4u o; o.x = pk2(v[0], v[1]); o.y = pk2(v[2], v[3]); o.z = pk2(v[4], v[5]); o.w = pk2(v[6], v[7]);
            *(v4u*)(dm + (size_t)i * 8) = o; }
    }
}

template <int MODE>
__device__ __forceinline__ void row_pass(const Frame& F, int l_cur, int l_nxt, bool dummy = false) {
    const KArgsP A = kargs();
    LAS float* wl = (LAS float*)F.lds;
    if (MODE != 2) { const f32x4* src = (const f32x4*)((const float*)(F.ws + WS_WABT) + (size_t)l_nxt * 16 * D);
        for (int i = F.tid; i < 16 * D / 4; i += NTHR) ((LAS f32x4*)wl)[i] = src[i];
        __syncthreads(); }
    const int nrows = MODE == 2 ? NLAT : MT;
    const int* selp = (const int*)(F.ws + WS_SELP); const float* selg = (const float*)(F.ws + WS_SELG);
    const bf16* ys = (const bf16*)(F.ws + WS_XS);
    bf16* hx = (bf16*)(F.ws + WS_ACT); float* ab = (float*)(F.ws + WS_AB);
    f32x4 xc[4]; int dc[4]; float gc[4]; v2u yc[4][4];
    int t = F.gw;
    if (t < nrows) {
        const float* xin = MODE == 0 ? (t < NLAT ? A->in[I_X] + (size_t)t * D : A->in[I_CTX] + (size_t)(t - NLAT) * D) : xr_row(F, t);
#pragma unroll
        for (int j = 0; j < 4; ++j) xc[j] = *((const f32x4*)xin + F.lane + 64 * j);
        if (MODE != 0) {
#pragma unroll
            for (int k = 0; k < 4; ++k) { dc[k] = selp[t * 4 + k]; gc[k] = selg[t * 4 + k]; }
#pragma unroll
            for (int k = 0; k < 4; ++k) { const v2u* yr = (const v2u*)(ys + (size_t)dc[k] * D) + F.lane;
#pragma unroll
                for (int j = 0; j < 4; ++j) yc[k][j] = yr[64 * j]; } }
    }
    for (; t < nrows; t += F.NGW) {
        const int tn = t + F.NGW < nrows ? t + F.NGW : t;
        f32x4 xn[4]; int dn[4]; float gn[4];
        { const float* xin = MODE == 0 ? (tn < NLAT ? A->in[I_X] + (size_t)tn * D : A->in[I_CTX] + (size_t)(tn - NLAT) * D) : xr_row(F, tn);
#pragma unroll
          for (int j = 0; j < 4; ++j) xn[j] = *((const f32x4*)xin + F.lane + 64 * j);
          if (MODE != 0) {
#pragma unroll
              for (int k = 0; k < 4; ++k) { dn[k] = selp[tn * 4 + k]; gn[k] = selg[tn * 4 + k]; } } }
        const int r = mod_row(t);
        f32x4 v[4];
#pragma unroll
        for (int j = 0; j < 4; ++j) v[j] = xc[j];
        float* xr = xr_row(F, t);
        if (MODE != 0) {
            f32x4 y[4];
#pragma unroll
            for (int j = 0; j < 4; ++j) y[j] = (f32x4){0.f, 0.f, 0.f, 0.f};
#pragma unroll
            for (int k = 0; k < 4; ++k)
#pragma unroll
                for (int j = 0; j < 4; ++j) { const v2u w = yc[k][j]; y[j] += gc[k] * (f32x4){bflo(w.x), bfhi(w.x), bflo(w.y), bfhi(w.y)}; }
            const f32x4* g2 = (const f32x4*)modv(F, l_cur, r, 5) + F.lane;
#pragma unroll
            for (int j = 0; j < 4; ++j) v[j] += g2[64 * j] * y[j];
#pragma unroll
            for (int k = 0; k < 4; ++k) { const v2u* yr = (const v2u*)(ys + (size_t)dn[k] * D) + F.lane;
#pragma unroll
                for (int j = 0; j < 4; ++j) yc[k][j] = yr[64 * j]; }
        }
        if (MODE != 2 && !dummy) {
#pragma unroll
            for (int j = 0; j < 4; ++j) *((f32x4*)xr + F.lane + 64 * j) = v[j];
        }
        float ss = 0.f;
#pragma unroll
        for (int j = 0; j < 4; ++j) ss += (v[j].x * v[j].x + v[j].y * v[j].y) + (v[j].z * v[j].z + v[j].w * v[j].w);
        const float rstd = 1.0f / sqrtf(wave_sum(ss) * (1.0f / D) + EPS);
        if (MODE == 2) {
            const f32x4* gf = (const f32x4*)A->in[I_GF] + F.lane;
#pragma unroll
            for (int j = 0; j < 4; ++j) *((f32x4*)(F.out + (size_t)t * D) + F.lane + 64 * j) = v[j] * rstd * gf[64 * j];
        } else {
            const f32x4* g1 = (const f32x4*)(A->in[I_GN1] + (size_t)l_nxt * D) + F.lane;
            const f32x4* sh = (const f32x4*)modv(F, l_nxt, r, 0) + F.lane; const f32x4* scl = (const f32x4*)modv(F, l_nxt, r, 1) + F.lane;
            v2u* ho = (v2u*)(hx + (size_t)t * D) + F.lane;
#pragma unroll
            for (int j = 0; j < 4; ++j) { v[j] = v[j] * rstd * g1[64 * j] * (scl[64 * j] + 1.0f) + sh[64 * j]; v2u w; w.x = pk2(v[j].x, v[j].y); w.y = pk2(v[j].z, v[j].w); ho[64 * j] = w; }
            float pp[16];
            int lofs = F.lane; asm volatile("" : "+v"(lofs));
#pragma unroll
            for (int jj = 0; jj < 16; ++jj) { float p = 0.f;
#pragma unroll
                for (int j = 0; j < 4; ++j) { const f32x4 w = ((const LAS f32x4*)(wl + jj * D))[lofs + 64 * j]; p += (v[j].x * w.x + v[j].y * w.y) + (v[j].z * w.z + v[j].w * w.w); }
                pp[jj] = p; if ((jj & 3) == 3) asm volatile("" ::: "memory"); }
            const float mine = rs16(pp, F.lane);
            if ((F.lane & 3) == 0) ab[(size_t)t * 16 + (F.lane >> 2)] = mine;
        }
#pragma unroll
        for (int j = 0; j < 4; ++j) xc[j] = xn[j];
        if (MODE != 0) {
#pragma unroll
            for (int k = 0; k < 4; ++k) { dc[k] = dn[k]; gc[k] = gn[k]; } }
    }
}

__device__ __forceinline__ int seq_id(int x) { return x < 0 ? -1 : (x < NLAT ? (x >> 12) : (x < MT ? 8 + ((x - NLAT) >> 8) : -2)); }
__device__ __forceinline__ void conv_phase(const Frame& F, int l) {
    const KArgsP A = kargs();
    LAS float* cw = (LAS float*)F.lds;
    for (int i = F.tid; i < 5 * 1536; i += NTHR) cw[i] = A->in[I_CONVW][(size_t)l * 5 * 1536 + i];
    __syncthreads();
    const bf16* qkvz = (const bf16*)(F.ws + WS_QKVZ); bf16* qkvn = (bf16*)(F.ws + WS_QKVN);
    const float* ab = (const float*)(F.ws + WS_AB); float* gb = (float*)(F.ws + WS_G); float* bb = (float*)(F.ws + WS_BETA);
    constexpr int RUN = MT / (256 * NWAVES);
    static_assert(RUN * 256 * NWAVES == MT, "conv runs");
    for (int run = F.gw; run < MT / RUN; run += F.NGW) {
        const int t0 = run * RUN;
        v4u W[5][3];
#pragma unroll
        for (int k = 0; k < 5; ++k) { const int g = t0 + k - 2, gc = g < 0 ? 0 : (g >= MT ? MT - 1 : g);
#pragma unroll
            for (int q = 0; q < 3; ++q) W[k][q] = *(const v4u*)(qkvz + (size_t)gc * 2048 + q * 512 + 8 * F.lane); }
#pragma unroll 1
        for (int t = t0; t < t0 + RUN; ++t) {
            v4u N[3];
            { const int g = t + 3, gc = g >= MT ? MT - 1 : g;
#pragma unroll
              for (int q = 0; q < 3; ++q) N[q] = *(const v4u*)(qkvz + (size_t)gc * 2048 + q * 512 + 8 * F.lane); }
            const int sid = seq_id(t);
            float a[3][8];
#pragma unroll
            for (int q = 0; q < 3; ++q)
#pragma unroll
                for (int i = 0; i < 8; ++i) a[q][i] = 0.f;
#pragma unroll
            for (int tap = 0; tap < 5; ++tap) { const float vm = (seq_id(t + tap - 2) == sid) ? 1.0f : 0.0f;
#pragma unroll
                for (int q = 0; q < 3; ++q) { const v4u u = W[tap][q];
                    const LAS f32x4* wp = (const LAS f32x4*)(cw + tap * 1536 + q * 512 + 8 * F.lane); const f32x4 w0 = wp[0] * vm, w1 = wp[1] * vm;
                    a[q][0] += bflo(u.x) * w0.x; a[q][1] += bfhi(u.x) * w0.y; a[q][2] += bflo(u.y) * w0.z; a[q][3] += bfhi(u.y) * w0.w;
                    a[q][4] += bflo(u.z) * w1.x; a[q][5] += bfhi(u.z) * w1.y; a[q][6] += bflo(u.w) * w1.z; a[q][7] += bfhi(u.w) * w1.w; } }
#pragma unroll
            for (int q = 0; q < 3; ++q) { float ss = 0.f;
#pragma unroll
                for (int i = 0; i < 8; ++i) { a[q][i] = silu_f(a[q][i]); ss += a[q][i] * a[q][i]; }
                float sc = 1.0f;
                if (q < 2) { ss = sum16(ss); sc = (1.0f / sqrtf(ss + EPS)) * (q == 0 ? 0.08838834764831845f : 1.0f); }
                v4u o; o.x = pk2(a[q][0] * sc, a[q][1] * sc); o.y = pk2(a[q][2] * sc, a[q][3] * sc); o.z = pk2(a[q][4] * sc, a[q][5] * sc); o.w = pk2(a[q][6] * sc, a[q][7] * sc);
                *(v4u*)(qkvn + (size_t)t * 1536 + q * 512 + 8 * F.lane) = o; }
            if (F.lane < 8) { const int d = F.lane >> 2, h = F.lane & 3;
                const float xg = ab[(size_t)t * 16 + d * 8 + h] + A->in[I_DTB][l * 8 + d * 4 + h];
                const float sp = xg > 20.f ? xg : log1pf(expf(xg));
                gb[(size_t)t * 8 + F.lane] = -expf(A->in[I_ALOG][l * 8 + d * 4 + h]) * sp;
                bb[(size_t)t * 8 + F.lane] = 1.0f / (1.0f + expf(-ab[(size_t)t * 16 + d * 8 + 4 + h])); }
#pragma unroll
            for (int q = 0; q < 3; ++q) { W[0][q] = W[1][q]; W[1][q] = W[2][q]; W[2][q] = W[3][q]; W[3][q] = W[4][q]; W[4][q] = N[q]; }
        }
    }
}

__device__ __forceinline__ void fold_phase(const Frame& F) {
    const bf16* ztl = (const bf16*)(F.ws + WS_ZTL); bf16* eo = (bf16*)(F.ws + WS_EO); float* zn = (float*)(F.ws + WS_ZN);
    const int lam = F.lane;
    for (int row = F.gw; row < 8 * 512; row += F.NGW) {
        const int b = row >> 9, c = row & 511;
        const bf16* zr = ztl + (size_t)row * 8192; const bf16* zi = zr + 4096;
        v4u lo_r[4], hi_r[4], lo_i[4], hi_i[4];
#pragma unroll
        for (int q = 0; q < 4; ++q) { lo_r[q] = *(const v4u*)(zr + 32 * lam + 8 * q); hi_r[q] = *(const v4u*)(zr + 4064 - 32 * lam + 8 * q);
                                      lo_i[q] = *(const v4u*)(zi + 32 * lam + 8 * q); hi_i[q] = *(const v4u*)(zi + 4064 - 32 * lam + 8 * q); }
        float Lr[32], Hr[32], Li[32], Hi[32];
#pragma unroll
        for (int q = 0; q < 4; ++q)
#pragma unroll
            for (int e = 0; e < 4; ++e) { Lr[8 * q + 2 * e] = bflo(lo_r[q][e]); Lr[8 * q + 2 * e + 1] = bfhi(lo_r[q][e]); Hr[8 * q + 2 * e] = bflo(hi_r[q][e]); Hr[8 * q + 2 * e + 1] = bfhi(hi_r[q][e]);
                                          Li[8 * q + 2 * e] = bflo(lo_i[q][e]); Li[8 * q + 2 * e + 1] = bfhi(lo_i[q][e]); Hi[8 * q + 2 * e] = bflo(hi_i[q][e]); Hi[8 * q + 2 * e + 1] = bfhi(hi_i[q][e]); }
        float mr = __shfl_up(Hr[0], 1), mi = __shfl_up(Hi[0], 1); if (lam == 0) { mr = 0.f; mi = 0.f; }
        float E[32], O[32]; float ny = 0.f;
        E[0] = Lr[0] + mr; O[0] = lam == 0 ? 0.f : Li[0] - mi;
#pragma unroll
        for (int j = 1; j < 32; ++j) { E[j] = Lr[j] + Hr[32 - j]; O[j] = Li[j] - Hi[32 - j]; }
#pragma unroll
        for (int j = 0; j < 32; ++j) ny += (j & 1) ? -(Lr[j] + Hr[j]) : (Lr[j] + Hr[j]);
        ny = wave_sum(ny);
        bf16* ep = eo + ((size_t)(b * 2) * 512 + c) * 2048 + 32 * lam; bf16* op = ep + (size_t)512 * 2048;
#pragma unroll
        for (int q = 0; q < 4; ++q) { v4u e4, o4;
            e4.x = pk2(E[8 * q], E[8 * q + 1]); e4.y = pk2(E[8 * q + 2], E[8 * q + 3]); e4.z = pk2(E[8 * q + 4], E[8 * q + 5]); e4.w = pk2(E[8 * q + 6], E[8 * q + 7]);
            o4.x = pk2(O[8 * q], O[8 * q + 1]); o4.y = pk2(O[8 * q + 2], O[8 * q + 3]); o4.z = pk2(O[8 * q + 4], O[8 * q + 5]); o4.w = pk2(O[8 * q + 6], O[8 * q + 7]);
            *(v4u*)(ep + 8 * q) = e4; *(v4u*)(op + 8 * q) = o4; }
        if (lam == 63) zn[row] = Hr[0];
        if (lam == 0) zn[4096 + row] = ny;
    }
}

__device__ __forceinline__ void ctx_dft(const Frame& F) {
    LAS float* cs = (LAS float*)F.lds;
    LAS float* sn = cs + 256;
    LAS float* Z = sn + 256;
    const bf16* ztc = (const bf16*)(F.ws + WS_ZTC); bf16* mix = (bf16*)(F.ws + WS_ACT);
    const float scale = 1.0f / sqrtf(256.0f * 128.0f);
    __syncthreads();
    if (F.tid < 256) { cs[F.tid] = cospif((float)F.tid * (1.0f / 128.0f)); sn[F.tid] = sinpif((float)F.tid * (1.0f / 128.0f)); }
    for (int item = F.vcu - 128; item < 256; item += 128) {
        const int b = item >> 5, cg = item & 31;
        __syncthreads();
        for (int i = F.tid; i < 16 * 256; i += NTHR) { const int c = i >> 8, l2 = (i & 255) * 2; const unsigned w = *(const unsigned*)(ztc + ((size_t)b * 512 + cg * 16 + c) * 512 + l2);
            Z[c * 516 + l2] = bflo(w); Z[c * 516 + l2 + 1] = bfhi(w); }
        __syncthreads();
        const int c = F.tid & 15, lp0 = F.tid >> 4;
        float acc[8];
#pragma unroll
        for (int k = 0; k < 8; ++k) acc[k] = 0.f;
#pragma unroll 2
        for (int l = 0; l < 256; ++l) { const float zr = Z[c * 516 + l], zi = Z[c * 516 + 256 + l];
#pragma unroll
            for (int k = 0; k < 8; ++k) { const int idx = (l * (lp0 + 32 * k)) & 255; acc[k] += zr * cs[idx] + zi * sn[idx]; } }
#pragma unroll
        for (int k = 0; k < 8; ++k) mix[(size_t)(NLAT + b * 256 + lp0 + 32 * k) * D + cg * 16 + c] = (bf16)f2bf(acc[k] * scale);
    }
    __syncthreads();
}

__device__ __forceinline__ void scan_naive(const Frame& F, int l) {
    LAS float* kL = (LAS float*)F.lds;
    LAS float* qL = kL + 64 * 128;
    LAS float* vL = qL + 64 * 128;
    LAS float* oL = vL + 64 * 32;
    LAS float* gL = oL + 64 * 32;
    LAS float* bL = gL + 64;
    const bf16* qkvn = (const bf16*)(F.ws + WS_QKVN);
    const float* gb = (const float*)(F.ws + WS_G); const float* bb = (const float*)(F.ws + WS_BETA);
    for (int unit = F.vcu; unit < 256; unit += F.G) {
        const int qd = unit & 3, s = unit >> 2, d = s & 1, h = (s >> 1) & 3, b = s >> 3;
        bf16* od = (bf16*)(F.ws + (d ? WS_OB : WS_OF));
        const int j = F.tid >> 4, rg = F.tid & 15;
        float S[8];
#pragma unroll
        for (int i = 0; i < 8; ++i) S[i] = 0.f;
#pragma unroll 1
        for (int ci = 0; ci < 68; ++ci) {
            int rowbase; const bool isctx = ci < 4;
            if (isctx) rowbase = NLAT + b * 256 + (d ? 3 - ci : ci) * 64; else { const int lc = ci - 4; rowbase = b * SEQ + (d ? 63 - lc : lc) * 64; }
            __syncthreads();
            for (int i = F.tid; i < 64 * 16; i += NTHR) { const int r = i >> 4, g8 = i & 15; const bf16* rp = qkvn + (size_t)(rowbase + r) * 1536 + h * 128 + g8 * 8;
                const v4u q = *(const v4u*)rp, k = *(const v4u*)(rp + 512);
                LAS float* qo = qL + r * 128 + g8 * 8; LAS float* ko = kL + r * 128 + g8 * 8;
                qo[0] = bflo(q.x); qo[1] = bfhi(q.x); qo[2] = bflo(q.y); qo[3] = bfhi(q.y); qo[4] = bflo(q.z); qo[5] = bfhi(q.z); qo[6] = bflo(q.w); qo[7] = bfhi(q.w);
                ko[0] = bflo(k.x); ko[1] = bfhi(k.x); ko[2] = bflo(k.y); ko[3] = bfhi(k.y); ko[4] = bflo(k.z); ko[5] = bfhi(k.z); ko[6] = bflo(k.w); ko[7] = bfhi(k.w); }
            if (F.tid < 256) { const int r = F.tid >> 2, g8 = F.tid & 3; const v4u v = *(const v4u*)(qkvn + (size_t)(rowbase + r) * 1536 + 1024 + h * 128 + qd * 32 + g8 * 8);
                LAS float* vo = vL + r * 32 + g8 * 8;
                vo[0] = bflo(v.x); vo[1] = bfhi(v.x); vo[2] = bflo(v.y); vo[3] = bfhi(v.y); vo[4] = bflo(v.z); vo[5] = bfhi(v.z); vo[6] = bflo(v.w); vo[7] = bfhi(v.w); }
            else if (F.tid < 320) { const int r = F.tid - 256; gL[r] = __expf(gb[(size_t)(rowbase + r) * 8 + d * 4 + h]); bL[r] = bb[(size_t)(rowbase + r) * 8 + d * 4 + h]; }
            __syncthreads();
#pragma unroll 2
            for (int st = 0; st < 64; ++st) {
                const int r = d ? 63 - st : st;
                const float alpha = gL[r], bt = bL[r];
                const f32x4 k0 = *(const LAS f32x4*)(kL + r * 128 + rg * 8), k1 = *(const LAS f32x4*)(kL + r * 128 + rg * 8 + 4);
                const f32x4 q0 = *(const LAS f32x4*)(qL + r * 128 + rg * 8), q1 = *(const LAS f32x4*)(qL + r * 128 + rg * 8 + 4);
                float part = (k0.x * S[0] + k0.y * S[1]) + (k0.z * S[2] + k0.w * S[3]) + (k1.x * S[4] + k1.y * S[5]) + (k1.z * S[6] + k1.w * S[7]);
                part = sum16(part);
                const float dl = bt * (vL[r * 32 + j] - alpha * part);
                S[0] = alpha * S[0] + k0.x * dl; S[1] = alpha * S[1] + k0.y * dl; S[2] = alpha * S[2] + k0.z * dl; S[3] = alpha * S[3] + k0.w * dl;
                S[4] = alpha * S[4] + k1.x * dl; S[5] = alpha * S[5] + k1.y * dl; S[6] = alpha * S[6] + k1.z * dl; S[7] = alpha * S[7] + k1.w * dl;
                float op = (q0.x * S[0] + q0.y * S[1]) + (q0.z * S[2] + q0.w * S[3]) + (q1.x * S[4] + q1.y * S[5]) + (q1.z * S[6] + q1.w * S[7]);
                op = sum16(op);
                if (rg == 0) oL[r * 32 + j] = op;
            }
            __syncthreads();
            if (!(isctx && l == NL - 1)) { const int r = F.tid >> 3, g4 = F.tid & 7; const LAS float* op = oL + r * 32 + g4 * 4;
                v2u w; w.x = pk2(op[0], op[1]); w.y = pk2(op[2], op[3]);
                *(v2u*)(od + (size_t)(rowbase + r) * 512 + h * 128 + qd * 32 + g4 * 4) = w; }
        }
        __syncthreads();
    }
}

__device__ __forceinline__ void gated_out(const Frame& F, int l) {
    const KArgsP A = kargs();
    const bf16* of = (const bf16*)(F.ws + WS_OF); const bf16* ob = (const bf16*)(F.ws + WS_OB); const bf16* qkvz = (const bf16*)(F.ws + WS_QKVZ);
    const bf16* ab2 = (const bf16*)(F.ws + WS_AB2); const float* zn = (const float*)(F.ws + WS_ZN);
    bf16* mix = (bf16*)(F.ws + WS_ACT);
    const int nrows = l == NL - 1 ? NLAT : MT;
    const float fsc = 1.0f / sqrtf(4096.0f * 128.0f);
    const f32x4 g0 = *(const f32x4*)(A->in[I_GOUT] + l * 128 + (F.lane & 15) * 8), g1 = *(const f32x4*)(A->in[I_GOUT] + l * 128 + (F.lane & 15) * 8 + 4);
    for (int t = F.gw; t < nrows; t += F.NGW) {
        const v4u a = *(const v4u*)(of + (size_t)t * 512 + 8 * F.lane), b = *(const v4u*)(ob + (size_t)t * 512 + 8 * F.lane), z = *(const v4u*)(qkvz + (size_t)t * 2048 + 1536 + 8 * F.lane);
        if (t < NLAT) {
            const int bb_ = t >> 12, lp = t & 4095, k = lp <= 2048 ? lp : 4096 - lp;
            float y[8];
            if (k == 2048) { const f32x4 n0 = *(const f32x4*)(zn + 4096 + bb_ * 512 + 8 * F.lane), n1 = *(const f32x4*)(zn + 4096 + bb_ * 512 + 8 * F.lane + 4);
                y[0] = n0.x; y[1] = n0.y; y[2] = n0.z; y[3] = n0.w; y[4] = n1.x; y[5] = n1.y; y[6] = n1.z; y[7] = n1.w; }
            else { const v4u pa = *(const v4u*)(ab2 + ((size_t)(bb_ * 2) * 2048 + k) * 512 + 8 * F.lane), pb_ = *(const v4u*)(ab2 + ((size_t)(bb_ * 2 + 1) * 2048 + k) * 512 + 8 * F.lane);
                const f32x4 z0 = *(const f32x4*)(zn + bb_ * 512 + 8 * F.lane), z1 = *(const f32x4*)(zn + bb_ * 512 + 8 * F.lane + 4);
                const float sg = lp <= 2048 ? 1.0f : -1.0f, sz = (k & 1) ? -1.0f : 1.0f;
                y[0] = bflo(pa.x) + sg * bflo(pb_.x) + sz * z0.x; y[1] = bfhi(pa.x) + sg * bfhi(pb_.x) + sz * z0.y; y[2] = bflo(pa.y) + sg * bflo(pb_.y) + sz * z0.z; y[3] = bfhi(pa.y) + sg * bfhi(pb_.y) + sz * z0.w;
                y[4] = bflo(pa.z) + sg * bflo(pb_.z) + sz * z1.x; y[5] = bfhi(pa.z) + sg * bfhi(pb_.z) + sz * z1.y; y[6] = bflo(pa.w) + sg * bflo(pb_.w) + sz * z1.z; y[7] = bfhi(pa.w) + sg * bfhi(pb_.w) + sz * z1.w; }
            v4u wy; wy.x = pk2(y[0] * fsc, y[1] * fsc); wy.y = pk2(y[2] * fsc, y[3] * fsc); wy.z = pk2(y[4] * fsc, y[5] * fsc); wy.w = pk2(y[6] * fsc, y[7] * fsc);
            *(v4u*)(mix + (size_t)t * D + 8 * F.lane) = wy;
        }
        float o[8] = {bflo(a.x) + bflo(b.x), bfhi(a.x) + bfhi(b.x), bflo(a.y) + bflo(b.y), bfhi(a.y) + bfhi(b.y), bflo(a.z) + bflo(b.z), bfhi(a.z) + bfhi(b.z), bflo(a.w) + bflo(b.w), bfhi(a.w) + bfhi(b.w)};
        const float zz[8] = {bflo(z.x), bfhi(z.x), bflo(z.y), bfhi(z.y), bflo(z.z), bfhi(z.z), bflo(z.w), bfhi(z.w)};
        const float gg[8] = {g0.x, g0.y, g0.z, g0.w, g1.x, g1.y, g1.z, g1.w};
        float ss = 0.f;
#pragma unroll
        for (int i = 0; i < 8; ++i) ss += o[i] * o[i];
        const float rs = 1.0f / sqrtf(sum16(ss) * (1.0f / 128.0f) + EPS);
#pragma unroll
        for (int i = 0; i < 8; ++i) o[i] = o[i] * rs * gg[i] * silu_f(zz[i]);
        v4u w; w.x = pk2(o[0], o[1]); w.y = pk2(o[2], o[3]); w.z = pk2(o[4], o[5]); w.w = pk2(o[6], o[7]);
        *(v4u*)(mix + (size_t)t * D + 512 + 8 * F.lane) = w;
    }
}

__device__ __forceinline__ void router_phase(const Frame& F, int l, int bank = 0) {
    const KArgsP A = kargs();
    LAS float* wr = (LAS float*)F.lds;
    LAS int* lcnt = (LAS int*)(F.lds + XT_OFF);
    LAS int* lbase = lcnt + 32;
    LAS int* sE = lbase + 32;
    LAS int* sP = sE + 136 * 4;
    LAS float* sG = (LAS float*)(sP + 136 * 4);
    const int nrows = l == NL - 1 ? NLAT : MT, rpb = nrows / 256;
    { const f32x4* src = (const f32x4*)((const float*)(F.ws + WS_WRT) + (size_t)l * NEXP * D);
      for (int i = F.tid; i < NEXP * D / 4; i += NTHR) ((LAS f32x4*)wr)[i] = src[i];
      if (F.tid < 32) lcnt[F.tid] = 0; }
    __syncthreads();
    bf16* h2 = (bf16*)(F.ws + WS_ACT);
    const int row0 = F.vcu * rpb;
    if (F.vcu < 256) {
    for (int rl = F.wave; rl < rpb; rl += NWAVES) {
        const int t = row0 + rl, r = mod_row(t);
        const float* xr = xr_row(F, t);
        f32x4 v[4]; float ss = 0.f;
#pragma unroll
        for (int j = 0; j < 4; ++j) { v[j] = *((const f32x4*)xr + F.lane + 64 * j); ss += (v[j].x * v[j].x + v[j].y * v[j].y) + (v[j].z * v[j].z + v[j].w * v[j].w); }
        const float rstd = 1.0f / sqrtf(wave_sum(ss) * (1.0f / D) + EPS);
        const f32x4* g2 = (const f32x4*)(A->in[I_GN2] + (size_t)l * D) + F.lane;
        const f32x4* sh = (const f32x4*)modv(F, l, r, 3) + F.lane; const f32x4* scl = (const f32x4*)modv(F, l, r, 4) + F.lane;
        v2u* ho = (v2u*)(h2 + (size_t)t * D) + F.lane;
#pragma unroll
        for (int j = 0; j < 4; ++j) { v[j] = v[j] * rstd * g2[64 * j] * (scl[64 * j] + 1.0f) + sh[64 * j]; v2u w; w.x = pk2(v[j].x, v[j].y); w.y = pk2(v[j].z, v[j].w); ho[64 * j] = w; }
        float pe[32];
        int lofs = F.lane; asm volatile("" : "+v"(lofs));
#pragma unroll
        for (int e = 0; e < NEXP; ++e) { float p = 0.f;
#pragma unroll
            for (int j = 0; j < 4; ++j) { const f32x4 w = ((const LAS f32x4*)(wr + e * D))[lofs + 64 * j]; p += (v[j].x * w.x + v[j].y * w.y) + (v[j].z * w.z + v[j].w * w.w); }
            pe[e] = p; if ((e & 3) == 3) asm volatile("" ::: "memory"); }
        float lg = rs32(pe, F.lane) + A->in[I_BR][l * NEXP + (F.lane >> 1)];
        if (F.lane & 1) lg = -3.0e38f;
        int se[4]; float sv[4];
#pragma unroll
        for (int k = 0; k < 4; ++k) { float m = lg;
#pragma unroll
            for (int o = 1; o < 64; o <<= 1) m = fmaxf(m, __shfl_xor(m, o));
            const unsigned long long bal = __ballot(lg == m); const int idx = __ffsll((long long)bal) - 1;
            se[k] = idx >> 1; sv[k] = m; if (F.lane == idx) lg = -3.0e38f; }
        const float e1 = __expf(sv[1] - sv[0]), e2 = __expf(sv[2] - sv[0]), e3 = __expf(sv[3] - sv[0]), inv = 1.0f / (1.0f + e1 + e2 + e3);
        if (F.lane == 0) {
            const float gt[4] = {inv, e1 * inv, e2 * inv, e3 * inv};
#pragma unroll
            for (int k = 0; k < 4; ++k) { sE[rl * 4 + k] = se[k]; sP[rl * 4 + k] = __hip_atomic_fetch_add(lcnt + se[k], 1, __ATOMIC_RELAXED, __HIP_MEMORY_SCOPE_WORKGROUP); sG[rl * 4 + k] = gt[k]; } }
    }
    }
    __syncthreads();
    if (F.tid < 32) { const int n = lcnt[F.tid]; lbase[F.tid] = n ? (int)__hip_atomic_fetch_add(F.ctl + CW_GCNT + ((bank * 2 + l) * 32 + F.tid) * 64, (unsigned)n, RLX_AGENT) : 0; }
    __syncthreads();
    if (F.vcu < 256) {
        int* sele = (int*)(F.ws + WS_SELE); int* selp = (int*)(F.ws + WS_SELP); float* selg = (float*)(F.ws + WS_SELG);
        for (int i = F.tid; i < rpb * 4; i += NTHR) { const int e = sE[i]; sele[(size_t)row0 * 4 + i] = e; selp[(size_t)row0 * 4 + i] = lbase[e] + sP[i]; selg[(size_t)row0 * 4 + i] = sG[i]; }
    }
}
__device__ __forceinline__ void moe_layout(const Frame& F, int l, LAS int* pend, LAS int* pstart) {
    __syncthreads();
    if (F.tid == 0) { int acc = 0;
        for (int e = 0; e < NEXP; ++e) { const int n = (int)__hip_atomic_load(F.ctl + CW_GCNT + (l * 32 + e) * 64, RLX_AGENT); pstart[e] = acc * 256; acc += (n + 255) >> 8; pend[e] = acc; } }
    __syncthreads();
}
__device__ __forceinline__ void gather_phase(const Frame& F, int l, bool dummy = false) {
    LAS int* pend = (LAS int*)(F.lds + XT_OFF); LAS int* pstart = pend + 32;
    moe_layout(F, l, pend, pstart);
    const int nrows = l == NL - 1 ? NLAT : MT;
    const int* sele = (const int*)(F.ws + WS_SELE); int* selp = (int*)(F.ws + WS_SELP);
    unsigned* goff = (unsigned*)(F.ws + WS_GOFF);
    for (int it = F.gw; it < nrows * 4; it += F.NGW) {
        const int t = it >> 2, e = sele[it], dst = pstart[e] + selp[it];
        if (F.lane < 8) { const int pm = dst >> 8, h = (dst >> 7) & 1, R = dst & 127, b = pg8::lds_byte(R, 8 * F.lane);
            goff[((size_t)pm * 512 + ((b & 8191) >> 4)) * 4 + h * 2 + (b >> 13)] = (unsigned)(t * 2048 + 16 * F.lane); }
        if (F.lane == 0 && !dummy) selp[it] = dst;
    }
}

constexpr size_t WS_PW = WS_OB + 34 * MiB;
constexpr size_t WS_PKET = WS_PW + 68 * MiB;
constexpr size_t WS_PUT = WS_PKET + 68 * MiB;
constexpr size_t WS_PATT = WS_PUT + 68 * MiB;
constexpr size_t WS_PGAM = WS_PATT + 34 * MiB;
static_assert(WS_PGAM + 6 * MiB <= WS_END, "prep map");
typedef short bf16x8_t __attribute__((ext_vector_type(8)));
#define MFMA16(a, b, c) __builtin_amdgcn_mfma_f32_16x16x32_bf16((a), (b), (c), 0, 0, 0)
__device__ __forceinline__ v2u pack4(const f32x4 v) { v2u w; w.x = pk2(v.x, v.y); w.y = pk2(v.z, v.w); return w; }
__device__ __forceinline__ int chunk_rowbase(int b, int cn) { return cn < 4 ? NLAT + b * CTXL + cn * 64 : b * SEQ + (cn - 4) * 64; }

__device__ __forceinline__ void prep_phase(const Frame& F) {
    LAS bf16* k_rm = (LAS bf16*)F.lds;
    LAS bf16* q_rm = k_rm + 64 * 136;
    LAS bf16* kT = (LAS bf16*)(F.lds + 36864);
    LAS bf16* vT = kT + 128 * 72;
    LAS float* Gm = (LAS float*)(F.lds + 36864 + 36864);
    LAS float* A0 = Gm + 64 * 72;
    LAS float* bs = (LAS float*)(F.lds + 36864 + 36864 + 36864);
    LAS float* gam = bs + 128;
    const bf16* qkvn = (const bf16*)(F.ws + WS_QKVN);
    const float* gb = (const float*)(F.ws + WS_G); const float* bb = (const float*)(F.ws + WS_BETA);
    const int w = F.wave;
    v4u ld[2][3];
    {
        int tid_ = F.tid; asm volatile("" : "+v"(tid_));
        const int unit = F.vcu;
        if (unit < 32 * 68) { const int bh = unit / 68, cn = unit % 68, rowbase = chunk_rowbase(bh >> 2, cn);
#pragma unroll
            for (int it = 0; it < 2; ++it) { const int p = tid_ + it * NTHR, i = p & 63, c8 = p >> 6; const bf16* rp = qkvn + (size_t)(rowbase + i) * 1536 + (bh & 3) * 128 + c8 * 8;
                ld[it][0] = *(const v4u*)rp; ld[it][1] = *(const v4u*)(rp + 512); ld[it][2] = *(const v4u*)(rp + 1024); } }
    }
    for (int unit = F.vcu; unit < 32 * 68; unit += F.G) {
        int tid_ = F.tid; asm volatile("" : "+v"(tid_));
        const int tid = tid_, lane = tid & 63, l15 = lane & 15, l4 = lane >> 4;
        const int bh = unit / 68, cn = unit % 68, b = bh >> 2, h = bh & 3, rowbase = chunk_rowbase(b, cn);
        const size_t pu = (size_t)(bh * 68 + cn) * 2;
        __syncthreads();
#pragma unroll
        for (int it = 0; it < 2; ++it) { const int p = tid + it * NTHR, i = p & 63, c8 = p >> 6;
            const v4u qv = ld[it][0], kv = ld[it][1], vv = ld[it][2];
            *(LAS v4u*)(q_rm + i * 136 + c8 * 8) = qv; *(LAS v4u*)(k_rm + i * 136 + c8 * 8) = kv;
#pragma unroll
            for (int e = 0; e < 4; ++e) { const unsigned kw = kv[e], vw = vv[e];
                kT[(c8 * 8 + 2 * e) * 72 + i] = (bf16)(kw & 0xffffu); kT[(c8 * 8 + 2 * e + 1) * 72 + i] = (bf16)(kw >> 16);
                vT[(c8 * 8 + 2 * e) * 72 + i] = (bf16)(vw & 0xffffu); vT[(c8 * 8 + 2 * e + 1) * 72 + i] = (bf16)(vw >> 16); } }
        if (w < 2) { const int d = w; float g = gb[(size_t)(rowbase + lane) * 8 + d * 4 + h]; bs[d * 64 + lane] = bb[(size_t)(rowbase + lane) * 8 + d * 4 + h];
            if (d == 0) {
#pragma unroll
                for (int o = 1; o < 64; o <<= 1) { const float t = __shfl_up(g, o); if (lane >= o) g += t; } }
            else {
#pragma unroll
                for (int o = 1; o < 64; o <<= 1) { const float t = __shfl_down(g, o); if (lane + o < 64) g += t; } }
            gam[d * 64 + lane] = g; }
        {
            const int un = unit + F.G;
            if (un < 32 * 68) { const int bh2 = un / 68, cn2 = un % 68, rb2 = chunk_rowbase(bh2 >> 2, cn2);
#pragma unroll
                for (int it = 0; it < 2; ++it) { const int p = tid + it * NTHR, i = p & 63, c8 = p >> 6; const bf16* rp = qkvn + (size_t)(rb2 + i) * 1536 + (bh2 & 3) * 128 + c8 * 8;
                    ld[it][0] = *(const v4u*)rp; ld[it][1] = *(const v4u*)(rp + 512); ld[it][2] = *(const v4u*)(rp + 1024); } }
        }
        __syncthreads();
#pragma unroll
        for (int tt = 0; tt < 2; ++tt) { const int idx = 2 * w + tt, ti = idx >> 2, tj = idx & 3;
            f32x4 aG = {0.f, 0.f, 0.f, 0.f}, aA = {0.f, 0.f, 0.f, 0.f};
#pragma unroll
            for (int ks = 0; ks < 4; ++ks) { const int co = 32 * ks + 8 * l4;
                const bf16x8_t bk = *(const LAS bf16x8_t*)(k_rm + (16 * tj + l15) * 136 + co), ak = *(const LAS bf16x8_t*)(k_rm + (16 * ti + l15) * 136 + co), aq = *(const LAS bf16x8_t*)(q_rm + (16 * ti + l15) * 136 + co);
                aG = MFMA16(ak, bk, aG); aA = MFMA16(aq, bk, aA); }
#pragma unroll
            for (int r = 0; r < 4; ++r) { Gm[(16 * ti + 4 * l4 + r) * 72 + 16 * tj + l15] = aG[r]; A0[(16 * ti + 4 * l4 + r) * 72 + 16 * tj + l15] = aA[r]; } }
        __syncthreads();
        for (int idx = tid; idx < 8192; idx += NTHR) { const int d = idx >> 12, ip = (idx >> 6) & 63, jp = idx & 63, i = d ? 63 - ip : ip, j = d ? 63 - jp : jp;
            ((LAS float*)(F.lds + d * 18432))[idx & 4095] = jp < ip ? bs[d * 64 + i] * Gm[i * 72 + j] * __expf(gam[d * 64 + i] - gam[d * 64 + j]) : 0.f; }
        __syncthreads();
        if (w < 2) {
            const int d = w; const LAS float* Lr = (const LAS float*)(F.lds + d * 18432);
            float t[64];
#pragma unroll
            for (int ip = 0; ip < 64; ++ip) {
                float a0 = (lane == ip) ? 1.f : 0.f, a1 = 0.f;
#pragma unroll
                for (int j4 = 0; j4 < (ip + 3) / 4; ++j4) { const f32x4 Lv = *(const LAS f32x4*)(Lr + ip * 64 + 4 * j4);
                    if (4 * j4 + 0 < ip) a0 -= Lv.x * t[4 * j4 + 0];
                    if (4 * j4 + 1 < ip) a1 -= Lv.y * t[4 * j4 + 1];
                    if (4 * j4 + 2 < ip) a0 -= Lv.z * t[4 * j4 + 2];
                    if (4 * j4 + 3 < ip) a1 -= Lv.w * t[4 * j4 + 3]; }
                t[ip] = a0 + a1; if (ip & 1) asm volatile("" ::: "memory"); }
            const int jn = d ? 63 - lane : lane; const float bj = bs[d * 64 + jn], bge = bj * __expf(gam[d * 64 + jn]);
            asm volatile("s_waitcnt lgkmcnt(0)" ::: "memory");
            LAS bf16* Tu = (LAS bf16*)(F.lds + d * 18432); LAS bf16* Tw = Tu + 64 * 72;
#pragma unroll
            for (int ip = 0; ip < 64; ++ip) { const int in = d ? 63 - ip : ip; Tu[in * 72 + jn] = (bf16)f2bf(t[ip] * bj); Tw[in * 72 + jn] = (bf16)f2bf(t[ip] * bge); }
        } else {
            const int t6 = tid - 128;
            for (int it = t6; it < 1024; it += NTHR - 128) { const int d = it >> 9, i = (it >> 3) & 63, j0 = (it & 7) * 8; float v[8];
#pragma unroll
                for (int e = 0; e < 8; ++e) { const int j = j0 + e; const bool in = d ? (j >= i) : (j <= i); v[e] = in ? A0[i * 72 + j] * __expf(gam[d * 64 + i] - gam[d * 64 + j]) : 0.f; }
                v4u o; o.x = pk2(v[0], v[1]); o.y = pk2(v[2], v[3]); o.z = pk2(v[4], v[5]); o.w = pk2(v[6], v[7]);
                *(v4u*)((bf16*)(F.ws + WS_PATT) + (pu + d) * 4096 + ((((i >> 4) * 2 + (j0 >> 5)) * 16 + (i & 15)) * 32 + (j0 & 31))) = o; }
            for (int it = t6; it < 2048; it += NTHR - 128) { const int d = it >> 10, dk = (it >> 3) & 127, j0 = (it & 7) * 8; const float gl = d ? gam[64] : gam[63]; float v[8];
                const v4u kk = *(const LAS v4u*)(kT + dk * 72 + j0);
                v[0] = bflo(kk.x); v[1] = bfhi(kk.x); v[2] = bflo(kk.y); v[3] = bfhi(kk.y); v[4] = bflo(kk.z); v[5] = bfhi(kk.z); v[6] = bflo(kk.w); v[7] = bfhi(kk.w);
#pragma unroll
                for (int e = 0; e < 8; ++e) v[e] *= __expf(gl - gam[d * 64 + j0 + e]);
                v4u o; o.x = pk2(v[0], v[1]); o.y = pk2(v[2], v[3]); o.z = pk2(v[4], v[5]); o.w = pk2(v[6], v[7]);
                *(v4u*)((bf16*)(F.ws + WS_PKET) + (pu + d) * 8192 + ((((dk >> 4) * 2 + (j0 >> 5)) * 16 + (dk & 15)) * 32 + (j0 & 31))) = o; }
            if (t6 < 128) ((float*)(F.ws + WS_PGAM))[(pu + (t6 >> 6)) * 64 + (t6 & 63)] = gam[t6];
        }
        __syncthreads();
        {
            const int d = w >> 2, ww = w & 3;
            const LAS bf16* Tu = (const LAS bf16*)(F.lds + d * 18432); const LAS bf16* Tw = Tu + 64 * 72;
            bf16x8_t tu[2], tw[2];
#pragma unroll
            for (int ks = 0; ks < 2; ++ks) { tu[ks] = *(const LAS bf16x8_t*)(Tu + (16 * ww + l15) * 72 + 32 * ks + 8 * l4); tw[ks] = *(const LAS bf16x8_t*)(Tw + (16 * ww + l15) * 72 + 32 * ks + 8 * l4); }
            bf16* ut = (bf16*)(F.ws + WS_PUT) + (pu + d) * 8192; bf16* wg = (bf16*)(F.ws + WS_PW) + (pu + d) * 8192;
#pragma unroll 2
            for (int tj = 0; tj < 8; ++tj) {
                f32x4 au = {0.f, 0.f, 0.f, 0.f}, aw = {0.f, 0.f, 0.f, 0.f};
#pragma unroll
                for (int ks = 0; ks < 2; ++ks) { const bf16x8_t bv = *(const LAS bf16x8_t*)(vT + (16 * tj + l15) * 72 + 32 * ks + 8 * l4), ak = *(const LAS bf16x8_t*)(kT + (16 * tj + l15) * 72 + 32 * ks + 8 * l4);
                    au = MFMA16(tu[ks], bv, au); aw = MFMA16(ak, tw[ks], aw); }
                *(v2u*)(ut + (((((tj >> 2) * 16 + l15) * 4 + ww) * 4 + l4) * 4 + (tj & 3)) * 4) = pack4(au);
                *(v2u*)(wg + ((ww * 4 + (tj >> 1)) * 16 + l15) * 32 + 16 * (tj & 1) + 4 * l4) = pack4(aw);
            }
        }
    }
    __syncthreads();
}

struct ScanRegs { bf16x8_t fa[4], fx[2], kf[2]; float graw, glast; int rowbase, cn; };
__device__ __forceinline__ void scan_load(ScanRegs& R, const unsigned char* ws, int ci_in, int b, int bh, int h, int d, int s, int w, int l15, int l4) {
    const int ci = ci_in < 68 ? ci_in : 67, rt = w & 3;
    const int cn = ci < 4 ? (d ? 3 - ci : ci) : 4 + (d ? 67 - ci : ci - 4);
    R.cn = cn; R.rowbase = chunk_rowbase(b, cn);
    const size_t pu = (size_t)(bh * 68 + cn) * 2 + d;
    const float* gmp = (const float*)(ws + WS_PGAM) + pu * 64;
    R.glast = gmp[d ? 0 : 63]; R.graw = gmp[16 * rt + l15];
    const bf16* ket = (const bf16*)(ws + WS_PKET) + pu * 8192 + ((w * 2) * 16 + l15) * 32 + 8 * l4;
    R.kf[0] = *(const bf16x8_t*)ket; R.kf[1] = *(const bf16x8_t*)(ket + 512);
    const bf16* wp = (const bf16*)(ws + WS_PW) + pu * 8192 + ((rt * 4) * 16 + l15) * 32 + 8 * l4;
    const bf16* qp = (const bf16*)(ws + WS_QKVN) + (size_t)(R.rowbase + 16 * rt + l15) * 1536 + h * 128 + 8 * l4;
    const bf16* ap_ = w < 4 ? wp : qp; const int kst = w < 4 ? 512 : 32;
#pragma unroll
    for (int ks = 0; ks < 4; ++ks) R.fa[ks] = *(const bf16x8_t*)(ap_ + kst * ks);
    const bf16* up = (const bf16*)(ws + WS_PUT) + pu * 8192 + ((((s * 16 + l15) * 4 + rt) * 4 + l4) * 16);
    const bf16* ap = (const bf16*)(ws + WS_PATT) + pu * 4096 + ((rt * 2) * 16 + l15) * 32 + 8 * l4;
    const bf16* xp = w < 4 ? up : ap; const int xo = w < 4 ? 8 : 512;
    R.fx[0] = *(const bf16x8_t*)xp; R.fx[1] = *(const bf16x8_t*)(xp + xo);
}
#if defined(PROBE_SCAN) && PROBE_SCAN >= 2
#define SCAN_SYNC(n) do { const unsigned long long t0_ = __builtin_amdgcn_s_memrealtime(); __syncthreads(); if (PROBE_SCAN == 2 || PROBE_SCAN == 2 + (n)) g_pacc += __builtin_amdgcn_s_memrealtime() - t0_; } while (0)
#else
#define SCAN_SYNC(n) __syncthreads()
#endif
__device__ __forceinline__ void scan_step(const ScanRegs& R, f32x4 (&S)[4], LAS bf16* ST, LAS bf16* vnT, LAS bf16* oS, bf16* od, bf16* dump, bool skip_ctx_out, int h, int s, int w, int l15, int l4, int tid, unsigned long long& g_pacc) {
#if defined(PROBE_SCAN) && PROBE_SCAN == 6
    const unsigned long long tp0_ = __builtin_amdgcn_s_memrealtime();
#endif
    const int rt = w & 3;
    const float gend = __expf(R.glast), eg = w < 4 ? 1.0f : __expf(R.graw);
    bf16x8_t fa[4];
#pragma unroll
    for (int ks = 0; ks < 4; ++ks) fa[ks] = R.fa[ks];
#if defined(PROBE_SCAN) && PROBE_SCAN == 5
    const unsigned long long tq0_ = __builtin_amdgcn_s_memrealtime();
#endif
    if (w >= 4) {
#pragma unroll
        for (int ks = 0; ks < 4; ++ks) { const v4u qv = __builtin_bit_cast(v4u, R.fa[ks]); v4u o;
            o.x = pk2(bflo(qv.x) * eg, bfhi(qv.x) * eg); o.y = pk2(bflo(qv.y) * eg, bfhi(qv.y) * eg); o.z = pk2(bflo(qv.z) * eg, bfhi(qv.z) * eg); o.w = pk2(bflo(qv.w) * eg, bfhi(qv.w) * eg);
            fa[ks] = __builtin_bit_cast(bf16x8_t, o); } }
#if defined(PROBE_SCAN) && PROBE_SCAN == 5
    asm volatile("" :: "v"(fa[0]), "v"(fa[1]), "v"(fa[2]), "v"(fa[3])); g_pacc += __builtin_amdgcn_s_memrealtime() - tq0_;
#endif
    f32x4 c[4];
#pragma unroll
    for (int ct = 0; ct < 4; ++ct) { c[ct] = (f32x4){0.f, 0.f, 0.f, 0.f};
#pragma unroll
        for (int ks = 0; ks < 4; ++ks) { const bf16x8_t bq = *(const LAS bf16x8_t*)(ST + (16 * ct + l15) * 136 + 32 * ks + 8 * l4); c[ct] = MFMA16(fa[ks], bq, c[ct]); } }
    {
        const v4u ua = __builtin_bit_cast(v4u, R.fx[0]), ub = __builtin_bit_cast(v4u, R.fx[1]);
        const f32x4 u0 = {bflo(ua.x), bfhi(ua.x), bflo(ua.y), bfhi(ua.y)}, u1 = {bflo(ua.z), bfhi(ua.z), bflo(ua.w), bfhi(ua.w)};
        const f32x4 u2 = {bflo(ub.x), bfhi(ub.x), bflo(ub.y), bfhi(ub.y)}, u3 = {bflo(ub.z), bfhi(ub.z), bflo(ub.w), bfhi(ub.w)};
        LAS bf16* vp = vnT + (w < 4 ? 0 : 64 * 72) + l15 * 72 + 16 * rt + 4 * l4;
        *(LAS v2u*)(vp) = pack4(u0 - c[0]); *(LAS v2u*)(vp + 16 * 72) = pack4(u1 - c[1]); *(LAS v2u*)(vp + 32 * 72) = pack4(u2 - c[2]); *(LAS v2u*)(vp + 48 * 72) = pack4(u3 - c[3]);
    }
#if defined(PROBE_SCAN) && PROBE_SCAN == 6
    asm volatile("s_waitcnt lgkmcnt(0)" ::: "memory"); g_pacc += __builtin_amdgcn_s_memrealtime() - tp0_;
#endif
    SCAN_SYNC(1);
    {
        LAS bf16* op = oS + (w < 4 ? 64 * 72 : 0) + (16 * rt + 4 * l4) * 72 + l15;
#pragma unroll
        for (int ct = 0; ct < 4; ++ct) { const bf16x8_t v0 = *(const LAS bf16x8_t*)(vnT + (16 * ct + l15) * 72 + 8 * l4), v1 = *(const LAS bf16x8_t*)(vnT + (16 * ct + l15) * 72 + 32 + 8 * l4);
            f32x4 o = MFMA16(R.fx[0], v0, c[ct]); o = MFMA16(R.fx[1], v1, o);
#pragma unroll
            for (int r = 0; r < 4; ++r) op[r * 72 + 16 * ct] = (bf16)f2bf(o[r]);
            f32x4 sn = S[ct] * gend; sn = MFMA16(R.kf[0], v0, sn); sn = MFMA16(R.kf[1], v1, sn); S[ct] = sn;
            *(LAS v2u*)(ST + (16 * ct + l15) * 136 + 16 * w + 4 * l4) = pack4(sn); }
    }
    SCAN_SYNC(2);
    {
        const int i = tid >> 3, pc = tid & 7;
        const v4u ov = *(const LAS v4u*)(oS + i * 72 + pc * 8);
        const bool real = !(R.cn < 4 && skip_ctx_out);
        bf16* gp = real ? od + (size_t)(R.rowbase + i) * 512 + h * 128 + 64 * s + pc * 8 : dump + (size_t)i * 64 + pc * 8;
        *(v4u*)gp = ov;
    }
}
__device__ __forceinline__ void scan_mfma(const Frame& F, int l) {
    LAS bf16* ST = (LAS bf16*)F.lds;
    LAS bf16* vnT = ST + 64 * 136;
    LAS bf16* oS = vnT + 2 * 64 * 72;
    const int lane = F.lane, l15 = lane & 15, l4 = lane >> 4, w = F.wave;
    const bool skip_ctx_out = (l == NL - 1);
    if (w >= 4) __builtin_amdgcn_s_setprio(1);
    for (int unit = F.vcu; unit < 128; unit += F.G) {
        const int s = unit & 1, sd = unit >> 1, d = sd & 1, bh = sd >> 1, b = bh >> 2, h = bh & 3;
        bf16* od = (bf16*)(F.ws + (d ? WS_OB : WS_OF)); bf16* dump = (bf16*)(F.ws + WS_PGAM + 1536 * 1024) + (size_t)unit * 16 * 512;
        __syncthreads();
        for (int i = F.tid; i < 64 * 136 / 2; i += NTHR) ((LAS unsigned*)ST)[i] = 0u;
        f32x4 S[4];
#pragma unroll
        for (int ct = 0; ct < 4; ++ct) S[ct] = (f32x4){0.f, 0.f, 0.f, 0.f};
        ScanRegs R0, R1, R2;
        scan_load(R0, F.ws, 0, b, bh, h, d, s, w, l15, l4); scan_load(R1, F.ws, 1, b, bh, h, d, s, w, l15, l4); scan_load(R2, F.ws, 2, b, bh, h, d, s, w, l15, l4);
        __syncthreads();
        unsigned long long pacc = 0ull;
#pragma unroll 1
        for (int ci = 0; ci < 66; ci += 3) {
#if defined(PROBE_SCAN) && PROBE_SCAN == 1
            { const unsigned long long t0 = __builtin_amdgcn_s_memrealtime(); asm volatile("s_waitcnt vmcnt(0)" ::: "memory"); pacc += __builtin_amdgcn_s_memrealtime() - t0; }
#endif
            scan_step(R0, S, ST, vnT, oS, od, dump, skip_ctx_out, h, s, w, l15, l4, F.tid, pacc); scan_load(R0, F.ws, ci + 3, b, bh, h, d, s, w, l15, l4);
            scan_step(R1, S, ST, vnT, oS, od, dump, skip_ctx_out, h, s, w, l15, l4, F.tid, pacc); scan_load(R1, F.ws, ci + 4, b, bh, h, d, s, w, l15, l4);
            scan_step(R2, S, ST, vnT, oS, od, dump, skip_ctx_out, h, s, w, l15, l4, F.tid, pacc); scan_load(R2, F.ws, ci + 5, b, bh, h, d, s, w, l15, l4);
        }
        scan_step(R0, S, ST, vnT, oS, od, dump, skip_ctx_out, h, s, w, l15, l4, F.tid, pacc);
        scan_step(R1, S, ST, vnT, oS, od, dump, skip_ctx_out, h, s, w, l15, l4, F.tid, pacc);
   #ifdef PROBE_SCAN
        if (F.vcu == 0 && F.tid == PROBE_TID) *(unsigned long long*)(F.ws + WS_ZN + 48 * 1024) += pacc;
#endif
    }
    __builtin_amdgcn_s_setprio(0);
}

#ifndef USE_NAIVE_SCAN
#define USE_NAIVE_SCAN 0
#endif
#ifndef REP_MASK
#define REP_MASK 0
#endif
#define REPS(p) for (int _r = 0; _r < 1 + ((REP_MASK >> (p)) & 1); ++_r)
#define LASTREP(p) (_r == ((REP_MASK >> (p)) & 1))
constexpr int PH_PER_LAYER = 11, N_PHASES = 2 + NL * PH_PER_LAYER;
#ifndef PG8_SP2
#define PG8_SP2 true
#endif
#ifndef PG8_ALIGN
#define PG8_ALIGN true
#endif
__device__ __forceinline__ Frame make_frame(int wv) {
    extern __shared__ __attribute__((aligned(16))) unsigned char lds[];
    const KArgsP A = kargs();
    Frame F;
    { unsigned lb = (unsigned)(uintptr_t)(LAS unsigned char*)lds; asm volatile("" : "+s"(lb)); F.lds = (LAS unsigned char*)(uintptr_t)lb; }
    F.MISC = (volatile LAS unsigned*)(F.lds + MISC_OFF);
    { unsigned m1 = ~0u; asm volatile("" : "+s"(m1)); int ln = (int)__builtin_amdgcn_mbcnt_hi(m1, __builtin_amdgcn_mbcnt_lo(m1, 0u)); asm volatile("" : "+v"(ln)); F.lane = ln; }
    { int w_ = wv; asm volatile("" : "+s"(w_)); F.wave = w_; } F.tid = F.wave * 64 + F.lane;
    F.G = gridDim.x; { const int bx = blockIdx.x; F.vcu = (F.G % 8 == 0) ? (bx % 8) * (F.G / 8) + bx / 8 : bx; }
    F.gw = F.vcu * NWAVES + F.wave; F.NGW = F.G * NWAVES;
    F.ws = A->ws; F.ctl = (unsigned*)(A->ws + WS_CTL); F.out = A->out;
    return F;
}
__global__ void __launch_bounds__(NTHR, 2) mk_fwd(Args args) {
    const int wv = __builtin_amdgcn_readfirstlane((int)threadIdx.x >> 6);
    { Frame F = make_frame(wv);
      for (int u = F.tid; u < (LDS_BYTES - LDSCTL_OFF) / 4; u += NTHR) ((LAS unsigned*)(F.lds + LDSCTL_OFF))[u] = 0u;
      __syncthreads(); }
    const int lo = args.ph_lo, hi = args.ph_hi;
#if defined(PROBE_SCAN) || defined(PROBE_ROUTER)
    { Frame Fp = make_frame(wv); if (Fp.vcu == 0 && Fp.tid == 0) *(unsigned long long*)(Fp.ws + WS_ZN + 48 * 1024) = 0ull; }
#endif
#ifdef PROBE_P
    unsigned long long pr_acc = 0ull, pr_t0 = 0ull;
#define PR_BEGIN(p) do { if (((p) < 2 ? (p) : 2 + ((p) - 2) % PH_PER_LAYER) == PROBE_P) pr_t0 = __builtin_amdgcn_s_memrealtime(); } while (0)
#define PR_END(p) do { if (((p) < 2 ? (p) : 2 + ((p) - 2) % PH_PER_LAYER) == PROBE_P) pr_acc += __builtin_amdgcn_s_memrealtime() - pr_t0; } while (0)
#else
#define PR_BEGIN(p) do {} while (0)
#define PR_END(p) do {} while (0)
#endif
    if (hi - lo > 1) { Frame F = make_frame(wv); (void)xcd_barrier_post((unsigned*)(F.ctl + CW_BAR), F.MISC + 8, F.tid); }
#define IN(k) (lo <= (k) && (k) < hi)
#define SEAM(k) do { if (IN(k) && IN((k) + 1)) { Frame Fb = make_frame(wv); XcdBarrier bar; bar.bar = (unsigned*)(Fb.ctl + CW_BAR); bar.x = xb_xcc_id(); bar.st = Fb.MISC + 8; xcd_barrier(bar, Fb.tid); } } while (0)
    PR_BEGIN(0); if (IN(0)) { Frame F = make_frame(wv); REPS(0) { p0_prologue(F); __syncthreads(); } }
    SEAM(0); PR_END(0);
    PR_BEGIN(1); if (IN(1)) { Frame F = make_frame(wv); REPS(1) { row_pass<0>(F, 0, 0); __syncthreads(); } }
    SEAM(1); PR_END(1);
#define LAYER_BODY(l) { \
        const int pb = 2 + l * PH_PER_LAYER; \
        PR_BEGIN(pb + 0); if (IN(pb + 0)) { Frame F = make_frame(wv); \
            SchedIn S{(const bf16*)(F.ws + WS_ACT), (const bf16*)(F.ws + WS_WIN) + (size_t)l * 3072 * D, F.G, (int)blockIdx.x}; \
            EpiIn E{(bf16*)(F.ws + WS_QKVZ), (bf16*)(F.ws + WS_ZTL), (bf16*)(F.ws + WS_ZTC)}; \
            REPS(8) { pg8::gemm_phase<EpiIn, SchedIn, PG8_ALIGN, PG8_SP2>(F.lds, pg8::Gemm{D}, S, E, F.tid); __syncthreads(); } } \
        SEAM(pb + 0); PR_END(pb + 0); \
        PR_BEGIN(pb + 1); if (IN(pb + 1)) { Frame F = make_frame(wv); REPS(2) { conv_phase(F, l); __syncthreads(); } fold_phase(F); } \
        SEAM(pb + 1); PR_END(pb + 1); \
        PR_BEGIN(pb + 2); if (IN(pb + 2)) { \
            { Frame F = make_frame(wv); REPS(3) { prep_phase(F); } } \
        } \
        SEAM(pb + 2); PR_END(pb + 2); \
        PR_BEGIN(pb + 3); if (IN(pb + 3)) { Frame F = make_frame(wv); \
            if (F.vcu < 128) { REPS(4) { scan_mfma(F, l); __syncthreads(); } } \
            else { \
              SchedDft S{(const bf16*)(F.ws + WS_DFTM), (const bf16*)(F.ws + WS_EO), F.vcu - 128}; \
              EpiDft E{(bf16*)(F.ws + WS_AB2)}; \
              REPS(9) { pg8::gemm_phase<EpiDft, SchedDft, PG8_ALIGN, PG8_SP2>(F.lds, pg8::Gemm{2048}, S, E, F.tid); __syncthreads(); } \
              if (l == 0) ctx_dft(F); } \
        } \
        SEAM(pb + 3); PR_END(pb + 3); \
        PR_BEGIN(pb + 4); if (IN(pb + 4)) { Frame F = make_frame(wv); REPS(5) { gated_out(F, l); __syncthreads(); } } \
        SEAM(pb + 4); PR_END(pb + 4); \
        PR_BEGIN(pb + 5); if (IN(pb + 5)) { Frame F = make_frame(wv); \
            SchedOut S{(const bf16*)(F.ws + WS_ACT), (const bf16*)(F.ws + WS_WOUT) + (size_t)l * D * D, l == NL - 1 ? NLAT / 256 : MT / 256, F.G, (int)blockIdx.x}; \
            REPS(10) { EpiOut E{F.out, (float*)(F.ws + WS_XC), modv(F, l, 0, 2), LASTREP(10) ? 1.0f : 0.0f}; \
                pg8::gemm_phase<EpiOut, SchedOut, PG8_ALIGN, PG8_SP2>(F.lds, pg8::Gemm{D}, S, E, F.tid); __syncthreads(); } } \
        SEAM(pb + 5); PR_END(pb + 5); \
        PR_BEGIN(pb + 6); if (IN(pb + 6)) { Frame F = make_frame(wv); REPS(6) { router_phase(F, l, LASTREP(6) ? 0 : 1); __syncthreads(); } } \
        SEAM(pb + 6); PR_END(pb + 6); \
        PR_BEGIN(pb + 7); if (IN(pb + 7)) { Frame F = make_frame(wv); REPS(7) { gather_phase(F, l, !LASTREP(7)); __syncthreads(); } } \
        SEAM(pb + 7); PR_END(pb + 7); \
        PR_BEGIN(pb + 8); if (IN(pb + 8)) { Frame F = make_frame(wv); \
            LAS int* pend = (LAS int*)(F.lds + XT_OFF); moe_layout(F, l, pend, pend + 32); \
            SchedMoe S{(const bf16*)(F.ws + WS_ACT), (const bf16*)(F.ws + WS_W1), (size_t)2048 * D * 2, pend, pend[NEXP - 1], 8, F.G, (int)blockIdx.x, 1}; \
            EpiSwiglu E{(bf16*)(F.ws + WS_HS), kargs()->in[I_BG] + (size_t)l * NEXP * D, kargs()->in[I_BU] + (size_t)l * NEXP * D}; \
            REPS(11) { pg8::gemm_phase<EpiSwiglu, SchedMoe, PG8_ALIGN, PG8_SP2, true>(F.lds, pg8::Gemm{D}, S, E, F.tid, (const unsigned*)(F.ws + WS_GOFF), F.lds + XT_OFF + 1024, (unsigned)MT * 2048u); __syncthreads(); } } \
        SEAM(pb + 8); PR_END(pb + 8); \
        PR_BEGIN(pb + 9); if (IN(pb + 9)) { Frame F = make_frame(wv); \
            LAS int* pend = (LAS int*)(F.lds + XT_OFF); moe_layout(F, l, pend, pend + 32); \
            SchedMoe S{(const bf16*)(F.ws + WS_HS), (const bf16*)(F.ws + WS_W2), (size_t)D * D * 2, pend, pend[NEXP - 1], 4, F.G, (int)blockIdx.x, 0}; \
            EpiDown E{(bf16*)(F.ws + WS_XS), kargs()->in[I_BD] + (size_t)l * NEXP * D}; \
            REPS(12) { pg8::gemm_phase<EpiDown, SchedMoe, PG8_ALIGN, PG8_SP2>(F.lds, pg8::Gemm{D}, S, E, F.tid); __syncthreads(); } } \
        SEAM(pb + 9); PR_END(pb + 9); \
        PR_BEGIN(pb + 10); if (IN(pb + 10)) { \
            { Frame F = make_frame(wv); \
              if (l == NL - 1) row_pass<2>(F, l, l); else { REPS(13) { row_pass<1>(F, l, l + 1, !LASTREP(13)); __syncthreads(); } } } \
            if (l != NL - 1) { Frame F = make_frame(wv); __syncthreads(); REPS(14) { convert_experts(F, l + 1); __syncthreads(); } } \
        } \
        if (l + 1 < NL) SEAM(pb + 10); PR_END(pb + 10); \
    }
    LAYER_BODY(0)
    LAYER_BODY(1)
#undef LAYER_BODY
#ifdef PROBE_P
#if defined(PROBE_SCAN) || defined(PROBE_ROUTER)
    { Frame Fp = make_frame(wv); if (Fp.vcu == 0 && Fp.tid == 0) pr_acc = *(unsigned long long*)(Fp.ws + WS_ZN + 48 * 1024); else pr_acc = 0; }
#endif
    if (blockIdx.x == 0 && threadIdx.x == 0) { const unsigned long long t0 = __builtin_amdgcn_s_memrealtime(), want = pr_acc * PROBE_SCALE; while (__builtin_amdgcn_s_memrealtime() - t0 < want) __builtin_amdgcn_s_sleep(8); }
#endif
#undef IN
#undef SEAM
}

extern "C" void kernel_launch(void* const* d_in, const int* in_sizes, int n_in, void* d_out, int out_size, void* d_ws, size_t ws_size, hipStream_t stream) {
    static int grid = 0;
    if (grid == 0) {
        if (n_in != 23 || out_size != NLAT * D || ws_size < WS_END) { fprintf(stderr, "kernel_launch: unexpected shapes (n_in %d, out %d, ws %zu); nothing launched\n", n_in, out_size, ws_size); grid = -1; return; }
        int dev = 0, cus = 0, per_cu = 0;
        if (hipGetDevice(&dev) != hipSuccess || hipDeviceGetAttribute(&cus, hipDeviceAttributeMultiprocessorCount, dev) != hipSuccess) { grid = -1; return; }
        if (hipFuncSetAttribute((const void*)mk_fwd, hipFuncAttributeMaxDynamicSharedMemorySize, LDS_BYTES) != hipSuccess) { fprintf(stderr, "kernel_launch: hipFuncSetAttribute failed\n"); grid = -1; return; }
        if (hipOccupancyMaxActiveBlocksPerMultiprocessor(&per_cu, (const void*)mk_fwd, NTHR, LDS_BYTES) != hipSuccess || per_cu < 1)
            fprintf(stderr, "kernel_launch: note: occupancy query reports %d workgroups per CU\n", per_cu);
        (void)hipGetLastError();
        grid = cus;
        if (grid != 256) { fprintf(stderr, "kernel_launch: built for 256 CUs, found %d; nothing launched\n", grid); grid = -1; return; }
    }
    if (grid < 0) return;
    if (hipMemsetAsync((char*)d_ws + WS_CTL, 0, CTL_ZERO_BYTES, stream) != hipSuccess) { fprintf(stderr, "kernel_launch: hipMemsetAsync failed\n"); return; }
    Args a{};
    for (int i = 0; i < 23; ++i) a.in[i] = (const float*)d_in[i];
    a.out = (float*)d_out; a.ws = (unsigned char*)d_ws;
#if MK_ONE_LAUNCH
    a.ph_lo = 0; a.ph_hi = N_PHASES;
    hipLaunchKernelGGL(mk_fwd, dim3(grid), dim3(NTHR), LDS_BYTES, stream, a);
#else
    for (int p = 0; p < N_PHASES; ++p) { a.ph_lo = p; a.ph_hi = p + 1; hipLaunchKernelGGL(mk_fwd, dim3(grid), dim3(NTHR), LDS_BYTES, stream, a); }
#endif
    const hipError_t le = hipPeekAtLastError();
    if (le != hipSuccess) fprintf(stderr, "kernel_launch: launch failed: %s\n", hipGetErrorName(le));
}
```

```cpp
#define MK_ONE_LAUNCH 1
#include <hip/hip_runtime.h>
#include <cstdio>
#include <cstdint>

#ifndef MK_ONE_LAUNCH
#define MK_ONE_LAUNCH 1
#endif

namespace pg8 {
#define PG8_LAS __attribute__((address_space(3)))
typedef unsigned short bf16_t;
typedef short bf16x8 __attribute__((ext_vector_type(8)));
typedef float f32x4 __attribute__((ext_vector_type(4)));
typedef unsigned u32x4 __attribute__((ext_vector_type(4)));
constexpr int BM = 256, BK = 64, HALF = 128, HTB = HALF * BK * 2  , STAGE_BYTES = 8 * HTB, NXCD = 8, WGM = 8;

__host__ __device__ __forceinline__ int lds_byte(int r, int c) { const int st = (r >> 4) * 2 + (c >> 5), rr = r & 15, cc = c & 31, ob = rr * 64 + cc * 2; return st * 1024 + (ob ^ (((ob >> 9) & 1) << 5)); }
__host__ __device__ __forceinline__ void stage_rc(int b, int& R, int& C) { const int st = b / 1024, sb = b % 1024, swz = sb ^ (((sb >> 9) & 1) << 5); R = (st >> 1) * 16 + swz / 64; C = (st & 1) * 32 + (swz % 64) / 2; }
__host__ __device__ __forceinline__ int perm32(int rho) { const int n = rho >> 4, i = rho & 15; return 8 * (i >> 2) + 4 * n + (i & 3); }

struct Unit { int pm, pn, kind, e; };
struct Gemm { int K; };

__device__ __forceinline__ int xcd_remap(int L, int nwg) { const int q = nwg / NXCD, r = nwg % NXCD, xcd = L % NXCD, off = L / NXCD; return (xcd < r ? xcd * (q + 1) : r * (q + 1) + (xcd - r) * q) + off; }
__device__ __forceinline__ void grp_decode(int wgid, int nM, int nN, int& pm, int& pn) { const int nig = WGM * nN, gid = wgid / nig, fm = gid * WGM, gsz = (nM - fm) < WGM ? (nM - fm) : WGM; pm = fm + ((wgid % nig) % gsz); pn = (wgid % nig) / gsz; }

__device__ __forceinline__ const char* uni_ptr(const char* p) { const unsigned long long v = (unsigned long long)p; const unsigned lo = __builtin_amdgcn_readfirstlane((unsigned)v), hi = __builtin_amdgcn_readfirstlane((unsigned)(v >> 32)); return (const char*)(((unsigned long long)hi << 32) | lo); }
__device__ __forceinline__ unsigned cvt_pk_bf16(float lo, float hi) { unsigned r; asm volatile("v_cvt_pk_bf16_f32 %0, %1, %2" : "=v"(r) : "v"(lo), "v"(hi)); return r; }

template <class Epi, class Sched, bool ALIGN_EPI = false, bool SP2 = false, bool GATHER = false>
__device__ __forceinline__ void gemm_phase(PG8_LAS unsigned char* lds, const Gemm g, const Sched& S, const Epi& E, int tid_in, const unsigned* gtab = nullptr, PG8_LAS unsigned char* gl_tab = nullptr, unsigned glim = 0u) {
    static_assert(!GATHER || SP2, "GATHER is written for the SP2 loop");
    int tid_ = tid_in; asm volatile("" : "+v"(tid_));
    const int tid = tid_, wid = __builtin_amdgcn_readfirstlane(tid >> 6), lane = tid & 63, wr = wid >> 2, wc = wid & 3, fr = lane & 15, fq = lane >> 4;
    const int K = g.K, nt = K / BK;
    unsigned voffA[2], voffB[2];
#pragma unroll
    for (int i = 0; i < 2; ++i) { int R, C; stage_rc(tid * 16 + i * 8192, R, C); const int Rb = Epi::PERM ? ((R & ~31) + perm32(R & 31)) : R;
        voffA[i] = (unsigned)(R * K + C) * 2u; voffB[i] = (unsigned)(Rb * K + C) * 2u; }
    const size_t kstep = (size_t)(BK * 2);
    const size_t hstep = (size_t)HALF * K * 2;
    const size_t tstep = 2 * hstep;
    const unsigned ldsw = (unsigned)wid * 1024u;
    const int aoff = lds_byte(wr * 64 + fr, fq * 8), boff = lds_byte(wc * 32 + fr, fq * 8);
#define PG8_SA(b, h) (((b) * 2 + (h)) * HTB)
#define PG8_SB(b, h) ((4 + (b) * 2 + (h)) * HTB)
#define PG8_STAGE(bufoff, gbase, voff) do { _Pragma("unroll") for (int _i = 0; _i < 2; ++_i) \
        __builtin_amdgcn_global_load_lds((const unsigned*)((const char*)(gbase) + (voff)[_i]), (PG8_LAS unsigned*)(lds + (bufoff) + ldsw + _i * 8192), 16, 0, 0); } while (0)
#define PG8_STAGE_G(bufoff, gbase, G, H) do { _Pragma("unroll") for (int _i = 0; _i < 2; ++_i) \
        __builtin_amdgcn_global_load_lds((const unsigned*)((const char*)(gbase) + (G)[H][_i]), (PG8_LAS unsigned*)(lds + (bufoff) + ldsw + _i * 8192), 16, 0, 0); } while (0)
#define PG8_STAGE_A(bufoff, gbase, G, H) do { if constexpr (GATHER) PG8_STAGE_G(bufoff, gbase, G, H); else PG8_STAGE(bufoff, (gbase) + (H) * hstep, voffA); } while (0)
#define PG8_TAB_ISSUE(u_) __builtin_amdgcn_global_load_lds(gtab + ((size_t)(u_).pm * 512 + tid) * 4, (PG8_LAS unsigned*)(gl_tab + wid * 1024), 16, 0, 0)
#define PG8_TAB_READ(G) do { const u32x4 gv_ = *(const PG8_LAS u32x4*)(gl_tab + tid * 16); G[0][0] = gv_.x < glim ? gv_.x : 0u; G[0][1] = gv_.y < glim ? gv_.y : 0u; G[1][0] = gv_.z < glim ? gv_.z : 0u; G[1][1] = gv_.w < glim ? gv_.w : 0u; } while (0)
#define PG8_LDA(dst, b, h) do { _Pragma("unroll") for (int m = 0; m < 4; ++m) _Pragma("unroll") for (int k = 0; k < 2; ++k) dst[m][k] = *(const PG8_LAS bf16x8*)(lds + PG8_SA(b, h) + aoff + m * 2048 + k * 1024); } while (0)
#define PG8_LDB(dst, b, h) do { _Pragma("unroll") for (int n = 0; n < 2; ++n) _Pragma("unroll") for (int k = 0; k < 2; ++k) dst[n][k] = *(const PG8_LAS bf16x8*)(lds + PG8_SB(b, h) + boff + n * 2048 + k * 1024); } while (0)
#define PG8_MMA(ai, bj, At, Bt) do { __builtin_amdgcn_s_setprio(1); _Pragma("unroll") for (int m = 0; m < 4; ++m) _Pragma("unroll") for (int n = 0; n < 2; ++n) _Pragma("unroll") for (int k = 0; k < 2; ++k) \
        acc[ai][bj][m][n] = __builtin_amdgcn_mfma_f32_16x16x32_bf16(Bt[n][k], At[m][k], acc[ai][bj][m][n], 0, 0, 0); __builtin_amdgcn_s_setprio(0); } while (0)
#define PG8_WAIT_V(n) asm volatile("s_waitcnt vmcnt(" #n ")" ::: "memory")
#define PG8_WAIT_L(n) asm volatile("s_waitcnt lgkmcnt(" #n ")" ::: "memory")
#define PG8_BAR __builtin_amdgcn_s_barrier()
#define PG8_SCHED __builtin_amdgcn_sched_barrier(0)
    Unit cur, nxt; int ui = 0;
    if (!S.next(0, cur)) return;
    f32x4 acc[2][2][4][2];
#pragma unroll
    for (int a = 0; a < 2; ++a)
#pragma unroll
        for (int b = 0; b < 2; ++b)
#pragma unroll
            for (int m = 0; m < 4; ++m)
#pragma unroll
                for (int n = 0; n < 2; ++n) acc[a][b][m][n] = (f32x4){0.f, 0.f, 0.f, 0.f};
    bf16x8 At[4][2], B0[2][2], B1[2][2];
    const char* cA = uni_ptr(S.a_base(cur, tstep)); const char* cB = uni_ptr(S.b_base(cur, tstep));
    S.a_ready(cur);
    unsigned gC[2][2] = {{0u, 0u}, {0u, 0u}}, gN[2][2] = {{0u, 0u}, {0u, 0u}};
    if constexpr (GATHER) { PG8_TAB_ISSUE(cur); asm volatile("s_waitcnt vmcnt(0)" ::: "memory"); __builtin_amdgcn_s_barrier(); asm volatile("" ::: "memory"); PG8_TAB_READ(gC); }
    if constexpr (SP2) {
        PG8_STAGE(PG8_SB(0, 0), cB, voffB); PG8_STAGE(PG8_SB(0, 1), cB + hstep, voffB); PG8_STAGE_A(PG8_SA(0, 0), cA, gC, 0); PG8_STAGE_A(PG8_SA(0, 1), cA, gC, 1);
        if (wr == 1) PG8_BAR;
        PG8_WAIT_V(2); PG8_BAR;
        PG8_STAGE(PG8_SB(1, 0), cB + kstep, voffB); PG8_STAGE_A(PG8_SA(1, 0), cA + kstep, gC, 0); PG8_STAGE(PG8_SB(1, 1), cB + hstep + kstep, voffB);
        PG8_WAIT_V(6); PG8_BAR;
    } else {
        PG8_STAGE(PG8_SB(0, 0), cB, voffB); PG8_STAGE(PG8_SA(0, 0), cA, voffA); PG8_STAGE(PG8_SB(0, 1), cB + hstep, voffB); PG8_STAGE(PG8_SA(0, 1), cA + hstep, voffA);
        if (wr == 1) PG8_BAR;
        PG8_WAIT_V(4); PG8_BAR;
        PG8_STAGE(PG8_SB(1, 0), cB + kstep, voffB); PG8_STAGE(PG8_SA(1, 0), cA + kstep, voffA); PG8_STAGE(PG8_SB(1, 1), cB + hstep + kstep, voffB);
        PG8_WAIT_V(6); PG8_BAR;
    }
    for (;;) {
        const bool has_next = S.next(ui + 1, nxt);
        const char* nA = uni_ptr(has_next ? S.a_base(nxt, tstep) : cA); const char* nB = uni_ptr(has_next ? S.b_base(nxt, tstep) : cB);
        for (int t = 0; t < nt; t += 2) {
            const bool last = (t == nt - 2);
            const char* a1 = cA + (size_t)(t + 1) * kstep;
            const char* a2 = last ? nA : cA + (size_t)(t + 2) * kstep; const char* b2 = last ? nB : cB + (size_t)(t + 2) * kstep;
            const char* a3 = a2 + kstep; const char* b3 = b2 + kstep;
            if (last && has_next) S.a_ready(nxt);
            unsigned g2[2][2] = {{gC[0][0], gC[0][1]}, {gC[1][0], gC[1][1]}};
            if constexpr (GATHER) {
                if (t == nt - 4 && has_next) PG8_TAB_ISSUE(nxt);
                if (last && has_next) { PG8_TAB_READ(gN); g2[0][0] = gN[0][0]; g2[0][1] = gN[0][1]; g2[1][0] = gN[1][0]; g2[1][1] = gN[1][1]; }
            }
            if constexpr (SP2) {
            PG8_LDB(B0, 0, 0); PG8_LDB(B1, 0, 1); PG8_SCHED; PG8_LDA(At, 0, 0); PG8_STAGE_A(PG8_SA(1, 1), a1, gC, 1);
            PG8_WAIT_V(8); PG8_WAIT_L(0); PG8_BAR; PG8_MMA(0, 0, At, B0); PG8_MMA(0, 1, At, B1); PG8_BAR; PG8_SCHED;
            PG8_LDA(At, 0, 1); PG8_STAGE(PG8_SB(0, 0), b2, voffB); PG8_STAGE(PG8_SB(0, 1), b2 + hstep, voffB); PG8_STAGE_A(PG8_SA(0, 0), a2, g2, 0);
            PG8_WAIT_V(8); PG8_WAIT_L(0); PG8_BAR; PG8_MMA(1, 0, At, B0); PG8_MMA(1, 1, At, B1); PG8_BAR; PG8_SCHED;
            PG8_LDB(B0, 1, 0); PG8_LDB(B1, 1, 1); PG8_SCHED; PG8_LDA(At, 1, 0); PG8_STAGE_A(PG8_SA(0, 1), a2, g2, 1);
            PG8_WAIT_V(8); PG8_WAIT_L(0); PG8_BAR; PG8_MMA(0, 0, At, B0); PG8_MMA(0, 1, At, B1); PG8_BAR; PG8_SCHED;
            PG8_LDA(At, 1, 1); PG8_STAGE(PG8_SB(1, 0), b3, voffB); PG8_STAGE(PG8_SB(1, 1), b3 + hstep, voffB); PG8_STAGE_A(PG8_SA(1, 0), a3, g2, 0);
            PG8_WAIT_V(8); PG8_WAIT_L(0); PG8_BAR; PG8_MMA(1, 0, At, B0); PG8_MMA(1, 1, At, B1); PG8_BAR; PG8_SCHED;
            } else {
            PG8_LDB(B0, 0, 0); PG8_SCHED; PG8_LDA(At, 0, 0); PG8_STAGE(PG8_SA(1, 1), a1 + hstep, voffA);
            PG8_WAIT_L(8); PG8_BAR; PG8_WAIT_L(0); PG8_MMA(0, 0, At, B0); PG8_BAR; PG8_SCHED;
            PG8_LDB(B1, 0, 1); PG8_STAGE(PG8_SB(0, 0), b2, voffB);
            PG8_BAR; PG8_WAIT_L(0); PG8_MMA(0, 1, At, B1); PG8_BAR;
            PG8_LDA(At, 0, 1); PG8_STAGE(PG8_SA(0, 0), a2, voffA);
            PG8_BAR; PG8_WAIT_L(0); PG8_MMA(1, 0, At, B0); PG8_BAR; PG8_SCHED;
            PG8_STAGE(PG8_SB(0, 1), b2 + hstep, voffB);
            PG8_WAIT_V(6); PG8_BAR; PG8_MMA(1, 1, At, B1); PG8_BAR;
            PG8_LDB(B0, 1, 0); PG8_SCHED; PG8_LDA(At, 1, 0); PG8_STAGE(PG8_SA(0, 1), a2 + hstep, voffA);
            PG8_WAIT_L(8); PG8_BAR; PG8_WAIT_L(0); PG8_MMA(0, 0, At, B0); PG8_BAR; PG8_SCHED;
            PG8_LDB(B1, 1, 1); PG8_STAGE(PG8_SB(1, 0), b3, voffB);
            PG8_BAR; PG8_WAIT_L(0); PG8_MMA(0, 1, At, B1); PG8_BAR;
            PG8_LDA(At, 1, 1); PG8_STAGE(PG8_SA(1, 0), a3, voffA);
            PG8_BAR; PG8_WAIT_L(0); PG8_MMA(1, 0, At, B0); PG8_BAR; PG8_SCHED;
            PG8_STAGE(PG8_SB(1, 1), b3 + hstep, voffB);
            PG8_WAIT_V(6); PG8_BAR; PG8_MMA(1, 1, At, B1); PG8_BAR;
            }
        }
        if constexpr (ALIGN_EPI) { if (wr == 0) PG8_BAR; }
        if constexpr (!Epi::AFTER_DRAIN) { E(acc, cur, wr, wc, fr, fq); S.done(cur); }
        if (!has_next) break;
#pragma unroll
        for (int a = 0; a < 2; ++a)
#pragma unroll
            for (int b = 0; b < 2; ++b)
#pragma unroll
                for (int m = 0; m < 4; ++m)
#pragma unroll
                    for (int n = 0; n < 2; ++n) acc[a][b][m][n] = (f32x4){0.f, 0.f, 0.f, 0.f};
        cur = nxt; cA = nA; cB = nB; ++ui;
        if constexpr (GATHER) { gC[0][0] = gN[0][0]; gC[0][1] = gN[0][1]; gC[1][0] = gN[1][0]; gC[1][1] = gN[1][1]; }
        if constexpr (ALIGN_EPI) { if (wr == 1) PG8_BAR; }
    }
    PG8_WAIT_V(0);
    if constexpr (!ALIGN_EPI) { if (wr == 0) PG8_BAR; }
    PG8_BAR;
    if constexpr (Epi::AFTER_DRAIN) { E.fused(acc, cur, wr, wc, fr, fq, lds, wid, lane); S.done(cur); }
#undef PG8_SA
#undef PG8_SB
#undef PG8_STAGE
#undef PG8_STAGE_G
#undef PG8_STAGE_A
#undef PG8_TAB_ISSUE
#undef PG8_TAB_READ
#undef PG8_LDA
#undef PG8_LDB
#undef PG8_MMA
#undef PG8_WAIT_V
#undef PG8_WAIT_L
#undef PG8_BAR
#undef PG8_SCHED
}
}

constexpr int NWAVES = 8, NTHR = 512;
constexpr int D = 1024, NB = 8, SEQ = 4096, CTXL = 256, NL = 2;
constexpr int NLAT = NB * SEQ;
constexpr int NCTX = NB * CTXL;
constexpr int MT = NLAT + NCTX;
constexpr int INW = 2576, NEXP = 32, TOPK = 4;
constexpr int PMAX = (MT * TOPK / 256 + NEXP) * 256;
constexpr float EPS = 1e-6f;
constexpr int CVT_ITEMS = 3 * 32 * 512, CVT_SPLIT = (CVT_ITEMS * 5 / 8) / 512 * 512;

constexpr size_t MiB = 1u << 20;
constexpr size_t WS_CTL = 0, CTL_ZERO_BYTES = 1 * MiB;
constexpr size_t WS_MODV = 1 * MiB;
constexpr size_t WS_WRT = 2 * MiB;
constexpr size_t WS_WABT = WS_WRT + 512 * 1024;
constexpr size_t WS_SELE = 3 * MiB;
constexpr size_t WS_SELP = WS_SELE + 640 * 1024;
constexpr size_t WS_SELG = WS_SELP + 640 * 1024;
constexpr size_t WS_G = 5 * MiB;
constexpr size_t WS_BETA = WS_G + 1536 * 1024;
constexpr size_t WS_AB = 8 * MiB;
constexpr size_t WS_WIN = 12 * MiB;
constexpr size_t WS_WOUT = 24 * MiB;
constexpr size_t WS_DFTM = 32 * MiB;
constexpr size_t WS_W1 = 96 * MiB;
constexpr size_t WS_W2 = 224 * MiB;
constexpr size_t WS_XC = 288 * MiB;
constexpr size_t WS_ACT = 296 * MiB;
constexpr size_t WS_S = 364 * MiB;
constexpr size_t WS_QKVZ = WS_S;
constexpr size_t WS_ZTL = WS_S + 136 * MiB;
constexpr size_t WS_ZTC = WS_ZTL + 64 * MiB;
constexpr size_t WS_QKVN = WS_ZTC + 4 * MiB;
constexpr size_t WS_OF = WS_QKVN + 102 * MiB;
constexpr size_t WS_OB = WS_OF + 34 * MiB;
constexpr size_t WS_XS = WS_S;
constexpr size_t WS_HS = WS_S + 288 * MiB;
constexpr size_t WS_EO = 984 * MiB;
constexpr size_t WS_AB2 = WS_ZTL;
constexpr size_t WS_ZN = 11 * MiB - 64 * 1024;
constexpr size_t WS_GOFF = 944 * MiB;
constexpr size_t WS_END = 1024 * MiB;
static_assert(WS_OB + 34 * MiB <= WS_END && WS_HS + 288 * MiB <= WS_END && (size_t)PMAX * 1024 * 2 == 288 * MiB, "d_ws map");
static_assert((size_t)MT * 16 <= 640 * 1024 && (size_t)MT * 32 <= 1536 * 1024, "sel / g maps");
constexpr int CW_BAR = 4096;
constexpr int CW_GCNT = 16384;

constexpr int RING_BYTES = 131072;
constexpr int LDSCTL_OFF = RING_BYTES, MISC_OFF = LDSCTL_OFF + 320;
constexpr int XT_OFF = RING_BYTES + 1024;
constexpr int LDS_BYTES = 147456;

#define GAS __attribute__((address_space(1)))
#define LAS __attribute__((address_space(3)))
typedef unsigned short bf16;
typedef unsigned v4u __attribute__((ext_vector_type(4)));
typedef unsigned v2u __attribute__((ext_vector_type(2)));
typedef float f32x4 __attribute__((ext_vector_type(4)));
typedef GAS unsigned gu32;
#define RLX_AGENT __ATOMIC_RELAXED, __HIP_MEMORY_SCOPE_AGENT
#define LDS_WAIT() asm volatile("s_waitcnt lgkmcnt(0)" ::: "memory")
#define VM_WAIT() asm volatile("s_waitcnt vmcnt(0)" ::: "memory")
typedef float f32x2_t __attribute__((ext_vector_type(2))); typedef __bf16 bf16x2_t __attribute__((ext_vector_type(2)));
__device__ __forceinline__ unsigned pk2(float lo, float hi) { const f32x2_t v = {lo, hi}; const bf16x2_t b = __builtin_convertvector(v, bf16x2_t); return __builtin_bit_cast(unsigned, b); }
__device__ __forceinline__ unsigned f2bf(float f) { return pk2(f, 0.f) & 0xffffu; }
__device__ __forceinline__ float bflo(unsigned w) { return __builtin_bit_cast(float, w << 16); }
__device__ __forceinline__ float bfhi(unsigned w) { return __builtin_bit_cast(float, w & 0xffff0000u); }
__device__ __forceinline__ float wave_sum(float v) {
#pragma unroll
    for (int o = 1; o < 64; o <<= 1) v += __shfl_xor(v, o);
    return v;
}
__device__ __forceinline__ float sum16(float v) {
#pragma unroll
    for (int o = 1; o < 16; o <<= 1) v += __shfl_xor(v, o);
    return v;
}
__device__ __forceinline__ float rs32(float (&p)[32], int lane) {
#pragma unroll
    for (int e = 0; e < 16; ++e) { const bool up = (lane & 32) != 0; const float send = up ? p[e] : p[e + 16], keep = up ? p[e + 16] : p[e]; p[e] = keep + __shfl_xor(send, 32); }
#pragma unroll
    for (int e = 0; e < 8; ++e) { const bool up = (lane & 16) != 0; const float send = up ? p[e] : p[e + 8], keep = up ? p[e + 8] : p[e]; p[e] = keep + __shfl_xor(send, 16); }
#pragma unroll
    for (int e = 0; e < 4; ++e) { const bool up = (lane & 8) != 0; const float send = up ? p[e] : p[e + 4], keep = up ? p[e + 4] : p[e]; p[e] = keep + __shfl_xor(send, 8); }
#pragma unroll
    for (int e = 0; e < 2; ++e) { const bool up = (lane & 4) != 0; const float send = up ? p[e] : p[e + 2], keep = up ? p[e + 2] : p[e]; p[e] = keep + __shfl_xor(send, 4); }
    { const bool up = (lane & 2) != 0; const float send = up ? p[0] : p[1], keep = up ? p[1] : p[0]; p[0] = keep + __shfl_xor(send, 2); }
    return p[0] + __shfl_xor(p[0], 1);
}
__device__ __forceinline__ float rs16(float (&p)[16], int lane) {
#pragma unroll
    for (int e = 0; e < 8; ++e) { const bool up = (lane & 32) != 0; const float send = up ? p[e] : p[e + 8], keep = up ? p[e + 8] : p[e]; p[e] = keep + __shfl_xor(send, 32); }
#pragma unroll
    for (int e = 0; e < 4; ++e) { const bool up = (lane & 16) != 0; const float send = up ? p[e] : p[e + 4], keep = up ? p[e + 4] : p[e]; p[e] = keep + __shfl_xor(send, 16); }
#pragma unroll
    for (int e = 0; e < 2; ++e) { const bool up = (lane & 8) != 0; const float send = up ? p[e] : p[e + 2], keep = up ? p[e + 2] : p[e]; p[e] = keep + __shfl_xor(send, 8); }
    { const bool up = (lane & 4) != 0; const float send = up ? p[0] : p[1], keep = up ? p[1] : p[0]; p[0] = keep + __shfl_xor(send, 4); }
    float r = p[0] + __shfl_xor(p[0], 2);
    return r + __shfl_xor(r, 1);
}
__device__ __forceinline__ float silu_f(float x) { return x / (1.f + __expf(-x)); }

#define XB_TMO      128
#define XB_XCNT(j)  (256  + 64 * (j))
#define XB_XSUB(j)  (1280 + 64 * (j))
#define XB_XGEN(j)  (2304 + 64 * (j))
#define XB_TOP      3328
#define XB_TOPGEN   3392
#define XCD_BAR_WORDS 3456
#define XB_SPIN_CAP (1u << 18)
__device__ __forceinline__ unsigned xb_ld(unsigned* p)              { return __hip_atomic_load(p, __ATOMIC_RELAXED, __HIP_MEMORY_SCOPE_AGENT); }
__device__ __forceinline__ unsigned xb_add(unsigned* p, unsigned v) { return __hip_atomic_fetch_add(p, v, __ATOMIC_RELAXED, __HIP_MEMORY_SCOPE_AGENT); }
__device__ __forceinline__ unsigned xb_xcc_id() { return (unsigned)__builtin_amdgcn_s_getreg((3 << 11) | 20) & 0xFu; }
#define XB_SPIN(cond, bar) do { unsigned _sp = 0; while (cond) { __builtin_amdgcn_s_sleep(1); \
    if ((++_sp & 255u) == 0u) { if (xb_ld(&(bar)[XB_TMO])) break; if (_sp > XB_SPIN_CAP) { atomicAdd(&(bar)[XB_TMO], 1u); break; } } } } while (0)
struct XcdBarrier { unsigned* bar; unsigned x; volatile LAS unsigned* st; };
__device__ __forceinline__ XcdBarrier xcd_barrier_post(unsigned* bar, volatile LAS unsigned* st, int tid) {
    XcdBarrier b; b.bar = bar; b.x = xb_xcc_id(); b.st = st;
    if (tid == 0) (void)xb_add(&bar[XB_XCNT(b.x)], 1u);
    return b;
}
__device__ __forceinline__ void xcd_barrier_complete(unsigned* bar, unsigned x, unsigned& nloc, unsigned& nx) {
    const unsigned G = gridDim.x * gridDim.y * gridDim.z;
    unsigned sum, cnt, mine, sp = 0u;
    for (;;) {
        sum = 0u; cnt = 0u; mine = 0u;
#pragma unroll
        for (unsigned j = 0; j < 16; ++j) { const unsigned c = xb_ld(&bar[XB_XCNT(j)]); sum += c; cnt += (c > 0u) ? 1u : 0u; mine = (j == x) ? c : mine; }
        if (sum == G) break;
        __builtin_amdgcn_s_sleep(1);
        if ((++sp & 255u) == 0u) { if (xb_ld(&bar[XB_TMO])) break; if (sp > XB_SPIN_CAP) { atomicAdd(&bar[XB_TMO], 1u); break; } }
    }
    nloc = mine > 0u ? mine : 1u; nx = cnt > 0u ? cnt : 1u;
}
__device__ __forceinline__ void xcd_barrier(const XcdBarrier& b, int tid) {
    asm volatile("s_waitcnt vmcnt(0)" ::: "memory");
    __syncthreads();
    if (tid == 0) {
        unsigned* bar = b.bar; unsigned bx = b.x;
        asm volatile("" : "+v"(bar), "+v"(bx));
        __builtin_amdgcn_s_waitcnt(0);
        unsigned nloc = b.st[0], nx = b.st[1];
        if (nloc == 0u) { xcd_barrier_complete(bar, bx, nloc, nx); b.st[0] = nloc; b.st[1] = nx; }
        const unsigned old = xb_add(&bar[XB_XSUB(bx)], 1u);
        const unsigned gen = old / nloc;
        if (old + 1u == (gen + 1u) * nloc) {
            __builtin_amdgcn_fence(__ATOMIC_RELEASE, "agent");
            asm volatile("s_waitcnt vmcnt(0)" ::: "memory");
            const unsigned og = xb_add(&bar[XB_TOP], 1u);
            const unsigned tg = og / nx;
            if (og + 1u == (tg + 1u) * nx) xb_add(&bar[XB_TOPGEN], 1u);
            else XB_SPIN(xb_ld(&bar[XB_TOPGEN]) == tg, bar);
            __builtin_amdgcn_fence(__ATOMIC_ACQUIRE, "agent");
            xb_add(&bar[XB_XGEN(bx)], 1u);
            asm volatile("s_waitcnt vmcnt(0)" ::: "memory");
        } else {
            XB_SPIN(xb_ld(&bar[XB_XGEN(bx)]) == gen, bar);
            __builtin_amdgcn_fence(__ATOMIC_ACQUIRE, "agent");
            asm volatile("s_waitcnt vmcnt(0)" ::: "memory");
        }
    }
    __syncthreads();
}

struct Args { const float* in[23]; float* out; unsigned char* ws; int ph_lo, ph_hi; };
struct Frame {
    LAS unsigned char* lds;
    volatile LAS unsigned* MISC;
    unsigned* ctl;
    unsigned char* ws;
    int tid, lane, wave, vcu, G, gw, NGW;
    float* out;
};
typedef const Args __attribute__((address_space(4)))* KArgsP;
__device__ __forceinline__ KArgsP kargs() { unsigned long long v = (unsigned long long)__builtin_amdgcn_kernarg_segment_ptr(); asm volatile("" : "+s"(v)); return (KArgsP)v; }
enum InIdx { I_X = 0, I_C, I_CTX, I_CCTX, I_WMOD, I_BMOD, I_GN1, I_WIN, I_CONVW, I_ALOG, I_DTB, I_GOUT, I_WOUT, I_GN2, I_WR, I_BR, I_WG, I_BG, I_WU, I_BU, I_WD, I_BD, I_GF };
__device__ __forceinline__ float* xr_row(const Frame& F, int t) { return t < NLAT ? F.out + (size_t)t * D : (float*)(F.ws + WS_XC) + (size_t)(t - NLAT) * D; }
__device__ __forceinline__ int mod_row(int t) { return t < NLAT ? (t >> 12) : 8; }
__device__ __forceinline__ const float* modv(const Frame& F, int l, int r, int piece) { return (const float*)(F.ws + WS_MODV) + ((size_t)(l * 9 + r) * 6 + piece) * D; }

struct SchedIn {
    const bf16* hx; const bf16* win; int G, c;
    static constexpr int N0 = (MT / 256) * 8, N1 = 4 * (MT / 256), NWG = N0 + N1;
    __device__ __forceinline__ bool next(int i, pg8::Unit& u) const {
        const long L = (long)i * G + c; if (L >= NWG) return false;
        int w = pg8::xcd_remap((int)L, NWG);
        if (w < N0) { u.kind = 0; pg8::grp_decode(w, MT / 256, 8, u.pm, u.pn); } else { w -= N0; u.kind = 1; u.pn = w >> 2; u.pm = w & 3; }
        u.e = 0; return true;
    }
    __device__ __forceinline__ const char* a_base(const pg8::Unit& u, size_t tstep) const { return u.kind == 0 ? (const char*)hx + (size_t)u.pm * tstep : (const char*)win + (size_t)(8 + u.pm) * tstep; }
    __device__ __forceinline__ const char* b_base(const pg8::Unit& u, size_t tstep) const { return u.kind == 0 ? (const char*)win + (size_t)u.pn * tstep : (const char*)hx + (size_t)u.pn * tstep; }
    __device__ __forceinline__ void a_ready(const pg8::Unit&) const {}
    __device__ __forceinline__ void done(const pg8::Unit&) const {}
};
struct EpiIn {
    static constexpr bool PERM = true, AFTER_DRAIN = false;
    bf16* qkvz; bf16* ztl; bf16* ztc;
    __device__ __forceinline__ void operator()(const pg8::f32x4 (&acc)[2][2][4][2], const pg8::Unit& u, int wr, int wc, int fr_, int fq_) const {
        int fr = fr_, fq = fq_; asm volatile("" : "+v"(fr), "+v"(fq));
        const int row0 = u.pm * 256 + wr * 64 + fr, cin = wc * 32 + 8 * fq;
        bf16* base; size_t ldc;
        if (u.kind == 0) { base = qkvz + (size_t)u.pn * 256 + cin; ldc = 2048; }
        else if (u.pn < 128) { base = ztl + (size_t)(u.pn >> 4) * 1024 * 4096 + (size_t)(u.pn & 15) * 256 + cin; ldc = 4096; }
        else { base = ztc + (size_t)(u.pn - 128) * 1024 * 256 + cin; ldc = 256; }
#pragma unroll
        for (int ai = 0; ai < 2; ++ai)
#pragma unroll
            for (int m = 0; m < 4; ++m) { bf16* rowp = base + (size_t)(row0 + ai * 128 + m * 16) * ldc;
#pragma unroll
                for (int bj = 0; bj < 2; ++bj) { const pg8::f32x4 v0 = acc[ai][bj][m][0], v1 = acc[ai][bj][m][1]; pg8::u32x4 w;
                    w.x = pg8::cvt_pk_bf16(v0[0], v0[1]); w.y = pg8::cvt_pk_bf16(v0[2], v0[3]); w.z = pg8::cvt_pk_bf16(v1[0], v1[1]); w.w = pg8::cvt_pk_bf16(v1[2], v1[3]);
                    *(pg8::u32x4*)(rowp + bj * 128) = w; } }
    }
};
struct SchedDft {
    const bf16* dftm; const bf16* eo; int v;
    __device__ __forceinline__ bool next(int i, pg8::Unit& u) const {
        if (i >= 2 || v < 0) return false;
        const int w = (v >> 5) * 64 + i * 32 + (v & 31), x = w >> 5, j = w & 31;
        u.kind = x & 1; u.pm = 4 * ((x >> 1) & 1) + (j & 3); u.e = 4 * (x >> 2) + ((j >> 2) & 3); u.pn = j >> 4; return true;
    }
    __device__ __forceinline__ const char* a_base(const pg8::Unit& u, size_t tstep) const { return (const char*)dftm + (size_t)u.kind * (2048 * 2048 * 2) + (size_t)u.pm * tstep; }
    __device__ __forceinline__ const char* b_base(const pg8::Unit& u, size_t tstep) const { return (const char*)eo + (size_t)(u.e * 2 + u.kind) * (512 * 2048 * 2) + (size_t)u.pn * tstep; }
    __device__ __forceinline__ void a_ready(const pg8::Unit&) const {}
    __device__ __forceinline__ void done(const pg8::Unit&) const {}
};
struct EpiDft {
    static constexpr bool PERM = true, AFTER_DRAIN = false;
    bf16* ab2;
    __device__ __forceinline__ void operator()(const pg8::f32x4 (&acc)[2][2][4][2], const pg8::Unit& u, int wr, int wc, int fr_, int fq_) const {
        int fr = fr_, fq = fq_; asm volatile("" : "+v"(fr), "+v"(fq));
        const int row0 = u.pm * 256 + wr * 64 + fr, col0 = u.pn * 256 + wc * 32 + 8 * fq;
        bf16* base = ab2 + (size_t)(u.e * 2 + u.kind) * 2048 * 512;
#pragma unroll
        for (int ai = 0; ai < 2; ++ai)
#pragma unroll
            for (int m = 0; m < 4; ++m) { bf16* rowp = base + (size_t)(row0 + ai * 128 + m * 16) * 512 + col0;
#pragma unroll
                for (int bj = 0; bj < 2; ++bj) { const pg8::f32x4 v0 = acc[ai][bj][m][0], v1 = acc[ai][bj][m][1]; pg8::u32x4 w;
                    w.x = pg8::cvt_pk_bf16(v0[0], v0[1]); w.y = pg8::cvt_pk_bf16(v0[2], v0[3]); w.z = pg8::cvt_pk_bf16(v1[0], v1[1]); w.w = pg8::cvt_pk_bf16(v1[2], v1[3]);
                    *(pg8::u32x4*)(rowp + bj * 128) = w; } }
    }
};
struct SchedOut {
    const bf16* mix; const bf16* wout; int nM, G, c;
    __device__ __forceinline__ bool next(int i, pg8::Unit& u) const {
        const int nwg = nM * 4; const long L = (long)i * G + c; if (L >= nwg) return false;
        pg8::grp_decode(pg8::xcd_remap((int)L, nwg), nM, 4, u.pm, u.pn); u.kind = 0; u.e = 0; return true;
    }
    __device__ __forceinline__ const char* a_base(const pg8::Unit& u, size_t tstep) const { return (const char*)mix + (size_t)u.pm * tstep; }
    __device__ __forceinline__ const char* b_base(const pg8::Unit& u, size_t tstep) const { return (const char*)wout + (size_t)u.pn * tstep; }
    __device__ __forceinline__ void a_ready(const pg8::Unit&) const {}
    __device__ __forceinline__ void done(const pg8::Unit&) const {}
};
struct EpiOut {
    static constexpr bool PERM = false, AFTER_DRAIN = false;
    float* xlat; float* xctx; const float* rlat; const float* rctx; const float* gt1; float dsc;
    __device__ __forceinline__ void operator()(const pg8::f32x4 (&acc)[2][2][4][2], const pg8::Unit& u, int wr, int wc, int fr_, int fq_) const {
        int fr = fr_, fq = fq_; asm volatile("" : "+v"(fr), "+v"(fq));
        const int col0 = u.pn * 256 + wc * 32 + 4 * fq, rl = wr * 64 + fr;
        float* xb = u.pm < 128 ? xlat + (size_t)u.pm * 256 * D : xctx + (size_t)(u.pm - 128) * 256 * D;
        const float* rb = u.pm < 128 ? rlat + (size_t)u.pm * 256 * D : rctx + (size_t)(u.pm - 128) * 256 * D;
        const float* g = gt1 + (size_t)(u.pm < 128 ? (u.pm >> 4) : 8) * 6 * D + col0;
        pg8::f32x4 gv[2][2];
#pragma unroll
        for (int bj = 0; bj < 2; ++bj)
#pragma unroll
            for (int n = 0; n < 2; ++n) gv[bj][n] = *(const pg8::f32x4*)(g + bj * 128 + n * 16);
#pragma unroll
        for (int ai = 0; ai < 2; ++ai)
#pragma unroll
            for (int m = 0; m < 4; ++m) { float* rowp = xb + (size_t)(rl + ai * 128 + m * 16) * D + col0; const float* rrow = rb + (size_t)(rl + ai * 128 + m * 16) * D + col0;
#pragma unroll
                for (int bj = 0; bj < 2; ++bj)
#pragma unroll
                    for (int n = 0; n < 2; ++n) { pg8::f32x4* p = (pg8::f32x4*)(rowp + bj * 128 + n * 16); const pg8::f32x4 xo = *(const pg8::f32x4*)(rrow + bj * 128 + n * 16); *p = xo + gv[bj][n] * acc[ai][bj][m][n] * dsc; }
                if (m & 1) asm volatile("" ::: "memory"); }
    }
};
struct SchedMoe {
    const bf16* A; const bf16* W; size_t wstride; const LAS int* pend; int nM, nN, G, c, gather;
    __device__ __forceinline__ bool next(int i, pg8::Unit& u) const {
        const int nwg = nM * nN; const long L = (long)i * G + c; if (L >= nwg) return false;
        pg8::grp_decode(pg8::xcd_remap((int)L, nwg), nM, nN, u.pm, u.pn);
        int e = 0;
#pragma unroll 1
        for (int j = 0; j < NEXP - 1; ++j) e += (pend[j] <= u.pm) ? 1 : 0;
        u.e = e; u.kind = 0; return true;
    }
    __device__ __forceinline__ const char* a_base(const pg8::Unit& u, size_t tstep) const { return gather ? (const char*)A : (const char*)A + (size_t)u.pm * tstep; }
    __device__ __forceinline__ const char* b_base(const pg8::Unit& u, size_t tstep) const { return (const char*)W + (size_t)u.e * wstride + (size_t)u.pn * tstep; }
    __device__ __forceinline__ void a_ready(const pg8::Unit&) const {}
    __device__ __forceinline__ void done(const pg8::Unit&) const {}
};
struct EpiSwiglu {
    static constexpr bool PERM = true, AFTER_DRAIN = false;
    bf16* hs; const float* bg; const float* bu;
    __device__ __forceinline__ void operator()(const pg8::f32x4 (&acc)[2][2][4][2], const pg8::Unit& u, int wr, int wc, int fr_, int fq_) const {
        int fr = fr_, fq = fq_; asm volatile("" : "+v"(fr), "+v"(fq));
        const int row0 = u.pm * 256 + wr * 64 + fr, f0 = u.pn * 128 + wc * 32 + 8 * fq;
        const pg8::f32x4 bg0 = *(const pg8::f32x4*)(bg + u.e * D + f0), bg1 = *(const pg8::f32x4*)(bg + u.e * D + f0 + 4);
        const pg8::f32x4 bu0 = *(const pg8::f32x4*)(bu + u.e * D + f0), bu1 = *(const pg8::f32x4*)(bu + u.e * D + f0 + 4);
#pragma unroll
        for (int ai = 0; ai < 2; ++ai)
#pragma unroll
            for (int m = 0; m < 4; ++m) {
                float h[8];
#pragma unroll
                for (int n = 0; n < 2; ++n) { const pg8::f32x4 ga = acc[ai][0][m][n] + (n ? bg1 : bg0), ua = acc[ai][1][m][n] + (n ? bu1 : bu0);
#pragma unroll
                    for (int j = 0; j < 4; ++j) { const float a = fminf(ga[j], 7.0f), uu = fminf(fmaxf(ua[j], -7.0f), 7.0f);
                        h[n * 4 + j] = a * __builtin_amdgcn_rcpf(1.0f + __expf(-1.702f * a)) * (uu + 1.0f); } }
                pg8::u32x4 w; w.x = pg8::cvt_pk_bf16(h[0], h[1]); w.y = pg8::cvt_pk_bf16(h[2], h[3]); w.z = pg8::cvt_pk_bf16(h[4], h[5]); w.w = pg8::cvt_pk_bf16(h[6], h[7]);
                *(pg8::u32x4*)(hs + (size_t)(row0 + ai * 128 + m * 16) * D + f0) = w; }
    }
};
struct EpiDown {
    static constexpr bool PERM = true, AFTER_DRAIN = false;
    bf16* ys; const float* bd;
    __device__ __forceinline__ void operator()(const pg8::f32x4 (&acc)[2][2][4][2], const pg8::Unit& u, int wr, int wc, int fr_, int fq_) const {
        int fr = fr_, fq = fq_; asm volatile("" : "+v"(fr), "+v"(fq));
        const int row0 = u.pm * 256 + wr * 64 + fr, col0 = u.pn * 256 + wc * 32 + 8 * fq;
        pg8::f32x4 bv[2][2];
#pragma unroll
        for (int bj = 0; bj < 2; ++bj)
#pragma unroll
            for (int n = 0; n < 2; ++n) bv[bj][n] = *(const pg8::f32x4*)(bd + u.e * D + col0 + bj * 128 + 4 * n);
#pragma unroll
        for (int ai = 0; ai < 2; ++ai)
#pragma unroll
            for (int m = 0; m < 4; ++m) { bf16* rowp = ys + (size_t)(row0 + ai * 128 + m * 16) * D + col0;
#pragma unroll
                for (int bj = 0; bj < 2; ++bj) { const pg8::f32x4 v0 = acc[ai][bj][m][0] + bv[bj][0], v1 = acc[ai][bj][m][1] + bv[bj][1]; pg8::u32x4 w;
                    w.x = pg8::cvt_pk_bf16(v0[0], v0[1]); w.y = pg8::cvt_pk_bf16(v0[2], v0[3]); w.z = pg8::cvt_pk_bf16(v1[0], v1[1]); w.w = pg8::cvt_pk_bf16(v1[2], v1[3]);
                    *(pg8::u32x4*)(rowp + bj * 128) = w; } }
    }
};

__device__ __forceinline__ void transpose_item(const float* W, int ldw, int col0, int K, bf16* WT, int drow0, LAS float* scr, int kb, int lane) {
    const int k0 = 64 * kb;
#pragma unroll 8
    for (int i = 0; i < 32; ++i) { const int kk = 2 * i + (lane >> 5); scr[kk * 33 + (lane & 31)] = W[(size_t)(k0 + kk) * ldw + col0 + (lane & 31)]; }
    LDS_WAIT(); asm volatile("" ::: "memory");
    const int c = lane & 7;
#pragma unroll
    for (int j = 0; j < 4; ++j) { const int n = (lane >> 3) + 8 * j; const LAS float* s = scr + (8 * c) * 33 + n;
        v4u o; o.x = pk2(s[0 * 33], s[1 * 33]); o.y = pk2(s[2 * 33], s[3 * 33]); o.z = pk2(s[4 * 33], s[5 * 33]); o.w = pk2(s[6 * 33], s[7 * 33]);
        *(v4u*)(WT + (size_t)(drow0 + n) * K + k0 + 8 * c) = o; }
    LDS_WAIT(); asm volatile("" ::: "memory");
}
__device__ __forceinline__ void convert_experts(const Frame& F, int l, int lo, int hi, int wi, int nw) {
    const KArgsP A = kargs();
    LAS float* scr = (LAS float*)(F.lds + F.wave * 16384);
    bf16* W1 = (bf16*)(F.ws + WS_W1); bf16* W2 = (bf16*)(F.ws + WS_W2);
    constexpr int IPM = 16 * 32;
    for (int it = lo + wi; it < hi; it += nw) {
        const int which = it / (NEXP * IPM), r = it % (NEXP * IPM), e = r / IPM, q = r % IPM, kb = q >> 5, nb = q & 31;
        const size_t moff = ((size_t)l * NEXP + e) * D * D;
        if (which == 0) transpose_item(A->in[I_WG] + moff, D, nb * 32, D, W1 + (size_t)e * 2048 * D, 256 * (nb >> 2) + 32 * (nb & 3), scr, kb, F.lane);
        else if (which == 1) transpose_item(A->in[I_WU] + moff, D, nb * 32, D, W1 + (size_t)e * 2048 * D, 256 * (nb >> 2) + 128 + 32 * (nb & 3), scr, kb, F.lane);
        else transpose_item(A->in[I_WD] + moff, D, nb * 32, D, W2 + (size_t)e * D * D, nb * 32, scr, kb, F.lane);
    }
}
__device__ __forceinline__ void p0_prologue(const Frame& F) {
    const KArgsP A = kargs();
    float* mv = (float*)(F.ws + WS_MODV);
    {
        LAS float* sc = (LAS float*)F.lds;
        LAS float* red = sc + 9 * 1024;
        for (int i = F.tid; i < 9 * 1024; i += NTHR) { const int r = i >> 10, k = i & 1023; sc[i] = silu_f(r < 8 ? A->in[I_C][r * D + k] : A->in[I_CCTX][k]); }
        __syncthreads();
        for (int item = blockIdx.x; item < 192; item += F.G) {
            const int l = item / 96, cg = item % 96, cl = F.tid & 63, ks = F.tid >> 6;
            const float* w = A->in[I_WMOD] + ((size_t)l * D + ks * 128) * 6144 + cg * 64 + cl;
            float a[9];
#pragma unroll
            for (int r = 0; r < 9; ++r) a[r] = 0.f;
#pragma unroll 4
            for (int k = 0; k < 128; ++k) { const float wv = w[(size_t)k * 6144];
#pragma unroll
                for (int r = 0; r < 9; ++r) a[r] += sc[r * 1024 + ks * 128 + k] * wv; }
#pragma unroll
            for (int r = 0; r < 9; ++r) red[(ks * 9 + r) * 64 + cl] = a[r];
            __syncthreads();
            for (int i = F.tid; i < 9 * 64; i += NTHR) { const int r = i >> 6, cc = i & 63; float s = 0.f;
#pragma unroll
                for (int k2 = 0; k2 < 8; ++k2) s += red[(k2 * 9 + r) * 64 + cc];
                mv[(size_t)(l * 9 + r) * 6144 + cg * 64 + cc] = s + A->in[I_BMOD][l * 6144 + cg * 64 + cc]; }
            __syncthreads();
        }
    }
    {
        LAS float* T = (LAS float*)F.lds;
        LAS float* cs = T + 64 * 129; LAS float* sn = cs + 128;
        __syncthreads();
        if (F.tid < 128) { cs[F.tid] = cospif((float)F.tid * (1.0f / 64.0f)); sn[F.tid] = sinpif((float)F.tid * (1.0f / 64.0f)); }
        for (int item = (blockIdx.x + 64) % F.G; item < 128; item += F.G) {
            const int l = item >> 6, kg = (item & 63) >> 2, g = item & 3;
            __syncthreads();
            for (int i = F.tid; i < 64 * 128; i += NTHR) { const int kk = i >> 7, cc = i & 127; T[kk * 129 + cc] = A->in[I_WIN][((size_t)l * D + kg * 64 + kk) * INW + g * 128 + cc]; }
            __syncthreads();
            const int kk = F.tid & 63, ng = F.tid >> 6;
            bf16* dst = (bf16*)(F.ws + WS_WIN) + ((size_t)l * 3072 + 2048 + g * 256) * D + kg * 64 + kk;
#pragma unroll 1
            for (int nn = 0; nn < 32; ++nn) { const int np = ng * 32 + nn, cp = np >> 1; float s = 0.f;
                if (np & 1) {
#pragma unroll 8
                    for (int cc = 0; cc < 128; ++cc) s -= T[kk * 129 + cc] * sn[(cc * cp) & 127]; }
                else {
#pragma unroll 8
                    for (int cc = 0; cc < 128; ++cc) s += T[kk * 129 + cc] * cs[(cc * cp) & 127]; }
                dst[(size_t)np * D] = (bf16)f2bf(s); }
        }
        __syncthreads();
    }
    {
        LAS float* scr = (LAS float*)(F.lds + F.wave * 16384);
        constexpr int I_IN = 16 * 64, I_OUT = 16 * 32;
        for (int it = F.gw; it < NL * (I_IN + I_OUT); it += F.NGW) {
            const int l = it / (I_IN + I_OUT), r = it % (I_IN + I_OUT);
            if (r < I_IN) transpose_item(A->in[I_WIN] + (size_t)l * D * INW, INW, 512 + 32 * (r & 63), D, (bf16*)(F.ws + WS_WIN) + (size_t)l * 3072 * D, 32 * (r & 63), scr, r >> 6, F.lane);
            else { const int q = r - I_IN; transpose_item(A->in[I_WOUT] + (size_t)l * D * D, D, 32 * (q & 31), D, (bf16*)(F.ws + WS_WOUT) + (size_t)l * D * D, 32 * (q & 31), scr, q >> 5, F.lane); }
        }
    }
    convert_experts(F, 0, 0, CVT_SPLIT, F.gw, F.NGW);
    {
        const int gt = F.gw * 64 + F.lane, NT = F.NGW * 64;
        float* wrt = (float*)(F.ws + WS_WRT); float* wabt = (float*)(F.ws + WS_WABT);
        for (int i = gt; i < NL * NEXP * D; i += NT) { const int l = i >> 15, e = (i >> 10) & 31, c = i & 1023; wrt[i] = A->in[I_WR][((size_t)l * D + c) * NEXP + e]; }
        for (int i = gt; i < NL * 16 * D; i += NT) { const int l = i >> 14, j = (i >> 10) & 15, c = i & 1023; wabt[i] = A->in[I_WIN][((size_t)l * D + c) * INW + 2560 + j]; }
        bf16* dm = (bf16*)(F.ws + WS_DFTM);
        for (int i = gt; i < 2 * 2048 * 256; i += NT) { const int mat = i >> 19, kf = (i >> 8) & 2047, j0 = (i & 255) * 8; float v[8];
#pragma unroll
            for (int jj = 0; jj < 8; ++jj) { const float a = (float)((kf * (j0 + jj)) & 4095) * (1.0f / 2048.0f); v[jj] = mat ? sinpif(a) : cospif(a); }
            v4u o; o.x = pk2(v[0], v[1]); o.y = pk2(v[2], v[3]); o.z = pk2(v[4], v[5]); o.w = pk2(v[6], v[7]);
            *(v4u*)(dm + (size_t)i * 8) = o; }
    }
}

template <int MODE>
__device__ __forceinline__ void row_pass(const Frame& F, int l_cur, int l_nxt, bool dummy = false) {
    const KArgsP A = kargs();
    LAS float* wl = (LAS float*)F.lds;
    if (MODE != 2) { const f32x4* src = (const f32x4*)((const float*)(F.ws + WS_WABT) + (size_t)l_nxt * 16 * D);
        for (int i = F.tid; i < 16 * D / 4; i += NTHR) ((LAS f32x4*)wl)[i] = src[i];
        __syncthreads(); }
    const int nrows = MODE == 2 ? NLAT : MT;
    const int* selp = (const int*)(F.ws + WS_SELP); const float* selg = (const float*)(F.ws + WS_SELG);
    const bf16* ys = (const bf16*)(F.ws + WS_XS);
    bf16* hx = (bf16*)(F.ws + WS_ACT); float* ab = (float*)(F.ws + WS_AB);
    f32x4 xc[4]; int dc[4]; float gc[4]; v2u yc[4][4];
    int t = F.gw;
    if (t < nrows) {
        const float* xin = MODE == 0 ? (t < NLAT ? A->in[I_X] + (size_t)t * D : A->in[I_CTX] + (size_t)(t - NLAT) * D) : xr_row(F, t);
#pragma unroll
        for (int j = 0; j < 4; ++j) xc[j] = *((const f32x4*)xin + F.lane + 64 * j);
        if (MODE != 0) {
#pragma unroll
            for (int k = 0; k < 4; ++k) { dc[k] = selp[t * 4 + k]; gc[k] = selg[t * 4 + k]; }
#pragma unroll
            for (int k = 0; k < 4; ++k) { const v2u* yr = (const v2u*)(ys + (size_t)dc[k] * D) + F.lane;
#pragma unroll
                for (int j = 0; j < 4; ++j) yc[k][j] = yr[64 * j]; } }
    }
    for (; t < nrows; t += F.NGW) {
        const int tn = t + F.NGW < nrows ? t + F.NGW : t;
        f32x4 xn[4]; int dn[4]; float gn[4];
        { const float* xin = MODE == 0 ? (tn < NLAT ? A->in[I_X] + (size_t)tn * D : A->in[I_CTX] + (size_t)(tn - NLAT) * D) : xr_row(F, tn);
#pragma unroll
          for (int j = 0; j < 4; ++j) xn[j] = *((const f32x4*)xin + F.lane + 64 * j);
          if (MODE != 0) {
#pragma unroll
              for (int k = 0; k < 4; ++k) { dn[k] = selp[tn * 4 + k]; gn[k] = selg[tn * 4 + k]; } } }
        const int r = mod_row(t);
        f32x4 v[4];
#pragma unroll
        for (int j = 0; j < 4; ++j) v[j] = xc[j];
        float* xr = xr_row(F, t);
        if (MODE != 0) {
            f32x4 y[4];
#pragma unroll
            for (int j = 0; j < 4; ++j) y[j] = (f32x4){0.f, 0.f, 0.f, 0.f};
#pragma unroll
            for (int k = 0; k < 4; ++k)
#pragma unroll
                for (int j = 0; j < 4; ++j) { const v2u w = yc[k][j]; y[j] += gc[k] * (f32x4){bflo(w.x), bfhi(w.x), bflo(w.y), bfhi(w.y)}; }
            const f32x4* g2 = (const f32x4*)modv(F, l_cur, r, 5) + F.lane;
#pragma unroll
            for (int j = 0; j < 4; ++j) v[j] += g2[64 * j] * y[j];
#pragma unroll
            for (int k = 0; k < 4; ++k) { const v2u* yr = (const v2u*)(ys + (size_t)dn[k] * D) + F.lane;
#pragma unroll
                for (int j = 0; j < 4; ++j) yc[k][j] = yr[64 * j]; }
        }
        if (MODE == 1 && !dummy) {
#pragma unroll
            for (int j = 0; j < 4; ++j) *((f32x4*)xr + F.lane + 64 * j) = v[j];
        }
        float ss = 0.f;
#pragma unroll
        for (int j = 0; j < 4; ++j) ss += (v[j].x * v[j].x + v[j].y * v[j].y) + (v[j].z * v[j].z + v[j].w * v[j].w);
        const float rstd = 1.0f / sqrtf(wave_sum(ss) * (1.0f / D) + EPS);
        if (MODE == 2) {
            const f32x4* gf = (const f32x4*)A->in[I_GF] + F.lane;
#pragma unroll
            for (int j = 0; j < 4; ++j) *((f32x4*)(F.out + (size_t)t * D) + F.lane + 64 * j) = v[j] * rstd * gf[64 * j];
        } else {
            const f32x4* g1 = (const f32x4*)(A->in[I_GN1] + (size_t)l_nxt * D) + F.lane;
            const f32x4* sh = (const f32x4*)modv(F, l_nxt, r, 0) + F.lane; const f32x4* scl = (const f32x4*)modv(F, l_nxt, r, 1) + F.lane;
            v2u* ho = (v2u*)(hx + (size_t)t * D) + F.lane;
#pragma unroll
            for (int j = 0; j < 4; ++j) { v[j] = v[j] * rstd * g1[64 * j] * (scl[64 * j] + 1.0f) + sh[64 * j]; v2u w; w.x = pk2(v[j].x, v[j].y); w.y = pk2(v[j].z, v[j].w); ho[64 * j] = w; }
            float pp[16];
            int lofs = F.lane; asm volatile("" : "+v"(lofs));
#pragma unroll
            for (int jj = 0; jj < 16; ++jj) { float p = 0.f;
#pragma unroll
                for (int j = 0; j < 4; ++j) { const f32x4 w = ((const LAS f32x4*)(wl + jj * D))[lofs + 64 * j]; p += (v[j].x * w.x + v[j].y * w.y) + (v[j].z * w.z + v[j].w * w.w); }
                pp[jj] = p; if ((jj & 3) == 3) asm volatile("" ::: "memory"); }
            const float mine = rs16(pp, F.lane);
            if ((F.lane & 3) == 0) ab[(size_t)t * 16 + (F.lane >> 2)] = mine;
        }
#pragma unroll
        for (int j = 0; j < 4; ++j) xc[j] = xn[j];
        if (MODE != 0) {
#pragma unroll
            for (int k = 0; k < 4; ++k) { dc[k] = dn[k]; gc[k] = gn[k]; } }
    }
}

__device__ __forceinline__ int seq_id(int x) { return x < 0 ? -1 : (x < NLAT ? (x >> 12) : (x < MT ? 8 + ((x - NLAT) >> 8) : -2)); }
__device__ __forceinline__ void conv_phase(const Frame& F, int l) {
    const KArgsP A = kargs();
    LAS float* cw = (LAS float*)F.lds;
    for (int i = F.tid; i < 5 * 1536; i += NTHR) cw[i] = A->in[I_CONVW][(size_t)l * 5 * 1536 + i];
    __syncthreads();
    const bf16* qkvz = (const bf16*)(F.ws + WS_QKVZ); bf16* qkvn = (bf16*)(F.ws + WS_QKVN);
    const float* ab = (const float*)(F.ws + WS_AB); float* gb = (float*)(F.ws + WS_G); float* bb = (float*)(F.ws + WS_BETA);
    constexpr int RUN = MT / (256 * NWAVES);
    static_assert(RUN * 256 * NWAVES == MT, "conv runs");
    for (int run = F.gw; run < MT / RUN; run += F.NGW) {
        const int t0 = run * RUN;
        v4u W[5][3];
#pragma unroll
        for (int k = 0; k < 5; ++k) { const int g = t0 + k - 2, gc = g < 0 ? 0 : (g >= MT ? MT - 1 : g);
#pragma unroll
            for (int q = 0; q < 3; ++q) W[k][q] = *(const v4u*)(qkvz + (size_t)gc * 2048 + q * 512 + 8 * F.lane); }
#pragma unroll 1
        for (int t = t0; t < t0 + RUN; ++t) {
            v4u N[3];
            { const int g = t + 3, gc = g >= MT ? MT - 1 : g;
#pragma unroll
              for (int q = 0; q < 3; ++q) N[q] = *(const v4u*)(qkvz + (size_t)gc * 2048 + q * 512 + 8 * F.lane); }
            const int sid = seq_id(t);
            float a[3][8];
#pragma unroll
            for (int q = 0; q < 3; ++q)
#pragma unroll
                for (int i = 0; i < 8; ++i) a[q][i] = 0.f;
#pragma unroll
            for (int tap = 0; tap < 5; ++tap) { const float vm = (seq_id(t + tap - 2) == sid) ? 1.0f : 0.0f;
#pragma unroll
                for (int q = 0; q < 3; ++q) { const v4u u = W[tap][q];
                    const LAS f32x4* wp = (const LAS f32x4*)(cw + tap * 1536 + q * 512 + 8 * F.lane); const f32x4 w0 = wp[0] * vm, w1 = wp[1] * vm;
                    a[q][0] += bflo(u.x) * w0.x; a[q][1] += bfhi(u.x) * w0.y; a[q][2] += bflo(u.y) * w0.z; a[q][3] += bfhi(u.y) * w0.w;
                    a[q][4] += bflo(u.z) * w1.x; a[q][5] += bfhi(u.z) * w1.y; a[q][6] += bflo(u.w) * w1.z; a[q][7] += bfhi(u.w) * w1.w; } }
#pragma unroll
            for (int q = 0; q < 3; ++q) { float ss = 0.f;
#pragma unroll
                for (int i = 0; i < 8; ++i) { a[q][i] = silu_f(a[q][i]); ss += a[q][i] * a[q][i]; }
                float sc = 1.0f;
                if (q < 2) { ss = sum16(ss); sc = (1.0f / sqrtf(ss + EPS)) * (q == 0 ? 0.08838834764831845f : 1.0f); }
                v4u o; o.x = pk2(a[q][0] * sc, a[q][1] * sc); o.y = pk2(a[q][2] * sc, a[q][3] * sc); o.z = pk2(a[q][4] * sc, a[q][5] * sc); o.w = pk2(a[q][6] * sc, a[q][7] * sc);
                *(v4u*)(qkvn + (size_t)t * 1536 + q * 512 + 8 * F.lane) = o; }
            if (F.lane < 8) { const int d = F.lane >> 2, h = F.lane & 3;
                const float xg = ab[(size_t)t * 16 + d * 8 + h] + A->in[I_DTB][l * 8 + d * 4 + h];
                const float sp = xg > 20.f ? xg : log1pf(expf(xg));
                gb[(size_t)t * 8 + F.lane] = -expf(A->in[I_ALOG][l * 8 + d * 4 + h]) * sp;
                bb[(size_t)t * 8 + F.lane] = 1.0f / (1.0f + expf(-ab[(size_t)t * 16 + d * 8 + 4 + h])); }
#pragma unroll
            for (int q = 0; q < 3; ++q) { W[0][q] = W[1][q]; W[1][q] = W[2][q]; W[2][q] = W[3][q]; W[3][q] = W[4][q]; W[4][q] = N[q]; }
        }
    }
}

__device__ __forceinline__ void fold_phase(const Frame& F) {
    const bf16* ztl = (const bf16*)(F.ws + WS_ZTL); bf16* eo = (bf16*)(F.ws + WS_EO); float* zn = (float*)(F.ws + WS_ZN);
    const int lam = F.lane;
    for (int row = F.gw; row < 8 * 512; row += F.NGW) {
        const int b = row >> 9, c = row & 511;
        const bf16* zr = ztl + (size_t)row * 8192; const bf16* zi = zr + 4096;
        v4u lo_r[4], hi_r[4], lo_i[4], hi_i[4];
#pragma unroll
        for (int q = 0; q < 4; ++q) { lo_r[q] = *(const v4u*)(zr + 32 * lam + 8 * q); hi_r[q] = *(const v4u*)(zr + 4064 - 32 * lam + 8 * q);
                                      lo_i[q] = *(const v4u*)(zi + 32 * lam + 8 * q); hi_i[q] = *(const v4u*)(zi + 4064 - 32 * lam + 8 * q); }
        float Lr[32], Hr[32], Li[32], Hi[32];
#pragma unroll
        for (int q = 0; q < 4; ++q)
#pragma unroll
            for (int e = 0; e < 4; ++e) { Lr[8 * q + 2 * e] = bflo(lo_r[q][e]); Lr[8 * q + 2 * e + 1] = bfhi(lo_r[q][e]); Hr[8 * q + 2 * e] = bflo(hi_r[q][e]); Hr[8 * q + 2 * e + 1] = bfhi(hi_r[q][e]);
                                          Li[8 * q + 2 * e] = bflo(lo_i[q][e]); Li[8 * q + 2 * e + 1] = bfhi(lo_i[q][e]); Hi[8 * q + 2 * e] = bflo(hi_i[q][e]); Hi[8 * q + 2 * e + 1] = bfhi(hi_i[q][e]); }
        float mr = __shfl_up(Hr[0], 1), mi = __shfl_up(Hi[0], 1); if (lam == 0) { mr = 0.f; mi = 0.f; }
        float E[32], O[32]; float ny = 0.f;
        E[0] = Lr[0] + mr; O[0] = lam == 0 ? 0.f : Li[0] - mi;
#pragma unroll
        for (int j = 1; j < 32; ++j) { E[j] = Lr[j] + Hr[32 - j]; O[j] = Li[j] - Hi[32 - j]; }
#pragma unroll
        for (int j = 0; j < 32; ++j) ny += (j & 1) ? -(Lr[j] + Hr[j]) : (Lr[j] + Hr[j]);
        ny = wave_sum(ny);
        bf16* ep = eo + ((size_t)(b * 2) * 512 + c) * 2048 + 32 * lam; bf16* op = ep + (size_t)512 * 2048;
#pragma unroll
        for (int q = 0; q < 4; ++q) { v4u e4, o4;
            e4.x = pk2(E[8 * q], E[8 * q + 1]); e4.y = pk2(E[8 * q + 2], E[8 * q + 3]); e4.z = pk2(E[8 * q + 4], E[8 * q + 5]); e4.w = pk2(E[8 * q + 6], E[8 * q + 7]);
            o4.x = pk2(O[8 * q], O[8 * q + 1]); o4.y = pk2(O[8 * q + 2], O[8 * q + 3]); o4.z = pk2(O[8 * q + 4], O[8 * q + 5]); o4.w = pk2(O[8 * q + 6], O[8 * q + 7]);
            *(v4u*)(ep + 8 * q) = e4; *(v4u*)(op + 8 * q) = o4; }
        if (lam == 63) zn[row] = Hr[0];
        if (lam == 0) zn[4096 + row] = ny;
    }
}

__device__ __forceinline__ void ctx_dft(const Frame& F) {
    LAS float* cs = (LAS float*)F.lds;
    LAS float* sn = cs + 256;
    LAS float* Z = sn + 256;
    const bf16* ztc = (const bf16*)(F.ws + WS_ZTC); bf16* mix = (bf16*)(F.ws + WS_ACT);
    const float scale = 1.0f / sqrtf(256.0f * 128.0f);
    __syncthreads();
    if (F.tid < 256) { cs[F.tid] = cospif((float)F.tid * (1.0f / 128.0f)); sn[F.tid] = sinpif((float)F.tid * (1.0f / 128.0f)); }
    for (int item = F.vcu - 128; item < 256; item += 128) {
        const int b = item >> 5, cg = item & 31;
        __syncthreads();
        for (int i = F.tid; i < 16 * 256; i += NTHR) { const int c = i >> 8, l2 = (i & 255) * 2; const unsigned w = *(const unsigned*)(ztc + ((size_t)b * 512 + cg * 16 + c) * 512 + l2);
            Z[c * 516 + l2] = bflo(w); Z[c * 516 + l2 + 1] = bfhi(w); }
        __syncthreads();
        const int c = F.tid & 15, lp0 = F.tid >> 4;
        float acc[8];
#pragma unroll
        for (int k = 0; k < 8; ++k) acc[k] = 0.f;
#pragma unroll 2
        for (int l = 0; l < 256; ++l) { const float zr = Z[c * 516 + l], zi = Z[c * 516 + 256 + l];
#pragma unroll
            for (int k = 0; k < 8; ++k) { const int idx = (l * (lp0 + 32 * k)) & 255; acc[k] += zr * cs[idx] + zi * sn[idx]; } }
#pragma unroll
        for (int k = 0; k < 8; ++k) mix[(size_t)(NLAT + b * 256 + lp0 + 32 * k) * D + cg * 16 + c] = (bf16)f2bf(acc[k] * scale);
    }
    __syncthreads();
}

__device__ __forceinline__ void scan_naive(const Frame& F, int l) {
    LAS float* kL = (LAS float*)F.lds;
    LAS float* qL = kL + 64 * 128;
    LAS float* vL = qL + 64 * 128;
    LAS float* oL = vL + 64 * 32;
    LAS float* gL = oL + 64 * 32;
    LAS float* bL = gL + 64;
    const bf16* qkvn = (const bf16*)(F.ws + WS_QKVN);
    const float* gb = (const float*)(F.ws + WS_G); const float* bb = (const float*)(F.ws + WS_BETA);
    for (int unit = F.vcu; unit < 256; unit += F.G) {
        const int qd = unit & 3, s = unit >> 2, d = s & 1, h = (s >> 1) & 3, b = s >> 3;
        bf16* od = (bf16*)(F.ws + (d ? WS_OB : WS_OF));
        const int j = F.tid >> 4, rg = F.tid & 15;
        float S[8];
#pragma unroll
        for (int i = 0; i < 8; ++i) S[i] = 0.f;
#pragma unroll 1
        for (int ci = 0; ci < 68; ++ci) {
            int rowbase; const bool isctx = ci < 4;
            if (isctx) rowbase = NLAT + b * 256 + (d ? 3 - ci : ci) * 64; else { const int lc = ci - 4; rowbase = b * SEQ + (d ? 63 - lc : lc) * 64; }
            __syncthreads();
            for (int i = F.tid; i < 64 * 16; i += NTHR) { const int r = i >> 4, g8 = i & 15; const bf16* rp = qkvn + (size_t)(rowbase + r) * 1536 + h * 128 + g8 * 8;
                const v4u q = *(const v4u*)rp, k = *(const v4u*)(rp + 512);
                LAS float* qo = qL + r * 128 + g8 * 8; LAS float* ko = kL + r * 128 + g8 * 8;
                qo[0] = bflo(q.x); qo[1] = bfhi(q.x); qo[2] = bflo(q.y); qo[3] = bfhi(q.y); qo[4] = bflo(q.z); qo[5] = bfhi(q.z); qo[6] = bflo(q.w); qo[7] = bfhi(q.w);
                ko[0] = bflo(k.x); ko[1] = bfhi(k.x); ko[2] = bflo(k.y); ko[3] = bfhi(k.y); ko[4] = bflo(k.z); ko[5] = bfhi(k.z); ko[6] = bflo(k.w); ko[7] = bfhi(k.w); }
            if (F.tid < 256) { const int r = F.tid >> 2, g8 = F.tid & 3; const v4u v = *(const v4u*)(qkvn + (size_t)(rowbase + r) * 1536 + 1024 + h * 128 + qd * 32 + g8 * 8);
                LAS float* vo = vL + r * 32 + g8 * 8;
                vo[0] = bflo(v.x); vo[1] = bfhi(v.x); vo[2] = bflo(v.y); vo[3] = bfhi(v.y); vo[4] = bflo(v.z); vo[5] = bfhi(v.z); vo[6] = bflo(v.w); vo[7] = bfhi(v.w); }
            else if (F.tid < 320) { const int r = F.tid - 256; gL[r] = __expf(gb[(size_t)(rowbase + r) * 8 + d * 4 + h]); bL[r] = bb[(size_t)(rowbase + r) * 8 + d * 4 + h]; }
            __syncthreads();
#pragma unroll 2
            for (int st = 0; st < 64; ++st) {
                const int r = d ? 63 - st : st;
                const float alpha = gL[r], bt = bL[r];
                const f32x4 k0 = *(const LAS f32x4*)(kL + r * 128 + rg * 8), k1 = *(const LAS f32x4*)(kL + r * 128 + rg * 8 + 4);
                const f32x4 q0 = *(const LAS f32x4*)(qL + r * 128 + rg * 8), q1 = *(const LAS f32x4*)(qL + r * 128 + rg * 8 + 4);
                float part = (k0.x * S[0] + k0.y * S[1]) + (k0.z * S[2] + k0.w * S[3]) + (k1.x * S[4] + k1.y * S[5]) + (k1.z * S[6] + k1.w * S[7]);
                part = sum16(part);
                const float dl = bt * (vL[r * 32 + j] - alpha * part);
                S[0] = alpha * S[0] + k0.x * dl; S[1] = alpha * S[1] + k0.y * dl; S[2] = alpha * S[2] + k0.z * dl; S[3] = alpha * S[3] + k0.w * dl;
                S[4] = alpha * S[4] + k1.x * dl; S[5] = alpha * S[5] + k1.y * dl; S[6] = alpha * S[6] + k1.z * dl; S[7] = alpha * S[7] + k1.w * dl;
                float op = (q0.x * S[0] + q0.y * S[1]) + (q0.z * S[2] + q0.w * S[3]) + (q1.x * S[4] + q1.y * S[5]) + (q1.z * S[6] + q1.w * S[7]);
                op = sum16(op);
                if (rg == 0) oL[r * 32 + j] = op;
            }
            __syncthreads();
            if (!(isctx && l == NL - 1)) { const int r = F.tid >> 3, g4 = F.tid & 7; const LAS float* op = oL + r * 32 + g4 * 4;
                v2u w; w.x = pk2(op[0], op[1]); w.y = pk2(op[2], op[3]);
                *(v2u*)(od + (size_t)(rowbase + r) * 512 + h * 128 + qd * 32 + g4 * 4) = w; }
        }
        __syncthreads();
    }
}

__device__ __forceinline__ void gated_out(const Frame& F, int l) {
    const KArgsP A = kargs();
    const bf16* of = (const bf16*)(F.ws + WS_OF); const bf16* ob = (const bf16*)(F.ws + WS_OB); const bf16* qkvz = (const bf16*)(F.ws + WS_QKVZ);
    const bf16* ab2 = (const bf16*)(F.ws + WS_AB2); const float* zn = (const float*)(F.ws + WS_ZN);
    bf16* mix = (bf16*)(F.ws + WS_ACT);
    const int nrows = l == NL - 1 ? NLAT : MT;
    const float fsc = 1.0f / sqrtf(4096.0f * 128.0f);
    const f32x4 g0 = *(const f32x4*)(A->in[I_GOUT] + l * 128 + (F.lane & 15) * 8), g1 = *(const f32x4*)(A->in[I_GOUT] + l * 128 + (F.lane & 15) * 8 + 4);
    for (int t = F.gw; t < nrows; t += F.NGW) {
        const v4u a = *(const v4u*)(of + (size_t)t * 512 + 8 * F.lane), b = *(const v4u*)(ob + (size_t)t * 512 + 8 * F.lane), z = *(const v4u*)(qkvz + (size_t)t * 2048 + 1536 + 8 * F.lane);
        if (t < NLAT) {
            const int bb_ = t >> 12, lp = t & 4095, k = lp <= 2048 ? lp : 4096 - lp;
            float y[8];
            if (k == 2048) { const f32x4 n0 = *(const f32x4*)(zn + 4096 + bb_ * 512 + 8 * F.lane), n1 = *(const f32x4*)(zn + 4096 + bb_ * 512 + 8 * F.lane + 4);
                y[0] = n0.x; y[1] = n0.y; y[2] = n0.z; y[3] = n0.w; y[4] = n1.x; y[5] = n1.y; y[6] = n1.z; y[7] = n1.w; }
            else { const v4u pa = *(const v4u*)(ab2 + ((size_t)(bb_ * 2) * 2048 + k) * 512 + 8 * F.lane), pb_ = *(const v4u*)(ab2 + ((size_t)(bb_ * 2 + 1) * 2048 + k) * 512 + 8 * F.lane);
                const f32x4 z0 = *(const f32x4*)(zn + bb_ * 512 + 8 * F.lane), z1 = *(const f32x4*)(zn + bb_ * 512 + 8 * F.lane + 4);
                const float sg = lp <= 2048 ? 1.0f : -1.0f, sz = (k & 1) ? -1.0f : 1.0f;
                y[0] = bflo(pa.x) + sg * bflo(pb_.x) + sz * z0.x; y[1] = bfhi(pa.x) + sg * bfhi(pb_.x) + sz * z0.y; y[2] = bflo(pa.y) + sg * bflo(pb_.y) + sz * z0.z; y[3] = bfhi(pa.y) + sg * bfhi(pb_.y) + sz * z0.w;
                y[4] = bflo(pa.z) + sg * bflo(pb_.z) + sz * z1.x; y[5] = bfhi(pa.z) + sg * bfhi(pb_.z) + sz * z1.y; y[6] = bflo(pa.w) + sg * bflo(pb_.w) + sz * z1.z; y[7] = bfhi(pa.w) + sg * bfhi(pb_.w) + sz * z1.w; }
            v4u wy; wy.x = pk2(y[0] * fsc, y[1] * fsc); wy.y = pk2(y[2] * fsc, y[3] * fsc); wy.z = pk2(y[4] * fsc, y[5] * fsc); wy.w = pk2(y[6] * fsc, y[7] * fsc);
            *(v4u*)(mix + (size_t)t * D + 8 * F.lane) = wy;
        }
        float o[8] = {bflo(a.x) + bflo(b.x), bfhi(a.x) + bfhi(b.x), bflo(a.y) + bflo(b.y), bfhi(a.y) + bfhi(b.y), bflo(a.z) + bflo(b.z), bfhi(a.z) + bfhi(b.z), bflo(a.w) + bflo(b.w), bfhi(a.w) + bfhi(b.w)};
        const float zz[8] = {bflo(z.x), bfhi(z.x), bflo(z.y), bfhi(z.y), bflo(z.z), bfhi(z.z), bflo(z.w), bfhi(z.w)};
        const float gg[8] = {g0.x, g0.y, g0.z, g0.w, g1.x, g1.y, g1.z, g1.w};
        float ss = 0.f;
#pragma unroll
        for (int i = 0; i < 8; ++i) ss += o[i] * o[i];
        const float rs = 1.0f / sqrtf(sum16(ss) * (1.0f / 128.0f) + EPS);
#pragma unroll
        for (int i = 0; i < 8; ++i) o[i] = o[i] * rs * gg[i] * silu_f(zz[i]);
        v4u w; w.x = pk2(o[0], o[1]); w.y = pk2(o[2], o[3]); w.z = pk2(o[4], o[5]); w.w = pk2(o[6], o[7]);
        *(v4u*)(mix + (size_t)t * D + 512 + 8 * F.lane) = w;
    }
}

__device__ __forceinline__ void router_phase(const Frame& F, int l, int bank = 0) {
    const KArgsP A = kargs();
    LAS float* wr = (LAS float*)F.lds;
    LAS int* lcnt = (LAS int*)(F.lds + XT_OFF);
    LAS int* lbase = lcnt + 32;
    LAS int* sE = lbase + 32;
    LAS int* sP = sE + 136 * 4;
    LAS float* sG = (LAS float*)(sP + 136 * 4);
    const int nrows = l == NL - 1 ? NLAT : MT, rpb = nrows / 256;
    { const f32x4* src = (const f32x4*)((const float*)(F.ws + WS_WRT) + (size_t)l * NEXP * D);
      for (int i = F.tid; i < NEXP * D / 4; i += NTHR) ((LAS f32x4*)wr)[i] = src[i];
      if (F.tid < 32) lcnt[F.tid] = 0; }
    __syncthreads();
    bf16* h2 = (bf16*)(F.ws + WS_ACT);
    const int row0 = F.vcu * rpb;
    if (F.vcu < 256) {
    for (int rl = F.wave; rl < rpb; rl += NWAVES) {
        const int t = row0 + rl, r = mod_row(t);
        const float* xr = xr_row(F, t);
        f32x4 v[4]; float ss = 0.f;
#pragma unroll
        for (int j = 0; j < 4; ++j) { v[j] = *((const f32x4*)xr + F.lane + 64 * j); ss += (v[j].x * v[j].x + v[j].y * v[j].y) + (v[j].z * v[j].z + v[j].w * v[j].w); }
        const float rstd = 1.0f / sqrtf(wave_sum(ss) * (1.0f / D) + EPS);
        const f32x4* g2 = (const f32x4*)(A->in[I_GN2] + (size_t)l * D) + F.lane;
        const f32x4* sh = (const f32x4*)modv(F, l, r, 3) + F.lane; const f32x4* scl = (const f32x4*)modv(F, l, r, 4) + F.lane;
        v2u* ho = (v2u*)(h2 + (size_t)t * D) + F.lane;
#pragma unroll
        for (int j = 0; j < 4; ++j) { v[j] = v[j] * rstd * g2[64 * j] * (scl[64 * j] + 1.0f) + sh[64 * j]; v2u w; w.x = pk2(v[j].x, v[j].y); w.y = pk2(v[j].z, v[j].w); ho[64 * j] = w; }
        float pe[32];
        int lofs = F.lane; asm volatile("" : "+v"(lofs));
#pragma unroll
        for (int e = 0; e < NEXP; ++e) { float p = 0.f;
#pragma unroll
            for (int j = 0; j < 4; ++j) { const f32x4 w = ((const LAS f32x4*)(wr + e * D))[lofs + 64 * j]; p += (v[j].x * w.x + v[j].y * w.y) + (v[j].z * w.z + v[j].w * w.w); }
            pe[e] = p; if ((e & 3) == 3) asm volatile("" ::: "memory"); }
        float lg = rs32(pe, F.lane) + A->in[I_BR][l * NEXP + (F.lane >> 1)];
        if (F.lane & 1) lg = -3.0e38f;
        int se[4]; float sv[4];
#pragma unroll
        for (int k = 0; k < 4; ++k) { float m = lg;
#pragma unroll
            for (int o = 1; o < 64; o <<= 1) m = fmaxf(m, __shfl_xor(m, o));
            const unsigned long long bal = __ballot(lg == m); const int idx = __ffsll((long long)bal) - 1;
            se[k] = idx >> 1; sv[k] = m; if (F.lane == idx) lg = -3.0e38f; }
        const float e1 = __expf(sv[1] - sv[0]), e2 = __expf(sv[2] - sv[0]), e3 = __expf(sv[3] - sv[0]), inv = 1.0f / (1.0f + e1 + e2 + e3);
        if (F.lane == 0) {
            const float gt[4] = {inv, e1 * inv, e2 * inv, e3 * inv};
#pragma unroll
            for (int k = 0; k < 4; ++k) { sE[rl * 4 + k] = se[k]; sP[rl * 4 + k] = __hip_atomic_fetch_add(lcnt + se[k], 1, __ATOMIC_RELAXED, __HIP_MEMORY_SCOPE_WORKGROUP); sG[rl * 4 + k] = gt[k]; } }
    }
    }
    __syncthreads();
    if (F.tid < 32) { const int n = lcnt[F.tid]; lbase[F.tid] = n ? (int)__hip_atomic_fetch_add(F.ctl + CW_GCNT + ((bank * 2 + l) * 32 + F.tid) * 64, (unsigned)n, RLX_AGENT) : 0; }
    __syncthreads();
    if (F.vcu < 256) {
        int* sele = (int*)(F.ws + WS_SELE); int* selp = (int*)(F.ws + WS_SELP); float* selg = (float*)(F.ws + WS_SELG);
        for (int i = F.tid; i < rpb * 4; i += NTHR) { const int e = sE[i]; sele[(size_t)row0 * 4 + i] = e; selp[(size_t)row0 * 4 + i] = lbase[e] + sP[i]; selg[(size_t)row0 * 4 + i] = sG[i]; }
    }
}
__device__ __forceinline__ void moe_layout(const Frame& F, int l, LAS int* pend, LAS int* pstart) {
    __syncthreads();
    if (F.tid < 64) {
        const int e = F.tid & 31;
        const int n = (int)__hip_atomic_load(F.ctl + CW_GCNT + (l * 32 + e) * 64, RLX_AGENT);
        const int nb = (F.tid < 32) ? ((n + 255) >> 8) : 0;
        int inc = nb;
#pragma unroll
        for (int o = 1; o < 32; o <<= 1) { const int t = __shfl_up(inc, o); if ((F.tid & 63) >= o) inc += t; }
        if (F.tid < 32) { pend[e] = inc; pstart[e] = (inc - nb) * 256; }
    }
    __syncthreads();
}
__device__ __forceinline__ void gather_phase(const Frame& F, int l, bool dummy = false) {
    LAS int* pend = (LAS int*)(F.lds + XT_OFF); LAS int* pstart = pend + 32;
    moe_layout(F, l, pend, pstart);
    const int nrows = l == NL - 1 ? NLAT : MT;
    const int* sele = (const int*)(F.ws + WS_SELE); int* selp = (int*)(F.ws + WS_SELP);
    unsigned* goff = (unsigned*)(F.ws + WS_GOFF);
    for (int it = F.gw * 64 + F.lane; it < nrows * 4; it += F.NGW * 64) {
        const int t = it >> 2, e = sele[it], dst = pstart[e] + selp[it];
        const int pm = dst >> 8, h = (dst >> 7) & 1, R = dst & 127;
        unsigned* gp = goff + (size_t)pm * 2048 + h * 2;
#pragma unroll
        for (int cp = 0; cp < 8; ++cp) { const int b = pg8::lds_byte(R, 8 * cp);
            gp[((b & 8191) >> 4) * 4 + (b >> 13)] = (unsigned)(t * 2048 + 16 * cp); }
        if (!dummy) selp[it] = dst;
    }
}


constexpr size_t WS_PW = WS_OB + 34 * MiB;
constexpr size_t WS_PKET = WS_PW + 68 * MiB;
constexpr size_t WS_PUT = WS_PKET + 68 * MiB;
constexpr size_t WS_PATT = WS_PUT + 68 * MiB;
constexpr size_t WS_PGAM = WS_PATT + 34 * MiB;
static_assert(WS_PGAM + 6 * MiB <= WS_END, "prep map");
typedef short bf16x8_t __attribute__((ext_vector_type(8)));
#define MFMA16(a, b, c) __builtin_amdgcn_mfma_f32_16x16x32_bf16((a), (b), (c), 0, 0, 0)
__device__ __forceinline__ v2u pack4(const f32x4 v) { v2u w; w.x = pk2(v.x, v.y); w.y = pk2(v.z, v.w); return w; }
__device__ __forceinline__ int chunk_rowbase(int b, int cn) { return cn < 4 ? NLAT + b * CTXL + cn * 64 : b * SEQ + (cn - 4) * 64; }

#ifdef PROBE_PREP
#define PSTAMP(k) do { const unsigned long long t_ = __builtin_amdgcn_s_memrealtime(); if (PROBE_PREP == (k)) pp_acc += t_ - pp_last; pp_last = t_; } while (0)
#else
#define PSTAMP(k) do {} while (0)
#endif
__device__ __forceinline__ void prep_phase(const Frame& F) {
#ifdef PROBE_PREP
    unsigned long long pp_acc = 0ull, pp_last = 0ull;
#endif
    LAS bf16* k_rm = (LAS bf16*)F.lds;
    LAS bf16* q_rm = k_rm + 64 * 136;
    LAS bf16* kT = (LAS bf16*)(F.lds + 36864);
    LAS bf16* vT = kT + 128 * 72;
    LAS float* Gm = (LAS float*)(F.lds + 36864 + 36864);
    LAS float* A0 = Gm + 64 * 72;
    LAS float* bs = (LAS float*)(F.lds + 36864 + 36864 + 36864);
    LAS float* gam = bs + 128;
    const bf16* qkvn = (const bf16*)(F.ws + WS_QKVN);
    const float* gb = (const float*)(F.ws + WS_G); const float* bb = (const float*)(F.ws + WS_BETA);
    const int w = F.wave;
    v4u ld[2][3];
    {
        int tid_ = F.tid; asm volatile("" : "+v"(tid_));
        const int unit = F.vcu;
        if (unit < 32 * 68) { const int bh = unit / 68, cn = unit % 68, rowbase = chunk_rowbase(bh >> 2, cn);
#pragma unroll
            for (int it = 0; it < 2; ++it) { const int p = tid_ + it * NTHR, i = p & 63, c8 = p >> 6; const bf16* rp = qkvn + (size_t)(rowbase + i) * 1536 + (bh & 3) * 128 + c8 * 8;
                ld[it][0] = *(const v4u*)rp; ld[it][1] = *(const v4u*)(rp + 512); ld[it][2] = *(const v4u*)(rp + 1024); } }
    }
    for (int unit = F.vcu; unit < 32 * 68; unit += F.G) {
        int tid_ = F.tid; asm volatile("" : "+v"(tid_));
        const int tid = tid_, lane = tid & 63, l15 = lane & 15, l4 = lane >> 4;
        const int bh = unit / 68, cn = unit % 68, b = bh >> 2, h = bh & 3, rowbase = chunk_rowbase(b, cn);
        const size_t pu = (size_t)(bh * 68 + cn) * 2;
        __syncthreads();
        PSTAMP(0);
#pragma unroll
        for (int it = 0; it < 2; ++it) { const int p = tid + it * NTHR, i = p & 63, c8 = p >> 6;
            const v4u qv = ld[it][0], kv = ld[it][1], vv = ld[it][2];
            *(LAS v4u*)(q_rm + i * 136 + c8 * 8) = qv; *(LAS v4u*)(k_rm + i * 136 + c8 * 8) = kv;
#pragma unroll
            for (int e = 0; e < 4; ++e) { const unsigned kw = kv[e], vw = vv[e];
                kT[(c8 * 8 + 2 * e) * 72 + i] = (bf16)(kw & 0xffffu); kT[(c8 * 8 + 2 * e + 1) * 72 + i] = (bf16)(kw >> 16);
                vT[(c8 * 8 + 2 * e) * 72 + i] = (bf16)(vw & 0xffffu); vT[(c8 * 8 + 2 * e + 1) * 72 + i] = (bf16)(vw >> 16); } }
        if (w < 2) { const int d = w; float g = gb[(size_t)(rowbase + lane) * 8 + d * 4 + h]; bs[d * 64 + lane] = bb[(size_t)(rowbase + lane) * 8 + d * 4 + h];
            if (d == 0) {
#pragma unroll
                for (int o = 1; o < 64; o <<= 1) { const float t = __shfl_up(g, o); if (lane >= o) g += t; } }
            else {
#pragma unroll
                for (int o = 1; o < 64; o <<= 1) { const float t = __shfl_down(g, o); if (lane + o < 64) g += t; } }
            gam[d * 64 + lane] = g; }
        {
            const int un = unit + F.G;
            if (un < 32 * 68) { const int bh2 = un / 68, cn2 = un % 68, rb2 = chunk_rowbase(bh2 >> 2, cn2);
#pragma unroll
                for (int it = 0; it < 2; ++it) { const int p = tid + it * NTHR, i = p & 63, c8 = p >> 6; const bf16* rp = qkvn + (size_t)(rb2 + i) * 1536 + (bh2 & 3) * 128 + c8 * 8;
                    ld[it][0] = *(const v4u*)rp; ld[it][1] = *(const v4u*)(rp + 512); ld[it][2] = *(const v4u*)(rp + 1024); } }
        }
        __syncthreads();
        PSTAMP(1);
#pragma unroll
        for (int tt = 0; tt < 2; ++tt) { const int idx = 2 * w + tt, ti = idx >> 2, tj = idx & 3;
            f32x4 aG = {0.f, 0.f, 0.f, 0.f}, aA = {0.f, 0.f, 0.f, 0.f};
#pragma unroll
            for (int ks = 0; ks < 4; ++ks) { const int co = 32 * ks + 8 * l4;
                const bf16x8_t bk = *(const LAS bf16x8_t*)(k_rm + (16 * tj + l15) * 136 + co), ak = *(const LAS bf16x8_t*)(k_rm + (16 * ti + l15) * 136 + co), aq = *(const LAS bf16x8_t*)(q_rm + (16 * ti + l15) * 136 + co);
                aG = MFMA16(ak, bk, aG); aA = MFMA16(aq, bk, aA); }
#pragma unroll
            for (int r = 0; r < 4; ++r) { Gm[(16 * ti + 4 * l4 + r) * 72 + 16 * tj + l15] = aG[r]; A0[(16 * ti + 4 * l4 + r) * 72 + 16 * tj + l15] = aA[r]; } }
        __syncthreads();
        PSTAMP(2);
        for (int idx = tid; idx < 8192; idx += NTHR) { const int d = idx >> 12, ip = (idx >> 6) & 63, jp = idx & 63, i = d ? 63 - ip : ip, j = d ? 63 - jp : jp;
            ((LAS float*)(F.lds + d * 18432))[idx & 4095] = jp < ip ? bs[d * 64 + i] * Gm[i * 72 + j] * __expf(gam[d * 64 + i] - gam[d * 64 + j]) : 0.f; }
        __syncthreads();
        PSTAMP(3);
        if (w < 2) {
            const int d = w; const LAS float* Lr = (const LAS float*)(F.lds + d * 18432);
            const int blk = lane >> 5, cc = lane & 31;
            const LAS float* Lb = Lr + (32 * blk) * 64 + 32 * blk;
            LAS bf16* SB = (LAS bf16*)(F.lds + 36864 + 36864 + 36864 + 1024 + d * 9216);
            LAS bf16* L21b = SB;
            LAS bf16* T22r = SB + 32 * 40;
            LAS bf16* T11T = SB + 64 * 40;
            LAS bf16* XT = T11T + 32 * 32;
            float t[32];
            f32x4 LA[8], LB[8];
#pragma unroll
            for (int ip = 0; ip < 32; ++ip) {
                if (ip + 1 < 32) {
#pragma unroll
                    for (int j4 = 0; j4 < (ip + 4) / 4; ++j4) { const f32x4 Lv = *(const LAS f32x4*)(Lb + (ip + 1) * 64 + 4 * j4); if (ip & 1) LA[j4] = Lv; else LB[j4] = Lv; }
                }
                float a0 = (cc == ip) ? 1.f : 0.f, a1 = 0.f, a2 = 0.f, a3 = 0.f;
#pragma unroll
                for (int j4 = 0; j4 < (ip + 3) / 4; ++j4) { const f32x4 Lv = (ip & 1) ? LB[j4] : LA[j4];
                    if (4 * j4 + 0 < ip) a0 -= Lv.x * t[4 * j4 + 0];
                    if (4 * j4 + 1 < ip) a1 -= Lv.y * t[4 * j4 + 1];
                    if (4 * j4 + 2 < ip) a2 -= Lv.z * t[4 * j4 + 2];
                    if (4 * j4 + 3 < ip) a3 -= Lv.w * t[4 * j4 + 3]; }
                t[ip] = (a0 + a1) + (a2 + a3); asm volatile("" ::: "memory"); }
            { const int i = lane >> 1, j0 = (lane & 1) * 16; const LAS f32x4* lp = (const LAS f32x4*)(Lr + (32 + i) * 64 + j0);
              const f32x4 x0 = lp[0], x1 = lp[1], x2 = lp[2], x3 = lp[3];
              v4u o0, o1; o0.x = pk2(x0.x, x0.y); o0.y = pk2(x0.z, x0.w); o0.z = pk2(x1.x, x1.y); o0.w = pk2(x1.z, x1.w); o1.x = pk2(x2.x, x2.y); o1.y = pk2(x2.z, x2.w); o1.z = pk2(x3.x, x3.y); o1.w = pk2(x3.z, x3.w);
              *(LAS v4u*)(L21b + i * 40 + j0) = o0; *(LAS v4u*)(L21b + i * 40 + j0 + 8) = o1; }
            if (blk == 0) {
#pragma unroll
                for (int q = 0; q < 4; ++q) { v4u o; o.x = pk2(t[8 * q], t[8 * q + 1]); o.y = pk2(t[8 * q + 2], t[8 * q + 3]); o.z = pk2(t[8 * q + 4], t[8 * q + 5]); o.w = pk2(t[8 * q + 6], t[8 * q + 7]);
                    *(LAS v4u*)(T11T + cc * 32 + 8 * q) = o; }
            } else {
#pragma unroll
                for (int ip = 0; ip < 32; ++ip) T22r[ip * 40 + cc] = (bf16)f2bf(t[ip]);
            }
            asm volatile("s_waitcnt lgkmcnt(0)" ::: "memory");
            f32x4 xa[2][2];
#pragma unroll
            for (int ti = 0; ti < 2; ++ti) { const bf16x8_t af = *(const LAS bf16x8_t*)(L21b + (16 * ti + l15) * 40 + 8 * l4);
#pragma unroll
                for (int tj = 0; tj < 2; ++tj) { const bf16x8_t bf = *(const LAS bf16x8_t*)(T11T + (16 * tj + l15) * 32 + 8 * l4);
                    xa[ti][tj] = MFMA16(af, bf, ((f32x4){0.f, 0.f, 0.f, 0.f}));
                    *(LAS v2u*)(XT + (16 * tj + l15) * 32 + 16 * ti + 4 * l4) = pack4(xa[ti][tj]); } }
            asm volatile("s_waitcnt lgkmcnt(0)" ::: "memory");
#pragma unroll
            for (int ti = 0; ti < 2; ++ti) { const bf16x8_t af = *(const LAS bf16x8_t*)(T22r + (16 * ti + l15) * 40 + 8 * l4);
#pragma unroll
                for (int tj = 0; tj < 2; ++tj) { const bf16x8_t bf = *(const LAS bf16x8_t*)(XT + (16 * tj + l15) * 32 + 8 * l4);
                    xa[ti][tj] = MFMA16(af, bf, ((f32x4){0.f, 0.f, 0.f, 0.f})); } }
            asm volatile("s_waitcnt lgkmcnt(0)" ::: "memory");
            LAS bf16* Tu = (LAS bf16*)(F.lds + d * 18432); LAS bf16* Tw = Tu + 64 * 72;
            {
                const int jp = 32 * blk + cc, jn = d ? 63 - jp : jp; const float bj = bs[d * 64 + jn], bge = bj * __expf(gam[d * 64 + jn]);
#pragma unroll
                for (int ip = 0; ip < 32; ++ip) { const int ipp = 32 * blk + ip, in = d ? 63 - ipp : ipp; Tu[in * 72 + jn] = (bf16)f2bf(t[ip] * bj); Tw[in * 72 + jn] = (bf16)f2bf(t[ip] * bge); }
                if (blk == 1) {
#pragma unroll
                    for (int ip = 0; ip < 32; ++ip) { const int in = d ? 63 - ip : ip; Tu[in * 72 + jn] = (bf16)0; Tw[in * 72 + jn] = (bf16)0; } }
            }
#pragma unroll
            for (int tj = 0; tj < 2; ++tj) {
                const int jp = 16 * tj + l15, jn = d ? 63 - jp : jp; const float bj = bs[d * 64 + jn], bge = bj * __expf(gam[d * 64 + jn]);
#pragma unroll
                for (int ti = 0; ti < 2; ++ti)
#pragma unroll
                    for (int r = 0; r < 4; ++r) { const int ipp = 32 + 16 * ti + 4 * l4 + r, in = d ? 63 - ipp : ipp; const float v = -xa[ti][tj][r];
                        Tu[in * 72 + jn] = (bf16)f2bf(v * bj); Tw[in * 72 + jn] = (bf16)f2bf(v * bge); } }
        } else {
            const int t6 = tid - 128;
            for (int it = t6; it < 1024; it += NTHR - 128) { const int d = it >> 9, i = (it >> 3) & 63, j0 = (it & 7) * 8; float v[8];
#pragma unroll
                for (int e = 0; e < 8; ++e) { const int j = j0 + e; const bool in = d ? (j >= i) : (j <= i); v[e] = in ? A0[i * 72 + j] * __expf(gam[d * 64 + i] - gam[d * 64 + j]) : 0.f; }
                v4u o; o.x = pk2(v[0], v[1]); o.y = pk2(v[2], v[3]); o.z = pk2(v[4], v[5]); o.w = pk2(v[6], v[7]);
                *(v4u*)((bf16*)(F.ws + WS_PATT) + (pu + d) * 4096 + ((((i >> 4) * 2 + (j0 >> 5)) * 16 + (i & 15)) * 32 + (j0 & 31))) = o; }
            for (int it = t6; it < 2048; it += NTHR - 128) { const int d = it >> 10, dk = (it >> 3) & 127, j0 = (it & 7) * 8; const float gl = d ? gam[64] : gam[63]; float v[8];
                const v4u kk = *(const LAS v4u*)(kT + dk * 72 + j0);
                v[0] = bflo(kk.x); v[1] = bfhi(kk.x); v[2] = bflo(kk.y); v[3] = bfhi(kk.y); v[4] = bflo(kk.z); v[5] = bfhi(kk.z); v[6] = bflo(kk.w); v[7] = bfhi(kk.w);
#pragma unroll
                for (int e = 0; e < 8; ++e) v[e] *= __expf(gl - gam[d * 64 + j0 + e]);
                v4u o; o.x = pk2(v[0], v[1]); o.y = pk2(v[2], v[3]); o.z = pk2(v[4], v[5]); o.w = pk2(v[6], v[7]);
                *(v4u*)((bf16*)(F.ws + WS_PKET) + (pu + d) * 8192 + ((((dk >> 4) * 2 + (j0 >> 5)) * 16 + (dk & 15)) * 32 + (j0 & 31))) = o; }
            if (t6 < 128) ((float*)(F.ws + WS_PGAM))[(pu + (t6 >> 6)) * 64 + (t6 & 63)] = gam[t6];
        }
        __syncthreads();
        PSTAMP(4);
        {
            const int d = w >> 2, ww = w & 3;
            const LAS bf16* Tu = (const LAS bf16*)(F.lds + d * 18432); const LAS bf16* Tw = Tu + 64 * 72;
            bf16x8_t tu[2], tw[2];
#pragma unroll
            for (int ks = 0; ks < 2; ++ks) { tu[ks] = *(const LAS bf16x8_t*)(Tu + (16 * ww + l15) * 72 + 32 * ks + 8 * l4); tw[ks] = *(const LAS bf16x8_t*)(Tw + (16 * ww + l15) * 72 + 32 * ks + 8 * l4); }
            bf16* ut = (bf16*)(F.ws + WS_PUT) + (pu + d) * 8192; bf16* wg = (bf16*)(F.ws + WS_PW) + (pu + d) * 8192;
#pragma unroll 2
            for (int tj = 0; tj < 8; ++tj) {
                f32x4 au = {0.f, 0.f, 0.f, 0.f}, aw = {0.f, 0.f, 0.f, 0.f};
#pragma unroll
                for (int ks = 0; ks < 2; ++ks) { const bf16x8_t bv = *(const LAS bf16x8_t*)(vT + (16 * tj + l15) * 72 + 32 * ks + 8 * l4), ak = *(const LAS bf16x8_t*)(kT + (16 * tj + l15) * 72 + 32 * ks + 8 * l4);
                    au = MFMA16(tu[ks], bv, au); aw = MFMA16(ak, tw[ks], aw); }
                *(v2u*)(ut + (((((tj >> 2) * 16 + l15) * 4 + ww) * 4 + l4) * 4 + (tj & 3)) * 4) = pack4(au);
                *(v2u*)(wg + ((ww * 4 + (tj >> 1)) * 16 + l15) * 32 + 16 * (tj & 1) + 4 * l4) = pack4(aw);
            }
        }
        PSTAMP(5);
    }
    __syncthreads();
#ifdef PROBE_PREP
    if (F.vcu == 0 && F.tid == 0) *(unsigned long long*)(F.ws + WS_ZN + 48 * 1024) += pp_acc;
#endif
}

struct ScanRegs { bf16x8_t fa[4], fx[2], kf[2]; f32x4 graw; float glast; int rowbase, cn; };
__device__ __forceinline__ void scan_load(ScanRegs& R, const unsigned char* ws, int ci_in, int b, int bh, int h, int d, int s, int w, int l15, int l4) {
    const int ci = ci_in < 68 ? ci_in : 67, rt = w & 3;
    const int cn = ci < 4 ? (d ? 3 - ci : ci) : 4 + (d ? 67 - ci : ci - 4);
    R.cn = cn; R.rowbase = chunk_rowbase(b, cn);
    const size_t pu = (size_t)(bh * 68 + cn) * 2 + d;
    const float* gmp = (const float*)(ws + WS_PGAM) + pu * 64;
    R.glast = gmp[d ? 0 : 63]; R.graw = *(const f32x4*)(gmp + 16 * rt + 4 * l4);
    const bf16* ket = (const bf16*)(ws + WS_PKET) + pu * 8192 + ((w * 2) * 16 + l15) * 32 + 8 * l4;
    R.kf[0] = *(const bf16x8_t*)ket; R.kf[1] = *(const bf16x8_t*)(ket + 512);
    const bf16* wp = (const bf16*)(ws + WS_PW) + pu * 8192 + ((rt * 4) * 16 + l15) * 32 + 8 * l4;
    const bf16* qp = (const bf16*)(ws + WS_QKVN) + (size_t)(R.rowbase + 16 * rt + l15) * 1536 + h * 128 + 8 * l4;
    const bf16* ap_ = w < 4 ? wp : qp; const int kst = w < 4 ? 512 : 32;
#pragma unroll
    for (int ks = 0; ks < 4; ++ks) R.fa[ks] = *(const bf16x8_t*)(ap_ + kst * ks);
    const bf16* up = (const bf16*)(ws + WS_PUT) + pu * 8192 + ((((s * 16 + l15) * 4 + rt) * 4 + l4) * 16);
    const bf16* ap = (const bf16*)(ws + WS_PATT) + pu * 4096 + ((rt * 2) * 16 + l15) * 32 + 8 * l4;
    const bf16* xp = w < 4 ? up : ap; const int xo = w < 4 ? 8 : 512;
    R.fx[0] = *(const bf16x8_t*)xp; R.fx[1] = *(const bf16x8_t*)(xp + xo);
#ifdef SCAN_DUP_LOADS
    { bf16x8_t d0 = *(const volatile bf16x8_t*)ket, d1 = *(const volatile bf16x8_t*)(ket + 512), d2 = *(const volatile bf16x8_t*)ap_, d3 = *(const volatile bf16x8_t*)(ap_ + kst), d4 = *(const volatile bf16x8_t*)(ap_ + 2 * kst), d5 = *(const volatile bf16x8_t*)(ap_ + 3 * kst), d6 = *(const volatile bf16x8_t*)xp, d7 = *(const volatile bf16x8_t*)(xp + xo);
      asm volatile("" :: "v"(d0), "v"(d1), "v"(d2), "v"(d3), "v"(d4), "v"(d5), "v"(d6), "v"(d7)); }
#endif
}
#if defined(PROBE_SCAN) && PROBE_SCAN >= 2
#define SCAN_SYNC(n) do { const unsigned long long t0_ = __builtin_amdgcn_s_memrealtime(); __syncthreads(); if (PROBE_SCAN == 2 || PROBE_SCAN == 2 + (n)) g_pacc += __builtin_amdgcn_s_memrealtime() - t0_; } while (0)
#else
#define SCAN_SYNC(n) __syncthreads()
#endif
__device__ __forceinline__ void scan_step(const ScanRegs& R, f32x4 (&S)[4], LAS bf16* ST, LAS bf16* vnT, LAS bf16* oS, bf16* od, bf16* dump, bool skip_ctx_out, int h, int s, int w, int l15, int l4, int tid, unsigned long long& g_pacc) {
#if defined(PROBE_SCAN) && PROBE_SCAN == 6
    const unsigned long long tp0_ = __builtin_amdgcn_s_memrealtime();
#endif
    const int rt = w & 3;
    const float gend = __expf(R.glast);
    const bool hiw = w >= 4;
    const f32x4 eg = {hiw ? __expf(R.graw.x) : 1.0f, hiw ? __expf(R.graw.y) : 1.0f, hiw ? __expf(R.graw.z) : 1.0f, hiw ? __expf(R.graw.w) : 1.0f};
    bf16x8_t fa[4];
#pragma unroll
    for (int ks = 0; ks < 4; ++ks) fa[ks] = R.fa[ks];
    f32x4 c[4];
#pragma unroll
    for (int ct = 0; ct < 4; ++ct) { c[ct] = (f32x4){0.f, 0.f, 0.f, 0.f};
#pragma unroll
        for (int ks = 0; ks < 4; ++ks) { const bf16x8_t bq = *(const LAS bf16x8_t*)(ST + (16 * ct + l15) * 136 + 32 * ks + 8 * l4); c[ct] = MFMA16(fa[ks], bq, c[ct]); }
        c[ct] = c[ct] * eg; }
    {
        const v4u ua = __builtin_bit_cast(v4u, R.fx[0]), ub = __builtin_bit_cast(v4u, R.fx[1]);
        const f32x4 u0 = {bflo(ua.x), bfhi(ua.x), bflo(ua.y), bfhi(ua.y)}, u1 = {bflo(ua.z), bfhi(ua.z), bflo(ua.w), bfhi(ua.w)};
        const f32x4 u2 = {bflo(ub.x), bfhi(ub.x), bflo(ub.y), bfhi(ub.y)}, u3 = {bflo(ub.z), bfhi(ub.z), bflo(ub.w), bfhi(ub.w)};
        LAS bf16* vp = vnT + (w < 4 ? 0 : 64 * 72) + l15 * 72 + 16 * rt + 4 * l4;
        *(LAS v2u*)(vp) = pack4(u0 - c[0]); *(LAS v2u*)(vp + 16 * 72) = pack4(u1 - c[1]); *(LAS v2u*)(vp + 32 * 72) = pack4(u2 - c[2]); *(LAS v2u*)(vp + 48 * 72) = pack4(u3 - c[3]);
    }
#if defined(PROBE_SCAN) && PROBE_SCAN == 6
    asm volatile("s_waitcnt lgkmcnt(0)" ::: "memory"); g_pacc += __builtin_amdgcn_s_memrealtime() - tp0_;
#endif
    SCAN_SYNC(1);
    {
        LAS bf16* op = oS + (w < 4 ? 64 * 72 : 0) + (16 * rt + 4 * l4) * 72 + l15;
#pragma unroll
        for (int ct = 0; ct < 4; ++ct) { const bf16x8_t v0 = *(const LAS bf16x8_t*)(vnT + (16 * ct + l15) * 72 + 8 * l4), v1 = *(const LAS bf16x8_t*)(vnT + (16 * ct + l15) * 72 + 32 + 8 * l4);
            f32x4 o = MFMA16(R.fx[0], v0, c[ct]); o = MFMA16(R.fx[1], v1, o);
#pragma unroll
            for (int r = 0; r < 4; ++r) op[r * 72 + 16 * ct] = (bf16)f2bf(o[r]);
            f32x4 sn = S[ct] * gend; sn = MFMA16(R.kf[0], v0, sn); sn = MFMA16(R.kf[1], v1, sn); S[ct] = sn;
            *(LAS v2u*)(ST + (16 * ct + l15) * 136 + 16 * w + 4 * l4) = pack4(sn); }
    }
    SCAN_SYNC(2);
    {
        const int i = tid >> 3, pc = tid & 7;
        const v4u ov = *(const LAS v4u*)(oS + i * 72 + pc * 8);
        const bool real = !(R.cn < 4 && skip_ctx_out);
        bf16* gp = real ? od + (size_t)(R.rowbase + i) * 512 + h * 128 + 64 * s + pc * 8 : dump + (size_t)i * 64 + pc * 8;
        *(v4u*)gp = ov;
    }
}
__device__ __forceinline__ void scan_mfma(const Frame& F, int l) {
    LAS bf16* ST = (LAS bf16*)F.lds;
    LAS bf16* vnT = ST + 64 * 136;
    LAS bf16* oS = vnT + 2 * 64 * 72;
    const int lane = F.lane, l15 = lane & 15, l4 = lane >> 4, w = F.wave;
    const bool skip_ctx_out = (l == NL - 1);
    if (w >= 4) __builtin_amdgcn_s_setprio(1);
    for (int unit = F.vcu; unit < 128; unit += F.G) {
        const int s = unit & 1, sd = unit >> 1, d = sd & 1, bh = sd >> 1, b = bh >> 2, h = bh & 3;
        bf16* od = (bf16*)(F.ws + (d ? WS_OB : WS_OF)); bf16* dump = (bf16*)(F.ws + WS_PGAM + 1536 * 1024) + (size_t)unit * 16 * 512;
        __syncthreads();
        for (int i = F.tid; i < 64 * 136 / 2; i += NTHR) ((LAS unsigned*)ST)[i] = 0u;
        f32x4 S[4];
#pragma unroll
        for (int ct = 0; ct < 4; ++ct) S[ct] = (f32x4){0.f, 0.f, 0.f, 0.f};
        ScanRegs R0, R1, R2;
        scan_load(R0, F.ws, 0, b, bh, h, d, s, w, l15, l4); scan_load(R1, F.ws, 1, b, bh, h, d, s, w, l15, l4); scan_load(R2, F.ws, 2, b, bh, h, d, s, w, l15, l4);
        __syncthreads();
        unsigned long long pacc = 0ull;
#pragma unroll 1
        for (int ci = 0; ci < 66; ci += 3) {
#if defined(PROBE_SCAN) && PROBE_SCAN == 1
            { const unsigned long long t0 = __builtin_amdgcn_s_memrealtime(); asm volatile("s_waitcnt vmcnt(0)" ::: "memory"); pacc += __builtin_amdgcn_s_memrealtime() - t0; }
#endif
            scan_step(R0, S, ST, vnT, oS, od, dump, skip_ctx_out, h, s, w, l15, l4, F.tid, pacc); scan_load(R0, F.ws, ci + 3, b, bh, h, d, s, w, l15, l4);
            scan_step(R1, S, ST, vnT, oS, od, dump, skip_ctx_out, h, s, w, l15, l4, F.tid, pacc); scan_load(R1, F.ws, ci + 4, b, bh, h, d, s, w, l15, l4);
            scan_step(R2, S, ST, vnT, oS, od, dump, skip_ctx_out, h, s, w, l15, l4, F.tid, pacc); scan_load(R2, F.ws, ci + 5, b, bh, h, d, s, w, l15, l4);
        }
        scan_step(R0, S, ST, vnT, oS, od, dump, skip_ctx_out, h, s, w, l15, l4, F.tid, pacc);
        scan_step(R1, S, ST, vnT, oS, od, dump, skip_ctx_out, h, s, w, l15, l4, F.tid, pacc);
   #ifdef PROBE_SCAN
        if (F.vcu == 0 && F.tid == PROBE_TID) *(unsigned long long*)(F.ws + WS_ZN + 48 * 1024) += pacc;
#endif
    }
    __builtin_amdgcn_s_setprio(0);
}


#ifndef USE_NAIVE_SCAN
#define USE_NAIVE_SCAN 0
#endif
#ifndef REP_MASK
#define REP_MASK 0
#endif
#define REPS(p) for (int _r = 0; _r < 1 + ((REP_MASK >> (p)) & 1); ++_r)
#define LASTREP(p) (_r == ((REP_MASK >> (p)) & 1))
constexpr int PH_PER_LAYER = 11, N_PHASES = 2 + NL * PH_PER_LAYER;
#ifndef PG8_SP2
#define PG8_SP2 true
#endif
#ifndef PG8_ALIGN
#define PG8_ALIGN true
#endif
__device__ __forceinline__ Frame make_frame(int wv) {
    extern __shared__ __attribute__((aligned(16))) unsigned char lds[];
    const KArgsP A = kargs();
    Frame F;
    { unsigned lb = (unsigned)(uintptr_t)(LAS unsigned char*)lds; asm volatile("" : "+s"(lb)); F.lds = (LAS unsigned char*)(uintptr_t)lb; }
    F.MISC = (volatile LAS unsigned*)(F.lds + MISC_OFF);
    { unsigned m1 = ~0u; asm volatile("" : "+s"(m1)); int ln = (int)__builtin_amdgcn_mbcnt_hi(m1, __builtin_amdgcn_mbcnt_lo(m1, 0u)); asm volatile("" : "+v"(ln)); F.lane = ln; }
    { int w_ = wv; asm volatile("" : "+s"(w_)); F.wave = w_; } F.tid = F.wave * 64 + F.lane;
    F.G = gridDim.x; { const int bx = blockIdx.x; F.vcu = (F.G % 8 == 0) ? (bx % 8) * (F.G / 8) + bx / 8 : bx; }
    F.gw = F.vcu * NWAVES + F.wave; F.NGW = F.G * NWAVES;
    F.ws = A->ws; F.ctl = (unsigned*)(A->ws + WS_CTL); F.out = A->out;
    return F;
}
__global__ void __launch_bounds__(NTHR, 2) mk_fwd(Args args) {
    const int wv = __builtin_amdgcn_readfirstlane((int)threadIdx.x >> 6);
    { Frame F = make_frame(wv);
      for (int u = F.tid; u < (LDS_BYTES - LDSCTL_OFF) / 4; u += NTHR) ((LAS unsigned*)(F.lds + LDSCTL_OFF))[u] = 0u;
      __syncthreads(); }
    const int lo = args.ph_lo, hi = args.ph_hi;
#if defined(PROBE_SCAN) || defined(PROBE_ROUTER) || defined(PROBE_PREP)
    { Frame Fp = make_frame(wv); if (Fp.vcu == 0 && Fp.tid == 0) *(unsigned long long*)(Fp.ws + WS_ZN + 48 * 1024) = 0ull; }
#endif
#ifdef PROBE_P
    unsigned long long pr_acc = 0ull, pr_t0 = 0ull;
#define PR_BEGIN(p) do { if (((p) < 2 ? (p) : 2 + ((p) - 2) % PH_PER_LAYER) == PROBE_P) pr_t0 = __builtin_amdgcn_s_memrealtime(); } while (0)
#define PR_END(p) do { if (((p) < 2 ? (p) : 2 + ((p) - 2) % PH_PER_LAYER) == PROBE_P) pr_acc += __builtin_amdgcn_s_memrealtime() - pr_t0; } while (0)
#else
#define PR_BEGIN(p) do {} while (0)
#define PR_END(p) do {} while (0)
#endif
    if (hi - lo > 1) { Frame F = make_frame(wv); (void)xcd_barrier_post((unsigned*)(F.ctl + CW_BAR), F.MISC + 8, F.tid); }
#define IN(k) (lo <= (k) && (k) < hi)
#define SEAM(k) do { if (IN(k) && IN((k) + 1)) { Frame Fb = make_frame(wv); XcdBarrier bar; bar.bar = (unsigned*)(Fb.ctl + CW_BAR); bar.x = xb_xcc_id(); bar.st = Fb.MISC + 8; xcd_barrier(bar, Fb.tid); } } while (0)
    PR_BEGIN(0); if (IN(0)) { Frame F = make_frame(wv); REPS(0) { p0_prologue(F); __syncthreads(); } }
    SEAM(0); PR_END(0);
    PR_BEGIN(1); if (IN(1)) { Frame F = make_frame(wv); REPS(1) { row_pass<0>(F, 0, 0); __syncthreads(); } }
    SEAM(1); PR_END(1);
#define LAYER_BODY(l) { \
        const int pb = 2 + l * PH_PER_LAYER; \
        PR_BEGIN(pb + 0); if (IN(pb + 0)) { Frame F = make_frame(wv); \
            SchedIn S{(const bf16*)(F.ws + WS_ACT), (const bf16*)(F.ws + WS_WIN) + (size_t)l * 3072 * D, F.G, (int)blockIdx.x}; \
            EpiIn E{(bf16*)(F.ws + WS_QKVZ), (bf16*)(F.ws + WS_ZTL), (bf16*)(F.ws + WS_ZTC)}; \
            REPS(8) { pg8::gemm_phase<EpiIn, SchedIn, PG8_ALIGN, PG8_SP2>(F.lds, pg8::Gemm{D}, S, E, F.tid); __syncthreads(); } } \
        SEAM(pb + 0); PR_END(pb + 0); \
        PR_BEGIN(pb + 1); if (IN(pb + 1)) { Frame F = make_frame(wv); REPS(2) { conv_phase(F, l); __syncthreads(); } fold_phase(F); } \
        SEAM(pb + 1); PR_END(pb + 1); \
        PR_BEGIN(pb + 2); if (IN(pb + 2)) { \
            { Frame F = make_frame(wv); REPS(3) { prep_phase(F); } } \
        } \
        SEAM(pb + 2); PR_END(pb + 2); \
        PR_BEGIN(pb + 3); if (IN(pb + 3)) { Frame F = make_frame(wv); \
            if (F.vcu < 128) { REPS(4) { scan_mfma(F, l); __syncthreads(); } } \
            else { \
              SchedDft S{(const bf16*)(F.ws + WS_DFTM), (const bf16*)(F.ws + WS_EO), F.vcu - 128}; \
              EpiDft E{(bf16*)(F.ws + WS_AB2)}; \
              REPS(9) { pg8::gemm_phase<EpiDft, SchedDft, PG8_ALIGN, PG8_SP2>(F.lds, pg8::Gemm{2048}, S, E, F.tid); __syncthreads(); } \
              if (l == 0) ctx_dft(F); \
              __syncthreads(); convert_experts(F, l, CVT_SPLIT, CVT_ITEMS, (F.vcu - 128) * NWAVES + F.wave, 128 * NWAVES); } \
        } \
        SEAM(pb + 3); PR_END(pb + 3); \
        PR_BEGIN(pb + 4); if (IN(pb + 4)) { Frame F = make_frame(wv); REPS(5) { gated_out(F, l); __syncthreads(); } } \
        SEAM(pb + 4); PR_END(pb + 4); \
        PR_BEGIN(pb + 5); if (IN(pb + 5)) { Frame F = make_frame(wv); \
            SchedOut S{(const bf16*)(F.ws + WS_ACT), (const bf16*)(F.ws + WS_WOUT) + (size_t)l * D * D, l == NL - 1 ? NLAT / 256 : MT / 256, F.G, (int)blockIdx.x}; \
            REPS(10) { EpiOut E{F.out, (float*)(F.ws + WS_XC), l == 0 ? kargs()->in[I_X] : (const float*)F.out, l == 0 ? kargs()->in[I_CTX] : (const float*)(F.ws + WS_XC), modv(F, l, 0, 2), LASTREP(10) ? 1.0f : 0.0f}; \
                pg8::gemm_phase<EpiOut, SchedOut, PG8_ALIGN, PG8_SP2>(F.lds, pg8::Gemm{D}, S, E, F.tid); __syncthreads(); } } \
        SEAM(pb + 5); PR_END(pb + 5); \
        PR_BEGIN(pb + 6); if (IN(pb + 6)) { Frame F = make_frame(wv); REPS(6) { router_phase(F, l, LASTREP(6) ? 0 : 1); __syncthreads(); } } \
        SEAM(pb + 6); PR_END(pb + 6); \
        PR_BEGIN(pb + 7); if (IN(pb + 7)) { Frame F = make_frame(wv); REPS(7) { gather_phase(F, l, !LASTREP(7)); __syncthreads(); } } \
        SEAM(pb + 7); PR_END(pb + 7); \
        PR_BEGIN(pb + 8); if (IN(pb + 8)) { Frame F = make_frame(wv); \
            LAS int* pend = (LAS int*)(F.lds + XT_OFF); moe_layout(F, l, pend, pend + 32); \
            SchedMoe S{(const bf16*)(F.ws + WS_ACT), (const bf16*)(F.ws + WS_W1), (size_t)2048 * D * 2, pend, pend[NEXP - 1], 8, F.G, (int)blockIdx.x, 1}; \
            EpiSwiglu E{(bf16*)(F.ws + WS_HS), kargs()->in[I_BG] + (size_t)l * NEXP * D, kargs()->in[I_BU] + (size_t)l * NEXP * D}; \
            REPS(11) { pg8::gemm_phase<EpiSwiglu, SchedMoe, PG8_ALIGN, PG8_SP2, true>(F.lds, pg8::Gemm{D}, S, E, F.tid, (const unsigned*)(F.ws + WS_GOFF), F.lds + XT_OFF + 1024, (unsigned)MT * 2048u); __syncthreads(); } } \
        SEAM(pb + 8); PR_END(pb + 8); \
        PR_BEGIN(pb + 9); if (IN(pb + 9)) { Frame F = make_frame(wv); \
            LAS int* pend = (LAS int*)(F.lds + XT_OFF); moe_layout(F, l, pend, pend + 32); \
            SchedMoe S{(const bf16*)(F.ws + WS_HS), (const bf16*)(F.ws + WS_W2), (size_t)D * D * 2, pend, pend[NEXP - 1], 4, F.G, (int)blockIdx.x, 0}; \
            EpiDown E{(bf16*)(F.ws + WS_XS), kargs()->in[I_BD] + (size_t)l * NEXP * D}; \
            REPS(12) { pg8::gemm_phase<EpiDown, SchedMoe, PG8_ALIGN, PG8_SP2>(F.lds, pg8::Gemm{D}, S, E, F.tid); __syncthreads(); } } \
        SEAM(pb + 9); PR_END(pb + 9); \
        PR_BEGIN(pb + 10); if (IN(pb + 10)) { \
            { Frame F = make_frame(wv); \
              if (l == NL - 1) row_pass<2>(F, l, l); else { REPS(13) { row_pass<1>(F, l, l + 1, !LASTREP(13)); __syncthreads(); } } } \
            if (l != NL - 1) { Frame F = make_frame(wv); __syncthreads(); REPS(14) { convert_experts(F, l + 1, 0, CVT_SPLIT, F.gw, F.NGW); __syncthreads(); } } \
        } \
        if (l + 1 < NL) SEAM(pb + 10); PR_END(pb + 10); \
    }
    LAYER_BODY(0)
    LAYER_BODY(1)
#undef LAYER_BODY
#ifdef PROBE_P
#if defined(PROBE_SCAN) || defined(PROBE_ROUTER) || defined(PROBE_PREP)
    { Frame Fp = make_frame(wv); if (Fp.vcu == 0 && Fp.tid == 0) pr_acc = *(unsigned long long*)(Fp.ws + WS_ZN + 48 * 1024); else pr_acc = 0; }
#endif
    if (blockIdx.x == 0 && threadIdx.x == 0) { const unsigned long long t0 = __builtin_amdgcn_s_memrealtime(), want = pr_acc * PROBE_SCALE; while (__builtin_amdgcn_s_memrealtime() - t0 < want) __builtin_amdgcn_s_sleep(8); }
#endif
#undef IN
#undef SEAM
}

extern "C" void kernel_launch(void* const* d_in, const int* in_sizes, int n_in, void* d_out, int out_size, void* d_ws, size_t ws_size, hipStream_t stream) {
    static int grid = 0;
    if (grid == 0) {
        if (n_in != 23 || out_size != NLAT * D || ws_size < WS_END) { fprintf(stderr, "kernel_launch: unexpected shapes (n_in %d, out %d, ws %zu); nothing launched\n", n_in, out_size, ws_size); grid = -1; return; }
        int dev = 0, cus = 0, per_cu = 0;
        if (hipGetDevice(&dev) != hipSuccess || hipDeviceGetAttribute(&cus, hipDeviceAttributeMultiprocessorCount, dev) != hipSuccess) { grid = -1; return; }
        if (hipFuncSetAttribute((const void*)mk_fwd, hipFuncAttributeMaxDynamicSharedMemorySize, LDS_BYTES) != hipSuccess) { fprintf(stderr, "kernel_launch: hipFuncSetAttribute failed\n"); grid = -1; return; }
        if (hipOccupancyMaxActiveBlocksPerMultiprocessor(&per_cu, (const void*)mk_fwd, NTHR, LDS_BYTES) != hipSuccess || per_cu < 1)
            fprintf(stderr, "kernel_launch: note: occupancy query reports %d workgroups per CU\n", per_cu);
        (void)hipGetLastError();
        grid = cus;
        if (grid != 256) { fprintf(stderr, "kernel_launch: built for 256 CUs, found %d; nothing launched\n", grid); grid = -1; return; }
    }
    if (grid < 0) return;
    if (hipMemsetAsync((char*)d_ws + WS_CTL, 0, CTL_ZERO_BYTES, stream) != hipSuccess) { fprintf(stderr, "kernel_launch: hipMemsetAsync failed\n"); return; }
    Args a{};
    for (int i = 0; i < 23; ++i) a.in[i] = (const float*)d_in[i];
    a.out = (float*)d_out; a.ws = (unsigned char*)d_ws;
#if MK_ONE_LAUNCH
    a.ph_lo = 0; a.ph_hi = N_PHASES;
    hipLaunchKernelGGL(mk_fwd, dim3(grid), dim3(NTHR), LDS_BYTES, stream, a);
#else
    for (int p = 0; p < N_PHASES; ++p) { a.ph_lo = p; a.ph_hi = p + 1; hipLaunchKernelGGL(mk_fwd, dim3(grid), dim3(NTHR), LDS_BYTES, stream, a); }
#endif
    const hipError_t le = hipPeekAtLastError();
    if (le != hipSuccess) fprintf(stderr, "kernel_launch: launch failed: %s\n", hipGetErrorName(le));
}
```

```cpp
#define MK_ONE_LAUNCH 1
#include <hip/hip_runtime.h>
#include <cstdio>
#include <cstdint>

#ifndef MK_ONE_LAUNCH
#define MK_ONE_LAUNCH 1
#endif

namespace pg8 {
#define PG8_LAS __attribute__((address_space(3)))
typedef unsigned short bf16_t;
typedef short bf16x8 __attribute__((ext_vector_type(8)));
typedef float f32x4 __attribute__((ext_vector_type(4)));
typedef unsigned u32x4 __attribute__((ext_vector_type(4)));
constexpr int BM = 256, BK = 64, HALF = 128, HTB = HALF * BK * 2  , STAGE_BYTES = 8 * HTB, NXCD = 8, WGM = 8;

__host__ __device__ __forceinline__ int lds_byte(int r, int c) { const int st = (r >> 4) * 2 + (c >> 5), rr = r & 15, cc = c & 31, ob = rr * 64 + cc * 2; return st * 1024 + (ob ^ (((ob >> 9) & 1) << 5)); }
__host__ __device__ __forceinline__ void stage_rc(int b, int& R, int& C) { const int st = b / 1024, sb = b % 1024, swz = sb ^ (((sb >> 9) & 1) << 5); R = (st >> 1) * 16 + swz / 64; C = (st & 1) * 32 + (swz % 64) / 2; }
__host__ __device__ __forceinline__ int perm32(int rho) { const int n = rho >> 4, i = rho & 15; return 8 * (i >> 2) + 4 * n + (i & 3); }

struct Unit { int pm, pn, kind, e; };
struct Gemm { int K; };

__device__ __forceinline__ int xcd_remap(int L, int nwg) { const int q = nwg / NXCD, r = nwg % NXCD, xcd = L % NXCD, off = L / NXCD; return (xcd < r ? xcd * (q + 1) : r * (q + 1) + (xcd - r) * q) + off; }
__device__ __forceinline__ void grp_decode(int wgid, int nM, int nN, int& pm, int& pn) { const int nig = WGM * nN, gid = wgid / nig, fm = gid * WGM, gsz = (nM - fm) < WGM ? (nM - fm) : WGM; pm = fm + ((wgid % nig) % gsz); pn = (wgid % nig) / gsz; }

__device__ __forceinline__ const char* uni_ptr(const char* p) { const unsigned long long v = (unsigned long long)p; const unsigned lo = __builtin_amdgcn_readfirstlane((unsigned)v), hi = __builtin_amdgcn_readfirstlane((unsigned)(v >> 32)); return (const char*)(((unsigned long long)hi << 32) | lo); }
__device__ __forceinline__ unsigned cvt_pk_bf16(float lo, float hi) { unsigned r; asm volatile("v_cvt_pk_bf16_f32 %0, %1, %2" : "=v"(r) : "v"(lo), "v"(hi)); return r; }

template <class Epi, class Sched, bool ALIGN_EPI = false, bool SP2 = false, bool GATHER = false>
__device__ __forceinline__ void gemm_phase(PG8_LAS unsigned char* lds, const Gemm g, const Sched& S, const Epi& E, int tid_in, const unsigned* gtab = nullptr, PG8_LAS unsigned char* gl_tab = nullptr, unsigned glim = 0u) {
    static_assert(!GATHER || SP2, "GATHER is written for the SP2 loop");
    int tid_ = tid_in; asm volatile("" : "+v"(tid_));
    const int tid = tid_, wid = __builtin_amdgcn_readfirstlane(tid >> 6), lane = tid & 63, wr = wid >> 2, wc = wid & 3, fr = lane & 15, fq = lane >> 4;
    const int K = g.K, nt = K / BK;
    unsigned voffA[2], voffB[2];
#pragma unroll
    for (int i = 0; i < 2; ++i) { int R, C; stage_rc(tid * 16 + i * 8192, R, C); const int Rb = Epi::PERM ? ((R & ~31) + perm32(R & 31)) : R;
        voffA[i] = (unsigned)(R * K + C) * 2u; voffB[i] = (unsigned)(Rb * K + C) * 2u; }
    const size_t kstep = (size_t)(BK * 2);
    const size_t hstep = (size_t)HALF * K * 2;
    const size_t tstep = 2 * hstep;
    const unsigned ldsw = (unsigned)wid * 1024u;
    const int aoff = lds_byte(wr * 64 + fr, fq * 8), boff = lds_byte(wc * 32 + fr, fq * 8);
#define PG8_SA(b, h) (((b) * 2 + (h)) * HTB)
#define PG8_SB(b, h) ((4 + (b) * 2 + (h)) * HTB)
#define PG8_STAGE(bufoff, gbase, voff) do { _Pragma("unroll") for (int _i = 0; _i < 2; ++_i) \
        __builtin_amdgcn_global_load_lds((const unsigned*)((const char*)(gbase) + (voff)[_i]), (PG8_LAS unsigned*)(lds + (bufoff) + ldsw + _i * 8192), 16, 0, 0); } while (0)
#define PG8_STAGE_G(bufoff, gbase, G, H) do { _Pragma("unroll") for (int _i = 0; _i < 2; ++_i) \
        __builtin_amdgcn_global_load_lds((const unsigned*)((const char*)(gbase) + (G)[H][_i]), (PG8_LAS unsigned*)(lds + (bufoff) + ldsw + _i * 8192), 16, 0, 0); } while (0)
#define PG8_STAGE_A(bufoff, gbase, G, H) do { if constexpr (GATHER) PG8_STAGE_G(bufoff, gbase, G, H); else PG8_STAGE(bufoff, (gbase) + (H) * hstep, voffA); } while (0)
#define PG8_TAB_ISSUE(u_) __builtin_amdgcn_global_load_lds(gtab + ((size_t)(u_).pm * 512 + tid) * 4, (PG8_LAS unsigned*)(gl_tab + wid * 1024), 16, 0, 0)
#define PG8_TAB_READ(G) do { const u32x4 gv_ = *(const PG8_LAS u32x4*)(gl_tab + tid * 16); G[0][0] = gv_.x < glim ? gv_.x : 0u; G[0][1] = gv_.y < glim ? gv_.y : 0u; G[1][0] = gv_.z < glim ? gv_.z : 0u; G[1][1] = gv_.w < glim ? gv_.w : 0u; } while (0)
#define PG8_LDA(dst, b, h) do { _Pragma("unroll") for (int m = 0; m < 4; ++m) _Pragma("unroll") for (int k = 0; k < 2; ++k) dst[m][k] = *(const PG8_LAS bf16x8*)(lds + PG8_SA(b, h) + aoff + m * 2048 + k * 1024); } while (0)
#define PG8_LDB(dst, b, h) do { _Pragma("unroll") for (int n = 0; n < 2; ++n) _Pragma("unroll") for (int k = 0; k < 2; ++k) dst[n][k] = *(const PG8_LAS bf16x8*)(lds + PG8_SB(b, h) + boff + n * 2048 + k * 1024); } while (0)
#define PG8_MMA(ai, bj, At, Bt) do { __builtin_amdgcn_s_setprio(1); _Pragma("unroll") for (int m = 0; m < 4; ++m) _Pragma("unroll") for (int n = 0; n < 2; ++n) _Pragma("unroll") for (int k = 0; k < 2; ++k) \
        acc[ai][bj][m][n] = __builtin_amdgcn_mfma_f32_16x16x32_bf16(Bt[n][k], At[m][k], acc[ai][bj][m][n], 0, 0, 0); __builtin_amdgcn_s_setprio(0); } while (0)
#define PG8_WAIT_V(n) asm volatile("s_waitcnt vmcnt(" #n ")" ::: "memory")
#define PG8_WAIT_L(n) asm volatile("s_waitcnt lgkmcnt(" #n ")" ::: "memory")
#define PG8_BAR __builtin_amdgcn_s_barrier()
#define PG8_SCHED __builtin_amdgcn_sched_barrier(0)
    Unit cur, nxt; int ui = 0;
    if (!S.next(0, cur)) return;
    f32x4 acc[2][2][4][2];
#pragma unroll
    for (int a = 0; a < 2; ++a)
#pragma unroll
        for (int b = 0; b < 2; ++b)
#pragma unroll
            for (int m = 0; m < 4; ++m)
#pragma unroll
                for (int n = 0; n < 2; ++n) acc[a][b][m][n] = (f32x4){0.f, 0.f, 0.f, 0.f};
    bf16x8 At[4][2], B0[2][2], B1[2][2];
    const char* cA = uni_ptr(S.a_base(cur, tstep)); const char* cB = uni_ptr(S.b_base(cur, tstep));
    S.a_ready(cur);
    unsigned gC[2][2] = {{0u, 0u}, {0u, 0u}}, gN[2][2] = {{0u, 0u}, {0u, 0u}};
    if constexpr (GATHER) { PG8_TAB_ISSUE(cur); asm volatile("s_waitcnt vmcnt(0)" ::: "memory"); __builtin_amdgcn_s_barrier(); asm volatile("" ::: "memory"); PG8_TAB_READ(gC); }
    if constexpr (SP2) {
        PG8_STAGE(PG8_SB(0, 0), cB, voffB); PG8_STAGE(PG8_SB(0, 1), cB + hstep, voffB); PG8_STAGE_A(PG8_SA(0, 0), cA, gC, 0); PG8_STAGE_A(PG8_SA(0, 1), cA, gC, 1);
        if (wr == 1) PG8_BAR;
        PG8_WAIT_V(2); PG8_BAR;
        PG8_STAGE(PG8_SB(1, 0), cB + kstep, voffB); PG8_STAGE_A(PG8_SA(1, 0), cA + kstep, gC, 0); PG8_STAGE(PG8_SB(1, 1), cB + hstep + kstep, voffB);
        PG8_WAIT_V(6); PG8_BAR;
    } else {
        PG8_STAGE(PG8_SB(0, 0), cB, voffB); PG8_STAGE(PG8_SA(0, 0), cA, voffA); PG8_STAGE(PG8_SB(0, 1), cB + hstep, voffB); PG8_STAGE(PG8_SA(0, 1), cA + hstep, voffA);
        if (wr == 1) PG8_BAR;
        PG8_WAIT_V(4); PG8_BAR;
        PG8_STAGE(PG8_SB(1, 0), cB + kstep, voffB); PG8_STAGE(PG8_SA(1, 0), cA + kstep, voffA); PG8_STAGE(PG8_SB(1, 1), cB + hstep + kstep, voffB);
        PG8_WAIT_V(6); PG8_BAR;
    }
    for (;;) {
        const bool has_next = S.next(ui + 1, nxt);
        const char* nA = uni_ptr(has_next ? S.a_base(nxt, tstep) : cA); const char* nB = uni_ptr(has_next ? S.b_base(nxt, tstep) : cB);
        for (int t = 0; t < nt; t += 2) {
            const bool last = (t == nt - 2);
            const char* a1 = cA + (size_t)(t + 1) * kstep;
            const char* a2 = last ? nA : cA + (size_t)(t + 2) * kstep; const char* b2 = last ? nB : cB + (size_t)(t + 2) * kstep;
            const char* a3 = a2 + kstep; const char* b3 = b2 + kstep;
            if (last && has_next) S.a_ready(nxt);
            unsigned g2[2][2] = {{gC[0][0], gC[0][1]}, {gC[1][0], gC[1][1]}};
            if constexpr (GATHER) {
                if (t == nt - 4 && has_next) PG8_TAB_ISSUE(nxt);
                if (last && has_next) { PG8_TAB_READ(gN); g2[0][0] = gN[0][0]; g2[0][1] = gN[0][1]; g2[1][0] = gN[1][0]; g2[1][1] = gN[1][1]; }
            }
            if constexpr (SP2) {
            PG8_LDB(B0, 0, 0); PG8_LDB(B1, 0, 1); PG8_SCHED; PG8_LDA(At, 0, 0); PG8_STAGE_A(PG8_SA(1, 1), a1, gC, 1);
            PG8_WAIT_V(8); PG8_WAIT_L(0); PG8_BAR; PG8_MMA(0, 0, At, B0); PG8_MMA(0, 1, At, B1); PG8_BAR; PG8_SCHED;
            PG8_LDA(At, 0, 1); PG8_STAGE(PG8_SB(0, 0), b2, voffB); PG8_STAGE(PG8_SB(0, 1), b2 + hstep, voffB); PG8_STAGE_A(PG8_SA(0, 0), a2, g2, 0);
            PG8_WAIT_V(8); PG8_WAIT_L(0); PG8_BAR; PG8_MMA(1, 0, At, B0); PG8_MMA(1, 1, At, B1); PG8_BAR; PG8_SCHED;
            PG8_LDB(B0, 1, 0); PG8_LDB(B1, 1, 1); PG8_SCHED; PG8_LDA(At, 1, 0); PG8_STAGE_A(PG8_SA(0, 1), a2, g2, 1);
            PG8_WAIT_V(8); PG8_WAIT_L(0); PG8_BAR; PG8_MMA(0, 0, At, B0); PG8_MMA(0, 1, At, B1); PG8_BAR; PG8_SCHED;
            PG8_LDA(At, 1, 1); PG8_STAGE(PG8_SB(1, 0), b3, voffB); PG8_STAGE(PG8_SB(1, 1), b3 + hstep, voffB); PG8_STAGE_A(PG8_SA(1, 0), a3, g2, 0);
            PG8_WAIT_V(8); PG8_WAIT_L(0); PG8_BAR; PG8_MMA(1, 0, At, B0); PG8_MMA(1, 1, At, B1); PG8_BAR; PG8_SCHED;
            } else {
            PG8_LDB(B0, 0, 0); PG8_SCHED; PG8_LDA(At, 0, 0); PG8_STAGE(PG8_SA(1, 1), a1 + hstep, voffA);
            PG8_WAIT_L(8); PG8_BAR; PG8_WAIT_L(0); PG8_MMA(0, 0, At, B0); PG8_BAR; PG8_SCHED;
            PG8_LDB(B1, 0, 1); PG8_STAGE(PG8_SB(0, 0), b2, voffB);
            PG8_BAR; PG8_WAIT_L(0); PG8_MMA(0, 1, At, B1); PG8_BAR;
            PG8_LDA(At, 0, 1); PG8_STAGE(PG8_SA(0, 0), a2, voffA);
            PG8_BAR; PG8_WAIT_L(0); PG8_MMA(1, 0, At, B0); PG8_BAR; PG8_SCHED;
            PG8_STAGE(PG8_SB(0, 1), b2 + hstep, voffB);
            PG8_WAIT_V(6); PG8_BAR; PG8_MMA(1, 1, At, B1); PG8_BAR;
            PG8_LDB(B0, 1, 0); PG8_SCHED; PG8_LDA(At, 1, 0); PG8_STAGE(PG8_SA(0, 1), a2 + hstep, voffA);
            PG8_WAIT_L(8); PG8_BAR; PG8_WAIT_L(0); PG8_MMA(0, 0, At, B0); PG8_BAR; PG8_SCHED;
            PG8_LDB(B1, 1, 1); PG8_STAGE(PG8_SB(1, 0), b3, voffB);
            PG8_BAR; PG8_WAIT_L(0); PG8_MMA(0, 1, At, B1); PG8_BAR;
            PG8_LDA(At, 1, 1); PG8_STAGE(PG8_SA(1, 0), a3, voffA);
            PG8_BAR; PG8_WAIT_L(0); PG8_MMA(1, 0, At, B0); PG8_BAR; PG8_SCHED;
            PG8_STAGE(PG8_SB(1, 1), b3 + hstep, voffB);
            PG8_WAIT_V(6); PG8_BAR; PG8_MMA(1, 1, At, B1); PG8_BAR;
            }
        }
        if constexpr (ALIGN_EPI) { if (wr == 0) PG8_BAR; }
        if constexpr (!Epi::AFTER_DRAIN) { E(acc, cur, wr, wc, fr, fq); S.done(cur); }
        if (!has_next) break;
#pragma unroll
        for (int a = 0; a < 2; ++a)
#pragma unroll
            for (int b = 0; b < 2; ++b)
#pragma unroll
                for (int m = 0; m < 4; ++m)
#pragma unroll
                    for (int n = 0; n < 2; ++n) acc[a][b][m][n] = (f32x4){0.f, 0.f, 0.f, 0.f};
        cur = nxt; cA = nA; cB = nB; ++ui;
        if constexpr (GATHER) { gC[0][0] = gN[0][0]; gC[0][1] = gN[0][1]; gC[1][0] = gN[1][0]; gC[1][1] = gN[1][1]; }
        if constexpr (ALIGN_EPI) { if (wr == 1) PG8_BAR; }
    }
    PG8_WAIT_V(0);
    if constexpr (!ALIGN_EPI) { if (wr == 0) PG8_BAR; }
    PG8_BAR;
    if constexpr (Epi::AFTER_DRAIN) { E.fused(acc, cur, wr, wc, fr, fq, lds, wid, lane); S.done(cur); }
#undef PG8_SA
#undef PG8_SB
#undef PG8_STAGE
#undef PG8_STAGE_G
#undef PG8_STAGE_A
#undef PG8_TAB_ISSUE
#undef PG8_TAB_READ
#undef PG8_LDA
#undef PG8_LDB
#undef PG8_MMA
#undef PG8_WAIT_V
#undef PG8_WAIT_L
#undef PG8_BAR
#undef PG8_SCHED
}
}

constexpr int NWAVES = 8, NTHR = 512;
constexpr int D = 1024, NB = 8, SEQ = 4096, CTXL = 256, NL = 2;
constexpr int NLAT = NB * SEQ;
constexpr int NCTX = NB * CTXL;
constexpr int MT = NLAT + NCTX;
constexpr int INW = 2576, NEXP = 32, TOPK = 4;
constexpr int PMAX = (MT * TOPK / 256 + NEXP) * 256;
constexpr float EPS = 1e-6f;
#ifndef CVT_NUM
#define CVT_NUM 5
#endif
constexpr int CVT_ITEMS = 3 * 32 * 512, CVT_SPLIT = (CVT_ITEMS * CVT_NUM / 8) / 512 * 512;

constexpr size_t MiB = 1u << 20;
constexpr size_t WS_CTL = 0, CTL_ZERO_BYTES = 1 * MiB;
constexpr size_t WS_MODV = 1 * MiB;
constexpr size_t WS_WRT = 2 * MiB;
constexpr size_t WS_WABT = WS_WRT + 512 * 1024;
constexpr size_t WS_SELE = 3 * MiB;
constexpr size_t WS_SELP = WS_SELE + 640 * 1024;
constexpr size_t WS_SELG = WS_SELP + 640 * 1024;
constexpr size_t WS_G = 5 * MiB;
constexpr size_t WS_BETA = WS_G + 1536 * 1024;
constexpr size_t WS_AB = 8 * MiB;
constexpr size_t WS_WIN = 12 * MiB;
constexpr size_t WS_WOUT = 24 * MiB;
constexpr size_t WS_DFTM = 32 * MiB;
constexpr size_t WS_W1 = 96 * MiB;
constexpr size_t WS_W2 = 224 * MiB;
constexpr size_t WS_XC = 288 * MiB;
constexpr size_t WS_ACT = 296 * MiB;
constexpr size_t WS_S = 364 * MiB;
constexpr size_t WS_QKVZ = WS_S;
constexpr size_t WS_ZTL = WS_S + 136 * MiB;
constexpr size_t WS_ZTC = WS_ZTL + 64 * MiB;
constexpr size_t WS_QKVN = WS_ZTC + 4 * MiB;
constexpr size_t WS_OF = WS_QKVN + 102 * MiB;
constexpr size_t WS_OB = WS_OF + 34 * MiB;
constexpr size_t WS_XS = WS_S;
constexpr size_t WS_HS = WS_S + 288 * MiB;
constexpr size_t WS_EO = 984 * MiB;
constexpr size_t WS_AB2 = WS_ZTL;
constexpr size_t WS_ZN = 11 * MiB - 64 * 1024;
constexpr size_t WS_GOFF = 944 * MiB;
constexpr size_t WS_END = 1024 * MiB;
static_assert(WS_OB + 34 * MiB <= WS_END && WS_HS + 288 * MiB <= WS_END && (size_t)PMAX * 1024 * 2 == 288 * MiB, "d_ws map");
static_assert((size_t)MT * 16 <= 640 * 1024 && (size_t)MT * 32 <= 1536 * 1024, "sel / g maps");
constexpr int CW_BAR = 4096;
constexpr int CW_GCNT = 16384;

constexpr int RING_BYTES = 131072;
constexpr int LDSCTL_OFF = RING_BYTES, MISC_OFF = LDSCTL_OFF + 320;
constexpr int XT_OFF = RING_BYTES + 1024;
constexpr int LDS_BYTES = 147456;

#define GAS __attribute__((address_space(1)))
#define LAS __attribute__((address_space(3)))
typedef unsigned short bf16;
typedef unsigned v4u __attribute__((ext_vector_type(4)));
typedef unsigned v2u __attribute__((ext_vector_type(2)));
typedef float f32x4 __attribute__((ext_vector_type(4)));
typedef GAS unsigned gu32;
#define RLX_AGENT __ATOMIC_RELAXED, __HIP_MEMORY_SCOPE_AGENT
#define LDS_WAIT() asm volatile("s_waitcnt lgkmcnt(0)" ::: "memory")
#define VM_WAIT() asm volatile("s_waitcnt vmcnt(0)" ::: "memory")
typedef float f32x2_t __attribute__((ext_vector_type(2))); typedef __bf16 bf16x2_t __attribute__((ext_vector_type(2)));
__device__ __forceinline__ unsigned pk2(float lo, float hi) { const f32x2_t v = {lo, hi}; const bf16x2_t b = __builtin_convertvector(v, bf16x2_t); return __builtin_bit_cast(unsigned, b); }
__device__ __forceinline__ unsigned f2bf(float f) { return pk2(f, 0.f) & 0xffffu; }
__device__ __forceinline__ float bflo(unsigned w) { return __builtin_bit_cast(float, w << 16); }
__device__ __forceinline__ float bfhi(unsigned w) { return __builtin_bit_cast(float, w & 0xffff0000u); }
__device__ __forceinline__ float wave_sum(float v) {
#pragma unroll
    for (int o = 1; o < 64; o <<= 1) v += __shfl_xor(v, o);
    return v;
}
__device__ __forceinline__ float sum16(float v) {
#pragma unroll
    for (int o = 1; o < 16; o <<= 1) v += __shfl_xor(v, o);
    return v;
}
__device__ __forceinline__ float rs32(float (&p)[32], int lane) {
#pragma unroll
    for (int e = 0; e < 16; ++e) { const bool up = (lane & 32) != 0; const float send = up ? p[e] : p[e + 16], keep = up ? p[e + 16] : p[e]; p[e] = keep + __shfl_xor(send, 32); }
#pragma unroll
    for (int e = 0; e < 8; ++e) { const bool up = (lane & 16) != 0; const float send = up ? p[e] : p[e + 8], keep = up ? p[e + 8] : p[e]; p[e] = keep + __shfl_xor(send, 16); }
#pragma unroll
    for (int e = 0; e < 4; ++e) { const bool up = (lane & 8) != 0; const float send = up ? p[e] : p[e + 4], keep = up ? p[e + 4] : p[e]; p[e] = keep + __shfl_xor(send, 8); }
#pragma unroll
    for (int e = 0; e < 2; ++e) { const bool up = (lane & 4) != 0; const float send = up ? p[e] : p[e + 2], keep = up ? p[e + 2] : p[e]; p[e] = keep + __shfl_xor(send, 4); }
    { const bool up = (lane & 2) != 0; const float send = up ? p[0] : p[1], keep = up ? p[1] : p[0]; p[0] = keep + __shfl_xor(send, 2); }
    return p[0] + __shfl_xor(p[0], 1);
}
__device__ __forceinline__ float rs16(float (&p)[16], int lane) {
#pragma unroll
    for (int e = 0; e < 8; ++e) { const bool up = (lane & 32) != 0; const float send = up ? p[e] : p[e + 8], keep = up ? p[e + 8] : p[e]; p[e] = keep + __shfl_xor(send, 32); }
#pragma unroll
    for (int e = 0; e < 4; ++e) { const bool up = (lane & 16) != 0; const float send = up ? p[e] : p[e + 4], keep = up ? p[e + 4] : p[e]; p[e] = keep + __shfl_xor(send, 16); }
#pragma unroll
    for (int e = 0; e < 2; ++e) { const bool up = (lane & 8) != 0; const float send = up ? p[e] : p[e + 2], keep = up ? p[e + 2] : p[e]; p[e] = keep + __shfl_xor(send, 8); }
    { const bool up = (lane & 4) != 0; const float send = up ? p[0] : p[1], keep = up ? p[1] : p[0]; p[0] = keep + __shfl_xor(send, 4); }
    float r = p[0] + __shfl_xor(p[0], 2);
    return r + __shfl_xor(r, 1);
}
__device__ __forceinline__ float silu_f(float x) { return x / (1.f + __expf(-x)); }

#define XB_TMO      128
#define XB_XCNT(j)  (256  + 64 * (j))
#define XB_XSUB(j)  (1280 + 64 * (j))
#define XB_XGEN(j)  (2304 + 64 * (j))
#define XB_TOP      3328
#define XB_TOPGEN   3392
#define XCD_BAR_WORDS 3456
#define XB_SPIN_CAP (1u << 18)
__device__ __forceinline__ unsigned xb_ld(unsigned* p)              { return __hip_atomic_load(p, __ATOMIC_RELAXED, __HIP_MEMORY_SCOPE_AGENT); }
__device__ __forceinline__ unsigned xb_add(unsigned* p, unsigned v) { return __hip_atomic_fetch_add(p, v, __ATOMIC_RELAXED, __HIP_MEMORY_SCOPE_AGENT); }
__device__ __forceinline__ unsigned xb_xcc_id() { return (unsigned)__builtin_amdgcn_s_getreg((3 << 11) | 20) & 0xFu; }
#define XB_SPIN(cond, bar) do { unsigned _sp = 0; while (cond) { __builtin_amdgcn_s_sleep(1); \
    if ((++_sp & 255u) == 0u) { if (xb_ld(&(bar)[XB_TMO])) break; if (_sp > XB_SPIN_CAP) { atomicAdd(&(bar)[XB_TMO], 1u); break; } } } } while (0)
struct XcdBarrier { unsigned* bar; unsigned x; volatile LAS unsigned* st; };
__device__ __forceinline__ XcdBarrier xcd_barrier_post(unsigned* bar, volatile LAS unsigned* st, int tid) {
    XcdBarrier b; b.bar = bar; b.x = xb_xcc_id(); b.st = st;
    if (tid == 0) (void)xb_add(&bar[XB_XCNT(b.x)], 1u);
    return b;
}
__device__ __forceinline__ void xcd_barrier_complete(unsigned* bar, unsigned x, unsigned& nloc, unsigned& nx) {
    const unsigned G = gridDim.x * gridDim.y * gridDim.z;
    unsigned sum, cnt, mine, sp = 0u;
    for (;;) {
        sum = 0u; cnt = 0u; mine = 0u;
#pragma unroll
        for (unsigned j = 0; j < 16; ++j) { const unsigned c = xb_ld(&bar[XB_XCNT(j)]); sum += c; cnt += (c > 0u) ? 1u : 0u; mine = (j == x) ? c : mine; }
        if (sum == G) break;
        __builtin_amdgcn_s_sleep(1);
        if ((++sp & 255u) == 0u) { if (xb_ld(&bar[XB_TMO])) break; if (sp > XB_SPIN_CAP) { atomicAdd(&bar[XB_TMO], 1u); break; } }
    }
    nloc = mine > 0u ? mine : 1u; nx = cnt > 0u ? cnt : 1u;
}
__device__ __forceinline__ void xcd_barrier(const XcdBarrier& b, int tid) {
    asm volatile("s_waitcnt vmcnt(0)" ::: "memory");
    __syncthreads();
    if (tid == 0) {
        unsigned* bar = b.bar; unsigned bx = b.x;
        asm volatile("" : "+v"(bar), "+v"(bx));
        __builtin_amdgcn_s_waitcnt(0);
        unsigned nloc = b.st[0], nx = b.st[1];
        if (nloc == 0u) { xcd_barrier_complete(bar, bx, nloc, nx); b.st[0] = nloc; b.st[1] = nx; }
        const unsigned old = xb_add(&bar[XB_XSUB(bx)], 1u);
        const unsigned gen = old / nloc;
        if (old + 1u == (gen + 1u) * nloc) {
            __builtin_amdgcn_fence(__ATOMIC_RELEASE, "agent");
            asm volatile("s_waitcnt vmcnt(0)" ::: "memory");
            const unsigned og = xb_add(&bar[XB_TOP], 1u);
            const unsigned tg = og / nx;
            if (og + 1u == (tg + 1u) * nx) xb_add(&bar[XB_TOPGEN], 1u);
            else XB_SPIN(xb_ld(&bar[XB_TOPGEN]) == tg, bar);
            __builtin_amdgcn_fence(__ATOMIC_ACQUIRE, "agent");
            xb_add(&bar[XB_XGEN(bx)], 1u);
            asm volatile("s_waitcnt vmcnt(0)" ::: "memory");
        } else {
            XB_SPIN(xb_ld(&bar[XB_XGEN(bx)]) == gen, bar);
            __builtin_amdgcn_fence(__ATOMIC_ACQUIRE, "agent");
            asm volatile("s_waitcnt vmcnt(0)" ::: "memory");
        }
    }
    __syncthreads();
}

struct Args { const float* in[23]; float* out; unsigned char* ws; int ph_lo, ph_hi; };
struct Frame {
    LAS unsigned char* lds;
    volatile LAS unsigned* MISC;
    unsigned* ctl;
    unsigned char* ws;
    int tid, lane, wave, vcu, G, gw, NGW;
    float* out;
};
typedef const Args __attribute__((address_space(4)))* KArgsP;
__device__ __forceinline__ KArgsP kargs() { unsigned long long v = (unsigned long long)__builtin_amdgcn_kernarg_segment_ptr(); asm volatile("" : "+s"(v)); return (KArgsP)v; }
enum InIdx { I_X = 0, I_C, I_CTX, I_CCTX, I_WMOD, I_BMOD, I_GN1, I_WIN, I_CONVW, I_ALOG, I_DTB, I_GOUT, I_WOUT, I_GN2, I_WR, I_BR, I_WG, I_BG, I_WU, I_BU, I_WD, I_BD, I_GF };
__device__ __forceinline__ float* xr_row(const Frame& F, int t) { return t < NLAT ? F.out + (size_t)t * D : (float*)(F.ws + WS_XC) + (size_t)(t - NLAT) * D; }
__device__ __forceinline__ int mod_row(int t) { return t < NLAT ? (t >> 12) : 8; }
__device__ __forceinline__ const float* modv(const Frame& F, int l, int r, int piece) { return (const float*)(F.ws + WS_MODV) + ((size_t)(l * 9 + r) * 6 + piece) * D; }

struct SchedIn {
    const bf16* hx; const bf16* win; int G, c;
    static constexpr int N0 = (MT / 256) * 8, N1 = 4 * (MT / 256), NWG = N0 + N1;
    __device__ __forceinline__ bool next(int i, pg8::Unit& u) const {
        const long L = (long)i * G + c; if (L >= NWG) return false;
        int w = pg8::xcd_remap((int)L, NWG);
        if (w < N0) { u.kind = 0; pg8::grp_decode(w, MT / 256, 8, u.pm, u.pn); } else { w -= N0; u.kind = 1; u.pn = w >> 2; u.pm = w & 3; }
        u.e = 0; return true;
    }
    __device__ __forceinline__ const char* a_base(const pg8::Unit& u, size_t tstep) const { return u.kind == 0 ? (const char*)hx + (size_t)u.pm * tstep : (const char*)win + (size_t)(8 + u.pm) * tstep; }
    __device__ __forceinline__ const char* b_base(const pg8::Unit& u, size_t tstep) const { return u.kind == 0 ? (const char*)win + (size_t)u.pn * tstep : (const char*)hx + (size_t)u.pn * tstep; }
    __device__ __forceinline__ void a_ready(const pg8::Unit&) const {}
    __device__ __forceinline__ void done(const pg8::Unit&) const {}
};
struct EpiIn {
    static constexpr bool PERM = true, AFTER_DRAIN = false;
    bf16* qkvz; bf16* ztl; bf16* ztc;
    __device__ __forceinline__ void operator()(const pg8::f32x4 (&acc)[2][2][4][2], const pg8::Unit& u, int wr, int wc, int fr_, int fq_) const {
        int fr = fr_, fq = fq_; asm volatile("" : "+v"(fr), "+v"(fq));
        const int row0 = u.pm * 256 + wr * 64 + fr, cin = wc * 32 + 8 * fq;
        bf16* base; size_t ldc;
        if (u.kind == 0) { base = qkvz + (size_t)u.pn * 256 + cin; ldc = 2048; }
        else if (u.pn < 128) { base = ztl + (size_t)(u.pn >> 4) * 1024 * 4096 + (size_t)(u.pn & 15) * 256 + cin; ldc = 4096; }
        else { base = ztc + (size_t)(u.pn - 128) * 1024 * 256 + cin; ldc = 256; }
#pragma unroll
        for (int ai = 0; ai < 2; ++ai)
#pragma unroll
            for (int m = 0; m < 4; ++m) { bf16* rowp = base + (size_t)(row0 + ai * 128 + m * 16) * ldc;
#pragma unroll
                for (int bj = 0; bj < 2; ++bj) { const pg8::f32x4 v0 = acc[ai][bj][m][0], v1 = acc[ai][bj][m][1]; pg8::u32x4 w;
                    w.x = pg8::cvt_pk_bf16(v0[0], v0[1]); w.y = pg8::cvt_pk_bf16(v0[2], v0[3]); w.z = pg8::cvt_pk_bf16(v1[0], v1[1]); w.w = pg8::cvt_pk_bf16(v1[2], v1[3]);
                    *(pg8::u32x4*)(rowp + bj * 128) = w; } }
    }
};
struct SchedDft {
    const bf16* dftm; const bf16* eo; int v;
    __device__ __forceinline__ bool next(int i, pg8::Unit& u) const {
        if (i >= 2 || v < 0) return false;
        const int w = (v >> 5) * 64 + i * 32 + (v & 31), x = w >> 5, j = w & 31;
        u.kind = x & 1; u.pm = 4 * ((x >> 1) & 1) + (j & 3); u.e = 4 * (x >> 2) + ((j >> 2) & 3); u.pn = j >> 4; return true;
    }
    __device__ __forceinline__ const char* a_base(const pg8::Unit& u, size_t tstep) const { return (const char*)dftm + (size_t)u.kind * (2048 * 2048 * 2) + (size_t)u.pm * tstep; }
    __device__ __forceinline__ const char* b_base(const pg8::Unit& u, size_t tstep) const { return (const char*)eo + (size_t)(u.e * 2 + u.kind) * (512 * 2048 * 2) + (size_t)u.pn * tstep; }
    __device__ __forceinline__ void a_ready(const pg8::Unit&) const {}
    __device__ __forceinline__ void done(const pg8::Unit&) const {}
};
struct EpiDft {
    static constexpr bool PERM = true, AFTER_DRAIN = false;
    bf16* ab2;
    __device__ __forceinline__ void operator()(const pg8::f32x4 (&acc)[2][2][4][2], const pg8::Unit& u, int wr, int wc, int fr_, int fq_) const {
        int fr = fr_, fq = fq_; asm volatile("" : "+v"(fr), "+v"(fq));
        const int row0 = u.pm * 256 + wr * 64 + fr, col0 = u.pn * 256 + wc * 32 + 8 * fq;
        bf16* base = ab2 + (size_t)(u.e * 2 + u.kind) * 2048 * 512;
#pragma unroll
        for (int ai = 0; ai < 2; ++ai)
#pragma unroll
            for (int m = 0; m < 4; ++m) { bf16* rowp = base + (size_t)(row0 + ai * 128 + m * 16) * 512 + col0;
#pragma unroll
                for (int bj = 0; bj < 2; ++bj) { const pg8::f32x4 v0 = acc[ai][bj][m][0], v1 = acc[ai][bj][m][1]; pg8::u32x4 w;
                    w.x = pg8::cvt_pk_bf16(v0[0], v0[1]); w.y = pg8::cvt_pk_bf16(v0[2], v0[3]); w.z = pg8::cvt_pk_bf16(v1[0], v1[1]); w.w = pg8::cvt_pk_bf16(v1[2], v1[3]);
                    *(pg8::u32x4*)(rowp + bj * 128) = w; } }
    }
};
struct SchedOut {
    const bf16* mix; const bf16* wout; int nM, G, c;
    __device__ __forceinline__ bool next(int i, pg8::Unit& u) const {
        const int nwg = nM * 4; const long L = (long)i * G + c; if (L >= nwg) return false;
        pg8::grp_decode(pg8::xcd_remap((int)L, nwg), nM, 4, u.pm, u.pn); u.kind = 0; u.e = 0; return true;
    }
    __device__ __forceinline__ const char* a_base(const pg8::Unit& u, size_t tstep) const { return (const char*)mix + (size_t)u.pm * tstep; }
    __device__ __forceinline__ const char* b_base(const pg8::Unit& u, size_t tstep) const { return (const char*)wout + (size_t)u.pn * tstep; }
    __device__ __forceinline__ void a_ready(const pg8::Unit&) const {}
    __device__ __forceinline__ void done(const pg8::Unit&) const {}
};
struct EpiOut {
    static constexpr bool PERM = false, AFTER_DRAIN = false;
    float* xlat; float* xctx; const float* rlat; const float* rctx; const float* gt1; float dsc;
    __device__ __forceinline__ void operator()(const pg8::f32x4 (&acc)[2][2][4][2], const pg8::Unit& u, int wr, int wc, int fr_, int fq_) const {
        int fr = fr_, fq = fq_; asm volatile("" : "+v"(fr), "+v"(fq));
        const int col0 = u.pn * 256 + wc * 32 + 4 * fq, rl = wr * 64 + fr;
        float* xb = u.pm < 128 ? xlat + (size_t)u.pm * 256 * D : xctx + (size_t)(u.pm - 128) * 256 * D;
        const float* rb = u.pm < 128 ? rlat + (size_t)u.pm * 256 * D : rctx + (size_t)(u.pm - 128) * 256 * D;
        const float* g = gt1 + (size_t)(u.pm < 128 ? (u.pm >> 4) : 8) * 6 * D + col0;
        pg8::f32x4 gv[2][2];
#pragma unroll
        for (int bj = 0; bj < 2; ++bj)
#pragma unroll
            for (int n = 0; n < 2; ++n) gv[bj][n] = *(const pg8::f32x4*)(g + bj * 128 + n * 16);
#pragma unroll
        for (int ai = 0; ai < 2; ++ai)
#pragma unroll
            for (int m = 0; m < 4; ++m) { float* rowp = xb + (size_t)(rl + ai * 128 + m * 16) * D + col0; const float* rrow = rb + (size_t)(rl + ai * 128 + m * 16) * D + col0;
#pragma unroll
                for (int bj = 0; bj < 2; ++bj)
#pragma unroll
                    for (int n = 0; n < 2; ++n) { pg8::f32x4* p = (pg8::f32x4*)(rowp + bj * 128 + n * 16); const pg8::f32x4 xo = *(const pg8::f32x4*)(rrow + bj * 128 + n * 16); *p = xo + gv[bj][n] * acc[ai][bj][m][n] * dsc; }
                if (m & 1) asm volatile("" ::: "memory"); }
    }
};
struct SchedMoe {
    const bf16* A; const bf16* W; size_t wstride; const LAS int* pend; int nM, nN, G, c, gather;
    __device__ __forceinline__ bool next(int i, pg8::Unit& u) const {
        const int nwg = nM * nN; const long L = (long)i * G + c; if (L >= nwg) return false;
        pg8::grp_decode(pg8::xcd_remap((int)L, nwg), nM, nN, u.pm, u.pn);
        int e = 0;
#pragma unroll 1
        for (int j = 0; j < NEXP - 1; ++j) e += (pend[j] <= u.pm) ? 1 : 0;
        u.e = e; u.kind = 0; return true;
    }
    __device__ __forceinline__ const char* a_base(const pg8::Unit& u, size_t tstep) const { return gather ? (const char*)A : (const char*)A + (size_t)u.pm * tstep; }
    __device__ __forceinline__ const char* b_base(const pg8::Unit& u, size_t tstep) const { return (const char*)W + (size_t)u.e * wstride + (size_t)u.pn * tstep; }
    __device__ __forceinline__ void a_ready(const pg8::Unit&) const {}
    __device__ __forceinline__ void done(const pg8::Unit&) const {}
};
struct EpiSwiglu {
    static constexpr bool PERM = true, AFTER_DRAIN = false;
    bf16* hs; const float* bg; const float* bu;
    __device__ __forceinline__ void operator()(const pg8::f32x4 (&acc)[2][2][4][2], const pg8::Unit& u, int wr, int wc, int fr_, int fq_) const {
        int fr = fr_, fq = fq_; asm volatile("" : "+v"(fr), "+v"(fq));
        const int row0 = u.pm * 256 + wr * 64 + fr, f0 = u.pn * 128 + wc * 32 + 8 * fq;
        const pg8::f32x4 bg0 = *(const pg8::f32x4*)(bg + u.e * D + f0), bg1 = *(const pg8::f32x4*)(bg + u.e * D + f0 + 4);
        const pg8::f32x4 bu0 = *(const pg8::f32x4*)(bu + u.e * D + f0), bu1 = *(const pg8::f32x4*)(bu + u.e * D + f0 + 4);
#pragma unroll
        for (int ai = 0; ai < 2; ++ai)
#pragma unroll
            for (int m = 0; m < 4; ++m) {
                float h[8];
#pragma unroll
                for (int n = 0; n < 2; ++n) { const pg8::f32x4 ga = acc[ai][0][m][n] + (n ? bg1 : bg0), ua = acc[ai][1][m][n] + (n ? bu1 : bu0);
#pragma unroll
                    for (int j = 0; j < 4; ++j) { const float a = fminf(ga[j], 7.0f), uu = fminf(fmaxf(ua[j], -7.0f), 7.0f);
                        h[n * 4 + j] = a * __builtin_amdgcn_rcpf(1.0f + __expf(-1.702f * a)) * (uu + 1.0f); } }
                pg8::u32x4 w; w.x = pg8::cvt_pk_bf16(h[0], h[1]); w.y = pg8::cvt_pk_bf16(h[2], h[3]); w.z = pg8::cvt_pk_bf16(h[4], h[5]); w.w = pg8::cvt_pk_bf16(h[6], h[7]);
                *(pg8::u32x4*)(hs + (size_t)(row0 + ai * 128 + m * 16) * D + f0) = w; }
    }
};
struct EpiDown {
    static constexpr bool PERM = true, AFTER_DRAIN = false;
    bf16* ys; const float* bd;
    __device__ __forceinline__ void operator()(const pg8::f32x4 (&acc)[2][2][4][2], const pg8::Unit& u, int wr, int wc, int fr_, int fq_) const {
        int fr = fr_, fq = fq_; asm volatile("" : "+v"(fr), "+v"(fq));
        const int row0 = u.pm * 256 + wr * 64 + fr, col0 = u.pn * 256 + wc * 32 + 8 * fq;
        pg8::f32x4 bv[2][2];
#pragma unroll
        for (int bj = 0; bj < 2; ++bj)
#pragma unroll
            for (int n = 0; n < 2; ++n) bv[bj][n] = *(const pg8::f32x4*)(bd + u.e * D + col0 + bj * 128 + 4 * n);
#pragma unroll
        for (int ai = 0; ai < 2; ++ai)
#pragma unroll
            for (int m = 0; m < 4; ++m) { bf16* rowp = ys + (size_t)(row0 + ai * 128 + m * 16) * D + col0;
#pragma unroll
                for (int bj = 0; bj < 2; ++bj) { const pg8::f32x4 v0 = acc[ai][bj][m][0] + bv[bj][0], v1 = acc[ai][bj][m][1] + bv[bj][1]; pg8::u32x4 w;
                    w.x = pg8::cvt_pk_bf16(v0[0], v0[1]); w.y = pg8::cvt_pk_bf16(v0[2], v0[3]); w.z = pg8::cvt_pk_bf16(v1[0], v1[1]); w.w = pg8::cvt_pk_bf16(v1[2], v1[3]);
                    *(pg8::u32x4*)(rowp + bj * 128) = w; } }
    }
};

__device__ __forceinline__ void transpose_item(const float* W, int ldw, int col0, int K, bf16* WT, int drow0, LAS float* scr, int kb, int lane) {
    const int k0 = 64 * kb;
#pragma unroll 8
    for (int i = 0; i < 32; ++i) { const int kk = 2 * i + (lane >> 5); scr[kk * 33 + (lane & 31)] = W[(size_t)(k0 + kk) * ldw + col0 + (lane & 31)]; }
    LDS_WAIT(); asm volatile("" ::: "memory");
    const int c = lane & 7;
#pragma unroll
    for (int j = 0; j < 4; ++j) { const int n = (lane >> 3) + 8 * j; const LAS float* s = scr + (8 * c) * 33 + n;
        v4u o; o.x = pk2(s[0 * 33], s[1 * 33]); o.y = pk2(s[2 * 33], s[3 * 33]); o.z = pk2(s[4 * 33], s[5 * 33]); o.w = pk2(s[6 * 33], s[7 * 33]);
        *(v4u*)(WT + (size_t)(drow0 + n) * K + k0 + 8 * c) = o; }
    LDS_WAIT(); asm volatile("" ::: "memory");
}
__device__ __forceinline__ void convert_experts(const Frame& F, int l, int lo, int hi, int wi, int nw) {
    const KArgsP A = kargs();
    LAS float* scr = (LAS float*)(F.lds + F.wave * 16384);
    bf16* W1 = (bf16*)(F.ws + WS_W1); bf16* W2 = (bf16*)(F.ws + WS_W2);
    constexpr int IPM = 16 * 32;
    for (int it = lo + wi; it < hi; it += nw) {
        const int which = it / (NEXP * IPM), r = it % (NEXP * IPM), e = r / IPM, q = r % IPM, kb = q >> 5, nb = q & 31;
        const size_t moff = ((size_t)l * NEXP + e) * D * D;
        if (which == 0) transpose_item(A->in[I_WG] + moff, D, nb * 32, D, W1 + (size_t)e * 2048 * D, 256 * (nb >> 2) + 32 * (nb & 3), scr, kb, F.lane);
        else if (which == 1) transpose_item(A->in[I_WU] + moff, D, nb * 32, D, W1 + (size_t)e * 2048 * D, 256 * (nb >> 2) + 128 + 32 * (nb & 3), scr, kb, F.lane);
        else transpose_item(A->in[I_WD] + moff, D, nb * 32, D, W2 + (size_t)e * D * D, nb * 32, scr, kb, F.lane);
    }
}
__device__ __forceinline__ void p0_prologue(const Frame& F) {
    const KArgsP A = kargs();
    float* mv = (float*)(F.ws + WS_MODV);
    {
        LAS float* sc = (LAS float*)F.lds;
        LAS float* red = sc + 9 * 1024;
        for (int i = F.tid; i < 9 * 1024; i += NTHR) { const int r = i >> 10, k = i & 1023; sc[i] = silu_f(r < 8 ? A->in[I_C][r * D + k] : A->in[I_CCTX][k]); }
        __syncthreads();
        for (int item = blockIdx.x; item < 192; item += F.G) {
            const int l = item / 96, cg = item % 96, cl = F.tid & 63, ks = F.tid >> 6;
            const float* w = A->in[I_WMOD] + ((size_t)l * D + ks * 128) * 6144 + cg * 64 + cl;
            float a[9];
#pragma unroll
            for (int r = 0; r < 9; ++r) a[r] = 0.f;
#pragma unroll 4
            for (int k = 0; k < 128; ++k) { const float wv = w[(size_t)k * 6144];
#pragma unroll
                for (int r = 0; r < 9; ++r) a[r] += sc[r * 1024 + ks * 128 + k] * wv; }
#pragma unroll
            for (int r = 0; r < 9; ++r) red[(ks * 9 + r) * 64 + cl] = a[r];
            __syncthreads();
            for (int i = F.tid; i < 9 * 64; i += NTHR) { const int r = i >> 6, cc = i & 63; float s = 0.f;
#pragma unroll
                for (int k2 = 0; k2 < 8; ++k2) s += red[(k2 * 9 + r) * 64 + cc];
                mv[(size_t)(l * 9 + r) * 6144 + cg * 64 + cc] = s + A->in[I_BMOD][l * 6144 + cg * 64 + cc]; }
            __syncthreads();
        }
    }
    {
        LAS float* T = (LAS float*)F.lds;
        LAS float* cs = T + 64 * 129; LAS float* sn = cs + 128;
        __syncthreads();
        if (F.tid < 128) { cs[F.tid] = cospif((float)F.tid * (1.0f / 64.0f)); sn[F.tid] = sinpif((float)F.tid * (1.0f / 64.0f)); }
        for (int item = (blockIdx.x + 64) % F.G; item < 128; item += F.G) {
            const int l = item >> 6, kg = (item & 63) >> 2, g = item & 3;
            __syncthreads();
            for (int i = F.tid; i < 64 * 128; i += NTHR) { const int kk = i >> 7, cc = i & 127; T[kk * 129 + cc] = A->in[I_WIN][((size_t)l * D + kg * 64 + kk) * INW + g * 128 + cc]; }
            __syncthreads();
            const int kk = F.tid & 63, ng = F.tid >> 6;
            bf16* dst = (bf16*)(F.ws + WS_WIN) + ((size_t)l * 3072 + 2048 + g * 256) * D + kg * 64 + kk;
#pragma unroll 1
            for (int nn = 0; nn < 32; ++nn) { const int np = ng * 32 + nn, cp = np >> 1; float s = 0.f;
                if (np & 1) {
#pragma unroll 8
                    for (int cc = 0; cc < 128; ++cc) s -= T[kk * 129 + cc] * sn[(cc * cp) & 127]; }
                else {
#pragma unroll 8
                    for (int cc = 0; cc < 128; ++cc) s += T[kk * 129 + cc] * cs[(cc * cp) & 127]; }
                dst[(size_t)np * D] = (bf16)f2bf(s); }
        }
        __syncthreads();
    }
    {
        LAS float* scr = (LAS float*)(F.lds + F.wave * 16384);
        constexpr int I_IN = 16 * 64, I_OUT = 16 * 32;
        for (int it = F.gw; it < NL * (I_IN + I_OUT); it += F.NGW) {
            const int l = it / (I_IN + I_OUT), r = it % (I_IN + I_OUT);
            if (r < I_IN) transpose_item(A->in[I_WIN] + (size_t)l * D * INW, INW, 512 + 32 * (r & 63), D, (bf16*)(F.ws + WS_WIN) + (size_t)l * 3072 * D, 32 * (r & 63), scr, r >> 6, F.lane);
            else { const int q = r - I_IN; transpose_item(A->in[I_WOUT] + (size_t)l * D * D, D, 32 * (q & 31), D, (bf16*)(F.ws + WS_WOUT) + (size_t)l * D * D, 32 * (q & 31), scr, q >> 5, F.lane); }
        }
    }
    convert_experts(F, 0, 0, CVT_SPLIT, F.gw, F.NGW);
    {
        const int gt = F.gw * 64 + F.lane, NT = F.NGW * 64;
        float* wrt = (float*)(F.ws + WS_WRT); float* wabt = (float*)(F.ws + WS_WABT);
        for (int i = gt; i < NL * NEXP * D; i += NT) { const int l = i >> 15, e = (i >> 10) & 31, c = i & 1023; wrt[i] = A->in[I_WR][((size_t)l * D + c) * NEXP + e]; }
        for (int i = gt; i < NL * 16 * D; i += NT) { const int l = i >> 14, j = (i >> 10) & 15, c = i & 1023; wabt[i] = A->in[I_WIN][((size_t)l * D + c) * INW + 2560 + j]; }
        bf16* dm = (bf16*)(F.ws + WS_DFTM);
        for (int i = gt; i < 2 * 2048 * 256; i += NT) { const int mat = i >> 19, kf = (i >> 8) & 2047, j0 = (i & 255) * 8; float v[8];
#pragma unroll
            for (int jj = 0; jj < 8; ++jj) { const float a = (float)((kf * (j0 + jj)) & 4095) * (1.0f / 2048.0f); v[jj] = mat ? sinpif(a) : cospif(a); }
            v4u o; o.x = pk2(v[0], v[1]); o.y = pk2(v[2], v[3]); o.z = pk2(v[4], v[5]); o.w = pk2(v[6], v[7]);
            *(v4u*)(dm + (size_t)i * 8) = o; }
    }
}

template <int MODE>
__device__ __forceinline__ void row_pass(const Frame& F, int l_cur, int l_nxt, bool dummy = false) {
    const KArgsP A = kargs();
    LAS float* wl = (LAS float*)F.lds;
    if (MODE != 2) { const f32x4* src = (const f32x4*)((const float*)(F.ws + WS_WABT) + (size_t)l_nxt * 16 * D);
        for (int i = F.tid; i < 16 * D / 4; i += NTHR) ((LAS f32x4*)wl)[i] = src[i];
        __syncthreads(); }
    const int nrows = MODE == 2 ? NLAT : MT;
    const int* selp = (const int*)(F.ws + WS_SELP); const float* selg = (const float*)(F.ws + WS_SELG);
    const bf16* ys = (const bf16*)(F.ws + WS_XS);
    bf16* hx = (bf16*)(F.ws + WS_ACT); float* ab = (float*)(F.ws + WS_AB);
    f32x4 xc[4]; int dc[4]; float gc[4]; v2u yc[4][4];
    int t = F.gw;
    if (t < nrows) {
        const float* xin = MODE == 0 ? (t < NLAT ? A->in[I_X] + (size_t)t * D : A->in[I_CTX] + (size_t)(t - NLAT) * D) : xr_row(F, t);
#pragma unroll
        for (int j = 0; j < 4; ++j) xc[j] = *((const f32x4*)xin + F.lane + 64 * j);
        if (MODE != 0) {
#pragma unroll
            for (int k = 0; k < 4; ++k) { dc[k] = selp[t * 4 + k]; gc[k] = selg[t * 4 + k]; }
#pragma unroll
            for (int k = 0; k < 4; ++k) { const v2u* yr = (const v2u*)(ys + (size_t)dc[k] * D) + F.lane;
#pragma unroll
                for (int j = 0; j < 4; ++j) yc[k][j] = yr[64 * j]; } }
    }
    for (; t < nrows; t += F.NGW) {
        const int tn = t + F.NGW < nrows ? t + F.NGW : t;
        f32x4 xn[4]; int dn[4]; float gn[4];
        { const float* xin = MODE == 0 ? (tn < NLAT ? A->in[I_X] + (size_t)tn * D : A->in[I_CTX] + (size_t)(tn - NLAT) * D) : xr_row(F, tn);
#pragma unroll
          for (int j = 0; j < 4; ++j) xn[j] = *((const f32x4*)xin + F.lane + 64 * j);
          if (MODE != 0) {
#pragma unroll
              for (int k = 0; k < 4; ++k) { dn[k] = selp[tn * 4 + k]; gn[k] = selg[tn * 4 + k]; } } }
        const int r = mod_row(t);
        f32x4 v[4];
#pragma unroll
        for (int j = 0; j < 4; ++j) v[j] = xc[j];
        float* xr = xr_row(F, t);
        if (MODE != 0) {
            f32x4 y[4];
#pragma unroll
            for (int j = 0; j < 4; ++j) y[j] = (f32x4){0.f, 0.f, 0.f, 0.f};
#pragma unroll
            for (int k = 0; k < 4; ++k)
#pragma unroll
                for (int j = 0; j < 4; ++j) { const v2u w = yc[k][j]; y[j] += gc[k] * (f32x4){bflo(w.x), bfhi(w.x), bflo(w.y), bfhi(w.y)}; }
            const f32x4* g2 = (const f32x4*)modv(F, l_cur, r, 5) + F.lane;
#pragma unroll
            for (int j = 0; j < 4; ++j) v[j] += g2[64 * j] * y[j];
#pragma unroll
            for (int k = 0; k < 4; ++k) { const v2u* yr = (const v2u*)(ys + (size_t)dn[k] * D) + F.lane;
#pragma unroll
                for (int j = 0; j < 4; ++j) yc[k][j] = yr[64 * j]; }
        }
        if (MODE == 1 && !dummy) {
#pragma unroll
            for (int j = 0; j < 4; ++j) *((f32x4*)xr + F.lane + 64 * j) = v[j];
        }
        float ss = 0.f;
#pragma unroll
        for (int j = 0; j < 4; ++j) ss += (v[j].x * v[j].x + v[j].y * v[j].y) + (v[j].z * v[j].z + v[j].w * v[j].w);
        const float rstd = 1.0f / sqrtf(wave_sum(ss) * (1.0f / D) + EPS);
        if (MODE == 2) {
            const f32x4* gf = (const f32x4*)A->in[I_GF] + F.lane;
#pragma unroll
            for (int j = 0; j < 4; ++j) *((f32x4*)(F.out + (size_t)t * D) + F.lane + 64 * j) = v[j] * rstd * gf[64 * j];
        } else {
            const f32x4* g1 = (const f32x4*)(A->in[I_GN1] + (size_t)l_nxt * D) + F.lane;
            const f32x4* sh = (const f32x4*)modv(F, l_nxt, r, 0) + F.lane; const f32x4* scl = (const f32x4*)modv(F, l_nxt, r, 1) + F.lane;
            v2u* ho = (v2u*)(hx + (size_t)t * D) + F.lane;
#pragma unroll
            for (int j = 0; j < 4; ++j) { v[j] = v[j] * rstd * g1[64 * j] * (scl[64 * j] + 1.0f) + sh[64 * j]; v2u w; w.x = pk2(v[j].x, v[j].y); w.y = pk2(v[j].z, v[j].w); ho[64 * j] = w; }
            float pp[16];
            int lofs = F.lane; asm volatile("" : "+v"(lofs));
#pragma unroll
            for (int jj = 0; jj < 16; ++jj) { float p = 0.f;
#pragma unroll
                for (int j = 0; j < 4; ++j) { const f32x4 w = ((const LAS f32x4*)(wl + jj * D))[lofs + 64 * j]; p += (v[j].x * w.x + v[j].y * w.y) + (v[j].z * w.z + v[j].w * w.w); }
                pp[jj] = p; if ((jj & 3) == 3) asm volatile("" ::: "memory"); }
            const float mine = rs16(pp, F.lane);
            if ((F.lane & 3) == 0) ab[(size_t)t * 16 + (F.lane >> 2)] = mine;
        }
#pragma unroll
        for (int j = 0; j < 4; ++j) xc[j] = xn[j];
        if (MODE != 0) {
#pragma unroll
            for (int k = 0; k < 4; ++k) { dc[k] = dn[k]; gc[k] = gn[k]; } }
    }
}

__device__ __forceinline__ int seq_id(int x) { return x < 0 ? -1 : (x < NLAT ? (x >> 12) : (x < MT ? 8 + ((x - NLAT) >> 8) : -2)); }
__device__ __forceinline__ void conv_phase(const Frame& F, int l) {
    const KArgsP A = kargs();
    LAS float* cw = (LAS float*)F.lds;
    for (int i = F.tid; i < 5 * 1536; i += NTHR) cw[i] = A->in[I_CONVW][(size_t)l * 5 * 1536 + i];
    __syncthreads();
    const bf16* qkvz = (const bf16*)(F.ws + WS_QKVZ); bf16* qkvn = (bf16*)(F.ws + WS_QKVN);
    const float* ab = (const float*)(F.ws + WS_AB); float* gb = (float*)(F.ws + WS_G); float* bb = (float*)(F.ws + WS_BETA);
    constexpr int RUN = MT / (256 * NWAVES);
    static_assert(RUN * 256 * NWAVES == MT, "conv runs");
    for (int run = F.gw; run < MT / RUN; run += F.NGW) {
        const int t0 = run * RUN;
        v4u W[5][3];
#pragma unroll
        for (int k = 0; k < 5; ++k) { const int g = t0 + k - 2, gc = g < 0 ? 0 : (g >= MT ? MT - 1 : g);
#pragma unroll
            for (int q = 0; q < 3; ++q) W[k][q] = *(const v4u*)(qkvz + (size_t)gc * 2048 + q * 512 + 8 * F.lane); }
#pragma unroll 1
        for (int t = t0; t < t0 + RUN; ++t) {
            v4u N[3];
            { const int g = t + 3, gc = g >= MT ? MT - 1 : g;
#pragma unroll
              for (int q = 0; q < 3; ++q) N[q] = *(const v4u*)(qkvz + (size_t)gc * 2048 + q * 512 + 8 * F.lane); }
            const int sid = seq_id(t);
            float a[3][8];
#pragma unroll
            for (int q = 0; q < 3; ++q)
#pragma unroll
                for (int i = 0; i < 8; ++i) a[q][i] = 0.f;
#pragma unroll
            for (int tap = 0; tap < 5; ++tap) { const float vm = (seq_id(t + tap - 2) == sid) ? 1.0f : 0.0f;
#pragma unroll
                for (int q = 0; q < 3; ++q) { const v4u u = W[tap][q];
                    const LAS f32x4* wp = (const LAS f32x4*)(cw + tap * 1536 + q * 512 + 8 * F.lane); const f32x4 w0 = wp[0] * vm, w1 = wp[1] * vm;
                    a[q][0] += bflo(u.x) * w0.x; a[q][1] += bfhi(u.x) * w0.y; a[q][2] += bflo(u.y) * w0.z; a[q][3] += bfhi(u.y) * w0.w;
                    a[q][4] += bflo(u.z) * w1.x; a[q][5] += bfhi(u.z) * w1.y; a[q][6] += bflo(u.w) * w1.z; a[q][7] += bfhi(u.w) * w1.w; } }
#pragma unroll
            for (int q = 0; q < 3; ++q) { float ss = 0.f;
#pragma unroll
                for (int i = 0; i < 8; ++i) { a[q][i] = silu_f(a[q][i]); ss += a[q][i] * a[q][i]; }
                float sc = 1.0f;
                if (q < 2) { ss = sum16(ss); sc = (1.0f / sqrtf(ss + EPS)) * (q == 0 ? 0.08838834764831845f : 1.0f); }
                v4u o; o.x = pk2(a[q][0] * sc, a[q][1] * sc); o.y = pk2(a[q][2] * sc, a[q][3] * sc); o.z = pk2(a[q][4] * sc, a[q][5] * sc); o.w = pk2(a[q][6] * sc, a[q][7] * sc);
                *(v4u*)(qkvn + (size_t)t * 1536 + q * 512 + 8 * F.lane) = o; }
            if (F.lane < 8) { const int d = F.lane >> 2, h = F.lane & 3;
                const float xg = ab[(size_t)t * 16 + d * 8 + h] + A->in[I_DTB][l * 8 + d * 4 + h];
                const float sp = xg > 20.f ? xg : log1pf(expf(xg));
                gb[(size_t)t * 8 + F.lane] = -expf(A->in[I_ALOG][l * 8 + d * 4 + h]) * sp;
                bb[(size_t)t * 8 + F.lane] = 1.0f / (1.0f + expf(-ab[(size_t)t * 16 + d * 8 + 4 + h])); }
#pragma unroll
            for (int q = 0; q < 3; ++q) { W[0][q] = W[1][q]; W[1][q] = W[2][q]; W[2][q] = W[3][q]; W[3][q] = W[4][q]; W[4][q] = N[q]; }
        }
    }
}

__device__ __forceinline__ void fold_phase(const Frame& F) {
    const bf16* ztl = (const bf16*)(F.ws + WS_ZTL); bf16* eo = (bf16*)(F.ws + WS_EO); float* zn = (float*)(F.ws + WS_ZN);
    const int lam = F.lane;
    for (int row = F.gw; row < 8 * 512; row += F.NGW) {
        const int b = row >> 9, c = row & 511;
        const bf16* zr = ztl + (size_t)row * 8192; const bf16* zi = zr + 4096;
        v4u lo_r[4], hi_r[4], lo_i[4], hi_i[4];
#pragma unroll
        for (int q = 0; q < 4; ++q) { lo_r[q] = *(const v4u*)(zr + 32 * lam + 8 * q); hi_r[q] = *(const v4u*)(zr + 4064 - 32 * lam + 8 * q);
                                      lo_i[q] = *(const v4u*)(zi + 32 * lam + 8 * q); hi_i[q] = *(const v4u*)(zi + 4064 - 32 * lam + 8 * q); }
        float Lr[32], Hr[32], Li[32], Hi[32];
#pragma unroll
        for (int q = 0; q < 4; ++q)
#pragma unroll
            for (int e = 0; e < 4; ++e) { Lr[8 * q + 2 * e] = bflo(lo_r[q][e]); Lr[8 * q + 2 * e + 1] = bfhi(lo_r[q][e]); Hr[8 * q + 2 * e] = bflo(hi_r[q][e]); Hr[8 * q + 2 * e + 1] = bfhi(hi_r[q][e]);
                                          Li[8 * q + 2 * e] = bflo(lo_i[q][e]); Li[8 * q + 2 * e + 1] = bfhi(lo_i[q][e]); Hi[8 * q + 2 * e] = bflo(hi_i[q][e]); Hi[8 * q + 2 * e + 1] = bfhi(hi_i[q][e]); }
        float mr = __shfl_up(Hr[0], 1), mi = __shfl_up(Hi[0], 1); if (lam == 0) { mr = 0.f; mi = 0.f; }
        float E[32], O[32]; float ny = 0.f;
        E[0] = Lr[0] + mr; O[0] = lam == 0 ? 0.f : Li[0] - mi;
#pragma unroll
        for (int j = 1; j < 32; ++j) { E[j] = Lr[j] + Hr[32 - j]; O[j] = Li[j] - Hi[32 - j]; }
#pragma unroll
        for (int j = 0; j < 32; ++j) ny += (j & 1) ? -(Lr[j] + Hr[j]) : (Lr[j] + Hr[j]);
        ny = wave_sum(ny);
        bf16* ep = eo + ((size_t)(b * 2) * 512 + c) * 2048 + 32 * lam; bf16* op = ep + (size_t)512 * 2048;
#pragma unroll
        for (int q = 0; q < 4; ++q) { v4u e4, o4;
            e4.x = pk2(E[8 * q], E[8 * q + 1]); e4.y = pk2(E[8 * q + 2], E[8 * q + 3]); e4.z = pk2(E[8 * q + 4], E[8 * q + 5]); e4.w = pk2(E[8 * q + 6], E[8 * q + 7]);
            o4.x = pk2(O[8 * q], O[8 * q + 1]); o4.y = pk2(O[8 * q + 2], O[8 * q + 3]); o4.z = pk2(O[8 * q + 4], O[8 * q + 5]); o4.w = pk2(O[8 * q + 6], O[8 * q + 7]);
            *(v4u*)(ep + 8 * q) = e4; *(v4u*)(op + 8 * q) = o4; }
        if (lam == 63) zn[row] = Hr[0];
        if (lam == 0) zn[4096 + row] = ny;
    }
}

__device__ __forceinline__ void ctx_dft(const Frame& F) {
    LAS float* cs = (LAS float*)F.lds;
    LAS float* sn = cs + 256;
    LAS float* Z = sn + 256;
    const bf16* ztc = (const bf16*)(F.ws + WS_ZTC); bf16* mix = (bf16*)(F.ws + WS_ACT);
    const float scale = 1.0f / sqrtf(256.0f * 128.0f);
    __syncthreads();
    if (F.tid < 256) { cs[F.tid] = cospif((float)F.tid * (1.0f / 128.0f)); sn[F.tid] = sinpif((float)F.tid * (1.0f / 128.0f)); }
    for (int item = F.vcu - 128; item < 256; item += 128) {
        const int b = item >> 5, cg = item & 31;
        __syncthreads();
        for (int i = F.tid; i < 16 * 256; i += NTHR) { const int c = i >> 8, l2 = (i & 255) * 2; const unsigned w = *(const unsigned*)(ztc + ((size_t)b * 512 + cg * 16 + c) * 512 + l2);
            Z[c * 516 + l2] = bflo(w); Z[c * 516 + l2 + 1] = bfhi(w); }
        __syncthreads();
        const int c = F.tid & 15, lp0 = F.tid >> 4;
        float acc[8];
#pragma unroll
        for (int k = 0; k < 8; ++k) acc[k] = 0.f;
#pragma unroll 2
        for (int l = 0; l < 256; ++l) { const float zr = Z[c * 516 + l], zi = Z[c * 516 + 256 + l];
#pragma unroll
            for (int k = 0; k < 8; ++k) { const int idx = (l * (lp0 + 32 * k)) & 255; acc[k] += zr * cs[idx] + zi * sn[idx]; } }
#pragma unroll
        for (int k = 0; k < 8; ++k) mix[(size_t)(NLAT + b * 256 + lp0 + 32 * k) * D + cg * 16 + c] = (bf16)f2bf(acc[k] * scale);
    }
    __syncthreads();
}

__device__ __forceinline__ void scan_naive(const Frame& F, int l) {
    LAS float* kL = (LAS float*)F.lds;
    LAS float* qL = kL + 64 * 128;
    LAS float* vL = qL + 64 * 128;
    LAS float* oL = vL + 64 * 32;
    LAS float* gL = oL + 64 * 32;
    LAS float* bL = gL + 64;
    const bf16* qkvn = (const bf16*)(F.ws + WS_QKVN);
    const float* gb = (const float*)(F.ws + WS_G); const float* bb = (const float*)(F.ws + WS_BETA);
    for (int unit = F.vcu; unit < 256; unit += F.G) {
        const int qd = unit & 3, s = unit >> 2, d = s & 1, h = (s >> 1) & 3, b = s >> 3;
        bf16* od = (bf16*)(F.ws + (d ? WS_OB : WS_OF));
        const int j = F.tid >> 4, rg = F.tid & 15;
        float S[8];
#pragma unroll
        for (int i = 0; i < 8; ++i) S[i] = 0.f;
#pragma unroll 1
        for (int ci = 0; ci < 68; ++ci) {
            int rowbase; const bool isctx = ci < 4;
            if (isctx) rowbase = NLAT + b * 256 + (d ? 3 - ci : ci) * 64; else { const int lc = ci - 4; rowbase = b * SEQ + (d ? 63 - lc : lc) * 64; }
            __syncthreads();
            for (int i = F.tid; i < 64 * 16; i += NTHR) { const int r = i >> 4, g8 = i & 15; const bf16* rp = qkvn + (size_t)(rowbase + r) * 1536 + h * 128 + g8 * 8;
                const v4u q = *(const v4u*)rp, k = *(const v4u*)(rp + 512);
                LAS float* qo = qL + r * 128 + g8 * 8; LAS float* ko = kL + r * 128 + g8 * 8;
                qo[0] = bflo(q.x); qo[1] = bfhi(q.x); qo[2] = bflo(q.y); qo[3] = bfhi(q.y); qo[4] = bflo(q.z); qo[5] = bfhi(q.z); qo[6] = bflo(q.w); qo[7] = bfhi(q.w);
                ko[0] = bflo(k.x); ko[1] = bfhi(k.x); ko[2] = bflo(k.y); ko[3] = bfhi(k.y); ko[4] = bflo(k.z); ko[5] = bfhi(k.z); ko[6] = bflo(k.w); ko[7] = bfhi(k.w); }
            if (F.tid < 256) { const int r = F.tid >> 2, g8 = F.tid & 3; const v4u v = *(const v4u*)(qkvn + (size_t)(rowbase + r) * 1536 + 1024 + h * 128 + qd * 32 + g8 * 8);
                LAS float* vo = vL + r * 32 + g8 * 8;
                vo[0] = bflo(v.x); vo[1] = bfhi(v.x); vo[2] = bflo(v.y); vo[3] = bfhi(v.y); vo[4] = bflo(v.z); vo[5] = bfhi(v.z); vo[6] = bflo(v.w); vo[7] = bfhi(v.w); }
            else if (F.tid < 320) { const int r = F.tid - 256; gL[r] = __expf(gb[(size_t)(rowbase + r) * 8 + d * 4 + h]); bL[r] = bb[(size_t)(rowbase + r) * 8 + d * 4 + h]; }
            __syncthreads();
#pragma unroll 2
            for (int st = 0; st < 64; ++st) {
                const int r = d ? 63 - st : st;
                const float alpha = gL[r], bt = bL[r];
                const f32x4 k0 = *(const LAS f32x4*)(kL + r * 128 + rg * 8), k1 = *(const LAS f32x4*)(kL + r * 128 + rg * 8 + 4);
                const f32x4 q0 = *(const LAS f32x4*)(qL + r * 128 + rg * 8), q1 = *(const LAS f32x4*)(qL + r * 128 + rg * 8 + 4);
                float part = (k0.x * S[0] + k0.y * S[1]) + (k0.z * S[2] + k0.w * S[3]) + (k1.x * S[4] + k1.y * S[5]) + (k1.z * S[6] + k1.w * S[7]);
                part = sum16(part);
                const float dl = bt * (vL[r * 32 + j] - alpha * part);
                S[0] = alpha * S[0] + k0.x * dl; S[1] = alpha * S[1] + k0.y * dl; S[2] = alpha * S[2] + k0.z * dl; S[3] = alpha * S[3] + k0.w * dl;
                S[4] = alpha * S[4] + k1.x * dl; S[5] = alpha * S[5] + k1.y * dl; S[6] = alpha * S[6] + k1.z * dl; S[7] = alpha * S[7] + k1.w * dl;
                float op = (q0.x * S[0] + q0.y * S[1]) + (q0.z * S[2] + q0.w * S[3]) + (q1.x * S[4] + q1.y * S[5]) + (q1.z * S[6] + q1.w * S[7]);
                op = sum16(op);
                if (rg == 0) oL[r * 32 + j] = op;
            }
            __syncthreads();
            if (!(isctx && l == NL - 1)) { const int r = F.tid >> 3, g4 = F.tid & 7; const LAS float* op = oL + r * 32 + g4 * 4;
                v2u w; w.x = pk2(op[0], op[1]); w.y = pk2(op[2], op[3]);
                *(v2u*)(od + (size_t)(rowbase + r) * 512 + h * 128 + qd * 32 + g4 * 4) = w; }
        }
        __syncthreads();
    }
}

__device__ __forceinline__ void gated_out(const Frame& F, int l) {
    const KArgsP A = kargs();
    const bf16* of = (const bf16*)(F.ws + WS_OF); const bf16* ob = (const bf16*)(F.ws + WS_OB); const bf16* qkvz = (const bf16*)(F.ws + WS_QKVZ);
    const bf16* ab2 = (const bf16*)(F.ws + WS_AB2); const float* zn = (const float*)(F.ws + WS_ZN);
    bf16* mix = (bf16*)(F.ws + WS_ACT);
    const int nrows = l == NL - 1 ? NLAT : MT;
    const float fsc = 1.0f / sqrtf(4096.0f * 128.0f);
    const f32x4 g0 = *(const f32x4*)(A->in[I_GOUT] + l * 128 + (F.lane & 15) * 8), g1 = *(const f32x4*)(A->in[I_GOUT] + l * 128 + (F.lane & 15) * 8 + 4);
    for (int t = F.gw; t < nrows; t += F.NGW) {
        const v4u a = *(const v4u*)(of + (size_t)t * 512 + 8 * F.lane), b = *(const v4u*)(ob + (size_t)t * 512 + 8 * F.lane), z = *(const v4u*)(qkvz + (size_t)t * 2048 + 1536 + 8 * F.lane);
        if (t < NLAT) {
            const int bb_ = t >> 12, lp = t & 4095, k = lp <= 2048 ? lp : 4096 - lp;
            float y[8];
            if (k == 2048) { const f32x4 n0 = *(const f32x4*)(zn + 4096 + bb_ * 512 + 8 * F.lane), n1 = *(const f32x4*)(zn + 4096 + bb_ * 512 + 8 * F.lane + 4);
                y[0] = n0.x; y[1] = n0.y; y[2] = n0.z; y[3] = n0.w; y[4] = n1.x; y[5] = n1.y; y[6] = n1.z; y[7] = n1.w; }
            else { const v4u pa = *(const v4u*)(ab2 + ((size_t)(bb_ * 2) * 2048 + k) * 512 + 8 * F.lane), pb_ = *(const v4u*)(ab2 + ((size_t)(bb_ * 2 + 1) * 2048 + k) * 512 + 8 * F.lane);
                const f32x4 z0 = *(const f32x4*)(zn + bb_ * 512 + 8 * F.lane), z1 = *(const f32x4*)(zn + bb_ * 512 + 8 * F.lane + 4);
                const float sg = lp <= 2048 ? 1.0f : -1.0f, sz = (k & 1) ? -1.0f : 1.0f;
                y[0] = bflo(pa.x) + sg * bflo(pb_.x) + sz * z0.x; y[1] = bfhi(pa.x) + sg * bfhi(pb_.x) + sz * z0.y; y[2] = bflo(pa.y) + sg * bflo(pb_.y) + sz * z0.z; y[3] = bfhi(pa.y) + sg * bfhi(pb_.y) + sz * z0.w;
                y[4] = bflo(pa.z) + sg * bflo(pb_.z) + sz * z1.x; y[5] = bfhi(pa.z) + sg * bfhi(pb_.z) + sz * z1.y; y[6] = bflo(pa.w) + sg * bflo(pb_.w) + sz * z1.z; y[7] = bfhi(pa.w) + sg * bfhi(pb_.w) + sz * z1.w; }
            v4u wy; wy.x = pk2(y[0] * fsc, y[1] * fsc); wy.y = pk2(y[2] * fsc, y[3] * fsc); wy.z = pk2(y[4] * fsc, y[5] * fsc); wy.w = pk2(y[6] * fsc, y[7] * fsc);
            *(v4u*)(mix + (size_t)t * D + 8 * F.lane) = wy;
        }
        float o[8] = {bflo(a.x) + bflo(b.x), bfhi(a.x) + bfhi(b.x), bflo(a.y) + bflo(b.y), bfhi(a.y) + bfhi(b.y), bflo(a.z) + bflo(b.z), bfhi(a.z) + bfhi(b.z), bflo(a.w) + bflo(b.w), bfhi(a.w) + bfhi(b.w)};
        const float zz[8] = {bflo(z.x), bfhi(z.x), bflo(z.y), bfhi(z.y), bflo(z.z), bfhi(z.z), bflo(z.w), bfhi(z.w)};
        const float gg[8] = {g0.x, g0.y, g0.z, g0.w, g1.x, g1.y, g1.z, g1.w};
        float ss = 0.f;
#pragma unroll
        for (int i = 0; i < 8; ++i) ss += o[i] * o[i];
        const float rs = 1.0f / sqrtf(sum16(ss) * (1.0f / 128.0f) + EPS);
#pragma unroll
        for (int i = 0; i < 8; ++i) o[i] = o[i] * rs * gg[i] * silu_f(zz[i]);
        v4u w; w.x = pk2(o[0], o[1]); w.y = pk2(o[2], o[3]); w.z = pk2(o[4], o[5]); w.w = pk2(o[6], o[7]);
        *(v4u*)(mix + (size_t)t * D + 512 + 8 * F.lane) = w;
    }
}

__device__ __forceinline__ void router_phase(const Frame& F, int l, int bank = 0) {
    const KArgsP A = kargs();
    LAS float* wr = (LAS float*)F.lds;
    LAS int* lcnt = (LAS int*)(F.lds + XT_OFF);
    LAS int* lbase = lcnt + 32;
    LAS int* sE = lbase + 32;
    LAS int* sP = sE + 136 * 4;
    LAS float* sG = (LAS float*)(sP + 136 * 4);
    const int nrows = l == NL - 1 ? NLAT : MT, rpb = nrows / 256;
    { const f32x4* src = (const f32x4*)((const float*)(F.ws + WS_WRT) + (size_t)l * NEXP * D);
      for (int i = F.tid; i < NEXP * D / 4; i += NTHR) ((LAS f32x4*)wr)[i] = src[i];
      if (F.tid < 32) lcnt[F.tid] = 0; }
    __syncthreads();
    bf16* h2 = (bf16*)(F.ws + WS_ACT);
    const int row0 = F.vcu * rpb;
    if (F.vcu < 256) {
    for (int rl = F.wave; rl < rpb; rl += NWAVES) {
        const int t = row0 + rl, r = mod_row(t);
        const float* xr = xr_row(F, t);
        f32x4 v[4]; float ss = 0.f;
#pragma unroll
        for (int j = 0; j < 4; ++j) { v[j] = *((const f32x4*)xr + F.lane + 64 * j); ss += (v[j].x * v[j].x + v[j].y * v[j].y) + (v[j].z * v[j].z + v[j].w * v[j].w); }
        const float rstd = 1.0f / sqrtf(wave_sum(ss) * (1.0f / D) + EPS);
        const f32x4* g2 = (const f32x4*)(A->in[I_GN2] + (size_t)l * D) + F.lane;
        const f32x4* sh = (const f32x4*)modv(F, l, r, 3) + F.lane; const f32x4* scl = (const f32x4*)modv(F, l, r, 4) + F.lane;
        v2u* ho = (v2u*)(h2 + (size_t)t * D) + F.lane;
#pragma unroll
        for (int j = 0; j < 4; ++j) { v[j] = v[j] * rstd * g2[64 * j] * (scl[64 * j] + 1.0f) + sh[64 * j]; v2u w; w.x = pk2(v[j].x, v[j].y); w.y = pk2(v[j].z, v[j].w); ho[64 * j] = w; }
        float pe[32];
        int lofs = F.lane; asm volatile("" : "+v"(lofs));
#pragma unroll
        for (int e = 0; e < NEXP; ++e) { float p = 0.f;
#pragma unroll
            for (int j = 0; j < 4; ++j) { const f32x4 w = ((const LAS f32x4*)(wr + e * D))[lofs + 64 * j]; p += (v[j].x * w.x + v[j].y * w.y) + (v[j].z * w.z + v[j].w * w.w); }
            pe[e] = p; if ((e & 3) == 3) asm volatile("" ::: "memory"); }
        float lg = rs32(pe, F.lane) + A->in[I_BR][l * NEXP + (F.lane >> 1)];
        if (F.lane & 1) lg = -3.0e38f;
        int se[4]; float sv[4];
#pragma unroll
        for (int k = 0; k < 4; ++k) { float m = lg;
#pragma unroll
            for (int o = 1; o < 64; o <<= 1) m = fmaxf(m, __shfl_xor(m, o));
            const unsigned long long bal = __ballot(lg == m); const int idx = __ffsll((long long)bal) - 1;
            se[k] = idx >> 1; sv[k] = m; if (F.lane == idx) lg = -3.0e38f; }
        const float e1 = __expf(sv[1] - sv[0]), e2 = __expf(sv[2] - sv[0]), e3 = __expf(sv[3] - sv[0]), inv = 1.0f / (1.0f + e1 + e2 + e3);
        if (F.lane == 0) {
            const float gt[4] = {inv, e1 * inv, e2 * inv, e3 * inv};
#pragma unroll
            for (int k = 0; k < 4; ++k) { sE[rl * 4 + k] = se[k]; sP[rl * 4 + k] = __hip_atomic_fetch_add(lcnt + se[k], 1, __ATOMIC_RELAXED, __HIP_MEMORY_SCOPE_WORKGROUP); sG[rl * 4 + k] = gt[k]; } }
    }
    }
    __syncthreads();
    if (F.tid < 32) { const int n = lcnt[F.tid]; lbase[F.tid] = n ? (int)__hip_atomic_fetch_add(F.ctl + CW_GCNT + ((bank * 2 + l) * 32 + F.tid) * 64, (unsigned)n, RLX_AGENT) : 0; }
    __syncthreads();
    if (F.vcu < 256) {
        int* sele = (int*)(F.ws + WS_SELE); int* selp = (int*)(F.ws + WS_SELP); float* selg = (float*)(F.ws + WS_SELG);
        for (int i = F.tid; i < rpb * 4; i += NTHR) { const int e = sE[i]; sele[(size_t)row0 * 4 + i] = e; selp[(size_t)row0 * 4 + i] = lbase[e] + sP[i]; selg[(size_t)row0 * 4 + i] = sG[i]; }
    }
}
__device__ __forceinline__ void moe_layout(const Frame& F, int l, LAS int* pend, LAS int* pstart) {
    __syncthreads();
    if (F.tid < 64) {
        const int e = F.tid & 31;
        const int n = (int)__hip_atomic_load(F.ctl + CW_GCNT + (l * 32 + e) * 64, RLX_AGENT);
        const int nb = (F.tid < 32) ? ((n + 255) >> 8) : 0;
        int inc = nb;
#pragma unroll
        for (int o = 1; o < 32; o <<= 1) { const int t = __shfl_up(inc, o); if ((F.tid & 63) >= o) inc += t; }
        if (F.tid < 32) { pend[e] = inc; pstart[e] = (inc - nb) * 256; }
    }
    __syncthreads();
}
__device__ __forceinline__ void gather_phase(const Frame& F, int l, bool dummy = false) {
    LAS int* pend = (LAS int*)(F.lds + XT_OFF); LAS int* pstart = pend + 32;
    moe_layout(F, l, pend, pstart);
    const int nrows = l == NL - 1 ? NLAT : MT;
    const int* sele = (const int*)(F.ws + WS_SELE); int* selp = (int*)(F.ws + WS_SELP);
    unsigned* goff = (unsigned*)(F.ws + WS_GOFF);
    for (int it = F.gw * 64 + F.lane; it < nrows * 4; it += F.NGW * 64) {
        const int t = it >> 2, e = sele[it], dst = pstart[e] + selp[it];
        const int pm = dst >> 8, h = (dst >> 7) & 1, R = dst & 127;
        unsigned* gp = goff + (size_t)pm * 2048 + h * 2;
#pragma unroll
        for (int cp = 0; cp < 8; ++cp) { const int b = pg8::lds_byte(R, 8 * cp);
            gp[((b & 8191) >> 4) * 4 + (b >> 13)] = (unsigned)(t * 2048 + 16 * cp); }
        if (!dummy) selp[it] = dst;
    }
}


constexpr size_t WS_PW = WS_OB + 34 * MiB;
constexpr size_t WS_PKET = WS_PW + 68 * MiB;
constexpr size_t WS_PUT = WS_PKET + 68 * MiB;
constexpr size_t WS_PATT = WS_PUT + 68 * MiB;
constexpr size_t WS_PGAM = WS_PATT + 34 * MiB;
static_assert(WS_PGAM + 6 * MiB <= WS_END, "prep map");
typedef short bf16x8_t __attribute__((ext_vector_type(8)));
#define MFMA16(a, b, c) __builtin_amdgcn_mfma_f32_16x16x32_bf16((a), (b), (c), 0, 0, 0)
__device__ __forceinline__ v2u pack4(const f32x4 v) { v2u w; w.x = pk2(v.x, v.y); w.y = pk2(v.z, v.w); return w; }
__device__ __forceinline__ int chunk_rowbase(int b, int cn) { return cn < 4 ? NLAT + b * CTXL + cn * 64 : b * SEQ + (cn - 4) * 64; }

#ifdef PROBE_PREP
#define PSTAMP(k) do { const unsigned long long t_ = __builtin_amdgcn_s_memrealtime(); if (PROBE_PREP == (k)) pp_acc += t_ - pp_last; pp_last = t_; } while (0)
#else
#define PSTAMP(k) do {} while (0)
#endif
__device__ __forceinline__ void prep_phase(const Frame& F) {
#ifdef PROBE_PREP
    unsigned long long pp_acc = 0ull, pp_last = 0ull;
#endif
    LAS bf16* k_rm = (LAS bf16*)F.lds;
    LAS bf16* q_rm = k_rm + 64 * 136;
    LAS bf16* kT = (LAS bf16*)(F.lds + 36864);
    LAS bf16* vT = kT + 128 * 72;
    LAS float* Gm = (LAS float*)(F.lds + 36864 + 36864);
    LAS float* A0 = Gm + 64 * 72;
    LAS float* bs = (LAS float*)(F.lds + 36864 + 36864 + 36864);
    LAS float* gam = bs + 128;
    const bf16* qkvn = (const bf16*)(F.ws + WS_QKVN);
    const float* gb = (const float*)(F.ws + WS_G); const float* bb = (const float*)(F.ws + WS_BETA);
    const int w = F.wave;
    v4u ld[2][3];
    {
        int tid_ = F.tid; asm volatile("" : "+v"(tid_));
        const int unit = F.vcu;
        if (unit < 32 * 68) { const int bh = unit / 68, cn = unit % 68, rowbase = chunk_rowbase(bh >> 2, cn);
#pragma unroll
            for (int it = 0; it < 2; ++it) { const int p = tid_ + it * NTHR, i = p & 63, c8 = p >> 6; const bf16* rp = qkvn + (size_t)(rowbase + i) * 1536 + (bh & 3) * 128 + c8 * 8;
                ld[it][0] = *(const v4u*)rp; ld[it][1] = *(const v4u*)(rp + 512); ld[it][2] = *(const v4u*)(rp + 1024); } }
    }
    for (int unit = F.vcu; unit < 32 * 68; unit += F.G) {
        int tid_ = F.tid; asm volatile("" : "+v"(tid_));
        const int tid = tid_, lane = tid & 63, l15 = lane & 15, l4 = lane >> 4;
        const int bh = unit / 68, cn = unit % 68, b = bh >> 2, h = bh & 3, rowbase = chunk_rowbase(b, cn);
        const size_t pu = (size_t)(bh * 68 + cn) * 2;
        __syncthreads();
        PSTAMP(0);
#pragma unroll
        for (int it = 0; it < 2; ++it) { const int p = tid + it * NTHR, i = p & 63, c8 = p >> 6;
            const v4u qv = ld[it][0], kv = ld[it][1], vv = ld[it][2];
            *(LAS v4u*)(q_rm + i * 136 + c8 * 8) = qv; *(LAS v4u*)(k_rm + i * 136 + c8 * 8) = kv;
#pragma unroll
            for (int e = 0; e < 4; ++e) { const unsigned kw = kv[e], vw = vv[e];
                kT[(c8 * 8 + 2 * e) * 72 + i] = (bf16)(kw & 0xffffu); kT[(c8 * 8 + 2 * e + 1) * 72 + i] = (bf16)(kw >> 16);
                vT[(c8 * 8 + 2 * e) * 72 + i] = (bf16)(vw & 0xffffu); vT[(c8 * 8 + 2 * e + 1) * 72 + i] = (bf16)(vw >> 16); } }
        if (w < 2) { const int d = w; float g = gb[(size_t)(rowbase + lane) * 8 + d * 4 + h]; bs[d * 64 + lane] = bb[(size_t)(rowbase + lane) * 8 + d * 4 + h];
            if (d == 0) {
#pragma unroll
                for (int o = 1; o < 64; o <<= 1) { const float t = __shfl_up(g, o); if (lane >= o) g += t; } }
            else {
#pragma unroll
                for (int o = 1; o < 64; o <<= 1) { const float t = __shfl_down(g, o); if (lane + o < 64) g += t; } }
            gam[d * 64 + lane] = g; }
        {
            const int un = unit + F.G;
            if (un < 32 * 68) { const int bh2 = un / 68, cn2 = un % 68, rb2 = chunk_rowbase(bh2 >> 2, cn2);
#pragma unroll
                for (int it = 0; it < 2; ++it) { const int p = tid + it * NTHR, i = p & 63, c8 = p >> 6; const bf16* rp = qkvn + (size_t)(rb2 + i) * 1536 + (bh2 & 3) * 128 + c8 * 8;
                    ld[it][0] = *(const v4u*)rp; ld[it][1] = *(const v4u*)(rp + 512); ld[it][2] = *(const v4u*)(rp + 1024); } }
        }
        __syncthreads();
        PSTAMP(1);
        { bf16* qz = (bf16*)(F.ws + WS_QKVZ);
#pragma unroll
          for (int it = 0; it < 2; ++it) { const int p = tid + it * NTHR, tl = p >> 6, ln = p & 63, rt_ = tl >> 2, ks_ = tl & 3;
              const v4u qv = *(const LAS v4u*)(q_rm + (16 * rt_ + (ln & 15)) * 136 + 32 * ks_ + 8 * (ln >> 4));
              *(v4u*)(qz + (size_t)(rowbase + 16 * h + tl) * 2048 + ln * 8) = qv; } }
#pragma unroll
        for (int tt = 0; tt < 2; ++tt) { const int idx = 2 * w + tt, ti = idx >> 2, tj = idx & 3;
            f32x4 aG = {0.f, 0.f, 0.f, 0.f}, aA = {0.f, 0.f, 0.f, 0.f};
#pragma unroll
            for (int ks = 0; ks < 4; ++ks) { const int co = 32 * ks + 8 * l4;
                const bf16x8_t bk = *(const LAS bf16x8_t*)(k_rm + (16 * tj + l15) * 136 + co), ak = *(const LAS bf16x8_t*)(k_rm + (16 * ti + l15) * 136 + co), aq = *(const LAS bf16x8_t*)(q_rm + (16 * ti + l15) * 136 + co);
                aG = MFMA16(ak, bk, aG); aA = MFMA16(aq, bk, aA); }
#pragma unroll
            for (int r = 0; r < 4; ++r) { Gm[(16 * ti + 4 * l4 + r) * 72 + 16 * tj + l15] = aG[r]; A0[(16 * ti + 4 * l4 + r) * 72 + 16 * tj + l15] = aA[r]; } }
        __syncthreads();
        PSTAMP(2);
        for (int idx = tid; idx < 8192; idx += NTHR) { const int d = idx >> 12, ip = (idx >> 6) & 63, jp = idx & 63, i = d ? 63 - ip : ip, j = d ? 63 - jp : jp;
            ((LAS float*)(F.lds + d * 18432))[idx & 4095] = jp < ip ? bs[d * 64 + i] * Gm[i * 72 + j] * __expf(gam[d * 64 + i] - gam[d * 64 + j]) : 0.f; }
        __syncthreads();
        PSTAMP(3);
        if (w < 2) {
            const int d = w; const LAS float* Lr = (const LAS float*)(F.lds + d * 18432);
            const int blk = lane >> 5, cc = lane & 31;
            const LAS float* Lb = Lr + (32 * blk) * 64 + 32 * blk;
            LAS bf16* SB = (LAS bf16*)(F.lds + 36864 + 36864 + 36864 + 1024 + d * 9216);
            LAS bf16* L21b = SB;
            LAS bf16* T22r = SB + 32 * 40;
            LAS bf16* T11T = SB + 64 * 40;
            LAS bf16* XT = T11T + 32 * 32;
            float t[32];
            f32x4 LA[8], LB[8];
#pragma unroll
            for (int ip = 0; ip < 32; ++ip) {
                if (ip + 1 < 32) {
#pragma unroll
                    for (int j4 = 0; j4 < (ip + 4) / 4; ++j4) { const f32x4 Lv = *(const LAS f32x4*)(Lb + (ip + 1) * 64 + 4 * j4); if (ip & 1) LA[j4] = Lv; else LB[j4] = Lv; }
                }
                float a0 = (cc == ip) ? 1.f : 0.f, a1 = 0.f, a2 = 0.f, a3 = 0.f;
#pragma unroll
                for (int j4 = 0; j4 < (ip + 3) / 4; ++j4) { const f32x4 Lv = (ip & 1) ? LB[j4] : LA[j4];
                    if (4 * j4 + 0 < ip) a0 -= Lv.x * t[4 * j4 + 0];
                    if (4 * j4 + 1 < ip) a1 -= Lv.y * t[4 * j4 + 1];
                    if (4 * j4 + 2 < ip) a2 -= Lv.z * t[4 * j4 + 2];
                    if (4 * j4 + 3 < ip) a3 -= Lv.w * t[4 * j4 + 3]; }
                t[ip] = (a0 + a1) + (a2 + a3); asm volatile("" ::: "memory"); }
            { const int i = lane >> 1, j0 = (lane & 1) * 16; const LAS f32x4* lp = (const LAS f32x4*)(Lr + (32 + i) * 64 + j0);
              const f32x4 x0 = lp[0], x1 = lp[1], x2 = lp[2], x3 = lp[3];
              v4u o0, o1; o0.x = pk2(x0.x, x0.y); o0.y = pk2(x0.z, x0.w); o0.z = pk2(x1.x, x1.y); o0.w = pk2(x1.z, x1.w); o1.x = pk2(x2.x, x2.y); o1.y = pk2(x2.z, x2.w); o1.z = pk2(x3.x, x3.y); o1.w = pk2(x3.z, x3.w);
              *(LAS v4u*)(L21b + i * 40 + j0) = o0; *(LAS v4u*)(L21b + i * 40 + j0 + 8) = o1; }
            if (blk == 0) {
#pragma unroll
                for (int q = 0; q < 4; ++q) { v4u o; o.x = pk2(t[8 * q], t[8 * q + 1]); o.y = pk2(t[8 * q + 2], t[8 * q + 3]); o.z = pk2(t[8 * q + 4], t[8 * q + 5]); o.w = pk2(t[8 * q + 6], t[8 * q + 7]);
                    *(LAS v4u*)(T11T + cc * 32 + 8 * q) = o; }
            } else {
#pragma unroll
                for (int ip = 0; ip < 32; ++ip) T22r[ip * 40 + cc] = (bf16)f2bf(t[ip]);
            }
            asm volatile("s_waitcnt lgkmcnt(0)" ::: "memory");
            f32x4 xa[2][2];
#pragma unroll
            for (int ti = 0; ti < 2; ++ti) { const bf16x8_t af = *(const LAS bf16x8_t*)(L21b + (16 * ti + l15) * 40 + 8 * l4);
#pragma unroll
                for (int tj = 0; tj < 2; ++tj) { const bf16x8_t bf = *(const LAS bf16x8_t*)(T11T + (16 * tj + l15) * 32 + 8 * l4);
                    xa[ti][tj] = MFMA16(af, bf, ((f32x4){0.f, 0.f, 0.f, 0.f}));
                    *(LAS v2u*)(XT + (16 * tj + l15) * 32 + 16 * ti + 4 * l4) = pack4(xa[ti][tj]); } }
            asm volatile("s_waitcnt lgkmcnt(0)" ::: "memory");
#pragma unroll
            for (int ti = 0; ti < 2; ++ti) { const bf16x8_t af = *(const LAS bf16x8_t*)(T22r + (16 * ti + l15) * 40 + 8 * l4);
#pragma unroll
                for (int tj = 0; tj < 2; ++tj) { const bf16x8_t bf = *(const LAS bf16x8_t*)(XT + (16 * tj + l15) * 32 + 8 * l4);
                    xa[ti][tj] = MFMA16(af, bf, ((f32x4){0.f, 0.f, 0.f, 0.f})); } }
            asm volatile("s_waitcnt lgkmcnt(0)" ::: "memory");
            LAS bf16* Tu = (LAS bf16*)(F.lds + d * 18432); LAS bf16* Tw = Tu + 64 * 72;
            {
                const int jp = 32 * blk + cc, jn = d ? 63 - jp : jp; const float bj = bs[d * 64 + jn], bge = bj * __expf(gam[d * 64 + jn]);
#pragma unroll
                for (int ip = 0; ip < 32; ++ip) { const int ipp = 32 * blk + ip, in = d ? 63 - ipp : ipp; Tu[in * 72 + jn] = (bf16)f2bf(t[ip] * bj); Tw[in * 72 + jn] = (bf16)f2bf(t[ip] * bge); }
                if (blk == 1) {
#pragma unroll
                    for (int ip = 0; ip < 32; ++ip) { const int in = d ? 63 - ip : ip; Tu[in * 72 + jn] = (bf16)0; Tw[in * 72 + jn] = (bf16)0; } }
            }
#pragma unroll
            for (int tj = 0; tj < 2; ++tj) {
                const int jp = 16 * tj + l15, jn = d ? 63 - jp : jp; const float bj = bs[d * 64 + jn], bge = bj * __expf(gam[d * 64 + jn]);
#pragma unroll
                for (int ti = 0; ti < 2; ++ti)
#pragma unroll
                    for (int r = 0; r < 4; ++r) { const int ipp = 32 + 16 * ti + 4 * l4 + r, in = d ? 63 - ipp : ipp; const float v = -xa[ti][tj][r];
                        Tu[in * 72 + jn] = (bf16)f2bf(v * bj); Tw[in * 72 + jn] = (bf16)f2bf(v * bge); } }
        } else {
            const int t6 = tid - 128;
            for (int it = t6; it < 1024; it += NTHR - 128) { const int d = it >> 9, i = (it >> 3) & 63, j0 = (it & 7) * 8; float v[8];
#pragma unroll
                for (int e = 0; e < 8; ++e) { const int j = j0 + e; const bool in = d ? (j >= i) : (j <= i); v[e] = in ? A0[i * 72 + j] * __expf(gam[d * 64 + i] - gam[d * 64 + j]) : 0.f; }
                v4u o; o.x = pk2(v[0], v[1]); o.y = pk2(v[2], v[3]); o.z = pk2(v[4], v[5]); o.w = pk2(v[6], v[7]);
                *(v4u*)((bf16*)(F.ws + WS_PATT) + (pu + d) * 4096 + ((((i >> 4) * 2 + (j0 >> 5)) * 64 + ((j0 & 31) >> 3) * 16 + (i & 15)) * 8)) = o; }
            for (int it = t6; it < 2048; it += NTHR - 128) { const int d = it >> 10, dk = (it >> 3) & 127, j0 = (it & 7) * 8; const float gl = d ? gam[64] : gam[63]; float v[8];
                const v4u kk = *(const LAS v4u*)(kT + dk * 72 + j0);
                v[0] = bflo(kk.x); v[1] = bfhi(kk.x); v[2] = bflo(kk.y); v[3] = bfhi(kk.y); v[4] = bflo(kk.z); v[5] = bfhi(kk.z); v[6] = bflo(kk.w); v[7] = bfhi(kk.w);
#pragma unroll
                for (int e = 0; e < 8; ++e) v[e] *= __expf(gl - gam[d * 64 + j0 + e]);
                v4u o; o.x = pk2(v[0], v[1]); o.y = pk2(v[2], v[3]); o.z = pk2(v[4], v[5]); o.w = pk2(v[6], v[7]);
                *(v4u*)((bf16*)(F.ws + WS_PKET) + (pu + d) * 8192 + ((((dk >> 4) * 2 + (j0 >> 5)) * 64 + ((j0 & 31) >> 3) * 16 + (dk & 15)) * 8)) = o; }
            if (t6 < 128) ((float*)(F.ws + WS_PGAM))[(pu + (t6 >> 6)) * 64 + (t6 & 63)] = gam[t6];
        }
        __syncthreads();
        PSTAMP(4);
        {
            const int d = w >> 2, ww = w & 3;
            const LAS bf16* Tu = (const LAS bf16*)(F.lds + d * 18432); const LAS bf16* Tw = Tu + 64 * 72;
            bf16x8_t tu[2], tw[2];
#pragma unroll
            for (int ks = 0; ks < 2; ++ks) { tu[ks] = *(const LAS bf16x8_t*)(Tu + (16 * ww + l15) * 72 + 32 * ks + 8 * l4); tw[ks] = *(const LAS bf16x8_t*)(Tw + (16 * ww + l15) * 72 + 32 * ks + 8 * l4); }
            bf16* ut = (bf16*)(F.ws + WS_PUT) + (pu + d) * 8192; bf16* wg = (bf16*)(F.ws + WS_PW) + (pu + d) * 8192;
#pragma unroll 2
            for (int tj = 0; tj < 8; ++tj) {
                f32x4 au = {0.f, 0.f, 0.f, 0.f}, aw = {0.f, 0.f, 0.f, 0.f};
#pragma unroll
                for (int ks = 0; ks < 2; ++ks) { const bf16x8_t bv = *(const LAS bf16x8_t*)(vT + (16 * tj + l15) * 72 + 32 * ks + 8 * l4), ak = *(const LAS bf16x8_t*)(kT + (16 * tj + l15) * 72 + 32 * ks + 8 * l4);
                    au = MFMA16(tu[ks], bv, au); aw = MFMA16(ak, tw[ks], aw); }
                *(v2u*)(ut + ((((tj >> 2) * 4 + ww) * 2 + ((tj & 3) >> 1)) * 512 + (l4 * 16 + l15) * 8 + (tj & 1) * 4)) = pack4(au);
                *(v2u*)(wg + ((ww * 4 + (tj >> 1)) * 512 + ((2 * (tj & 1) + (l4 >> 1)) * 16 + l15) * 8 + 4 * (l4 & 1))) = pack4(aw);
            }
        }
        PSTAMP(5);
    }
    __syncthreads();
#ifdef PROBE_PREP
    if (F.vcu == 0 && F.tid == 0) *(unsigned long long*)(F.ws + WS_ZN + 48 * 1024) += pp_acc;
#endif
}

__device__ __forceinline__ void gl16(bf16x8_t& d, const void* p) { asm volatile("global_load_dwordx4 %0, %1, off" : "=v"(d) : "v"(p) : "memory"); }
__device__ __forceinline__ void gl16f(f32x4& d, const void* p) { asm volatile("global_load_dwordx4 %0, %1, off" : "=v"(d) : "v"(p) : "memory"); }
__device__ __forceinline__ void gl4f(float& d, const void* p) { asm volatile("global_load_dword %0, %1, off" : "=v"(d) : "v"(p) : "memory"); }
struct ScanRegs { bf16x8_t fa[4], fx[2], kf[2]; f32x4 graw; float glast; };
__device__ __forceinline__ int scan_cn(int ci_in, int d) { const int ci = ci_in < 68 ? ci_in : 67; return ci < 4 ? (d ? 3 - ci : ci) : 4 + (d ? 67 - ci : ci - 4); }
__device__ __forceinline__ void scan_load(ScanRegs& R, const unsigned char* ws, int ci_in, int b, int bh, int h, int d, int s, int w, int l15, int l4) {
    const int rt = w & 3, cn = scan_cn(ci_in, d), rowbase = chunk_rowbase(b, cn);
    const size_t pu = (size_t)(bh * 68 + cn) * 2 + d;
    const float* gmp = (const float*)(ws + WS_PGAM) + pu * 64;
    gl4f(R.glast, gmp + (d ? 0 : 63)); gl16f(R.graw, gmp + 16 * rt + 4 * l4);
    const int ln8 = (l4 * 16 + l15) * 8;
    const bf16* ket = (const bf16*)(ws + WS_PKET) + pu * 8192 + (w * 2) * 512 + ln8;
    gl16(R.kf[0], ket); gl16(R.kf[1], ket + 512);
    const bf16* wp = (const bf16*)(ws + WS_PW) + pu * 8192 + (rt * 4) * 512 + ln8;
    const bf16* qp = (const bf16*)(ws + WS_QKVZ) + (size_t)(rowbase + 16 * h + 4 * rt) * 2048 + ln8;
    const bf16* ap_ = w < 4 ? wp : qp; const int kst = w < 4 ? 512 : 2048;
#pragma unroll
    for (int ks = 0; ks < 4; ++ks) gl16(R.fa[ks], ap_ + kst * ks);
    const bf16* up = (const bf16*)(ws + WS_PUT) + pu * 8192 + ((s * 4 + rt) * 2) * 512 + ln8;
    const bf16* ap = (const bf16*)(ws + WS_PATT) + pu * 4096 + (rt * 2) * 512 + ln8;
    const bf16* xp = w < 4 ? up : ap; const int xo = 512;
    gl16(R.fx[0], xp); gl16(R.fx[1], xp + xo);
}
__device__ __forceinline__ void scan_step(ScanRegs& R, f32x4 (&S)[4], LAS bf16* ST, LAS bf16* vnT, LAS bf16* oT, LAS bf16* oDump, int w, int l15, int l4, unsigned& g_p2) {
    const int rt = w & 3;
#ifdef PROBE_SCAN2
    const unsigned tw0_ = (unsigned)__builtin_amdgcn_s_memrealtime();
#endif
    asm volatile("s_waitcnt vmcnt(20)" : "+v"(R.fa[0]), "+v"(R.fa[1]), "+v"(R.fa[2]), "+v"(R.fa[3]), "+v"(R.fx[0]), "+v"(R.fx[1]), "+v"(R.kf[0]), "+v"(R.kf[1]), "+v"(R.graw), "+v"(R.glast) :: "memory");
#ifdef PROBE_SCAN2
    const unsigned tw1_ = (unsigned)__builtin_amdgcn_s_memrealtime(); if (PROBE_SCAN2 == 1) g_p2 += tw1_ - tw0_;
#endif
    const float gend = __expf(R.glast);
    const bool hiw = w >= 4;
    const f32x4 eg = {hiw ? __expf(R.graw.x) : 1.0f, hiw ? __expf(R.graw.y) : 1.0f, hiw ? __expf(R.graw.z) : 1.0f, hiw ? __expf(R.graw.w) : 1.0f};
    f32x4 c[4];
#pragma unroll
    for (int ct = 0; ct < 4; ++ct) { c[ct] = (f32x4){0.f, 0.f, 0.f, 0.f};
#pragma unroll
        for (int ks = 0; ks < 4; ++ks) { const bf16x8_t bq = *(const LAS bf16x8_t*)(ST + (16 * ct + l15) * 136 + 32 * ks + 8 * l4); c[ct] = MFMA16(R.fa[ks], bq, c[ct]); }
        c[ct] = c[ct] * eg; }
    {
        const v4u ua = __builtin_bit_cast(v4u, R.fx[0]), ub = __builtin_bit_cast(v4u, R.fx[1]);
        const f32x4 u0 = {bflo(ua.x), bfhi(ua.x), bflo(ua.y), bfhi(ua.y)}, u1 = {bflo(ua.z), bfhi(ua.z), bflo(ua.w), bfhi(ua.w)};
        const f32x4 u2 = {bflo(ub.x), bfhi(ub.x), bflo(ub.y), bfhi(ub.y)}, u3 = {bflo(ub.z), bfhi(ub.z), bflo(ub.w), bfhi(ub.w)};
        LAS bf16* vp = vnT + (w < 4 ? 0 : 64 * 72) + l15 * 72 + 16 * rt + 4 * l4;
        *(LAS v2u*)(vp) = pack4(u0 - c[0]); *(LAS v2u*)(vp + 16 * 72) = pack4(u1 - c[1]); *(LAS v2u*)(vp + 32 * 72) = pack4(u2 - c[2]); *(LAS v2u*)(vp + 48 * 72) = pack4(u3 - c[3]);
    }
    __syncthreads();
    {
        LAS bf16* op = (w < 4 ? oDump : oT) + (16 * rt + 4 * l4) * 72 + l15;
#pragma unroll
        for (int ct = 0; ct < 4; ++ct) { const bf16x8_t v0 = *(const LAS bf16x8_t*)(vnT + (16 * ct + l15) * 72 + 8 * l4), v1 = *(const LAS bf16x8_t*)(vnT + (16 * ct + l15) * 72 + 32 + 8 * l4);
            f32x4 o = MFMA16(R.fx[0], v0, c[ct]); o = MFMA16(R.fx[1], v1, o);
#pragma unroll
            for (int r = 0; r < 4; ++r) op[r * 72 + 16 * ct] = (bf16)f2bf(o[r]);
            f32x4 sn = S[ct] * gend; sn = MFMA16(R.kf[0], v0, sn); sn = MFMA16(R.kf[1], v1, sn); S[ct] = sn;
            *(LAS v2u*)(ST + (16 * ct + l15) * 136 + 16 * w + 4 * l4) = pack4(sn); }
    }
    __syncthreads();
#ifdef PROBE_SCAN2
    if (PROBE_SCAN2 == 2) g_p2 += (unsigned)__builtin_amdgcn_s_memrealtime() - tw1_;
#endif
}
__device__ __forceinline__ void scan_flush(LAS bf16* oS, int ci0, int n, bf16* od, bf16* dump, bool skip_ctx_out, int b, int d, int h, int s, int tid) {
    const int i = tid >> 3, pc = tid & 7;
    for (int k = 0; k < n; ++k) { const int cn = scan_cn(ci0 + k, d), rowbase = chunk_rowbase(b, cn);
        const v4u ov = *(const LAS v4u*)(oS + k * 64 * 72 + i * 72 + pc * 8);
        const bool real = !(cn < 4 && skip_ctx_out);
        bf16* gp = real ? od + (size_t)(rowbase + i) * 512 + h * 128 + 64 * s + pc * 8 : dump + (size_t)i * 64 + pc * 8;
        *(v4u*)gp = ov; }
    asm volatile("s_waitcnt vmcnt(0)" ::: "memory");
    __syncthreads();
}
__device__ __forceinline__ void scan_mfma(const Frame& F, int l) {
    LAS bf16* ST = (LAS bf16*)F.lds;
    LAS bf16* vnT = ST + 64 * 136;
    LAS bf16* oS = vnT + 2 * 64 * 72;
    LAS bf16* oDump = oS + 6 * 64 * 72;
    const int lane = F.lane, l15 = lane & 15, l4 = lane >> 4, w = F.wave;
    const bool skip_ctx_out = (l == NL - 1);
    if (w >= 4) __builtin_amdgcn_s_setprio(1);
    for (int unit = F.vcu; unit < 128; unit += F.G) {
        const int s = unit & 1, sd = unit >> 1, d = sd & 1, bh = sd >> 1, b = bh >> 2, h = bh & 3;
        bf16* od = (bf16*)(F.ws + (d ? WS_OB : WS_OF)); bf16* dump = (bf16*)(F.ws + WS_PGAM + 1536 * 1024) + (size_t)unit * 16 * 512;
        asm volatile("s_waitcnt vmcnt(0)" ::: "memory");
        __syncthreads();
        for (int i = F.tid; i < 64 * 136 / 2; i += NTHR) ((LAS unsigned*)ST)[i] = 0u;
        f32x4 S[4];
#pragma unroll
        for (int ct = 0; ct < 4; ++ct) S[ct] = (f32x4){0.f, 0.f, 0.f, 0.f};
        ScanRegs R0, R1, R2; unsigned g_p2 = 0u;
        scan_load(R0, F.ws, 0, b, bh, h, d, s, w, l15, l4); scan_load(R1, F.ws, 1, b, bh, h, d, s, w, l15, l4); scan_load(R2, F.ws, 2, b, bh, h, d, s, w, l15, l4);
        __syncthreads();
#pragma unroll 1
        for (int ci = 0; ci < 66; ci += 6) {
            scan_step(R0, S, ST, vnT, oS + 0 * 64 * 72, oDump, w, l15, l4, g_p2); scan_load(R0, F.ws, ci + 3, b, bh, h, d, s, w, l15, l4);
            scan_step(R1, S, ST, vnT, oS + 1 * 64 * 72, oDump, w, l15, l4, g_p2); scan_load(R1, F.ws, ci + 4, b, bh, h, d, s, w, l15, l4);
            scan_step(R2, S, ST, vnT, oS + 2 * 64 * 72, oDump, w, l15, l4, g_p2); scan_load(R2, F.ws, ci + 5, b, bh, h, d, s, w, l15, l4);
            scan_step(R0, S, ST, vnT, oS + 3 * 64 * 72, oDump, w, l15, l4, g_p2); scan_load(R0, F.ws, ci + 6, b, bh, h, d, s, w, l15, l4);
            scan_step(R1, S, ST, vnT, oS + 4 * 64 * 72, oDump, w, l15, l4, g_p2); scan_load(R1, F.ws, ci + 7, b, bh, h, d, s, w, l15, l4);
            scan_step(R2, S, ST, vnT, oS + 5 * 64 * 72, oDump, w, l15, l4, g_p2); scan_load(R2, F.ws, ci + 8, b, bh, h, d, s, w, l15, l4);
            scan_flush(oS, ci, 6, od, dump, skip_ctx_out, b, d, h, s, F.tid);
        }
        scan_step(R0, S, ST, vnT, oS + 0 * 64 * 72, oDump, w, l15, l4, g_p2);
        scan_step(R1, S, ST, vnT, oS + 1 * 64 * 72, oDump, w, l15, l4, g_p2);
        scan_flush(oS, 66, 2, od, dump, skip_ctx_out, b, d, h, s, F.tid);
#ifdef PROBE_SCAN2
        if (F.vcu == 0 && F.tid == PROBE_TID) *(unsigned long long*)(F.ws + WS_ZN + 48 * 1024) += g_p2;
#endif
    }
    __builtin_amdgcn_s_setprio(0);
}

#ifndef USE_NAIVE_SCAN
#define USE_NAIVE_SCAN 0
#endif
#ifndef REP_MASK
#define REP_MASK 0
#endif
#define REPS(p) for (int _r = 0; _r < 1 + ((REP_MASK >> (p)) & 1); ++_r)
#define LASTREP(p) (_r == ((REP_MASK >> (p)) & 1))
constexpr int PH_PER_LAYER = 11, N_PHASES = 2 + NL * PH_PER_LAYER;
#ifndef PG8_SP2
#define PG8_SP2 true
#endif
#ifndef PG8_ALIGN
#define PG8_ALIGN true
#endif
__device__ __forceinline__ Frame make_frame(int wv) {
    extern __shared__ __attribute__((aligned(16))) unsigned char lds[];
    const KArgsP A = kargs();
    Frame F;
    { unsigned lb = (unsigned)(uintptr_t)(LAS unsigned char*)lds; asm volatile("" : "+s"(lb)); F.lds = (LAS unsigned char*)(uintptr_t)lb; }
    F.MISC = (volatile LAS unsigned*)(F.lds + MISC_OFF);
    { unsigned m1 = ~0u; asm volatile("" : "+s"(m1)); int ln = (int)__builtin_amdgcn_mbcnt_hi(m1, __builtin_amdgcn_mbcnt_lo(m1, 0u)); asm volatile("" : "+v"(ln)); F.lane = ln; }
    { int w_ = wv; asm volatile("" : "+s"(w_)); F.wave = w_; } F.tid = F.wave * 64 + F.lane;
    F.G = gridDim.x; { const int bx = blockIdx.x; F.vcu = (F.G % 8 == 0) ? (bx % 8) * (F.G / 8) + bx / 8 : bx; }
    F.gw = F.vcu * NWAVES + F.wave; F.NGW = F.G * NWAVES;
    F.ws = A->ws; F.ctl = (unsigned*)(A->ws + WS_CTL); F.out = A->out;
    return F;
}
__global__ void __launch_bounds__(NTHR, 2) mk_fwd(Args args) {
    const int wv = __builtin_amdgcn_readfirstlane((int)threadIdx.x >> 6);
    { Frame F = make_frame(wv);
      for (int u = F.tid; u < (LDS_BYTES - LDSCTL_OFF) / 4; u += NTHR) ((LAS unsigned*)(F.lds + LDSCTL_OFF))[u] = 0u;
      __syncthreads(); }
    const int lo = args.ph_lo, hi = args.ph_hi;
#if defined(PROBE_SCAN) || defined(PROBE_ROUTER) || defined(PROBE_PREP) || defined(PROBE_SCAN2)
    { Frame Fp = make_frame(wv); if (Fp.vcu == 0 && Fp.tid == 0) *(unsigned long long*)(Fp.ws + WS_ZN + 48 * 1024) = 0ull; }
#endif
#ifdef PROBE_P
    unsigned long long pr_acc = 0ull, pr_t0 = 0ull;
#define PR_BEGIN(p) do { if (((p) < 2 ? (p) : 2 + ((p) - 2) % PH_PER_LAYER) == PROBE_P) pr_t0 = __builtin_amdgcn_s_memrealtime(); } while (0)
#define PR_END(p) do { if (((p) < 2 ? (p) : 2 + ((p) - 2) % PH_PER_LAYER) == PROBE_P) pr_acc += __builtin_amdgcn_s_memrealtime() - pr_t0; } while (0)
#else
#define PR_BEGIN(p) do {} while (0)
#define PR_END(p) do {} while (0)
#endif
    if (hi - lo > 1) { Frame F = make_frame(wv); (void)xcd_barrier_post((unsigned*)(F.ctl + CW_BAR), F.MISC + 8, F.tid); }
#define IN(k) (lo <= (k) && (k) < hi)
#define SEAM(k) do { if (IN(k) && IN((k) + 1)) { Frame Fb = make_frame(wv); XcdBarrier bar; bar.bar = (unsigned*)(Fb.ctl + CW_BAR); bar.x = xb_xcc_id(); bar.st = Fb.MISC + 8; xcd_barrier(bar, Fb.tid); } } while (0)
    PR_BEGIN(0); if (IN(0)) { Frame F = make_frame(wv); REPS(0) { p0_prologue(F); __syncthreads(); } }
    SEAM(0); PR_END(0);
    PR_BEGIN(1); if (IN(1)) { Frame F = make_frame(wv); REPS(1) { row_pass<0>(F, 0, 0); __syncthreads(); } }
    SEAM(1); PR_END(1);
#define LAYER_BODY(l) { \
        const int pb = 2 + l * PH_PER_LAYER; \
        PR_BEGIN(pb + 0); if (IN(pb + 0)) { Frame F = make_frame(wv); \
            SchedIn S{(const bf16*)(F.ws + WS_ACT), (const bf16*)(F.ws + WS_WIN) + (size_t)l * 3072 * D, F.G, (int)blockIdx.x}; \
            EpiIn E{(bf16*)(F.ws + WS_QKVZ), (bf16*)(F.ws + WS_ZTL), (bf16*)(F.ws + WS_ZTC)}; \
            REPS(8) { pg8::gemm_phase<EpiIn, SchedIn, PG8_ALIGN, PG8_SP2>(F.lds, pg8::Gemm{D}, S, E, F.tid); __syncthreads(); } } \
        SEAM(pb + 0); PR_END(pb + 0); \
        PR_BEGIN(pb + 1); if (IN(pb + 1)) { Frame F = make_frame(wv); REPS(2) { conv_phase(F, l); __syncthreads(); } fold_phase(F); } \
        SEAM(pb + 1); PR_END(pb + 1); \
        PR_BEGIN(pb + 2); if (IN(pb + 2)) { \
            { Frame F = make_frame(wv); REPS(3) { prep_phase(F); } } \
        } \
        SEAM(pb + 2); PR_END(pb + 2); \
        PR_BEGIN(pb + 3); if (IN(pb + 3)) { Frame F = make_frame(wv); \
            if (F.vcu < 128) { REPS(4) { scan_mfma(F, l); __syncthreads(); } } \
            else { \
              SchedDft S{(const bf16*)(F.ws + WS_DFTM), (const bf16*)(F.ws + WS_EO), F.vcu - 128}; \
              EpiDft E{(bf16*)(F.ws + WS_AB2)}; \
              REPS(9) { pg8::gemm_phase<EpiDft, SchedDft, PG8_ALIGN, PG8_SP2>(F.lds, pg8::Gemm{2048}, S, E, F.tid); __syncthreads(); } \
              if (l == 0) ctx_dft(F); \
              __syncthreads(); convert_experts(F, l, CVT_SPLIT, CVT_ITEMS, (F.vcu - 128) * NWAVES + F.wave, 128 * NWAVES); } \
        } \
        SEAM(pb + 3); PR_END(pb + 3); \
        PR_BEGIN(pb + 4); if (IN(pb + 4)) { Frame F = make_frame(wv); REPS(5) { gated_out(F, l); __syncthreads(); } } \
        SEAM(pb + 4); PR_END(pb + 4); \
        PR_BEGIN(pb + 5); if (IN(pb + 5)) { Frame F = make_frame(wv); \
            SchedOut S{(const bf16*)(F.ws + WS_ACT), (const bf16*)(F.ws + WS_WOUT) + (size_t)l * D * D, l == NL - 1 ? NLAT / 256 : MT / 256, F.G, (int)blockIdx.x}; \
            REPS(10) { EpiOut E{F.out, (float*)(F.ws + WS_XC), l == 0 ? kargs()->in[I_X] : (const float*)F.out, l == 0 ? kargs()->in[I_CTX] : (const float*)(F.ws + WS_XC), modv(F, l, 0, 2), LASTREP(10) ? 1.0f : 0.0f}; \
                pg8::gemm_phase<EpiOut, SchedOut, PG8_ALIGN, PG8_SP2>(F.lds, pg8::Gemm{D}, S, E, F.tid); __syncthreads(); } } \
        SEAM(pb + 5); PR_END(pb + 5); \
        PR_BEGIN(pb + 6); if (IN(pb + 6)) { Frame F = make_frame(wv); REPS(6) { router_phase(F, l, LASTREP(6) ? 0 : 1); __syncthreads(); } } \
        SEAM(pb + 6); PR_END(pb + 6); \
        PR_BEGIN(pb + 7); if (IN(pb + 7)) { Frame F = make_frame(wv); REPS(7) { gather_phase(F, l, !LASTREP(7)); __syncthreads(); } } \
        SEAM(pb + 7); PR_END(pb + 7); \
        PR_BEGIN(pb + 8); if (IN(pb + 8)) { Frame F = make_frame(wv); \
            LAS int* pend = (LAS int*)(F.lds + XT_OFF); moe_layout(F, l, pend, pend + 32); \
            SchedMoe S{(const bf16*)(F.ws + WS_ACT), (const bf16*)(F.ws + WS_W1), (size_t)2048 * D * 2, pend, pend[NEXP - 1], 8, F.G, (int)blockIdx.x, 1}; \
            EpiSwiglu E{(bf16*)(F.ws + WS_HS), kargs()->in[I_BG] + (size_t)l * NEXP * D, kargs()->in[I_BU] + (size_t)l * NEXP * D}; \
            REPS(11) { pg8::gemm_phase<EpiSwiglu, SchedMoe, PG8_ALIGN, PG8_SP2, true>(F.lds, pg8::Gemm{D}, S, E, F.tid, (const unsigned*)(F.ws + WS_GOFF), F.lds + XT_OFF + 1024, (unsigned)MT * 2048u); __syncthreads(); } } \
        SEAM(pb + 8); PR_END(pb + 8); \
        PR_BEGIN(pb + 9); if (IN(pb + 9)) { Frame F = make_frame(wv); \
            LAS int* pend = (LAS int*)(F.lds + XT_OFF); moe_layout(F, l, pend, pend + 32); \
            SchedMoe S{(const bf16*)(F.ws + WS_HS), (const bf16*)(F.ws + WS_W2), (size_t)D * D * 2, pend, pend[NEXP - 1], 4, F.G, (int)blockIdx.x, 0}; \
            EpiDown E{(bf16*)(F.ws + WS_XS), kargs()->in[I_BD] + (size_t)l * NEXP * D}; \
            REPS(12) { pg8::gemm_phase<EpiDown, SchedMoe, PG8_ALIGN, PG8_SP2>(F.lds, pg8::Gemm{D}, S, E, F.tid); __syncthreads(); } } \
        SEAM(pb + 9); PR_END(pb + 9); \
        PR_BEGIN(pb + 10); if (IN(pb + 10)) { \
            { Frame F = make_frame(wv); \
              if (l == NL - 1) row_pass<2>(F, l, l); else { REPS(13) { row_pass<1>(F, l, l + 1, !LASTREP(13)); __syncthreads(); } } } \
            if (l != NL - 1) { Frame F = make_frame(wv); __syncthreads(); REPS(14) { convert_experts(F, l + 1, 0, CVT_SPLIT, F.gw, F.NGW); __syncthreads(); } } \
        } \
        if (l + 1 < NL) SEAM(pb + 10); PR_END(pb + 10); \
    }
    LAYER_BODY(0)
    LAYER_BODY(1)
#undef LAYER_BODY
#ifdef PROBE_P
#if defined(PROBE_SCAN) || defined(PROBE_ROUTER) || defined(PROBE_PREP) || defined(PROBE_SCAN2)
    { Frame Fp = make_frame(wv); if (Fp.vcu == 0 && Fp.tid == 0) pr_acc = *(unsigned long long*)(Fp.ws + WS_ZN + 48 * 1024); else pr_acc = 0; }
#endif
    if (blockIdx.x == 0 && threadIdx.x == 0) { const unsigned long long t0 = __builtin_amdgcn_s_memrealtime(), want = pr_acc * PROBE_SCALE; while (__builtin_amdgcn_s_memrealtime() - t0 < want) __builtin_amdgcn_s_sleep(8); }
#endif
#undef IN
#undef SEAM
}

extern "C" void kernel_launch(void* const* d_in, const int* in_sizes, int n_in, void* d_out, int out_size, void* d_ws, size_t ws_size, hipStream_t stream) {
    static int grid = 0;
    if (grid == 0) {
        if (n_in != 23 || out_size != NLAT * D || ws_size < WS_END) { fprintf(stderr, "kernel_launch: unexpected shapes (n_in %d, out %d, ws %zu); nothing launched\n", n_in, out_size, ws_size); grid = -1; return; }
        int dev = 0, cus = 0, per_cu = 0;
        if (hipGetDevice(&dev) != hipSuccess || hipDeviceGetAttribute(&cus, hipDeviceAttributeMultiprocessorCount, dev) != hipSuccess) { grid = -1; return; }
        if (hipFuncSetAttribute((const void*)mk_fwd, hipFuncAttributeMaxDynamicSharedMemorySize, LDS_BYTES) != hipSuccess) { fprintf(stderr, "kernel_launch: hipFuncSetAttribute failed\n"); grid = -1; return; }
        if (hipOccupancyMaxActiveBlocksPerMultiprocessor(&per_cu, (const void*)mk_fwd, NTHR, LDS_BYTES) != hipSuccess || per_cu < 1)
            fprintf(stderr, "kernel_launch: note: occupancy query reports %d workgroups per CU\n", per_cu);
        (void)hipGetLastError();
        grid = cus;
        if (grid != 256) { fprintf(stderr, "kernel_launch: built for 256 CUs, found %d; nothing launched\n", grid); grid = -1; return; }
    }
    if (grid < 0) return;
    if (hipMemsetAsync((char*)d_ws + WS_CTL, 0, CTL_ZERO_BYTES, stream) != hipSuccess) { fprintf(stderr, "kernel_launch: hipMemsetAsync failed\n"); return; }
    Args a{};
    for (int i = 0; i < 23; ++i) a.in[i] = (const float*)d_in[i];
    a.out = (float*)d_out; a.ws = (unsigned char*)d_ws;
#if MK_ONE_LAUNCH
    a.ph_lo = 0; a.ph_hi = N_PHASES;
    hipLaunchKernelGGL(mk_fwd, dim3(grid), dim3(NTHR), LDS_BYTES, stream, a);
#else
    for (int p = 0; p < N_PHASES; ++p) { a.ph_lo = p; a.ph_hi = p + 1; hipLaunchKernelGGL(mk_fwd, dim3(grid), dim3(NTHR), LDS_BYTES, stream, a); }
#endif
    const hipError_t le = hipPeekAtLastError();
    if (le != hipSuccess) fprintf(stderr, "kernel_launch: launch failed: %s\n", hipGetErrorName(le));
}
```

```cpp
#define MK_ONE_LAUNCH 1
#include <hip/hip_runtime.h>
#include <cstdio>
#include <cstdint>

#ifndef MK_ONE_LAUNCH
#define MK_ONE_LAUNCH 1
#endif

namespace pg8 {
#define PG8_LAS __attribute__((address_space(3)))
typedef unsigned short bf16_t;
typedef short bf16x8 __attribute__((ext_vector_type(8)));
typedef float f32x4 __attribute__((ext_vector_type(4)));
typedef unsigned u32x4 __attribute__((ext_vector_type(4)));
constexpr int BM = 256, BK = 64, HALF = 128, HTB = HALF * BK * 2  , STAGE_BYTES = 8 * HTB, NXCD = 8, WGM = 8;

__host__ __device__ __forceinline__ int lds_byte(int r, int c) { const int st = (r >> 4) * 2 + (c >> 5), rr = r & 15, cc = c & 31, ob = rr * 64 + cc * 2; return st * 1024 + (ob ^ (((ob >> 9) & 1) << 5)); }
__host__ __device__ __forceinline__ void stage_rc(int b, int& R, int& C) { const int st = b / 1024, sb = b % 1024, swz = sb ^ (((sb >> 9) & 1) << 5); R = (st >> 1) * 16 + swz / 64; C = (st & 1) * 32 + (swz % 64) / 2; }
__host__ __device__ __forceinline__ int perm32(int rho) { const int n = rho >> 4, i = rho & 15; return 8 * (i >> 2) + 4 * n + (i & 3); }

struct Unit { int pm, pn, kind, e; };
struct Gemm { int K; };

__device__ __forceinline__ int xcd_remap(int L, int nwg) { const int q = nwg / NXCD, r = nwg % NXCD, xcd = L % NXCD, off = L / NXCD; return (xcd < r ? xcd * (q + 1) : r * (q + 1) + (xcd - r) * q) + off; }
__device__ __forceinline__ void grp_decode(int wgid, int nM, int nN, int& pm, int& pn) { const int nig = WGM * nN, gid = wgid / nig, fm = gid * WGM, gsz = (nM - fm) < WGM ? (nM - fm) : WGM; pm = fm + ((wgid % nig) % gsz); pn = (wgid % nig) / gsz; }

__device__ __forceinline__ const char* uni_ptr(const char* p) { const unsigned long long v = (unsigned long long)p; const unsigned lo = __builtin_amdgcn_readfirstlane((unsigned)v), hi = __builtin_amdgcn_readfirstlane((unsigned)(v >> 32)); return (const char*)(((unsigned long long)hi << 32) | lo); }
__device__ __forceinline__ unsigned cvt_pk_bf16(float lo, float hi) { unsigned r; asm volatile("v_cvt_pk_bf16_f32 %0, %1, %2" : "=v"(r) : "v"(lo), "v"(hi)); return r; }

template <class Epi, class Sched, bool ALIGN_EPI = false, bool SP2 = false, bool GATHER = false>
__device__ __forceinline__ void gemm_phase(PG8_LAS unsigned char* lds, const Gemm g, const Sched& S, const Epi& E, int tid_in, const unsigned* gtab = nullptr, PG8_LAS unsigned char* gl_tab = nullptr, unsigned glim = 0u) {
    static_assert(!GATHER || SP2, "GATHER is written for the SP2 loop");
    int tid_ = tid_in; asm volatile("" : "+v"(tid_));
    const int tid = tid_, wid = __builtin_amdgcn_readfirstlane(tid >> 6), lane = tid & 63, wr = wid >> 2, wc = wid & 3, fr = lane & 15, fq = lane >> 4;
    const int K = g.K, nt = K / BK;
    unsigned voffA[2], voffB[2];
#pragma unroll
    for (int i = 0; i < 2; ++i) { int R, C; stage_rc(tid * 16 + i * 8192, R, C); const int Rb = Epi::PERM ? ((R & ~31) + perm32(R & 31)) : R;
        voffA[i] = (unsigned)(R * K + C) * 2u; voffB[i] = (unsigned)(Rb * K + C) * 2u; }
    const size_t kstep = (size_t)(BK * 2);
    const size_t hstep = (size_t)HALF * K * 2;
    const size_t tstep = 2 * hstep;
    const unsigned ldsw = (unsigned)wid * 1024u;
    const int aoff = lds_byte(wr * 64 + fr, fq * 8), boff = lds_byte(wc * 32 + fr, fq * 8);
#define PG8_SA(b, h) (((b) * 2 + (h)) * HTB)
#define PG8_SB(b, h) ((4 + (b) * 2 + (h)) * HTB)
#define PG8_STAGE(bufoff, gbase, voff) do { _Pragma("unroll") for (int _i = 0; _i < 2; ++_i) \
        __builtin_amdgcn_global_load_lds((const unsigned*)((const char*)(gbase) + (voff)[_i]), (PG8_LAS unsigned*)(lds + (bufoff) + ldsw + _i * 8192), 16, 0, 0); } while (0)
#define PG8_STAGE_G(bufoff, gbase, G, H) do { _Pragma("unroll") for (int _i = 0; _i < 2; ++_i) \
        __builtin_amdgcn_global_load_lds((const unsigned*)((const char*)(gbase) + (G)[H][_i]), (PG8_LAS unsigned*)(lds + (bufoff) + ldsw + _i * 8192), 16, 0, 0); } while (0)
#define PG8_STAGE_A(bufoff, gbase, G, H) do { if constexpr (GATHER) PG8_STAGE_G(bufoff, gbase, G, H); else PG8_STAGE(bufoff, (gbase) + (H) * hstep, voffA); } while (0)
#define PG8_TAB_ISSUE(u_) __builtin_amdgcn_global_load_lds(gtab + ((size_t)(u_).pm * 512 + tid) * 4, (PG8_LAS unsigned*)(gl_tab + wid * 1024), 16, 0, 0)
#define PG8_TAB_READ(G) do { const u32x4 gv_ = *(const PG8_LAS u32x4*)(gl_tab + tid * 16); G[0][0] = gv_.x < glim ? gv_.x : 0u; G[0][1] = gv_.y < glim ? gv_.y : 0u; G[1][0] = gv_.z < glim ? gv_.z : 0u; G[1][1] = gv_.w < glim ? gv_.w : 0u; } while (0)
#define PG8_LDA(dst, b, h) do { _Pragma("unroll") for (int m = 0; m < 4; ++m) _Pragma("unroll") for (int k = 0; k < 2; ++k) dst[m][k] = *(const PG8_LAS bf16x8*)(lds + PG8_SA(b, h) + aoff + m * 2048 + k * 1024); } while (0)
#define PG8_LDB(dst, b, h) do { _Pragma("unroll") for (int n = 0; n < 2; ++n) _Pragma("unroll") for (int k = 0; k < 2; ++k) dst[n][k] = *(const PG8_LAS bf16x8*)(lds + PG8_SB(b, h) + boff + n * 2048 + k * 1024); } while (0)
#define PG8_MMA(ai, bj, At, Bt) do { __builtin_amdgcn_s_setprio(1); _Pragma("unroll") for (int m = 0; m < 4; ++m) _Pragma("unroll") for (int n = 0; n < 2; ++n) _Pragma("unroll") for (int k = 0; k < 2; ++k) \
        acc[ai][bj][m][n] = __builtin_amdgcn_mfma_f32_16x16x32_bf16(Bt[n][k], At[m][k], acc[ai][bj][m][n], 0, 0, 0); __builtin_amdgcn_s_setprio(0); } while (0)
#define PG8_WAIT_V(n) asm volatile("s_waitcnt vmcnt(" #n ")" ::: "memory")
#define PG8_WAIT_L(n) asm volatile("s_waitcnt lgkmcnt(" #n ")" ::: "memory")
#define PG8_BAR __builtin_amdgcn_s_barrier()
#define PG8_SCHED __builtin_amdgcn_sched_barrier(0)
    Unit cur, nxt; int ui = 0;
    if (!S.next(0, cur)) return;
    f32x4 acc[2][2][4][2];
#pragma unroll
    for (int a = 0; a < 2; ++a)
#pragma unroll
        for (int b = 0; b < 2; ++b)
#pragma unroll
            for (int m = 0; m < 4; ++m)
#pragma unroll
                for (int n = 0; n < 2; ++n) acc[a][b][m][n] = (f32x4){0.f, 0.f, 0.f, 0.f};
    bf16x8 At[4][2], B0[2][2], B1[2][2];
    const char* cA = uni_ptr(S.a_base(cur, tstep)); const char* cB = uni_ptr(S.b_base(cur, tstep));
    S.a_ready(cur);
    unsigned gC[2][2] = {{0u, 0u}, {0u, 0u}}, gN[2][2] = {{0u, 0u}, {0u, 0u}};
    if constexpr (GATHER) { PG8_TAB_ISSUE(cur); asm volatile("s_waitcnt vmcnt(0)" ::: "memory"); __builtin_amdgcn_s_barrier(); asm volatile("" ::: "memory"); PG8_TAB_READ(gC); }
    if constexpr (SP2) {
        PG8_STAGE(PG8_SB(0, 0), cB, voffB); PG8_STAGE(PG8_SB(0, 1), cB + hstep, voffB); PG8_STAGE_A(PG8_SA(0, 0), cA, gC, 0); PG8_STAGE_A(PG8_SA(0, 1), cA, gC, 1);
        if (wr == 1) PG8_BAR;
        PG8_WAIT_V(2); PG8_BAR;
        PG8_STAGE(PG8_SB(1, 0), cB + kstep, voffB); PG8_STAGE_A(PG8_SA(1, 0), cA + kstep, gC, 0); PG8_STAGE(PG8_SB(1, 1), cB + hstep + kstep, voffB);
        PG8_WAIT_V(6); PG8_BAR;
    } else {
        PG8_STAGE(PG8_SB(0, 0), cB, voffB); PG8_STAGE(PG8_SA(0, 0), cA, voffA); PG8_STAGE(PG8_SB(0, 1), cB + hstep, voffB); PG8_STAGE(PG8_SA(0, 1), cA + hstep, voffA);
        if (wr == 1) PG8_BAR;
        PG8_WAIT_V(4); PG8_BAR;
        PG8_STAGE(PG8_SB(1, 0), cB + kstep, voffB); PG8_STAGE(PG8_SA(1, 0), cA + kstep, voffA); PG8_STAGE(PG8_SB(1, 1), cB + hstep + kstep, voffB);
        PG8_WAIT_V(6); PG8_BAR;
    }
    for (;;) {
        const bool has_next = S.next(ui + 1, nxt);
        const char* nA = uni_ptr(has_next ? S.a_base(nxt, tstep) : cA); const char* nB = uni_ptr(has_next ? S.b_base(nxt, tstep) : cB);
        for (int t = 0; t < nt; t += 2) {
            const bool last = (t == nt - 2);
            const char* a1 = cA + (size_t)(t + 1) * kstep;
            const char* a2 = last ? nA : cA + (size_t)(t + 2) * kstep; const char* b2 = last ? nB : cB + (size_t)(t + 2) * kstep;
            const char* a3 = a2 + kstep; const char* b3 = b2 + kstep;
            if (last && has_next) S.a_ready(nxt);
            unsigned g2[2][2] = {{gC[0][0], gC[0][1]}, {gC[1][0], gC[1][1]}};
            if constexpr (GATHER) {
                if (t == nt - 4 && has_next) PG8_TAB_ISSUE(nxt);
                if (last && has_next) { PG8_TAB_READ(gN); g2[0][0] = gN[0][0]; g2[0][1] = gN[0][1]; g2[1][0] = gN[1][0]; g2[1][1] = gN[1][1]; }
            }
            if constexpr (SP2) {
            PG8_LDB(B0, 0, 0); PG8_LDB(B1, 0, 1); PG8_SCHED; PG8_LDA(At, 0, 0); PG8_STAGE_A(PG8_SA(1, 1), a1, gC, 1);
            PG8_WAIT_V(8); PG8_WAIT_L(0); PG8_BAR; PG8_MMA(0, 0, At, B0); PG8_MMA(0, 1, At, B1); PG8_BAR; PG8_SCHED;
            PG8_LDA(At, 0, 1); PG8_STAGE(PG8_SB(0, 0), b2, voffB); PG8_STAGE(PG8_SB(0, 1), b2 + hstep, voffB); PG8_STAGE_A(PG8_SA(0, 0), a2, g2, 0);
            PG8_WAIT_V(8); PG8_WAIT_L(0); PG8_BAR; PG8_MMA(1, 0, At, B0); PG8_MMA(1, 1, At, B1); PG8_BAR; PG8_SCHED;
            PG8_LDB(B0, 1, 0); PG8_LDB(B1, 1, 1); PG8_SCHED; PG8_LDA(At, 1, 0); PG8_STAGE_A(PG8_SA(0, 1), a2, g2, 1);
            PG8_WAIT_V(8); PG8_WAIT_L(0); PG8_BAR; PG8_MMA(0, 0, At, B0); PG8_MMA(0, 1, At, B1); PG8_BAR; PG8_SCHED;
            PG8_LDA(At, 1, 1); PG8_STAGE(PG8_SB(1, 0), b3, voffB); PG8_STAGE(PG8_SB(1, 1), b3 + hstep, voffB); PG8_STAGE_A(PG8_SA(1, 0), a3, g2, 0);
            PG8_WAIT_V(8); PG8_WAIT_L(0); PG8_BAR; PG8_MMA(1, 0, At, B0); PG8_MMA(1, 1, At, B1); PG8_BAR; PG8_SCHED;
            } else {
            PG8_LDB(B0, 0, 0); PG8_SCHED; PG8_LDA(At, 0, 0); PG8_STAGE(PG8_SA(1, 1), a1 + hstep, voffA);
            PG8_WAIT_L(8); PG8_BAR; PG8_WAIT_L(0); PG8_MMA(0, 0, At, B0); PG8_BAR; PG8_SCHED;
            PG8_LDB(B1, 0, 1); PG8_STAGE(PG8_SB(0, 0), b2, voffB);
            PG8_BAR; PG8_WAIT_L(0); PG8_MMA(0, 1, At, B1); PG8_BAR;
            PG8_LDA(At, 0, 1); PG8_STAGE(PG8_SA(0, 0), a2, voffA);
            PG8_BAR; PG8_WAIT_L(0); PG8_MMA(1, 0, At, B0); PG8_BAR; PG8_SCHED;
            PG8_STAGE(PG8_SB(0, 1), b2 + hstep, voffB);
            PG8_WAIT_V(6); PG8_BAR; PG8_MMA(1, 1, At, B1); PG8_BAR;
            PG8_LDB(B0, 1, 0); PG8_SCHED; PG8_LDA(At, 1, 0); PG8_STAGE(PG8_SA(0, 1), a2 + hstep, voffA);
            PG8_WAIT_L(8); PG8_BAR; PG8_WAIT_L(0); PG8_MMA(0, 0, At, B0); PG8_BAR; PG8_SCHED;
            PG8_LDB(B1, 1, 1); PG8_STAGE(PG8_SB(1, 0), b3, voffB);
            PG8_BAR; PG8_WAIT_L(0); PG8_MMA(0, 1, At, B1); PG8_BAR;
            PG8_LDA(At, 1, 1); PG8_STAGE(PG8_SA(1, 0), a3, voffA);
            PG8_BAR; PG8_WAIT_L(0); PG8_MMA(1, 0, At, B0); PG8_BAR; PG8_SCHED;
            PG8_STAGE(PG8_SB(1, 1), b3 + hstep, voffB);
            PG8_WAIT_V(6); PG8_BAR; PG8_MMA(1, 1, At, B1); PG8_BAR;
            }
        }
        if constexpr (ALIGN_EPI) { if (wr == 0) PG8_BAR; }
        if constexpr (!Epi::AFTER_DRAIN) { E(acc, cur, wr, wc, fr, fq); S.done(cur); }
        if (!has_next) break;
#pragma unroll
        for (int a = 0; a < 2; ++a)
#pragma unroll
            for (int b = 0; b < 2; ++b)
#pragma unroll
                for (int m = 0; m < 4; ++m)
#pragma unroll
                    for (int n = 0; n < 2; ++n) acc[a][b][m][n] = (f32x4){0.f, 0.f, 0.f, 0.f};
        cur = nxt; cA = nA; cB = nB; ++ui;
        if constexpr (GATHER) { gC[0][0] = gN[0][0]; gC[0][1] = gN[0][1]; gC[1][0] = gN[1][0]; gC[1][1] = gN[1][1]; }
        if constexpr (ALIGN_EPI) { if (wr == 1) PG8_BAR; }
    }
    PG8_WAIT_V(0);
    if constexpr (!ALIGN_EPI) { if (wr == 0) PG8_BAR; }
    PG8_BAR;
    if constexpr (Epi::AFTER_DRAIN) { E.fused(acc, cur, wr, wc, fr, fq, lds, wid, lane); S.done(cur); }
#undef PG8_SA
#undef PG8_SB
#undef PG8_STAGE
#undef PG8_STAGE_G
#undef PG8_STAGE_A
#undef PG8_TAB_ISSUE
#undef PG8_TAB_READ
#undef PG8_LDA
#undef PG8_LDB
#undef PG8_MMA
#undef PG8_WAIT_V
#undef PG8_WAIT_L
#undef PG8_BAR
#undef PG8_SCHED
}
}

constexpr int NWAVES = 8, NTHR = 512;
constexpr int D = 1024, NB = 8, SEQ = 4096, CTXL = 256, NL = 2;
constexpr int NLAT = NB * SEQ;
constexpr int NCTX = NB * CTXL;
constexpr int MT = NLAT + NCTX;
constexpr int INW = 2576, NEXP = 32, TOPK = 4;
constexpr int PMAX = (MT * TOPK / 256 + NEXP) * 256;
constexpr float EPS = 1e-6f;
#ifndef CVT_NUM
#define CVT_NUM 5
#endif
constexpr int CVT_ITEMS = 3 * 32 * 512, CVT_SPLIT = (CVT_ITEMS * CVT_NUM / 8) / 512 * 512;

constexpr size_t MiB = 1u << 20;
constexpr size_t WS_CTL = 0, CTL_ZERO_BYTES = 1 * MiB;
constexpr size_t WS_MODV = 1 * MiB;
constexpr size_t WS_WRT = 2 * MiB;
constexpr size_t WS_WABT = WS_WRT + 512 * 1024;
constexpr size_t WS_SELE = 3 * MiB;
constexpr size_t WS_SELP = WS_SELE + 640 * 1024;
constexpr size_t WS_SELG = WS_SELP + 640 * 1024;
constexpr size_t WS_G = 5 * MiB;
constexpr size_t WS_BETA = WS_G + 1536 * 1024;
constexpr size_t WS_AB = 8 * MiB;
constexpr size_t WS_WIN = 12 * MiB;
constexpr size_t WS_WOUT = 24 * MiB;
constexpr size_t WS_DFTM = 32 * MiB;
constexpr size_t WS_W1 = 96 * MiB;
constexpr size_t WS_W2 = 224 * MiB;
constexpr size_t WS_XC = 288 * MiB;
constexpr size_t WS_ACT = 296 * MiB;
constexpr size_t WS_S = 364 * MiB;
constexpr size_t WS_QKVZ = WS_S;
constexpr size_t WS_ZTL = WS_S + 136 * MiB;
constexpr size_t WS_ZTC = WS_ZTL + 64 * MiB;
constexpr size_t WS_QKVN = WS_ZTC + 4 * MiB;
constexpr size_t WS_OF = WS_QKVN + 102 * MiB;
constexpr size_t WS_OB = WS_OF + 34 * MiB;
constexpr size_t WS_XS = WS_S;
constexpr size_t WS_HS = WS_S + 288 * MiB;
constexpr size_t WS_EO = 984 * MiB;
constexpr size_t WS_AB2 = WS_ZTL;
constexpr size_t WS_ZN = 11 * MiB - 64 * 1024;
constexpr size_t WS_GOFF = 944 * MiB;
constexpr size_t WS_END = 1024 * MiB;
static_assert(WS_OB + 34 * MiB <= WS_END && WS_HS + 288 * MiB <= WS_END && (size_t)PMAX * 1024 * 2 == 288 * MiB, "d_ws map");
static_assert((size_t)MT * 16 <= 640 * 1024 && (size_t)MT * 32 <= 1536 * 1024, "sel / g maps");
constexpr int CW_BAR = 4096;
constexpr int CW_GCNT = 16384;

constexpr int RING_BYTES = 131072;
constexpr int LDSCTL_OFF = RING_BYTES, MISC_OFF = LDSCTL_OFF + 320;
constexpr int XT_OFF = RING_BYTES + 1024;
constexpr int LDS_BYTES = 147456;

#define GAS __attribute__((address_space(1)))
#define LAS __attribute__((address_space(3)))
typedef unsigned short bf16;
typedef unsigned v4u __attribute__((ext_vector_type(4)));
typedef unsigned v2u __attribute__((ext_vector_type(2)));
typedef float f32x4 __attribute__((ext_vector_type(4)));
typedef GAS unsigned gu32;
#define RLX_AGENT __ATOMIC_RELAXED, __HIP_MEMORY_SCOPE_AGENT
#define LDS_WAIT() asm volatile("s_waitcnt lgkmcnt(0)" ::: "memory")
#define VM_WAIT() asm volatile("s_waitcnt vmcnt(0)" ::: "memory")
typedef float f32x2_t __attribute__((ext_vector_type(2))); typedef __bf16 bf16x2_t __attribute__((ext_vector_type(2)));
__device__ __forceinline__ unsigned pk2(float lo, float hi) { const f32x2_t v = {lo, hi}; const bf16x2_t b = __builtin_convertvector(v, bf16x2_t); return __builtin_bit_cast(unsigned, b); }
__device__ __forceinline__ unsigned f2bf(float f) { return pk2(f, 0.f) & 0xffffu; }
__device__ __forceinline__ float bflo(unsigned w) { return __builtin_bit_cast(float, w << 16); }
__device__ __forceinline__ float bfhi(unsigned w) { return __builtin_bit_cast(float, w & 0xffff0000u); }
__device__ __forceinline__ float wave_sum(float v) {
#pragma unroll
    for (int o = 1; o < 64; o <<= 1) v += __shfl_xor(v, o);
    return v;
}
__device__ __forceinline__ float sum16(float v) {
#pragma unroll
    for (int o = 1; o < 16; o <<= 1) v += __shfl_xor(v, o);
    return v;
}
__device__ __forceinline__ float rs32(float (&p)[32], int lane) {
#pragma unroll
    for (int e = 0; e < 16; ++e) { const bool up = (lane & 32) != 0; const float send = up ? p[e] : p[e + 16], keep = up ? p[e + 16] : p[e]; p[e] = keep + __shfl_xor(send, 32); }
#pragma unroll
    for (int e = 0; e < 8; ++e) { const bool up = (lane & 16) != 0; const float send = up ? p[e] : p[e + 8], keep = up ? p[e + 8] : p[e]; p[e] = keep + __shfl_xor(send, 16); }
#pragma unroll
    for (int e = 0; e < 4; ++e) { const bool up = (lane & 8) != 0; const float send = up ? p[e] : p[e + 4], keep = up ? p[e + 4] : p[e]; p[e] = keep + __shfl_xor(send, 8); }
#pragma unroll
    for (int e = 0; e < 2; ++e) { const bool up = (lane & 4) != 0; const float send = up ? p[e] : p[e + 2], keep = up ? p[e + 2] : p[e]; p[e] = keep + __shfl_xor(send, 4); }
    { const bool up = (lane & 2) != 0; const float send = up ? p[0] : p[1], keep = up ? p[1] : p[0]; p[0] = keep + __shfl_xor(send, 2); }
    return p[0] + __shfl_xor(p[0], 1);
}
__device__ __forceinline__ float rs8(float (&p)[8], int lane) {
#pragma unroll
    for (int e = 0; e < 4; ++e) { const bool up = (lane & 32) != 0; const float send = up ? p[e] : p[e + 4], keep = up ? p[e + 4] : p[e]; p[e] = keep + __shfl_xor(send, 32); }
#pragma unroll
    for (int e = 0; e < 2; ++e) { const bool up = (lane & 16) != 0; const float send = up ? p[e] : p[e + 2], keep = up ? p[e + 2] : p[e]; p[e] = keep + __shfl_xor(send, 16); }
    { const bool up = (lane & 8) != 0; const float send = up ? p[0] : p[1], keep = up ? p[1] : p[0]; p[0] = keep + __shfl_xor(send, 8); }
    float r = p[0] + __shfl_xor(p[0], 4); r += __shfl_xor(r, 2);
    return r + __shfl_xor(r, 1);
}
__device__ __forceinline__ float rs16(float (&p)[16], int lane) {
#pragma unroll
    for (int e = 0; e < 8; ++e) { const bool up = (lane & 32) != 0; const float send = up ? p[e] : p[e + 8], keep = up ? p[e + 8] : p[e]; p[e] = keep + __shfl_xor(send, 32); }
#pragma unroll
    for (int e = 0; e < 4; ++e) { const bool up = (lane & 16) != 0; const float send = up ? p[e] : p[e + 4], keep = up ? p[e + 4] : p[e]; p[e] = keep + __shfl_xor(send, 16); }
#pragma unroll
    for (int e = 0; e < 2; ++e) { const bool up = (lane & 8) != 0; const float send = up ? p[e] : p[e + 2], keep = up ? p[e + 2] : p[e]; p[e] = keep + __shfl_xor(send, 8); }
    { const bool up = (lane & 4) != 0; const float send = up ? p[0] : p[1], keep = up ? p[1] : p[0]; p[0] = keep + __shfl_xor(send, 4); }
    float r = p[0] + __shfl_xor(p[0], 2);
    return r + __shfl_xor(r, 1);
}
__device__ __forceinline__ float silu_f(float x) { return x / (1.f + __expf(-x)); }

#define XB_TMO      128
#define XB_XCNT(j)  (256  + 64 * (j))
#define XB_XSUB(j)  (1280 + 64 * (j))
#define XB_XGEN(j)  (2304 + 64 * (j))
#define XB_TOP      3328
#define XB_TOPGEN   3392
#define XCD_BAR_WORDS 3456
#define XB_SPIN_CAP (1u << 18)
__device__ __forceinline__ unsigned xb_ld(unsigned* p)              { return __hip_atomic_load(p, __ATOMIC_RELAXED, __HIP_MEMORY_SCOPE_AGENT); }
__device__ __forceinline__ unsigned xb_add(unsigned* p, unsigned v) { return __hip_atomic_fetch_add(p, v, __ATOMIC_RELAXED, __HIP_MEMORY_SCOPE_AGENT); }
__device__ __forceinline__ unsigned xb_xcc_id() { return (unsigned)__builtin_amdgcn_s_getreg((3 << 11) | 20) & 0xFu; }
#define XB_SPIN(cond, bar) do { unsigned _sp = 0; while (cond) { __builtin_amdgcn_s_sleep(1); \
    if ((++_sp & 255u) == 0u) { if (xb_ld(&(bar)[XB_TMO])) break; if (_sp > XB_SPIN_CAP) { atomicAdd(&(bar)[XB_TMO], 1u); break; } } } } while (0)
struct XcdBarrier { unsigned* bar; unsigned x; volatile LAS unsigned* st; };
__device__ __forceinline__ XcdBarrier xcd_barrier_post(unsigned* bar, volatile LAS unsigned* st, int tid) {
    XcdBarrier b; b.bar = bar; b.x = xb_xcc_id(); b.st = st;
    if (tid == 0) (void)xb_add(&bar[XB_XCNT(b.x)], 1u);
    return b;
}
__device__ __forceinline__ void xcd_barrier_complete(unsigned* bar, unsigned x, unsigned& nloc, unsigned& nx) {
    const unsigned G = gridDim.x * gridDim.y * gridDim.z;
    unsigned sum, cnt, mine, sp = 0u;
    for (;;) {
        sum = 0u; cnt = 0u; mine = 0u;
#pragma unroll
        for (unsigned j = 0; j < 16; ++j) { const unsigned c = xb_ld(&bar[XB_XCNT(j)]); sum += c; cnt += (c > 0u) ? 1u : 0u; mine = (j == x) ? c : mine; }
        if (sum == G) break;
        __builtin_amdgcn_s_sleep(1);
        if ((++sp & 255u) == 0u) { if (xb_ld(&bar[XB_TMO])) break; if (sp > XB_SPIN_CAP) { atomicAdd(&bar[XB_TMO], 1u); break; } }
    }
    nloc = mine > 0u ? mine : 1u; nx = cnt > 0u ? cnt : 1u;
}
__device__ __forceinline__ void xcd_barrier(const XcdBarrier& b, int tid) {
    asm volatile("s_waitcnt vmcnt(0)" ::: "memory");
    __syncthreads();
    if (tid == 0) {
        unsigned* bar = b.bar; unsigned bx = b.x;
        asm volatile("" : "+v"(bar), "+v"(bx));
        __builtin_amdgcn_s_waitcnt(0);
        unsigned nloc = b.st[0], nx = b.st[1];
        if (nloc == 0u) { xcd_barrier_complete(bar, bx, nloc, nx); b.st[0] = nloc; b.st[1] = nx; }
        const unsigned old = xb_add(&bar[XB_XSUB(bx)], 1u);
        const unsigned gen = old / nloc;
        if (old + 1u == (gen + 1u) * nloc) {
            __builtin_amdgcn_fence(__ATOMIC_RELEASE, "agent");
            asm volatile("s_waitcnt vmcnt(0)" ::: "memory");
            const unsigned og = xb_add(&bar[XB_TOP], 1u);
            const unsigned tg = og / nx;
            if (og + 1u == (tg + 1u) * nx) xb_add(&bar[XB_TOPGEN], 1u);
            else XB_SPIN(xb_ld(&bar[XB_TOPGEN]) == tg, bar);
            __builtin_amdgcn_fence(__ATOMIC_ACQUIRE, "agent");
            xb_add(&bar[XB_XGEN(bx)], 1u);
            asm volatile("s_waitcnt vmcnt(0)" ::: "memory");
        } else {
            XB_SPIN(xb_ld(&bar[XB_XGEN(bx)]) == gen, bar);
            __builtin_amdgcn_fence(__ATOMIC_ACQUIRE, "agent");
            asm volatile("s_waitcnt vmcnt(0)" ::: "memory");
        }
    }
    __syncthreads();
}

struct Args { const float* in[23]; float* out; unsigned char* ws; int ph_lo, ph_hi; };
struct Frame {
    LAS unsigned char* lds;
    volatile LAS unsigned* MISC;
    unsigned* ctl;
    unsigned char* ws;
    int tid, lane, wave, vcu, G, gw, NGW;
    float* out;
};
typedef const Args __attribute__((address_space(4)))* KArgsP;
__device__ __forceinline__ KArgsP kargs() { unsigned long long v = (unsigned long long)__builtin_amdgcn_kernarg_segment_ptr(); asm volatile("" : "+s"(v)); return (KArgsP)v; }
enum InIdx { I_X = 0, I_C, I_CTX, I_CCTX, I_WMOD, I_BMOD, I_GN1, I_WIN, I_CONVW, I_ALOG, I_DTB, I_GOUT, I_WOUT, I_GN2, I_WR, I_BR, I_WG, I_BG, I_WU, I_BU, I_WD, I_BD, I_GF };
__device__ __forceinline__ float* xr_row(const Frame& F, int t) { return t < NLAT ? F.out + (size_t)t * D : (float*)(F.ws + WS_XC) + (size_t)(t - NLAT) * D; }
__device__ __forceinline__ int mod_row(int t) { return t < NLAT ? (t >> 12) : 8; }
__device__ __forceinline__ const float* modv(const Frame& F, int l, int r, int piece) { return (const float*)(F.ws + WS_MODV) + ((size_t)(l * 9 + r) * 6 + piece) * D; }

struct SchedIn {
    const bf16* hx; const bf16* win; int G, c;
    static constexpr int N0 = (MT / 256) * 8, N1 = 4 * (MT / 256), NWG = N0 + N1;
    __device__ __forceinline__ bool next(int i, pg8::Unit& u) const {
        const long L = (long)i * G + c; if (L >= NWG) return false;
        int w = pg8::xcd_remap((int)L, NWG);
        if (w < N0) { u.kind = 0; pg8::grp_decode(w, MT / 256, 8, u.pm, u.pn); } else { w -= N0; u.kind = 1; u.pn = w >> 2; u.pm = w & 3; }
        u.e = 0; return true;
    }
    __device__ __forceinline__ const char* a_base(const pg8::Unit& u, size_t tstep) const { return u.kind == 0 ? (const char*)hx + (size_t)u.pm * tstep : (const char*)win + (size_t)(8 + u.pm) * tstep; }
    __device__ __forceinline__ const char* b_base(const pg8::Unit& u, size_t tstep) const { return u.kind == 0 ? (const char*)win + (size_t)u.pn * tstep : (const char*)hx + (size_t)u.pn * tstep; }
    __device__ __forceinline__ void a_ready(const pg8::Unit&) const {}
    __device__ __forceinline__ void done(const pg8::Unit&) const {}
};
struct EpiIn {
    static constexpr bool PERM = true, AFTER_DRAIN = false;
    bf16* qkvz; bf16* ztl; bf16* ztc;
    __device__ __forceinline__ void operator()(const pg8::f32x4 (&acc)[2][2][4][2], const pg8::Unit& u, int wr, int wc, int fr_, int fq_) const {
        int fr = fr_, fq = fq_; asm volatile("" : "+v"(fr), "+v"(fq));
        const int row0 = u.pm * 256 + wr * 64 + fr, cin = wc * 32 + 8 * fq;
        bf16* base; size_t ldc;
        if (u.kind == 0) { base = qkvz + (size_t)u.pn * 256 + cin; ldc = 2048; }
        else if (u.pn < 128) { base = ztl + (size_t)(u.pn >> 4) * 1024 * 4096 + (size_t)(u.pn & 15) * 256 + cin; ldc = 4096; }
        else { base = ztc + (size_t)(u.pn - 128) * 1024 * 256 + cin; ldc = 256; }
#pragma unroll
        for (int ai = 0; ai < 2; ++ai)
#pragma unroll
            for (int m = 0; m < 4; ++m) { bf16* rowp = base + (size_t)(row0 + ai * 128 + m * 16) * ldc;
#pragma unroll
                for (int bj = 0; bj < 2; ++bj) { const pg8::f32x4 v0 = acc[ai][bj][m][0], v1 = acc[ai][bj][m][1]; pg8::u32x4 w;
                    w.x = pg8::cvt_pk_bf16(v0[0], v0[1]); w.y = pg8::cvt_pk_bf16(v0[2], v0[3]); w.z = pg8::cvt_pk_bf16(v1[0], v1[1]); w.w = pg8::cvt_pk_bf16(v1[2], v1[3]);
                    *(pg8::u32x4*)(rowp + bj * 128) = w; } }
    }
};
struct SchedDft {
    const bf16* dftm; const bf16* eo; int v;
    __device__ __forceinline__ bool next(int i, pg8::Unit& u) const {
        if (i >= 2 || v < 0) return false;
        const int w = (v >> 5) * 64 + i * 32 + (v & 31), x = w >> 5, j = w & 31;
        u.kind = x & 1; u.pm = 4 * ((x >> 1) & 1) + (j & 3); u.e = 4 * (x >> 2) + ((j >> 2) & 3); u.pn = j >> 4; return true;
    }
    __device__ __forceinline__ const char* a_base(const pg8::Unit& u, size_t tstep) const { return (const char*)dftm + (size_t)u.kind * (2048 * 2048 * 2) + (size_t)u.pm * tstep; }
    __device__ __forceinline__ const char* b_base(const pg8::Unit& u, size_t tstep) const { return (const char*)eo + (size_t)(u.e * 2 + u.kind) * (512 * 2048 * 2) + (size_t)u.pn * tstep; }
    __device__ __forceinline__ void a_ready(const pg8::Unit&) const {}
    __device__ __forceinline__ void done(const pg8::Unit&) const {}
};
struct EpiDft {
    static constexpr bool PERM = true, AFTER_DRAIN = false;
    bf16* ab2;
    __device__ __forceinline__ void operator()(const pg8::f32x4 (&acc)[2][2][4][2], const pg8::Unit& u, int wr, int wc, int fr_, int fq_) const {
        int fr = fr_, fq = fq_; asm volatile("" : "+v"(fr), "+v"(fq));
        const int row0 = u.pm * 256 + wr * 64 + fr, col0 = u.pn * 256 + wc * 32 + 8 * fq;
        bf16* base = ab2 + (size_t)(u.e * 2 + u.kind) * 2048 * 512;
#pragma unroll
        for (int ai = 0; ai < 2; ++ai)
#pragma unroll
            for (int m = 0; m < 4; ++m) { bf16* rowp = base + (size_t)(row0 + ai * 128 + m * 16) * 512 + col0;
#pragma unroll
                for (int bj = 0; bj < 2; ++bj) { const pg8::f32x4 v0 = acc[ai][bj][m][0], v1 = acc[ai][bj][m][1]; pg8::u32x4 w;
                    w.x = pg8::cvt_pk_bf16(v0[0], v0[1]); w.y = pg8::cvt_pk_bf16(v0[2], v0[3]); w.z = pg8::cvt_pk_bf16(v1[0], v1[1]); w.w = pg8::cvt_pk_bf16(v1[2], v1[3]);
                    *(pg8::u32x4*)(rowp + bj * 128) = w; } }
    }
};
struct SchedOut {
    const bf16* mix; const bf16* wout; int nM, G, c;
    __device__ __forceinline__ bool next(int i, pg8::Unit& u) const {
        const int nwg = nM * 4; const long L = (long)i * G + c; if (L >= nwg) return false;
        pg8::grp_decode(pg8::xcd_remap((int)L, nwg), nM, 4, u.pm, u.pn); u.kind = 0; u.e = 0; return true;
    }
    __device__ __forceinline__ const char* a_base(const pg8::Unit& u, size_t tstep) const { return (const char*)mix + (size_t)u.pm * tstep; }
    __device__ __forceinline__ const char* b_base(const pg8::Unit& u, size_t tstep) const { return (const char*)wout + (size_t)u.pn * tstep; }
    __device__ __forceinline__ void a_ready(const pg8::Unit&) const {}
    __device__ __forceinline__ void done(const pg8::Unit&) const {}
};
struct EpiOut {
    static constexpr bool PERM = false, AFTER_DRAIN = false;
    float* xlat; float* xctx; const float* rlat; const float* rctx; const float* gt1; float dsc;
    __device__ __forceinline__ void operator()(const pg8::f32x4 (&acc)[2][2][4][2], const pg8::Unit& u, int wr, int wc, int fr_, int fq_) const {
        int fr = fr_, fq = fq_; asm volatile("" : "+v"(fr), "+v"(fq));
        const int col0 = u.pn * 256 + wc * 32 + 4 * fq, rl = wr * 64 + fr;
        float* xb = u.pm < 128 ? xlat + (size_t)u.pm * 256 * D : xctx + (size_t)(u.pm - 128) * 256 * D;
        const float* rb = u.pm < 128 ? rlat + (size_t)u.pm * 256 * D : rctx + (size_t)(u.pm - 128) * 256 * D;
        const float* g = gt1 + (size_t)(u.pm < 128 ? (u.pm >> 4) : 8) * 6 * D + col0;
        pg8::f32x4 gv[2][2];
#pragma unroll
        for (int bj = 0; bj < 2; ++bj)
#pragma unroll
            for (int n = 0; n < 2; ++n) gv[bj][n] = *(const pg8::f32x4*)(g + bj * 128 + n * 16);
#pragma unroll
        for (int ai = 0; ai < 2; ++ai)
#pragma unroll
            for (int m = 0; m < 4; ++m) { float* rowp = xb + (size_t)(rl + ai * 128 + m * 16) * D + col0; const float* rrow = rb + (size_t)(rl + ai * 128 + m * 16) * D + col0;
#pragma unroll
                for (int bj = 0; bj < 2; ++bj)
#pragma unroll
                    for (int n = 0; n < 2; ++n) { pg8::f32x4* p = (pg8::f32x4*)(rowp + bj * 128 + n * 16); const pg8::f32x4 xo = *(const pg8::f32x4*)(rrow + bj * 128 + n * 16); *p = xo + gv[bj][n] * acc[ai][bj][m][n] * dsc; }
                if (m & 1) asm volatile("" ::: "memory"); }
    }
};
struct SchedMoe {
    const bf16* A; const bf16* W; size_t wstride; const LAS int* pend; int nM, nN, G, c, gather;
    __device__ __forceinline__ bool next(int i, pg8::Unit& u) const {
        const int nwg = nM * nN; const long L = (long)i * G + c; if (L >= nwg) return false;
        pg8::grp_decode(pg8::xcd_remap((int)L, nwg), nM, nN, u.pm, u.pn);
        int e = 0;
#pragma unroll 1
        for (int j = 0; j < NEXP - 1; ++j) e += (pend[j] <= u.pm) ? 1 : 0;
        u.e = e; u.kind = 0; return true;
    }
    __device__ __forceinline__ const char* a_base(const pg8::Unit& u, size_t tstep) const { return gather ? (const char*)A : (const char*)A + (size_t)u.pm * tstep; }
    __device__ __forceinline__ const char* b_base(const pg8::Unit& u, size_t tstep) const { return (const char*)W + (size_t)u.e * wstride + (size_t)u.pn * tstep; }
    __device__ __forceinline__ void a_ready(const pg8::Unit&) const {}
    __device__ __forceinline__ void done(const pg8::Unit&) const {}
};
struct EpiSwiglu {
    static constexpr bool PERM = true, AFTER_DRAIN = false;
    bf16* hs; const float* bg; const float* bu;
    __device__ __forceinline__ void operator()(const pg8::f32x4 (&acc)[2][2][4][2], const pg8::Unit& u, int wr, int wc, int fr_, int fq_) const {
        int fr = fr_, fq = fq_; asm volatile("" : "+v"(fr), "+v"(fq));
        const int row0 = u.pm * 256 + wr * 64 + fr, f0 = u.pn * 128 + wc * 32 + 8 * fq;
        const pg8::f32x4 bg0 = *(const pg8::f32x4*)(bg + u.e * D + f0), bg1 = *(const pg8::f32x4*)(bg + u.e * D + f0 + 4);
        const pg8::f32x4 bu0 = *(const pg8::f32x4*)(bu + u.e * D + f0), bu1 = *(const pg8::f32x4*)(bu + u.e * D + f0 + 4);
#pragma unroll
        for (int ai = 0; ai < 2; ++ai)
#pragma unroll
            for (int m = 0; m < 4; ++m) {
                float h[8];
#pragma unroll
                for (int n = 0; n < 2; ++n) { const pg8::f32x4 ga = acc[ai][0][m][n] + (n ? bg1 : bg0), ua = acc[ai][1][m][n] + (n ? bu1 : bu0);
#pragma unroll
                    for (int j = 0; j < 4; ++j) { const float a = fminf(ga[j], 7.0f), uu = fminf(fmaxf(ua[j], -7.0f), 7.0f);
                        h[n * 4 + j] = a * __builtin_amdgcn_rcpf(1.0f + __expf(-1.702f * a)) * (uu + 1.0f); } }
                pg8::u32x4 w; w.x = pg8::cvt_pk_bf16(h[0], h[1]); w.y = pg8::cvt_pk_bf16(h[2], h[3]); w.z = pg8::cvt_pk_bf16(h[4], h[5]); w.w = pg8::cvt_pk_bf16(h[6], h[7]);
                *(pg8::u32x4*)(hs + (size_t)(row0 + ai * 128 + m * 16) * D + f0) = w; }
    }
};
struct EpiDown {
    static constexpr bool PERM = true, AFTER_DRAIN = false;
    bf16* ys; const float* bd;
    __device__ __forceinline__ void operator()(const pg8::f32x4 (&acc)[2][2][4][2], const pg8::Unit& u, int wr, int wc, int fr_, int fq_) const {
        int fr = fr_, fq = fq_; asm volatile("" : "+v"(fr), "+v"(fq));
        const int row0 = u.pm * 256 + wr * 64 + fr, col0 = u.pn * 256 + wc * 32 + 8 * fq;
        pg8::f32x4 bv[2][2];
#pragma unroll
        for (int bj = 0; bj < 2; ++bj)
#pragma unroll
            for (int n = 0; n < 2; ++n) bv[bj][n] = *(const pg8::f32x4*)(bd + u.e * D + col0 + bj * 128 + 4 * n);
#pragma unroll
        for (int ai = 0; ai < 2; ++ai)
#pragma unroll
            for (int m = 0; m < 4; ++m) { bf16* rowp = ys + (size_t)(row0 + ai * 128 + m * 16) * D + col0;
#pragma unroll
                for (int bj = 0; bj < 2; ++bj) { const pg8::f32x4 v0 = acc[ai][bj][m][0] + bv[bj][0], v1 = acc[ai][bj][m][1] + bv[bj][1]; pg8::u32x4 w;
                    w.x = pg8::cvt_pk_bf16(v0[0], v0[1]); w.y = pg8::cvt_pk_bf16(v0[2], v0[3]); w.z = pg8::cvt_pk_bf16(v1[0], v1[1]); w.w = pg8::cvt_pk_bf16(v1[2], v1[3]);
                    *(pg8::u32x4*)(rowp + bj * 128) = w; } }
    }
};

__device__ __forceinline__ void transpose_item(const float* W, int ldw, int col0, int K, bf16* WT, int drow0, LAS float* scr, int kb, int lane) {
    const int k0 = 64 * kb;
#pragma unroll 8
    for (int i = 0; i < 32; ++i) { const int kk = 2 * i + (lane >> 5); scr[kk * 33 + (lane & 31)] = W[(size_t)(k0 + kk) * ldw + col0 + (lane & 31)]; }
    LDS_WAIT(); asm volatile("" ::: "memory");
    const int c = lane & 7;
#pragma unroll
    for (int j = 0; j < 4; ++j) { const int n = (lane >> 3) + 8 * j; const LAS float* s = scr + (8 * c) * 33 + n;
        v4u o; o.x = pk2(s[0 * 33], s[1 * 33]); o.y = pk2(s[2 * 33], s[3 * 33]); o.z = pk2(s[4 * 33], s[5 * 33]); o.w = pk2(s[6 * 33], s[7 * 33]);
        *(v4u*)(WT + (size_t)(drow0 + n) * K + k0 + 8 * c) = o; }
    LDS_WAIT(); asm volatile("" ::: "memory");
}
__device__ __forceinline__ void convert_experts(const Frame& F, int l, int lo, int hi, int wi, int nw) {
    const KArgsP A = kargs();
    LAS float* scr = (LAS float*)(F.lds + F.wave * 16384);
    bf16* W1 = (bf16*)(F.ws + WS_W1); bf16* W2 = (bf16*)(F.ws + WS_W2);
    constexpr int IPM = 16 * 32;
    for (int it = lo + wi; it < hi; it += nw) {
        const int which = it / (NEXP * IPM), r = it % (NEXP * IPM), e = r / IPM, q = r % IPM, kb = q >> 5, nb = q & 31;
        const size_t moff = ((size_t)l * NEXP + e) * D * D;
        if (which == 0) transpose_item(A->in[I_WG] + moff, D, nb * 32, D, W1 + (size_t)e * 2048 * D, 256 * (nb >> 2) + 32 * (nb & 3), scr, kb, F.lane);
        else if (which == 1) transpose_item(A->in[I_WU] + moff, D, nb * 32, D, W1 + (size_t)e * 2048 * D, 256 * (nb >> 2) + 128 + 32 * (nb & 3), scr, kb, F.lane);
        else transpose_item(A->in[I_WD] + moff, D, nb * 32, D, W2 + (size_t)e * D * D, nb * 32, scr, kb, F.lane);
    }
}
__device__ __forceinline__ void p0_prologue(const Frame& F) {
    const KArgsP A = kargs();
    float* mv = (float*)(F.ws + WS_MODV);
    {
        LAS float* sc = (LAS float*)F.lds;
        LAS float* red = sc + 9 * 1024;
        for (int i = F.tid; i < 9 * 1024; i += NTHR) { const int r = i >> 10, k = i & 1023; sc[i] = silu_f(r < 8 ? A->in[I_C][r * D + k] : A->in[I_CCTX][k]); }
        __syncthreads();
        for (int item = blockIdx.x; item < 192; item += F.G) {
            const int l = item / 96, cg = item % 96, cl = F.tid & 63, ks = F.tid >> 6;
            const float* w = A->in[I_WMOD] + ((size_t)l * D + ks * 128) * 6144 + cg * 64 + cl;
            float a[9];
#pragma unroll
            for (int r = 0; r < 9; ++r) a[r] = 0.f;
#pragma unroll 4
            for (int k = 0; k < 128; ++k) { const float wv = w[(size_t)k * 6144];
#pragma unroll
                for (int r = 0; r < 9; ++r) a[r] += sc[r * 1024 + ks * 128 + k] * wv; }
#pragma unroll
            for (int r = 0; r < 9; ++r) red[(ks * 9 + r) * 64 + cl] = a[r];
            __syncthreads();
            for (int i = F.tid; i < 9 * 64; i += NTHR) { const int r = i >> 6, cc = i & 63; float s = 0.f;
#pragma unroll
                for (int k2 = 0; k2 < 8; ++k2) s += red[(k2 * 9 + r) * 64 + cc];
                mv[(size_t)(l * 9 + r) * 6144 + cg * 64 + cc] = s + A->in[I_BMOD][l * 6144 + cg * 64 + cc]; }
            __syncthreads();
        }
    }
    {
        LAS float* T = (LAS float*)F.lds;
        LAS float* cs = T + 64 * 129; LAS float* sn = cs + 128;
        __syncthreads();
        if (F.tid < 128) { cs[F.tid] = cospif((float)F.tid * (1.0f / 64.0f)); sn[F.tid] = sinpif((float)F.tid * (1.0f / 64.0f)); }
        for (int item = (blockIdx.x + 64) % F.G; item < 128; item += F.G) {
            const int l = item >> 6, kg = (item & 63) >> 2, g = item & 3;
            __syncthreads();
            for (int i = F.tid; i < 64 * 128; i += NTHR) { const int kk = i >> 7, cc = i & 127; T[kk * 129 + cc] = A->in[I_WIN][((size_t)l * D + kg * 64 + kk) * INW + g * 128 + cc]; }
            __syncthreads();
            const int kk = F.tid & 63, ng = F.tid >> 6;
            bf16* dst = (bf16*)(F.ws + WS_WIN) + ((size_t)l * 3072 + 2048 + g * 256) * D + kg * 64 + kk;
#pragma unroll 1
            for (int nn = 0; nn < 32; ++nn) { const int np = ng * 32 + nn, cp = np >> 1; float s = 0.f;
                if (np & 1) {
#pragma unroll 8
                    for (int cc = 0; cc < 128; ++cc) s -= T[kk * 129 + cc] * sn[(cc * cp) & 127]; }
                else {
#pragma unroll 8
                    for (int cc = 0; cc < 128; ++cc) s += T[kk * 129 + cc] * cs[(cc * cp) & 127]; }
                dst[(size_t)np * D] = (bf16)f2bf(s); }
        }
        __syncthreads();
    }
    {
        LAS float* scr = (LAS float*)(F.lds + F.wave * 16384);
        constexpr int I_IN = 16 * 64, I_OUT = 16 * 32;
        for (int it = F.gw; it < NL * (I_IN + I_OUT); it += F.NGW) {
            const int l = it / (I_IN + I_OUT), r = it % (I_IN + I_OUT);
            if (r < I_IN) transpose_item(A->in[I_WIN] + (size_t)l * D * INW, INW, 512 + 32 * (r & 63), D, (bf16*)(F.ws + WS_WIN) + (size_t)l * 3072 * D, 32 * (r & 63), scr, r >> 6, F.lane);
            else { const int q = r - I_IN; transpose_item(A->in[I_WOUT] + (size_t)l * D * D, D, 32 * (q & 31), D, (bf16*)(F.ws + WS_WOUT) + (size_t)l * D * D, 32 * (q & 31), scr, q >> 5, F.lane); }
        }
    }
    convert_experts(F, 0, 0, CVT_SPLIT, F.gw, F.NGW);
    {
        const int gt = F.gw * 64 + F.lane, NT = F.NGW * 64;
        float* wrt = (float*)(F.ws + WS_WRT); float* wabt = (float*)(F.ws + WS_WABT);
        for (int i = gt; i < NL * NEXP * D; i += NT) { const int l = i >> 15, e = (i >> 10) & 31, c = i & 1023; wrt[i] = A->in[I_WR][((size_t)l * D + c) * NEXP + e]; }
        for (int i = gt; i < NL * 16 * D; i += NT) { const int l = i >> 14, j = (i >> 10) & 15, c = i & 1023; wabt[i] = A->in[I_WIN][((size_t)l * D + c) * INW + 2560 + j]; }
        bf16* dm = (bf16*)(F.ws + WS_DFTM);
        for (int i = gt; i < 2 * 2048 * 256; i += NT) { const int mat = i >> 19, kf = (i >> 8) & 2047, j0 = (i & 255) * 8; float v[8];
#pragma unroll
            for (int jj = 0; jj < 8; ++jj) { const float a = (float)((kf * (j0 + jj)) & 4095) * (1.0f / 2048.0f); v[jj] = mat ? sinpif(a) : cospif(a); }
            v4u o; o.x = pk2(v[0], v[1]); o.y = pk2(v[2], v[3]); o.z = pk2(v[4], v[5]); o.w = pk2(v[6], v[7]);
            *(v4u*)(dm + (size_t)i * 8) = o; }
    }
}

template <int MODE>
__device__ __forceinline__ void row_pass(const Frame& F, int l_cur, int l_nxt, bool dummy = false) {
    const KArgsP A = kargs();
    LAS float* wl = (LAS float*)F.lds;
    if (MODE != 2) { const f32x4* src = (const f32x4*)((const float*)(F.ws + WS_WABT) + (size_t)l_nxt * 16 * D);
        for (int i = F.tid; i < 16 * D / 4; i += NTHR) ((LAS f32x4*)wl)[i] = src[i];
        __syncthreads(); }
    const int nrows = MODE == 2 ? NLAT : MT;
    const int* selp = (const int*)(F.ws + WS_SELP); const float* selg = (const float*)(F.ws + WS_SELG);
    const bf16* ys = (const bf16*)(F.ws + WS_XS);
    bf16* hx = (bf16*)(F.ws + WS_ACT); float* ab = (float*)(F.ws + WS_AB);
    f32x4 xc[4]; int dc[4]; float gc[4]; v2u yc[4][4];
    int t = F.gw;
    if (t < nrows) {
        const float* xin = MODE == 0 ? (t < NLAT ? A->in[I_X] + (size_t)t * D : A->in[I_CTX] + (size_t)(t - NLAT) * D) : xr_row(F, t);
#pragma unroll
        for (int j = 0; j < 4; ++j) xc[j] = *((const f32x4*)xin + F.lane + 64 * j);
        if (MODE != 0) {
#pragma unroll
            for (int k = 0; k < 4; ++k) { dc[k] = selp[t * 4 + k]; gc[k] = selg[t * 4 + k]; }
#pragma unroll
            for (int k = 0; k < 4; ++k) { const v2u* yr = (const v2u*)(ys + (size_t)dc[k] * D) + F.lane;
#pragma unroll
                for (int j = 0; j < 4; ++j) yc[k][j] = yr[64 * j]; } }
    }
    for (; t < nrows; t += F.NGW) {
        const int tn = t + F.NGW < nrows ? t + F.NGW : t;
        f32x4 xn[4]; int dn[4]; float gn[4];
        { const float* xin = MODE == 0 ? (tn < NLAT ? A->in[I_X] + (size_t)tn * D : A->in[I_CTX] + (size_t)(tn - NLAT) * D) : xr_row(F, tn);
#pragma unroll
          for (int j = 0; j < 4; ++j) xn[j] = *((const f32x4*)xin + F.lane + 64 * j);
          if (MODE != 0) {
#pragma unroll
              for (int k = 0; k < 4; ++k) { dn[k] = selp[tn * 4 + k]; gn[k] = selg[tn * 4 + k]; } } }
        const int r = mod_row(t);
        f32x4 v[4];
#pragma unroll
        for (int j = 0; j < 4; ++j) v[j] = xc[j];
        float* xr = xr_row(F, t);
        if (MODE != 0) {
            f32x4 y[4];
#pragma unroll
            for (int j = 0; j < 4; ++j) y[j] = (f32x4){0.f, 0.f, 0.f, 0.f};
#pragma unroll
            for (int k = 0; k < 4; ++k)
#pragma unroll
                for (int j = 0; j < 4; ++j) { const v2u w = yc[k][j]; y[j] += gc[k] * (f32x4){bflo(w.x), bfhi(w.x), bflo(w.y), bfhi(w.y)}; }
            const f32x4* g2 = (const f32x4*)modv(F, l_cur, r, 5) + F.lane;
#pragma unroll
            for (int j = 0; j < 4; ++j) v[j] += g2[64 * j] * y[j];
#pragma unroll
            for (int k = 0; k < 4; ++k) { const v2u* yr = (const v2u*)(ys + (size_t)dn[k] * D) + F.lane;
#pragma unroll
                for (int j = 0; j < 4; ++j) yc[k][j] = yr[64 * j]; }
        }
        if (MODE == 1 && !dummy) {
#pragma unroll
            for (int j = 0; j < 4; ++j) *((f32x4*)xr + F.lane + 64 * j) = v[j];
        }
        float ss = 0.f;
#pragma unroll
        for (int j = 0; j < 4; ++j) ss += (v[j].x * v[j].x + v[j].y * v[j].y) + (v[j].z * v[j].z + v[j].w * v[j].w);
        const float rstd = 1.0f / sqrtf(wave_sum(ss) * (1.0f / D) + EPS);
        if (MODE == 2) {
            const f32x4* gf = (const f32x4*)A->in[I_GF] + F.lane;
#pragma unroll
            for (int j = 0; j < 4; ++j) *((f32x4*)(F.out + (size_t)t * D) + F.lane + 64 * j) = v[j] * rstd * gf[64 * j];
        } else {
            const f32x4* g1 = (const f32x4*)(A->in[I_GN1] + (size_t)l_nxt * D) + F.lane;
            const f32x4* sh = (const f32x4*)modv(F, l_nxt, r, 0) + F.lane; const f32x4* scl = (const f32x4*)modv(F, l_nxt, r, 1) + F.lane;
            v2u* ho = (v2u*)(hx + (size_t)t * D) + F.lane;
#pragma unroll
            for (int j = 0; j < 4; ++j) { v[j] = v[j] * rstd * g1[64 * j] * (scl[64 * j] + 1.0f) + sh[64 * j]; v2u w; w.x = pk2(v[j].x, v[j].y); w.y = pk2(v[j].z, v[j].w); ho[64 * j] = w; }
            float pp[16];
            int lofs = F.lane; asm volatile("" : "+v"(lofs));
#pragma unroll
            for (int jj = 0; jj < 16; ++jj) { float p = 0.f;
#pragma unroll
                for (int j = 0; j < 4; ++j) { const f32x4 w = ((const LAS f32x4*)(wl + jj * D))[lofs + 64 * j]; p += (v[j].x * w.x + v[j].y * w.y) + (v[j].z * w.z + v[j].w * w.w); }
                pp[jj] = p; if ((jj & 3) == 3) asm volatile("" ::: "memory"); }
            const float mine = rs16(pp, F.lane);
            if ((F.lane & 3) == 0) ab[(size_t)t * 16 + (F.lane >> 2)] = mine;
        }
#pragma unroll
        for (int j = 0; j < 4; ++j) xc[j] = xn[j];
        if (MODE != 0) {
#pragma unroll
            for (int k = 0; k < 4; ++k) { dc[k] = dn[k]; gc[k] = gn[k]; } }
    }
}

__device__ __forceinline__ int seq_id(int x) { return x < 0 ? -1 : (x < NLAT ? (x >> 12) : (x < MT ? 8 + ((x - NLAT) >> 8) : -2)); }
__device__ __forceinline__ void conv_phase(const Frame& F, int l) {
    const KArgsP A = kargs();
    LAS float* cw = (LAS float*)F.lds;
    for (int i = F.tid; i < 5 * 1536; i += NTHR) cw[i] = A->in[I_CONVW][(size_t)l * 5 * 1536 + i];
    __syncthreads();
    const bf16* qkvz = (const bf16*)(F.ws + WS_QKVZ); bf16* qkvn = (bf16*)(F.ws + WS_QKVN);
    const float* ab = (const float*)(F.ws + WS_AB); float* gb = (float*)(F.ws + WS_G); float* bb = (float*)(F.ws + WS_BETA);
    constexpr int RUN = MT / (256 * NWAVES);
    static_assert(RUN * 256 * NWAVES == MT, "conv runs");
    for (int run = F.gw; run < MT / RUN; run += F.NGW) {
        const int t0 = run * RUN;
        v4u W[5][3];
#pragma unroll
        for (int k = 0; k < 5; ++k) { const int g = t0 + k - 2, gc = g < 0 ? 0 : (g >= MT ? MT - 1 : g);
#pragma unroll
            for (int q = 0; q < 3; ++q) W[k][q] = *(const v4u*)(qkvz + (size_t)gc * 2048 + q * 512 + 8 * F.lane); }
#pragma unroll 1
        for (int t = t0; t < t0 + RUN; ++t) {
            v4u N[3];
            { const int g = t + 3, gc = g >= MT ? MT - 1 : g;
#pragma unroll
              for (int q = 0; q < 3; ++q) N[q] = *(const v4u*)(qkvz + (size_t)gc * 2048 + q * 512 + 8 * F.lane); }
            const int sid = seq_id(t);
            float a[3][8];
#pragma unroll
            for (int q = 0; q < 3; ++q)
#pragma unroll
                for (int i = 0; i < 8; ++i) a[q][i] = 0.f;
#pragma unroll
            for (int tap = 0; tap < 5; ++tap) { const float vm = (seq_id(t + tap - 2) == sid) ? 1.0f : 0.0f;
#pragma unroll
                for (int q = 0; q < 3; ++q) { const v4u u = W[tap][q];
                    const LAS f32x4* wp = (const LAS f32x4*)(cw + tap * 1536 + q * 512 + 8 * F.lane); const f32x4 w0 = wp[0] * vm, w1 = wp[1] * vm;
                    a[q][0] += bflo(u.x) * w0.x; a[q][1] += bfhi(u.x) * w0.y; a[q][2] += bflo(u.y) * w0.z; a[q][3] += bfhi(u.y) * w0.w;
                    a[q][4] += bflo(u.z) * w1.x; a[q][5] += bfhi(u.z) * w1.y; a[q][6] += bflo(u.w) * w1.z; a[q][7] += bfhi(u.w) * w1.w; } }
#pragma unroll
            for (int q = 0; q < 3; ++q) { float ss = 0.f;
#pragma unroll
                for (int i = 0; i < 8; ++i) { a[q][i] = silu_f(a[q][i]); ss += a[q][i] * a[q][i]; }
                float sc = 1.0f;
                if (q < 2) { ss = sum16(ss); sc = (1.0f / sqrtf(ss + EPS)) * (q == 0 ? 0.08838834764831845f : 1.0f); }
                v4u o; o.x = pk2(a[q][0] * sc, a[q][1] * sc); o.y = pk2(a[q][2] * sc, a[q][3] * sc); o.z = pk2(a[q][4] * sc, a[q][5] * sc); o.w = pk2(a[q][6] * sc, a[q][7] * sc);
                *(v4u*)(qkvn + (size_t)t * 1536 + q * 512 + 8 * F.lane) = o; }
            if (F.lane < 8) { const int d = F.lane >> 2, h = F.lane & 3;
                const float xg = ab[(size_t)t * 16 + d * 8 + h] + A->in[I_DTB][l * 8 + d * 4 + h];
                const float sp = xg > 20.f ? xg : log1pf(expf(xg));
                gb[(size_t)t * 8 + F.lane] = -expf(A->in[I_ALOG][l * 8 + d * 4 + h]) * sp;
                bb[(size_t)t * 8 + F.lane] = 1.0f / (1.0f + expf(-ab[(size_t)t * 16 + d * 8 + 4 + h])); }
#pragma unroll
            for (int q = 0; q < 3; ++q) { W[0][q] = W[1][q]; W[1][q] = W[2][q]; W[2][q] = W[3][q]; W[3][q] = W[4][q]; W[4][q] = N[q]; }
        }
    }
}

__device__ __forceinline__ void fold_phase(const Frame& F) {
    const bf16* ztl = (const bf16*)(F.ws + WS_ZTL); bf16* eo = (bf16*)(F.ws + WS_EO); float* zn = (float*)(F.ws + WS_ZN);
    const int lam = F.lane;
    for (int row = F.gw; row < 8 * 512; row += F.NGW) {
        const int b = row >> 9, c = row & 511;
        const bf16* zr = ztl + (size_t)row * 8192; const bf16* zi = zr + 4096;
        v4u lo_r[4], hi_r[4], lo_i[4], hi_i[4];
#pragma unroll
        for (int q = 0; q < 4; ++q) { lo_r[q] = *(const v4u*)(zr + 32 * lam + 8 * q); hi_r[q] = *(const v4u*)(zr + 4064 - 32 * lam + 8 * q);
                                      lo_i[q] = *(const v4u*)(zi + 32 * lam + 8 * q); hi_i[q] = *(const v4u*)(zi + 4064 - 32 * lam + 8 * q); }
        float Lr[32], Hr[32], Li[32], Hi[32];
#pragma unroll
        for (int q = 0; q < 4; ++q)
#pragma unroll
            for (int e = 0; e < 4; ++e) { Lr[8 * q + 2 * e] = bflo(lo_r[q][e]); Lr[8 * q + 2 * e + 1] = bfhi(lo_r[q][e]); Hr[8 * q + 2 * e] = bflo(hi_r[q][e]); Hr[8 * q + 2 * e + 1] = bfhi(hi_r[q][e]);
                                          Li[8 * q + 2 * e] = bflo(lo_i[q][e]); Li[8 * q + 2 * e + 1] = bfhi(lo_i[q][e]); Hi[8 * q + 2 * e] = bflo(hi_i[q][e]); Hi[8 * q + 2 * e + 1] = bfhi(hi_i[q][e]); }
        float mr = __shfl_up(Hr[0], 1), mi = __shfl_up(Hi[0], 1); if (lam == 0) { mr = 0.f; mi = 0.f; }
        float E[32], O[32]; float ny = 0.f;
        E[0] = Lr[0] + mr; O[0] = lam == 0 ? 0.f : Li[0] - mi;
#pragma unroll
        for (int j = 1; j < 32; ++j) { E[j] = Lr[j] + Hr[32 - j]; O[j] = Li[j] - Hi[32 - j]; }
#pragma unroll
        for (int j = 0; j < 32; ++j) ny += (j & 1) ? -(Lr[j] + Hr[j]) : (Lr[j] + Hr[j]);
        ny = wave_sum(ny);
        bf16* ep = eo + ((size_t)(b * 2) * 512 + c) * 2048 + 32 * lam; bf16* op = ep + (size_t)512 * 2048;
#pragma unroll
        for (int q = 0; q < 4; ++q) { v4u e4, o4;
            e4.x = pk2(E[8 * q], E[8 * q + 1]); e4.y = pk2(E[8 * q + 2], E[8 * q + 3]); e4.z = pk2(E[8 * q + 4], E[8 * q + 5]); e4.w = pk2(E[8 * q + 6], E[8 * q + 7]);
            o4.x = pk2(O[8 * q], O[8 * q + 1]); o4.y = pk2(O[8 * q + 2], O[8 * q + 3]); o4.z = pk2(O[8 * q + 4], O[8 * q + 5]); o4.w = pk2(O[8 * q + 6], O[8 * q + 7]);
            *(v4u*)(ep + 8 * q) = e4; *(v4u*)(op + 8 * q) = o4; }
        if (lam == 63) zn[row] = Hr[0];
        if (lam == 0) zn[4096 + row] = ny;
    }
}

__device__ __forceinline__ void ctx_dft(const Frame& F) {
    LAS float* cs = (LAS float*)F.lds;
    LAS float* sn = cs + 256;
    LAS float* Z = sn + 256;
    const bf16* ztc = (const bf16*)(F.ws + WS_ZTC); bf16* mix = (bf16*)(F.ws + WS_ACT);
    const float scale = 1.0f / sqrtf(256.0f * 128.0f);
    __syncthreads();
    if (F.tid < 256) { cs[F.tid] = cospif((float)F.tid * (1.0f / 128.0f)); sn[F.tid] = sinpif((float)F.tid * (1.0f / 128.0f)); }
    for (int item = F.vcu - 128; item < 256; item += 128) {
        const int b = item >> 5, cg = item & 31;
        __syncthreads();
        for (int i = F.tid; i < 16 * 256; i += NTHR) { const int c = i >> 8, l2 = (i & 255) * 2; const unsigned w = *(const unsigned*)(ztc + ((size_t)b * 512 + cg * 16 + c) * 512 + l2);
            Z[c * 516 + l2] = bflo(w); Z[c * 516 + l2 + 1] = bfhi(w); }
        __syncthreads();
        const int c = F.tid & 15, lp0 = F.tid >> 4;
        float acc[8];
#pragma unroll
        for (int k = 0; k < 8; ++k) acc[k] = 0.f;
#pragma unroll 2
        for (int l = 0; l < 256; ++l) { const float zr = Z[c * 516 + l], zi = Z[c * 516 + 256 + l];
#pragma unroll
            for (int k = 0; k < 8; ++k) { const int idx = (l * (lp0 + 32 * k)) & 255; acc[k] += zr * cs[idx] + zi * sn[idx]; } }
#pragma unroll
        for (int k = 0; k < 8; ++k) mix[(size_t)(NLAT + b * 256 + lp0 + 32 * k) * D + cg * 16 + c] = (bf16)f2bf(acc[k] * scale);
    }
    __syncthreads();
}

__device__ __forceinline__ void scan_naive(const Frame& F, int l) {
    LAS float* kL = (LAS float*)F.lds;
    LAS float* qL = kL + 64 * 128;
    LAS float* vL = qL + 64 * 128;
    LAS float* oL = vL + 64 * 32;
    LAS float* gL = oL + 64 * 32;
    LAS float* bL = gL + 64;
    const bf16* qkvn = (const bf16*)(F.ws + WS_QKVN);
    const float* gb = (const float*)(F.ws + WS_G); const float* bb = (const float*)(F.ws + WS_BETA);
    for (int unit = F.vcu; unit < 256; unit += F.G) {
        const int qd = unit & 3, s = unit >> 2, d = s & 1, h = (s >> 1) & 3, b = s >> 3;
        bf16* od = (bf16*)(F.ws + (d ? WS_OB : WS_OF));
        const int j = F.tid >> 4, rg = F.tid & 15;
        float S[8];
#pragma unroll
        for (int i = 0; i < 8; ++i) S[i] = 0.f;
#pragma unroll 1
        for (int ci = 0; ci < 68; ++ci) {
            int rowbase; const bool isctx = ci < 4;
            if (isctx) rowbase = NLAT + b * 256 + (d ? 3 - ci : ci) * 64; else { const int lc = ci - 4; rowbase = b * SEQ + (d ? 63 - lc : lc) * 64; }
            __syncthreads();
            for (int i = F.tid; i < 64 * 16; i += NTHR) { const int r = i >> 4, g8 = i & 15; const bf16* rp = qkvn + (size_t)(rowbase + r) * 1536 + h * 128 + g8 * 8;
                const v4u q = *(const v4u*)rp, k = *(const v4u*)(rp + 512);
                LAS float* qo = qL + r * 128 + g8 * 8; LAS float* ko = kL + r * 128 + g8 * 8;
                qo[0] = bflo(q.x); qo[1] = bfhi(q.x); qo[2] = bflo(q.y); qo[3] = bfhi(q.y); qo[4] = bflo(q.z); qo[5] = bfhi(q.z); qo[6] = bflo(q.w); qo[7] = bfhi(q.w);
                ko[0] = bflo(k.x); ko[1] = bfhi(k.x); ko[2] = bflo(k.y); ko[3] = bfhi(k.y); ko[4] = bflo(k.z); ko[5] = bfhi(k.z); ko[6] = bflo(k.w); ko[7] = bfhi(k.w); }
            if (F.tid < 256) { const int r = F.tid >> 2, g8 = F.tid & 3; const v4u v = *(const v4u*)(qkvn + (size_t)(rowbase + r) * 1536 + 1024 + h * 128 + qd * 32 + g8 * 8);
                LAS float* vo = vL + r * 32 + g8 * 8;
                vo[0] = bflo(v.x); vo[1] = bfhi(v.x); vo[2] = bflo(v.y); vo[3] = bfhi(v.y); vo[4] = bflo(v.z); vo[5] = bfhi(v.z); vo[6] = bflo(v.w); vo[7] = bfhi(v.w); }
            else if (F.tid < 320) { const int r = F.tid - 256; gL[r] = __expf(gb[(size_t)(rowbase + r) * 8 + d * 4 + h]); bL[r] = bb[(size_t)(rowbase + r) * 8 + d * 4 + h]; }
            __syncthreads();
#pragma unroll 2
            for (int st = 0; st < 64; ++st) {
                const int r = d ? 63 - st : st;
                const float alpha = gL[r], bt = bL[r];
                const f32x4 k0 = *(const LAS f32x4*)(kL + r * 128 + rg * 8), k1 = *(const LAS f32x4*)(kL + r * 128 + rg * 8 + 4);
                const f32x4 q0 = *(const LAS f32x4*)(qL + r * 128 + rg * 8), q1 = *(const LAS f32x4*)(qL + r * 128 + rg * 8 + 4);
                float part = (k0.x * S[0] + k0.y * S[1]) + (k0.z * S[2] + k0.w * S[3]) + (k1.x * S[4] + k1.y * S[5]) + (k1.z * S[6] + k1.w * S[7]);
                part = sum16(part);
                const float dl = bt * (vL[r * 32 + j] - alpha * part);
                S[0] = alpha * S[0] + k0.x * dl; S[1] = alpha * S[1] + k0.y * dl; S[2] = alpha * S[2] + k0.z * dl; S[3] = alpha * S[3] + k0.w * dl;
                S[4] = alpha * S[4] + k1.x * dl; S[5] = alpha * S[5] + k1.y * dl; S[6] = alpha * S[6] + k1.z * dl; S[7] = alpha * S[7] + k1.w * dl;
                float op = (q0.x * S[0] + q0.y * S[1]) + (q0.z * S[2] + q0.w * S[3]) + (q1.x * S[4] + q1.y * S[5]) + (q1.z * S[6] + q1.w * S[7]);
                op = sum16(op);
                if (rg == 0) oL[r * 32 + j] = op;
            }
            __syncthreads();
            if (!(isctx && l == NL - 1)) { const int r = F.tid >> 3, g4 = F.tid & 7; const LAS float* op = oL + r * 32 + g4 * 4;
                v2u w; w.x = pk2(op[0], op[1]); w.y = pk2(op[2], op[3]);
                *(v2u*)(od + (size_t)(rowbase + r) * 512 + h * 128 + qd * 32 + g4 * 4) = w; }
        }
        __syncthreads();
    }
}

__device__ __forceinline__ void gated_out(const Frame& F, int l) {
    const KArgsP A = kargs();
    const bf16* of = (const bf16*)(F.ws + WS_OF); const bf16* ob = (const bf16*)(F.ws + WS_OB); const bf16* qkvz = (const bf16*)(F.ws + WS_QKVZ);
    const bf16* ab2 = (const bf16*)(F.ws + WS_AB2); const float* zn = (const float*)(F.ws + WS_ZN);
    bf16* mix = (bf16*)(F.ws + WS_ACT);
    const int nrows = l == NL - 1 ? NLAT : MT;
    const float fsc = 1.0f / sqrtf(4096.0f * 128.0f);
    const f32x4 g0 = *(const f32x4*)(A->in[I_GOUT] + l * 128 + (F.lane & 15) * 8), g1 = *(const f32x4*)(A->in[I_GOUT] + l * 128 + (F.lane & 15) * 8 + 4);
    for (int t = F.gw; t < nrows; t += F.NGW) {
        const v4u a = *(const v4u*)(of + (size_t)t * 512 + 8 * F.lane), b = *(const v4u*)(ob + (size_t)t * 512 + 8 * F.lane), z = *(const v4u*)(qkvz + (size_t)t * 2048 + 1536 + 8 * F.lane);
        if (t < NLAT) {
            const int bb_ = t >> 12, lp = t & 4095, k = lp <= 2048 ? lp : 4096 - lp;
            float y[8];
            if (k == 2048) { const f32x4 n0 = *(const f32x4*)(zn + 4096 + bb_ * 512 + 8 * F.lane), n1 = *(const f32x4*)(zn + 4096 + bb_ * 512 + 8 * F.lane + 4);
                y[0] = n0.x; y[1] = n0.y; y[2] = n0.z; y[3] = n0.w; y[4] = n1.x; y[5] = n1.y; y[6] = n1.z; y[7] = n1.w; }
            else { const v4u pa = *(const v4u*)(ab2 + ((size_t)(bb_ * 2) * 2048 + k) * 512 + 8 * F.lane), pb_ = *(const v4u*)(ab2 + ((size_t)(bb_ * 2 + 1) * 2048 + k) * 512 + 8 * F.lane);
                const f32x4 z0 = *(const f32x4*)(zn + bb_ * 512 + 8 * F.lane), z1 = *(const f32x4*)(zn + bb_ * 512 + 8 * F.lane + 4);
                const float sg = lp <= 2048 ? 1.0f : -1.0f, sz = (k & 1) ? -1.0f : 1.0f;
                y[0] = bflo(pa.x) + sg * bflo(pb_.x) + sz * z0.x; y[1] = bfhi(pa.x) + sg * bfhi(pb_.x) + sz * z0.y; y[2] = bflo(pa.y) + sg * bflo(pb_.y) + sz * z0.z; y[3] = bfhi(pa.y) + sg * bfhi(pb_.y) + sz * z0.w;
                y[4] = bflo(pa.z) + sg * bflo(pb_.z) + sz * z1.x; y[5] = bfhi(pa.z) + sg * bfhi(pb_.z) + sz * z1.y; y[6] = bflo(pa.w) + sg * bflo(pb_.w) + sz * z1.z; y[7] = bfhi(pa.w) + sg * bfhi(pb_.w) + sz * z1.w; }
            v4u wy; wy.x = pk2(y[0] * fsc, y[1] * fsc); wy.y = pk2(y[2] * fsc, y[3] * fsc); wy.z = pk2(y[4] * fsc, y[5] * fsc); wy.w = pk2(y[6] * fsc, y[7] * fsc);
            *(v4u*)(mix + (size_t)t * D + 8 * F.lane) = wy;
        }
        float o[8] = {bflo(a.x) + bflo(b.x), bfhi(a.x) + bfhi(b.x), bflo(a.y) + bflo(b.y), bfhi(a.y) + bfhi(b.y), bflo(a.z) + bflo(b.z), bfhi(a.z) + bfhi(b.z), bflo(a.w) + bflo(b.w), bfhi(a.w) + bfhi(b.w)};
        const float zz[8] = {bflo(z.x), bfhi(z.x), bflo(z.y), bfhi(z.y), bflo(z.z), bfhi(z.z), bflo(z.w), bfhi(z.w)};
        const float gg[8] = {g0.x, g0.y, g0.z, g0.w, g1.x, g1.y, g1.z, g1.w};
        float ss = 0.f;
#pragma unroll
        for (int i = 0; i < 8; ++i) ss += o[i] * o[i];
        const float rs = 1.0f / sqrtf(sum16(ss) * (1.0f / 128.0f) + EPS);
#pragma unroll
        for (int i = 0; i < 8; ++i) o[i] = o[i] * rs * gg[i] * silu_f(zz[i]);
        v4u w; w.x = pk2(o[0], o[1]); w.y = pk2(o[2], o[3]); w.z = pk2(o[4], o[5]); w.w = pk2(o[6], o[7]);
        *(v4u*)(mix + (size_t)t * D + 512 + 8 * F.lane) = w;
    }
}

__device__ __forceinline__ void router_phase(const Frame& F, int l, int bank = 0) {
    const KArgsP A = kargs();
    LAS float* wr = (LAS float*)F.lds;
    LAS int* lcnt = (LAS int*)(F.lds + XT_OFF);
    LAS int* lbase = lcnt + 32;
    LAS int* sE = lbase + 32;
    LAS int* sP = sE + 136 * 4;
    LAS float* sG = (LAS float*)(sP + 136 * 4);
    const int nrows = l == NL - 1 ? NLAT : MT, rpb = nrows / 256;
    { const f32x4* src = (const f32x4*)((const float*)(F.ws + WS_WRT) + (size_t)l * NEXP * D);
      for (int i = F.tid; i < NEXP * D / 4; i += NTHR) ((LAS f32x4*)wr)[i] = src[i];
      if (F.tid < 32) lcnt[F.tid] = 0; }
    __syncthreads();
    bf16* h2 = (bf16*)(F.ws + WS_ACT);
    const int row0 = F.vcu * rpb;
    if (F.vcu < 256) {
    for (int rl = F.wave; rl < rpb; rl += NWAVES) {
        const int t = row0 + rl, r = mod_row(t);
        const float* xr = xr_row(F, t);
        f32x4 v[4]; float ss = 0.f;
#pragma unroll
        for (int j = 0; j < 4; ++j) { v[j] = *((const f32x4*)xr + F.lane + 64 * j); ss += (v[j].x * v[j].x + v[j].y * v[j].y) + (v[j].z * v[j].z + v[j].w * v[j].w); }
        const float rstd = 1.0f / sqrtf(wave_sum(ss) * (1.0f / D) + EPS);
        const f32x4* g2 = (const f32x4*)(A->in[I_GN2] + (size_t)l * D) + F.lane;
        const f32x4* sh = (const f32x4*)modv(F, l, r, 3) + F.lane; const f32x4* scl = (const f32x4*)modv(F, l, r, 4) + F.lane;
        v2u* ho = (v2u*)(h2 + (size_t)t * D) + F.lane;
#pragma unroll
        for (int j = 0; j < 4; ++j) { v[j] = v[j] * rstd * g2[64 * j] * (scl[64 * j] + 1.0f) + sh[64 * j]; v2u w; w.x = pk2(v[j].x, v[j].y); w.y = pk2(v[j].z, v[j].w); ho[64 * j] = w; }
        float lgv[4];
#pragma unroll
        for (int g = 0; g < 4; ++g) {
            float pe[8];
            int lofs = F.lane; asm volatile("" : "+v"(lofs));
#pragma unroll
            for (int e = 0; e < 8; ++e) { f32x2_t p2 = {0.f, 0.f};
#pragma unroll
                for (int j = 0; j < 4; ++j) { const f32x4 w = ((const LAS f32x4*)(wr + (8 * g + e) * D))[lofs + 64 * j];
                    p2 = (f32x2_t){v[j].x, v[j].y} * (f32x2_t){w.x, w.y} + p2; p2 = (f32x2_t){v[j].z, v[j].w} * (f32x2_t){w.z, w.w} + p2; }
                pe[e] = p2.x + p2.y; }
            lgv[g] = rs8(pe, F.lane) + A->in[I_BR][l * NEXP + 8 * g + (F.lane >> 3)];
            if (F.lane & 7) lgv[g] = -3.0e38f;
            asm volatile("" ::: "memory");
        }
        int se[4]; float sv[4];
#pragma unroll
        for (int k = 0; k < 4; ++k) {
            float ml = lgv[0]; int gl = 0;
#pragma unroll
            for (int g = 1; g < 4; ++g) if (lgv[g] > ml) { ml = lgv[g]; gl = g; }
            float m = ml;
#pragma unroll
            for (int o = 1; o < 64; o <<= 1) m = fmaxf(m, __shfl_xor(m, o));
            const unsigned long long bal = __ballot(ml == m); const int idx = __ffsll((long long)bal) - 1;
            const int gs = __shfl(gl, idx);
            se[k] = 8 * gs + (idx >> 3); sv[k] = m;
#pragma unroll
            for (int g = 0; g < 4; ++g) if (F.lane == idx && g == gs) lgv[g] = -3.0e38f;
        }
        const float e1 = __expf(sv[1] - sv[0]), e2 = __expf(sv[2] - sv[0]), e3 = __expf(sv[3] - sv[0]), inv = 1.0f / (1.0f + e1 + e2 + e3);
        if (F.lane == 0) {
            const float gt[4] = {inv, e1 * inv, e2 * inv, e3 * inv};
#pragma unroll
            for (int k = 0; k < 4; ++k) { sE[rl * 4 + k] = se[k]; sP[rl * 4 + k] = __hip_atomic_fetch_add(lcnt + se[k], 1, __ATOMIC_RELAXED, __HIP_MEMORY_SCOPE_WORKGROUP); sG[rl * 4 + k] = gt[k]; } }
    }
    }
    __syncthreads();
    if (F.tid < 32) { const int n = lcnt[F.tid]; lbase[F.tid] = n ? (int)__hip_atomic_fetch_add(F.ctl + CW_GCNT + ((bank * 2 + l) * 32 + F.tid) * 64, (unsigned)n, RLX_AGENT) : 0; }
    __syncthreads();
    if (F.vcu < 256) {
        int* sele = (int*)(F.ws + WS_SELE); int* selp = (int*)(F.ws + WS_SELP); float* selg = (float*)(F.ws + WS_SELG);
        for (int i = F.tid; i < rpb * 4; i += NTHR) { const int e = sE[i]; sele[(size_t)row0 * 4 + i] = e; selp[(size_t)row0 * 4 + i] = lbase[e] + sP[i]; selg[(size_t)row0 * 4 + i] = sG[i]; }
    }
}
__device__ __forceinline__ void moe_layout(const Frame& F, int l, LAS int* pend, LAS int* pstart) {
    __syncthreads();
    if (F.tid < 64) {
        const int e = F.tid & 31;
        const int n = (int)__hip_atomic_load(F.ctl + CW_GCNT + (l * 32 + e) * 64, RLX_AGENT);
        const int nb = (F.tid < 32) ? ((n + 255) >> 8) : 0;
        int inc = nb;
#pragma unroll
        for (int o = 1; o < 32; o <<= 1) { const int t = __shfl_up(inc, o); if ((F.tid & 63) >= o) inc += t; }
        if (F.tid < 32) { pend[e] = inc; pstart[e] = (inc - nb) * 256; }
    }
    __syncthreads();
}
__device__ __forceinline__ void gather_phase(const Frame& F, int l, bool dummy = false) {
    LAS int* pend = (LAS int*)(F.lds + XT_OFF); LAS int* pstart = pend + 32;
    moe_layout(F, l, pend, pstart);
    const int nrows = l == NL - 1 ? NLAT : MT;
    const int* sele = (const int*)(F.ws + WS_SELE); int* selp = (int*)(F.ws + WS_SELP);
    unsigned* goff = (unsigned*)(F.ws + WS_GOFF);
    for (int it = F.gw * 64 + F.lane; it < nrows * 4; it += F.NGW * 64) {
        const int t = it >> 2, e = sele[it], dst = pstart[e] + selp[it];
        const int pm = dst >> 8, h = (dst >> 7) & 1, R = dst & 127;
        unsigned* gp = goff + (size_t)pm * 2048 + h * 2;
#pragma unroll
        for (int cp = 0; cp < 8; ++cp) { const int b = pg8::lds_byte(R, 8 * cp);
            gp[((b & 8191) >> 4) * 4 + (b >> 13)] = (unsigned)(t * 2048 + 16 * cp); }
        if (!dummy) selp[it] = dst;
    }
}


constexpr size_t WS_PW = WS_OB + 34 * MiB;
constexpr size_t WS_PKET = WS_PW + 68 * MiB;
constexpr size_t WS_PUT = WS_PKET + 68 * MiB;
constexpr size_t WS_PATT = WS_PUT + 68 * MiB;
constexpr size_t WS_PGAM = WS_PATT + 34 * MiB;
static_assert(WS_PGAM + 6 * MiB <= WS_END, "prep map");
typedef short bf16x8_t __attribute__((ext_vector_type(8)));
#define MFMA16(a, b, c) __builtin_amdgcn_mfma_f32_16x16x32_bf16((a), (b), (c), 0, 0, 0)
__device__ __forceinline__ v2u pack4(const f32x4 v) { v2u w; w.x = pk2(v.x, v.y); w.y = pk2(v.z, v.w); return w; }
__device__ __forceinline__ int chunk_rowbase(int b, int cn) { return cn < 4 ? NLAT + b * CTXL + cn * 64 : b * SEQ + (cn - 4) * 64; }

#ifdef PROBE_PREP
#define PSTAMP(k) do { const unsigned long long t_ = __builtin_amdgcn_s_memrealtime(); if (PROBE_PREP == (k)) pp_acc += t_ - pp_last; pp_last = t_; } while (0)
#else
#define PSTAMP(k) do {} while (0)
#endif
__device__ __forceinline__ void prep_phase(const Frame& F) {
#ifdef PROBE_PREP
    unsigned long long pp_acc = 0ull, pp_last = 0ull;
#endif
    LAS bf16* k_rm = (LAS bf16*)F.lds;
    LAS bf16* q_rm = k_rm + 64 * 136;
    LAS bf16* kT = (LAS bf16*)(F.lds + 36864);
    LAS bf16* vT = kT + 128 * 72;
    LAS float* Gm = (LAS float*)(F.lds + 36864 + 36864);
    LAS float* A0 = Gm + 64 * 72;
    LAS float* bs = (LAS float*)(F.lds + 36864 + 36864 + 36864);
    LAS float* gam = bs + 128;
    const bf16* qkvn = (const bf16*)(F.ws + WS_QKVN);
    const float* gb = (const float*)(F.ws + WS_G); const float* bb = (const float*)(F.ws + WS_BETA);
    const int w = F.wave;
    v4u ld[2][3];
    {
        int tid_ = F.tid; asm volatile("" : "+v"(tid_));
        const int unit = F.vcu;
        if (unit < 32 * 68) { const int bh = unit / 68, cn = unit % 68, rowbase = chunk_rowbase(bh >> 2, cn);
#pragma unroll
            for (int it = 0; it < 2; ++it) { const int p = tid_ + it * NTHR, i = p & 63, c8 = p >> 6; const bf16* rp = qkvn + (size_t)(rowbase + i) * 1536 + (bh & 3) * 128 + c8 * 8;
                ld[it][0] = *(const v4u*)rp; ld[it][1] = *(const v4u*)(rp + 512); ld[it][2] = *(const v4u*)(rp + 1024); } }
    }
    for (int unit = F.vcu; unit < 32 * 68; unit += F.G) {
        int tid_ = F.tid; asm volatile("" : "+v"(tid_));
        const int tid = tid_, lane = tid & 63, l15 = lane & 15, l4 = lane >> 4;
        const int bh = unit / 68, cn = unit % 68, b = bh >> 2, h = bh & 3, rowbase = chunk_rowbase(b, cn);
        const size_t pu = (size_t)(bh * 68 + cn) * 2;
        __syncthreads();
        PSTAMP(0);
#pragma unroll
        for (int it = 0; it < 2; ++it) { const int p = tid + it * NTHR, i = p & 63, c8 = p >> 6;
            const v4u qv = ld[it][0], kv = ld[it][1], vv = ld[it][2];
            *(LAS v4u*)(q_rm + i * 136 + c8 * 8) = qv; *(LAS v4u*)(k_rm + i * 136 + c8 * 8) = kv;
#pragma unroll
            for (int e = 0; e < 4; ++e) { const unsigned kw = kv[e], vw = vv[e];
                kT[(c8 * 8 + 2 * e) * 72 + i] = (bf16)(kw & 0xffffu); kT[(c8 * 8 + 2 * e + 1) * 72 + i] = (bf16)(kw >> 16);
                vT[(c8 * 8 + 2 * e) * 72 + i] = (bf16)(vw & 0xffffu); vT[(c8 * 8 + 2 * e + 1) * 72 + i] = (bf16)(vw >> 16); } }
        if (w < 2) { const int d = w; float g = gb[(size_t)(rowbase + lane) * 8 + d * 4 + h]; bs[d * 64 + lane] = bb[(size_t)(rowbase + lane) * 8 + d * 4 + h];
            if (d == 0) {
#pragma unroll
                for (int o = 1; o < 64; o <<= 1) { const float t = __shfl_up(g, o); if (lane >= o) g += t; } }
            else {
#pragma unroll
                for (int o = 1; o < 64; o <<= 1) { const float t = __shfl_down(g, o); if (lane + o < 64) g += t; } }
            gam[d * 64 + lane] = g; }
        {
            const int un = unit + F.G;
            if (un < 32 * 68) { const int bh2 = un / 68, cn2 = un % 68, rb2 = chunk_rowbase(bh2 >> 2, cn2);
#pragma unroll
                for (int it = 0; it < 2; ++it) { const int p = tid + it * NTHR, i = p & 63, c8 = p >> 6; const bf16* rp = qkvn + (size_t)(rb2 + i) * 1536 + (bh2 & 3) * 128 + c8 * 8;
                    ld[it][0] = *(const v4u*)rp; ld[it][1] = *(const v4u*)(rp + 512); ld[it][2] = *(const v4u*)(rp + 1024); } }
        }
        __syncthreads();
        PSTAMP(1);
        { bf16* qz = (bf16*)(F.ws + WS_QKVZ);
#pragma unroll
          for (int it = 0; it < 2; ++it) { const int p = tid + it * NTHR, tl = p >> 6, ln = p & 63, rt_ = tl >> 2, ks_ = tl & 3;
              const v4u qv = *(const LAS v4u*)(q_rm + (16 * rt_ + (ln & 15)) * 136 + 32 * ks_ + 8 * (ln >> 4));
              *(v4u*)(qz + (size_t)(rowbase + 16 * h + tl) * 2048 + ln * 8) = qv; } }
#pragma unroll
        for (int tt = 0; tt < 2; ++tt) { const int idx = 2 * w + tt, ti = idx >> 2, tj = idx & 3;
            f32x4 aG = {0.f, 0.f, 0.f, 0.f}, aA = {0.f, 0.f, 0.f, 0.f};
#pragma unroll
            for (int ks = 0; ks < 4; ++ks) { const int co = 32 * ks + 8 * l4;
                const bf16x8_t bk = *(const LAS bf16x8_t*)(k_rm + (16 * tj + l15) * 136 + co), ak = *(const LAS bf16x8_t*)(k_rm + (16 * ti + l15) * 136 + co), aq = *(const LAS bf16x8_t*)(q_rm + (16 * ti + l15) * 136 + co);
                aG = MFMA16(ak, bk, aG); aA = MFMA16(aq, bk, aA); }
#pragma unroll
            for (int r = 0; r < 4; ++r) { Gm[(16 * ti + 4 * l4 + r) * 72 + 16 * tj + l15] = aG[r]; A0[(16 * ti + 4 * l4 + r) * 72 + 16 * tj + l15] = aA[r]; } }
        __syncthreads();
        PSTAMP(2);
        for (int idx = tid; idx < 8192; idx += NTHR) { const int d = idx >> 12, ip = (idx >> 6) & 63, jp = idx & 63, i = d ? 63 - ip : ip, j = d ? 63 - jp : jp;
            ((LAS float*)(F.lds + d * 18432))[idx & 4095] = jp < ip ? bs[d * 64 + i] * Gm[i * 72 + j] * __expf(gam[d * 64 + i] - gam[d * 64 + j]) : 0.f; }
        __syncthreads();
        PSTAMP(3);
        if (w < 2) {
            const int d = w; const LAS float* Lr = (const LAS float*)(F.lds + d * 18432);
            const int blk = lane >> 5, cc = lane & 31;
            const LAS float* Lb = Lr + (32 * blk) * 64 + 32 * blk;
            LAS bf16* SB = (LAS bf16*)(F.lds + 36864 + 36864 + 36864 + 1024 + d * 9216);
            LAS bf16* L21b = SB;
            LAS bf16* T22r = SB + 32 * 40;
            LAS bf16* T11T = SB + 64 * 40;
            LAS bf16* XT = T11T + 32 * 32;
            float t[32];
            f32x4 LA[8], LB[8];
#pragma unroll
            for (int ip = 0; ip < 32; ++ip) {
                if (ip + 1 < 32) {
#pragma unroll
                    for (int j4 = 0; j4 < (ip + 4) / 4; ++j4) { const f32x4 Lv = *(const LAS f32x4*)(Lb + (ip + 1) * 64 + 4 * j4); if (ip & 1) LA[j4] = Lv; else LB[j4] = Lv; }
                }
                float a0 = (cc == ip) ? 1.f : 0.f, a1 = 0.f, a2 = 0.f, a3 = 0.f;
#pragma unroll
                for (int j4 = 0; j4 < (ip + 3) / 4; ++j4) { const f32x4 Lv = (ip & 1) ? LB[j4] : LA[j4];
                    if (4 * j4 + 0 < ip) a0 -= Lv.x * t[4 * j4 + 0];
                    if (4 * j4 + 1 < ip) a1 -= Lv.y * t[4 * j4 + 1];
                    if (4 * j4 + 2 < ip) a2 -= Lv.z * t[4 * j4 + 2];
                    if (4 * j4 + 3 < ip) a3 -= Lv.w * t[4 * j4 + 3]; }
                t[ip] = (a0 + a1) + (a2 + a3); asm volatile("" ::: "memory"); }
            { const int i = lane >> 1, j0 = (lane & 1) * 16; const LAS f32x4* lp = (const LAS f32x4*)(Lr + (32 + i) * 64 + j0);
              const f32x4 x0 = lp[0], x1 = lp[1], x2 = lp[2], x3 = lp[3];
              v4u o0, o1; o0.x = pk2(x0.x, x0.y); o0.y = pk2(x0.z, x0.w); o0.z = pk2(x1.x, x1.y); o0.w = pk2(x1.z, x1.w); o1.x = pk2(x2.x, x2.y); o1.y = pk2(x2.z, x2.w); o1.z = pk2(x3.x, x3.y); o1.w = pk2(x3.z, x3.w);
              *(LAS v4u*)(L21b + i * 40 + j0) = o0; *(LAS v4u*)(L21b + i * 40 + j0 + 8) = o1; }
            if (blk == 0) {
#pragma unroll
                for (int q = 0; q < 4; ++q) { v4u o; o.x = pk2(t[8 * q], t[8 * q + 1]); o.y = pk2(t[8 * q + 2], t[8 * q + 3]); o.z = pk2(t[8 * q + 4], t[8 * q + 5]); o.w = pk2(t[8 * q + 6], t[8 * q + 7]);
                    *(LAS v4u*)(T11T + cc * 32 + 8 * q) = o; }
            } else {
#pragma unroll
                for (int ip = 0; ip < 32; ++ip) T22r[ip * 40 + cc] = (bf16)f2bf(t[ip]);
            }
            asm volatile("s_waitcnt lgkmcnt(0)" ::: "memory");
            f32x4 xa[2][2];
#pragma unroll
            for (int ti = 0; ti < 2; ++ti) { const bf16x8_t af = *(const LAS bf16x8_t*)(L21b + (16 * ti + l15) * 40 + 8 * l4);
#pragma unroll
                for (int tj = 0; tj < 2; ++tj) { const bf16x8_t bf = *(const LAS bf16x8_t*)(T11T + (16 * tj + l15) * 32 + 8 * l4);
                    xa[ti][tj] = MFMA16(af, bf, ((f32x4){0.f, 0.f, 0.f, 0.f}));
                    *(LAS v2u*)(XT + (16 * tj + l15) * 32 + 16 * ti + 4 * l4) = pack4(xa[ti][tj]); } }
            asm volatile("s_waitcnt lgkmcnt(0)" ::: "memory");
#pragma unroll
            for (int ti = 0; ti < 2; ++ti) { const bf16x8_t af = *(const LAS bf16x8_t*)(T22r + (16 * ti + l15) * 40 + 8 * l4);
#pragma unroll
                for (int tj = 0; tj < 2; ++tj) { const bf16x8_t bf = *(const LAS bf16x8_t*)(XT + (16 * tj + l15) * 32 + 8 * l4);
                    xa[ti][tj] = MFMA16(af, bf, ((f32x4){0.f, 0.f, 0.f, 0.f})); } }
            asm volatile("s_waitcnt lgkmcnt(0)" ::: "memory");
            LAS bf16* Tu = (LAS bf16*)(F.lds + d * 18432); LAS bf16* Tw = Tu + 64 * 72;
            {
                const int jp = 32 * blk + cc, jn = d ? 63 - jp : jp; const float bj = bs[d * 64 + jn], bge = bj * __expf(gam[d * 64 + jn]);
#pragma unroll
                for (int ip = 0; ip < 32; ++ip) { const int ipp = 32 * blk + ip, in = d ? 63 - ipp : ipp; Tu[in * 72 + jn] = (bf16)f2bf(t[ip] * bj); Tw[in * 72 + jn] = (bf16)f2bf(t[ip] * bge); }
                if (blk == 1) {
#pragma unroll
                    for (int ip = 0; ip < 32; ++ip) { const int in = d ? 63 - ip : ip; Tu[in * 72 + jn] = (bf16)0; Tw[in * 72 + jn] = (bf16)0; } }
            }
#pragma unroll
            for (int tj = 0; tj < 2; ++tj) {
                const int jp = 16 * tj + l15, jn = d ? 63 - jp : jp; const float bj = bs[d * 64 + jn], bge = bj * __expf(gam[d * 64 + jn]);
#pragma unroll
                for (int ti = 0; ti < 2; ++ti)
#pragma unroll
                    for (int r = 0; r < 4; ++r) { const int ipp = 32 + 16 * ti + 4 * l4 + r, in = d ? 63 - ipp : ipp; const float v = -xa[ti][tj][r];
                        Tu[in * 72 + jn] = (bf16)f2bf(v * bj); Tw[in * 72 + jn] = (bf16)f2bf(v * bge); } }
        } else {
            const int t6 = tid - 128;
            for (int it = t6; it < 1024; it += NTHR - 128) { const int d = it >> 9, i = (it >> 3) & 63, j0 = (it & 7) * 8; float v[8];
#pragma unroll
                for (int e = 0; e < 8; ++e) { const int j = j0 + e; const bool in = d ? (j >= i) : (j <= i); v[e] = in ? A0[i * 72 + j] * __expf(gam[d * 64 + i] - gam[d * 64 + j]) : 0.f; }
                v4u o; o.x = pk2(v[0], v[1]); o.y = pk2(v[2], v[3]); o.z = pk2(v[4], v[5]); o.w = pk2(v[6], v[7]);
                *(v4u*)((bf16*)(F.ws + WS_PATT) + (pu + d) * 4096 + ((((i >> 4) * 2 + (j0 >> 5)) * 64 + ((j0 & 31) >> 3) * 16 + (i & 15)) * 8)) = o; }
            for (int it = t6; it < 2048; it += NTHR - 128) { const int d = it >> 10, dk = (it >> 3) & 127, j0 = (it & 7) * 8; const float gl = d ? gam[64] : gam[63]; float v[8];
                const v4u kk = *(const LAS v4u*)(kT + dk * 72 + j0);
                v[0] = bflo(kk.x); v[1] = bfhi(kk.x); v[2] = bflo(kk.y); v[3] = bfhi(kk.y); v[4] = bflo(kk.z); v[5] = bfhi(kk.z); v[6] = bflo(kk.w); v[7] = bfhi(kk.w);
#pragma unroll
                for (int e = 0; e < 8; ++e) v[e] *= __expf(gl - gam[d * 64 + j0 + e]);
                v4u o; o.x = pk2(v[0], v[1]); o.y = pk2(v[2], v[3]); o.z = pk2(v[4], v[5]); o.w = pk2(v[6], v[7]);
                *(v4u*)((bf16*)(F.ws + WS_PKET) + (pu + d) * 8192 + ((((dk >> 4) * 2 + (j0 >> 5)) * 64 + ((j0 & 31) >> 3) * 16 + (dk & 15)) * 8)) = o; }
            if (t6 < 128) ((float*)(F.ws + WS_PGAM))[(pu + (t6 >> 6)) * 64 + (t6 & 63)] = gam[t6];
        }
        __syncthreads();
        PSTAMP(4);
        {
            const int d = w >> 2, ww = w & 3;
            const LAS bf16* Tu = (const LAS bf16*)(F.lds + d * 18432); const LAS bf16* Tw = Tu + 64 * 72;
            bf16x8_t tu[2], tw[2];
#pragma unroll
            for (int ks = 0; ks < 2; ++ks) { tu[ks] = *(const LAS bf16x8_t*)(Tu + (16 * ww + l15) * 72 + 32 * ks + 8 * l4); tw[ks] = *(const LAS bf16x8_t*)(Tw + (16 * ww + l15) * 72 + 32 * ks + 8 * l4); }
            bf16* ut = (bf16*)(F.ws + WS_PUT) + (pu + d) * 8192; bf16* wg = (bf16*)(F.ws + WS_PW) + (pu + d) * 8192;
#pragma unroll 2
            for (int tj = 0; tj < 8; ++tj) {
                f32x4 au = {0.f, 0.f, 0.f, 0.f}, aw = {0.f, 0.f, 0.f, 0.f};
#pragma unroll
                for (int ks = 0; ks < 2; ++ks) { const bf16x8_t bv = *(const LAS bf16x8_t*)(vT + (16 * tj + l15) * 72 + 32 * ks + 8 * l4), ak = *(const LAS bf16x8_t*)(kT + (16 * tj + l15) * 72 + 32 * ks + 8 * l4);
                    au = MFMA16(tu[ks], bv, au); aw = MFMA16(ak, tw[ks], aw); }
                *(v2u*)(ut + ((((tj >> 2) * 4 + ww) * 2 + ((tj & 3) >> 1)) * 512 + (l4 * 16 + l15) * 8 + (tj & 1) * 4)) = pack4(au);
                *(v2u*)(wg + ((ww * 4 + (tj >> 1)) * 512 + ((2 * (tj & 1) + (l4 >> 1)) * 16 + l15) * 8 + 4 * (l4 & 1))) = pack4(aw);
            }
        }
        PSTAMP(5);
    }
    __syncthreads();
#ifdef PROBE_PREP
    if (F.vcu == 0 && F.tid == 0) *(unsigned long long*)(F.ws + WS_ZN + 48 * 1024) += pp_acc;
#endif
}

__device__ __forceinline__ void gl16(bf16x8_t& d, const void* p) { asm volatile("global_load_dwordx4 %0, %1, off" : "=v"(d) : "v"(p) : "memory"); }
__device__ __forceinline__ void gl16f(f32x4& d, const void* p) { asm volatile("global_load_dwordx4 %0, %1, off" : "=v"(d) : "v"(p) : "memory"); }
__device__ __forceinline__ void gl4f(float& d, const void* p) { asm volatile("global_load_dword %0, %1, off" : "=v"(d) : "v"(p) : "memory"); }
struct ScanRegs { bf16x8_t fa[4], fx[2], kf[2]; f32x4 graw; float glast; };
__device__ __forceinline__ int scan_cn(int ci_in, int d) { const int ci = ci_in < 68 ? ci_in : 67; return ci < 4 ? (d ? 3 - ci : ci) : 4 + (d ? 67 - ci : ci - 4); }
__device__ __forceinline__ void scan_load(ScanRegs& R, const unsigned char* ws, int ci_in, int b, int bh, int h, int d, int s, int w, int l15, int l4) {
    const int rt = w & 3, cn = scan_cn(ci_in, d), rowbase = chunk_rowbase(b, cn);
    const size_t pu = (size_t)(bh * 68 + cn) * 2 + d;
    const float* gmp = (const float*)(ws + WS_PGAM) + pu * 64;
    gl4f(R.glast, gmp + (d ? 0 : 63)); gl16f(R.graw, gmp + 16 * rt + 4 * l4);
    const int ln8 = (l4 * 16 + l15) * 8;
    const bf16* ket = (const bf16*)(ws + WS_PKET) + pu * 8192 + (w * 2) * 512 + ln8;
    gl16(R.kf[0], ket); gl16(R.kf[1], ket + 512);
    const bf16* wp = (const bf16*)(ws + WS_PW) + pu * 8192 + (rt * 4) * 512 + ln8;
    const bf16* qp = (const bf16*)(ws + WS_QKVZ) + (size_t)(rowbase + 16 * h + 4 * rt) * 2048 + ln8;
    const bf16* ap_ = w < 4 ? wp : qp; const int kst = w < 4 ? 512 : 2048;
#pragma unroll
    for (int ks = 0; ks < 4; ++ks) gl16(R.fa[ks], ap_ + kst * ks);
    const bf16* up = (const bf16*)(ws + WS_PUT) + pu * 8192 + ((s * 4 + rt) * 2) * 512 + ln8;
    const bf16* ap = (const bf16*)(ws + WS_PATT) + pu * 4096 + (rt * 2) * 512 + ln8;
    const bf16* xp = w < 4 ? up : ap; const int xo = 512;
    gl16(R.fx[0], xp); gl16(R.fx[1], xp + xo);
}
__device__ __forceinline__ void scan_step(ScanRegs& R, f32x4 (&S)[4], LAS bf16* ST, LAS bf16* vnT, LAS bf16* oT, LAS bf16* oDump, int w, int l15, int l4, unsigned& g_p2) {
    const int rt = w & 3;
#ifdef PROBE_SCAN2
    const unsigned tw0_ = (unsigned)__builtin_amdgcn_s_memrealtime();
#endif
    asm volatile("s_waitcnt vmcnt(20)" : "+v"(R.fa[0]), "+v"(R.fa[1]), "+v"(R.fa[2]), "+v"(R.fa[3]), "+v"(R.fx[0]), "+v"(R.fx[1]), "+v"(R.kf[0]), "+v"(R.kf[1]), "+v"(R.graw), "+v"(R.glast) :: "memory");
#ifdef PROBE_SCAN2
    const unsigned tw1_ = (unsigned)__builtin_amdgcn_s_memrealtime(); if (PROBE_SCAN2 == 1) g_p2 += tw1_ - tw0_;
#endif
    const float gend = __expf(R.glast);
    const bool hiw = w >= 4;
    const f32x4 eg = {hiw ? __expf(R.graw.x) : 1.0f, hiw ? __expf(R.graw.y) : 1.0f, hiw ? __expf(R.graw.z) : 1.0f, hiw ? __expf(R.graw.w) : 1.0f};
    f32x4 c[4];
#pragma unroll
    for (int ct = 0; ct < 4; ++ct) { c[ct] = (f32x4){0.f, 0.f, 0.f, 0.f};
#pragma unroll
        for (int ks = 0; ks < 4; ++ks) { const bf16x8_t bq = *(const LAS bf16x8_t*)(ST + (16 * ct + l15) * 136 + 32 * ks + 8 * l4); c[ct] = MFMA16(R.fa[ks], bq, c[ct]); }
        c[ct] = c[ct] * eg; }
    {
        const v4u ua = __builtin_bit_cast(v4u, R.fx[0]), ub = __builtin_bit_cast(v4u, R.fx[1]);
        const f32x4 u0 = {bflo(ua.x), bfhi(ua.x), bflo(ua.y), bfhi(ua.y)}, u1 = {bflo(ua.z), bfhi(ua.z), bflo(ua.w), bfhi(ua.w)};
        const f32x4 u2 = {bflo(ub.x), bfhi(ub.x), bflo(ub.y), bfhi(ub.y)}, u3 = {bflo(ub.z), bfhi(ub.z), bflo(ub.w), bfhi(ub.w)};
        if (w < 4) { LAS bf16* vp = vnT + l15 * 72 + 16 * rt + 4 * l4;
            *(LAS v2u*)(vp) = pack4(u0 - c[0]); *(LAS v2u*)(vp + 16 * 72) = pack4(u1 - c[1]); *(LAS v2u*)(vp + 32 * 72) = pack4(u2 - c[2]); *(LAS v2u*)(vp + 48 * 72) = pack4(u3 - c[3]); }
    }
    __syncthreads();
    {
        LAS bf16* op = (w < 4 ? oDump : oT) + (16 * rt + 4 * l4) * 72 + l15;
#pragma unroll
        for (int ct = 0; ct < 4; ++ct) { const bf16x8_t v0 = *(const LAS bf16x8_t*)(vnT + (16 * ct + l15) * 72 + 8 * l4), v1 = *(const LAS bf16x8_t*)(vnT + (16 * ct + l15) * 72 + 32 + 8 * l4);
            if (w >= 4) { f32x4 o = MFMA16(R.fx[0], v0, c[ct]); o = MFMA16(R.fx[1], v1, o);
#pragma unroll
                for (int r = 0; r < 4; ++r) op[r * 72 + 16 * ct] = (bf16)f2bf(o[r]); }
            f32x4 sn = S[ct] * gend; sn = MFMA16(R.kf[0], v0, sn); sn = MFMA16(R.kf[1], v1, sn); S[ct] = sn;
            *(LAS v2u*)(ST + (16 * ct + l15) * 136 + 16 * w + 4 * l4) = pack4(sn); }
    }
    __syncthreads();
#ifdef PROBE_SCAN2
    if (PROBE_SCAN2 == 2) g_p2 += (unsigned)__builtin_amdgcn_s_memrealtime() - tw1_;
#endif
}
__device__ __forceinline__ void scan_flush(LAS bf16* oS, int ci0, int n, bf16* od, bf16* dump, bool skip_ctx_out, int b, int d, int h, int s, int tid) {
    const int i = tid >> 3, pc = tid & 7;
    for (int k = 0; k < n; ++k) { const int cn = scan_cn(ci0 + k, d), rowbase = chunk_rowbase(b, cn);
        const v4u ov = *(const LAS v4u*)(oS + k * 64 * 72 + i * 72 + pc * 8);
        const bool real = !(cn < 4 && skip_ctx_out);
        bf16* gp = real ? od + (size_t)(rowbase + i) * 512 + h * 128 + 64 * s + pc * 8 : dump + (size_t)i * 64 + pc * 8;
        *(v4u*)gp = ov; }
    asm volatile("s_waitcnt vmcnt(0)" ::: "memory");
    __syncthreads();
}
__device__ __forceinline__ void scan_mfma(const Frame& F, int l) {
    LAS bf16* ST = (LAS bf16*)F.lds;
    LAS bf16* vnT = ST + 64 * 136;
    LAS bf16* oS = vnT + 2 * 64 * 72;
    LAS bf16* oDump = oS + 6 * 64 * 72;
    const int lane = F.lane, l15 = lane & 15, l4 = lane >> 4, w = F.wave;
    const bool skip_ctx_out = (l == NL - 1);
    if (w >= 4) __builtin_amdgcn_s_setprio(1);
    for (int unit = F.vcu; unit < 128; unit += F.G) {
        const int s = unit & 1, sd = unit >> 1, d = sd & 1, bh = sd >> 1, b = bh >> 2, h = bh & 3;
        bf16* od = (bf16*)(F.ws + (d ? WS_OB : WS_OF)); bf16* dump = (bf16*)(F.ws + WS_PGAM + 1536 * 1024) + (size_t)unit * 16 * 512;
        asm volatile("s_waitcnt vmcnt(0)" ::: "memory");
        __syncthreads();
        for (int i = F.tid; i < 64 * 136 / 2; i += NTHR) ((LAS unsigned*)ST)[i] = 0u;
        f32x4 S[4];
#pragma unroll
        for (int ct = 0; ct < 4; ++ct) S[ct] = (f32x4){0.f, 0.f, 0.f, 0.f};
        ScanRegs R0, R1, R2; unsigned g_p2 = 0u;
        scan_load(R0, F.ws, 0, b, bh, h, d, s, w, l15, l4); scan_load(R1, F.ws, 1, b, bh, h, d, s, w, l15, l4); scan_load(R2, F.ws, 2, b, bh, h, d, s, w, l15, l4);
        __syncthreads();
#pragma unroll 1
        for (int ci = 0; ci < 66; ci += 6) {
            scan_step(R0, S, ST, vnT, oS + 0 * 64 * 72, oDump, w, l15, l4, g_p2); scan_load(R0, F.ws, ci + 3, b, bh, h, d, s, w, l15, l4);
            scan_step(R1, S, ST, vnT, oS + 1 * 64 * 72, oDump, w, l15, l4, g_p2); scan_load(R1, F.ws, ci + 4, b, bh, h, d, s, w, l15, l4);
            scan_step(R2, S, ST, vnT, oS + 2 * 64 * 72, oDump, w, l15, l4, g_p2); scan_load(R2, F.ws, ci + 5, b, bh, h, d, s, w, l15, l4);
            scan_step(R0, S, ST, vnT, oS + 3 * 64 * 72, oDump, w, l15, l4, g_p2); scan_load(R0, F.ws, ci + 6, b, bh, h, d, s, w, l15, l4);
            scan_step(R1, S, ST, vnT, oS + 4 * 64 * 72, oDump, w, l15, l4, g_p2); scan_load(R1, F.ws, ci + 7, b, bh, h, d, s, w, l15, l4);
            scan_step(R2, S, ST, vnT, oS + 5 * 64 * 72, oDump, w, l15, l4, g_p2); scan_load(R2, F.ws, ci + 8, b, bh, h, d, s, w, l15, l4);
            scan_flush(oS, ci, 6, od, dump, skip_ctx_out, b, d, h, s, F.tid);
        }
        scan_step(R0, S, ST, vnT, oS + 0 * 64 * 72, oDump, w, l15, l4, g_p2);
        scan_step(R1, S, ST, vnT, oS + 1 * 64 * 72, oDump, w, l15, l4, g_p2);
        scan_flush(oS, 66, 2, od, dump, skip_ctx_out, b, d, h, s, F.tid);
#ifdef PROBE_SCAN2
        if (F.vcu == 0 && F.tid == PROBE_TID) *(unsigned long long*)(F.ws + WS_ZN + 48 * 1024) += g_p2;
#endif
    }
    __builtin_amdgcn_s_setprio(0);
}

#ifndef USE_NAIVE_SCAN
#define USE_NAIVE_SCAN 0
#endif
#ifndef REP_MASK
#define REP_MASK 0
#endif
#define REPS(p) for (int _r = 0; _r < 1 + ((REP_MASK >> (p)) & 1); ++_r)
#define LASTREP(p) (_r == ((REP_MASK >> (p)) & 1))
constexpr int PH_PER_LAYER = 11, N_PHASES = 2 + NL * PH_PER_LAYER;
#ifndef PG8_SP2
#define PG8_SP2 true
#endif
#ifndef PG8_ALIGN
#define PG8_ALIGN true
#endif
__device__ __forceinline__ Frame make_frame(int wv) {
    extern __shared__ __attribute__((aligned(16))) unsigned char lds[];
    const KArgsP A = kargs();
    Frame F;
    { unsigned lb = (unsigned)(uintptr_t)(LAS unsigned char*)lds; asm volatile("" : "+s"(lb)); F.lds = (LAS unsigned char*)(uintptr_t)lb; }
    F.MISC = (volatile LAS unsigned*)(F.lds + MISC_OFF);
    { unsigned m1 = ~0u; asm volatile("" : "+s"(m1)); int ln = (int)__builtin_amdgcn_mbcnt_hi(m1, __builtin_amdgcn_mbcnt_lo(m1, 0u)); asm volatile("" : "+v"(ln)); F.lane = ln; }
    { int w_ = wv; asm volatile("" : "+s"(w_)); F.wave = w_; } F.tid = F.wave * 64 + F.lane;
    F.G = gridDim.x; { const int bx = blockIdx.x; F.vcu = (F.G % 8 == 0) ? (bx % 8) * (F.G / 8) + bx / 8 : bx; }
    F.gw = F.vcu * NWAVES + F.wave; F.NGW = F.G * NWAVES;
    F.ws = A->ws; F.ctl = (unsigned*)(A->ws + WS_CTL); F.out = A->out;
    return F;
}
__global__ void __launch_bounds__(NTHR, 2) mk_fwd(Args args) {
    const int wv = __builtin_amdgcn_readfirstlane((int)threadIdx.x >> 6);
    { Frame F = make_frame(wv);
      for (int u = F.tid; u < (LDS_BYTES - LDSCTL_OFF) / 4; u += NTHR) ((LAS unsigned*)(F.lds + LDSCTL_OFF))[u] = 0u;
      __syncthreads(); }
    const int lo = args.ph_lo, hi = args.ph_hi;
#if defined(PROBE_SCAN) || defined(PROBE_ROUTER) || defined(PROBE_PREP) || defined(PROBE_SCAN2)
    { Frame Fp = make_frame(wv); if (Fp.vcu == 0 && Fp.tid == 0) *(unsigned long long*)(Fp.ws + WS_ZN + 48 * 1024) = 0ull; }
#endif
#ifdef PROBE_P
    unsigned long long pr_acc = 0ull, pr_t0 = 0ull;
#define PR_BEGIN(p) do { if (((p) < 2 ? (p) : 2 + ((p) - 2) % PH_PER_LAYER) == PROBE_P) pr_t0 = __builtin_amdgcn_s_memrealtime(); } while (0)
#define PR_END(p) do { if (((p) < 2 ? (p) : 2 + ((p) - 2) % PH_PER_LAYER) == PROBE_P) pr_acc += __builtin_amdgcn_s_memrealtime() - pr_t0; } while (0)
#else
#define PR_BEGIN(p) do {} while (0)
#define PR_END(p) do {} while (0)
#endif
    if (hi - lo > 1) { Frame F = make_frame(wv); (void)xcd_barrier_post((unsigned*)(F.ctl + CW_BAR), F.MISC + 8, F.tid); }
#define IN(k) (lo <= (k) && (k) < hi)
#define SEAM(k) do { if (IN(k) && IN((k) + 1)) { Frame Fb = make_frame(wv); XcdBarrier bar; bar.bar = (unsigned*)(Fb.ctl + CW_BAR); bar.x = xb_xcc_id(); bar.st = Fb.MISC + 8; xcd_barrier(bar, Fb.tid); } } while (0)
    PR_BEGIN(0); if (IN(0)) { Frame F = make_frame(wv); REPS(0) { p0_prologue(F); __syncthreads(); } }
    SEAM(0); PR_END(0);
    PR_BEGIN(1); if (IN(1)) { Frame F = make_frame(wv); REPS(1) { row_pass<0>(F, 0, 0); __syncthreads(); } }
    SEAM(1); PR_END(1);
#define LAYER_BODY(l) { \
        const int pb = 2 + l * PH_PER_LAYER; \
        PR_BEGIN(pb + 0); if (IN(pb + 0)) { Frame F = make_frame(wv); \
            SchedIn S{(const bf16*)(F.ws + WS_ACT), (const bf16*)(F.ws + WS_WIN) + (size_t)l * 3072 * D, F.G, (int)blockIdx.x}; \
            EpiIn E{(bf16*)(F.ws + WS_QKVZ), (bf16*)(F.ws + WS_ZTL), (bf16*)(F.ws + WS_ZTC)}; \
            REPS(8) { pg8::gemm_phase<EpiIn, SchedIn, PG8_ALIGN, PG8_SP2>(F.lds, pg8::Gemm{D}, S, E, F.tid); __syncthreads(); } } \
        SEAM(pb + 0); PR_END(pb + 0); \
        PR_BEGIN(pb + 1); if (IN(pb + 1)) { Frame F = make_frame(wv); REPS(2) { conv_phase(F, l); __syncthreads(); } fold_phase(F); } \
        SEAM(pb + 1); PR_END(pb + 1); \
        PR_BEGIN(pb + 2); if (IN(pb + 2)) { \
            { Frame F = make_frame(wv); REPS(3) { prep_phase(F); } } \
        } \
        SEAM(pb + 2); PR_END(pb + 2); \
        PR_BEGIN(pb + 3); if (IN(pb + 3)) { Frame F = make_frame(wv); \
            if (F.vcu < 128) { REPS(4) { scan_mfma(F, l); __syncthreads(); } } \
            else { \
              SchedDft S{(const bf16*)(F.ws + WS_DFTM), (const bf16*)(F.ws + WS_EO), F.vcu - 128}; \
              EpiDft E{(bf16*)(F.ws + WS_AB2)}; \
              REPS(9) { pg8::gemm_phase<EpiDft, SchedDft, PG8_ALIGN, PG8_SP2>(F.lds, pg8::Gemm{2048}, S, E, F.tid); __syncthreads(); } \
              if (l == 0) ctx_dft(F); \
              __syncthreads(); convert_experts(F, l, CVT_SPLIT, CVT_ITEMS, (F.vcu - 128) * NWAVES + F.wave, 128 * NWAVES); } \
        } \
        SEAM(pb + 3); PR_END(pb + 3); \
        PR_BEGIN(pb + 4); if (IN(pb + 4)) { Frame F = make_frame(wv); REPS(5) { gated_out(F, l); __syncthreads(); } } \
        SEAM(pb + 4); PR_END(pb + 4); \
        PR_BEGIN(pb + 5); if (IN(pb + 5)) { Frame F = make_frame(wv); \
            SchedOut S{(const bf16*)(F.ws + WS_ACT), (const bf16*)(F.ws + WS_WOUT) + (size_t)l * D * D, l == NL - 1 ? NLAT / 256 : MT / 256, F.G, (int)blockIdx.x}; \
            REPS(10) { EpiOut E{F.out, (float*)(F.ws + WS_XC), l == 0 ? kargs()->in[I_X] : (const float*)F.out, l == 0 ? kargs()->in[I_CTX] : (const float*)(F.ws + WS_XC), modv(F, l, 0, 2), LASTREP(10) ? 1.0f : 0.0f}; \
                pg8::gemm_phase<EpiOut, SchedOut, PG8_ALIGN, PG8_SP2>(F.lds, pg8::Gemm{D}, S, E, F.tid); __syncthreads(); } } \
        SEAM(pb + 5); PR_END(pb + 5); \
        PR_BEGIN(pb + 6); if (IN(pb + 6)) { Frame F = make_frame(wv); REPS(6) { router_phase(F, l, LASTREP(6) ? 0 : 1); __syncthreads(); } } \
        SEAM(pb + 6); PR_END(pb + 6); \
        PR_BEGIN(pb + 7); if (IN(pb + 7)) { Frame F = make_frame(wv); REPS(7) { gather_phase(F, l, !LASTREP(7)); __syncthreads(); } } \
        SEAM(pb + 7); PR_END(pb + 7); \
        PR_BEGIN(pb + 8); if (IN(pb + 8)) { Frame F = make_frame(wv); \
            LAS int* pend = (LAS int*)(F.lds + XT_OFF); moe_layout(F, l, pend, pend + 32); \
            SchedMoe S{(const bf16*)(F.ws + WS_ACT), (const bf16*)(F.ws + WS_W1), (size_t)2048 * D * 2, pend, pend[NEXP - 1], 8, F.G, (int)blockIdx.x, 1}; \
            EpiSwiglu E{(bf16*)(F.ws + WS_HS), kargs()->in[I_BG] + (size_t)l * NEXP * D, kargs()->in[I_BU] + (size_t)l * NEXP * D}; \
            REPS(11) { pg8::gemm_phase<EpiSwiglu, SchedMoe, PG8_ALIGN, PG8_SP2, true>(F.lds, pg8::Gemm{D}, S, E, F.tid, (const unsigned*)(F.ws + WS_GOFF), F.lds + XT_OFF + 1024, (unsigned)MT * 2048u); __syncthreads(); } } \
        SEAM(pb + 8); PR_END(pb + 8); \
        PR_BEGIN(pb + 9); if (IN(pb + 9)) { Frame F = make_frame(wv); \
            LAS int* pend = (LAS int*)(F.lds + XT_OFF); moe_layout(F, l, pend, pend + 32); \
            SchedMoe S{(const bf16*)(F.ws + WS_HS), (const bf16*)(F.ws + WS_W2), (size_t)D * D * 2, pend, pend[NEXP - 1], 4, F.G, (int)blockIdx.x, 0}; \
            EpiDown E{(bf16*)(F.ws + WS_XS), kargs()->in[I_BD] + (size_t)l * NEXP * D}; \
            REPS(12) { pg8::gemm_phase<EpiDown, SchedMoe, PG8_ALIGN, PG8_SP2>(F.lds, pg8::Gemm{D}, S, E, F.tid); __syncthreads(); } } \
        SEAM(pb + 9); PR_END(pb + 9); \
        PR_BEGIN(pb + 10); if (IN(pb + 10)) { \
            { Frame F = make_frame(wv); \
              if (l == NL - 1) row_pass<2>(F, l, l); else { REPS(13) { row_pass<1>(F, l, l + 1, !LASTREP(13)); __syncthreads(); } } } \
            if (l != NL - 1) { Frame F = make_frame(wv); __syncthreads(); REPS(14) { convert_experts(F, l + 1, 0, CVT_SPLIT, F.gw, F.NGW); __syncthreads(); } } \
        } \
        if (l + 1 < NL) SEAM(pb + 10); PR_END(pb + 10); \
    }
    LAYER_BODY(0)
    LAYER_BODY(1)
#undef LAYER_BODY
#ifdef PROBE_P
#if defined(PROBE_SCAN) || defined(PROBE_ROUTER) || defined(PROBE_PREP) || defined(PROBE_SCAN2)
    { Frame Fp = make_frame(wv); if (Fp.vcu == 0 && Fp.tid == 0) pr_acc = *(unsigned long long*)(Fp.ws + WS_ZN + 48 * 1024); else pr_acc = 0; }
#endif
    if (blockIdx.x == 0 && threadIdx.x == 0) { const unsigned long long t0 = __builtin_amdgcn_s_memrealtime(), want = pr_acc * PROBE_SCALE; while (__builtin_amdgcn_s_memrealtime() - t0 < want) __builtin_amdgcn_s_sleep(8); }
#endif
#undef IN
#undef SEAM
}

extern "C" void kernel_launch(void* const* d_in, const int* in_sizes, int n_in, void* d_out, int out_size, void* d_ws, size_t ws_size, hipStream_t stream) {
    static int grid = 0;
    if (grid == 0) {
        if (n_in != 23 || out_size != NLAT * D || ws_size < WS_END) { fprintf(stderr, "kernel_launch: unexpected shapes (n_in %d, out %d, ws %zu); nothing launched\n", n_in, out_size, ws_size); grid = -1; return; }
        int dev = 0, cus = 0, per_cu = 0;
        if (hipGetDevice(&dev) != hipSuccess || hipDeviceGetAttribute(&cus, hipDeviceAttributeMultiprocessorCount, dev) != hipSuccess) { grid = -1; return; }
        if (hipFuncSetAttribute((const void*)mk_fwd, hipFuncAttributeMaxDynamicSharedMemorySize, LDS_BYTES) != hipSuccess) { fprintf(stderr, "kernel_launch: hipFuncSetAttribute failed\n"); grid = -1; return; }
        if (hipOccupancyMaxActiveBlocksPerMultiprocessor(&per_cu, (const void*)mk_fwd, NTHR, LDS_BYTES) != hipSuccess || per_cu < 1)
            fprintf(stderr, "kernel_launch: note: occupancy query reports %d workgroups per CU\n", per_cu);
        (void)hipGetLastError();
        grid = cus;
        if (grid != 256) { fprintf(stderr, "kernel_launch: built for 256 CUs, found %d; nothing launched\n", grid); grid = -1; return; }
    }
    if (grid < 0) return;
    if (hipMemsetAsync((char*)d_ws + WS_CTL, 0, CTL_ZERO_BYTES, stream) != hipSuccess) { fprintf(stderr, "kernel_launch: hipMemsetAsync failed\n"); return; }
    Args a{};
    for (int i = 0; i < 23; ++i) a.in[i] = (const float*)d_in[i];
    a.out = (float*)d_out; a.ws = (unsigned char*)d_ws;
#if MK_ONE_LAUNCH
    a.ph_lo = 0; a.ph_hi = N_PHASES;
    hipLaunchKernelGGL(mk_fwd, dim3(grid), dim3(NTHR), LDS_BYTES, stream, a);
#else
    for (int p = 0; p < N_PHASES; ++p) { a.ph_lo = p; a.ph_hi = p + 1; hipLaunchKernelGGL(mk_fwd, dim3(grid), dim3(NTHR), LDS_BYTES, stream, a); }
#endif
    const hipError_t le = hipPeekAtLastError();
    if (le != hipSuccess) fprintf(stderr, "kernel_launch: launch failed: %s\n", hipGetErrorName(le));
}
```

```cpp
#define MK_ONE_LAUNCH 1
#include <hip/hip_runtime.h>
#include <cstdio>
#include <cstdint>

#ifndef MK_ONE_LAUNCH
#define MK_ONE_LAUNCH 1
#endif

namespace pg8 {
#define PG8_LAS __attribute__((address_space(3)))
typedef unsigned short bf16_t;
typedef short bf16x8 __attribute__((ext_vector_type(8)));
typedef float f32x4 __attribute__((ext_vector_type(4)));
typedef unsigned u32x4 __attribute__((ext_vector_type(4)));
constexpr int BM = 256, BK = 64, HALF = 128, HTB = HALF * BK * 2  , STAGE_BYTES = 8 * HTB, NXCD = 8, WGM = 8;

__host__ __device__ __forceinline__ int lds_byte(int r, int c) { const int st = (r >> 4) * 2 + (c >> 5), rr = r & 15, cc = c & 31, ob = rr * 64 + cc * 2; return st * 1024 + (ob ^ (((ob >> 9) & 1) << 5)); }
__host__ __device__ __forceinline__ void stage_rc(int b, int& R, int& C) { const int st = b / 1024, sb = b % 1024, swz = sb ^ (((sb >> 9) & 1) << 5); R = (st >> 1) * 16 + swz / 64; C = (st & 1) * 32 + (swz % 64) / 2; }
__host__ __device__ __forceinline__ int perm32(int rho) { const int n = rho >> 4, i = rho & 15; return 8 * (i >> 2) + 4 * n + (i & 3); }

struct Unit { int pm, pn, kind, e; };
struct Gemm { int K; };

__device__ __forceinline__ int xcd_remap(int L, int nwg) { const int q = nwg / NXCD, r = nwg % NXCD, xcd = L % NXCD, off = L / NXCD; return (xcd < r ? xcd * (q + 1) : r * (q + 1) + (xcd - r) * q) + off; }
__device__ __forceinline__ void grp_decode(int wgid, int nM, int nN, int& pm, int& pn) { const int nig = WGM * nN, gid = wgid / nig, fm = gid * WGM, gsz = (nM - fm) < WGM ? (nM - fm) : WGM; pm = fm + ((wgid % nig) % gsz); pn = (wgid % nig) / gsz; }

__device__ __forceinline__ const char* uni_ptr(const char* p) { const unsigned long long v = (unsigned long long)p; const unsigned lo = __builtin_amdgcn_readfirstlane((unsigned)v), hi = __builtin_amdgcn_readfirstlane((unsigned)(v >> 32)); return (const char*)(((unsigned long long)hi << 32) | lo); }
__device__ __forceinline__ unsigned cvt_pk_bf16(float lo, float hi) { unsigned r; asm volatile("v_cvt_pk_bf16_f32 %0, %1, %2" : "=v"(r) : "v"(lo), "v"(hi)); return r; }

template <class Epi, class Sched, bool ALIGN_EPI = false, bool SP2 = false, bool GATHER = false>
__device__ __forceinline__ void gemm_phase(PG8_LAS unsigned char* lds, const Gemm g, const Sched& S, const Epi& E, int tid_in, const unsigned* gtab = nullptr, PG8_LAS unsigned char* gl_tab = nullptr, unsigned glim = 0u) {
    static_assert(!GATHER || SP2, "GATHER is written for the SP2 loop");
    int tid_ = tid_in; asm volatile("" : "+v"(tid_));
    const int tid = tid_, wid = __builtin_amdgcn_readfirstlane(tid >> 6), lane = tid & 63, wr = wid >> 2, wc = wid & 3, fr = lane & 15, fq = lane >> 4;
    const int K = g.K, nt = K / BK;
    unsigned voffA[2], voffB[2];
#pragma unroll
    for (int i = 0; i < 2; ++i) { int R, C; stage_rc(tid * 16 + i * 8192, R, C); const int Rb = Epi::PERM ? ((R & ~31) + perm32(R & 31)) : R;
        voffA[i] = (unsigned)(R * K + C) * 2u; voffB[i] = (unsigned)(Rb * K + C) * 2u; }
    const size_t kstep = (size_t)(BK * 2);
    const size_t hstep = (size_t)HALF * K * 2;
    const size_t tstep = 2 * hstep;
    const unsigned ldsw = (unsigned)wid * 1024u;
    const int aoff = lds_byte(wr * 64 + fr, fq * 8), boff = lds_byte(wc * 32 + fr, fq * 8);
#define PG8_SA(b, h) (((b) * 2 + (h)) * HTB)
#define PG8_SB(b, h) ((4 + (b) * 2 + (h)) * HTB)
#define PG8_STAGE(bufoff, gbase, voff) do { _Pragma("unroll") for (int _i = 0; _i < 2; ++_i) \
        __builtin_amdgcn_global_load_lds((const unsigned*)((const char*)(gbase) + (voff)[_i]), (PG8_LAS unsigned*)(lds + (bufoff) + ldsw + _i * 8192), 16, 0, 0); } while (0)
#define PG8_STAGE_G(bufoff, gbase, G, H) do { _Pragma("unroll") for (int _i = 0; _i < 2; ++_i) \
        __builtin_amdgcn_global_load_lds((const unsigned*)((const char*)(gbase) + (G)[H][_i]), (PG8_LAS unsigned*)(lds + (bufoff) + ldsw + _i * 8192), 16, 0, 0); } while (0)
#define PG8_STAGE_A(bufoff, gbase, G, H) do { if constexpr (GATHER) PG8_STAGE_G(bufoff, gbase, G, H); else PG8_STAGE(bufoff, (gbase) + (H) * hstep, voffA); } while (0)
#define PG8_TAB_ISSUE(u_) __builtin_amdgcn_global_load_lds(gtab + ((size_t)(u_).kind * 512 + tid) * 4, (PG8_LAS unsigned*)(gl_tab + wid * 1024), 16, 0, 0)
#define PG8_TAB_READ(G) do { const u32x4 gv_ = *(const PG8_LAS u32x4*)(gl_tab + tid * 16); G[0][0] = gv_.x < glim ? gv_.x : 0u; G[0][1] = gv_.y < glim ? gv_.y : 0u; G[1][0] = gv_.z < glim ? gv_.z : 0u; G[1][1] = gv_.w < glim ? gv_.w : 0u; } while (0)
#define PG8_LDA(dst, b, h) do { _Pragma("unroll") for (int m = 0; m < 4; ++m) _Pragma("unroll") for (int k = 0; k < 2; ++k) dst[m][k] = *(const PG8_LAS bf16x8*)(lds + PG8_SA(b, h) + aoff + m * 2048 + k * 1024); } while (0)
#define PG8_LDB(dst, b, h) do { _Pragma("unroll") for (int n = 0; n < 2; ++n) _Pragma("unroll") for (int k = 0; k < 2; ++k) dst[n][k] = *(const PG8_LAS bf16x8*)(lds + PG8_SB(b, h) + boff + n * 2048 + k * 1024); } while (0)
#define PG8_MMA(ai, bj, At, Bt) do { __builtin_amdgcn_s_setprio(1); _Pragma("unroll") for (int m = 0; m < 4; ++m) _Pragma("unroll") for (int n = 0; n < 2; ++n) _Pragma("unroll") for (int k = 0; k < 2; ++k) \
        acc[ai][bj][m][n] = __builtin_amdgcn_mfma_f32_16x16x32_bf16(Bt[n][k], At[m][k], acc[ai][bj][m][n], 0, 0, 0); __builtin_amdgcn_s_setprio(0); } while (0)
#define PG8_WAIT_V(n) asm volatile("s_waitcnt vmcnt(" #n ")" ::: "memory")
#define PG8_WAIT_L(n) asm volatile("s_waitcnt lgkmcnt(" #n ")" ::: "memory")
#define PG8_BAR __builtin_amdgcn_s_barrier()
#define PG8_SCHED __builtin_amdgcn_sched_barrier(0)
    Unit cur, nxt; int ui = 0;
    if (!S.next(0, cur)) return;
    f32x4 acc[2][2][4][2];
#pragma unroll
    for (int a = 0; a < 2; ++a)
#pragma unroll
        for (int b = 0; b < 2; ++b)
#pragma unroll
            for (int m = 0; m < 4; ++m)
#pragma unroll
                for (int n = 0; n < 2; ++n) acc[a][b][m][n] = (f32x4){0.f, 0.f, 0.f, 0.f};
    bf16x8 At[4][2], B0[2][2], B1[2][2];
    const char* cA = uni_ptr(S.a_base(cur, tstep)); const char* cB = uni_ptr(S.b_base(cur, tstep));
    S.a_ready(cur);
    unsigned gC[2][2] = {{0u, 0u}, {0u, 0u}}, gN[2][2] = {{0u, 0u}, {0u, 0u}};
    if constexpr (GATHER) { PG8_TAB_ISSUE(cur); asm volatile("s_waitcnt vmcnt(0)" ::: "memory"); __builtin_amdgcn_s_barrier(); asm volatile("" ::: "memory"); PG8_TAB_READ(gC); }
    if constexpr (SP2) {
        PG8_STAGE(PG8_SB(0, 0), cB, voffB); PG8_STAGE(PG8_SB(0, 1), cB + hstep, voffB); PG8_STAGE_A(PG8_SA(0, 0), cA, gC, 0); PG8_STAGE_A(PG8_SA(0, 1), cA, gC, 1);
        if (wr == 1) PG8_BAR;
        PG8_WAIT_V(2); PG8_BAR;
        PG8_STAGE(PG8_SB(1, 0), cB + kstep, voffB); PG8_STAGE_A(PG8_SA(1, 0), cA + kstep, gC, 0); PG8_STAGE(PG8_SB(1, 1), cB + hstep + kstep, voffB);
        PG8_WAIT_V(6); PG8_BAR;
    } else {
        PG8_STAGE(PG8_SB(0, 0), cB, voffB); PG8_STAGE(PG8_SA(0, 0), cA, voffA); PG8_STAGE(PG8_SB(0, 1), cB + hstep, voffB); PG8_STAGE(PG8_SA(0, 1), cA + hstep, voffA);
        if (wr == 1) PG8_BAR;
        PG8_WAIT_V(4); PG8_BAR;
        PG8_STAGE(PG8_SB(1, 0), cB + kstep, voffB); PG8_STAGE(PG8_SA(1, 0), cA + kstep, voffA); PG8_STAGE(PG8_SB(1, 1), cB + hstep + kstep, voffB);
        PG8_WAIT_V(6); PG8_BAR;
    }
    for (;;) {
        const bool has_next = S.next(ui + 1, nxt);
        const char* nA = uni_ptr(has_next ? S.a_base(nxt, tstep) : cA); const char* nB = uni_ptr(has_next ? S.b_base(nxt, tstep) : cB);
        for (int t = 0; t < nt; t += 2) {
            const bool last = (t == nt - 2);
            const char* a1 = cA + (size_t)(t + 1) * kstep;
            const char* a2 = last ? nA : cA + (size_t)(t + 2) * kstep; const char* b2 = last ? nB : cB + (size_t)(t + 2) * kstep;
            const char* a3 = a2 + kstep; const char* b3 = b2 + kstep;
            if (last && has_next) S.a_ready(nxt);
            unsigned g2[2][2] = {{gC[0][0], gC[0][1]}, {gC[1][0], gC[1][1]}};
            if constexpr (GATHER) {
                if (t == nt - 4 && has_next) PG8_TAB_ISSUE(nxt);
                if (last && has_next) { PG8_TAB_READ(gN); g2[0][0] = gN[0][0]; g2[0][1] = gN[0][1]; g2[1][0] = gN[1][0]; g2[1][1] = gN[1][1]; }
            }
            if constexpr (SP2) {
            PG8_LDB(B0, 0, 0); PG8_LDB(B1, 0, 1); PG8_SCHED; PG8_LDA(At, 0, 0); PG8_STAGE_A(PG8_SA(1, 1), a1, gC, 1);
            PG8_WAIT_V(8); PG8_WAIT_L(0); PG8_BAR; PG8_MMA(0, 0, At, B0); PG8_MMA(0, 1, At, B1); PG8_BAR; PG8_SCHED;
            PG8_LDA(At, 0, 1); PG8_STAGE(PG8_SB(0, 0), b2, voffB); PG8_STAGE(PG8_SB(0, 1), b2 + hstep, voffB); PG8_STAGE_A(PG8_SA(0, 0), a2, g2, 0);
            PG8_WAIT_V(8); PG8_WAIT_L(0); PG8_BAR; PG8_MMA(1, 0, At, B0); PG8_MMA(1, 1, At, B1); PG8_BAR; PG8_SCHED;
            PG8_LDB(B0, 1, 0); PG8_LDB(B1, 1, 1); PG8_SCHED; PG8_LDA(At, 1, 0); PG8_STAGE_A(PG8_SA(0, 1), a2, g2, 1);
            PG8_WAIT_V(8); PG8_WAIT_L(0); PG8_BAR; PG8_MMA(0, 0, At, B0); PG8_MMA(0, 1, At, B1); PG8_BAR; PG8_SCHED;
            PG8_LDA(At, 1, 1); PG8_STAGE(PG8_SB(1, 0), b3, voffB); PG8_STAGE(PG8_SB(1, 1), b3 + hstep, voffB); PG8_STAGE_A(PG8_SA(1, 0), a3, g2, 0);
            PG8_WAIT_V(8); PG8_WAIT_L(0); PG8_BAR; PG8_MMA(1, 0, At, B0); PG8_MMA(1, 1, At, B1); PG8_BAR; PG8_SCHED;
            } else {
            PG8_LDB(B0, 0, 0); PG8_SCHED; PG8_LDA(At, 0, 0); PG8_STAGE(PG8_SA(1, 1), a1 + hstep, voffA);
            PG8_WAIT_L(8); PG8_BAR; PG8_WAIT_L(0); PG8_MMA(0, 0, At, B0); PG8_BAR; PG8_SCHED;
            PG8_LDB(B1, 0, 1); PG8_STAGE(PG8_SB(0, 0), b2, voffB);
            PG8_BAR; PG8_WAIT_L(0); PG8_MMA(0, 1, At, B1); PG8_BAR;
            PG8_LDA(At, 0, 1); PG8_STAGE(PG8_SA(0, 0), a2, voffA);
            PG8_BAR; PG8_WAIT_L(0); PG8_MMA(1, 0, At, B0); PG8_BAR; PG8_SCHED;
            PG8_STAGE(PG8_SB(0, 1), b2 + hstep, voffB);
            PG8_WAIT_V(6); PG8_BAR; PG8_MMA(1, 1, At, B1); PG8_BAR;
            PG8_LDB(B0, 1, 0); PG8_SCHED; PG8_LDA(At, 1, 0); PG8_STAGE(PG8_SA(0, 1), a2 + hstep, voffA);
            PG8_WAIT_L(8); PG8_BAR; PG8_WAIT_L(0); PG8_MMA(0, 0, At, B0); PG8_BAR; PG8_SCHED;
            PG8_LDB(B1, 1, 1); PG8_STAGE(PG8_SB(1, 0), b3, voffB);
            PG8_BAR; PG8_WAIT_L(0); PG8_MMA(0, 1, At, B1); PG8_BAR;
            PG8_LDA(At, 1, 1); PG8_STAGE(PG8_SA(1, 0), a3, voffA);
            PG8_BAR; PG8_WAIT_L(0); PG8_MMA(1, 0, At, B0); PG8_BAR; PG8_SCHED;
            PG8_STAGE(PG8_SB(1, 1), b3 + hstep, voffB);
            PG8_WAIT_V(6); PG8_BAR; PG8_MMA(1, 1, At, B1); PG8_BAR;
            }
        }
        if constexpr (ALIGN_EPI) { if (wr == 0) PG8_BAR; }
        if constexpr (!Epi::AFTER_DRAIN) { E(acc, cur, wr, wc, fr, fq); S.done(cur); }
        if (!has_next) break;
#pragma unroll
        for (int a = 0; a < 2; ++a)
#pragma unroll
            for (int b = 0; b < 2; ++b)
#pragma unroll
                for (int m = 0; m < 4; ++m)
#pragma unroll
                    for (int n = 0; n < 2; ++n) acc[a][b][m][n] = (f32x4){0.f, 0.f, 0.f, 0.f};
        cur = nxt; cA = nA; cB = nB; ++ui;
        if constexpr (GATHER) { gC[0][0] = gN[0][0]; gC[0][1] = gN[0][1]; gC[1][0] = gN[1][0]; gC[1][1] = gN[1][1]; }
        if constexpr (ALIGN_EPI) { if (wr == 1) PG8_BAR; }
    }
    PG8_WAIT_V(0);
    if constexpr (!ALIGN_EPI) { if (wr == 0) PG8_BAR; }
    PG8_BAR;
    if constexpr (Epi::AFTER_DRAIN) { E.fused(acc, cur, wr, wc, fr, fq, lds, wid, lane); S.done(cur); }
#undef PG8_SA
#undef PG8_SB
#undef PG8_STAGE
#undef PG8_STAGE_G
#undef PG8_STAGE_A
#undef PG8_TAB_ISSUE
#undef PG8_TAB_READ
#undef PG8_LDA
#undef PG8_LDB
#undef PG8_MMA
#undef PG8_WAIT_V
#undef PG8_WAIT_L
#undef PG8_BAR
#undef PG8_SCHED
}
}

constexpr int NWAVES = 8, NTHR = 512;
constexpr int D = 1024, NB = 8, SEQ = 4096, CTXL = 256, NL = 2;
constexpr int NLAT = NB * SEQ;
constexpr int NCTX = NB * CTXL;
constexpr int MT = NLAT + NCTX;
constexpr int INW = 2576, NEXP = 32, TOPK = 4;
constexpr int PMAX = (MT * TOPK / 256 + NEXP) * 256;
constexpr float EPS = 1e-6f;
#ifndef CVT_NUM
#define CVT_NUM 5
#endif
#ifndef CVT_ORDER
#define CVT_ORDER 0
#endif
#ifndef CVT_GIN
#define CVT_GIN 4
#endif
constexpr int SchedInUnits = (34816 / 256) * 8 + 4 * (34816 / 256);
#ifndef CVT_SCAN
#define CVT_SCAN 3
#endif
constexpr int CVT_ITEMS = 3 * 32 * 512, CVT_SPLIT = (CVT_ITEMS * CVT_NUM / 8) / 512 * 512, CVT_GWG = SchedInUnits - 6 * 256  , CVT_G = CVT_ITEMS - CVT_GIN * (256 - CVT_GWG) * 8, CVT_MID = CVT_G - CVT_SCAN * 1024;
static_assert(CVT_MID >= CVT_SPLIT, "conversion split");

constexpr size_t MiB = 1u << 20;
constexpr size_t WS_CTL = 0, CTL_ZERO_BYTES = 1 * MiB;
constexpr size_t WS_MODV = 1 * MiB;
constexpr size_t WS_WRT = 2 * MiB;
constexpr size_t WS_WABT = WS_WRT + 512 * 1024;
constexpr size_t WS_SELE = 3 * MiB;
constexpr size_t WS_SELP = WS_SELE + 640 * 1024;
constexpr size_t WS_SELG = WS_SELP + 640 * 1024;
constexpr size_t WS_G = 5 * MiB;
constexpr size_t WS_BETA = WS_G + 1536 * 1024;
constexpr size_t WS_AB = 8 * MiB;
constexpr size_t WS_WIN = 12 * MiB;
constexpr size_t WS_WOUT = 24 * MiB;
constexpr size_t WS_DFTM = 32 * MiB;
constexpr size_t WS_XR = 48 * MiB;
constexpr size_t WS_W1 = 112 * MiB;
constexpr size_t WS_W2 = 240 * MiB;
constexpr size_t WS_ACT = 304 * MiB;
constexpr size_t WS_S = 372 * MiB;
constexpr size_t WS_QKVZ = WS_S;
constexpr size_t WS_ZTL = WS_S + 136 * MiB;
constexpr size_t WS_ZTC = WS_ZTL + 64 * MiB;
constexpr size_t WS_QKVN = WS_ZTC + 4 * MiB;
constexpr size_t WS_OF = WS_QKVN + 102 * MiB;
constexpr size_t WS_OB = WS_OF + 34 * MiB;
constexpr size_t WS_XS = WS_S;
constexpr size_t WS_HS = WS_S + 288 * MiB;
constexpr size_t WS_EO = 992 * MiB;
constexpr size_t WS_AB2 = WS_ZTL;
constexpr size_t WS_ZN = 11 * MiB - 64 * 1024;
constexpr size_t WS_GOFF = 952 * MiB;
constexpr size_t WS_END = 1024 * MiB;
static_assert(WS_XR + 64 * MiB <= WS_W1 && WS_W2 + 64 * MiB <= WS_ACT && WS_ACT + 68 * MiB <= WS_S && WS_GOFF + 35 * MiB <= WS_EO && WS_EO + 32 * MiB <= WS_END && WS_HS + 288 * MiB <= WS_GOFF, "d_ws map");
static_assert(WS_OB + 34 * MiB <= WS_END && WS_HS + 288 * MiB <= WS_END && (size_t)PMAX * 1024 * 2 == 288 * MiB, "d_ws map");
static_assert((size_t)MT * 16 <= 640 * 1024 && (size_t)MT * 32 <= 1536 * 1024, "sel / g maps");
constexpr int CW_BAR = 4096;
constexpr int GT_BLK = MT / 256;
constexpr int CW_GCNT = 16384;

constexpr int RING_BYTES = 131072;
constexpr int LDSCTL_OFF = RING_BYTES, MISC_OFF = LDSCTL_OFF + 320;
constexpr int XT_OFF = RING_BYTES + 1024;
constexpr int LDS_BYTES = 147456;

#define GAS __attribute__((address_space(1)))
#define LAS __attribute__((address_space(3)))
typedef unsigned short bf16;
typedef unsigned v4u __attribute__((ext_vector_type(4)));
typedef unsigned v2u __attribute__((ext_vector_type(2)));
typedef float f32x4 __attribute__((ext_vector_type(4)));
typedef GAS unsigned gu32;
#define RLX_AGENT __ATOMIC_RELAXED, __HIP_MEMORY_SCOPE_AGENT
#define LDS_WAIT() asm volatile("s_waitcnt lgkmcnt(0)" ::: "memory")
#define VM_WAIT() asm volatile("s_waitcnt vmcnt(0)" ::: "memory")
typedef float f32x2_t __attribute__((ext_vector_type(2))); typedef __bf16 bf16x2_t __attribute__((ext_vector_type(2)));
__device__ __forceinline__ unsigned pk2(float lo, float hi) { const f32x2_t v = {lo, hi}; const bf16x2_t b = __builtin_convertvector(v, bf16x2_t); return __builtin_bit_cast(unsigned, b); }
__device__ __forceinline__ unsigned f2bf(float f) { return pk2(f, 0.f) & 0xffffu; }
__device__ __forceinline__ float bflo(unsigned w) { return __builtin_bit_cast(float, w << 16); }
__device__ __forceinline__ float bfhi(unsigned w) { return __builtin_bit_cast(float, w & 0xffff0000u); }
__device__ __forceinline__ float wave_sum(float v) {
#pragma unroll
    for (int o = 1; o < 64; o <<= 1) v += __shfl_xor(v, o);
    return v;
}
template <int CTRL> __device__ __forceinline__ float dpp_mov(float v) { return __builtin_bit_cast(float, __builtin_amdgcn_update_dpp(0, __builtin_bit_cast(int, v), CTRL, 0xF, 0xF, true)); }
__device__ __forceinline__ float row16_sum(float x) { x += dpp_mov<0xB1>(x); x += dpp_mov<0x4E>(x); x += dpp_mov<0x141>(x); x += dpp_mov<0x140>(x); return x; }
__device__ __forceinline__ float row16_max(float x) { x = fmaxf(x, dpp_mov<0xB1>(x)); x = fmaxf(x, dpp_mov<0x4E>(x)); x = fmaxf(x, dpp_mov<0x141>(x)); x = fmaxf(x, dpp_mov<0x140>(x)); return x; }
__device__ __forceinline__ float sum16(float v) {
#pragma unroll
    for (int o = 1; o < 16; o <<= 1) v += __shfl_xor(v, o);
    return v;
}
__device__ __forceinline__ float rs32(float (&p)[32], int lane) {
#pragma unroll
    for (int e = 0; e < 16; ++e) { const bool up = (lane & 32) != 0; const float send = up ? p[e] : p[e + 16], keep = up ? p[e + 16] : p[e]; p[e] = keep + __shfl_xor(send, 32); }
#pragma unroll
    for (int e = 0; e < 8; ++e) { const bool up = (lane & 16) != 0; const float send = up ? p[e] : p[e + 8], keep = up ? p[e + 8] : p[e]; p[e] = keep + __shfl_xor(send, 16); }
#pragma unroll
    for (int e = 0; e < 4; ++e) { const bool up = (lane & 8) != 0; const float send = up ? p[e] : p[e + 4], keep = up ? p[e + 4] : p[e]; p[e] = keep + __shfl_xor(send, 8); }
#pragma unroll
    for (int e = 0; e < 2; ++e) { const bool up = (lane & 4) != 0; const float send = up ? p[e] : p[e + 2], keep = up ? p[e + 2] : p[e]; p[e] = keep + __shfl_xor(send, 4); }
    { const bool up = (lane & 2) != 0; const float send = up ? p[0] : p[1], keep = up ? p[1] : p[0]; p[0] = keep + __shfl_xor(send, 2); }
    return p[0] + __shfl_xor(p[0], 1);
}
__device__ __forceinline__ float rs8(float (&p)[8], int lane) {
#pragma unroll
    for (int e = 0; e < 4; ++e) { const bool up = (lane & 32) != 0; const float send = up ? p[e] : p[e + 4], keep = up ? p[e + 4] : p[e]; p[e] = keep + __shfl_xor(send, 32); }
#pragma unroll
    for (int e = 0; e < 2; ++e) { const bool up = (lane & 16) != 0; const float send = up ? p[e] : p[e + 2], keep = up ? p[e + 2] : p[e]; p[e] = keep + __shfl_xor(send, 16); }
    { const bool up = (lane & 8) != 0; const float send = up ? p[0] : p[1], keep = up ? p[1] : p[0]; p[0] = keep + __shfl_xor(send, 8); }
    float r = p[0] + __shfl_xor(p[0], 4); r += __shfl_xor(r, 2);
    return r + __shfl_xor(r, 1);
}
__device__ __forceinline__ float rs16(float (&p)[16], int lane) {
#pragma unroll
    for (int e = 0; e < 8; ++e) { const bool up = (lane & 32) != 0; const float send = up ? p[e] : p[e + 8], keep = up ? p[e + 8] : p[e]; p[e] = keep + __shfl_xor(send, 32); }
#pragma unroll
    for (int e = 0; e < 4; ++e) { const bool up = (lane & 16) != 0; const float send = up ? p[e] : p[e + 4], keep = up ? p[e + 4] : p[e]; p[e] = keep + __shfl_xor(send, 16); }
#pragma unroll
    for (int e = 0; e < 2; ++e) { const bool up = (lane & 8) != 0; const float send = up ? p[e] : p[e + 2], keep = up ? p[e + 2] : p[e]; p[e] = keep + __shfl_xor(send, 8); }
    { const bool up = (lane & 4) != 0; const float send = up ? p[0] : p[1], keep = up ? p[1] : p[0]; p[0] = keep + __shfl_xor(send, 4); }
    float r = p[0] + __shfl_xor(p[0], 2);
    return r + __shfl_xor(r, 1);
}
__device__ __forceinline__ float silu_f(float x) { return x * __builtin_amdgcn_rcpf(1.f + __expf(-x)); }
__device__ __forceinline__ void split_bf(const float (&v)[8], pg8::bf16x8& hi, pg8::bf16x8& lo) {
    v4u h, q;
    h.x = pk2(v[0], v[1]); h.y = pk2(v[2], v[3]); h.z = pk2(v[4], v[5]); h.w = pk2(v[6], v[7]);
    q.x = pk2(v[0] - bflo(h.x), v[1] - bfhi(h.x)); q.y = pk2(v[2] - bflo(h.y), v[3] - bfhi(h.y)); q.z = pk2(v[4] - bflo(h.z), v[5] - bfhi(h.z)); q.w = pk2(v[6] - bflo(h.w), v[7] - bfhi(h.w));
    hi = __builtin_bit_cast(pg8::bf16x8, h); lo = __builtin_bit_cast(pg8::bf16x8, q);
}
#define RT_MFMA(a, b, c) __builtin_amdgcn_mfma_f32_16x16x32_bf16((a), (b), (c), 0, 0, 0)

#define XB_TMO      128
#define XB_XCNT(j)  (256  + 64 * (j))
#define XB_XSUB(j)  (1280 + 64 * (j))
#define XB_XGEN(j)  (2304 + 64 * (j))
#define XB_TOP      3328
#define XB_TOPGEN   3392
#define XCD_BAR_WORDS 3456
#define XB_SPIN_CAP (1u << 18)
__device__ __forceinline__ unsigned xb_ld(unsigned* p)              { return __hip_atomic_load(p, __ATOMIC_RELAXED, __HIP_MEMORY_SCOPE_AGENT); }
__device__ __forceinline__ unsigned xb_add(unsigned* p, unsigned v) { return __hip_atomic_fetch_add(p, v, __ATOMIC_RELAXED, __HIP_MEMORY_SCOPE_AGENT); }
__device__ __forceinline__ unsigned xb_xcc_id() { return (unsigned)__builtin_amdgcn_s_getreg((3 << 11) | 20) & 0xFu; }
#define XB_SPIN(cond, bar) do { unsigned _sp = 0; while (cond) { __builtin_amdgcn_s_sleep(1); \
    if ((++_sp & 255u) == 0u) { if (xb_ld(&(bar)[XB_TMO])) break; if (_sp > XB_SPIN_CAP) { atomicAdd(&(bar)[XB_TMO], 1u); break; } } } } while (0)
struct XcdBarrier { unsigned* bar; unsigned x; volatile LAS unsigned* st; };
__device__ __forceinline__ XcdBarrier xcd_barrier_post(unsigned* bar, volatile LAS unsigned* st, int tid) {
    XcdBarrier b; b.bar = bar; b.x = xb_xcc_id(); b.st = st;
    if (tid == 0) (void)xb_add(&bar[XB_XCNT(b.x)], 1u);
    return b;
}
__device__ __forceinline__ void xcd_barrier_complete(unsigned* bar, unsigned x, unsigned& nloc, unsigned& nx) {
    const unsigned G = gridDim.x * gridDim.y * gridDim.z;
    unsigned sum, cnt, mine, sp = 0u;
    for (;;) {
        sum = 0u; cnt = 0u; mine = 0u;
#pragma unroll
        for (unsigned j = 0; j < 16; ++j) { const unsigned c = xb_ld(&bar[XB_XCNT(j)]); sum += c; cnt += (c > 0u) ? 1u : 0u; mine = (j == x) ? c : mine; }
        if (sum == G) break;
        __builtin_amdgcn_s_sleep(1);
        if ((++sp & 255u) == 0u) { if (xb_ld(&bar[XB_TMO])) break; if (sp > XB_SPIN_CAP) { atomicAdd(&bar[XB_TMO], 1u); break; } }
    }
    nloc = mine > 0u ? mine : 1u; nx = cnt > 0u ? cnt : 1u;
}
__device__ __forceinline__ void xcd_barrier(const XcdBarrier& b, int tid) {
    asm volatile("s_waitcnt vmcnt(0)" ::: "memory");
    __syncthreads();
    if (tid == 0) {
        unsigned* bar = b.bar; unsigned bx = b.x;
        asm volatile("" : "+v"(bar), "+v"(bx));
        __builtin_amdgcn_s_waitcnt(0);
        unsigned nloc = b.st[0], nx = b.st[1];
        if (nloc == 0u) { xcd_barrier_complete(bar, bx, nloc, nx); b.st[0] = nloc; b.st[1] = nx; }
        const unsigned old = xb_add(&bar[XB_XSUB(bx)], 1u);
        const unsigned gen = old / nloc;
        if (old + 1u == (gen + 1u) * nloc) {
            __builtin_amdgcn_fence(__ATOMIC_RELEASE, "agent");
            asm volatile("s_waitcnt vmcnt(0)" ::: "memory");
            const unsigned og = xb_add(&bar[XB_TOP], 1u);
            const unsigned tg = og / nx;
            if (og + 1u == (tg + 1u) * nx) xb_add(&bar[XB_TOPGEN], 1u);
            else XB_SPIN(xb_ld(&bar[XB_TOPGEN]) == tg, bar);
            __builtin_amdgcn_fence(__ATOMIC_ACQUIRE, "agent");
            xb_add(&bar[XB_XGEN(bx)], 1u);
            asm volatile("s_waitcnt vmcnt(0)" ::: "memory");
        } else {
            XB_SPIN(xb_ld(&bar[XB_XGEN(bx)]) == gen, bar);
            __builtin_amdgcn_fence(__ATOMIC_ACQUIRE, "agent");
            asm volatile("s_waitcnt vmcnt(0)" ::: "memory");
        }
    }
    __syncthreads();
}

struct Args { const float* in[23]; float* out; unsigned char* ws; int ph_lo, ph_hi; };
struct Frame {
    LAS unsigned char* lds;
    volatile LAS unsigned* MISC;
    unsigned* ctl;
    unsigned char* ws;
    int tid, lane, wave, vcu, G, gw, NGW;
    float* out;
};
typedef const Args __attribute__((address_space(4)))* KArgsP;
__device__ __forceinline__ KArgsP kargs() { unsigned long long v = (unsigned long long)__builtin_amdgcn_kernarg_segment_ptr(); asm volatile("" : "+s"(v)); return (KArgsP)v; }
enum InIdx { I_X = 0, I_C, I_CTX, I_CCTX, I_WMOD, I_BMOD, I_GN1, I_WIN, I_CONVW, I_ALOG, I_DTB, I_GOUT, I_WOUT, I_GN2, I_WR, I_BR, I_WG, I_BG, I_WU, I_BU, I_WD, I_BD, I_GF };
__device__ __forceinline__ bf16* xr_row(const Frame& F, int t) { return t < NLAT ? (bf16*)(F.ws + WS_XR) + (size_t)t * D : (bf16*)((unsigned char*)F.out + 124 * MiB) + (size_t)(t - NLAT) * D; }
__device__ __forceinline__ int mod_row(int t) { return t < NLAT ? (t >> 12) : 8; }
__device__ __forceinline__ const float* modv(const Frame& F, int l, int r, int piece) { return (const float*)(F.ws + WS_MODV) + ((size_t)(l * 9 + r) * 6 + piece) * D; }

struct SchedIn {
    const bf16* hx; const bf16* win; int G, c;
    static constexpr int N0 = (MT / 256) * 8, N1 = 4 * (MT / 256), NWG = N0 + N1;
    __device__ __forceinline__ bool next(int i, pg8::Unit& u) const {
        const long L = (long)i * G + c; if (L >= NWG) return false;
        int w = pg8::xcd_remap((int)L, NWG);
        if (w < N0) { u.kind = 0; pg8::grp_decode(w, MT / 256, 8, u.pm, u.pn); } else { w -= N0; u.kind = 1; u.pn = w >> 2; u.pm = w & 3; }
        u.e = 0; return true;
    }
    __device__ __forceinline__ const char* a_base(const pg8::Unit& u, size_t tstep) const { return u.kind == 0 ? (const char*)hx + (size_t)u.pm * tstep : (const char*)win + (size_t)(8 + u.pm) * tstep; }
    __device__ __forceinline__ const char* b_base(const pg8::Unit& u, size_t tstep) const { return u.kind == 0 ? (const char*)win + (size_t)u.pn * tstep : (const char*)hx + (size_t)u.pn * tstep; }
    __device__ __forceinline__ void a_ready(const pg8::Unit&) const {}
    __device__ __forceinline__ void done(const pg8::Unit&) const {}
};
struct EpiIn {
    static constexpr bool PERM = true, AFTER_DRAIN = false;
    bf16* qkvz; bf16* ztl; bf16* ztc;
    __device__ __forceinline__ void operator()(const pg8::f32x4 (&acc)[2][2][4][2], const pg8::Unit& u, int wr, int wc, int fr_, int fq_) const {
        int fr = fr_, fq = fq_; asm volatile("" : "+v"(fr), "+v"(fq));
        const int row0 = u.pm * 256 + wr * 64 + fr, cin = wc * 32 + 8 * fq;
        bf16* base; size_t ldc;
        if (u.kind == 0) { base = qkvz + (size_t)u.pn * 256 + cin; ldc = 2048; }
        else if (u.pn < 128) { base = ztl + (size_t)(u.pn >> 4) * 1024 * 4096 + (size_t)(u.pn & 15) * 256 + cin; ldc = 4096; }
        else { base = ztc + (size_t)(u.pn - 128) * 1024 * 256 + cin; ldc = 256; }
#pragma unroll
        for (int ai = 0; ai < 2; ++ai)
#pragma unroll
            for (int m = 0; m < 4; ++m) { bf16* rowp = base + (size_t)(row0 + ai * 128 + m * 16) * ldc;
#pragma unroll
                for (int bj = 0; bj < 2; ++bj) { const pg8::f32x4 v0 = acc[ai][bj][m][0], v1 = acc[ai][bj][m][1]; pg8::u32x4 w;
                    w.x = pg8::cvt_pk_bf16(v0[0], v0[1]); w.y = pg8::cvt_pk_bf16(v0[2], v0[3]); w.z = pg8::cvt_pk_bf16(v1[0], v1[1]); w.w = pg8::cvt_pk_bf16(v1[2], v1[3]);
                    *(pg8::u32x4*)(rowp + bj * 128) = w; } }
    }
};
struct SchedDft {
    const bf16* dftm; const bf16* eo; int v;
    __device__ __forceinline__ bool next(int i, pg8::Unit& u) const {
        if (i >= 2 || v < 0) return false;
        const int w = (v >> 5) * 64 + i * 32 + (v & 31), x = w >> 5, j = w & 31;
        u.kind = x & 1; u.pm = 4 * ((x >> 1) & 1) + (j & 3); u.e = 4 * (x >> 2) + ((j >> 2) & 3); u.pn = j >> 4; return true;
    }
    __device__ __forceinline__ const char* a_base(const pg8::Unit& u, size_t tstep) const { return (const char*)dftm + (size_t)u.kind * (2048 * 2048 * 2) + (size_t)u.pm * tstep; }
    __device__ __forceinline__ const char* b_base(const pg8::Unit& u, size_t tstep) const { return (const char*)eo + (size_t)(u.e * 2 + u.kind) * (512 * 2048 * 2) + (size_t)u.pn * tstep; }
    __device__ __forceinline__ void a_ready(const pg8::Unit&) const {}
    __device__ __forceinline__ void done(const pg8::Unit&) const {}
};
struct EpiDft {
    static constexpr bool PERM = true, AFTER_DRAIN = false;
    bf16* ab2;
    __device__ __forceinline__ void operator()(const pg8::f32x4 (&acc)[2][2][4][2], const pg8::Unit& u, int wr, int wc, int fr_, int fq_) const {
        int fr = fr_, fq = fq_; asm volatile("" : "+v"(fr), "+v"(fq));
        const int row0 = u.pm * 256 + wr * 64 + fr, col0 = u.pn * 256 + wc * 32 + 8 * fq;
        bf16* base = ab2 + (size_t)(u.e * 2 + u.kind) * 2048 * 512;
#pragma unroll
        for (int ai = 0; ai < 2; ++ai)
#pragma unroll
            for (int m = 0; m < 4; ++m) { bf16* rowp = base + (size_t)(row0 + ai * 128 + m * 16) * 512 + col0;
#pragma unroll
                for (int bj = 0; bj < 2; ++bj) { const pg8::f32x4 v0 = acc[ai][bj][m][0], v1 = acc[ai][bj][m][1]; pg8::u32x4 w;
                    w.x = pg8::cvt_pk_bf16(v0[0], v0[1]); w.y = pg8::cvt_pk_bf16(v0[2], v0[3]); w.z = pg8::cvt_pk_bf16(v1[0], v1[1]); w.w = pg8::cvt_pk_bf16(v1[2], v1[3]);
                    *(pg8::u32x4*)(rowp + bj * 128) = w; } }
    }
};
struct SchedOut {
    const bf16* mix; const bf16* wout; int nM, G, c;
    __device__ __forceinline__ bool next(int i, pg8::Unit& u) const {
        const int nwg = nM * 4; const long L = (long)i * G + c; if (L >= nwg) return false;
        pg8::grp_decode(pg8::xcd_remap((int)L, nwg), nM, 4, u.pm, u.pn); u.kind = 0; u.e = 0; return true;
    }
    __device__ __forceinline__ const char* a_base(const pg8::Unit& u, size_t tstep) const { return (const char*)mix + (size_t)u.pm * tstep; }
    __device__ __forceinline__ const char* b_base(const pg8::Unit& u, size_t tstep) const { return (const char*)wout + (size_t)u.pn * tstep; }
    __device__ __forceinline__ void a_ready(const pg8::Unit&) const {}
    __device__ __forceinline__ void done(const pg8::Unit&) const {}
};
template <bool RBF> struct EpiOut {
    static constexpr bool PERM = false, AFTER_DRAIN = false;
    bf16* xlat; bf16* xctx; const void* rlat; const void* rctx; const float* gt1; float dsc;
    __device__ __forceinline__ void operator()(const pg8::f32x4 (&acc)[2][2][4][2], const pg8::Unit& u, int wr, int wc, int fr_, int fq_) const {
        int fr = fr_, fq = fq_; asm volatile("" : "+v"(fr), "+v"(fq));
        const int col0 = u.pn * 256 + wc * 32 + 4 * fq, rl = wr * 64 + fr;
        const size_t ro = (size_t)(u.pm < 128 ? u.pm : u.pm - 128) * 256 * D;
        bf16* xb = (u.pm < 128 ? xlat : xctx) + ro;
        const char* rb = (const char*)(u.pm < 128 ? rlat : rctx) + ro * (RBF ? 2 : 4);
        const float* g = gt1 + (size_t)(u.pm < 128 ? (u.pm >> 4) : 8) * 6 * D + col0;
        pg8::f32x4 gv[2][2];
#pragma unroll
        for (int bj = 0; bj < 2; ++bj)
#pragma unroll
            for (int n = 0; n < 2; ++n) gv[bj][n] = *(const pg8::f32x4*)(g + bj * 128 + n * 16);
#pragma unroll
        for (int ai = 0; ai < 2; ++ai)
#pragma unroll
            for (int m = 0; m < 4; ++m) { const size_t eo = (size_t)(rl + ai * 128 + m * 16) * D + col0; bf16* rowp = xb + eo; const char* rrow = rb + eo * (RBF ? 2 : 4);
#pragma unroll
                for (int bj = 0; bj < 2; ++bj)
#pragma unroll
                    for (int n = 0; n < 2; ++n) { pg8::f32x4 xo;
                        if constexpr (RBF) { const v2u rv = *(const v2u*)(rrow + (bj * 128 + n * 16) * 2); xo = (pg8::f32x4){bflo(rv.x), bfhi(rv.x), bflo(rv.y), bfhi(rv.y)}; }
                        else xo = *(const pg8::f32x4*)(rrow + (bj * 128 + n * 16) * 4);
                        const pg8::f32x4 y = xo + gv[bj][n] * acc[ai][bj][m][n] * dsc; v2u w; w.x = pk2(y[0], y[1]); w.y = pk2(y[2], y[3]);
                        *(v2u*)(rowp + bj * 128 + n * 16) = w; }
                if (m & 1) asm volatile("" ::: "memory"); }
    }
};
struct SchedMoe {
    const bf16* A; const bf16* W; size_t wstride; const LAS int* pend; int nM, nN, G, c, gather;
    __device__ __forceinline__ bool next(int i, pg8::Unit& u) const {
        const int nwg = nM * nN; const long L = (long)i * G + c; if (L >= nwg) return false;
        pg8::grp_decode(pg8::xcd_remap((int)L, nwg), nM, nN, u.pm, u.pn);
        if (!gather) u.pm = nM - 1 - u.pm;
        unsigned m1 = ~0u; asm volatile("" : "+s"(m1));
        const int ln = (int)__builtin_amdgcn_mbcnt_hi(m1, __builtin_amdgcn_mbcnt_lo(m1, 0u));
        const int pv = pend[ln & 31];
        const int e = __builtin_popcount((unsigned)__ballot(pv <= u.pm) & 0x7fffffffu);
        const int st = e ? __builtin_amdgcn_readlane(pv, e - 1) : 0;
        u.e = e; u.kind = e * GT_BLK + (u.pm - st); return true;
    }
    __device__ __forceinline__ const char* a_base(const pg8::Unit& u, size_t tstep) const { return gather ? (const char*)A : (const char*)A + (size_t)u.pm * tstep; }
    __device__ __forceinline__ const char* b_base(const pg8::Unit& u, size_t tstep) const { return (const char*)W + (size_t)u.e * wstride + (size_t)u.pn * tstep; }
    __device__ __forceinline__ void a_ready(const pg8::Unit&) const {}
    __device__ __forceinline__ void done(const pg8::Unit&) const {}
};
struct EpiSwiglu {
    static constexpr bool PERM = true, AFTER_DRAIN = false;
    bf16* hs; const float* bg; const float* bu;
    __device__ __forceinline__ void operator()(const pg8::f32x4 (&acc)[2][2][4][2], const pg8::Unit& u, int wr, int wc, int fr_, int fq_) const {
        int fr = fr_, fq = fq_; asm volatile("" : "+v"(fr), "+v"(fq));
        const int row0 = u.pm * 256 + wr * 64 + fr, f0 = u.pn * 128 + wc * 32 + 8 * fq;
        const pg8::f32x4 bg0 = *(const pg8::f32x4*)(bg + u.e * D + f0), bg1 = *(const pg8::f32x4*)(bg + u.e * D + f0 + 4);
        const pg8::f32x4 bu0 = *(const pg8::f32x4*)(bu + u.e * D + f0), bu1 = *(const pg8::f32x4*)(bu + u.e * D + f0 + 4);
#pragma unroll
        for (int ai = 0; ai < 2; ++ai)
#pragma unroll
            for (int m = 0; m < 4; ++m) {
                float h[8];
#pragma unroll
                for (int n = 0; n < 2; ++n) { const pg8::f32x4 ga = acc[ai][0][m][n] + (n ? bg1 : bg0), ua = acc[ai][1][m][n] + (n ? bu1 : bu0);
#pragma unroll
                    for (int j = 0; j < 4; ++j) { const float a = fminf(ga[j], 7.0f), uu = fminf(fmaxf(ua[j], -7.0f), 7.0f);
                        h[n * 4 + j] = a * __builtin_amdgcn_rcpf(1.0f + __expf(-1.702f * a)) * (uu + 1.0f); } }
                pg8::u32x4 w; w.x = pg8::cvt_pk_bf16(h[0], h[1]); w.y = pg8::cvt_pk_bf16(h[2], h[3]); w.z = pg8::cvt_pk_bf16(h[4], h[5]); w.w = pg8::cvt_pk_bf16(h[6], h[7]);
                *(pg8::u32x4*)(hs + (size_t)(row0 + ai * 128 + m * 16) * D + f0) = w; }
    }
};
struct EpiDown {
    static constexpr bool PERM = true, AFTER_DRAIN = false;
    bf16* ys; const float* bd;
    __device__ __forceinline__ void operator()(const pg8::f32x4 (&acc)[2][2][4][2], const pg8::Unit& u, int wr, int wc, int fr_, int fq_) const {
        int fr = fr_, fq = fq_; asm volatile("" : "+v"(fr), "+v"(fq));
        const int row0 = u.pm * 256 + wr * 64 + fr, col0 = u.pn * 256 + wc * 32 + 8 * fq;
        pg8::f32x4 bv[2][2];
#pragma unroll
        for (int bj = 0; bj < 2; ++bj)
#pragma unroll
            for (int n = 0; n < 2; ++n) bv[bj][n] = *(const pg8::f32x4*)(bd + u.e * D + col0 + bj * 128 + 4 * n);
#pragma unroll
        for (int ai = 0; ai < 2; ++ai)
#pragma unroll
            for (int m = 0; m < 4; ++m) { bf16* rowp = ys + (size_t)(row0 + ai * 128 + m * 16) * D + col0;
#pragma unroll
                for (int bj = 0; bj < 2; ++bj) { const pg8::f32x4 v0 = acc[ai][bj][m][0] + bv[bj][0], v1 = acc[ai][bj][m][1] + bv[bj][1]; pg8::u32x4 w;
                    w.x = pg8::cvt_pk_bf16(v0[0], v0[1]); w.y = pg8::cvt_pk_bf16(v0[2], v0[3]); w.z = pg8::cvt_pk_bf16(v1[0], v1[1]); w.w = pg8::cvt_pk_bf16(v1[2], v1[3]);
                    *(pg8::u32x4*)(rowp + bj * 128) = w; } }
    }
};

template <bool NT = false>
__device__ __forceinline__ void transpose_item(const float* W, int ldw, int col0, int K, bf16* WT, int drow0, LAS float* scr, int kb, int lane) {
    const int k0 = 64 * kb;
#pragma unroll 8
    for (int i = 0; i < 32; ++i) { const int kk = 2 * i + (lane >> 5); const float* wp = W + (size_t)(k0 + kk) * ldw + col0 + (lane & 31); scr[kk * 33 + (lane & 31)] = NT ? __builtin_nontemporal_load(wp) : *wp; }
    LDS_WAIT(); asm volatile("" ::: "memory");
    const int c = lane & 7;
#pragma unroll
    for (int j = 0; j < 4; ++j) { const int n = (lane >> 3) + 8 * j; const LAS float* s = scr + (8 * c) * 33 + n;
        v4u o; o.x = pk2(s[0 * 33], s[1 * 33]); o.y = pk2(s[2 * 33], s[3 * 33]); o.z = pk2(s[4 * 33], s[5 * 33]); o.w = pk2(s[6 * 33], s[7 * 33]);
        if (NT) __builtin_nontemporal_store(o, (v4u*)(WT + (size_t)(drow0 + n) * K + k0 + 8 * c)); else *(v4u*)(WT + (size_t)(drow0 + n) * K + k0 + 8 * c) = o; }
    LDS_WAIT(); asm volatile("" ::: "memory");
}
struct CvtItem { const float* src; bf16* dst; };
__device__ __forceinline__ CvtItem cvt_decode(const Frame& F, KArgsP A, int l, int it) {
    constexpr int IPM = 16 * 32;
    const int which = it / (NEXP * IPM), r = it % (NEXP * IPM), e = r / IPM, q = r % IPM, kb = q >> 5, nb = q & 31;
    const size_t moff = ((size_t)l * NEXP + e) * D * D;
    const float* W = which == 0 ? A->in[I_WG] : (which == 1 ? A->in[I_WU] : A->in[I_WD]);
    bf16* WT = which == 2 ? (bf16*)(F.ws + WS_W2) + (size_t)e * D * D : (bf16*)(F.ws + WS_W1) + (size_t)e * 2048 * D;
    const int drow0 = which == 2 ? nb * 32 : 256 * (nb >> 2) + (which == 1 ? 128 : 0) + 32 * (nb & 3);
    CvtItem c; c.src = W + moff + (size_t)(64 * kb) * D + nb * 32; c.dst = WT + (size_t)drow0 * D + 64 * kb; return c;
}
__device__ __forceinline__ void cvt_load(f32x4 (&v)[8], const float* src, int lane) {
    const float* p = src + (size_t)(lane >> 3) * D + 4 * (lane & 7);
#pragma unroll
    for (int i = 0; i < 8; ++i) v[i] = __builtin_nontemporal_load((const f32x4*)(p + (size_t)(8 * i) * D));
}
__device__ __forceinline__ void cvt_store(const f32x4 (&v)[8], bf16* dst, LAS float* scr, int lane) {
    LAS float* w = scr + (lane >> 3) * 33 + 4 * (lane & 7);
#pragma unroll
    for (int i = 0; i < 8; ++i) { w[(8 * i) * 33 + 0] = v[i].x; w[(8 * i) * 33 + 1] = v[i].y; w[(8 * i) * 33 + 2] = v[i].z; w[(8 * i) * 33 + 3] = v[i].w; }
    LDS_WAIT(); asm volatile("" ::: "memory");
    const int c = lane & 7;
#pragma unroll
    for (int j = 0; j < 4; ++j) { const int n = (lane >> 3) + 8 * j; const LAS float* s = scr + (8 * c) * 33 + n;
        v4u o; o.x = pk2(s[0 * 33], s[1 * 33]); o.y = pk2(s[2 * 33], s[3 * 33]); o.z = pk2(s[4 * 33], s[5 * 33]); o.w = pk2(s[6 * 33], s[7 * 33]);
        __builtin_nontemporal_store(o, (v4u*)(dst + (size_t)n * D + 8 * c)); }
    LDS_WAIT(); asm volatile("" ::: "memory");
}
__device__ __forceinline__ void convert_experts(const Frame& F, int l, int lo, int hi, int wi, int nw) {
    const KArgsP A = kargs();
    LAS float* scr = (LAS float*)(F.lds + F.wave * 16384);
    f32x4 va[8], vb[8];
    int it = lo + wi;
    if (it < hi) cvt_load(va, cvt_decode(F, A, l, it).src, F.lane);
#pragma unroll 1
    for (; it < hi; it += 2 * nw) {
        const bool hb = it + nw < hi;
        if (hb) cvt_load(vb, cvt_decode(F, A, l, it + nw).src, F.lane);
        cvt_store(va, cvt_decode(F, A, l, it).dst, scr, F.lane);
        if (it + 2 * nw < hi) cvt_load(va, cvt_decode(F, A, l, it + 2 * nw).src, F.lane);
        if (hb) cvt_store(vb, cvt_decode(F, A, l, it + nw).dst, scr, F.lane);
    }
}
#ifdef PROBE_P0
#ifndef PROBE_P0_WG
#define PROBE_P0_WG 64
#endif
#define P0STAMP(k) do { __syncthreads(); const unsigned long long t_ = __builtin_amdgcn_s_memrealtime(); if (PROBE_P0 == (k) && blockIdx.x == PROBE_P0_WG && F.tid == 0) *(unsigned long long*)(F.ws + WS_ZN + 48 * 1024) += t_ - p0_last; p0_last = t_; } while (0)
#else
#define P0STAMP(k) do {} while (0)
#endif
__device__ __forceinline__ void p0_prologue(const Frame& F) {
    const KArgsP A = kargs();
    float* mv = (float*)(F.ws + WS_MODV);
#ifdef PROBE_P0
    unsigned long long p0_last = __builtin_amdgcn_s_memrealtime();
#endif
    {
        LAS float* sc = (LAS float*)F.lds;
        LAS float* red = sc + 9 * 1024;
        { f32x4 cv[5];
#pragma unroll
          for (int j = 0; j < 5; ++j) { const int i4 = F.tid + NTHR * j, r = i4 >> 8, k = (i4 & 255) * 4; if (i4 < 9 * 256) cv[j] = *(const f32x4*)(r < 8 ? A->in[I_C] + r * D + k : A->in[I_CCTX] + k); }
#pragma unroll
          for (int j = 0; j < 5; ++j) { const int i4 = F.tid + NTHR * j; if (i4 < 9 * 256) *(LAS f32x4*)(sc + 4 * i4) = (f32x4){silu_f(cv[j].x), silu_f(cv[j].y), silu_f(cv[j].z), silu_f(cv[j].w)}; } }
        __syncthreads();
        for (int item = (blockIdx.x + 192) % F.G; item < 192; item += F.G) {
            const int l = item / 96, cg = item % 96, c4 = F.lane & 15, rs = F.lane >> 4, ks = F.wave;
            const float* w = A->in[I_WMOD] + ((size_t)l * D + ks * 128 + rs) * 6144 + cg * 64 + 4 * c4;
            f32x4 wv[32];
#pragma unroll
            for (int i = 0; i < 32; ++i) wv[i] = *(const f32x4*)(w + (size_t)(4 * i) * 6144);
            f32x4 a[9];
#pragma unroll
            for (int r = 0; r < 9; ++r) a[r] = (f32x4){0.f, 0.f, 0.f, 0.f};
#pragma unroll
            for (int i = 0; i < 32; ++i) {
#pragma unroll
                for (int r = 0; r < 9; ++r) a[r] += sc[r * 1024 + ks * 128 + 4 * i + rs] * wv[i]; }
#pragma unroll
            for (int r = 0; r < 9; ++r) *(LAS f32x4*)(red + ((ks * 4 + rs) * 9 + r) * 64 + 4 * c4) = a[r];
            __syncthreads();
            for (int i = F.tid; i < 9 * 64; i += NTHR) { const int r = i >> 6, cc = i & 63; float s = 0.f;
#pragma unroll
                for (int k2 = 0; k2 < 32; ++k2) s += red[(k2 * 9 + r) * 64 + cc];
                mv[(size_t)(l * 9 + r) * 6144 + cg * 64 + cc] = s + A->in[I_BMOD][l * 6144 + cg * 64 + cc]; }
            __syncthreads();
        }
    }
    P0STAMP(1);
    {
        LAS float* T = (LAS float*)F.lds;
        LAS float* cs = T + 64 * 132; LAS float* sn = cs + 128;
        __syncthreads();
        if (F.tid < 128) { cs[F.tid] = cospif((float)F.tid * (1.0f / 64.0f)); sn[F.tid] = sinpif((float)F.tid * (1.0f / 64.0f)); }
        __syncthreads();
        const int l15 = F.lane & 15, l4 = F.lane >> 4;
        pg8::bf16x8 bh[2][4], bl[2][4];
        if (blockIdx.x < 128) {
#pragma unroll
            for (int nt = 0; nt < 2; ++nt) { const int np = 32 * F.wave + 16 * nt + l15, cp = np >> 1;
#pragma unroll
                for (int ks = 0; ks < 4; ++ks) { float v[8];
#pragma unroll
                    for (int j = 0; j < 8; ++j) { const int cc = 32 * ks + 8 * l4 + j; v[j] = (np & 1) ? -sn[(cc * cp) & 127] : cs[(cc * cp) & 127]; }
                    split_bf(v, bh[nt][ks], bl[nt][ks]); } }
        }
        for (int item = blockIdx.x; item < 128; item += F.G) {
            const int l = item >> 6, kg = (item & 63) >> 2, g = item & 3;
            __syncthreads();
            { const int kk = F.tid >> 3, c0 = 16 * (F.tid & 7); const float* wp = A->in[I_WIN] + ((size_t)l * D + kg * 64 + kk) * INW + g * 128 + c0;
              f32x4 tv[4];
#pragma unroll
              for (int j = 0; j < 4; ++j) tv[j] = *(const f32x4*)(wp + 4 * j);
#pragma unroll
              for (int j = 0; j < 4; ++j) *(LAS f32x4*)(T + kk * 132 + c0 + 4 * j) = tv[j]; }
            __syncthreads();
            f32x4 acc[4][2];
#pragma unroll
            for (int mt = 0; mt < 4; ++mt)
#pragma unroll
                for (int nt = 0; nt < 2; ++nt) acc[mt][nt] = (f32x4){0.f, 0.f, 0.f, 0.f};
#pragma unroll
            for (int mt = 0; mt < 4; ++mt)
#pragma unroll
                for (int ks = 0; ks < 4; ++ks) { const LAS f32x4* tp = (const LAS f32x4*)(T + (16 * mt + l15) * 132 + 32 * ks + 8 * l4); const f32x4 t0 = tp[0], t1 = tp[1];
                    const float v[8] = {t0.x, t0.y, t0.z, t0.w, t1.x, t1.y, t1.z, t1.w}; pg8::bf16x8 ah, al; split_bf(v, ah, al);
#pragma unroll
                    for (int nt = 0; nt < 2; ++nt) { acc[mt][nt] = RT_MFMA(al, bl[nt][ks], acc[mt][nt]); acc[mt][nt] = RT_MFMA(al, bh[nt][ks], acc[mt][nt]); acc[mt][nt] = RT_MFMA(ah, bl[nt][ks], acc[mt][nt]); acc[mt][nt] = RT_MFMA(ah, bh[nt][ks], acc[mt][nt]); } }
            bf16* dst = (bf16*)(F.ws + WS_WIN) + ((size_t)l * 3072 + 2048 + g * 256) * D + kg * 64;
#pragma unroll
            for (int mt = 0; mt < 4; ++mt)
#pragma unroll
                for (int nt = 0; nt < 2; ++nt) { const int np = 32 * F.wave + 16 * nt + l15; v2u w; w.x = pk2(acc[mt][nt].x, acc[mt][nt].y); w.y = pk2(acc[mt][nt].z, acc[mt][nt].w);
                    *(v2u*)(dst + (size_t)np * D + 16 * mt + 4 * l4) = w; }
        }
        __syncthreads();
    }
    P0STAMP(2);
    {
        LAS float* scr = (LAS float*)(F.lds + F.wave * 16384);
        constexpr int I_IN = 16 * 64, I_OUT = 16 * 32;
        for (int it = F.gw; it < NL * (I_IN + I_OUT); it += F.NGW) {
            const int l = it / (I_IN + I_OUT), r = it % (I_IN + I_OUT);
            if (r < I_IN) transpose_item(A->in[I_WIN] + (size_t)l * D * INW, INW, 512 + 32 * (r & 63), D, (bf16*)(F.ws + WS_WIN) + (size_t)l * 3072 * D, 32 * (r & 63), scr, r >> 6, F.lane);
            else { const int q = r - I_IN; transpose_item(A->in[I_WOUT] + (size_t)l * D * D, D, 32 * (q & 31), D, (bf16*)(F.ws + WS_WOUT) + (size_t)l * D * D, 32 * (q & 31), scr, q >> 5, F.lane); }
        }
    }
    P0STAMP(3);
    convert_experts(F, 0, 0, CVT_SPLIT, F.gw, F.NGW);
    P0STAMP(4);
    {
        const int gt = F.gw * 64 + F.lane, NT = F.NGW * 64;
        float* wrt = (float*)(F.ws + WS_WRT); float* wabt = (float*)(F.ws + WS_WABT);
        for (int i = gt; i < NL * NEXP * D; i += NT) { const int l = i >> 15, e = (i >> 10) & 31, c = i & 1023; wrt[i] = A->in[I_WR][((size_t)l * D + c) * NEXP + e]; }
        for (int i = gt; i < NL * 16 * D; i += NT) { const int l = i >> 14, j = (i >> 10) & 15, c = i & 1023; wabt[i] = A->in[I_WIN][((size_t)l * D + c) * INW + 2560 + j]; }
        bf16* dm = (bf16*)(F.ws + WS_DFTM);
        for (int i = gt; i < 2 * 2048 * 256; i += NT) { const int mat = i >> 19, kf = (i >> 8) & 2047, j0 = (i & 255) * 8; float v[8];
#pragma unroll
            for (int jj = 0; jj < 8; ++jj) { const float a = (float)((kf * (j0 + jj)) & 4095) * (1.0f / 2048.0f); v[jj] = mat ? sinpif(a) : cospif(a); }
            v4u o; o.x = pk2(v[0], v[1]); o.y = pk2(v[2], v[3]); o.z = pk2(v[4], v[5]); o.w = pk2(v[6], v[7]);
            *(v4u*)(dm + (size_t)i * 8) = o; }
    }
    P0STAMP(5);
}

__device__ __forceinline__ void moe_layout(const Frame& F, int l, LAS int* pend, LAS int* pstart) {
    __syncthreads();
    if (F.tid < 64) {
        const int e = F.tid & 31;
        const int n = (int)__hip_atomic_load(F.ctl + CW_GCNT + (l * 32 + e) * 64, RLX_AGENT);
        const int nb = (F.tid < 32) ? ((n + 255) >> 8) : 0;
        int inc = nb;
#pragma unroll
        for (int o = 1; o < 32; o <<= 1) { const int t = __shfl_up(inc, o); if ((F.tid & 63) >= o) inc += t; }
        if (F.tid < 32) { pend[e] = inc; pstart[e] = (inc - nb) * 256; }
    }
    __syncthreads();
}

template <int MODE>
__device__ __forceinline__ void row_pass(const Frame& F, int l_cur, int l_nxt, bool dummy = false) {
    const KArgsP A = kargs();
    LAS float* wl = (LAS float*)F.lds;
    if (MODE != 2) { const f32x4* src = (const f32x4*)((const float*)(F.ws + WS_WABT) + (size_t)l_nxt * 16 * D);
        for (int i = F.tid; i < 16 * D / 4; i += NTHR) ((LAS f32x4*)wl)[i] = src[i];
        __syncthreads(); }
    const int nrows = MODE == 2 ? NLAT : MT;
    LAS int* pstart = (LAS int*)(F.lds + XT_OFF) + 32;
    if (MODE != 0) moe_layout(F, l_cur, pstart - 32, pstart);
    const int* selp = (const int*)(F.ws + WS_SELP); const float* selg = (const float*)(F.ws + WS_SELG);
    const bf16* ys = (const bf16*)(F.ws + WS_XS);
    bf16* hx = (bf16*)(F.ws + WS_ACT); float* ab = (float*)(F.ws + WS_AB);
    f32x4 xc[4]; v2u xcb[4]; int dc[4]; float gc[4]; v2u yc[4][4];
    int t = F.gw;
    if (t < nrows) {
        if (MODE == 0) { const float* xin = t < NLAT ? A->in[I_X] + (size_t)t * D : A->in[I_CTX] + (size_t)(t - NLAT) * D;
#pragma unroll
            for (int j = 0; j < 4; ++j) xc[j] = *((const f32x4*)xin + F.lane + 64 * j); }
        else { const bf16* xin = xr_row(F, t);
#pragma unroll
            for (int j = 0; j < 4; ++j) xcb[j] = *((const v2u*)xin + F.lane + 64 * j); }
        if (MODE != 0) {
#pragma unroll
            for (int k = 0; k < 4; ++k) { const int pk = selp[t * 4 + k]; dc[k] = pstart[pk >> 20] + (pk & 0xfffff); gc[k] = selg[t * 4 + k]; }
#pragma unroll
            for (int k = 0; k < 4; ++k) { const v2u* yr = (const v2u*)(ys + (size_t)dc[k] * D) + F.lane;
#pragma unroll
                for (int j = 0; j < 4; ++j) yc[k][j] = yr[64 * j]; } }
    }
    for (; t < nrows; t += F.NGW) {
        const int tn = t + F.NGW < nrows ? t + F.NGW : t;
        f32x4 xn[4]; v2u xnb[4]; int dn[4]; float gn[4];
        { if (MODE == 0) { const float* xin = tn < NLAT ? A->in[I_X] + (size_t)tn * D : A->in[I_CTX] + (size_t)(tn - NLAT) * D;
#pragma unroll
              for (int j = 0; j < 4; ++j) xn[j] = *((const f32x4*)xin + F.lane + 64 * j); }
          else { const bf16* xin = xr_row(F, tn);
#pragma unroll
              for (int j = 0; j < 4; ++j) xnb[j] = *((const v2u*)xin + F.lane + 64 * j); }
          if (MODE != 0) {
#pragma unroll
              for (int k = 0; k < 4; ++k) { dn[k] = selp[tn * 4 + k]; gn[k] = selg[tn * 4 + k]; } } }
        const int r = mod_row(t);
        f32x4 v[4];
#pragma unroll
        for (int j = 0; j < 4; ++j) v[j] = MODE == 0 ? xc[j] : (f32x4){bflo(xcb[j].x), bfhi(xcb[j].x), bflo(xcb[j].y), bfhi(xcb[j].y)};
        bf16* xr = xr_row(F, t);
        if (MODE != 0) {
            f32x4 y[4];
#pragma unroll
            for (int j = 0; j < 4; ++j) y[j] = (f32x4){0.f, 0.f, 0.f, 0.f};
#pragma unroll
            for (int k = 0; k < 4; ++k)
#pragma unroll
                for (int j = 0; j < 4; ++j) { const v2u w = yc[k][j]; y[j] += gc[k] * (f32x4){bflo(w.x), bfhi(w.x), bflo(w.y), bfhi(w.y)}; }
            const f32x4* g2 = (const f32x4*)modv(F, l_cur, r, 5) + F.lane;
#pragma unroll
            for (int j = 0; j < 4; ++j) v[j] += g2[64 * j] * y[j];
#pragma unroll
            for (int k = 0; k < 4; ++k) { const v2u* yr = (const v2u*)(ys + (size_t)(pstart[dn[k] >> 20] + (dn[k] & 0xfffff)) * D) + F.lane;
#pragma unroll
                for (int j = 0; j < 4; ++j) yc[k][j] = yr[64 * j]; }
        }
        if (MODE == 1 && !dummy) {
#pragma unroll
            for (int j = 0; j < 4; ++j) { v2u w; w.x = pk2(v[j].x, v[j].y); w.y = pk2(v[j].z, v[j].w); *((v2u*)xr + F.lane + 64 * j) = w; }
        }
        float ss = 0.f;
#pragma unroll
        for (int j = 0; j < 4; ++j) ss += (v[j].x * v[j].x + v[j].y * v[j].y) + (v[j].z * v[j].z + v[j].w * v[j].w);
        const float rstd = 1.0f / sqrtf(wave_sum(ss) * (1.0f / D) + EPS);
        if (MODE == 2) {
            const f32x4* gf = (const f32x4*)A->in[I_GF] + F.lane;
#pragma unroll
            for (int j = 0; j < 4; ++j) *((f32x4*)(F.out + (size_t)t * D) + F.lane + 64 * j) = v[j] * rstd * gf[64 * j];
        } else {
            const f32x4* g1 = (const f32x4*)(A->in[I_GN1] + (size_t)l_nxt * D) + F.lane;
            const f32x4* sh = (const f32x4*)modv(F, l_nxt, r, 0) + F.lane; const f32x4* scl = (const f32x4*)modv(F, l_nxt, r, 1) + F.lane;
            v2u* ho = (v2u*)(hx + (size_t)t * D) + F.lane;
#pragma unroll
            for (int j = 0; j < 4; ++j) { v[j] = v[j] * rstd * g1[64 * j] * (scl[64 * j] + 1.0f) + sh[64 * j]; v2u w; w.x = pk2(v[j].x, v[j].y); w.y = pk2(v[j].z, v[j].w); ho[64 * j] = w; }
            float pp[16];
            int lofs = F.lane; asm volatile("" : "+v"(lofs));
#pragma unroll
            for (int jj = 0; jj < 16; ++jj) { float p = 0.f;
#pragma unroll
                for (int j = 0; j < 4; ++j) { const f32x4 w = ((const LAS f32x4*)(wl + jj * D))[lofs + 64 * j]; p += (v[j].x * w.x + v[j].y * w.y) + (v[j].z * w.z + v[j].w * w.w); }
                pp[jj] = p; if ((jj & 3) == 3) asm volatile("" ::: "memory"); }
            const float mine = rs16(pp, F.lane);
            if ((F.lane & 3) == 0) ab[(size_t)t * 16 + (F.lane >> 2)] = mine;
        }
#pragma unroll
        for (int j = 0; j < 4; ++j) { if (MODE == 0) xc[j] = xn[j]; else xcb[j] = xnb[j]; }
        if (MODE != 0) {
#pragma unroll
            for (int k = 0; k < 4; ++k) { dc[k] = dn[k]; gc[k] = gn[k]; } }
    }
}

__device__ __forceinline__ int seq_id(int x) { return x < 0 ? -1 : (x < NLAT ? (x >> 12) : (x < MT ? 8 + ((x - NLAT) >> 8) : -2)); }
__device__ __forceinline__ void conv_phase(const Frame& F, int l) {
    const KArgsP A = kargs();
    LAS float* cw = (LAS float*)F.lds;
#pragma unroll
    for (int j = 0; j < 4; ++j) { const int i4 = F.tid + NTHR * j; if (i4 < 5 * 1536 / 4) *(LAS f32x4*)(cw + 4 * i4) = *(const f32x4*)(A->in[I_CONVW] + (size_t)l * 5 * 1536 + 4 * i4); }
    __syncthreads();
    const bf16* qkvz = (const bf16*)(F.ws + WS_QKVZ); bf16* qkvn = (bf16*)(F.ws + WS_QKVN);
    const float* ab = (const float*)(F.ws + WS_AB); float* gb = (float*)(F.ws + WS_G); float* bb = (float*)(F.ws + WS_BETA);
    constexpr int RUN = MT / (256 * NWAVES);
    static_assert(RUN * 256 * NWAVES == MT, "conv runs");
    for (int run = F.gw; run < MT / RUN; run += F.NGW) {
        const int t0 = run * RUN;
        v4u W[5][3];
#pragma unroll
        for (int k = 0; k < 5; ++k) { const int g = t0 + k - 2, gc = g < 0 ? 0 : (g >= MT ? MT - 1 : g);
#pragma unroll
            for (int q = 0; q < 3; ++q) W[k][q] = *(const v4u*)(qkvz + (size_t)gc * 2048 + q * 512 + 8 * F.lane); }
#pragma unroll 1
        for (int t = t0; t < t0 + RUN; ++t) {
            v4u N[3];
            { const int g = t + 3, gc = g >= MT ? MT - 1 : g;
#pragma unroll
              for (int q = 0; q < 3; ++q) N[q] = *(const v4u*)(qkvz + (size_t)gc * 2048 + q * 512 + 8 * F.lane); }
            const int sid = seq_id(t);
            float a[3][8];
#pragma unroll
            for (int q = 0; q < 3; ++q)
#pragma unroll
                for (int i = 0; i < 8; ++i) a[q][i] = 0.f;
#pragma unroll
            for (int tap = 0; tap < 5; ++tap) { const bool ok = seq_id(t + tap - 2) == sid;
#pragma unroll
                for (int q = 0; q < 3; ++q) { const v4u u = ok ? W[tap][q] : (v4u){0u, 0u, 0u, 0u};
                    const LAS f32x4* wp = (const LAS f32x4*)(cw + tap * 1536 + q * 512 + 8 * F.lane); const f32x4 w0 = wp[0], w1 = wp[1];
                    a[q][0] += bflo(u.x) * w0.x; a[q][1] += bfhi(u.x) * w0.y; a[q][2] += bflo(u.y) * w0.z; a[q][3] += bfhi(u.y) * w0.w;
                    a[q][4] += bflo(u.z) * w1.x; a[q][5] += bfhi(u.z) * w1.y; a[q][6] += bflo(u.w) * w1.z; a[q][7] += bfhi(u.w) * w1.w; } }
#pragma unroll
            for (int q = 0; q < 3; ++q) { float ss = 0.f;
#pragma unroll
                for (int i = 0; i < 8; ++i) { a[q][i] = silu_f(a[q][i]); ss += a[q][i] * a[q][i]; }
                float sc = 1.0f;
                if (q < 2) { ss = sum16(ss); sc = (1.0f / sqrtf(ss + EPS)) * (q == 0 ? 0.08838834764831845f : 1.0f); }
                v4u o; o.x = pk2(a[q][0] * sc, a[q][1] * sc); o.y = pk2(a[q][2] * sc, a[q][3] * sc); o.z = pk2(a[q][4] * sc, a[q][5] * sc); o.w = pk2(a[q][6] * sc, a[q][7] * sc);
                *(v4u*)(qkvn + (size_t)t * 1536 + q * 512 + 8 * F.lane) = o; }
            if (F.lane < 8) { const int d = F.lane >> 2, h = F.lane & 3;
                const float xg = ab[(size_t)t * 16 + d * 8 + h] + A->in[I_DTB][l * 8 + d * 4 + h];
                const float y = __expf(xg), sp = xg > 20.f ? xg : (y < 0.03f ? y * (1.0f - y * (0.5f - y * 0.33333334f)) : __logf(1.0f + y));
                gb[(size_t)t * 8 + F.lane] = -__expf(A->in[I_ALOG][l * 8 + d * 4 + h]) * sp;
                bb[(size_t)t * 8 + F.lane] = __builtin_amdgcn_rcpf(1.0f + __expf(-ab[(size_t)t * 16 + d * 8 + 4 + h])); }
#pragma unroll
            for (int q = 0; q < 3; ++q) { W[0][q] = W[1][q]; W[1][q] = W[2][q]; W[2][q] = W[3][q]; W[3][q] = W[4][q]; W[4][q] = N[q]; }
        }
    }
}

__device__ __forceinline__ void fold_phase(const Frame& F) {
    const bf16* ztl = (const bf16*)(F.ws + WS_ZTL); bf16* eo = (bf16*)(F.ws + WS_EO); float* zn = (float*)(F.ws + WS_ZN);
    const int lam = F.lane;
    for (int row = F.gw; row < 8 * 512; row += F.NGW) {
        const int b = row >> 9, c = row & 511;
        const bf16* zr = ztl + (size_t)row * 8192; const bf16* zi = zr + 4096;
        v4u lo_r[4], hi_r[4], lo_i[4], hi_i[4];
#pragma unroll
        for (int q = 0; q < 4; ++q) { lo_r[q] = *(const v4u*)(zr + 32 * lam + 8 * q); hi_r[q] = *(const v4u*)(zr + 4064 - 32 * lam + 8 * q);
                                      lo_i[q] = *(const v4u*)(zi + 32 * lam + 8 * q); hi_i[q] = *(const v4u*)(zi + 4064 - 32 * lam + 8 * q); }
        float Lr[32], Hr[32], Li[32], Hi[32];
#pragma unroll
        for (int q = 0; q < 4; ++q)
#pragma unroll
            for (int e = 0; e < 4; ++e) { Lr[8 * q + 2 * e] = bflo(lo_r[q][e]); Lr[8 * q + 2 * e + 1] = bfhi(lo_r[q][e]); Hr[8 * q + 2 * e] = bflo(hi_r[q][e]); Hr[8 * q + 2 * e + 1] = bfhi(hi_r[q][e]);
                                          Li[8 * q + 2 * e] = bflo(lo_i[q][e]); Li[8 * q + 2 * e + 1] = bfhi(lo_i[q][e]); Hi[8 * q + 2 * e] = bflo(hi_i[q][e]); Hi[8 * q + 2 * e + 1] = bfhi(hi_i[q][e]); }
        float mr = __shfl_up(Hr[0], 1), mi = __shfl_up(Hi[0], 1); if (lam == 0) { mr = 0.f; mi = 0.f; }
        float E[32], O[32]; float ny = 0.f;
        E[0] = Lr[0] + mr; O[0] = lam == 0 ? 0.f : Li[0] - mi;
#pragma unroll
        for (int j = 1; j < 32; ++j) { E[j] = Lr[j] + Hr[32 - j]; O[j] = Li[j] - Hi[32 - j]; }
#pragma unroll
        for (int j = 0; j < 32; ++j) ny += (j & 1) ? -(Lr[j] + Hr[j]) : (Lr[j] + Hr[j]);
        ny = wave_sum(ny);
        bf16* ep = eo + ((size_t)(b * 2) * 512 + c) * 2048 + 32 * lam; bf16* op = ep + (size_t)512 * 2048;
#pragma unroll
        for (int q = 0; q < 4; ++q) { v4u e4, o4;
            e4.x = pk2(E[8 * q], E[8 * q + 1]); e4.y = pk2(E[8 * q + 2], E[8 * q + 3]); e4.z = pk2(E[8 * q + 4], E[8 * q + 5]); e4.w = pk2(E[8 * q + 6], E[8 * q + 7]);
            o4.x = pk2(O[8 * q], O[8 * q + 1]); o4.y = pk2(O[8 * q + 2], O[8 * q + 3]); o4.z = pk2(O[8 * q + 4], O[8 * q + 5]); o4.w = pk2(O[8 * q + 6], O[8 * q + 7]);
            *(v4u*)(ep + 8 * q) = e4; *(v4u*)(op + 8 * q) = o4; }
        if (lam == 63) zn[row] = Hr[0];
        if (lam == 0) zn[4096 + row] = ny;
    }
}

__device__ __forceinline__ void ctx_dft(const Frame& F) {
    LAS float* cs = (LAS float*)F.lds;
    LAS float* sn = cs + 256;
    LAS bf16* Zt = (LAS bf16*)(sn + 256);
    const bf16* ztc = (const bf16*)(F.ws + WS_ZTC); bf16* mix = (bf16*)(F.ws + WS_ACT);
    const float scale = 1.0f / sqrtf(256.0f * 128.0f);
    __syncthreads();
    if (F.tid < 256) { cs[F.tid] = cospif((float)F.tid * (1.0f / 128.0f)); sn[F.tid] = sinpif((float)F.tid * (1.0f / 128.0f)); }
    const int item = F.vcu - 128;
    if (item < 64) {
        const int b = item >> 3, cg = item & 7;
#pragma unroll
        for (int j = 0; j < 8; ++j) { const int p = F.tid + NTHR * j, c = p >> 6, pc = p & 63;
            *(LAS v4u*)(Zt + c * 520 + pc * 8) = *(const v4u*)(ztc + ((size_t)b * 512 + cg * 64 + c) * 512 + pc * 8); }
        __syncthreads();
        const int l15 = F.lane & 15, l4 = F.lane >> 4, w = F.wave;
        f32x4 acc[4][2];
#pragma unroll
        for (int mt = 0; mt < 4; ++mt)
#pragma unroll
            for (int nt = 0; nt < 2; ++nt) acc[mt][nt] = (f32x4){0.f, 0.f, 0.f, 0.f};
#pragma unroll 2
        for (int ks = 0; ks < 16; ++ks) {
            const LAS float* tw = ks < 8 ? cs : sn; const int l0 = (32 * ks + 8 * l4) & 255;
            pg8::bf16x8 bf[2];
#pragma unroll
            for (int nt = 0; nt < 2; ++nt) { const int lp = 32 * w + 16 * nt + l15; v4u t;
                t.x = pk2(tw[((l0 + 0) * lp) & 255], tw[((l0 + 1) * lp) & 255]); t.y = pk2(tw[((l0 + 2) * lp) & 255], tw[((l0 + 3) * lp) & 255]);
                t.z = pk2(tw[((l0 + 4) * lp) & 255], tw[((l0 + 5) * lp) & 255]); t.w = pk2(tw[((l0 + 6) * lp) & 255], tw[((l0 + 7) * lp) & 255]);
                bf[nt] = __builtin_bit_cast(pg8::bf16x8, t); }
#pragma unroll
            for (int mt = 0; mt < 4; ++mt) { const pg8::bf16x8 a = *(const LAS pg8::bf16x8*)(Zt + (16 * mt + l15) * 520 + 32 * ks + 8 * l4);
#pragma unroll
                for (int nt = 0; nt < 2; ++nt) acc[mt][nt] = RT_MFMA(a, bf[nt], acc[mt][nt]); }
        }
#pragma unroll
        for (int mt = 0; mt < 4; ++mt)
#pragma unroll
            for (int nt = 0; nt < 2; ++nt) { const int lp = 32 * w + 16 * nt + l15; v2u o; o.x = pk2(acc[mt][nt].x * scale, acc[mt][nt].y * scale); o.y = pk2(acc[mt][nt].z * scale, acc[mt][nt].w * scale);
                *(v2u*)(mix + (size_t)(NLAT + b * 256 + lp) * D + cg * 64 + 16 * mt + 4 * l4) = o; }
    }
    __syncthreads();
}

__device__ __forceinline__ void scan_naive(const Frame& F, int l) {
    LAS float* kL = (LAS float*)F.lds;
    LAS float* qL = kL + 64 * 128;
    LAS float* vL = qL + 64 * 128;
    LAS float* oL = vL + 64 * 32;
    LAS float* gL = oL + 64 * 32;
    LAS float* bL = gL + 64;
    const bf16* qkvn = (const bf16*)(F.ws + WS_QKVN);
    const float* gb = (const float*)(F.ws + WS_G); const float* bb = (const float*)(F.ws + WS_BETA);
    for (int unit = F.vcu; unit < 256; unit += F.G) {
        const int qd = unit & 3, s = unit >> 2, d = s & 1, h = (s >> 1) & 3, b = s >> 3;
        bf16* od = (bf16*)(F.ws + (d ? WS_OB : WS_OF));
        const int j = F.tid >> 4, rg = F.tid & 15;
        float S[8];
#pragma unroll
        for (int i = 0; i < 8; ++i) S[i] = 0.f;
#pragma unroll 1
        for (int ci = 0; ci < 68; ++ci) {
            int rowbase; const bool isctx = ci < 4;
            if (isctx) rowbase = NLAT + b * 256 + (d ? 3 - ci : ci) * 64; else { const int lc = ci - 4; rowbase = b * SEQ + (d ? 63 - lc : lc) * 64; }
            __syncthreads();
            for (int i = F.tid; i < 64 * 16; i += NTHR) { const int r = i >> 4, g8 = i & 15; const bf16* rp = qkvn + (size_t)(rowbase + r) * 1536 + h * 128 + g8 * 8;
                const v4u q = *(const v4u*)rp, k = *(const v4u*)(rp + 512);
                LAS float* qo = qL + r * 128 + g8 * 8; LAS float* ko = kL + r * 128 + g8 * 8;
                qo[0] = bflo(q.x); qo[1] = bfhi(q.x); qo[2] = bflo(q.y); qo[3] = bfhi(q.y); qo[4] = bflo(q.z); qo[5] = bfhi(q.z); qo[6] = bflo(q.w); qo[7] = bfhi(q.w);
                ko[0] = bflo(k.x); ko[1] = bfhi(k.x); ko[2] = bflo(k.y); ko[3] = bfhi(k.y); ko[4] = bflo(k.z); ko[5] = bfhi(k.z); ko[6] = bflo(k.w); ko[7] = bfhi(k.w); }
            if (F.tid < 256) { const int r = F.tid >> 2, g8 = F.tid & 3; const v4u v = *(const v4u*)(qkvn + (size_t)(rowbase + r) * 1536 + 1024 + h * 128 + qd * 32 + g8 * 8);
                LAS float* vo = vL + r * 32 + g8 * 8;
                vo[0] = bflo(v.x); vo[1] = bfhi(v.x); vo[2] = bflo(v.y); vo[3] = bfhi(v.y); vo[4] = bflo(v.z); vo[5] = bfhi(v.z); vo[6] = bflo(v.w); vo[7] = bfhi(v.w); }
            else if (F.tid < 320) { const int r = F.tid - 256; gL[r] = __expf(gb[(size_t)(rowbase + r) * 8 + d * 4 + h]); bL[r] = bb[(size_t)(rowbase + r) * 8 + d * 4 + h]; }
            __syncthreads();
#pragma unroll 2
            for (int st = 0; st < 64; ++st) {
                const int r = d ? 63 - st : st;
                const float alpha = gL[r], bt = bL[r];
                const f32x4 k0 = *(const LAS f32x4*)(kL + r * 128 + rg * 8), k1 = *(const LAS f32x4*)(kL + r * 128 + rg * 8 + 4);
                const f32x4 q0 = *(const LAS f32x4*)(qL + r * 128 + rg * 8), q1 = *(const LAS f32x4*)(qL + r * 128 + rg * 8 + 4);
                float part = (k0.x * S[0] + k0.y * S[1]) + (k0.z * S[2] + k0.w * S[3]) + (k1.x * S[4] + k1.y * S[5]) + (k1.z * S[6] + k1.w * S[7]);
                part = sum16(part);
                const float dl = bt * (vL[r * 32 + j] - alpha * part);
                S[0] = alpha * S[0] + k0.x * dl; S[1] = alpha * S[1] + k0.y * dl; S[2] = alpha * S[2] + k0.z * dl; S[3] = alpha * S[3] + k0.w * dl;
                S[4] = alpha * S[4] + k1.x * dl; S[5] = alpha * S[5] + k1.y * dl; S[6] = alpha * S[6] + k1.z * dl; S[7] = alpha * S[7] + k1.w * dl;
                float op = (q0.x * S[0] + q0.y * S[1]) + (q0.z * S[2] + q0.w * S[3]) + (q1.x * S[4] + q1.y * S[5]) + (q1.z * S[6] + q1.w * S[7]);
                op = sum16(op);
                if (rg == 0) oL[r * 32 + j] = op;
            }
            __syncthreads();
            if (!(isctx && l == NL - 1)) { const int r = F.tid >> 3, g4 = F.tid & 7; const LAS float* op = oL + r * 32 + g4 * 4;
                v2u w; w.x = pk2(op[0], op[1]); w.y = pk2(op[2], op[3]);
                *(v2u*)(od + (size_t)(rowbase + r) * 512 + h * 128 + qd * 32 + g4 * 4) = w; }
        }
        __syncthreads();
    }
}

__device__ __forceinline__ void gated_out(const Frame& F, int l) {
    const KArgsP A = kargs();
    const bf16* of = (const bf16*)(F.ws + WS_OF); const bf16* ob = (const bf16*)(F.ws + WS_OB); const bf16* qkvz = (const bf16*)(F.ws + WS_QKVZ);
    const bf16* ab2 = (const bf16*)(F.ws + WS_AB2); const float* zn = (const float*)(F.ws + WS_ZN);
    bf16* mix = (bf16*)(F.ws + WS_ACT);
    const int nrows = l == NL - 1 ? NLAT : MT;
    const float fsc = 1.0f / sqrtf(4096.0f * 128.0f);
    const f32x4 g0 = *(const f32x4*)(A->in[I_GOUT] + l * 128 + (F.lane & 15) * 8), g1 = *(const f32x4*)(A->in[I_GOUT] + l * 128 + (F.lane & 15) * 8 + 4);
    for (int t = F.gw; t < nrows; t += F.NGW) {
        const v4u a = *(const v4u*)(of + (size_t)t * 512 + 8 * F.lane), b = *(const v4u*)(ob + (size_t)t * 512 + 8 * F.lane), z = *(const v4u*)(qkvz + (size_t)t * 2048 + 1536 + 8 * F.lane);
        if (t < NLAT) {
            const int bb_ = t >> 12, lp = t & 4095, k = lp <= 2048 ? lp : 4096 - lp;
            float y[8];
            if (k == 2048) { const f32x4 n0 = *(const f32x4*)(zn + 4096 + bb_ * 512 + 8 * F.lane), n1 = *(const f32x4*)(zn + 4096 + bb_ * 512 + 8 * F.lane + 4);
                y[0] = n0.x; y[1] = n0.y; y[2] = n0.z; y[3] = n0.w; y[4] = n1.x; y[5] = n1.y; y[6] = n1.z; y[7] = n1.w; }
            else { const v4u pa = *(const v4u*)(ab2 + ((size_t)(bb_ * 2) * 2048 + k) * 512 + 8 * F.lane), pb_ = *(const v4u*)(ab2 + ((size_t)(bb_ * 2 + 1) * 2048 + k) * 512 + 8 * F.lane);
                const f32x4 z0 = *(const f32x4*)(zn + bb_ * 512 + 8 * F.lane), z1 = *(const f32x4*)(zn + bb_ * 512 + 8 * F.lane + 4);
                const float sg = lp <= 2048 ? 1.0f : -1.0f, sz = (k & 1) ? -1.0f : 1.0f;
                y[0] = bflo(pa.x) + sg * bflo(pb_.x) + sz * z0.x; y[1] = bfhi(pa.x) + sg * bfhi(pb_.x) + sz * z0.y; y[2] = bflo(pa.y) + sg * bflo(pb_.y) + sz * z0.z; y[3] = bfhi(pa.y) + sg * bfhi(pb_.y) + sz * z0.w;
                y[4] = bflo(pa.z) + sg * bflo(pb_.z) + sz * z1.x; y[5] = bfhi(pa.z) + sg * bfhi(pb_.z) + sz * z1.y; y[6] = bflo(pa.w) + sg * bflo(pb_.w) + sz * z1.z; y[7] = bfhi(pa.w) + sg * bfhi(pb_.w) + sz * z1.w; }
            v4u wy; wy.x = pk2(y[0] * fsc, y[1] * fsc); wy.y = pk2(y[2] * fsc, y[3] * fsc); wy.z = pk2(y[4] * fsc, y[5] * fsc); wy.w = pk2(y[6] * fsc, y[7] * fsc);
            *(v4u*)(mix + (size_t)t * D + 8 * F.lane) = wy;
        }
        float o[8] = {bflo(a.x) + bflo(b.x), bfhi(a.x) + bfhi(b.x), bflo(a.y) + bflo(b.y), bfhi(a.y) + bfhi(b.y), bflo(a.z) + bflo(b.z), bfhi(a.z) + bfhi(b.z), bflo(a.w) + bflo(b.w), bfhi(a.w) + bfhi(b.w)};
        const float zz[8] = {bflo(z.x), bfhi(z.x), bflo(z.y), bfhi(z.y), bflo(z.z), bfhi(z.z), bflo(z.w), bfhi(z.w)};
        const float gg[8] = {g0.x, g0.y, g0.z, g0.w, g1.x, g1.y, g1.z, g1.w};
        float ss = 0.f;
#pragma unroll
        for (int i = 0; i < 8; ++i) ss += o[i] * o[i];
        const float rs = 1.0f / sqrtf(sum16(ss) * (1.0f / 128.0f) + EPS);
#pragma unroll
        for (int i = 0; i < 8; ++i) o[i] = o[i] * rs * gg[i] * silu_f(zz[i]);
        v4u w; w.x = pk2(o[0], o[1]); w.y = pk2(o[2], o[3]); w.z = pk2(o[4], o[5]); w.w = pk2(o[6], o[7]);
        *(v4u*)(mix + (size_t)t * D + 512 + 8 * F.lane) = w;
    }
}

__device__ __forceinline__ void router_phase(const Frame& F, int l, int bank = 0) {
    const KArgsP A = kargs();
    LAS float* gmL = (LAS float*)F.lds;
    LAS float* shL = gmL + 9 * D;
    LAS float* red = shL + 9 * D;
    LAS float* cb = red + 8 * 64 * 9;
    LAS float* rsL = cb + 9 * 32;
    LAS int* lcnt = (LAS int*)(F.lds + XT_OFF);
    LAS int* lbase = lcnt + 32;
    LAS int* sE = lbase + 32;
    LAS int* sP = sE + 144 * 4;
    LAS float* sG = (LAS float*)(sP + 144 * 4);
    const int nrows = l == NL - 1 ? NLAT : MT, ngrp = nrows / 16;
    const int cnt = (ngrp - F.vcu + 255) >> 8;
    const int l15 = F.lane & 15, cw = 128 * F.wave + 8 * (F.lane >> 4);
    { const float* g2 = A->in[I_GN2] + (size_t)l * D;
#pragma unroll
      for (int j = 0; j < 5; ++j) { const int i4 = F.tid + NTHR * j;
          if (i4 < 9 * D / 4) { const int r = i4 >> 8, k = (i4 & 255) * 4; const f32x4 gv = *(const f32x4*)(g2 + k), sv = *(const f32x4*)(modv(F, l, r, 4) + k), hv = *(const f32x4*)(modv(F, l, r, 3) + k);
              *(LAS f32x4*)(gmL + 4 * i4) = gv * (sv + 1.0f); *(LAS f32x4*)(shL + 4 * i4) = hv; } }
      if (F.tid < 32) lcnt[F.tid] = 0; }
    pg8::bf16x8 wh[4][2], wl[4][2];
    { const float* wrt = (const float*)(F.ws + WS_WRT) + (size_t)l * NEXP * D;
#pragma unroll
      for (int ks = 0; ks < 4; ++ks)
#pragma unroll
        for (int mt = 0; mt < 2; ++mt) { const float* wp = wrt + (size_t)(16 * mt + l15) * D + cw + 32 * ks; const f32x4 a = *(const f32x4*)wp, b = *(const f32x4*)(wp + 4);
            const float v[8] = {a.x, a.y, a.z, a.w, b.x, b.y, b.z, b.w}; split_bf(v, wh[ks][mt], wl[ks][mt]); } }
    __syncthreads();
    bf16* h2 = (bf16*)(F.ws + WS_ACT);
    v4u xq[4];
#pragma unroll
    for (int i = 0; i < 4; ++i) xq[i] = (v4u){0u, 0u, 0u, 0u};
    for (int it = -1; it < cnt; ++it) {
        const int g = F.vcu + 256 * it, t = g * 16 + l15, r = it < 0 ? 0 : mod_row(g * 16);
        float xv[4][8]; float ss = 0.f;
        if (it < 0) {
#pragma unroll
            for (int ks = 0; ks < 4; ++ks) { const f32x4 a = *(const LAS f32x4*)(shL + (l15 < 9 ? l15 : 0) * D + cw + 32 * ks), b = *(const LAS f32x4*)(shL + (l15 < 9 ? l15 : 0) * D + cw + 32 * ks + 4); const float m = l15 < 9 ? 1.0f : 0.0f;
                xv[ks][0] = a.x * m; xv[ks][1] = a.y * m; xv[ks][2] = a.z * m; xv[ks][3] = a.w * m; xv[ks][4] = b.x * m; xv[ks][5] = b.y * m; xv[ks][6] = b.z * m; xv[ks][7] = b.w * m; }
        } else {
#pragma unroll
            for (int ks = 0; ks < 4; ++ks) { const v4u xu = xq[ks]; const f32x4 a = {bflo(xu.x), bfhi(xu.x), bflo(xu.y), bfhi(xu.y)}, b = {bflo(xu.z), bfhi(xu.z), bflo(xu.w), bfhi(xu.w)}; const f32x4 ga = *(const LAS f32x4*)(gmL + r * D + cw + 32 * ks), gb = *(const LAS f32x4*)(gmL + r * D + cw + 32 * ks + 4);
                ss += (a.x * a.x + a.y * a.y) + (a.z * a.z + a.w * a.w) + (b.x * b.x + b.y * b.y) + (b.z * b.z + b.w * b.w);
                xv[ks][0] = a.x * ga.x; xv[ks][1] = a.y * ga.y; xv[ks][2] = a.z * ga.z; xv[ks][3] = a.w * ga.w; xv[ks][4] = b.x * gb.x; xv[ks][5] = b.y * gb.y; xv[ks][6] = b.z * gb.z; xv[ks][7] = b.w * gb.w; }
        }
        if (it + 1 < cnt) { const bf16* xr = xr_row(F, (g + 256) * 16 + l15) + cw;
#pragma unroll
            for (int ks = 0; ks < 4; ++ks) xq[ks] = *(const v4u*)(xr + 32 * ks); }
        f32x4 acc[2] = {{0.f, 0.f, 0.f, 0.f}, {0.f, 0.f, 0.f, 0.f}};
#pragma unroll
        for (int ks = 0; ks < 4; ++ks) { pg8::bf16x8 xh, xl; split_bf(xv[ks], xh, xl);
#pragma unroll
            for (int mt = 0; mt < 2; ++mt) { acc[mt] = RT_MFMA(wl[ks][mt], xl, acc[mt]); acc[mt] = RT_MFMA(wl[ks][mt], xh, acc[mt]); acc[mt] = RT_MFMA(wh[ks][mt], xl, acc[mt]); acc[mt] = RT_MFMA(wh[ks][mt], xh, acc[mt]); } }
        { LAS float* rp = red + (F.wave * 64 + F.lane) * 9;
          rp[0] = acc[0].x; rp[1] = acc[0].y; rp[2] = acc[0].z; rp[3] = acc[0].w; rp[4] = acc[1].x; rp[5] = acc[1].y; rp[6] = acc[1].z; rp[7] = acc[1].w; rp[8] = ss; }
        __syncthreads();
        {
            const int rho = 2 * F.wave + (F.lane >> 5), e = F.lane & 31;
            const int src = (((e & 15) >> 2) * 16 + rho) * 9 + (e >> 4) * 4 + (e & 3);
            float s = 0.f;
#pragma unroll
            for (int wv = 0; wv < 8; ++wv) s += red[wv * 576 + src];
            if (it < 0) { if (rho < 9) cb[rho * 32 + e] = s + A->in[I_BR][l * NEXP + e]; }
            else {
                float sq = red[((e >> 2) * 64 + (e & 3) * 16 + rho) * 9 + 8];
                sq = row16_sum(sq); sq += __shfl_xor(sq, 16);
                const float rstd = 1.0f / sqrtf(sq * (1.0f / D) + EPS);
                float lg = s * rstd + cb[r * 32 + e];
                int se[4]; float sv[4];
#pragma unroll
                for (int k = 0; k < 4; ++k) {
                    float m = lg;
                    m = row16_max(m); m = fmaxf(m, __shfl_xor(m, 16));
                    const unsigned long long bal = __ballot(lg == m); const unsigned hb = (unsigned)(bal >> (F.lane & 32));
                    const int idx = __ffs((int)hb) - 1;
                    se[k] = idx; sv[k] = m; if (e == idx) lg = -3.0e38f;
                }
                const float e1 = __expf(sv[1] - sv[0]), e2 = __expf(sv[2] - sv[0]), e3 = __expf(sv[3] - sv[0]), inv = 1.0f / (1.0f + e1 + e2 + e3);
                if (e == 0) {
                    rsL[rho] = rstd;
                    const int ri = it * 16 + rho; const float gt[4] = {inv, e1 * inv, e2 * inv, e3 * inv};
#pragma unroll
                    for (int k = 0; k < 4; ++k) { sE[ri * 4 + k] = se[k]; sP[ri * 4 + k] = __hip_atomic_fetch_add(lcnt + se[k], 1, __ATOMIC_RELAXED, __HIP_MEMORY_SCOPE_WORKGROUP); sG[ri * 4 + k] = gt[k]; } }
            }
        }
        __syncthreads();
        if (it >= 0) { const float rs = rsL[l15]; bf16* ho = h2 + (size_t)t * D + cw;
#pragma unroll
            for (int ks = 0; ks < 4; ++ks) { const f32x4 sa = *(const LAS f32x4*)(shL + r * D + cw + 32 * ks), sb = *(const LAS f32x4*)(shL + r * D + cw + 32 * ks + 4);
                v4u w; w.x = pk2(xv[ks][0] * rs + sa.x, xv[ks][1] * rs + sa.y); w.y = pk2(xv[ks][2] * rs + sa.z, xv[ks][3] * rs + sa.w); w.z = pk2(xv[ks][4] * rs + sb.x, xv[ks][5] * rs + sb.y); w.w = pk2(xv[ks][6] * rs + sb.z, xv[ks][7] * rs + sb.w);
                *(v4u*)(ho + 32 * ks) = w; } }
    }
    __syncthreads();
    if (F.tid < 32) { const int n = lcnt[F.tid]; lbase[F.tid] = n ? (int)__hip_atomic_fetch_add(F.ctl + CW_GCNT + ((bank * 2 + l) * 32 + F.tid) * 64, (unsigned)n, RLX_AGENT) : 0; }
    __syncthreads();
    { int* selp = (int*)(F.ws + WS_SELP); float* selg = (float*)(F.ws + WS_SELG); unsigned* goff = (unsigned*)(F.ws + WS_GOFF);
      for (int i = F.tid; i < cnt * 64; i += NTHR) { const int ri = i >> 2, t = (F.vcu + 256 * (ri >> 4)) * 16 + (ri & 15); const size_t o = (size_t)t * 4 + (i & 3);
          const int e = sE[i], pos = lbase[e] + sP[i]; selp[o] = (e << 20) | pos; selg[o] = sG[i];
          const int h = (pos >> 7) & 1, R = pos & 127;
          unsigned* gp = goff + (size_t)(e * GT_BLK + (pos >> 8)) * 2048 + h * 2;
#pragma unroll
          for (int cp = 0; cp < 8; ++cp) { const int b = pg8::lds_byte(R, 8 * cp);
              gp[((b & 8191) >> 4) * 4 + (b >> 13)] = (unsigned)(t * 2048 + 16 * cp); } } }
}

constexpr size_t WS_PW = WS_OB + 34 * MiB;
constexpr size_t WS_PKET = WS_PW + 68 * MiB;
constexpr size_t WS_PUT = WS_PKET + 68 * MiB;
constexpr size_t WS_PATT = WS_PUT + 68 * MiB;
constexpr size_t WS_PGAM = WS_PATT + 34 * MiB;
static_assert(WS_PGAM + 6 * MiB <= WS_END, "prep map");
typedef short bf16x8_t __attribute__((ext_vector_type(8)));
#define MFMA16(a, b, c) __builtin_amdgcn_mfma_f32_16x16x32_bf16((a), (b), (c), 0, 0, 0)
__device__ __forceinline__ v2u pack4(const f32x4 v) { v2u w; w.x = pk2(v.x, v.y); w.y = pk2(v.z, v.w); return w; }
__device__ __forceinline__ int chunk_rowbase(int b, int cn) { return cn < 4 ? NLAT + b * CTXL + cn * 64 : b * SEQ + (cn - 4) * 64; }

#ifdef PROBE_PREP
#define PSTAMP(k) do { const unsigned long long t_ = __builtin_amdgcn_s_memrealtime(); if (PROBE_PREP == (k)) pp_acc += t_ - pp_last; pp_last = t_; } while (0)
#else
#define PSTAMP(k) do {} while (0)
#endif
__device__ __forceinline__ void prep_phase(const Frame& F) {
#ifdef PROBE_PREP
    unsigned long long pp_acc = 0ull, pp_last = 0ull;
#endif
    LAS bf16* k_rm = (LAS bf16*)F.lds;
    LAS bf16* q_rm = k_rm + 64 * 136;
    LAS bf16* kT = (LAS bf16*)(F.lds + 36864);
    LAS bf16* vT = kT + 128 * 72;
    LAS float* Gm = (LAS float*)(F.lds + 36864 + 36864);
    LAS float* A0 = Gm + 64 * 72;
    LAS float* bs = (LAS float*)(F.lds + 36864 + 36864 + 36864);
    LAS float* gam = bs + 128;
    const bf16* qkvn = (const bf16*)(F.ws + WS_QKVN);
    const float* gb = (const float*)(F.ws + WS_G); const float* bb = (const float*)(F.ws + WS_BETA);
    const int w = F.wave;
    v4u ld[2][3];
    {
        int tid_ = F.tid; asm volatile("" : "+v"(tid_));
        const int unit = F.vcu;
        if (unit < 32 * 68) { const int bh = unit / 68, cn = unit % 68, rowbase = chunk_rowbase(bh >> 2, cn);
#pragma unroll
            for (int it = 0; it < 2; ++it) { const int p = tid_ + it * NTHR, i = p & 63, c8 = p >> 6; const bf16* rp = qkvn + (size_t)(rowbase + i) * 1536 + (bh & 3) * 128 + c8 * 8;
                ld[it][0] = *(const v4u*)rp; ld[it][1] = *(const v4u*)(rp + 512); ld[it][2] = *(const v4u*)(rp + 1024); } }
    }
    for (int unit = F.vcu; unit < 32 * 68; unit += F.G) {
        int tid_ = F.tid; asm volatile("" : "+v"(tid_));
        const int tid = tid_, lane = tid & 63, l15 = lane & 15, l4 = lane >> 4;
        const int bh = unit / 68, cn = unit % 68, b = bh >> 2, h = bh & 3, rowbase = chunk_rowbase(b, cn);
        const size_t pu = (size_t)(bh * 68 + cn) * 2;
        __syncthreads();
        PSTAMP(0);
#pragma unroll
        for (int it = 0; it < 2; ++it) { const int p = tid + it * NTHR, i = p & 63, c8 = p >> 6;
            const v4u qv = ld[it][0], kv = ld[it][1], vv = ld[it][2];
            *(LAS v4u*)(q_rm + i * 136 + c8 * 8) = qv; *(LAS v4u*)(k_rm + i * 136 + c8 * 8) = kv;
#pragma unroll
            for (int e = 0; e < 4; ++e) { const unsigned kw = kv[e], vw = vv[e];
                kT[(c8 * 8 + 2 * e) * 72 + i] = (bf16)(kw & 0xffffu); kT[(c8 * 8 + 2 * e + 1) * 72 + i] = (bf16)(kw >> 16);
                vT[(c8 * 8 + 2 * e) * 72 + i] = (bf16)(vw & 0xffffu); vT[(c8 * 8 + 2 * e + 1) * 72 + i] = (bf16)(vw >> 16); } }
        if (w < 2) { const int d = w; float g = gb[(size_t)(rowbase + lane) * 8 + d * 4 + h]; bs[d * 64 + lane] = bb[(size_t)(rowbase + lane) * 8 + d * 4 + h];
            if (d == 0) {
#pragma unroll
                for (int o = 1; o < 64; o <<= 1) { const float t = __shfl_up(g, o); if (lane >= o) g += t; } }
            else {
#pragma unroll
                for (int o = 1; o < 64; o <<= 1) { const float t = __shfl_down(g, o); if (lane + o < 64) g += t; } }
            gam[d * 64 + lane] = g; }
        {
            const int un = unit + F.G;
            if (un < 32 * 68) { const int bh2 = un / 68, cn2 = un % 68, rb2 = chunk_rowbase(bh2 >> 2, cn2);
#pragma unroll
                for (int it = 0; it < 2; ++it) { const int p = tid + it * NTHR, i = p & 63, c8 = p >> 6; const bf16* rp = qkvn + (size_t)(rb2 + i) * 1536 + (bh2 & 3) * 128 + c8 * 8;
                    ld[it][0] = *(const v4u*)rp; ld[it][1] = *(const v4u*)(rp + 512); ld[it][2] = *(const v4u*)(rp + 1024); } }
        }
        __syncthreads();
        PSTAMP(1);
        { bf16* qz = (bf16*)(F.ws + WS_QKVZ);
#pragma unroll
          for (int it = 0; it < 2; ++it) { const int p = tid + it * NTHR, tl = p >> 6, ln = p & 63, rt_ = tl >> 2, ks_ = tl & 3;
              const v4u qv = *(const LAS v4u*)(q_rm + (16 * rt_ + (ln & 15)) * 136 + 32 * ks_ + 8 * (ln >> 4));
              *(v4u*)(qz + (size_t)(rowbase + 16 * h + tl) * 2048 + ln * 8) = qv; } }
#pragma unroll
        for (int tt = 0; tt < 2; ++tt) { const int idx = 2 * w + tt, ti = idx >> 2, tj = idx & 3;
            f32x4 aG = {0.f, 0.f, 0.f, 0.f}, aA = {0.f, 0.f, 0.f, 0.f};
#pragma unroll
            for (int ks = 0; ks < 4; ++ks) { const int co = 32 * ks + 8 * l4;
                const bf16x8_t bk = *(const LAS bf16x8_t*)(k_rm + (16 * tj + l15) * 136 + co), ak = *(const LAS bf16x8_t*)(k_rm + (16 * ti + l15) * 136 + co), aq = *(const LAS bf16x8_t*)(q_rm + (16 * ti + l15) * 136 + co);
                aG = MFMA16(ak, bk, aG); aA = MFMA16(aq, bk, aA); }
#pragma unroll
            for (int r = 0; r < 4; ++r) { Gm[(16 * ti + 4 * l4 + r) * 72 + 16 * tj + l15] = aG[r]; A0[(16 * ti + 4 * l4 + r) * 72 + 16 * tj + l15] = aA[r]; } }
        __syncthreads();
        PSTAMP(2);
        for (int idx = tid; idx < 8192; idx += NTHR) { const int d = idx >> 12, ip = (idx >> 6) & 63, jp = idx & 63, i = d ? 63 - ip : ip, j = d ? 63 - jp : jp;
            ((LAS float*)(F.lds + d * 18432))[idx & 4095] = jp < ip ? bs[d * 64 + i] * Gm[i * 72 + j] * __expf(gam[d * 64 + i] - gam[d * 64 + j]) : 0.f; }
        __syncthreads();
        PSTAMP(3);
        if (w < 2) {
            const int d = w; const LAS float* Lr = (const LAS float*)(F.lds + d * 18432);
            const int blk = lane >> 5, cc = lane & 31;
            const LAS float* Lb = Lr + (32 * blk) * 64 + 32 * blk;
            LAS bf16* SB = (LAS bf16*)(F.lds + 36864 + 36864 + 36864 + 1024 + d * 9216);
            LAS bf16* L21b = SB;
            LAS bf16* T22r = SB + 32 * 40;
            LAS bf16* T11T = SB + 64 * 40;
            LAS bf16* XT = T11T + 32 * 32;
            float t[32];
            f32x4 LA[8], LB[8];
#pragma unroll
            for (int ip = 0; ip < 32; ++ip) {
                if (ip + 1 < 32) {
#pragma unroll
                    for (int j4 = 0; j4 < (ip + 4) / 4; ++j4) { const f32x4 Lv = *(const LAS f32x4*)(Lb + (ip + 1) * 64 + 4 * j4); if (ip & 1) LA[j4] = Lv; else LB[j4] = Lv; }
                }
                float a0 = (cc == ip) ? 1.f : 0.f, a1 = 0.f, a2 = 0.f, a3 = 0.f;
#pragma unroll
                for (int j4 = 0; j4 < (ip + 3) / 4; ++j4) { const f32x4 Lv = (ip & 1) ? LB[j4] : LA[j4];
                    if (4 * j4 + 0 < ip) a0 -= Lv.x * t[4 * j4 + 0];
                    if (4 * j4 + 1 < ip) a1 -= Lv.y * t[4 * j4 + 1];
                    if (4 * j4 + 2 < ip) a2 -= Lv.z * t[4 * j4 + 2];
                    if (4 * j4 + 3 < ip) a3 -= Lv.w * t[4 * j4 + 3]; }
                t[ip] = (a0 + a1) + (a2 + a3); asm volatile("" ::: "memory"); }
            { const int i = lane >> 1, j0 = (lane & 1) * 16; const LAS f32x4* lp = (const LAS f32x4*)(Lr + (32 + i) * 64 + j0);
              const f32x4 x0 = lp[0], x1 = lp[1], x2 = lp[2], x3 = lp[3];
              v4u o0, o1; o0.x = pk2(x0.x, x0.y); o0.y = pk2(x0.z, x0.w); o0.z = pk2(x1.x, x1.y); o0.w = pk2(x1.z, x1.w); o1.x = pk2(x2.x, x2.y); o1.y = pk2(x2.z, x2.w); o1.z = pk2(x3.x, x3.y); o1.w = pk2(x3.z, x3.w);
              *(LAS v4u*)(L21b + i * 40 + j0) = o0; *(LAS v4u*)(L21b + i * 40 + j0 + 8) = o1; }
            if (blk == 0) {
#pragma unroll
                for (int q = 0; q < 4; ++q) { v4u o; o.x = pk2(t[8 * q], t[8 * q + 1]); o.y = pk2(t[8 * q + 2], t[8 * q + 3]); o.z = pk2(t[8 * q + 4], t[8 * q + 5]); o.w = pk2(t[8 * q + 6], t[8 * q + 7]);
                    *(LAS v4u*)(T11T + cc * 32 + 8 * q) = o; }
            } else {
#pragma unroll
                for (int ip = 0; ip < 32; ++ip) T22r[ip * 40 + cc] = (bf16)f2bf(t[ip]);
            }
            asm volatile("s_waitcnt lgkmcnt(0)" ::: "memory");
            f32x4 xa[2][2];
#pragma unroll
            for (int ti = 0; ti < 2; ++ti) { const bf16x8_t af = *(const LAS bf16x8_t*)(L21b + (16 * ti + l15) * 40 + 8 * l4);
#pragma unroll
                for (int tj = 0; tj < 2; ++tj) { const bf16x8_t bf = *(const LAS bf16x8_t*)(T11T + (16 * tj + l15) * 32 + 8 * l4);
                    xa[ti][tj] = MFMA16(af, bf, ((f32x4){0.f, 0.f, 0.f, 0.f}));
                    *(LAS v2u*)(XT + (16 * tj + l15) * 32 + 16 * ti + 4 * l4) = pack4(xa[ti][tj]); } }
            asm volatile("s_waitcnt lgkmcnt(0)" ::: "memory");
#pragma unroll
            for (int ti = 0; ti < 2; ++ti) { const bf16x8_t af = *(const LAS bf16x8_t*)(T22r + (16 * ti + l15) * 40 + 8 * l4);
#pragma unroll
                for (int tj = 0; tj < 2; ++tj) { const bf16x8_t bf = *(const LAS bf16x8_t*)(XT + (16 * tj + l15) * 32 + 8 * l4);
                    xa[ti][tj] = MFMA16(af, bf, ((f32x4){0.f, 0.f, 0.f, 0.f})); } }
            asm volatile("s_waitcnt lgkmcnt(0)" ::: "memory");
            LAS bf16* Tu = (LAS bf16*)(F.lds + d * 18432); LAS bf16* Tw = Tu + 64 * 72;
            {
                const int jp = 32 * blk + cc, jn = d ? 63 - jp : jp; const float bj = bs[d * 64 + jn], bge = bj * __expf(gam[d * 64 + jn]);
#pragma unroll
                for (int ip = 0; ip < 32; ++ip) { const int ipp = 32 * blk + ip, in = d ? 63 - ipp : ipp; Tu[in * 72 + jn] = (bf16)f2bf(t[ip] * bj); Tw[in * 72 + jn] = (bf16)f2bf(t[ip] * bge); }
                if (blk == 1) {
#pragma unroll
                    for (int ip = 0; ip < 32; ++ip) { const int in = d ? 63 - ip : ip; Tu[in * 72 + jn] = (bf16)0; Tw[in * 72 + jn] = (bf16)0; } }
            }
#pragma unroll
            for (int tj = 0; tj < 2; ++tj) {
                const int jp = 16 * tj + l15, jn = d ? 63 - jp : jp; const float bj = bs[d * 64 + jn], bge = bj * __expf(gam[d * 64 + jn]);
#pragma unroll
                for (int ti = 0; ti < 2; ++ti)
#pragma unroll
                    for (int r = 0; r < 4; ++r) { const int ipp = 32 + 16 * ti + 4 * l4 + r, in = d ? 63 - ipp : ipp; const float v = -xa[ti][tj][r];
                        Tu[in * 72 + jn] = (bf16)f2bf(v * bj); Tw[in * 72 + jn] = (bf16)f2bf(v * bge); } }
        } else {
            const int t6 = tid - 128;
            for (int it = t6; it < 1024; it += NTHR - 128) { const int d = it >> 9, i = (it >> 3) & 63, j0 = (it & 7) * 8; float v[8];
#pragma unroll
                for (int e = 0; e < 8; ++e) { const int j = j0 + e; const bool in = d ? (j >= i) : (j <= i); v[e] = in ? A0[i * 72 + j] * __expf(gam[d * 64 + i] - gam[d * 64 + j]) : 0.f; }
                v4u o; o.x = pk2(v[0], v[1]); o.y = pk2(v[2], v[3]); o.z = pk2(v[4], v[5]); o.w = pk2(v[6], v[7]);
                *(v4u*)((bf16*)(F.ws + WS_PATT) + (pu + d) * 4096 + ((((i >> 4) * 2 + (j0 >> 5)) * 64 + ((j0 & 31) >> 3) * 16 + (i & 15)) * 8)) = o; }
            for (int it = t6; it < 2048; it += NTHR - 128) { const int d = it >> 10, dk = (it >> 3) & 127, j0 = (it & 7) * 8; const float gl = d ? gam[64] : gam[63]; float v[8];
                const v4u kk = *(const LAS v4u*)(kT + dk * 72 + j0);
                v[0] = bflo(kk.x); v[1] = bfhi(kk.x); v[2] = bflo(kk.y); v[3] = bfhi(kk.y); v[4] = bflo(kk.z); v[5] = bfhi(kk.z); v[6] = bflo(kk.w); v[7] = bfhi(kk.w);
#pragma unroll
                for (int e = 0; e < 8; ++e) v[e] *= __expf(gl - gam[d * 64 + j0 + e]);
                v4u o; o.x = pk2(v[0], v[1]); o.y = pk2(v[2], v[3]); o.z = pk2(v[4], v[5]); o.w = pk2(v[6], v[7]);
                *(v4u*)((bf16*)(F.ws + WS_PKET) + (pu + d) * 8192 + ((((dk >> 4) * 2 + (j0 >> 5)) * 64 + ((j0 & 31) >> 3) * 16 + (dk & 15)) * 8)) = o; }
            if (t6 < 128) ((float*)(F.ws + WS_PGAM))[(pu + (t6 >> 6)) * 64 + (t6 & 63)] = gam[t6];
        }
        __syncthreads();
        PSTAMP(4);
        {
            const int d = w >> 2, ww = w & 3;
            const LAS bf16* Tu = (const LAS bf16*)(F.lds + d * 18432); const LAS bf16* Tw = Tu + 64 * 72;
            bf16x8_t tu[2], tw[2];
#pragma unroll
            for (int ks = 0; ks < 2; ++ks) { tu[ks] = *(const LAS bf16x8_t*)(Tu + (16 * ww + l15) * 72 + 32 * ks + 8 * l4); tw[ks] = *(const LAS bf16x8_t*)(Tw + (16 * ww + l15) * 72 + 32 * ks + 8 * l4); }
            bf16* ut = (bf16*)(F.ws + WS_PUT) + (pu + d) * 8192; bf16* wg = (bf16*)(F.ws + WS_PW) + (pu + d) * 8192;
#pragma unroll 2
            for (int tj = 0; tj < 8; ++tj) {
                f32x4 au = {0.f, 0.f, 0.f, 0.f}, aw = {0.f, 0.f, 0.f, 0.f};
#pragma unroll
                for (int ks = 0; ks < 2; ++ks) { const bf16x8_t bv = *(const LAS bf16x8_t*)(vT + (16 * tj + l15) * 72 + 32 * ks + 8 * l4), ak = *(const LAS bf16x8_t*)(kT + (16 * tj + l15) * 72 + 32 * ks + 8 * l4);
                    au = MFMA16(tu[ks], bv, au); aw = MFMA16(ak, tw[ks], aw); }
                *(v2u*)(ut + ((((tj >> 2) * 4 + ww) * 2 + ((tj & 3) >> 1)) * 512 + (l4 * 16 + l15) * 8 + (tj & 1) * 4)) = pack4(au);
                *(v2u*)(wg + ((ww * 4 + (tj >> 1)) * 512 + ((2 * (tj & 1) + (l4 >> 1)) * 16 + l15) * 8 + 4 * (l4 & 1))) = pack4(aw);
            }
        }
        PSTAMP(5);
    }
    __syncthreads();
#ifdef PROBE_PREP
    if (F.vcu == 0 && F.tid == 0) *(unsigned long long*)(F.ws + WS_ZN + 48 * 1024) += pp_acc;
#endif
}

struct ScanRegs { bf16x8_t fa[4], fx[2], kf[2]; f32x4 graw; float glast; int rowbase, cn; };
__device__ __forceinline__ void scan_load(ScanRegs& R, const unsigned char* ws, int ci_in, int b, int bh, int h, int d, int s, int w, int l15, int l4) {
    const int ci = ci_in < 68 ? ci_in : 67, rt = w & 3;
    const int cn = ci < 4 ? (d ? 3 - ci : ci) : 4 + (d ? 67 - ci : ci - 4);
    R.cn = cn; R.rowbase = chunk_rowbase(b, cn);
    const size_t pu = (size_t)(bh * 68 + cn) * 2 + d;
    const float* gmp = (const float*)(ws + WS_PGAM) + pu * 64;
    R.glast = gmp[d ? 0 : 63]; R.graw = *(const f32x4*)(gmp + 16 * rt + 4 * l4);
    const int ln8 = (l4 * 16 + l15) * 8;
    const bf16* ket = (const bf16*)(ws + WS_PKET) + pu * 8192 + (w * 2) * 512 + ln8;
    R.kf[0] = *(const bf16x8_t*)ket; R.kf[1] = *(const bf16x8_t*)(ket + 512);
    const bf16* wp = (const bf16*)(ws + WS_PW) + pu * 8192 + (rt * 4) * 512 + ln8;
    const bf16* qp = (const bf16*)(ws + WS_QKVZ) + (size_t)(R.rowbase + 16 * h + 4 * rt) * 2048 + ln8;
    const bf16* ap_ = w < 4 ? wp : qp; const int kst = w < 4 ? 512 : 2048;
#pragma unroll
    for (int ks = 0; ks < 4; ++ks) R.fa[ks] = *(const bf16x8_t*)(ap_ + kst * ks);
    const bf16* up = (const bf16*)(ws + WS_PUT) + pu * 8192 + ((s * 4 + rt) * 2) * 512 + ln8;
    const bf16* ap = (const bf16*)(ws + WS_PATT) + pu * 4096 + (rt * 2) * 512 + ln8;
    const bf16* xp = w < 4 ? up : ap; const int xo = 512;
    R.fx[0] = *(const bf16x8_t*)xp; R.fx[1] = *(const bf16x8_t*)(xp + xo);
#ifdef SCAN_DUP_LOADS
    { bf16x8_t d0 = *(const volatile bf16x8_t*)ket, d1 = *(const volatile bf16x8_t*)(ket + 512), d2 = *(const volatile bf16x8_t*)ap_, d3 = *(const volatile bf16x8_t*)(ap_ + kst), d4 = *(const volatile bf16x8_t*)(ap_ + 2 * kst), d5 = *(const volatile bf16x8_t*)(ap_ + 3 * kst), d6 = *(const volatile bf16x8_t*)xp, d7 = *(const volatile bf16x8_t*)(xp + xo);
      asm volatile("" :: "v"(d0), "v"(d1), "v"(d2), "v"(d3), "v"(d4), "v"(d5), "v"(d6), "v"(d7)); }
#endif
}
#if defined(PROBE_SCAN) && PROBE_SCAN >= 2
#define SCAN_SYNC(n) do { const unsigned long long t0_ = __builtin_amdgcn_s_memrealtime(); __syncthreads(); if (PROBE_SCAN == 2 || PROBE_SCAN == 2 + (n)) g_pacc += __builtin_amdgcn_s_memrealtime() - t0_; } while (0)
#else
#define SCAN_SYNC(n) __syncthreads()
#endif
__device__ __forceinline__ void scan_step(const ScanRegs& R, f32x4 (&S)[4], LAS bf16* ST, LAS bf16* vnT, LAS bf16* oS, bf16* od, bf16* dump, bool skip_ctx_out, int h, int s, int w, int l15, int l4, int tid, unsigned long long& g_pacc) {
#if defined(PROBE_SCAN) && PROBE_SCAN == 6
    const unsigned long long tp0_ = __builtin_amdgcn_s_memrealtime();
#endif
    const int rt = w & 3;
    const float gend = __expf(R.glast);
    const bool hiw = w >= 4;
    const f32x4 eg = {hiw ? __expf(R.graw.x) : 1.0f, hiw ? __expf(R.graw.y) : 1.0f, hiw ? __expf(R.graw.z) : 1.0f, hiw ? __expf(R.graw.w) : 1.0f};
    bf16x8_t fa[4];
#pragma unroll
    for (int ks = 0; ks < 4; ++ks) fa[ks] = R.fa[ks];
    f32x4 c[4]; bf16x8_t bq[4][4];
#pragma unroll
    for (int ct = 0; ct < 4; ++ct)
#pragma unroll
        for (int ks = 0; ks < 4; ++ks) bq[ct][ks] = *(const LAS bf16x8_t*)(ST + (16 * ct + l15) * 136 + 32 * ks + 8 * l4);
    __builtin_amdgcn_sched_barrier(0);
#pragma unroll
    for (int ct = 0; ct < 4; ++ct) c[ct] = (f32x4){0.f, 0.f, 0.f, 0.f};
#pragma unroll
    for (int ks = 0; ks < 4; ++ks)
#pragma unroll
        for (int ct = 0; ct < 4; ++ct) c[ct] = MFMA16(fa[ks], bq[ct][ks], c[ct]);
#pragma unroll
    for (int ct = 0; ct < 4; ++ct) c[ct] = c[ct] * eg;
    {
        const v4u ua = __builtin_bit_cast(v4u, R.fx[0]), ub = __builtin_bit_cast(v4u, R.fx[1]);
        const f32x4 u0 = {bflo(ua.x), bfhi(ua.x), bflo(ua.y), bfhi(ua.y)}, u1 = {bflo(ua.z), bfhi(ua.z), bflo(ua.w), bfhi(ua.w)};
        const f32x4 u2 = {bflo(ub.x), bfhi(ub.x), bflo(ub.y), bfhi(ub.y)}, u3 = {bflo(ub.z), bfhi(ub.z), bflo(ub.w), bfhi(ub.w)};
        LAS bf16* vp = vnT + (w < 4 ? 0 : 64 * 72) + l15 * 72 + 16 * rt + 4 * l4;
        *(LAS v2u*)(vp) = pack4(u0 - c[0]); *(LAS v2u*)(vp + 16 * 72) = pack4(u1 - c[1]); *(LAS v2u*)(vp + 32 * 72) = pack4(u2 - c[2]); *(LAS v2u*)(vp + 48 * 72) = pack4(u3 - c[3]);
    }
#if defined(PROBE_SCAN) && PROBE_SCAN == 6
    asm volatile("s_waitcnt lgkmcnt(0)" ::: "memory"); g_pacc += __builtin_amdgcn_s_memrealtime() - tp0_;
#endif
    SCAN_SYNC(1);
    {
        LAS bf16* op = oS + (w < 4 ? 64 * 72 : 0) + (16 * rt + 4 * l4) * 72 + l15;
        bf16x8_t v0[4], v1[4];
#pragma unroll
        for (int ct = 0; ct < 4; ++ct) { v0[ct] = *(const LAS bf16x8_t*)(vnT + (16 * ct + l15) * 72 + 8 * l4); v1[ct] = *(const LAS bf16x8_t*)(vnT + (16 * ct + l15) * 72 + 32 + 8 * l4); }
        __builtin_amdgcn_sched_barrier(0);
        f32x4 o[4], sn[4];
#pragma unroll
        for (int ct = 0; ct < 4; ++ct) { o[ct] = MFMA16(R.fx[0], v0[ct], c[ct]); sn[ct] = S[ct] * gend; }
#pragma unroll
        for (int ct = 0; ct < 4; ++ct) { o[ct] = MFMA16(R.fx[1], v1[ct], o[ct]); sn[ct] = MFMA16(R.kf[0], v0[ct], sn[ct]); }
#pragma unroll
        for (int ct = 0; ct < 4; ++ct) { sn[ct] = MFMA16(R.kf[1], v1[ct], sn[ct]); S[ct] = sn[ct]; }
#pragma unroll
        for (int ct = 0; ct < 4; ++ct) {
#pragma unroll
            for (int r = 0; r < 4; ++r) op[r * 72 + 16 * ct] = (bf16)f2bf(o[ct][r]);
            *(LAS v2u*)(ST + (16 * ct + l15) * 136 + 16 * w + 4 * l4) = pack4(sn[ct]); }
    }
    SCAN_SYNC(2);
    {
        const int i = tid >> 3, pc = tid & 7;
        const v4u ov = *(const LAS v4u*)(oS + i * 72 + pc * 8);
        const bool real = !(R.cn < 4 && skip_ctx_out);
        bf16* gp = real ? od + (size_t)(R.rowbase + i) * 512 + h * 128 + 64 * s + pc * 8 : dump + (size_t)i * 64 + pc * 8;
        *(v4u*)gp = ov;
    }
}
__device__ __forceinline__ void scan_mfma(const Frame& F, int l) {
    LAS bf16* ST = (LAS bf16*)F.lds;
    LAS bf16* vnT = ST + 64 * 136;
    LAS bf16* oS = vnT + 2 * 64 * 72;
    const int lane = F.lane, l15 = lane & 15, l4 = lane >> 4, w = F.wave;
    const bool skip_ctx_out = (l == NL - 1);
    if (w >= 4) __builtin_amdgcn_s_setprio(1);
    for (int unit = F.vcu; unit < 128; unit += F.G) {
#if defined(PROBE_SCAN) && PROBE_SCAN == 7
        const unsigned long long t7_ = __builtin_amdgcn_s_memrealtime();
#endif
        const int s = unit & 1, sd = unit >> 1, d = sd & 1, bh = sd >> 1, b = bh >> 2, h = bh & 3;
        bf16* od = (bf16*)(F.ws + (d ? WS_OB : WS_OF)); bf16* dump = (bf16*)(F.ws + WS_PGAM + 1536 * 1024) + (size_t)unit * 16 * 512;
        __syncthreads();
        for (int i = F.tid; i < 64 * 136 / 2; i += NTHR) ((LAS unsigned*)ST)[i] = 0u;
        f32x4 S[4];
#pragma unroll
        for (int ct = 0; ct < 4; ++ct) S[ct] = (f32x4){0.f, 0.f, 0.f, 0.f};
        ScanRegs R0, R1, R2;
        scan_load(R0, F.ws, 0, b, bh, h, d, s, w, l15, l4); scan_load(R1, F.ws, 1, b, bh, h, d, s, w, l15, l4); scan_load(R2, F.ws, 2, b, bh, h, d, s, w, l15, l4);
        __syncthreads();
        unsigned long long pacc = 0ull;
#pragma unroll 1
        for (int ci = 0; ci < 66; ci += 3) {
#if defined(PROBE_SCAN) && PROBE_SCAN == 1
            { const unsigned long long t0 = __builtin_amdgcn_s_memrealtime(); asm volatile("s_waitcnt vmcnt(0)" ::: "memory"); pacc += __builtin_amdgcn_s_memrealtime() - t0; }
#endif
            scan_step(R0, S, ST, vnT, oS, od, dump, skip_ctx_out, h, s, w, l15, l4, F.tid, pacc); scan_load(R0, F.ws, ci + 3, b, bh, h, d, s, w, l15, l4);
            scan_step(R1, S, ST, vnT, oS, od, dump, skip_ctx_out, h, s, w, l15, l4, F.tid, pacc); scan_load(R1, F.ws, ci + 4, b, bh, h, d, s, w, l15, l4);
            scan_step(R2, S, ST, vnT, oS, od, dump, skip_ctx_out, h, s, w, l15, l4, F.tid, pacc); scan_load(R2, F.ws, ci + 5, b, bh, h, d, s, w, l15, l4);
        }
        scan_step(R0, S, ST, vnT, oS, od, dump, skip_ctx_out, h, s, w, l15, l4, F.tid, pacc);
        scan_step(R1, S, ST, vnT, oS, od, dump, skip_ctx_out, h, s, w, l15, l4, F.tid, pacc);
#if defined(PROBE_SCAN) && PROBE_SCAN == 7
        pacc = __builtin_amdgcn_s_memrealtime() - t7_;
#endif
#ifdef PROBE_SCAN
        if (F.vcu == 0 && F.tid == PROBE_TID) *(unsigned long long*)(F.ws + WS_ZN + 48 * 1024) += pacc;
#endif
    }
    __builtin_amdgcn_s_setprio(0);
}


#ifndef USE_NAIVE_SCAN
#define USE_NAIVE_SCAN 0
#endif
#ifndef REP_MASK
#define REP_MASK 0
#endif
#define REPS(p) for (int _r = 0; _r < 1 + ((REP_MASK >> (p)) & 1); ++_r)
#define LASTREP(p) (_r == ((REP_MASK >> (p)) & 1))
constexpr int PH_PER_LAYER = 11, N_PHASES = 2 + NL * PH_PER_LAYER;
#ifndef PG8_SP2
#define PG8_SP2 true
#endif
#ifndef PG8_ALIGN
#define PG8_ALIGN true
#endif
__device__ __forceinline__ Frame make_frame(int wv) {
    extern __shared__ __attribute__((aligned(16))) unsigned char lds[];
    const KArgsP A = kargs();
    Frame F;
    { unsigned lb = (unsigned)(uintptr_t)(LAS unsigned char*)lds; asm volatile("" : "+s"(lb)); F.lds = (LAS unsigned char*)(uintptr_t)lb; }
    F.MISC = (volatile LAS unsigned*)(F.lds + MISC_OFF);
    { unsigned m1 = ~0u; asm volatile("" : "+s"(m1)); int ln = (int)__builtin_amdgcn_mbcnt_hi(m1, __builtin_amdgcn_mbcnt_lo(m1, 0u)); asm volatile("" : "+v"(ln)); F.lane = ln; }
    { int w_ = wv; asm volatile("" : "+s"(w_)); F.wave = w_; } F.tid = F.wave * 64 + F.lane;
    F.G = gridDim.x; { const int bx = blockIdx.x; F.vcu = (F.G % 8 == 0) ? (bx % 8) * (F.G / 8) + bx / 8 : bx; }
    F.gw = F.vcu * NWAVES + F.wave; F.NGW = F.G * NWAVES;
    F.ws = A->ws; F.ctl = (unsigned*)(A->ws + WS_CTL); F.out = A->out;
    return F;
}
__global__ void __launch_bounds__(NTHR, 2) mk_fwd(Args args) {
    const int wv = __builtin_amdgcn_readfirstlane((int)threadIdx.x >> 6);
    { Frame F = make_frame(wv);
      for (int u = F.tid; u < (LDS_BYTES - LDSCTL_OFF) / 4; u += NTHR) ((LAS unsigned*)(F.lds + LDSCTL_OFF))[u] = 0u;
      __syncthreads(); }
    const int lo = args.ph_lo, hi = args.ph_hi;
#if defined(PROBE_SCAN) || defined(PROBE_ROUTER) || defined(PROBE_PREP) || defined(PROBE_SCAN2) || defined(PROBE_DFT) || defined(PROBE_P0)
    { Frame Fp = make_frame(wv); if (Fp.vcu == 0 && Fp.tid == 0) *(unsigned long long*)(Fp.ws + WS_ZN + 48 * 1024) = 0ull; }
#endif
#ifdef PROBE_P
    unsigned long long pr_acc = 0ull, pr_t0 = 0ull;
#define PR_BEGIN(p) do { if (((p) < 2 ? (p) : 2 + ((p) - 2) % PH_PER_LAYER) == PROBE_P) pr_t0 = __builtin_amdgcn_s_memrealtime(); } while (0)
#define PR_END(p) do { if (((p) < 2 ? (p) : 2 + ((p) - 2) % PH_PER_LAYER) == PROBE_P) pr_acc += __builtin_amdgcn_s_memrealtime() - pr_t0; } while (0)
#else
#define PR_BEGIN(p) do {} while (0)
#define PR_END(p) do {} while (0)
#endif
    if (hi - lo > 1) { Frame F = make_frame(wv); (void)xcd_barrier_post((unsigned*)(F.ctl + CW_BAR), F.MISC + 8, F.tid); }
#define IN(k) (lo <= (k) && (k) < hi)
#define SEAM(k) do { if (IN(k) && IN((k) + 1)) { Frame Fb = make_frame(wv); XcdBarrier bar; bar.bar = (unsigned*)(Fb.ctl + CW_BAR); bar.x = xb_xcc_id(); bar.st = Fb.MISC + 8; xcd_barrier(bar, Fb.tid); } } while (0)
    PR_BEGIN(0); if (IN(0)) { Frame F = make_frame(wv); REPS(0) { p0_prologue(F); __syncthreads(); } }
    SEAM(0); PR_END(0);
    PR_BEGIN(1); if (IN(1)) { Frame F = make_frame(wv); REPS(1) { row_pass<0>(F, 0, 0); __syncthreads(); } }
    SEAM(1); PR_END(1);
#ifndef PROBE_DVCU
#define PROBE_DVCU 128
#endif
#ifdef PROBE_DFT
    unsigned long long dft_last = 0ull;
#define DSTAMP(k) do { const unsigned long long t_ = __builtin_amdgcn_s_memrealtime(); if ((PROBE_DFT == (k) || (PROBE_DFT == 9 && (k) > 0)) && F.vcu == PROBE_DVCU && F.tid == 0) *(unsigned long long*)(F.ws + WS_ZN + 48 * 1024) += t_ - dft_last; dft_last = t_; } while (0)
#else
#define DSTAMP(k) do {} while (0)
#endif
#define LAYER_BODY(l) { \
        const int pb = 2 + l * PH_PER_LAYER; \
        PR_BEGIN(pb + 0); if (IN(pb + 0)) { Frame F = make_frame(wv); \
            SchedIn S{(const bf16*)(F.ws + WS_ACT), (const bf16*)(F.ws + WS_WIN) + (size_t)l * 3072 * D, F.G, (int)blockIdx.x}; \
            EpiIn E{(bf16*)(F.ws + WS_QKVZ), (bf16*)(F.ws + WS_ZTL), (bf16*)(F.ws + WS_ZTC)}; \
            REPS(8) { pg8::gemm_phase<EpiIn, SchedIn, PG8_ALIGN, PG8_SP2>(F.lds, pg8::Gemm{D}, S, E, F.tid); __syncthreads(); } \
            if ((int)blockIdx.x >= CVT_GWG) { Frame F3 = make_frame(wv); convert_experts(F3, l, CVT_G, CVT_ITEMS, ((int)blockIdx.x - CVT_GWG) * NWAVES + F3.wave, (256 - CVT_GWG) * NWAVES); } } \
        SEAM(pb + 0); PR_END(pb + 0); \
        PR_BEGIN(pb + 1); if (IN(pb + 1)) { Frame F = make_frame(wv); REPS(2) { conv_phase(F, l); __syncthreads(); } fold_phase(F); } \
        SEAM(pb + 1); PR_END(pb + 1); \
        PR_BEGIN(pb + 2); if (IN(pb + 2)) { \
            { Frame F = make_frame(wv); REPS(3) { prep_phase(F); } } \
        } \
        SEAM(pb + 2); PR_END(pb + 2); \
        PR_BEGIN(pb + 3); if (IN(pb + 3)) { Frame F = make_frame(wv); \
            if (F.vcu < 128) { REPS(4) { scan_mfma(F, l); __syncthreads(); } \
              convert_experts(F, l, CVT_MID, CVT_G, F.vcu * NWAVES + F.wave, 128 * NWAVES); } \
            else { \
              SchedDft S{(const bf16*)(F.ws + WS_DFTM), (const bf16*)(F.ws + WS_EO), F.vcu - 128}; \
              EpiDft E{(bf16*)(F.ws + WS_AB2)}; \
              DSTAMP(0); REPS(9) { pg8::gemm_phase<EpiDft, SchedDft, PG8_ALIGN, PG8_SP2>(F.lds, pg8::Gemm{2048}, S, E, F.tid); __syncthreads(); } DSTAMP(1); \
              if (l == 0) ctx_dft(F); \
              __syncthreads(); DSTAMP(2); convert_experts(F, l, CVT_SPLIT, CVT_MID, (F.vcu - 128) * NWAVES + F.wave, 128 * NWAVES); DSTAMP(3); } \
        } \
        SEAM(pb + 3); PR_END(pb + 3); \
        PR_BEGIN(pb + 4); if (IN(pb + 4)) { Frame F = make_frame(wv); REPS(5) { gated_out(F, l); __syncthreads(); } } \
        SEAM(pb + 4); PR_END(pb + 4); \
        PR_BEGIN(pb + 5); if (IN(pb + 5)) { Frame F = make_frame(wv); \
            SchedOut S{(const bf16*)(F.ws + WS_ACT), (const bf16*)(F.ws + WS_WOUT) + (size_t)l * D * D, l == NL - 1 ? NLAT / 256 : MT / 256, F.G, (int)blockIdx.x}; \
            REPS(10) { EpiOut<(l != 0)> E{xr_row(F, 0), xr_row(F, NLAT), l == 0 ? (const void*)kargs()->in[I_X] : (const void*)xr_row(F, 0), l == 0 ? (const void*)kargs()->in[I_CTX] : (const void*)xr_row(F, NLAT), modv(F, l, 0, 2), LASTREP(10) ? 1.0f : 0.0f}; \
                pg8::gemm_phase<EpiOut<(l != 0)>, SchedOut, PG8_ALIGN, PG8_SP2>(F.lds, pg8::Gemm{D}, S, E, F.tid); __syncthreads(); } } \
        SEAM(pb + 5); PR_END(pb + 5); \
        PR_BEGIN(pb + 6); if (IN(pb + 6)) { Frame F = make_frame(wv); REPS(6) { router_phase(F, l, LASTREP(6) ? 0 : 1); __syncthreads(); } } \
        SEAM(pb + 6); PR_END(pb + 6); \
        PR_BEGIN(pb + 8); if (IN(pb + 8)) { Frame F = make_frame(wv); \
            LAS int* pend = (LAS int*)(F.lds + XT_OFF); moe_layout(F, l, pend, pend + 32); \
            SchedMoe S{(const bf16*)(F.ws + WS_ACT), (const bf16*)(F.ws + WS_W1), (size_t)2048 * D * 2, pend, pend[NEXP - 1], 8, F.G, (int)blockIdx.x, 1}; \
            EpiSwiglu E{(bf16*)(F.ws + WS_HS), kargs()->in[I_BG] + (size_t)l * NEXP * D, kargs()->in[I_BU] + (size_t)l * NEXP * D}; \
            REPS(11) { pg8::gemm_phase<EpiSwiglu, SchedMoe, PG8_ALIGN, PG8_SP2, true>(F.lds, pg8::Gemm{D}, S, E, F.tid, (const unsigned*)(F.ws + WS_GOFF), F.lds + XT_OFF + 1024, (unsigned)MT * 2048u); __syncthreads(); } } \
        SEAM(pb + 8); PR_END(pb + 8); \
        PR_BEGIN(pb + 9); if (IN(pb + 9)) { Frame F = make_frame(wv); \
            LAS int* pend = (LAS int*)(F.lds + XT_OFF); moe_layout(F, l, pend, pend + 32); \
            SchedMoe S{(const bf16*)(F.ws + WS_HS), (const bf16*)(F.ws + WS_W2), (size_t)D * D * 2, pend, pend[NEXP - 1], 4, F.G, (int)blockIdx.x, 0}; \
            EpiDown E{(bf16*)(F.ws + WS_XS), kargs()->in[I_BD] + (size_t)l * NEXP * D}; \
            REPS(12) { pg8::gemm_phase<EpiDown, SchedMoe, PG8_ALIGN, PG8_SP2>(F.lds, pg8::Gemm{D}, S, E, F.tid); __syncthreads(); } } \
        SEAM(pb + 9); PR_END(pb + 9); \
        PR_BEGIN(pb + 10); if (IN(pb + 10)) { \
            { Frame F = make_frame(wv); \
              if (l == NL - 1) row_pass<2>(F, l, l); else { REPS(13) { row_pass<1>(F, l, l + 1, !LASTREP(13)); __syncthreads(); } } } \
            if (l != NL - 1) { Frame F = make_frame(wv); __syncthreads(); REPS(14) { convert_experts(F, l + 1, 0, CVT_SPLIT, F.gw, F.NGW); __syncthreads(); } } \
        } \
        if (l + 1 < NL) SEAM(pb + 10); PR_END(pb + 10); \
    }
    LAYER_BODY(0)
    LAYER_BODY(1)
#undef LAYER_BODY
#ifdef PROBE_P
#if defined(PROBE_SCAN) || defined(PROBE_ROUTER) || defined(PROBE_PREP) || defined(PROBE_SCAN2) || defined(PROBE_DFT) || defined(PROBE_P0)
    { Frame Fp = make_frame(wv); if (Fp.vcu == 0 && Fp.tid == 0) pr_acc = *(unsigned long long*)(Fp.ws + WS_ZN + 48 * 1024); else pr_acc = 0; }
#endif
    if (blockIdx.x == 0 && threadIdx.x == 0) { const unsigned long long t0 = __builtin_amdgcn_s_memrealtime(), want = pr_acc * PROBE_SCALE; while (__builtin_amdgcn_s_memrealtime() - t0 < want) __builtin_amdgcn_s_sleep(8); }
#endif
#undef IN
#undef SEAM
}

extern "C" void kernel_launch(void* const* d_in, const int* in_sizes, int n_in, void* d_out, int out_size, void* d_ws, size_t ws_size, hipStream_t stream) {
    static int grid = 0;
    if (grid == 0) {
        if (n_in != 23 || out_size != NLAT * D || ws_size < WS_END) { fprintf(stderr, "kernel_launch: unexpected shapes (n_in %d, out %d, ws %zu); nothing launched\n", n_in, out_size, ws_size); grid = -1; return; }
        int dev = 0, cus = 0, per_cu = 0;
        if (hipGetDevice(&dev) != hipSuccess || hipDeviceGetAttribute(&cus, hipDeviceAttributeMultiprocessorCount, dev) != hipSuccess) { grid = -1; return; }
        if (hipFuncSetAttribute((const void*)mk_fwd, hipFuncAttributeMaxDynamicSharedMemorySize, LDS_BYTES) != hipSuccess) { fprintf(stderr, "kernel_launch: hipFuncSetAttribute failed\n"); grid = -1; return; }
        if (hipOccupancyMaxActiveBlocksPerMultiprocessor(&per_cu, (const void*)mk_fwd, NTHR, LDS_BYTES) != hipSuccess || per_cu < 1)
            fprintf(stderr, "kernel_launch: note: occupancy query reports %d workgroups per CU\n", per_cu);
        (void)hipGetLastError();
        grid = cus;
        if (grid != 256) { fprintf(stderr, "kernel_launch: built for 256 CUs, found %d; nothing launched\n", grid); grid = -1; return; }
    }
    if (grid < 0) return;
    if (hipMemsetAsync((char*)d_ws + WS_CTL, 0, CTL_ZERO_BYTES, stream) != hipSuccess) { fprintf(stderr, "kernel_launch: hipMemsetAsync failed\n"); return; }
    Args a{};
    for (int i = 0; i < 23; ++i) a.in[i] = (const float*)d_in[i];
    a.out = (float*)d_out; a.ws = (unsigned char*)d_ws;
#if MK_ONE_LAUNCH
    a.ph_lo = 0; a.ph_hi = N_PHASES;
    hipLaunchKernelGGL(mk_fwd, dim3(grid), dim3(NTHR), LDS_BYTES, stream, a);
#else
    for (int p = 0; p < N_PHASES; ++p) { a.ph_lo = p; a.ph_hi = p + 1; hipLaunchKernelGGL(mk_fwd, dim3(grid), dim3(NTHR), LDS_BYTES, stream, a); }
#endif
    const hipError_t le = hipPeekAtLastError();
    if (le != hipSuccess) fprintf(stderr, "kernel_launch: launch failed: %s\n", hipGetErrorName(le));
}
```
